# Optimizing an MI355X kernel written in HIP

```python
import jax, jax.numpy as jnp
from jax import lax
import numpy as np

D_MODEL = 2048
BATCH = 4
SEQ = 4096
DEPTH = 1

HEAD_DIM = 128
DIL_PATTERNS = ((128, 1), (512, 4), (2048, 16))
HEADS_PER_DIL_GROUP = 4
N_HEADS_DIL = HEADS_PER_DIL_GROUP * len(DIL_PATTERNS)
N_HEADS_SB = 8
WIDTH_DIL = N_HEADS_DIL * HEAD_DIM
WIDTH_SB = N_HEADS_SB * HEAD_DIM
D_DIL_OUT = HEADS_PER_DIL_GROUP * HEAD_DIM
Q_BLOCK = 128
ROPE_THETA = 500000.0
ROPE_DIM = HEAD_DIM // 4
N_BRANCHES = 2
D_IN = 3 * (WIDTH_DIL + WIDTH_SB) + N_BRANCHES * D_MODEL
N_EXPERTS = 64
TOP_K = 8
N_EXPERT_GROUPS = 8
TOPK_GROUPS = 4
D_EXPERT = 512
D_SHARED = 512
ROUTED_SCALE = 2.5
MOE_BLOCK = 256
RMS_EPS = 1e-6
N_MOD = 6

kernel_name = "hybrid_dilated_stickbreak_moe_layer"


def rms_norm(x, g):
    xf = x.astype(jnp.float32)
    y = xf * lax.rsqrt(jnp.mean(xf * xf, axis=-1, keepdims=True) + RMS_EPS)
    return (y * g.astype(jnp.float32)).astype(x.dtype)


def partial_rope(x, positions):
    inv_freq = ROPE_THETA ** (-jnp.arange(0, ROPE_DIM, 2, dtype=jnp.float32) / ROPE_DIM)
    ang = positions.astype(jnp.float32)[..., None] * inv_freq
    cos = jnp.cos(ang)[:, :, None, :]
    sin = jnp.sin(ang)[:, :, None, :]
    xr = x[..., :ROPE_DIM].astype(jnp.float32)
    x1, x2 = jnp.split(xr, 2, axis=-1)
    rot = jnp.concatenate([x1 * cos - x2 * sin, x2 * cos + x1 * sin], axis=-1)
    return jnp.concatenate([rot.astype(x.dtype), x[..., ROPE_DIM:]], axis=-1)


def dilated_window_attention(q, k, v, window, dilation):
    b, s, h, dh = q.shape
    w_sub = window // dilation
    L = s // dilation
    nb = -(-L // Q_BLOCK)
    Lp = nb * Q_BLOCK

    def split(t):
        t = t.reshape(b, L, dilation, h, dh).transpose(0, 2, 3, 1, 4)
        return jnp.pad(t, ((0, 0), (0, 0), (0, 0), (0, Lp - L), (0, 0)))

    def band(t):
        tp = jnp.pad(t, ((0, 0), (0, 0), (0, 0), (Q_BLOCK, 0), (0, 0)))
        tp = tp.reshape(b, dilation, h, nb + 1, Q_BLOCK, dh)
        return jnp.concatenate([tp[:, :, :, :-1], tp[:, :, :, 1:]], axis=4)

    qb = split(q).reshape(b, dilation, h, nb, Q_BLOCK, dh)
    kb = band(split(k))
    vb = band(split(v))
    scores = jnp.einsum('bdhnqe,bdhnke->bdhnqk', qb, kb).astype(jnp.float32) * (dh ** -0.5)
    qi = jnp.arange(nb)[:, None] * Q_BLOCK + jnp.arange(Q_BLOCK)[None, :]
    kj = (jnp.arange(nb)[:, None] - 1) * Q_BLOCK + jnp.arange(2 * Q_BLOCK)[None, :]
    rel = qi[:, :, None] - kj[:, None, :]
    mask = (rel >= 0) & (rel <= w_sub) & (kj[:, None, :] >= 0)
    scores = jnp.where(mask, scores, -jnp.inf)
    m = jnp.max(scores, axis=-1, keepdims=True)
    p = jnp.exp(scores - m)
    l = jnp.sum(p, axis=-1, keepdims=True)
    o = jnp.einsum('bdhnqk,bdhnke->bdhnqe', (p / l).astype(v.dtype), vb)
    lse = (m + jnp.log(l))[..., 0]
    o = o.reshape(b, dilation, h, Lp, dh)[:, :, :, :L].transpose(0, 3, 1, 2, 4).reshape(b, s, h, dh)
    lse = lse.reshape(b, dilation, h, Lp)[..., :L].transpose(0, 3, 1, 2).reshape(b, s, h)
    return o, lse


def stick_breaking_attention(q, k, v):
    b, s, h, dh = q.shape
    nb = s // Q_BLOCK
    qb = q.reshape(b, nb, Q_BLOCK, h, dh).transpose(1, 0, 3, 2, 4)
    kt = k.transpose(0, 2, 1, 3)
    vt = v.transpose(0, 2, 1, 3)
    key_pos = jnp.arange(s)

    def block(args):
        qblk, n = args
        z = jnp.einsum('bhqe,bhke->bhqk', qblk, kt).astype(jnp.float32) * (dh ** -0.5)
        qpos = n * Q_BLOCK + jnp.arange(Q_BLOCK)
        mask = key_pos[None, :] < qpos[:, None]
        log_1m = jnp.where(mask, jax.nn.log_sigmoid(-z), 0.0)
        tail = lax.cumsum(log_1m, axis=3, reverse=True) - log_1m
        a = jnp.where(mask, jnp.exp(jax.nn.log_sigmoid(z) + tail), 0.0)
        return jnp.einsum('bhqk,bhke->bhqe', a.astype(v.dtype), vt)

    o = lax.map(block, (qb, jnp.arange(nb)))
    return o.transpose(1, 0, 3, 2, 4).reshape(b, s, h * dh)


def hybrid_mixer(h, positions, w_in, w_dil_out, w_sb_out, w_mix_out):
    b, s, _ = h.shape
    proj = h @ w_in
    sizes = [WIDTH_DIL] * 3 + [WIDTH_SB] * 3 + [N_BRANCHES * D_MODEL]
    idx = np.cumsum(sizes)[:-1].tolist()
    qa, ka, va, qs, ks, vs, gate_logits = jnp.split(proj, idx, axis=-1)

    qa = partial_rope(qa.reshape(b, s, N_HEADS_DIL, HEAD_DIM), positions)
    ka = partial_rope(ka.reshape(b, s, N_HEADS_DIL, HEAD_DIM), positions)
    va = va.reshape(b, s, N_HEADS_DIL, HEAD_DIM)
    outs, lses = [], []
    for g, (window, dilation) in enumerate(DIL_PATTERNS):
        sl = slice(g * HEADS_PER_DIL_GROUP, (g + 1) * HEADS_PER_DIL_GROUP)
        o_g, lse_g = dilated_window_attention(qa[:, :, sl], ka[:, :, sl], va[:, :, sl], window, dilation)
        outs.append(o_g)
        lses.append(lse_g)
    o_stack = jnp.stack(outs, axis=2).astype(jnp.float32)
    wts = jax.nn.softmax(jnp.stack(lses, axis=2), axis=2)
    o_dil = jnp.sum(wts[..., None] * o_stack, axis=2).astype(h.dtype).reshape(b, s, D_DIL_OUT)

    o_sb = stick_breaking_attention(qs.reshape(b, s, N_HEADS_SB, HEAD_DIM),
                                    ks.reshape(b, s, N_HEADS_SB, HEAD_DIM),
                                    vs.reshape(b, s, N_HEADS_SB, HEAD_DIM))

    y_dil = o_dil @ w_dil_out
    y_sb = o_sb @ w_sb_out
    g_dil, g_sb = jnp.split(jax.nn.sigmoid(gate_logits), N_BRANCHES, axis=-1)
    return (g_dil * y_dil + g_sb * y_sb) @ w_mix_out


def swiglu(x, wg, wu, wd):
    return (jax.nn.silu(x @ wg) * (x @ wu)) @ wd


def routed_experts(uf, top_idx, top_w, w_gate_e, w_up_e, w_down_e):
    n, d = uf.shape
    nk = n * TOP_K
    flat_e = top_idx.reshape(-1)
    flat_tok = jnp.arange(nk, dtype=jnp.int32) // TOP_K
    flat_w = top_w.reshape(-1)
    order = jnp.argsort(flat_e)
    se = flat_e[order]
    counts = jnp.bincount(flat_e, length=N_EXPERTS)
    padded = (counts + MOE_BLOCK - 1) // MOE_BLOCK * MOE_BLOCK
    starts = jnp.cumsum(counts) - counts
    pends = jnp.cumsum(padded)
    pstarts = pends - padded
    dest = pstarts[se] + jnp.arange(nk, dtype=jnp.int32) - starts[se]
    n_blocks = -(-nk // MOE_BLOCK) + N_EXPERTS
    cap = n_blocks * MOE_BLOCK
    slot_tok = jnp.full((cap,), n, dtype=jnp.int32).at[dest].set(flat_tok[order])
    slot_w = jnp.zeros((cap,), jnp.float32).at[dest].set(flat_w[order])
    block_e = jnp.minimum(jnp.searchsorted(pends, jnp.arange(n_blocks) * MOE_BLOCK, side='right'),
                          N_EXPERTS - 1)
    u_pad = jnp.concatenate([uf, jnp.zeros((1, d), uf.dtype)], axis=0)

    def block(args):
        tok, wb, e = args
        yb = swiglu(u_pad[tok], w_gate_e[e], w_up_e[e], w_down_e[e])
        return yb * wb[:, None].astype(yb.dtype)

    yb = lax.map(block, (slot_tok.reshape(n_blocks, MOE_BLOCK), slot_w.reshape(n_blocks, MOE_BLOCK), block_e))
    out = jnp.zeros((n + 1, d), uf.dtype).at[slot_tok].add(yb.reshape(cap, d))
    return out[:n]


def moe_ffn(u, w_router, router_bias, w_gate_e, w_up_e, w_down_e, w_gate_s, w_up_s, w_down_s):
    b, s, d = u.shape
    n = b * s
    uf = u.reshape(n, d)
    scores = jax.nn.sigmoid((uf @ w_router).astype(jnp.float32))
    sel = scores + router_bias.astype(jnp.float32)
    grouped = sel.reshape(n, N_EXPERT_GROUPS, N_EXPERTS // N_EXPERT_GROUPS)
    group_score = lax.top_k(grouped, 2)[0].sum(-1)
    _, top_groups = lax.top_k(group_score, TOPK_GROUPS)
    group_mask = jax.nn.one_hot(top_groups, N_EXPERT_GROUPS, dtype=jnp.float32).sum(1) > 0
    expert_mask = jnp.repeat(group_mask, N_EXPERTS // N_EXPERT_GROUPS, axis=-1)
    _, top_idx = lax.top_k(jnp.where(expert_mask, sel, -jnp.inf), TOP_K)
    top_s = jnp.take_along_axis(scores, top_idx, axis=-1)
    top_w = top_s / jnp.sum(top_s, axis=-1, keepdims=True) * ROUTED_SCALE
    routed = routed_experts(uf, top_idx.astype(jnp.int32), top_w, w_gate_e, w_up_e, w_down_e)
    shared = swiglu(uf, w_gate_s, w_up_s, w_down_s)
    return (routed + shared).reshape(b, s, d)


def setup_inputs(seed: int = 0) -> dict:
    key = jax.random.key(seed)
    ks = jax.random.split(key, 24)
    f32 = jnp.float32
    D, L = D_MODEL, DEPTH

    def nrm(k, shape, fan_in, scale=1.0):
        return jax.random.normal(k, shape, f32) * (scale * fan_in ** -0.5)

    offsets = jax.random.randint(ks[2], (BATCH, 1), 0, SEQ, dtype=jnp.int32)
    positions = offsets + jnp.arange(SEQ, dtype=jnp.int32)[None, :]
    return {
        "x": jax.random.normal(ks[0], (BATCH, SEQ, D), f32),
        "c": jax.random.normal(ks[1], (BATCH, D), f32),
        "positions": positions,
        "w_ada": nrm(ks[3], (L, D, N_MOD * D), D, 0.5),
        "b_ada": 0.02 * jax.random.normal(ks[4], (L, N_MOD * D), f32),
        "g_pre_mix": 1.0 + 0.05 * jax.random.normal(ks[5], (L, D), f32),
        "g_post_mix": 1.0 + 0.05 * jax.random.normal(ks[6], (L, D), f32),
        "g_pre_ffn": 1.0 + 0.05 * jax.random.normal(ks[7], (L, D), f32),
        "g_post_ffn": 1.0 + 0.05 * jax.random.normal(ks[8], (L, D), f32),
        "w_in": nrm(ks[9], (L, D, D_IN), D),
        "w_dil_out": nrm(ks[10], (L, D_DIL_OUT, D), D_DIL_OUT),
        "w_sb_out": nrm(ks[11], (L, WIDTH_SB, D), WIDTH_SB),
        "w_mix_out": nrm(ks[12], (L, D, D), D),
        "w_router": nrm(ks[13], (L, D, N_EXPERTS), D),
        "router_bias": 0.01 * jax.random.normal(ks[14], (L, N_EXPERTS), f32),
        "w_gate_e": nrm(ks[15], (L, N_EXPERTS, D, D_EXPERT), D),
        "w_up_e": nrm(ks[16], (L, N_EXPERTS, D, D_EXPERT), D),
        "w_down_e": nrm(ks[17], (L, N_EXPERTS, D_EXPERT, D), D_EXPERT),
        "w_gate_s": nrm(ks[18], (L, D, D_SHARED), D),
        "w_up_s": nrm(ks[19], (L, D, D_SHARED), D),
        "w_down_s": nrm(ks[20], (L, D_SHARED, D), D_SHARED),
    }


def reference(x, c, positions, w_ada, b_ada, g_pre_mix, g_post_mix, g_pre_ffn, g_post_ffn,
              w_in, w_dil_out, w_sb_out, w_mix_out, w_router, router_bias,
              w_gate_e, w_up_e, w_down_e, w_gate_s, w_up_s, w_down_s):
    for l in range(DEPTH):
        mod = jax.nn.silu(c) @ w_ada[l] + b_ada[l]
        shift1, scale1, gate1, shift2, scale2, gate2 = [m[:, None, :] for m in jnp.split(mod, N_MOD, axis=-1)]
        h = rms_norm(x, g_pre_mix[l]) * (1.0 + scale1) + shift1
        y = hybrid_mixer(h, positions, w_in[l], w_dil_out[l], w_sb_out[l], w_mix_out[l])
        x = x + gate1 * rms_norm(y, g_post_mix[l])
        h = rms_norm(x, g_pre_ffn[l]) * (1.0 + scale2) + shift2
        y = moe_ffn(h, w_router[l], router_bias[l], w_gate_e[l], w_up_e[l], w_down_e[l],
                    w_gate_s[l], w_up_s[l], w_down_s[l])
        x = x + gate2 * rms_norm(y, g_post_ffn[l])
    return x
```

```cpp
#include <hip/hip_runtime.h>
#include <stdint.h>
#include <stdio.h>

#ifndef MK_FUSED
#define MK_FUSED 0
#endif

#define LAS __attribute__((address_space(3)))
#define DI __device__ __forceinline__
typedef unsigned short bf16_t;
typedef short bf16x8 __attribute__((ext_vector_type(8)));
typedef short s16x4 __attribute__((ext_vector_type(4)));
typedef float f32x2 __attribute__((ext_vector_type(2)));
typedef float f32x4 __attribute__((ext_vector_type(4)));
typedef float f32x16 __attribute__((ext_vector_type(16)));
typedef unsigned u32x2 __attribute__((ext_vector_type(2)));
typedef unsigned u32x4 __attribute__((ext_vector_type(4)));
typedef __bf16 bf16x2_t __attribute__((ext_vector_type(2)));

constexpr int NBATCH = 4, SEQ = 4096, NTOK = NBATCH * SEQ, DM = 2048, DIN = 11776;
constexpr int COL_QA = 0, COL_KA = 1536, COL_VA = 3072, COL_QS = 4608, COL_KS = 5632, COL_VS = 6656, COL_GD = 7680, COL_GS = 9728;
constexpr int NE = 64, DE = 512, NEX = 65;
constexpr int LIST_CAP = 16384;
constexpr float RMS_EPS = 1e-6f;
constexpr float QSCALE = 0.08838834764831845f * 1.4426950408889634f;
constexpr float LN2 = 0.6931471805599453f;

constexpr size_t MiB = 1ull << 20;
constexpr size_t WS_BAR = 0;
constexpr size_t WS_CNT = 16384;
constexpr size_t WS_ZERO_BYTES = 32768;
constexpr size_t WS_MOD = 65536;
constexpr size_t WS_LSE = 262144;
constexpr size_t WS_ROPE = 1 * MiB;
constexpr size_t WS_W9 = 3 * MiB;
constexpr size_t WS_LIST = 4 * MiB;
constexpr size_t WS_WD = 8 * MiB;
constexpr size_t WS_H = 138 * MiB;
constexpr size_t WS_HID = 202 * MiB;
constexpr size_t WS_WTIN = 202 * MiB;
constexpr size_t WS_WTDIL = 248 * MiB;
constexpr size_t WS_WTSB = 250 * MiB;
constexpr size_t WS_WTMIX = 254 * MiB;
constexpr size_t WS_OG = 262 * MiB;
constexpr size_t WS_OSB = 310 * MiB;
constexpr size_t WS_ODIL = 342 * MiB;
constexpr size_t WS_PROJ = 362 * MiB;
constexpr size_t WS_Y = 362 * MiB;
constexpr size_t WS_YB9 = 362 * MiB;
constexpr size_t WS_WGU = 730 * MiB;
constexpr size_t WS_TOTAL = 990 * MiB;

constexpr int LDS_BYTES = 147456;

struct Params {
    const float *x, *c; const int* pos;
    const float *w_ada, *b_ada, *g_pre_mix, *g_post_mix, *g_pre_ffn, *g_post_ffn;
    const float *w_in, *w_dil_out, *w_sb_out, *w_mix_out, *w_router, *router_bias;
    const float *w_gate_e, *w_up_e, *w_down_e, *w_gate_s, *w_up_s, *w_down_s;
    float* out; unsigned char* ws;
};

DI unsigned pk_bf16(float lo, float hi) { f32x2 v = {lo, hi}; bf16x2_t r = __builtin_convertvector(v, bf16x2_t); return __builtin_bit_cast(unsigned, r); }
DI float bf_lo(unsigned u) { return __uint_as_float(u << 16); }
DI float bf_hi(unsigned u) { return __uint_as_float(u & 0xffff0000u); }
DI float wave_sum(float v) {
#pragma unroll
    for (int o = 32; o >= 1; o >>= 1) v += __shfl_xor(v, o);
    return v;
}
DI float sigmoidf_(float x) { return 1.0f / (1.0f + __expf(-x)); }

#define XB_TMO      128
#define XB_XCNT(j)  (256  + 64 * (j))
#define XB_XSUB(j)  (1280 + 64 * (j))
#define XB_XGEN(j)  (2304 + 64 * (j))
#define XB_TOP      3328
#define XB_TOPGEN   3392
#define XCD_BAR_WORDS 3456
#define XB_SPIN_CAP (1u << 18)

__device__ __forceinline__ unsigned xb_ld(unsigned* p)              { return __hip_atomic_load(p, __ATOMIC_RELAXED, __HIP_MEMORY_SCOPE_AGENT); }
__device__ __forceinline__ unsigned xb_add(unsigned* p, unsigned v) { return __hip_atomic_fetch_add(p, v, __ATOMIC_RELAXED, __HIP_MEMORY_SCOPE_AGENT); }
__device__ __forceinline__ unsigned xb_xcc_id() { return (unsigned)__builtin_amdgcn_s_getreg((3 << 11) | 20) & 0xFu; }
#define XB_SPIN(cond, bar) do { unsigned _sp = 0; while (cond) { __builtin_amdgcn_s_sleep(1); \
    if ((++_sp & 255u) == 0u) { if (xb_ld(&(bar)[XB_TMO])) break; if (_sp > XB_SPIN_CAP) { atomicAdd(&(bar)[XB_TMO], 1u); break; } } } } while (0)

struct XcdBarrier { unsigned* bar; unsigned x; volatile LAS unsigned* st; };

__device__ __forceinline__ XcdBarrier xcd_barrier_post(unsigned* bar, volatile LAS unsigned* st) {
    XcdBarrier b; b.bar = bar; b.x = xb_xcc_id(); b.st = st;
    if (threadIdx.x == 0) (void)xb_add(&bar[XB_XCNT(b.x)], 1u);
    return b;
}
__device__ __forceinline__ void xcd_barrier_complete(unsigned* bar, unsigned x, unsigned& nloc, unsigned& nx) {
    const unsigned G = gridDim.x * gridDim.y * gridDim.z;
    unsigned sum, cnt, mine, sp = 0u;
    for (;;) {
        sum = 0u; cnt = 0u; mine = 0u;
#pragma unroll
        for (unsigned j = 0; j < 16; ++j) { const unsigned c = xb_ld(&bar[XB_XCNT(j)]); sum += c; cnt += (c > 0u) ? 1u : 0u; mine = (j == x) ? c : mine; }
        if (sum == G) break;
        __builtin_amdgcn_s_sleep(1);
        if ((++sp & 255u) == 0u) { if (xb_ld(&bar[XB_TMO])) break; if (sp > XB_SPIN_CAP) { atomicAdd(&bar[XB_TMO], 1u); break; } }
    }
    nloc = mine > 0u ? mine : 1u; nx = cnt > 0u ? cnt : 1u;
}
__device__ __forceinline__ void xcd_barrier(const XcdBarrier& b) {
    asm volatile("s_waitcnt vmcnt(0)" ::: "memory");
    __syncthreads();
    if (threadIdx.x == 0) {
        unsigned* bar = b.bar;
        __builtin_amdgcn_s_waitcnt(0);
        unsigned nloc = b.st[0], nx = b.st[1];
        if (nloc == 0u) { xcd_barrier_complete(bar, b.x, nloc, nx); b.st[0] = nloc; b.st[1] = nx; }
        const unsigned old = xb_add(&bar[XB_XSUB(b.x)], 1u);
        const unsigned gen = old / nloc;
        if (old + 1u == (gen + 1u) * nloc) {
            __builtin_amdgcn_fence(__ATOMIC_RELEASE, "agent");
            asm volatile("s_waitcnt vmcnt(0)" ::: "memory");
            const unsigned og = xb_add(&bar[XB_TOP], 1u);
            const unsigned tg = og / nx;
            if (og + 1u == (tg + 1u) * nx) xb_add(&bar[XB_TOPGEN], 1u);
            else XB_SPIN(xb_ld(&bar[XB_TOPGEN]) == tg, bar);
            __builtin_amdgcn_fence(__ATOMIC_ACQUIRE, "agent");
            xb_add(&bar[XB_XGEN(b.x)], 1u);
            asm volatile("s_waitcnt vmcnt(0)" ::: "memory");
        } else {
            XB_SPIN(xb_ld(&bar[XB_XGEN(b.x)]) == gen, bar);
            __builtin_amdgcn_fence(__ATOMIC_ACQUIRE, "agent");
            asm volatile("s_waitcnt vmcnt(0)" ::: "memory");
        }
    }
    __syncthreads();
}

struct CvtMat { const float* src; bf16_t* dst; int K, N, nb, mode; size_t sstride, dstride; };
constexpr int CVT_NMAT = 10;
constexpr int CVT_TILES[CVT_NMAT] = {2944, 128, 256, 512, 8192, 8192, 8192, 128, 128, 128};
constexpr int CVT_TOTAL = 2944 + 128 + 256 + 512 + 8192 * 3 + 128 * 3;
constexpr int P0_MOD_UNITS = 192, P0_ROPE_UNITS = 64, P0_ITEMS = P0_MOD_UNITS + P0_ROPE_UNITS + CVT_TOTAL;

DI CvtMat cvt_mat(const Params& p, int m) {
    bf16_t* wtin = (bf16_t*)(p.ws + WS_WTIN); bf16_t* wtdil = (bf16_t*)(p.ws + WS_WTDIL); bf16_t* wtsb = (bf16_t*)(p.ws + WS_WTSB); bf16_t* wtmix = (bf16_t*)(p.ws + WS_WTMIX);
    bf16_t* wgu = (bf16_t*)(p.ws + WS_WGU); bf16_t* wd = (bf16_t*)(p.ws + WS_WD);
    CvtMat r;
    switch (m) {
        case 0: r = {p.w_in, wtin, 2048, 11776, 1, 0, 0, 0}; break;
        case 1: r = {p.w_dil_out, wtdil, 512, 2048, 1, 0, 0, 0}; break;
        case 2: r = {p.w_sb_out, wtsb, 1024, 2048, 1, 0, 0, 0}; break;
        case 3: r = {p.w_mix_out, wtmix, 2048, 2048, 1, 0, 0, 0}; break;
        case 4: r = {p.w_gate_e, wgu, 2048, 512, 64, 1, (size_t)2048 * 512, (size_t)1024 * 2048}; break;
        case 5: r = {p.w_up_e, wgu, 2048, 512, 64, 2, (size_t)2048 * 512, (size_t)1024 * 2048}; break;
        case 6: r = {p.w_down_e, wd, 512, 2048, 64, 0, (size_t)512 * 2048, (size_t)2048 * 512}; break;
        case 7: r = {p.w_gate_s, wgu + (size_t)64 * 1024 * 2048, 2048, 512, 1, 1, 0, 0}; break;
        case 8: r = {p.w_up_s, wgu + (size_t)64 * 1024 * 2048, 2048, 512, 1, 2, 0, 0}; break;
        default: r = {p.w_down_s, wd + (size_t)64 * 2048 * 512, 512, 2048, 1, 0, 0, 0}; break;
    }
    return r;
}

DI void cvt_tile(const Params& p, int t, LAS unsigned char* lds) {
    int m = 0;
#pragma unroll
    for (int i = 0; i < CVT_NMAT - 1; ++i) { if (t >= CVT_TILES[i] && m == i) { t -= CVT_TILES[i]; m = i + 1; } }
    const CvtMat M = cvt_mat(p, m);
    const int tn = M.N / 64, tk = M.K / 128;
    const int b = t / (tn * tk); const int rem = t - b * (tn * tk); const int kt = rem / tn, nt = rem - kt * tn;
    const float* src = M.src + (size_t)b * M.sstride + (size_t)(kt * 128) * M.N + nt * 64;
    bf16_t* dst = M.dst + (size_t)b * M.dstride;
    const int tid = threadIdx.x;
    constexpr int P = 272;
    {
        const int kq = tid >> 4, n4 = (tid & 15) * 4;
        f32x4 v[4];
#pragma unroll
        for (int i = 0; i < 4; ++i) v[i] = *(const f32x4*)(src + (size_t)(kq + 32 * i) * M.N + n4);
#pragma unroll
        for (int i = 0; i < 4; ++i) {
            const int k = kq + 32 * i;
#pragma unroll
            for (int j = 0; j < 4; ++j) { const unsigned u = pk_bf16(v[i][j], 0.f); *(LAS bf16_t*)(lds + (n4 + j) * P + k * 2) = (bf16_t)(u & 0xffffu); }
        }
    }
    __syncthreads();
    {
        const int n = tid >> 3;
        const int c = nt * 64 + n;
        const int drow = M.mode == 0 ? c : (((c >> 7) << 8) + (c & 127) + (M.mode == 2 ? 128 : 0));
#pragma unroll
        for (int i = 0; i < 2; ++i) {
            const int ch = (tid & 7) + 8 * i;
            const u32x4 w = *(const LAS u32x4*)(lds + n * P + ch * 16);
            *(u32x4*)(dst + (size_t)drow * M.K + kt * 128 + ch * 8) = w;
        }
    }
    __syncthreads();
}

DI void mod_unit(const Params& p, int u, LAS unsigned char* lds) {
    const int tid = threadIdx.x, c0 = u * 64;
    LAS float* sc = (LAS float*)lds;
    LAS float* red = (LAS float*)(lds + 32768);
    for (int i = tid; i < 4 * 2048; i += 512) { const float v = p.c[i]; sc[i] = v / (1.0f + __expf(-v)); }
    __syncthreads();
    const int kq = tid >> 4, cq = tid & 15;
    float acc[4][4];
#pragma unroll
    for (int b = 0; b < 4; ++b)
#pragma unroll
        for (int j = 0; j < 4; ++j) acc[b][j] = 0.f;
    for (int it = 0; it < 64; ++it) {
        const int k = kq + 32 * it;
        const f32x4 w = *(const f32x4*)(p.w_ada + (size_t)k * 12288 + c0 + 4 * cq);
#pragma unroll
        for (int b = 0; b < 4; ++b) { const float s = sc[b * 2048 + k];
#pragma unroll
            for (int j = 0; j < 4; ++j) acc[b][j] += s * w[j]; }
    }
#pragma unroll
    for (int b = 0; b < 4; ++b)
#pragma unroll
        for (int j = 0; j < 4; ++j) red[(kq * 4 + b) * 64 + 4 * cq + j] = acc[b][j];
    __syncthreads();
    if (tid < 256) {
        const int b = tid >> 6, col = tid & 63;
        float s = 0.f;
        for (int q = 0; q < 32; ++q) s += red[(q * 4 + b) * 64 + col];
        float* mod = (float*)(p.ws + WS_MOD);
        mod[b * 12288 + c0 + col] = s + p.b_ada[c0 + col];
    }
    __syncthreads();
}

DI void rope_unit(const Params& p, int u) {
    float2* rope = (float2*)(p.ws + WS_ROPE);
    for (int e = threadIdx.x; e < 4096; e += 512) {
        const int tok = u * 256 + (e >> 4), i = e & 15;
        const float invf = (float)pow(500000.0, -(double)i / 16.0);
        const float ang = (float)p.pos[tok] * invf;
        rope[tok * 16 + i] = make_float2((float)cos((double)ang), (float)sin((double)ang));
    }
}

DI void phase_prologue(const Params& p, LAS unsigned char* lds) {
    for (int it = blockIdx.x; it < P0_ITEMS; it += gridDim.x) {
        if (it < P0_MOD_UNITS) mod_unit(p, it, lds);
        else if (it < P0_MOD_UNITS + P0_ROPE_UNITS) rope_unit(p, it - P0_MOD_UNITS);
        else cvt_tile(p, it - P0_MOD_UNITS - P0_ROPE_UNITS, lds);
    }
}

DI void phase_prenorm(const Params& p) {
    const int lane = threadIdx.x & 63, wid = threadIdx.x >> 6;
    const float* mod = (const float*)(p.ws + WS_MOD);
    bf16_t* h = (bf16_t*)(p.ws + WS_H);
    for (int tok = blockIdx.x * 8 + wid; tok < NTOK; tok += gridDim.x * 8) {
        const int b = tok >> 12;
        const float* xr = p.x + (size_t)tok * DM;
        f32x4 v[8]; float ss = 0.f;
#pragma unroll
        for (int i = 0; i < 8; ++i) { v[i] = *(const f32x4*)(xr + 4 * (lane + 64 * i)); ss += v[i][0] * v[i][0] + v[i][1] * v[i][1] + v[i][2] * v[i][2] + v[i][3] * v[i][3]; }
        ss = wave_sum(ss);
        const float rstd = rsqrtf(ss * (1.0f / DM) + RMS_EPS);
#pragma unroll
        for (int i = 0; i < 8; ++i) {
            const int ch = 4 * (lane + 64 * i);
            const f32x4 g = *(const f32x4*)(p.g_pre_mix + ch);
            const f32x4 sh = *(const f32x4*)(mod + b * 12288 + ch);
            const f32x4 sc = *(const f32x4*)(mod + b * 12288 + 2048 + ch);
            f32x4 o;
#pragma unroll
            for (int j = 0; j < 4; ++j) o[j] = v[i][j] * rstd * g[j] * (1.0f + sc[j]) + sh[j];
            u32x2 w; w.x = pk_bf16(o[0], o[1]); w.y = pk_bf16(o[2], o[3]);
            *(u32x2*)(h + (size_t)tok * DM + ch) = w;
        }
    }
}

namespace g8 {
constexpr int BM = 256, BK = 64, HALF = 128, HTB = HALF * BK * 2, STAGE_BYTES = 8 * HTB, NXCD = 8, WGM = 8;
DI int lds_byte(int r, int c) { const int st = (r >> 4) * 2 + (c >> 5), rr = r & 15, cc = c & 31, ob = rr * 64 + cc * 2; return st * 1024 + (ob ^ (((ob >> 9) & 1) << 5)); }
DI void stage_rc(int b, int& R, int& C) { const int st = b / 1024, sb = b % 1024, swz = sb ^ (((sb >> 9) & 1) << 5); R = (st >> 1) * 16 + swz / 64; C = (st & 1) * 32 + (swz % 64) / 2; }
DI int perm32(int rho) { const int n = rho >> 4, i = rho & 15; return 8 * (i >> 2) + 4 * n + (i & 3); }

struct Unit {
    const char* A; const char* B;
    int row0;
    int lda, ldb, nt;
    int pm, pn, aux, keep;
    int e, nvalid;
};

DI bool static_tile(int L, int nM, int nN, int& pm, int& pn) {
    const int nwg = nM * nN; if (L >= nwg) return false;
    int wgid = L; { const int q = nwg / NXCD, r = nwg % NXCD, xcd = wgid % NXCD, off = wgid / NXCD; wgid = (xcd < r ? xcd * (q + 1) : r * (q + 1) + (xcd - r) * q) + off; }
    const int nig = WGM * nN, gid = wgid / nig, fm = gid * WGM, gsz = (nM - fm) < WGM ? (nM - fm) : WGM;
    pm = fm + ((wgid % nig) % gsz); pn = (wgid % nig) / gsz; return true;
}

template <class Sched, class Epi>
DI void gemm_phase(LAS unsigned char* lds, const Sched& S, const Epi& E) {
    const int tid = threadIdx.x, wid = __builtin_amdgcn_readfirstlane(tid >> 6), lane = tid & 63, wr = wid >> 2, wc = wid & 3, fr = lane & 15, fq = lane >> 4;
    int sR[2], sC[2], sRb[2];
#pragma unroll
    for (int i = 0; i < 2; ++i) { int R, C; stage_rc(tid * 16 + i * 8192, R, C); sR[i] = R; sC[i] = C * 2; sRb[i] = (R & ~31) + perm32(R & 31); }
    const unsigned ldsw = (unsigned)wid * 1024u;
    const int aoff = lds_byte(wr * 64 + fr, fq * 8), boff = lds_byte(wc * 32 + fr, fq * 8);
#define G8_SA(b, h) (((b) * 2 + (h)) * HTB)
#define G8_SB(b, h) ((4 + (b) * 2 + (h)) * HTB)
#define G8_STAGE(bufoff, gbase, voff) do { _Pragma("unroll") for (int _i = 0; _i < 2; ++_i) \
        __builtin_amdgcn_global_load_lds((const unsigned*)((const char*)(gbase) + (voff)[_i]), (LAS unsigned*)(lds + (bufoff) + ldsw + _i * 8192), 16, 0, 0); } while (0)
#define G8_LDA(dst, b, h) do { _Pragma("unroll") for (int m = 0; m < 4; ++m) _Pragma("unroll") for (int k = 0; k < 2; ++k) dst[m][k] = *(const LAS bf16x8*)(lds + G8_SA(b, h) + aoff + m * 2048 + k * 1024); } while (0)
#define G8_LDB(dst, b, h) do { _Pragma("unroll") for (int n = 0; n < 2; ++n) _Pragma("unroll") for (int k = 0; k < 2; ++k) dst[n][k] = *(const LAS bf16x8*)(lds + G8_SB(b, h) + boff + n * 2048 + k * 1024); } while (0)
#define G8_MMA(ai, bj, At, Bt) do { __builtin_amdgcn_s_setprio(1); _Pragma("unroll") for (int m = 0; m < 4; ++m) _Pragma("unroll") for (int n = 0; n < 2; ++n) _Pragma("unroll") for (int k = 0; k < 2; ++k) \
        acc[ai][bj][m][n] = __builtin_amdgcn_mfma_f32_16x16x32_bf16(Bt[n][k], At[m][k], acc[ai][bj][m][n], 0, 0, 0); __builtin_amdgcn_s_setprio(0); } while (0)
#define G8_WAIT_V(n) asm volatile("s_waitcnt vmcnt(" #n ")" ::: "memory")
#define G8_WAIT_L(n) asm volatile("s_waitcnt lgkmcnt(" #n ")" ::: "memory")
#define G8_BAR __builtin_amdgcn_s_barrier()
#define G8_SCHED __builtin_amdgcn_sched_barrier(0)
#define G8_OFFS(u, vA, vB) do { _Pragma("unroll") for (int _h = 0; _h < 2; ++_h) _Pragma("unroll") for (int _i = 0; _i < 2; ++_i) \
        vA[_h][_i] = (unsigned)S.arow(u, _h * 128 + sR[_i]) * (unsigned)(u).lda + (unsigned)sC[_i]; \
        _Pragma("unroll") for (int _i = 0; _i < 2; ++_i) vB[_i] = (unsigned)sRb[_i] * (unsigned)(u).ldb + (unsigned)sC[_i]; } while (0)
    Unit cur, nxt; int ui = 0;
    if (!S.next(0, cur)) return;
    f32x4 acc[2][2][4][2];
#pragma unroll
    for (int a = 0; a < 2; ++a)
#pragma unroll
        for (int b = 0; b < 2; ++b)
#pragma unroll
            for (int m = 0; m < 4; ++m)
#pragma unroll
                for (int n = 0; n < 2; ++n) acc[a][b][m][n] = (f32x4){0.f, 0.f, 0.f, 0.f};
    bf16x8 At[4][2], B0[2][2], B1[2][2];
    unsigned vA[2][2], vB[2];
    G8_OFFS(cur, vA, vB);
    const char* cA = cur.A; const char* cB = cur.B; size_t hB = (size_t)128 * cur.ldb;
    constexpr size_t kstep = 128;
    G8_STAGE(G8_SB(0, 0), cB, vB); G8_STAGE(G8_SA(0, 0), cA, vA[0]); G8_STAGE(G8_SB(0, 1), cB + hB, vB); G8_STAGE(G8_SA(0, 1), cA, vA[1]);
    if (wr == 1) G8_BAR;
    G8_WAIT_V(4); G8_BAR;
    G8_STAGE(G8_SB(1, 0), cB + kstep, vB); G8_STAGE(G8_SA(1, 0), cA + kstep, vA[0]); G8_STAGE(G8_SB(1, 1), cB + hB + kstep, vB);
    G8_WAIT_V(6); G8_BAR;
    for (;;) {
        const bool has_next = S.next(ui + 1, nxt);
        unsigned nvA[2][2], nvB[2];
        const char* nA = cA; const char* nB = cB; size_t nhB = hB;
        if (has_next) { G8_OFFS(nxt, nvA, nvB); nA = nxt.A; nB = nxt.B; nhB = (size_t)128 * nxt.ldb; }
        else {
#pragma unroll
            for (int h = 0; h < 2; ++h) { nvA[h][0] = vA[h][0]; nvA[h][1] = vA[h][1]; }
            nvB[0] = vB[0]; nvB[1] = vB[1];
        }
        const int nt = cur.nt;
        for (int t = 0; t < nt; t += 2) {
            const bool last = (t == nt - 2);
            const char* a1 = cA + (size_t)(t + 1) * kstep;
            G8_LDB(B0, 0, 0); G8_SCHED; G8_LDA(At, 0, 0); G8_STAGE(G8_SA(1, 1), a1, vA[1]);
            G8_WAIT_L(8); G8_BAR; G8_WAIT_L(0); G8_MMA(0, 0, At, B0); G8_BAR; G8_SCHED;
            const char* a2; const char* b2; size_t h2;
            if (last) { a2 = nA; b2 = nB; h2 = nhB;
#pragma unroll
                for (int h = 0; h < 2; ++h) { vA[h][0] = nvA[h][0]; vA[h][1] = nvA[h][1]; }
                vB[0] = nvB[0]; vB[1] = nvB[1];
            } else { a2 = cA + (size_t)(t + 2) * kstep; b2 = cB + (size_t)(t + 2) * kstep; h2 = hB; }
            const char* a3 = a2 + kstep; const char* b3 = b2 + kstep;
            G8_LDB(B1, 0, 1); G8_STAGE(G8_SB(0, 0), b2, vB);
            G8_BAR; G8_WAIT_L(0); G8_MMA(0, 1, At, B1); G8_BAR;
            G8_LDA(At, 0, 1); G8_STAGE(G8_SA(0, 0), a2, vA[0]);
            G8_BAR; G8_WAIT_L(0); G8_MMA(1, 0, At, B0); G8_BAR; G8_SCHED;
            G8_STAGE(G8_SB(0, 1), b2 + h2, vB);
            G8_WAIT_V(6); G8_BAR; G8_MMA(1, 1, At, B1); G8_BAR;
            G8_LDB(B0, 1, 0); G8_SCHED; G8_LDA(At, 1, 0); G8_STAGE(G8_SA(0, 1), a2, vA[1]);
            G8_WAIT_L(8); G8_BAR; G8_WAIT_L(0); G8_MMA(0, 0, At, B0); G8_BAR; G8_SCHED;
            G8_LDB(B1, 1, 1); G8_STAGE(G8_SB(1, 0), b3, vB);
            G8_BAR; G8_WAIT_L(0); G8_MMA(0, 1, At, B1); G8_BAR;
            G8_LDA(At, 1, 1); G8_STAGE(G8_SA(1, 0), a3, vA[0]);
            G8_BAR; G8_WAIT_L(0); G8_MMA(1, 0, At, B0); G8_BAR; G8_SCHED;
            G8_STAGE(G8_SB(1, 1), b3 + h2, vB);
            G8_WAIT_V(6); G8_BAR; G8_MMA(1, 1, At, B1); G8_BAR;
        }
        E(acc, cur, wr, wc, fr, fq);
        if (!has_next) break;
        if (!cur.keep) {
#pragma unroll
            for (int a = 0; a < 2; ++a)
#pragma unroll
                for (int b = 0; b < 2; ++b)
#pragma unroll
                    for (int m = 0; m < 4; ++m)
#pragma unroll
                        for (int n = 0; n < 2; ++n) acc[a][b][m][n] = (f32x4){0.f, 0.f, 0.f, 0.f};
        }
        cur = nxt; cA = nA; cB = nB; hB = nhB; ++ui;
    }
    G8_WAIT_V(0);
    if (wr == 0) G8_BAR;
    G8_BAR;
#undef G8_SA
#undef G8_SB
#undef G8_STAGE
#undef G8_LDA
#undef G8_LDB
#undef G8_MMA
#undef G8_WAIT_V
#undef G8_WAIT_L
#undef G8_BAR
#undef G8_SCHED
#undef G8_OFFS
}
}

struct DenseSched {
    const char* A; const char* Bt; int nM, nN, lda, ldb, nt, G, c;
    DI bool next(int i, g8::Unit& u) const {
        int pm, pn; if (!g8::static_tile(i * G + c, nM, nN, pm, pn)) return false;
        u.A = A; u.B = Bt + (size_t)pn * 256 * ldb; u.row0 = pm * 256; u.lda = lda; u.ldb = ldb; u.nt = nt; u.pm = pm; u.pn = pn; u.aux = 0; u.keep = 0; u.e = 0; u.nvalid = 256; return true;
    }
    DI int arow(const g8::Unit& u, int rr) const { return u.row0 + rr; }
};
struct OutProjSched {
    const char *A0, *B0, *A1, *B1; int G, c;
    DI bool next(int i, g8::Unit& u) const {
        int pm, pn; if (!g8::static_tile((i >> 1) * G + c, 64, 8, pm, pn)) return false;
        const int part = i & 1;
        u.A = part ? A1 : A0; u.lda = part ? 2048 : 1024; u.ldb = part ? 2048 : 1024; u.nt = part ? 16 : 8;
        u.B = (part ? B1 : B0) + (size_t)pn * 256 * u.ldb; u.row0 = pm * 256; u.pm = pm; u.pn = pn; u.aux = part; u.keep = part ? 0 : 1; u.e = 0; u.nvalid = 256; return true;
    }
    DI int arow(const g8::Unit& u, int rr) const { return u.row0 + rr; }
};
struct MoeSched {
    const LAS int* tpre; const int* cnt; const int* list; const char* A; const char* W; int ncol, mode  , G, c;
    DI bool next(int i, g8::Unit& u) const {
        const int L = i * G + c; const int T = tpre[NEX];
        if (L >= T * ncol) return false;
        const int gt = L / ncol, pn = L - gt * ncol;
        int e = 0;
        for (int q = 1; q < NEX; ++q) e = (tpre[q] <= gt) ? q : e;
        const int tile = gt - tpre[e];
        const int n_e = (e < NE) ? cnt[e] : NTOK;
        u.e = e; u.pm = tile; u.pn = pn; u.nvalid = min(256, n_e - tile * 256); u.keep = 0; u.aux = gt * 256;
        if (mode == 0) { u.A = A; u.lda = 4096; u.ldb = 4096; u.nt = 32; u.B = W + ((size_t)e * 1024 + (size_t)pn * 256) * 4096; u.row0 = tile * 256; }
        else { u.A = A; u.lda = 1024; u.ldb = 1024; u.nt = 8; u.B = W + ((size_t)e * 2048 + (size_t)pn * 256) * 1024; u.row0 = gt * 256; }
        return true;
    }
    DI int arow(const g8::Unit& u, int rr) const {
        if (mode == 1) return u.row0 + rr;
        if (u.e >= NE) return u.row0 + rr;
        const int r = min(rr, u.nvalid - 1);
        return list[u.e * LIST_CAP + u.row0 + r] / 9;
    }
};

typedef f32x4 (&AccRef)[2][2][4][2];
#define EPI_FOR_ROWS _Pragma("unroll") for (int ai = 0; ai < 2; ++ai) _Pragma("unroll") for (int m = 0; m < 4; ++m)
#define EPI_RT (ai * 128 + wr * 64 + m * 16 + fr)

struct EpiInProj {
    bf16_t* proj; const float* rope;
    DI void operator()(AccRef acc, const g8::Unit& u, int wr, int wc, int fr, int fq) const {
        const int pn = u.pn;
        const int kind = pn < 6 ? 0 : pn < 12 ? 1 : pn < 18 ? 2 : pn < 22 ? 3 : pn < 30 ? 2 : 4;
        const bool do_rope = (kind <= 1) && (wc == 0);
        EPI_FOR_ROWS { const int rt = EPI_RT;
            const int row = u.pm * 256 + rt;
            f32x4 cs[4];
            if (do_rope) {
#pragma unroll
                for (int q = 0; q < 4; ++q) cs[q] = *(const f32x4*)(rope + (size_t)row * 32 + 16 * (fq & 1) + 4 * q);
            }
#pragma unroll
            for (int bj = 0; bj < 2; ++bj) {
                f32x4 v0 = acc[ai][bj][m][0], v1 = acc[ai][bj][m][1];
                if (do_rope) {
                    const float sg = (fq < 2) ? -1.0f : 1.0f;
                    f32x4 p0, p1;
#pragma unroll
                    for (int j = 0; j < 4; ++j) { p0[j] = __shfl_xor(v0[j], 32); p1[j] = __shfl_xor(v1[j], 32); }
#pragma unroll
                    for (int j = 0; j < 4; ++j) {
                        const float c0 = cs[j >> 1][(j & 1) * 2], s0 = cs[j >> 1][(j & 1) * 2 + 1];
                        const float c1 = cs[2 + (j >> 1)][(j & 1) * 2], s1 = cs[2 + (j >> 1)][(j & 1) * 2 + 1];
                        v0[j] = v0[j] * c0 + sg * p0[j] * s0;
                        v1[j] = v1[j] * c1 + sg * p1[j] * s1;
                    }
                }
                if (kind == 0 || kind == 3) { v0 *= QSCALE; v1 *= QSCALE; }
                if (kind == 4) {
#pragma unroll
                    for (int j = 0; j < 4; ++j) { v0[j] = sigmoidf_(v0[j]); v1[j] = sigmoidf_(v1[j]); }
                }
                u32x4 w; w.x = pk_bf16(v0[0], v0[1]); w.y = pk_bf16(v0[2], v0[3]); w.z = pk_bf16(v1[0], v1[1]); w.w = pk_bf16(v1[2], v1[3]);
                *(u32x4*)(proj + (size_t)row * DIN + pn * 256 + bj * 128 + wc * 32 + 8 * fq) = w;
            }
        }
    }
};
struct EpiOutProj {
    const bf16_t* proj; bf16_t* mixed;
    DI void operator()(AccRef acc, const g8::Unit& u, int wr, int wc, int fr, int fq) const {
        const int part = u.aux;
        EPI_FOR_ROWS { const int rt = EPI_RT;
            const int row = u.pm * 256 + rt;
#pragma unroll
            for (int bj = 0; bj < 2; ++bj) {
                const int col = u.pn * 256 + bj * 128 + wc * 32 + 8 * fq;
                const u32x4 gs = *(const u32x4*)(proj + (size_t)row * DIN + COL_GS + col);
                float s[8] = {bf_lo(gs.x), bf_hi(gs.x), bf_lo(gs.y), bf_hi(gs.y), bf_lo(gs.z), bf_hi(gs.z), bf_lo(gs.w), bf_hi(gs.w)};
                if (part == 0) {
                    const u32x4 gd = *(const u32x4*)(proj + (size_t)row * DIN + COL_GD + col);
                    float d[8] = {bf_lo(gd.x), bf_hi(gd.x), bf_lo(gd.y), bf_hi(gd.y), bf_lo(gd.z), bf_hi(gd.z), bf_lo(gd.w), bf_hi(gd.w)};
#pragma unroll
                    for (int j = 0; j < 4; ++j) { acc[ai][bj][m][0][j] *= d[j] / s[j]; acc[ai][bj][m][1][j] *= d[4 + j] / s[4 + j]; }
                } else {
                    f32x4 v0 = acc[ai][bj][m][0], v1 = acc[ai][bj][m][1];
#pragma unroll
                    for (int j = 0; j < 4; ++j) { v0[j] *= s[j]; v1[j] *= s[4 + j]; }
                    u32x4 w; w.x = pk_bf16(v0[0], v0[1]); w.y = pk_bf16(v0[2], v0[3]); w.z = pk_bf16(v1[0], v1[1]); w.w = pk_bf16(v1[2], v1[3]);
                    *(u32x4*)(mixed + (size_t)row * DM + col) = w;
                }
            }
        }
    }
};
struct EpiF32 {
    float* y;
    DI void operator()(AccRef acc, const g8::Unit& u, int wr, int wc, int fr, int fq) const {
        EPI_FOR_ROWS { const int rt = EPI_RT;
            const int row = u.pm * 256 + rt;
#pragma unroll
            for (int bj = 0; bj < 2; ++bj) {
                float* dst = y + (size_t)row * DM + u.pn * 256 + bj * 128 + wc * 32 + 8 * fq;
                *(f32x4*)dst = acc[ai][bj][m][0]; *(f32x4*)(dst + 4) = acc[ai][bj][m][1];
            }
        }
    }
};
struct EpiGateUp {
    bf16_t* hid;
    DI void operator()(AccRef acc, const g8::Unit& u, int wr, int wc, int fr, int fq) const {
        EPI_FOR_ROWS { const int rt = EPI_RT;
            const int row = u.aux + rt;
            const f32x4 g0 = acc[ai][0][m][0], g1 = acc[ai][0][m][1], u0 = acc[ai][1][m][0], u1 = acc[ai][1][m][1];
            f32x4 v0, v1;
#pragma unroll
            for (int j = 0; j < 4; ++j) { v0[j] = g0[j] * sigmoidf_(g0[j]) * u0[j]; v1[j] = g1[j] * sigmoidf_(g1[j]) * u1[j]; }
            u32x4 w; w.x = pk_bf16(v0[0], v0[1]); w.y = pk_bf16(v0[2], v0[3]); w.z = pk_bf16(v1[0], v1[1]); w.w = pk_bf16(v1[2], v1[3]);
            *(u32x4*)(hid + (size_t)row * DE + u.pn * 128 + wc * 32 + 8 * fq) = w;
        }
    }
};
struct EpiDown {
    const int* list; const float* w9; bf16_t* yb9;
    DI void operator()(AccRef acc, const g8::Unit& u, int wr, int wc, int fr, int fq) const {
        EPI_FOR_ROWS { const int rt = EPI_RT;
            if (rt < u.nvalid) {
                int v; float wgt;
                if (u.e < NE) { v = list[u.e * LIST_CAP + u.pm * 256 + rt]; wgt = w9[v]; }
                else { v = (u.pm * 256 + rt) * 9 + 8; wgt = 1.0f; }
#pragma unroll
                for (int bj = 0; bj < 2; ++bj) {
                    const f32x4 v0 = acc[ai][bj][m][0] * wgt, v1 = acc[ai][bj][m][1] * wgt;
                    u32x4 w; w.x = pk_bf16(v0[0], v0[1]); w.y = pk_bf16(v0[2], v0[3]); w.z = pk_bf16(v1[0], v1[1]); w.w = pk_bf16(v1[2], v1[3]);
                    *(u32x4*)(yb9 + (size_t)v * DM + u.pn * 256 + bj * 128 + wc * 32 + 8 * fq) = w;
                }
            }
        }
    }
};

DI void phase_inproj(const Params& p, LAS unsigned char* lds) {
    DenseSched S{(const char*)(p.ws + WS_H), (const char*)(p.ws + WS_WTIN), 64, 46, 4096, 4096, 32, (int)gridDim.x, (int)blockIdx.x};
    EpiInProj E{(bf16_t*)(p.ws + WS_PROJ), (const float*)(p.ws + WS_ROPE)};
    g8::gemm_phase(lds, S, E);
}
DI void phase_outproj(const Params& p, LAS unsigned char* lds) {
    OutProjSched S{(const char*)(p.ws + WS_ODIL), (const char*)(p.ws + WS_WTDIL), (const char*)(p.ws + WS_OSB), (const char*)(p.ws + WS_WTSB), (int)gridDim.x, (int)blockIdx.x};
    EpiOutProj E{(const bf16_t*)(p.ws + WS_PROJ), (bf16_t*)(p.ws + WS_H)};
    g8::gemm_phase(lds, S, E);
}
DI void phase_mixout(const Params& p, LAS unsigned char* lds) {
    DenseSched S{(const char*)(p.ws + WS_H), (const char*)(p.ws + WS_WTMIX), 64, 8, 4096, 4096, 32, (int)gridDim.x, (int)blockIdx.x};
    EpiF32 E{(float*)(p.ws + WS_Y)};
    g8::gemm_phase(lds, S, E);
}
DI void moe_tile_prefix(const Params& p, LAS int* tpre) {
    if (threadIdx.x == 0) {
        const int* cnt = (const int*)(p.ws + WS_CNT);
        int acc = 0;
        for (int e = 0; e < NE; ++e) { tpre[e] = acc; acc += (cnt[e] + 255) >> 8; }
        tpre[NE] = acc; acc += NTOK / 256; tpre[NEX] = acc;
    }
    __syncthreads();
}
DI void phase_gateup(const Params& p, LAS unsigned char* lds) {
    LAS int* tpre = (LAS int*)(lds + g8::STAGE_BYTES);
    moe_tile_prefix(p, tpre);
    MoeSched S{tpre, (const int*)(p.ws + WS_CNT), (const int*)(p.ws + WS_LIST), (const char*)(p.ws + WS_H), (const char*)(p.ws + WS_WGU), 4, 0, (int)gridDim.x, (int)blockIdx.x};
    EpiGateUp E{(bf16_t*)(p.ws + WS_HID)};
    g8::gemm_phase(lds, S, E);
}
DI void phase_down(const Params& p, LAS unsigned char* lds) {
    LAS int* tpre = (LAS int*)(lds + g8::STAGE_BYTES);
    moe_tile_prefix(p, tpre);
    MoeSched S{tpre, (const int*)(p.ws + WS_CNT), (const int*)(p.ws + WS_LIST), (const char*)(p.ws + WS_HID), (const char*)(p.ws + WS_WD), 8, 1, (int)gridDim.x, (int)blockIdx.x};
    EpiDown E{(const int*)(p.ws + WS_LIST), (const float*)(p.ws + WS_W9), (bf16_t*)(p.ws + WS_YB9)};
    g8::gemm_phase(lds, S, E);
}

namespace att {
constexpr int TB = 16384;
DI unsigned off_b(unsigned row, unsigned ch) { return 256u * row + 16u * (ch ^ (((row & 3u) << 2) | ((row >> 2) & 3u))); }
DI int crow(int i, int h) { return (i & 3) + 8 * (i >> 2) + 4 * h; }
DI f32x16 mfma32(bf16x8 a, bf16x8 b, f32x16 c) { return __builtin_amdgcn_mfma_f32_32x32x16_bf16(a, b, c, 0, 0, 0); }
DI bf16x8 pack8(const f32x16& x, int s) {
    u32x4 w; w.x = pk_bf16(x[8 * s + 0], x[8 * s + 1]); w.y = pk_bf16(x[8 * s + 2], x[8 * s + 3]); w.z = pk_bf16(x[8 * s + 4], x[8 * s + 5]); w.w = pk_bf16(x[8 * s + 6], x[8 * s + 7]);
    return __builtin_bit_cast(bf16x8, w);
}
DI void qk_tile(LAS const unsigned char* Kb, const bf16x8 (&qf)[8], f32x16& x0, f32x16& x1, int r, int h) {
#pragma unroll
    for (int i = 0; i < 16; ++i) { x0[i] = 0.f; x1[i] = 0.f; }
#pragma unroll
    for (int s = 0; s < 8; ++s) {
        const bf16x8 a0 = *(const LAS bf16x8*)(Kb + off_b(r, 2 * s + h));
        const bf16x8 a1 = *(const LAS bf16x8*)(Kb + off_b(32 + r, 2 * s + h));
        x0 = mfma32(a0, qf[s], x0); x1 = mfma32(a1, qf[s], x1);
    }
}
DI void pv_tile(LAS const unsigned char* Vb, const f32x16& p0, const f32x16& p1, f32x16 (&o)[4], int lane) {
    const int h = lane >> 5, blk = (lane >> 4) & 1, q = (lane & 15) >> 2, pp = lane & 3;
#pragma unroll
    for (int kb = 0; kb < 2; ++kb)
#pragma unroll
        for (int s = 0; s < 2; ++s) {
            const bf16x8 pf = pack8(kb ? p1 : p0, s);
#pragma unroll
            for (int db = 0; db < 4; ++db) {
                const unsigned row0 = 32 * kb + 16 * s + 4 * h + q;
                const unsigned ch = 4 * db + 2 * blk + (pp >> 1);
                const s16x4 t0 = __builtin_amdgcn_ds_read_tr16_b64_v4i16((LAS s16x4*)(Vb + off_b(row0, ch) + 8 * (pp & 1)));
                const s16x4 t1 = __builtin_amdgcn_ds_read_tr16_b64_v4i16((LAS s16x4*)(Vb + off_b(row0 + 8, ch) + 8 * (pp & 1)));
                const bf16x8 vf = {t0[0], t0[1], t0[2], t0[3], t1[0], t1[1], t1[2], t1[3]};
                o[db] = mfma32(vf, pf, o[db]);
            }
        }
}
DI void store_o(bf16_t* orow, const f32x16 (&o)[4], float scale, int h) {
#pragma unroll
    for (int db = 0; db < 4; ++db)
#pragma unroll
        for (int g = 0; g < 4; ++g) {
            u32x2 w; w.x = pk_bf16(o[db][4 * g] * scale, o[db][4 * g + 1] * scale); w.y = pk_bf16(o[db][4 * g + 2] * scale, o[db][4 * g + 3] * scale);
            *(u32x2*)(orow + 32 * db + 8 * g + 4 * h) = w;
        }
}

DI void sb_item(const Params& p, LAS unsigned char* lds, int b, int hd, int Q) {
    const bf16_t* proj = (const bf16_t*)(p.ws + WS_PROJ);
    bf16_t* osb = (bf16_t*)(p.ws + WS_OSB);
    const int tid = threadIdx.x, wid = __builtin_amdgcn_readfirstlane(tid >> 6), lane = tid & 63, r = lane & 31, h = lane >> 5;
    const size_t tokbase = (size_t)b * SEQ;
    const int wq0 = Q * 256 + 32 * wid;
    const int myq = wq0 + r;
    bf16x8 qf[8];
    {
        const bf16_t* qrow = proj + (tokbase + myq) * DIN + COL_QS + hd * 128;
#pragma unroll
        for (int s = 0; s < 8; ++s) qf[s] = *(const bf16x8*)(qrow + 16 * s + 8 * h);
    }
    f32x16 o[4];
#pragma unroll
    for (int db = 0; db < 4; ++db)
#pragma unroll
        for (int i = 0; i < 16; ++i) o[db][i] = 0.f;
    float R = 0.f;
    const int lrow = tid >> 3, lch = (tid & 7) * 2;
    const bf16_t* kbase = proj + tokbase * DIN + COL_KS + hd * 128 + lch * 8;
    const bf16_t* vbase = proj + tokbase * DIN + COL_VS + hd * 128 + lch * 8;
    u32x4 kr0, kr1, vr0, vr1;
    int j = 4 * Q + 3;
    { const size_t key = (size_t)64 * j + lrow; const bf16_t* kp = kbase + key * DIN; const bf16_t* vp = vbase + key * DIN;
      kr0 = *(const u32x4*)kp; kr1 = *(const u32x4*)(kp + 8); vr0 = *(const u32x4*)vp; vr1 = *(const u32x4*)(vp + 8); }
    int cur = 0;
    for (; j >= 0; --j) {
        LAS unsigned char* Kb = lds + cur * TB; LAS unsigned char* Vb = lds + 2 * TB + cur * TB;
        *(LAS u32x4*)(Kb + off_b(lrow, lch)) = kr0; *(LAS u32x4*)(Kb + off_b(lrow, lch + 1)) = kr1;
        *(LAS u32x4*)(Vb + off_b(lrow, lch)) = vr0; *(LAS u32x4*)(Vb + off_b(lrow, lch + 1)) = vr1;
        __syncthreads();
        if (j > 0) { const size_t key = (size_t)64 * (j - 1) + lrow; const bf16_t* kp = kbase + key * DIN; const bf16_t* vp = vbase + key * DIN;
            kr0 = *(const u32x4*)kp; kr1 = *(const u32x4*)(kp + 8); vr0 = *(const u32x4*)vp; vr1 = *(const u32x4*)(vp + 8); }
        const int key0 = 64 * j;
        if (key0 < wq0 + 31) {
            const bool need_mask = (key0 + 63 >= wq0);
            f32x16 x0, x1;
            qk_tile(Kb, qf, x0, x1, r, h);
            f32x16 l0, l1;
#pragma unroll
            for (int i = 0; i < 16; ++i) {
                l0[i] = __builtin_amdgcn_logf(1.0f + __builtin_amdgcn_exp2f(x0[i]));
                l1[i] = __builtin_amdgcn_logf(1.0f + __builtin_amdgcn_exp2f(x1[i]));
            }
            if (need_mask) {
#pragma unroll
                for (int i = 0; i < 16; ++i) { const int kk = key0 + crow(i, h); if (kk >= myq) l0[i] = 0.f; if (kk + 32 >= myq) l1[i] = 0.f; }
            }
#pragma unroll
            for (int g = 0; g < 4; ++g) {
                l0[4 * g + 2] += l0[4 * g + 3]; l0[4 * g + 1] += l0[4 * g + 2]; l0[4 * g] += l0[4 * g + 1];
                l1[4 * g + 2] += l1[4 * g + 3]; l1[4 * g + 1] += l1[4 * g + 2]; l1[4 * g] += l1[4 * g + 1];
            }
            float Tlo[8], Thi[8];
#pragma unroll
            for (int g = 0; g < 4; ++g) {
                { const unsigned t = __float_as_uint(l0[4 * g]); auto sw = __builtin_amdgcn_permlane32_swap(t, t, false, false); Tlo[g] = __uint_as_float(sw[0]); Thi[g] = __uint_as_float(sw[1]); }
                { const unsigned t = __float_as_uint(l1[4 * g]); auto sw = __builtin_amdgcn_permlane32_swap(t, t, false, false); Tlo[4 + g] = __uint_as_float(sw[0]); Thi[4 + g] = __uint_as_float(sw[1]); }
            }
            float offR[8];
            float run = 0.f;
#pragma unroll
            for (int g = 7; g >= 0; --g) { offR[g] = run + (h == 0 ? Thi[g] : 0.f) + R; run += Tlo[g] + Thi[g]; }
            f32x16 p0, p1;
#pragma unroll
            for (int i = 0; i < 16; ++i) {
                p0[i] = __builtin_amdgcn_exp2f(x0[i] - (l0[i] + offR[i >> 2]));
                p1[i] = __builtin_amdgcn_exp2f(x1[i] - (l1[i] + offR[4 + (i >> 2)]));
            }
            if (need_mask) {
#pragma unroll
                for (int i = 0; i < 16; ++i) { const int kk = key0 + crow(i, h); if (kk >= myq) p0[i] = 0.f; if (kk + 32 >= myq) p1[i] = 0.f; }
            }
            R += run;
            pv_tile(Vb, p0, p1, o, lane);
        }
        cur ^= 1;
    }
    store_o(osb + (tokbase + myq) * 1024 + hd * 128, o, 1.0f, h);
    __syncthreads();
}

DI void dil_item(const Params& p, LAS unsigned char* lds, int di) {
    const bf16_t* proj = (const bf16_t*)(p.ws + WS_PROJ);
    bf16_t* og = (bf16_t*)(p.ws + WS_OG);
    float* lse = (float*)(p.ws + WS_LSE);
    const int b = di / 192; const int rem = di - b * 192; const int head = rem >> 4, sub = rem & 15;
    const int grp = head >> 2;
    const int dil = grp == 0 ? 1 : grp == 1 ? 4 : 16;
    const int nblk = 16 / dil;
    const int res = sub / nblk, Qb = sub - res * nblk;
    const int i0 = Qb * 256;
    const int tid = threadIdx.x, wid = __builtin_amdgcn_readfirstlane(tid >> 6), lane = tid & 63, r = lane & 31, h = lane >> 5;
    const size_t tokbase = (size_t)b * SEQ;
    const int wq0 = i0 + 32 * wid;
    const int myqi = wq0 + r;
    const size_t mytok = tokbase + (size_t)myqi * dil + res;
    bf16x8 qf[8];
    {
        const bf16_t* qrow = proj + mytok * DIN + COL_QA + head * 128;
#pragma unroll
        for (int s = 0; s < 8; ++s) qf[s] = *(const bf16x8*)(qrow + 16 * s + 8 * h);
    }
    f32x16 o[4];
#pragma unroll
    for (int db = 0; db < 4; ++db)
#pragma unroll
        for (int i = 0; i < 16; ++i) o[db][i] = 0.f;
    float mrun = -1e30f, lrun = 0.f;
    const int lrow = tid >> 3, lch = (tid & 7) * 2;
    const bf16_t* kbase = proj + tokbase * DIN + COL_KA + head * 128 + lch * 8;
    const bf16_t* vbase = proj + tokbase * DIN + COL_VA + head * 128 + lch * 8;
    u32x4 kr0, kr1, vr0, vr1;
    const int jt0 = (i0 == 0) ? 2 : 0;
    { const size_t key = (size_t)(i0 - 128 + 64 * jt0 + lrow) * dil + res; const bf16_t* kp = kbase + key * DIN; const bf16_t* vp = vbase + key * DIN;
      kr0 = *(const u32x4*)kp; kr1 = *(const u32x4*)(kp + 8); vr0 = *(const u32x4*)vp; vr1 = *(const u32x4*)(vp + 8); }
    int cur = 0;
    for (int jt = jt0; jt < 6; ++jt) {
        LAS unsigned char* Kb = lds + cur * TB; LAS unsigned char* Vb = lds + 2 * TB + cur * TB;
        *(LAS u32x4*)(Kb + off_b(lrow, lch)) = kr0; *(LAS u32x4*)(Kb + off_b(lrow, lch + 1)) = kr1;
        *(LAS u32x4*)(Vb + off_b(lrow, lch)) = vr0; *(LAS u32x4*)(Vb + off_b(lrow, lch + 1)) = vr1;
        __syncthreads();
        if (jt < 5) { const size_t key = (size_t)(i0 - 128 + 64 * (jt + 1) + lrow) * dil + res; const bf16_t* kp = kbase + key * DIN; const bf16_t* vp = vbase + key * DIN;
            kr0 = *(const u32x4*)kp; kr1 = *(const u32x4*)(kp + 8); vr0 = *(const u32x4*)vp; vr1 = *(const u32x4*)(vp + 8); }
        const int ki0 = i0 - 128 + 64 * jt;
        if (ki0 <= wq0 + 31 && ki0 + 63 >= wq0 - 128) {
            f32x16 x0, x1;
            qk_tile(Kb, qf, x0, x1, r, h);
            const float NEG = -__builtin_inff();
#pragma unroll
            for (int i = 0; i < 16; ++i) {
                const int d0 = myqi - (ki0 + crow(i, h));
                if ((unsigned)d0 > 128u) x0[i] = NEG;
                if ((unsigned)(d0 - 32) > 128u) x1[i] = NEG;
            }
            float mx = x0[0];
#pragma unroll
            for (int i = 1; i < 16; ++i) mx = fmaxf(mx, x0[i]);
#pragma unroll
            for (int i = 0; i < 16; ++i) mx = fmaxf(mx, x1[i]);
            { const unsigned t = __float_as_uint(mx); auto sw = __builtin_amdgcn_permlane32_swap(t, t, false, false); mx = fmaxf(__uint_as_float(sw[0]), __uint_as_float(sw[1])); }
            const float mn = fmaxf(mrun, mx);
            const float alpha = __builtin_amdgcn_exp2f(mrun - mn);
            mrun = mn;
            f32x16 p0, p1; float rs = 0.f;
#pragma unroll
            for (int i = 0; i < 16; ++i) { p0[i] = __builtin_amdgcn_exp2f(x0[i] - mn); p1[i] = __builtin_amdgcn_exp2f(x1[i] - mn); rs += p0[i] + p1[i]; }
            { const unsigned t = __float_as_uint(rs); auto sw = __builtin_amdgcn_permlane32_swap(t, t, false, false); rs = __uint_as_float(sw[0]) + __uint_as_float(sw[1]); }
            lrun = lrun * alpha + rs;
#pragma unroll
            for (int db = 0; db < 4; ++db)
#pragma unroll
                for (int i = 0; i < 16; ++i) o[db][i] *= alpha;
            pv_tile(Vb, p0, p1, o, lane);
        }
        cur ^= 1;
    }
    store_o(og + mytok * 1536 + head * 128, o, 1.0f / lrun, h);
    if (h == 0) lse[mytok * 12 + head] = (mrun + __builtin_amdgcn_logf(lrun)) * LN2;
    __syncthreads();
}
}

DI void phase_attn(const Params& p, LAS unsigned char* lds) {
    for (int it = blockIdx.x; it < 1024; it += gridDim.x) {
        if (it < 256) {
            const int xcd = it & 7, rest = it >> 3, bhi = rest >> 3, x = rest & 7, bh = xcd * 4 + bhi;
            att::sb_item(p, lds, bh >> 3, bh & 7, 15 - x);
            att::sb_item(p, lds, bh >> 3, bh & 7, x);
        } else att::dil_item(p, lds, it - 256);
    }
}

DI void phase_merge(const Params& p) {
    const int lane = threadIdx.x & 63, wid = threadIdx.x >> 6;
    const bf16_t* og = (const bf16_t*)(p.ws + WS_OG); const float* lse = (const float*)(p.ws + WS_LSE); bf16_t* odil = (bf16_t*)(p.ws + WS_ODIL);
    const int hg = lane >> 4, d0 = (lane & 15) * 8;
    for (int tok = blockIdx.x * 8 + wid; tok < NTOK; tok += gridDim.x * 8) {
        const float l0 = lse[(size_t)tok * 12 + hg], l1 = lse[(size_t)tok * 12 + 4 + hg], l2 = lse[(size_t)tok * 12 + 8 + hg];
        const float mx = fmaxf(l0, fmaxf(l1, l2));
        float w0 = __expf(l0 - mx), w1 = __expf(l1 - mx), w2 = __expf(l2 - mx);
        const float inv = 1.0f / (w0 + w1 + w2); w0 *= inv; w1 *= inv; w2 *= inv;
        const u32x4 a = *(const u32x4*)(og + (size_t)tok * 1536 + hg * 128 + d0);
        const u32x4 bq = *(const u32x4*)(og + (size_t)tok * 1536 + (4 + hg) * 128 + d0);
        const u32x4 c = *(const u32x4*)(og + (size_t)tok * 1536 + (8 + hg) * 128 + d0);
        u32x4 o;
#pragma unroll
        for (int q = 0; q < 4; ++q) {
            const float lo = w0 * bf_lo(a[q]) + w1 * bf_lo(bq[q]) + w2 * bf_lo(c[q]);
            const float hi = w0 * bf_hi(a[q]) + w1 * bf_hi(bq[q]) + w2 * bf_hi(c[q]);
            o[q] = pk_bf16(lo, hi);
        }
        *(u32x4*)(odil + (size_t)tok * 512 + hg * 128 + d0) = o;
    }
}

DI void phase_postmix(const Params& p, LAS unsigned char* lds) {
    const int tid = threadIdx.x, lane = tid & 63, wid = __builtin_amdgcn_readfirstlane(tid >> 6);
    LAS float* hsm = (LAS float*)lds;
    LAS float* part = (LAS float*)(lds + 65536);
    const float* mod = (const float*)(p.ws + WS_MOD); const float* y = (const float*)(p.ws + WS_Y);
    bf16_t* h2 = (bf16_t*)(p.ws + WS_H);
    int* cnt = (int*)(p.ws + WS_CNT); int* list = (int*)(p.ws + WS_LIST); float* w9 = (float*)(p.ws + WS_W9);
    for (int it = blockIdx.x; it < NTOK / 8; it += gridDim.x) {
        const int tok = it * 8 + wid, b = tok >> 12;
        {
            f32x4 v[8]; float ss = 0.f;
#pragma unroll
            for (int i = 0; i < 8; ++i) { v[i] = *(const f32x4*)(y + (size_t)tok * DM + 4 * (lane + 64 * i)); ss += v[i][0] * v[i][0] + v[i][1] * v[i][1] + v[i][2] * v[i][2] + v[i][3] * v[i][3]; }
            ss = wave_sum(ss);
            const float rstd = rsqrtf(ss * (1.0f / DM) + RMS_EPS);
            float ss1 = 0.f;
#pragma unroll
            for (int i = 0; i < 8; ++i) {
                const int ch = 4 * (lane + 64 * i);
                const f32x4 g = *(const f32x4*)(p.g_post_mix + ch);
                const f32x4 gt = *(const f32x4*)(mod + b * 12288 + 4096 + ch);
                const f32x4 xv = *(const f32x4*)(p.x + (size_t)tok * DM + ch);
#pragma unroll
                for (int j = 0; j < 4; ++j) { v[i][j] = xv[j] + gt[j] * (v[i][j] * rstd * g[j]); ss1 += v[i][j] * v[i][j]; }
                *(f32x4*)(p.out + (size_t)tok * DM + ch) = v[i];
            }
            ss1 = wave_sum(ss1);
            const float rstd1 = rsqrtf(ss1 * (1.0f / DM) + RMS_EPS);
#pragma unroll
            for (int i = 0; i < 8; ++i) {
                const int ch = 4 * (lane + 64 * i);
                const f32x4 g = *(const f32x4*)(p.g_pre_ffn + ch);
                const f32x4 sh = *(const f32x4*)(mod + b * 12288 + 6144 + ch);
                const f32x4 sc = *(const f32x4*)(mod + b * 12288 + 8192 + ch);
                f32x4 o;
#pragma unroll
                for (int j = 0; j < 4; ++j) o[j] = v[i][j] * rstd1 * g[j] * (1.0f + sc[j]) + sh[j];
                u32x2 w; w.x = pk_bf16(o[0], o[1]); w.y = pk_bf16(o[2], o[3]);
                *(u32x2*)(h2 + (size_t)tok * DM + ch) = w;
                *(LAS f32x4*)(hsm + wid * 2048 + ch) = o;
            }
        }
        __syncthreads();
        {
            float acc[8];
#pragma unroll
            for (int t = 0; t < 8; ++t) acc[t] = 0.f;
            const float* wrp = p.w_router + (size_t)(256 * wid) * 64 + lane;
            for (int k4 = 0; k4 < 64; ++k4) {
                const float w0 = wrp[(4 * k4 + 0) * 64], w1 = wrp[(4 * k4 + 1) * 64], w2 = wrp[(4 * k4 + 2) * 64], w3 = wrp[(4 * k4 + 3) * 64];
#pragma unroll
                for (int t = 0; t < 8; ++t) { const f32x4 hv = *(const LAS f32x4*)(hsm + t * 2048 + 256 * wid + 4 * k4); acc[t] += hv[0] * w0 + hv[1] * w1 + hv[2] * w2 + hv[3] * w3; }
            }
#pragma unroll
            for (int t = 0; t < 8; ++t) part[(wid * 8 + t) * 64 + lane] = acc[t];
        }
        __syncthreads();
        {
            float logit = 0.f;
#pragma unroll
            for (int w = 0; w < 8; ++w) logit += part[(w * 8 + wid) * 64 + lane];
            const float score = 1.0f / (1.0f + __expf(-logit));
            const float sel = score + p.router_bias[lane];
            float m1 = sel;
            m1 = fmaxf(m1, __shfl_xor(m1, 1)); m1 = fmaxf(m1, __shfl_xor(m1, 2)); m1 = fmaxf(m1, __shfl_xor(m1, 4));
            const bool is1 = (sel == m1);
            const unsigned long long bal = __ballot(is1);
            const unsigned gm = (unsigned)(bal >> (lane & ~7)) & 0xffu;
            const int first = __ffs(gm) - 1;
            float m2 = (is1 && (lane & 7) == first) ? -__builtin_inff() : sel;
            m2 = fmaxf(m2, __shfl_xor(m2, 1)); m2 = fmaxf(m2, __shfl_xor(m2, 2)); m2 = fmaxf(m2, __shfl_xor(m2, 4));
            const float gs = m1 + m2;
            const int myg = lane >> 3;
            int grank = 0;
#pragma unroll
            for (int g = 0; g < 8; ++g) { const float gv = __shfl(gs, 8 * g); grank += (gv > gs || (gv == gs && g < myg)) ? 1 : 0; }
            const bool gsel = grank < 4;
            const float msel = gsel ? sel : -__builtin_inff();
            int rk = 0;
#pragma unroll
            for (int e = 0; e < 64; ++e) { const float v = __shfl(msel, e); rk += (v > msel || (v == msel && e < lane)) ? 1 : 0; }
            const bool chosen = gsel && rk < 8;
            const float ssum = wave_sum(chosen ? score : 0.f);
            if (chosen) {
                const int v = tok * 9 + rk;
                const int pos = atomicAdd(&cnt[lane], 1);
                list[lane * LIST_CAP + pos] = v;
                w9[v] = score / ssum * 2.5f;
            }
        }
        __syncthreads();
    }
}

DI void phase_combine(const Params& p) {
    const int lane = threadIdx.x & 63, wid = threadIdx.x >> 6;
    const float* mod = (const float*)(p.ws + WS_MOD); const bf16_t* yb9 = (const bf16_t*)(p.ws + WS_YB9);
    for (int tok = blockIdx.x * 8 + wid; tok < NTOK; tok += gridDim.x * 8) {
        const int b = tok >> 12;
        float acc[4][8];
#pragma unroll
        for (int i = 0; i < 4; ++i)
#pragma unroll
            for (int j = 0; j < 8; ++j) acc[i][j] = 0.f;
#pragma unroll
        for (int k = 0; k < 9; ++k) {
            const bf16_t* row = yb9 + ((size_t)tok * 9 + k) * DM;
#pragma unroll
            for (int i = 0; i < 4; ++i) {
                const u32x4 w = *(const u32x4*)(row + 8 * (lane + 64 * i));
#pragma unroll
                for (int q = 0; q < 4; ++q) { acc[i][2 * q] += bf_lo(w[q]); acc[i][2 * q + 1] += bf_hi(w[q]); }
            }
        }
        float ss = 0.f;
#pragma unroll
        for (int i = 0; i < 4; ++i)
#pragma unroll
            for (int j = 0; j < 8; ++j) ss += acc[i][j] * acc[i][j];
        ss = wave_sum(ss);
        const float rstd = rsqrtf(ss * (1.0f / DM) + RMS_EPS);
#pragma unroll
        for (int i = 0; i < 4; ++i) {
            const int ch = 8 * (lane + 64 * i);
#pragma unroll
            for (int hh = 0; hh < 2; ++hh) {
                const f32x4 g = *(const f32x4*)(p.g_post_ffn + ch + 4 * hh);
                const f32x4 gt = *(const f32x4*)(mod + b * 12288 + 10240 + ch + 4 * hh);
                f32x4 xv = *(const f32x4*)(p.out + (size_t)tok * DM + ch + 4 * hh);
#pragma unroll
                for (int j = 0; j < 4; ++j) xv[j] += gt[j] * (acc[i][4 * hh + j] * rstd * g[j]);
                *(f32x4*)(p.out + (size_t)tok * DM + ch + 4 * hh) = xv;
            }
        }
    }
}

constexpr int NPHASE = 11;
template <int PH> DI void run_phase(const Params& p, LAS unsigned char* lds) {
    if constexpr (PH == 0) phase_prologue(p, lds);
    else if constexpr (PH == 1) phase_prenorm(p);
    else if constexpr (PH == 2) phase_inproj(p, lds);
    else if constexpr (PH == 3) phase_attn(p, lds);
    else if constexpr (PH == 4) phase_merge(p);
    else if constexpr (PH == 5) phase_outproj(p, lds);
    else if constexpr (PH == 6) phase_mixout(p, lds);
    else if constexpr (PH == 7) phase_postmix(p, lds);
    else if constexpr (PH == 8) phase_gateup(p, lds);
    else if constexpr (PH == 9) phase_down(p, lds);
    else phase_combine(p);
}
template <int PH> __global__ __launch_bounds__(512, 2) void k_phase(Params p) {
    extern __shared__ __attribute__((aligned(16))) unsigned char shm[];
    run_phase<PH>(p, (LAS unsigned char*)shm);
}
#if MK_FUSED
__global__ __launch_bounds__(512, 2) void k_mega(Params p) {
    extern __shared__ __attribute__((aligned(16))) unsigned char shm[];
    LAS unsigned char* lds = (LAS unsigned char*)shm;
    volatile LAS unsigned* xbw = (volatile LAS unsigned*)(lds + LDS_BYTES - 16);
    if (threadIdx.x == 0) { xbw[0] = 0u; xbw[1] = 0u; xbw[2] = 0u; xbw[3] = 0u; }
    __syncthreads();
    XcdBarrier bar = xcd_barrier_post((unsigned*)(p.ws + WS_BAR), xbw);
    run_phase<0>(p, lds); xcd_barrier(bar);
    run_phase<1>(p, lds); xcd_barrier(bar);
    run_phase<2>(p, lds); xcd_barrier(bar);
    run_phase<3>(p, lds); xcd_barrier(bar);
    run_phase<4>(p, lds); xcd_barrier(bar);
    run_phase<5>(p, lds); xcd_barrier(bar);
    run_phase<6>(p, lds); xcd_barrier(bar);
    run_phase<7>(p, lds); xcd_barrier(bar);
    run_phase<8>(p, lds); xcd_barrier(bar);
    run_phase<9>(p, lds); xcd_barrier(bar);
    run_phase<10>(p, lds);
}
#endif

template <int PH> static void launch_phase(const Params& p, int grid, hipStream_t stream) {
    static bool init = false;
    if (!init) { (void)hipFuncSetAttribute((const void*)k_phase<PH>, hipFuncAttributeMaxDynamicSharedMemorySize, LDS_BYTES); init = true; }
    hipLaunchKernelGGL(k_phase<PH>, dim3(grid), dim3(512), LDS_BYTES, stream, p);
}

extern "C" void kernel_launch(void* const* d_in, const int* in_sizes, int n_in, void* d_out, int out_size, void* d_ws, size_t ws_size, hipStream_t stream) {
    (void)in_sizes; (void)n_in; (void)out_size;
    static int grid = 0;
    if (!grid) {
        int dev = 0, cus = 0; (void)hipGetDevice(&dev); (void)hipDeviceGetAttribute(&cus, hipDeviceAttributeMultiprocessorCount, dev);
        if (cus <= 0) cus = 256;
#if MK_FUSED
        (void)hipFuncSetAttribute((const void*)k_mega, hipFuncAttributeMaxDynamicSharedMemorySize, LDS_BYTES);
        int per_cu = 0;
        if (hipOccupancyMaxActiveBlocksPerMultiprocessor(&per_cu, (const void*)k_mega, 512, LDS_BYTES) != hipSuccess || per_cu < 1)
            fprintf(stderr, "kernel_launch: occupancy query reports %d workgroups per CU\n", per_cu);
#endif
        grid = cus;
        if (ws_size < WS_TOTAL) fprintf(stderr, "kernel_launch: workspace too small: %zu < %zu\n", ws_size, (size_t)WS_TOTAL);
    }
    Params p{};
    p.x = (const float*)d_in[0]; p.c = (const float*)d_in[1]; p.pos = (const int*)d_in[2];
    p.w_ada = (const float*)d_in[3]; p.b_ada = (const float*)d_in[4];
    p.g_pre_mix = (const float*)d_in[5]; p.g_post_mix = (const float*)d_in[6]; p.g_pre_ffn = (const float*)d_in[7]; p.g_post_ffn = (const float*)d_in[8];
    p.w_in = (const float*)d_in[9]; p.w_dil_out = (const float*)d_in[10]; p.w_sb_out = (const float*)d_in[11]; p.w_mix_out = (const float*)d_in[12];
    p.w_router = (const float*)d_in[13]; p.router_bias = (const float*)d_in[14];
    p.w_gate_e = (const float*)d_in[15]; p.w_up_e = (const float*)d_in[16]; p.w_down_e = (const float*)d_in[17];
    p.w_gate_s = (const float*)d_in[18]; p.w_up_s = (const float*)d_in[19]; p.w_down_s = (const float*)d_in[20];
    p.out = (float*)d_out; p.ws = (unsigned char*)d_ws;
    (void)hipMemsetAsync((unsigned char*)d_ws + WS_BAR, 0, WS_ZERO_BYTES, stream);
#if MK_FUSED
    hipLaunchKernelGGL(k_mega, dim3(grid), dim3(512), LDS_BYTES, stream, p);
#else
    launch_phase<0>(p, grid, stream); launch_phase<1>(p, grid, stream); launch_phase<2>(p, grid, stream); launch_phase<3>(p, grid, stream);
    launch_phase<4>(p, grid, stream); launch_phase<5>(p, grid, stream); launch_phase<6>(p, grid, stream); launch_phase<7>(p, grid, stream);
    launch_phase<8>(p, grid, stream); launch_phase<9>(p, grid, stream); launch_phase<10>(p, grid, stream);
#endif
}
```

```cpp
#include <hip/hip_runtime.h>
#include <stdint.h>
#include <stdio.h>

#ifndef MK_FUSED
#define MK_FUSED 1
#endif

#define LAS __attribute__((address_space(3)))
#define DI __device__ __forceinline__
typedef unsigned short bf16_t;
typedef short bf16x8 __attribute__((ext_vector_type(8)));
typedef short s16x4 __attribute__((ext_vector_type(4)));
typedef float f32x2 __attribute__((ext_vector_type(2)));
typedef float f32x4 __attribute__((ext_vector_type(4)));
typedef float f32x16 __attribute__((ext_vector_type(16)));
typedef unsigned u32x2 __attribute__((ext_vector_type(2)));
typedef unsigned u32x4 __attribute__((ext_vector_type(4)));
typedef __bf16 bf16x2_t __attribute__((ext_vector_type(2)));

constexpr int NBATCH = 4, SEQ = 4096, NTOK = NBATCH * SEQ, DM = 2048, DIN = 11776;
constexpr int COL_QA = 0, COL_KA = 1536, COL_VA = 3072, COL_QS = 4608, COL_KS = 5632, COL_VS = 6656, COL_GD = 7680, COL_GS = 9728;
constexpr int NE = 64, DE = 512, NEX = 65;
constexpr int LIST_CAP = 16384;
constexpr float RMS_EPS = 1e-6f;
constexpr float QSCALE = 0.08838834764831845f * 1.4426950408889634f;
constexpr float LN2 = 0.6931471805599453f;

constexpr size_t MiB = 1ull << 20;
constexpr size_t WS_BAR = 0;
constexpr size_t WS_CNT = 16384;
constexpr size_t WS_ZERO_BYTES = 32768;
constexpr size_t WS_MOD = 65536;
constexpr size_t WS_LSE = 262144;
constexpr size_t WS_ROPE = 1 * MiB;
constexpr size_t WS_W9 = 3 * MiB;
constexpr size_t WS_LIST = 4 * MiB;
constexpr size_t WS_WD = 8 * MiB;
constexpr size_t WS_H = 138 * MiB;
constexpr size_t WS_HID = 202 * MiB;
constexpr size_t WS_WTIN = 202 * MiB;
constexpr size_t WS_WTDIL = 248 * MiB;
constexpr size_t WS_WTSB = 250 * MiB;
constexpr size_t WS_WTMIX = 254 * MiB;
constexpr size_t WS_OG = 262 * MiB;
constexpr size_t WS_OSB = 310 * MiB;
constexpr size_t WS_ODIL = 342 * MiB;
constexpr size_t WS_PROJ = 362 * MiB;
constexpr size_t WS_Y = 362 * MiB;
constexpr size_t WS_YB9 = 362 * MiB;
constexpr size_t WS_WGU = 730 * MiB;
constexpr size_t WS_TOTAL = 990 * MiB;

constexpr int LDS_BYTES = 147456;

struct Params {
    const float *x, *c; const int* pos;
    const float *w_ada, *b_ada, *g_pre_mix, *g_post_mix, *g_pre_ffn, *g_post_ffn;
    const float *w_in, *w_dil_out, *w_sb_out, *w_mix_out, *w_router, *router_bias;
    const float *w_gate_e, *w_up_e, *w_down_e, *w_gate_s, *w_up_s, *w_down_s;
    float* out; unsigned char* ws;
};

DI unsigned pk_bf16(float lo, float hi) { f32x2 v = {lo, hi}; bf16x2_t r = __builtin_convertvector(v, bf16x2_t); return __builtin_bit_cast(unsigned, r); }
DI float bf_lo(unsigned u) { return __uint_as_float(u << 16); }
DI float bf_hi(unsigned u) { return __uint_as_float(u & 0xffff0000u); }
DI float wave_sum(float v) {
#pragma unroll
    for (int o = 32; o >= 1; o >>= 1) v += __shfl_xor(v, o);
    return v;
}
DI float sigmoidf_(float x) { return 1.0f / (1.0f + __expf(-x)); }

#define XB_TMO      128
#define XB_XCNT(j)  (256  + 64 * (j))
#define XB_XSUB(j)  (1280 + 64 * (j))
#define XB_XGEN(j)  (2304 + 64 * (j))
#define XB_TOP      3328
#define XB_TOPGEN   3392
#define XCD_BAR_WORDS 3456
#define XB_SPIN_CAP (1u << 18)

__device__ __forceinline__ unsigned xb_ld(unsigned* p)              { return __hip_atomic_load(p, __ATOMIC_RELAXED, __HIP_MEMORY_SCOPE_AGENT); }
__device__ __forceinline__ unsigned xb_add(unsigned* p, unsigned v) { return __hip_atomic_fetch_add(p, v, __ATOMIC_RELAXED, __HIP_MEMORY_SCOPE_AGENT); }
__device__ __forceinline__ unsigned xb_xcc_id() { return (unsigned)__builtin_amdgcn_s_getreg((3 << 11) | 20) & 0xFu; }
#define XB_SPIN(cond, bar) do { unsigned _sp = 0; while (cond) { __builtin_amdgcn_s_sleep(1); \
    if ((++_sp & 255u) == 0u) { if (xb_ld(&(bar)[XB_TMO])) break; if (_sp > XB_SPIN_CAP) { atomicAdd(&(bar)[XB_TMO], 1u); break; } } } } while (0)

struct XcdBarrier { unsigned* bar; unsigned x; volatile LAS unsigned* st; };

__device__ __forceinline__ XcdBarrier xcd_barrier_post(unsigned* bar, volatile LAS unsigned* st) {
    XcdBarrier b; b.bar = bar; b.x = xb_xcc_id(); b.st = st;
    if (threadIdx.x == 0) (void)xb_add(&bar[XB_XCNT(b.x)], 1u);
    return b;
}
__device__ __forceinline__ void xcd_barrier_complete(unsigned* bar, unsigned x, unsigned& nloc, unsigned& nx) {
    const unsigned G = gridDim.x * gridDim.y * gridDim.z;
    unsigned sum, cnt, mine, sp = 0u;
    for (;;) {
        sum = 0u; cnt = 0u; mine = 0u;
#pragma unroll
        for (unsigned j = 0; j < 16; ++j) { const unsigned c = xb_ld(&bar[XB_XCNT(j)]); sum += c; cnt += (c > 0u) ? 1u : 0u; mine = (j == x) ? c : mine; }
        if (sum == G) break;
        __builtin_amdgcn_s_sleep(1);
        if ((++sp & 255u) == 0u) { if (xb_ld(&bar[XB_TMO])) break; if (sp > XB_SPIN_CAP) { atomicAdd(&bar[XB_TMO], 1u); break; } }
    }
    nloc = mine > 0u ? mine : 1u; nx = cnt > 0u ? cnt : 1u;
}
__device__ __forceinline__ void xcd_barrier(const XcdBarrier& b) {
    asm volatile("s_waitcnt vmcnt(0)" ::: "memory");
    __syncthreads();
    if (threadIdx.x == 0) {
        unsigned* bar = b.bar;
        __builtin_amdgcn_s_waitcnt(0);
        unsigned nloc = b.st[0], nx = b.st[1];
        if (nloc == 0u) { xcd_barrier_complete(bar, b.x, nloc, nx); b.st[0] = nloc; b.st[1] = nx; }
        const unsigned old = xb_add(&bar[XB_XSUB(b.x)], 1u);
        const unsigned gen = old / nloc;
        if (old + 1u == (gen + 1u) * nloc) {
            __builtin_amdgcn_fence(__ATOMIC_RELEASE, "agent");
            asm volatile("s_waitcnt vmcnt(0)" ::: "memory");
            const unsigned og = xb_add(&bar[XB_TOP], 1u);
            const unsigned tg = og / nx;
            if (og + 1u == (tg + 1u) * nx) xb_add(&bar[XB_TOPGEN], 1u);
            else XB_SPIN(xb_ld(&bar[XB_TOPGEN]) == tg, bar);
            __builtin_amdgcn_fence(__ATOMIC_ACQUIRE, "agent");
            xb_add(&bar[XB_XGEN(b.x)], 1u);
            asm volatile("s_waitcnt vmcnt(0)" ::: "memory");
        } else {
            XB_SPIN(xb_ld(&bar[XB_XGEN(b.x)]) == gen, bar);
            __builtin_amdgcn_fence(__ATOMIC_ACQUIRE, "agent");
            asm volatile("s_waitcnt vmcnt(0)" ::: "memory");
        }
    }
    __syncthreads();
}

struct CvtMat { const float* src; bf16_t* dst; int K, N, nb, mode; size_t sstride, dstride; };
constexpr int CVT_NMAT = 10;
constexpr int CVT_TILES[CVT_NMAT] = {2944, 128, 256, 512, 8192, 8192, 8192, 128, 128, 128};
constexpr int CVT_TOTAL = 2944 + 128 + 256 + 512 + 8192 * 3 + 128 * 3;
constexpr int P0_MOD_UNITS = 192, P0_ROPE_UNITS = 64, P0_ITEMS = P0_MOD_UNITS + P0_ROPE_UNITS + CVT_TOTAL;

DI CvtMat cvt_mat(const Params& p, int m) {
    bf16_t* wtin = (bf16_t*)(p.ws + WS_WTIN); bf16_t* wtdil = (bf16_t*)(p.ws + WS_WTDIL); bf16_t* wtsb = (bf16_t*)(p.ws + WS_WTSB); bf16_t* wtmix = (bf16_t*)(p.ws + WS_WTMIX);
    bf16_t* wgu = (bf16_t*)(p.ws + WS_WGU); bf16_t* wd = (bf16_t*)(p.ws + WS_WD);
    CvtMat r;
    switch (m) {
        case 0: r = {p.w_in, wtin, 2048, 11776, 1, 0, 0, 0}; break;
        case 1: r = {p.w_dil_out, wtdil, 512, 2048, 1, 0, 0, 0}; break;
        case 2: r = {p.w_sb_out, wtsb, 1024, 2048, 1, 0, 0, 0}; break;
        case 3: r = {p.w_mix_out, wtmix, 2048, 2048, 1, 0, 0, 0}; break;
        case 4: r = {p.w_gate_e, wgu, 2048, 512, 64, 1, (size_t)2048 * 512, (size_t)1024 * 2048}; break;
        case 5: r = {p.w_up_e, wgu, 2048, 512, 64, 2, (size_t)2048 * 512, (size_t)1024 * 2048}; break;
        case 6: r = {p.w_down_e, wd, 512, 2048, 64, 0, (size_t)512 * 2048, (size_t)2048 * 512}; break;
        case 7: r = {p.w_gate_s, wgu + (size_t)64 * 1024 * 2048, 2048, 512, 1, 1, 0, 0}; break;
        case 8: r = {p.w_up_s, wgu + (size_t)64 * 1024 * 2048, 2048, 512, 1, 2, 0, 0}; break;
        default: r = {p.w_down_s, wd + (size_t)64 * 2048 * 512, 512, 2048, 1, 0, 0, 0}; break;
    }
    return r;
}

DI void cvt_tile(const Params& p, int t, LAS unsigned char* lds) {
    int m = 0;
#pragma unroll
    for (int i = 0; i < CVT_NMAT - 1; ++i) { if (t >= CVT_TILES[i] && m == i) { t -= CVT_TILES[i]; m = i + 1; } }
    const CvtMat M = cvt_mat(p, m);
    const int tn = M.N / 64, tk = M.K / 128;
    const int b = t / (tn * tk); const int rem = t - b * (tn * tk); const int kt = rem / tn, nt = rem - kt * tn;
    const float* src = M.src + (size_t)b * M.sstride + (size_t)(kt * 128) * M.N + nt * 64;
    bf16_t* dst = M.dst + (size_t)b * M.dstride;
    const int tid = threadIdx.x;
    constexpr int P = 272;
    {
        const int kq = tid >> 4, n4 = (tid & 15) * 4;
        f32x4 v[4];
#pragma unroll
        for (int i = 0; i < 4; ++i) v[i] = *(const f32x4*)(src + (size_t)(kq + 32 * i) * M.N + n4);
#pragma unroll
        for (int i = 0; i < 4; ++i) {
            const int k = kq + 32 * i;
#pragma unroll
            for (int j = 0; j < 4; ++j) { const unsigned u = pk_bf16(v[i][j], 0.f); *(LAS bf16_t*)(lds + (n4 + j) * P + k * 2) = (bf16_t)(u & 0xffffu); }
        }
    }
    __syncthreads();
    {
        const int n = tid >> 3;
        const int c = nt * 64 + n;
        const int drow = M.mode == 0 ? c : (((c >> 7) << 8) + (c & 127) + (M.mode == 2 ? 128 : 0));
#pragma unroll
        for (int i = 0; i < 2; ++i) {
            const int ch = (tid & 7) + 8 * i;
            const u32x4 w = *(const LAS u32x4*)(lds + n * P + ch * 16);
            *(u32x4*)(dst + (size_t)drow * M.K + kt * 128 + ch * 8) = w;
        }
    }
    __syncthreads();
}

DI void mod_unit(const Params& p, int u, LAS unsigned char* lds) {
    const int tid = threadIdx.x, c0 = u * 64;
    LAS float* sc = (LAS float*)lds;
    LAS float* red = (LAS float*)(lds + 32768);
    for (int i = tid; i < 4 * 2048; i += 512) { const float v = p.c[i]; sc[i] = v / (1.0f + __expf(-v)); }
    __syncthreads();
    const int kq = tid >> 4, cq = tid & 15;
    float acc[4][4];
#pragma unroll
    for (int b = 0; b < 4; ++b)
#pragma unroll
        for (int j = 0; j < 4; ++j) acc[b][j] = 0.f;
    for (int it = 0; it < 64; ++it) {
        const int k = kq + 32 * it;
        const f32x4 w = *(const f32x4*)(p.w_ada + (size_t)k * 12288 + c0 + 4 * cq);
#pragma unroll
        for (int b = 0; b < 4; ++b) { const float s = sc[b * 2048 + k];
#pragma unroll
            for (int j = 0; j < 4; ++j) acc[b][j] += s * w[j]; }
    }
#pragma unroll
    for (int b = 0; b < 4; ++b)
#pragma unroll
        for (int j = 0; j < 4; ++j) red[(kq * 4 + b) * 64 + 4 * cq + j] = acc[b][j];
    __syncthreads();
    if (tid < 256) {
        const int b = tid >> 6, col = tid & 63;
        float s = 0.f;
        for (int q = 0; q < 32; ++q) s += red[(q * 4 + b) * 64 + col];
        float* mod = (float*)(p.ws + WS_MOD);
        mod[b * 12288 + c0 + col] = s + p.b_ada[c0 + col];
    }
    __syncthreads();
}

DI void rope_unit(const Params& p, int u) {
    float2* rope = (float2*)(p.ws + WS_ROPE);
    for (int e = threadIdx.x; e < 4096; e += 512) {
        const int tok = u * 256 + (e >> 4), i = e & 15;
        const float invf = (float)pow(500000.0, -(double)i / 16.0);
        const float ang = (float)p.pos[tok] * invf;
        rope[tok * 16 + i] = make_float2((float)cos((double)ang), (float)sin((double)ang));
    }
}

DI void phase_prologue(const Params& p, LAS unsigned char* lds) {
    for (int it = blockIdx.x; it < P0_ITEMS; it += gridDim.x) {
        if (it < P0_MOD_UNITS) mod_unit(p, it, lds);
        else if (it < P0_MOD_UNITS + P0_ROPE_UNITS) rope_unit(p, it - P0_MOD_UNITS);
        else cvt_tile(p, it - P0_MOD_UNITS - P0_ROPE_UNITS, lds);
    }
}

DI void phase_prenorm(const Params& p) {
    const int lane = threadIdx.x & 63, wid = threadIdx.x >> 6;
    const float* mod = (const float*)(p.ws + WS_MOD);
    bf16_t* h = (bf16_t*)(p.ws + WS_H);
    for (int tok = blockIdx.x * 8 + wid; tok < NTOK; tok += gridDim.x * 8) {
        const int b = tok >> 12;
        const float* xr = p.x + (size_t)tok * DM;
        f32x4 v[8]; float ss = 0.f;
#pragma unroll
        for (int i = 0; i < 8; ++i) { v[i] = *(const f32x4*)(xr + 4 * (lane + 64 * i)); ss += v[i][0] * v[i][0] + v[i][1] * v[i][1] + v[i][2] * v[i][2] + v[i][3] * v[i][3]; }
        ss = wave_sum(ss);
        const float rstd = rsqrtf(ss * (1.0f / DM) + RMS_EPS);
#pragma unroll
        for (int i = 0; i < 8; ++i) {
            const int ch = 4 * (lane + 64 * i);
            const f32x4 g = *(const f32x4*)(p.g_pre_mix + ch);
            const f32x4 sh = *(const f32x4*)(mod + b * 12288 + ch);
            const f32x4 sc = *(const f32x4*)(mod + b * 12288 + 2048 + ch);
            f32x4 o;
#pragma unroll
            for (int j = 0; j < 4; ++j) o[j] = v[i][j] * rstd * g[j] * (1.0f + sc[j]) + sh[j];
            u32x2 w; w.x = pk_bf16(o[0], o[1]); w.y = pk_bf16(o[2], o[3]);
            *(u32x2*)(h + (size_t)tok * DM + ch) = w;
        }
    }
}

namespace g8 {
constexpr int BM = 256, BK = 64, HALF = 128, HTB = HALF * BK * 2, STAGE_BYTES = 8 * HTB, NXCD = 8, WGM = 8;
DI int lds_byte(int r, int c) { const int st = (r >> 4) * 2 + (c >> 5), rr = r & 15, cc = c & 31, ob = rr * 64 + cc * 2; return st * 1024 + (ob ^ (((ob >> 9) & 1) << 5)); }
DI void stage_rc(int b, int& R, int& C) { const int st = b / 1024, sb = b % 1024, swz = sb ^ (((sb >> 9) & 1) << 5); R = (st >> 1) * 16 + swz / 64; C = (st & 1) * 32 + (swz % 64) / 2; }
DI int perm32(int rho) { const int n = rho >> 4, i = rho & 15; return 8 * (i >> 2) + 4 * n + (i & 3); }

struct Unit {
    const char* A; const char* B;
    int row0;
    int lda, ldb, nt;
    int pm, pn, aux, keep;
    int e, nvalid;
};

DI bool static_tile(int L, int nM, int nN, int& pm, int& pn) {
    const int nwg = nM * nN; if (L >= nwg) return false;
    int wgid = L; { const int q = nwg / NXCD, r = nwg % NXCD, xcd = wgid % NXCD, off = wgid / NXCD; wgid = (xcd < r ? xcd * (q + 1) : r * (q + 1) + (xcd - r) * q) + off; }
    const int nig = WGM * nN, gid = wgid / nig, fm = gid * WGM, gsz = (nM - fm) < WGM ? (nM - fm) : WGM;
    pm = fm + ((wgid % nig) % gsz); pn = (wgid % nig) / gsz; return true;
}

template <class Sched, class Epi>
DI void gemm_phase(LAS unsigned char* lds, const Sched& S, const Epi& E) {
    const int tid = threadIdx.x, wid = __builtin_amdgcn_readfirstlane(tid >> 6), lane = tid & 63, wr = wid >> 2, wc = wid & 3, fr = lane & 15, fq = lane >> 4;
    int sR[2], sC[2], sRb[2];
#pragma unroll
    for (int i = 0; i < 2; ++i) { int R, C; stage_rc(tid * 16 + i * 8192, R, C); sR[i] = R; sC[i] = C * 2; sRb[i] = (R & ~31) + perm32(R & 31); }
    const unsigned ldsw = (unsigned)wid * 1024u;
    const int aoff = lds_byte(wr * 64 + fr, fq * 8), boff = lds_byte(wc * 32 + fr, fq * 8);
#define G8_SA(b, h) (((b) * 2 + (h)) * HTB)
#define G8_SB(b, h) ((4 + (b) * 2 + (h)) * HTB)
#define G8_STAGE(bufoff, gbase, voff) do { _Pragma("unroll") for (int _i = 0; _i < 2; ++_i) \
        __builtin_amdgcn_global_load_lds((const unsigned*)((const char*)(gbase) + (voff)[_i]), (LAS unsigned*)(lds + (bufoff) + ldsw + _i * 8192), 16, 0, 0); } while (0)
#define G8_LDA(dst, b, h) do { _Pragma("unroll") for (int m = 0; m < 4; ++m) _Pragma("unroll") for (int k = 0; k < 2; ++k) dst[m][k] = *(const LAS bf16x8*)(lds + G8_SA(b, h) + aoff + m * 2048 + k * 1024); } while (0)
#define G8_LDB(dst, b, h) do { _Pragma("unroll") for (int n = 0; n < 2; ++n) _Pragma("unroll") for (int k = 0; k < 2; ++k) dst[n][k] = *(const LAS bf16x8*)(lds + G8_SB(b, h) + boff + n * 2048 + k * 1024); } while (0)
#define G8_MMA(ai, bj, At, Bt) do { __builtin_amdgcn_s_setprio(1); _Pragma("unroll") for (int m = 0; m < 4; ++m) _Pragma("unroll") for (int n = 0; n < 2; ++n) _Pragma("unroll") for (int k = 0; k < 2; ++k) \
        acc[ai][bj][m][n] = __builtin_amdgcn_mfma_f32_16x16x32_bf16(Bt[n][k], At[m][k], acc[ai][bj][m][n], 0, 0, 0); __builtin_amdgcn_s_setprio(0); } while (0)
#define G8_WAIT_V(n) asm volatile("s_waitcnt vmcnt(" #n ")" ::: "memory")
#define G8_WAIT_L(n) asm volatile("s_waitcnt lgkmcnt(" #n ")" ::: "memory")
#define G8_BAR __builtin_amdgcn_s_barrier()
#define G8_SCHED __builtin_amdgcn_sched_barrier(0)
#define G8_OFFS(u, vA, vB) do { _Pragma("unroll") for (int _h = 0; _h < 2; ++_h) _Pragma("unroll") for (int _i = 0; _i < 2; ++_i) \
        vA[_h][_i] = (unsigned)S.arow(u, _h * 128 + sR[_i]) * (unsigned)(u).lda + (unsigned)sC[_i]; \
        _Pragma("unroll") for (int _i = 0; _i < 2; ++_i) vB[_i] = (unsigned)sRb[_i] * (unsigned)(u).ldb + (unsigned)sC[_i]; } while (0)
    Unit cur, nxt; int ui = 0;
    if (!S.next(0, cur)) return;
    f32x4 acc[2][2][4][2];
#pragma unroll
    for (int a = 0; a < 2; ++a)
#pragma unroll
        for (int b = 0; b < 2; ++b)
#pragma unroll
            for (int m = 0; m < 4; ++m)
#pragma unroll
                for (int n = 0; n < 2; ++n) acc[a][b][m][n] = (f32x4){0.f, 0.f, 0.f, 0.f};
    bf16x8 At[4][2], B0[2][2], B1[2][2];
    unsigned vA[2][2], vB[2];
    G8_OFFS(cur, vA, vB);
    const char* cA = cur.A; const char* cB = cur.B; size_t hB = (size_t)128 * cur.ldb;
    constexpr size_t kstep = 128;
    G8_STAGE(G8_SB(0, 0), cB, vB); G8_STAGE(G8_SA(0, 0), cA, vA[0]); G8_STAGE(G8_SB(0, 1), cB + hB, vB); G8_STAGE(G8_SA(0, 1), cA, vA[1]);
    if (wr == 1) G8_BAR;
    G8_WAIT_V(4); G8_BAR;
    G8_STAGE(G8_SB(1, 0), cB + kstep, vB); G8_STAGE(G8_SA(1, 0), cA + kstep, vA[0]); G8_STAGE(G8_SB(1, 1), cB + hB + kstep, vB);
    G8_WAIT_V(6); G8_BAR;
    for (;;) {
        bool has_next = false;
        const char* nA = cA; const char* nB = cB; size_t nhB = hB;
        const int nt = cur.nt;
#pragma unroll 1
        for (int t = 0; t < nt; t += 2) {
            const bool last = (t == nt - 2);
            const char* a1 = cA + (size_t)(t + 1) * kstep;
            G8_LDB(B0, 0, 0); G8_SCHED; G8_LDA(At, 0, 0); G8_STAGE(G8_SA(1, 1), a1, vA[1]);
            G8_WAIT_L(8); G8_BAR; G8_WAIT_L(0); G8_MMA(0, 0, At, B0); G8_BAR; G8_SCHED;
            const char* a2; const char* b2; size_t h2;
            if (last) {
                has_next = S.next(ui + 1, nxt);
                if (has_next) { G8_OFFS(nxt, vA, vB); nA = nxt.A; nB = nxt.B; nhB = (size_t)128 * nxt.ldb; }
                a2 = nA; b2 = nB; h2 = nhB;
            } else { a2 = cA + (size_t)(t + 2) * kstep; b2 = cB + (size_t)(t + 2) * kstep; h2 = hB; }
            const char* a3 = a2 + kstep; const char* b3 = b2 + kstep;
            G8_LDB(B1, 0, 1); G8_STAGE(G8_SB(0, 0), b2, vB);
            G8_BAR; G8_WAIT_L(0); G8_MMA(0, 1, At, B1); G8_BAR;
            G8_LDA(At, 0, 1); G8_STAGE(G8_SA(0, 0), a2, vA[0]);
            G8_BAR; G8_WAIT_L(0); G8_MMA(1, 0, At, B0); G8_BAR; G8_SCHED;
            G8_STAGE(G8_SB(0, 1), b2 + h2, vB);
            G8_WAIT_V(6); G8_BAR; G8_MMA(1, 1, At, B1); G8_BAR;
            G8_LDB(B0, 1, 0); G8_SCHED; G8_LDA(At, 1, 0); G8_STAGE(G8_SA(0, 1), a2, vA[1]);
            G8_WAIT_L(8); G8_BAR; G8_WAIT_L(0); G8_MMA(0, 0, At, B0); G8_BAR; G8_SCHED;
            G8_LDB(B1, 1, 1); G8_STAGE(G8_SB(1, 0), b3, vB);
            G8_BAR; G8_WAIT_L(0); G8_MMA(0, 1, At, B1); G8_BAR;
            G8_LDA(At, 1, 1); G8_STAGE(G8_SA(1, 0), a3, vA[0]);
            G8_BAR; G8_WAIT_L(0); G8_MMA(1, 0, At, B0); G8_BAR; G8_SCHED;
            G8_STAGE(G8_SB(1, 1), b3 + h2, vB);
            G8_WAIT_V(6); G8_BAR; G8_MMA(1, 1, At, B1); G8_BAR;
        }
        E(acc, cur, wr, wc, fr, fq);
        if (!has_next) break;
        if (!cur.keep) {
#pragma unroll
            for (int a = 0; a < 2; ++a)
#pragma unroll
                for (int b = 0; b < 2; ++b)
#pragma unroll
                    for (int m = 0; m < 4; ++m)
#pragma unroll
                        for (int n = 0; n < 2; ++n) acc[a][b][m][n] = (f32x4){0.f, 0.f, 0.f, 0.f};
        }
        cur = nxt; cA = nA; cB = nB; hB = nhB; ++ui;
    }
    G8_WAIT_V(0);
    if (wr == 0) G8_BAR;
    G8_BAR;
#undef G8_SA
#undef G8_SB
#undef G8_STAGE
#undef G8_LDA
#undef G8_LDB
#undef G8_MMA
#undef G8_WAIT_V
#undef G8_WAIT_L
#undef G8_BAR
#undef G8_SCHED
#undef G8_OFFS
}
}

struct DenseSched {
    const char* A; const char* Bt; int nM, nN, lda, ldb, nt, G, c;
    DI bool next(int i, g8::Unit& u) const {
        int pm, pn; if (!g8::static_tile(i * G + c, nM, nN, pm, pn)) return false;
        u.A = A; u.B = Bt + (size_t)pn * 256 * ldb; u.row0 = pm * 256; u.lda = lda; u.ldb = ldb; u.nt = nt; u.pm = pm; u.pn = pn; u.aux = 0; u.keep = 0; u.e = 0; u.nvalid = 256; return true;
    }
    DI int arow(const g8::Unit& u, int rr) const { return u.row0 + rr; }
};
struct OutProjSched {
    const char *A0, *B0, *A1, *B1; int G, c;
    DI bool next(int i, g8::Unit& u) const {
        int pm, pn; if (!g8::static_tile((i >> 1) * G + c, 64, 8, pm, pn)) return false;
        const int part = i & 1;
        u.A = part ? A1 : A0; u.lda = part ? 2048 : 1024; u.ldb = part ? 2048 : 1024; u.nt = part ? 16 : 8;
        u.B = (part ? B1 : B0) + (size_t)pn * 256 * u.ldb; u.row0 = pm * 256; u.pm = pm; u.pn = pn; u.aux = part; u.keep = part ? 0 : 1; u.e = 0; u.nvalid = 256; return true;
    }
    DI int arow(const g8::Unit& u, int rr) const { return u.row0 + rr; }
};
struct MoeSched {
    const LAS int* tpre; const int* cnt; const int* list; const char* A; const char* W; int ncol, mode  , G, c;
    DI bool next(int i, g8::Unit& u) const {
        const int L = i * G + c; const int T = tpre[NEX];
        if (L >= T * ncol) return false;
        const int gt = L / ncol, pn = L - gt * ncol;
        int e = 0;
        for (int q = 1; q < NEX; ++q) e = (tpre[q] <= gt) ? q : e;
        const int tile = gt - tpre[e];
        const int n_e = (e < NE) ? cnt[e] : NTOK;
        u.e = e; u.pm = tile; u.pn = pn; u.nvalid = min(256, n_e - tile * 256); u.keep = 0; u.aux = gt * 256;
        if (mode == 0) { u.A = A; u.lda = 4096; u.ldb = 4096; u.nt = 32; u.B = W + ((size_t)e * 1024 + (size_t)pn * 256) * 4096; u.row0 = tile * 256; }
        else { u.A = A; u.lda = 1024; u.ldb = 1024; u.nt = 8; u.B = W + ((size_t)e * 2048 + (size_t)pn * 256) * 1024; u.row0 = gt * 256; }
        return true;
    }
    DI int arow(const g8::Unit& u, int rr) const {
        if (mode == 1) return u.row0 + rr;
        if (u.e >= NE) return u.row0 + rr;
        const int r = min(rr, u.nvalid - 1);
        return list[u.e * LIST_CAP + u.row0 + r] / 9;
    }
};

typedef f32x4 (&AccRef)[2][2][4][2];
#define EPI_FOR_ROWS _Pragma("unroll") for (int ai = 0; ai < 2; ++ai) _Pragma("unroll") for (int m = 0; m < 4; ++m)
#define EPI_RT (ai * 128 + wr * 64 + m * 16 + fr)

struct EpiInProj {
    bf16_t* proj; const float* rope;
    DI void operator()(AccRef acc, const g8::Unit& u, int wr, int wc, int fr, int fq) const {
        const int pn = u.pn;
        const int kind = pn < 6 ? 0 : pn < 12 ? 1 : pn < 18 ? 2 : pn < 22 ? 3 : pn < 30 ? 2 : 4;
        const bool do_rope = (kind <= 1) && (wc == 0);
        EPI_FOR_ROWS { const int rt = EPI_RT;
            const int row = u.pm * 256 + rt;
            f32x4 cs[4];
            if (do_rope) {
#pragma unroll
                for (int q = 0; q < 4; ++q) cs[q] = *(const f32x4*)(rope + (size_t)row * 32 + 16 * (fq & 1) + 4 * q);
            }
#pragma unroll
            for (int bj = 0; bj < 2; ++bj) {
                f32x4 v0 = acc[ai][bj][m][0], v1 = acc[ai][bj][m][1];
                if (do_rope) {
                    const float sg = (fq < 2) ? -1.0f : 1.0f;
                    f32x4 p0, p1;
#pragma unroll
                    for (int j = 0; j < 4; ++j) { p0[j] = __shfl_xor(v0[j], 32); p1[j] = __shfl_xor(v1[j], 32); }
#pragma unroll
                    for (int j = 0; j < 4; ++j) {
                        const float c0 = cs[j >> 1][(j & 1) * 2], s0 = cs[j >> 1][(j & 1) * 2 + 1];
                        const float c1 = cs[2 + (j >> 1)][(j & 1) * 2], s1 = cs[2 + (j >> 1)][(j & 1) * 2 + 1];
                        v0[j] = v0[j] * c0 + sg * p0[j] * s0;
                        v1[j] = v1[j] * c1 + sg * p1[j] * s1;
                    }
                }
                if (kind == 0 || kind == 3) { v0 *= QSCALE; v1 *= QSCALE; }
                if (kind == 4) {
#pragma unroll
                    for (int j = 0; j < 4; ++j) { v0[j] = sigmoidf_(v0[j]); v1[j] = sigmoidf_(v1[j]); }
                }
                u32x4 w; w.x = pk_bf16(v0[0], v0[1]); w.y = pk_bf16(v0[2], v0[3]); w.z = pk_bf16(v1[0], v1[1]); w.w = pk_bf16(v1[2], v1[3]);
                *(u32x4*)(proj + (size_t)row * DIN + pn * 256 + bj * 128 + wc * 32 + 8 * fq) = w;
            }
        }
    }
};
struct EpiOutProj {
    const bf16_t* proj; bf16_t* mixed;
    DI void operator()(AccRef acc, const g8::Unit& u, int wr, int wc, int fr, int fq) const {
        const int part = u.aux;
        EPI_FOR_ROWS { const int rt = EPI_RT;
            const int row = u.pm * 256 + rt;
#pragma unroll
            for (int bj = 0; bj < 2; ++bj) {
                const int col = u.pn * 256 + bj * 128 + wc * 32 + 8 * fq;
                const u32x4 gs = *(const u32x4*)(proj + (size_t)row * DIN + COL_GS + col);
                float s[8] = {bf_lo(gs.x), bf_hi(gs.x), bf_lo(gs.y), bf_hi(gs.y), bf_lo(gs.z), bf_hi(gs.z), bf_lo(gs.w), bf_hi(gs.w)};
                if (part == 0) {
                    const u32x4 gd = *(const u32x4*)(proj + (size_t)row * DIN + COL_GD + col);
                    float d[8] = {bf_lo(gd.x), bf_hi(gd.x), bf_lo(gd.y), bf_hi(gd.y), bf_lo(gd.z), bf_hi(gd.z), bf_lo(gd.w), bf_hi(gd.w)};
#pragma unroll
                    for (int j = 0; j < 4; ++j) { acc[ai][bj][m][0][j] *= d[j] / s[j]; acc[ai][bj][m][1][j] *= d[4 + j] / s[4 + j]; }
                } else {
                    f32x4 v0 = acc[ai][bj][m][0], v1 = acc[ai][bj][m][1];
#pragma unroll
                    for (int j = 0; j < 4; ++j) { v0[j] *= s[j]; v1[j] *= s[4 + j]; }
                    u32x4 w; w.x = pk_bf16(v0[0], v0[1]); w.y = pk_bf16(v0[2], v0[3]); w.z = pk_bf16(v1[0], v1[1]); w.w = pk_bf16(v1[2], v1[3]);
                    *(u32x4*)(mixed + (size_t)row * DM + col) = w;
                }
            }
        }
    }
};
struct EpiF32 {
    float* y;
    DI void operator()(AccRef acc, const g8::Unit& u, int wr, int wc, int fr, int fq) const {
        EPI_FOR_ROWS { const int rt = EPI_RT;
            const int row = u.pm * 256 + rt;
#pragma unroll
            for (int bj = 0; bj < 2; ++bj) {
                float* dst = y + (size_t)row * DM + u.pn * 256 + bj * 128 + wc * 32 + 8 * fq;
                *(f32x4*)dst = acc[ai][bj][m][0]; *(f32x4*)(dst + 4) = acc[ai][bj][m][1];
            }
        }
    }
};
struct EpiGateUp {
    bf16_t* hid;
    DI void operator()(AccRef acc, const g8::Unit& u, int wr, int wc, int fr, int fq) const {
        EPI_FOR_ROWS { const int rt = EPI_RT;
            const int row = u.aux + rt;
            const f32x4 g0 = acc[ai][0][m][0], g1 = acc[ai][0][m][1], u0 = acc[ai][1][m][0], u1 = acc[ai][1][m][1];
            f32x4 v0, v1;
#pragma unroll
            for (int j = 0; j < 4; ++j) { v0[j] = g0[j] * sigmoidf_(g0[j]) * u0[j]; v1[j] = g1[j] * sigmoidf_(g1[j]) * u1[j]; }
            u32x4 w; w.x = pk_bf16(v0[0], v0[1]); w.y = pk_bf16(v0[2], v0[3]); w.z = pk_bf16(v1[0], v1[1]); w.w = pk_bf16(v1[2], v1[3]);
            *(u32x4*)(hid + (size_t)row * DE + u.pn * 128 + wc * 32 + 8 * fq) = w;
        }
    }
};
struct EpiDown {
    const int* list; const float* w9; bf16_t* yb9;
    DI void operator()(AccRef acc, const g8::Unit& u, int wr, int wc, int fr, int fq) const {
        EPI_FOR_ROWS { const int rt = EPI_RT;
            if (rt < u.nvalid) {
                int v; float wgt;
                if (u.e < NE) { v = list[u.e * LIST_CAP + u.pm * 256 + rt]; wgt = w9[v]; }
                else { v = (u.pm * 256 + rt) * 9 + 8; wgt = 1.0f; }
#pragma unroll
                for (int bj = 0; bj < 2; ++bj) {
                    const f32x4 v0 = acc[ai][bj][m][0] * wgt, v1 = acc[ai][bj][m][1] * wgt;
                    u32x4 w; w.x = pk_bf16(v0[0], v0[1]); w.y = pk_bf16(v0[2], v0[3]); w.z = pk_bf16(v1[0], v1[1]); w.w = pk_bf16(v1[2], v1[3]);
                    *(u32x4*)(yb9 + (size_t)v * DM + u.pn * 256 + bj * 128 + wc * 32 + 8 * fq) = w;
                }
            }
            asm volatile("" ::: "memory");
        }
    }
};

DI void phase_inproj(const Params& p, LAS unsigned char* lds) {
    DenseSched S{(const char*)(p.ws + WS_H), (const char*)(p.ws + WS_WTIN), 64, 46, 4096, 4096, 32, (int)gridDim.x, (int)blockIdx.x};
    EpiInProj E{(bf16_t*)(p.ws + WS_PROJ), (const float*)(p.ws + WS_ROPE)};
    g8::gemm_phase(lds, S, E);
}
DI void phase_outproj(const Params& p, LAS unsigned char* lds) {
    OutProjSched S{(const char*)(p.ws + WS_ODIL), (const char*)(p.ws + WS_WTDIL), (const char*)(p.ws + WS_OSB), (const char*)(p.ws + WS_WTSB), (int)gridDim.x, (int)blockIdx.x};
    EpiOutProj E{(const bf16_t*)(p.ws + WS_PROJ), (bf16_t*)(p.ws + WS_H)};
    g8::gemm_phase(lds, S, E);
}
DI void phase_mixout(const Params& p, LAS unsigned char* lds) {
    DenseSched S{(const char*)(p.ws + WS_H), (const char*)(p.ws + WS_WTMIX), 64, 8, 4096, 4096, 32, (int)gridDim.x, (int)blockIdx.x};
    EpiF32 E{(float*)(p.ws + WS_Y)};
    g8::gemm_phase(lds, S, E);
}
DI void moe_tile_prefix(const Params& p, LAS int* tpre) {
    if (threadIdx.x == 0) {
        const int* cnt = (const int*)(p.ws + WS_CNT);
        int acc = 0;
        for (int e = 0; e < NE; ++e) { tpre[e] = acc; acc += (cnt[e] + 255) >> 8; }
        tpre[NE] = acc; acc += NTOK / 256; tpre[NEX] = acc;
    }
    __syncthreads();
}
DI void phase_gateup(const Params& p, LAS unsigned char* lds) {
    LAS int* tpre = (LAS int*)(lds + g8::STAGE_BYTES);
    moe_tile_prefix(p, tpre);
    MoeSched S{tpre, (const int*)(p.ws + WS_CNT), (const int*)(p.ws + WS_LIST), (const char*)(p.ws + WS_H), (const char*)(p.ws + WS_WGU), 4, 0, (int)gridDim.x, (int)blockIdx.x};
    EpiGateUp E{(bf16_t*)(p.ws + WS_HID)};
    g8::gemm_phase(lds, S, E);
}
DI void phase_down(const Params& p, LAS unsigned char* lds) {
    LAS int* tpre = (LAS int*)(lds + g8::STAGE_BYTES);
    moe_tile_prefix(p, tpre);
    MoeSched S{tpre, (const int*)(p.ws + WS_CNT), (const int*)(p.ws + WS_LIST), (const char*)(p.ws + WS_HID), (const char*)(p.ws + WS_WD), 8, 1, (int)gridDim.x, (int)blockIdx.x};
    EpiDown E{(const int*)(p.ws + WS_LIST), (const float*)(p.ws + WS_W9), (bf16_t*)(p.ws + WS_YB9)};
    g8::gemm_phase(lds, S, E);
}

namespace att {
constexpr int TB = 16384;
DI unsigned off_b(unsigned row, unsigned ch) { return 256u * row + 16u * (ch ^ (((row & 3u) << 2) | ((row >> 2) & 3u))); }
DI int crow(int i, int h) { return (i & 3) + 8 * (i >> 2) + 4 * h; }
DI f32x16 mfma32(bf16x8 a, bf16x8 b, f32x16 c) { return __builtin_amdgcn_mfma_f32_32x32x16_bf16(a, b, c, 0, 0, 0); }
DI bf16x8 pack8(const f32x16& x, int s) {
    u32x4 w; w.x = pk_bf16(x[8 * s + 0], x[8 * s + 1]); w.y = pk_bf16(x[8 * s + 2], x[8 * s + 3]); w.z = pk_bf16(x[8 * s + 4], x[8 * s + 5]); w.w = pk_bf16(x[8 * s + 6], x[8 * s + 7]);
    return __builtin_bit_cast(bf16x8, w);
}
DI void qk_tile(LAS const unsigned char* Kb, const bf16x8 (&qf)[8], f32x16& x0, f32x16& x1, int r, int h) {
#pragma unroll
    for (int i = 0; i < 16; ++i) { x0[i] = 0.f; x1[i] = 0.f; }
#pragma unroll
    for (int s = 0; s < 8; ++s) {
        const bf16x8 a0 = *(const LAS bf16x8*)(Kb + off_b(r, 2 * s + h));
        const bf16x8 a1 = *(const LAS bf16x8*)(Kb + off_b(32 + r, 2 * s + h));
        x0 = mfma32(a0, qf[s], x0); x1 = mfma32(a1, qf[s], x1);
    }
}
DI void pv_tile(LAS const unsigned char* Vb, const f32x16& p0, const f32x16& p1, f32x16 (&o)[4], int lane) {
    const int h = lane >> 5, blk = (lane >> 4) & 1, q = (lane & 15) >> 2, pp = lane & 3;
#pragma unroll
    for (int kb = 0; kb < 2; ++kb)
#pragma unroll
        for (int s = 0; s < 2; ++s) {
            const bf16x8 pf = pack8(kb ? p1 : p0, s);
#pragma unroll
            for (int db = 0; db < 4; ++db) {
                const unsigned row0 = 32 * kb + 16 * s + 4 * h + q;
                const unsigned ch = 4 * db + 2 * blk + (pp >> 1);
                const s16x4 t0 = __builtin_amdgcn_ds_read_tr16_b64_v4i16((LAS s16x4*)(Vb + off_b(row0, ch) + 8 * (pp & 1)));
                const s16x4 t1 = __builtin_amdgcn_ds_read_tr16_b64_v4i16((LAS s16x4*)(Vb + off_b(row0 + 8, ch) + 8 * (pp & 1)));
                const bf16x8 vf = {t0[0], t0[1], t0[2], t0[3], t1[0], t1[1], t1[2], t1[3]};
                o[db] = mfma32(vf, pf, o[db]);
            }
        }
}
DI void store_o(bf16_t* orow, const f32x16 (&o)[4], float scale, int h) {
#pragma unroll
    for (int db = 0; db < 4; ++db)
#pragma unroll
        for (int g = 0; g < 4; ++g) {
            u32x2 w; w.x = pk_bf16(o[db][4 * g] * scale, o[db][4 * g + 1] * scale); w.y = pk_bf16(o[db][4 * g + 2] * scale, o[db][4 * g + 3] * scale);
            *(u32x2*)(orow + 32 * db + 8 * g + 4 * h) = w;
        }
}

DI void sb_item(const Params& p, LAS unsigned char* lds, int b, int hd, int Q) {
    const bf16_t* proj = (const bf16_t*)(p.ws + WS_PROJ);
    bf16_t* osb = (bf16_t*)(p.ws + WS_OSB);
    const int tid = threadIdx.x, wid = __builtin_amdgcn_readfirstlane(tid >> 6), lane = tid & 63, r = lane & 31, h = lane >> 5;
    const size_t tokbase = (size_t)b * SEQ;
    const int wq0 = Q * 256 + 32 * wid;
    const int myq = wq0 + r;
    bf16x8 qf[8];
    {
        const bf16_t* qrow = proj + (tokbase + myq) * DIN + COL_QS + hd * 128;
#pragma unroll
        for (int s = 0; s < 8; ++s) qf[s] = *(const bf16x8*)(qrow + 16 * s + 8 * h);
    }
    f32x16 o[4];
#pragma unroll
    for (int db = 0; db < 4; ++db)
#pragma unroll
        for (int i = 0; i < 16; ++i) o[db][i] = 0.f;
    float R = 0.f;
    unsigned goff[2];
#pragma unroll
    for (int i = 0; i < 2; ++i) { const unsigned row = 4 * (wid * 2 + i) + (lane >> 4), cp = lane & 15, ch = cp ^ (((row & 3u) << 2) | ((row >> 2) & 3u)); goff[i] = (row * DIN + ch * 8) * 2; }
    const char* kbase = (const char*)(proj + tokbase * DIN + COL_KS + hd * 128);
    const char* vbase = (const char*)(proj + tokbase * DIN + COL_VS + hd * 128);
#define ATT_ISSUE(key0_, buf_) do { const size_t _ko = (size_t)(key0_) * DIN * 2; _Pragma("unroll") for (int _i = 0; _i < 2; ++_i) { \
        __builtin_amdgcn_global_load_lds((const unsigned*)(kbase + _ko + goff[_i]), (LAS unsigned*)(lds + (buf_) * TB + 1024 * (wid * 2 + _i)), 16, 0, 0); \
        __builtin_amdgcn_global_load_lds((const unsigned*)(vbase + _ko + goff[_i]), (LAS unsigned*)(lds + 2 * TB + (buf_) * TB + 1024 * (wid * 2 + _i)), 16, 0, 0); } } while (0)
    int j = 4 * Q + 3;
    ATT_ISSUE(64 * j, 0);
    int cur = 0;
    for (; j >= 0; --j) {
        LAS unsigned char* Kb = lds + cur * TB; LAS unsigned char* Vb = lds + 2 * TB + cur * TB;
        asm volatile("s_waitcnt vmcnt(0)" ::: "memory");
        __syncthreads();
        if (j > 0) ATT_ISSUE(64 * (j - 1), cur ^ 1);
        const int key0 = 64 * j;
        if (key0 < wq0 + 31) {
            const bool need_mask = (key0 + 63 >= wq0);
            f32x16 x0, x1;
            qk_tile(Kb, qf, x0, x1, r, h);
            f32x16 l0, l1;
#pragma unroll
            for (int i = 0; i < 16; ++i) {
                l0[i] = __builtin_amdgcn_logf(1.0f + __builtin_amdgcn_exp2f(x0[i]));
                l1[i] = __builtin_amdgcn_logf(1.0f + __builtin_amdgcn_exp2f(x1[i]));
            }
            if (need_mask) {
#pragma unroll
                for (int i = 0; i < 16; ++i) { const int kk = key0 + crow(i, h); if (kk >= myq) l0[i] = 0.f; if (kk + 32 >= myq) l1[i] = 0.f; }
            }
#pragma unroll
            for (int g = 0; g < 4; ++g) {
                l0[4 * g + 2] += l0[4 * g + 3]; l0[4 * g + 1] += l0[4 * g + 2]; l0[4 * g] += l0[4 * g + 1];
                l1[4 * g + 2] += l1[4 * g + 3]; l1[4 * g + 1] += l1[4 * g + 2]; l1[4 * g] += l1[4 * g + 1];
            }
            float Tlo[8], Thi[8];
#pragma unroll
            for (int g = 0; g < 4; ++g) {
                { const unsigned t = __float_as_uint(l0[4 * g]); auto sw = __builtin_amdgcn_permlane32_swap(t, t, false, false); Tlo[g] = __uint_as_float(sw[0]); Thi[g] = __uint_as_float(sw[1]); }
                { const unsigned t = __float_as_uint(l1[4 * g]); auto sw = __builtin_amdgcn_permlane32_swap(t, t, false, false); Tlo[4 + g] = __uint_as_float(sw[0]); Thi[4 + g] = __uint_as_float(sw[1]); }
            }
            float offR[8];
            float run = 0.f;
#pragma unroll
            for (int g = 7; g >= 0; --g) { offR[g] = run + (h == 0 ? Thi[g] : 0.f) + R; run += Tlo[g] + Thi[g]; }
            f32x16 p0, p1;
#pragma unroll
            for (int i = 0; i < 16; ++i) {
                p0[i] = __builtin_amdgcn_exp2f(x0[i] - (l0[i] + offR[i >> 2]));
                p1[i] = __builtin_amdgcn_exp2f(x1[i] - (l1[i] + offR[4 + (i >> 2)]));
            }
            if (need_mask) {
#pragma unroll
                for (int i = 0; i < 16; ++i) { const int kk = key0 + crow(i, h); if (kk >= myq) p0[i] = 0.f; if (kk + 32 >= myq) p1[i] = 0.f; }
            }
            R += run;
            pv_tile(Vb, p0, p1, o, lane);
        }
        cur ^= 1;
    }
    store_o(osb + (tokbase + myq) * 1024 + hd * 128, o, 1.0f, h);
    __syncthreads();
}

DI void dil_item(const Params& p, LAS unsigned char* lds, int di) {
    const bf16_t* proj = (const bf16_t*)(p.ws + WS_PROJ);
    bf16_t* og = (bf16_t*)(p.ws + WS_OG);
    float* lse = (float*)(p.ws + WS_LSE);
    const int b = di / 192; const int rem = di - b * 192; const int head = rem >> 4, sub = rem & 15;
    const int grp = head >> 2;
    const int dil = grp == 0 ? 1 : grp == 1 ? 4 : 16;
    const int nblk = 16 / dil;
    const int res = sub / nblk, Qb = sub - res * nblk;
    const int i0 = Qb * 256;
    const int tid = threadIdx.x, wid = __builtin_amdgcn_readfirstlane(tid >> 6), lane = tid & 63, r = lane & 31, h = lane >> 5;
    const size_t tokbase = (size_t)b * SEQ;
    const int wq0 = i0 + 32 * wid;
    const int myqi = wq0 + r;
    const size_t mytok = tokbase + (size_t)myqi * dil + res;
    bf16x8 qf[8];
    {
        const bf16_t* qrow = proj + mytok * DIN + COL_QA + head * 128;
#pragma unroll
        for (int s = 0; s < 8; ++s) qf[s] = *(const bf16x8*)(qrow + 16 * s + 8 * h);
    }
    f32x16 o[4];
#pragma unroll
    for (int db = 0; db < 4; ++db)
#pragma unroll
        for (int i = 0; i < 16; ++i) o[db][i] = 0.f;
    float mrun = -1e30f, lrun = 0.f;
    unsigned goff[2];
#pragma unroll
    for (int i = 0; i < 2; ++i) { const unsigned row = 4 * (wid * 2 + i) + (lane >> 4), cp = lane & 15, ch = cp ^ (((row & 3u) << 2) | ((row >> 2) & 3u)); goff[i] = (row * dil * DIN + ch * 8) * 2; }
    const char* kbase = (const char*)(proj + (tokbase + res) * DIN + COL_KA + head * 128);
    const char* vbase = (const char*)(proj + (tokbase + res) * DIN + COL_VA + head * 128);
    const int jt0 = (i0 == 0) ? 2 : 0;
    ATT_ISSUE((i0 - 128 + 64 * jt0) * dil, 0);
    int cur = 0;
    for (int jt = jt0; jt < 6; ++jt) {
        LAS unsigned char* Kb = lds + cur * TB; LAS unsigned char* Vb = lds + 2 * TB + cur * TB;
        asm volatile("s_waitcnt vmcnt(0)" ::: "memory");
        __syncthreads();
        if (jt < 5) ATT_ISSUE((i0 - 128 + 64 * (jt + 1)) * dil, cur ^ 1);
        const int ki0 = i0 - 128 + 64 * jt;
        if (ki0 <= wq0 + 31 && ki0 + 63 >= wq0 - 128) {
            f32x16 x0, x1;
            qk_tile(Kb, qf, x0, x1, r, h);
            const float NEG = -__builtin_inff();
#pragma unroll
            for (int i = 0; i < 16; ++i) {
                const int d0 = myqi - (ki0 + crow(i, h));
                if ((unsigned)d0 > 128u) x0[i] = NEG;
                if ((unsigned)(d0 - 32) > 128u) x1[i] = NEG;
            }
            float mx = x0[0];
#pragma unroll
            for (int i = 1; i < 16; ++i) mx = fmaxf(mx, x0[i]);
#pragma unroll
            for (int i = 0; i < 16; ++i) mx = fmaxf(mx, x1[i]);
            { const unsigned t = __float_as_uint(mx); auto sw = __builtin_amdgcn_permlane32_swap(t, t, false, false); mx = fmaxf(__uint_as_float(sw[0]), __uint_as_float(sw[1])); }
            const float mn = fmaxf(mrun, mx);
            const float alpha = __builtin_amdgcn_exp2f(mrun - mn);
            mrun = mn;
            f32x16 p0, p1; float rs = 0.f;
#pragma unroll
            for (int i = 0; i < 16; ++i) { p0[i] = __builtin_amdgcn_exp2f(x0[i] - mn); p1[i] = __builtin_amdgcn_exp2f(x1[i] - mn); rs += p0[i] + p1[i]; }
            { const unsigned t = __float_as_uint(rs); auto sw = __builtin_amdgcn_permlane32_swap(t, t, false, false); rs = __uint_as_float(sw[0]) + __uint_as_float(sw[1]); }
            lrun = lrun * alpha + rs;
#pragma unroll
            for (int db = 0; db < 4; ++db)
#pragma unroll
                for (int i = 0; i < 16; ++i) o[db][i] *= alpha;
            pv_tile(Vb, p0, p1, o, lane);
        }
        cur ^= 1;
    }
    store_o(og + mytok * 1536 + head * 128, o, 1.0f / lrun, h);
    if (h == 0) lse[mytok * 12 + head] = (mrun + __builtin_amdgcn_logf(lrun)) * LN2;
    __syncthreads();
}
#undef ATT_ISSUE
}

DI void phase_attn(const Params& p, LAS unsigned char* lds) {
    for (int it = blockIdx.x; it < 1024; it += gridDim.x) {
        if (it < 256) {
            const int xcd = it & 7, rest = it >> 3, bhi = rest >> 3, x = rest & 7, bh = xcd * 4 + bhi;
            att::sb_item(p, lds, bh >> 3, bh & 7, 15 - x);
            att::sb_item(p, lds, bh >> 3, bh & 7, x);
        } else att::dil_item(p, lds, it - 256);
    }
}

DI void phase_merge(const Params& p) {
    const int lane = threadIdx.x & 63, wid = threadIdx.x >> 6;
    const bf16_t* og = (const bf16_t*)(p.ws + WS_OG); const float* lse = (const float*)(p.ws + WS_LSE); bf16_t* odil = (bf16_t*)(p.ws + WS_ODIL);
    const int hg = lane >> 4, d0 = (lane & 15) * 8;
    for (int tok = blockIdx.x * 8 + wid; tok < NTOK; tok += gridDim.x * 8) {
        const float l0 = lse[(size_t)tok * 12 + hg], l1 = lse[(size_t)tok * 12 + 4 + hg], l2 = lse[(size_t)tok * 12 + 8 + hg];
        const float mx = fmaxf(l0, fmaxf(l1, l2));
        float w0 = __expf(l0 - mx), w1 = __expf(l1 - mx), w2 = __expf(l2 - mx);
        const float inv = 1.0f / (w0 + w1 + w2); w0 *= inv; w1 *= inv; w2 *= inv;
        const u32x4 a = *(const u32x4*)(og + (size_t)tok * 1536 + hg * 128 + d0);
        const u32x4 bq = *(const u32x4*)(og + (size_t)tok * 1536 + (4 + hg) * 128 + d0);
        const u32x4 c = *(const u32x4*)(og + (size_t)tok * 1536 + (8 + hg) * 128 + d0);
        u32x4 o;
#pragma unroll
        for (int q = 0; q < 4; ++q) {
            const float lo = w0 * bf_lo(a[q]) + w1 * bf_lo(bq[q]) + w2 * bf_lo(c[q]);
            const float hi = w0 * bf_hi(a[q]) + w1 * bf_hi(bq[q]) + w2 * bf_hi(c[q]);
            o[q] = pk_bf16(lo, hi);
        }
        *(u32x4*)(odil + (size_t)tok * 512 + hg * 128 + d0) = o;
    }
}

DI void phase_postmix(const Params& p, LAS unsigned char* lds) {
    const int tid = threadIdx.x, lane = tid & 63, wid = __builtin_amdgcn_readfirstlane(tid >> 6);
    LAS float* hsm = (LAS float*)lds;
    LAS float* part = (LAS float*)(lds + 65536);
    const float* mod = (const float*)(p.ws + WS_MOD); const float* y = (const float*)(p.ws + WS_Y);
    bf16_t* h2 = (bf16_t*)(p.ws + WS_H);
    int* cnt = (int*)(p.ws + WS_CNT); int* list = (int*)(p.ws + WS_LIST); float* w9 = (float*)(p.ws + WS_W9);
    for (int it = blockIdx.x; it < NTOK / 8; it += gridDim.x) {
        const int tok = it * 8 + wid, b = tok >> 12;
        {
            f32x4 v[8]; float ss = 0.f;
#pragma unroll
            for (int i = 0; i < 8; ++i) { v[i] = *(const f32x4*)(y + (size_t)tok * DM + 4 * (lane + 64 * i)); ss += v[i][0] * v[i][0] + v[i][1] * v[i][1] + v[i][2] * v[i][2] + v[i][3] * v[i][3]; }
            ss = wave_sum(ss);
            const float rstd = rsqrtf(ss * (1.0f / DM) + RMS_EPS);
            float ss1 = 0.f;
#pragma unroll
            for (int i = 0; i < 8; ++i) {
                const int ch = 4 * (lane + 64 * i);
                const f32x4 g = *(const f32x4*)(p.g_post_mix + ch);
                const f32x4 gt = *(const f32x4*)(mod + b * 12288 + 4096 + ch);
                const f32x4 xv = *(const f32x4*)(p.x + (size_t)tok * DM + ch);
#pragma unroll
                for (int j = 0; j < 4; ++j) { v[i][j] = xv[j] + gt[j] * (v[i][j] * rstd * g[j]); ss1 += v[i][j] * v[i][j]; }
                *(f32x4*)(p.out + (size_t)tok * DM + ch) = v[i];
            }
            ss1 = wave_sum(ss1);
            const float rstd1 = rsqrtf(ss1 * (1.0f / DM) + RMS_EPS);
#pragma unroll
            for (int i = 0; i < 8; ++i) {
                const int ch = 4 * (lane + 64 * i);
                const f32x4 g = *(const f32x4*)(p.g_pre_ffn + ch);
                const f32x4 sh = *(const f32x4*)(mod + b * 12288 + 6144 + ch);
                const f32x4 sc = *(const f32x4*)(mod + b * 12288 + 8192 + ch);
                f32x4 o;
#pragma unroll
                for (int j = 0; j < 4; ++j) o[j] = v[i][j] * rstd1 * g[j] * (1.0f + sc[j]) + sh[j];
                u32x2 w; w.x = pk_bf16(o[0], o[1]); w.y = pk_bf16(o[2], o[3]);
                *(u32x2*)(h2 + (size_t)tok * DM + ch) = w;
                *(LAS f32x4*)(hsm + wid * 2048 + ch) = o;
            }
        }
        __syncthreads();
        {
            float acc[8];
#pragma unroll
            for (int t = 0; t < 8; ++t) acc[t] = 0.f;
            const float* wrp = p.w_router + (size_t)(256 * wid) * 64 + lane;
            for (int k4 = 0; k4 < 64; ++k4) {
                const float w0 = wrp[(4 * k4 + 0) * 64], w1 = wrp[(4 * k4 + 1) * 64], w2 = wrp[(4 * k4 + 2) * 64], w3 = wrp[(4 * k4 + 3) * 64];
#pragma unroll
                for (int t = 0; t < 8; ++t) { const f32x4 hv = *(const LAS f32x4*)(hsm + t * 2048 + 256 * wid + 4 * k4); acc[t] += hv[0] * w0 + hv[1] * w1 + hv[2] * w2 + hv[3] * w3; }
            }
#pragma unroll
            for (int t = 0; t < 8; ++t) part[(wid * 8 + t) * 64 + lane] = acc[t];
        }
        __syncthreads();
        {
            float logit = 0.f;
#pragma unroll
            for (int w = 0; w < 8; ++w) logit += part[(w * 8 + wid) * 64 + lane];
            const float score = 1.0f / (1.0f + __expf(-logit));
            const float sel = score + p.router_bias[lane];
            float m1 = sel;
            m1 = fmaxf(m1, __shfl_xor(m1, 1)); m1 = fmaxf(m1, __shfl_xor(m1, 2)); m1 = fmaxf(m1, __shfl_xor(m1, 4));
            const bool is1 = (sel == m1);
            const unsigned long long bal = __ballot(is1);
            const unsigned gm = (unsigned)(bal >> (lane & ~7)) & 0xffu;
            const int first = __ffs(gm) - 1;
            float m2 = (is1 && (lane & 7) == first) ? -__builtin_inff() : sel;
            m2 = fmaxf(m2, __shfl_xor(m2, 1)); m2 = fmaxf(m2, __shfl_xor(m2, 2)); m2 = fmaxf(m2, __shfl_xor(m2, 4));
            const float gs = m1 + m2;
            const int myg = lane >> 3;
            int grank = 0;
#pragma unroll 1
            for (int g = 0; g < 8; ++g) { const float gv = __uint_as_float(__builtin_amdgcn_readlane(__float_as_uint(gs), 8 * g)); grank += (gv > gs || (gv == gs && g < myg)) ? 1 : 0; }
            const bool gsel = grank < 4;
            const float msel = gsel ? sel : -__builtin_inff();
            int rk = 0;
#pragma unroll 4
            for (int e = 0; e < 64; ++e) { const float v = __uint_as_float(__builtin_amdgcn_readlane(__float_as_uint(msel), e)); rk += (v > msel || (v == msel && e < lane)) ? 1 : 0; }
            const bool chosen = gsel && rk < 8;
            const float ssum = wave_sum(chosen ? score : 0.f);
            if (chosen) {
                const int v = tok * 9 + rk;
                const int pos = atomicAdd(&cnt[lane], 1);
                list[lane * LIST_CAP + pos] = v;
                w9[v] = score / ssum * 2.5f;
            }
        }
        __syncthreads();
    }
}

DI void phase_combine(const Params& p) {
    const int lane = threadIdx.x & 63, wid = threadIdx.x >> 6;
    const float* mod = (const float*)(p.ws + WS_MOD); const bf16_t* yb9 = (const bf16_t*)(p.ws + WS_YB9);
    for (int tok = blockIdx.x * 8 + wid; tok < NTOK; tok += gridDim.x * 8) {
        const int b = tok >> 12;
        float acc[4][8];
#pragma unroll
        for (int i = 0; i < 4; ++i)
#pragma unroll
            for (int j = 0; j < 8; ++j) acc[i][j] = 0.f;
#pragma unroll
        for (int k = 0; k < 9; ++k) {
            const bf16_t* row = yb9 + ((size_t)tok * 9 + k) * DM;
#pragma unroll
            for (int i = 0; i < 4; ++i) {
                const u32x4 w = *(const u32x4*)(row + 8 * (lane + 64 * i));
#pragma unroll
                for (int q = 0; q < 4; ++q) { acc[i][2 * q] += bf_lo(w[q]); acc[i][2 * q + 1] += bf_hi(w[q]); }
            }
        }
        float ss = 0.f;
#pragma unroll
        for (int i = 0; i < 4; ++i)
#pragma unroll
            for (int j = 0; j < 8; ++j) ss += acc[i][j] * acc[i][j];
        ss = wave_sum(ss);
        const float rstd = rsqrtf(ss * (1.0f / DM) + RMS_EPS);
#pragma unroll
        for (int i = 0; i < 4; ++i) {
            const int ch = 8 * (lane + 64 * i);
#pragma unroll
            for (int hh = 0; hh < 2; ++hh) {
                const f32x4 g = *(const f32x4*)(p.g_post_ffn + ch + 4 * hh);
                const f32x4 gt = *(const f32x4*)(mod + b * 12288 + 10240 + ch + 4 * hh);
                f32x4 xv = *(const f32x4*)(p.out + (size_t)tok * DM + ch + 4 * hh);
#pragma unroll
                for (int j = 0; j < 4; ++j) xv[j] += gt[j] * (acc[i][4 * hh + j] * rstd * g[j]);
                *(f32x4*)(p.out + (size_t)tok * DM + ch + 4 * hh) = xv;
            }
        }
    }
}

constexpr int NPHASE = 11;
template <int PH> DI void run_phase(const Params& p, LAS unsigned char* lds) {
    if constexpr (PH == 0) phase_prologue(p, lds);
    else if constexpr (PH == 1) phase_prenorm(p);
    else if constexpr (PH == 2) phase_inproj(p, lds);
    else if constexpr (PH == 3) phase_attn(p, lds);
    else if constexpr (PH == 4) phase_merge(p);
    else if constexpr (PH == 5) phase_outproj(p, lds);
    else if constexpr (PH == 6) phase_mixout(p, lds);
    else if constexpr (PH == 7) phase_postmix(p, lds);
    else if constexpr (PH == 8) phase_gateup(p, lds);
    else if constexpr (PH == 9) phase_down(p, lds);
    else phase_combine(p);
}
template <int PH> __global__ __launch_bounds__(512, 2) void k_phase(Params p) {
    extern __shared__ __attribute__((aligned(16))) unsigned char shm[];
    run_phase<PH>(p, (LAS unsigned char*)shm);
}
#if MK_FUSED
typedef const __attribute__((address_space(4))) Params* KargPtr;
template <int PH> DI void mega_phase(KargPtr kp0, LAS unsigned char* lds) {
    KargPtr kp = kp0; asm volatile("" : "+s"(kp));
    Params p{};
#if defined(__HIP_DEVICE_COMPILE__)
    p.x = kp->x; p.c = kp->c; p.pos = kp->pos; p.w_ada = kp->w_ada; p.b_ada = kp->b_ada; p.g_pre_mix = kp->g_pre_mix; p.g_post_mix = kp->g_post_mix; p.g_pre_ffn = kp->g_pre_ffn; p.g_post_ffn = kp->g_post_ffn; p.w_in = kp->w_in; p.w_dil_out = kp->w_dil_out; p.w_sb_out = kp->w_sb_out; p.w_mix_out = kp->w_mix_out; p.w_router = kp->w_router; p.router_bias = kp->router_bias; p.w_gate_e = kp->w_gate_e; p.w_up_e = kp->w_up_e; p.w_down_e = kp->w_down_e; p.w_gate_s = kp->w_gate_s; p.w_up_s = kp->w_up_s; p.w_down_s = kp->w_down_s; p.out = kp->out; p.ws = kp->ws;
#endif
    run_phase<PH>(p, lds);
}
__global__ __launch_bounds__(512, 2) void k_mega(Params p_unused) {
    extern __shared__ __attribute__((aligned(16))) unsigned char shm[];
    LAS unsigned char* lds = (LAS unsigned char*)shm;
    KargPtr kp0 = (KargPtr)__builtin_amdgcn_kernarg_segment_ptr();
    volatile LAS unsigned* xbw = (volatile LAS unsigned*)(lds + LDS_BYTES - 16);
    if (threadIdx.x == 0) { xbw[0] = 0u; xbw[1] = 0u; xbw[2] = 0u; xbw[3] = 0u; }
    __syncthreads();
    XcdBarrier bar;
    { KargPtr kp = kp0; asm volatile("" : "+s"(kp)); bar = xcd_barrier_post((unsigned*)(kp->ws + WS_BAR), xbw); }
    mega_phase<0>(kp0, lds); xcd_barrier(bar);
    mega_phase<1>(kp0, lds); xcd_barrier(bar);
    mega_phase<2>(kp0, lds); xcd_barrier(bar);
    mega_phase<3>(kp0, lds); xcd_barrier(bar);
    mega_phase<4>(kp0, lds); xcd_barrier(bar);
    mega_phase<5>(kp0, lds); xcd_barrier(bar);
    mega_phase<6>(kp0, lds); xcd_barrier(bar);
    mega_phase<7>(kp0, lds); xcd_barrier(bar);
    mega_phase<8>(kp0, lds); xcd_barrier(bar);
    mega_phase<9>(kp0, lds); xcd_barrier(bar);
    mega_phase<10>(kp0, lds);
}
#endif

template <int PH> static void launch_phase(const Params& p, int grid, hipStream_t stream) {
    static bool init = false;
    if (!init) { (void)hipFuncSetAttribute((const void*)k_phase<PH>, hipFuncAttributeMaxDynamicSharedMemorySize, LDS_BYTES); init = true; }
    hipLaunchKernelGGL(k_phase<PH>, dim3(grid), dim3(512), LDS_BYTES, stream, p);
}

extern "C" void kernel_launch(void* const* d_in, const int* in_sizes, int n_in, void* d_out, int out_size, void* d_ws, size_t ws_size, hipStream_t stream) {
    (void)in_sizes; (void)n_in; (void)out_size;
    static int grid = 0;
    if (!grid) {
        int dev = 0, cus = 0; (void)hipGetDevice(&dev); (void)hipDeviceGetAttribute(&cus, hipDeviceAttributeMultiprocessorCount, dev);
        if (cus <= 0) cus = 256;
#if MK_FUSED
        (void)hipFuncSetAttribute((const void*)k_mega, hipFuncAttributeMaxDynamicSharedMemorySize, LDS_BYTES);
        int per_cu = 0;
        if (hipOccupancyMaxActiveBlocksPerMultiprocessor(&per_cu, (const void*)k_mega, 512, LDS_BYTES) != hipSuccess || per_cu < 1)
            fprintf(stderr, "kernel_launch: occupancy query reports %d workgroups per CU\n", per_cu);
#endif
        grid = cus;
        if (ws_size < WS_TOTAL) fprintf(stderr, "kernel_launch: workspace too small: %zu < %zu\n", ws_size, (size_t)WS_TOTAL);
    }
    Params p{};
    p.x = (const float*)d_in[0]; p.c = (const float*)d_in[1]; p.pos = (const int*)d_in[2];
    p.w_ada = (const float*)d_in[3]; p.b_ada = (const float*)d_in[4];
    p.g_pre_mix = (const float*)d_in[5]; p.g_post_mix = (const float*)d_in[6]; p.g_pre_ffn = (const float*)d_in[7]; p.g_post_ffn = (const float*)d_in[8];
    p.w_in = (const float*)d_in[9]; p.w_dil_out = (const float*)d_in[10]; p.w_sb_out = (const float*)d_in[11]; p.w_mix_out = (const float*)d_in[12];
    p.w_router = (const float*)d_in[13]; p.router_bias = (const float*)d_in[14];
    p.w_gate_e = (const float*)d_in[15]; p.w_up_e = (const float*)d_in[16]; p.w_down_e = (const float*)d_in[17];
    p.w_gate_s = (const float*)d_in[18]; p.w_up_s = (const float*)d_in[19]; p.w_down_s = (const float*)d_in[20];
    p.out = (float*)d_out; p.ws = (unsigned char*)d_ws;
    (void)hipMemsetAsync((unsigned char*)d_ws + WS_BAR, 0, WS_ZERO_BYTES, stream);
#if MK_FUSED
    hipLaunchKernelGGL(k_mega, dim3(grid), dim3(512), LDS_BYTES, stream, p);
#else
    launch_phase<0>(p, grid, stream); launch_phase<1>(p, grid, stream); launch_phase<2>(p, grid, stream); launch_phase<3>(p, grid, stream);
    launch_phase<4>(p, grid, stream); launch_phase<5>(p, grid, stream); launch_phase<6>(p, grid, stream); launch_phase<7>(p, grid, stream);
    launch_phase<8>(p, grid, stream); launch_phase<9>(p, grid, stream); launch_phase<10>(p, grid, stream);
#endif
}
```

```cpp
#include <hip/hip_runtime.h>
#include <stdint.h>
#include <stdio.h>

#ifndef MK_FUSED
#define MK_FUSED 1
#endif
#ifndef MK_STAMP
#define MK_STAMP -1
#endif
#ifndef MK_REP
#define MK_REP -1
#endif

#define LAS __attribute__((address_space(3)))
#define DI __device__ __forceinline__
typedef unsigned short bf16_t;
typedef short bf16x8 __attribute__((ext_vector_type(8)));
typedef short s16x4 __attribute__((ext_vector_type(4)));
typedef float f32x2 __attribute__((ext_vector_type(2)));
typedef float f32x4 __attribute__((ext_vector_type(4)));
typedef float f32x16 __attribute__((ext_vector_type(16)));
typedef unsigned u32x2 __attribute__((ext_vector_type(2)));
typedef unsigned u32x4 __attribute__((ext_vector_type(4)));
typedef __bf16 bf16x2_t __attribute__((ext_vector_type(2)));
typedef const __attribute__((address_space(1))) char* gcptr;
typedef const __attribute__((address_space(1))) u32x4* gu4ptr;

constexpr int NBATCH = 4, SEQ = 4096, NTOK = NBATCH * SEQ, DM = 2048, DIN = 11776;
constexpr int COL_QA = 0, COL_KA = 1536, COL_VA = 3072, COL_QS = 4608, COL_KS = 5632, COL_VS = 6656, COL_GD = 7680, COL_GS = 9728;
constexpr int NE = 64, DE = 512, NEX = 65;
constexpr int LIST_CAP = 16384;
constexpr int YB_SLOTS = 163840;
constexpr float RMS_EPS = 1e-6f;
constexpr float QSCALE = 0.08838834764831845f * 1.4426950408889634f;
constexpr float LN2 = 0.6931471805599453f;

constexpr size_t MiB = 1ull << 20;
constexpr size_t WS_BAR = 0;
constexpr size_t WS_CNT = 16384;
constexpr size_t WS_ZERO_BYTES = 32768;
constexpr size_t WS_STAMP = 32768;

constexpr size_t WS_MOD = 65536;
constexpr size_t WS_LSE = 262144;
constexpr size_t WS_ROPE = 1 * MiB;
constexpr size_t WS_LIST = 3 * MiB;
constexpr size_t WS_LISTW = 7 * MiB;
constexpr size_t WS_SLOT = 262144;
constexpr size_t WS_WD = 11 * MiB;
constexpr size_t WS_H = 141 * MiB;
constexpr size_t WS_HID = 205 * MiB;
constexpr size_t WS_WTIN = 205 * MiB;
constexpr size_t WS_TMP = 205 * MiB;
constexpr size_t WS_OG = 251 * MiB;
constexpr size_t WS_OSB = 299 * MiB;
constexpr size_t WS_ODIL = 331 * MiB;
constexpr size_t WS_WTDIL = 347 * MiB;
constexpr size_t WS_WTSB = 349 * MiB;
constexpr size_t WS_WTMIX = 353 * MiB;
constexpr size_t WS_PROJ = 365 * MiB;
constexpr size_t WS_Y = 365 * MiB;
constexpr size_t WS_YB9 = 365 * MiB;
constexpr size_t WS_WGU = 733 * MiB;
constexpr size_t WS_WRT = 1005 * MiB;
constexpr size_t WS_TOTAL = 1006 * MiB;

constexpr int LDS_BYTES = 163840;

struct Params {
    const float *x, *c; const int* pos;
    const float *w_ada, *b_ada, *g_pre_mix, *g_post_mix, *g_pre_ffn, *g_post_ffn;
    const float *w_in, *w_dil_out, *w_sb_out, *w_mix_out, *w_router, *router_bias;
    const float *w_gate_e, *w_up_e, *w_down_e, *w_gate_s, *w_up_s, *w_down_s;
    float* out; unsigned char* ws;
};

DI unsigned pk_bf16(float lo, float hi) { f32x2 v = {lo, hi}; bf16x2_t r = __builtin_convertvector(v, bf16x2_t); return __builtin_bit_cast(unsigned, r); }
DI float bf_lo(unsigned u) { return __uint_as_float(u << 16); }
DI float bf_hi(unsigned u) { return __uint_as_float(u & 0xffff0000u); }
DI float wave_sum(float v) {
#pragma unroll
    for (int o = 32; o >= 1; o >>= 1) v += __shfl_xor(v, o);
    return v;
}
DI float sigmoidf_(float x) { return 1.0f / (1.0f + __expf(-x)); }

#define XB_TMO      128
#define XB_XCNT(j)  (256  + 64 * (j))
#define XB_XSUB(j)  (1280 + 64 * (j))
#define XB_XGEN(j)  (2304 + 64 * (j))
#define XB_TOP      3328
#define XB_TOPGEN   3392
#define XCD_BAR_WORDS 3456
#define XB_SPIN_CAP (1u << 18)

__device__ __forceinline__ unsigned xb_ld(unsigned* p)              { return __hip_atomic_load(p, __ATOMIC_RELAXED, __HIP_MEMORY_SCOPE_AGENT); }
__device__ __forceinline__ unsigned xb_add(unsigned* p, unsigned v) { return __hip_atomic_fetch_add(p, v, __ATOMIC_RELAXED, __HIP_MEMORY_SCOPE_AGENT); }
__device__ __forceinline__ unsigned xb_xcc_id() { return (unsigned)__builtin_amdgcn_s_getreg((3 << 11) | 20) & 0xFu; }
#define XB_SPIN(cond, bar) do { unsigned _sp = 0; while (cond) { __builtin_amdgcn_s_sleep(1); \
    if ((++_sp & 255u) == 0u) { if (xb_ld(&(bar)[XB_TMO])) break; if (_sp > XB_SPIN_CAP) { atomicAdd(&(bar)[XB_TMO], 1u); break; } } } } while (0)

struct XcdBarrier { unsigned* bar; unsigned x; volatile LAS unsigned* st; };

__device__ __forceinline__ XcdBarrier xcd_barrier_post(unsigned* bar, volatile LAS unsigned* st) {
    XcdBarrier b; b.bar = bar; b.x = xb_xcc_id(); b.st = st;
    if (threadIdx.x == 0) (void)xb_add(&bar[XB_XCNT(b.x)], 1u);
    return b;
}
__device__ __forceinline__ void xcd_barrier_complete(unsigned* bar, unsigned x, unsigned& nloc, unsigned& nx) {
    const unsigned G = gridDim.x * gridDim.y * gridDim.z;
    unsigned sum, cnt, mine, sp = 0u;
    for (;;) {
        sum = 0u; cnt = 0u; mine = 0u;
#pragma unroll
        for (unsigned j = 0; j < 16; ++j) { const unsigned c = xb_ld(&bar[XB_XCNT(j)]); sum += c; cnt += (c > 0u) ? 1u : 0u; mine = (j == x) ? c : mine; }
        if (sum == G) break;
        __builtin_amdgcn_s_sleep(1);
        if ((++sp & 255u) == 0u) { if (xb_ld(&bar[XB_TMO])) break; if (sp > XB_SPIN_CAP) { atomicAdd(&bar[XB_TMO], 1u); break; } }
    }
    nloc = mine > 0u ? mine : 1u; nx = cnt > 0u ? cnt : 1u;
}
__device__ __forceinline__ void xcd_barrier(const XcdBarrier& b) {
    asm volatile("s_waitcnt vmcnt(0)" ::: "memory");
    __syncthreads();
    if (threadIdx.x == 0) {
        unsigned* bar = b.bar;
        __builtin_amdgcn_s_waitcnt(0);
        unsigned nloc = b.st[0], nx = b.st[1];
        if (nloc == 0u) { xcd_barrier_complete(bar, b.x, nloc, nx); b.st[0] = nloc; b.st[1] = nx; }
        const unsigned old = xb_add(&bar[XB_XSUB(b.x)], 1u);
        const unsigned gen = old / nloc;
        if (old + 1u == (gen + 1u) * nloc) {
            __builtin_amdgcn_fence(__ATOMIC_RELEASE, "agent");
            asm volatile("s_waitcnt vmcnt(0)" ::: "memory");
            const unsigned og = xb_add(&bar[XB_TOP], 1u);
            const unsigned tg = og / nx;
            if (og + 1u == (tg + 1u) * nx) xb_add(&bar[XB_TOPGEN], 1u);
            else XB_SPIN(xb_ld(&bar[XB_TOPGEN]) == tg, bar);
            __builtin_amdgcn_fence(__ATOMIC_ACQUIRE, "agent");
            xb_add(&bar[XB_XGEN(b.x)], 1u);
            asm volatile("s_waitcnt vmcnt(0)" ::: "memory");
        } else {
            XB_SPIN(xb_ld(&bar[XB_XGEN(b.x)]) == gen, bar);
            __builtin_amdgcn_fence(__ATOMIC_ACQUIRE, "agent");
            asm volatile("s_waitcnt vmcnt(0)" ::: "memory");
        }
    }
    __syncthreads();
}

struct CvtMat { const float* src; bf16_t* dst; int K, N, nb, mode; size_t sstride, dstride; };
constexpr int CVT_NMAT = 10;
constexpr int CVT_TILES[CVT_NMAT] = {2944, 128, 256, 512, 8192, 8192, 8192, 128, 128, 128};
constexpr int CVT_TOTAL = 2944 + 128 + 256 + 512 + 8192 * 3 + 128 * 3;
constexpr int P0_MOD_UNITS = 192, P0_ROPE_UNITS = 64, P0_WR_UNITS = 8, P0_ITEMS = P0_MOD_UNITS + P0_ROPE_UNITS + P0_WR_UNITS + CVT_TOTAL;

DI CvtMat cvt_mat(const Params& p, int m) {
    bf16_t* wtin = (bf16_t*)(p.ws + WS_WTIN); bf16_t* wtdil = (bf16_t*)(p.ws + WS_WTDIL); bf16_t* wtsb = (bf16_t*)(p.ws + WS_WTSB); bf16_t* wtmix = (bf16_t*)(p.ws + WS_WTMIX);
    bf16_t* wgu = (bf16_t*)(p.ws + WS_WGU); bf16_t* wd = (bf16_t*)(p.ws + WS_WD);
    CvtMat r;
    switch (m) {
        case 0: r = {p.w_in, wtin, 2048, 11776, 1, 0, 0, 0}; break;
        case 1: r = {p.w_dil_out, wtdil, 512, 2048, 1, 0, 0, 0}; break;
        case 2: r = {p.w_sb_out, wtsb, 1024, 2048, 1, 0, 0, 0}; break;
        case 3: r = {p.w_mix_out, wtmix, 2048, 2048, 1, 0, 0, 0}; break;
        case 4: r = {p.w_gate_e, wgu, 2048, 512, 64, 1, (size_t)2048 * 512, (size_t)1024 * 2048}; break;
        case 5: r = {p.w_up_e, wgu, 2048, 512, 64, 2, (size_t)2048 * 512, (size_t)1024 * 2048}; break;
        case 6: r = {p.w_down_e, wd, 512, 2048, 64, 0, (size_t)512 * 2048, (size_t)2048 * 512}; break;
        case 7: r = {p.w_gate_s, wgu + (size_t)64 * 1024 * 2048, 2048, 512, 1, 1, 0, 0}; break;
        case 8: r = {p.w_up_s, wgu + (size_t)64 * 1024 * 2048, 2048, 512, 1, 2, 0, 0}; break;
        default: r = {p.w_down_s, wd + (size_t)64 * 2048 * 512, 512, 2048, 1, 0, 0, 0}; break;
    }
    return r;
}

DI void cvt_tile(const Params& p, int t, LAS unsigned char* lds) {
    int m = 0;
#pragma unroll
    for (int i = 0; i < CVT_NMAT - 1; ++i) { if (t >= CVT_TILES[i] && m == i) { t -= CVT_TILES[i]; m = i + 1; } }
    const CvtMat M = cvt_mat(p, m);
    const int tn = M.N / 64, tk = M.K / 128;
    const int b = t / (tn * tk); const int rem = t - b * (tn * tk); const int kt = rem / tn, nt = rem - kt * tn;
    const float* src = M.src + (size_t)b * M.sstride + (size_t)(kt * 128) * M.N + nt * 64;
    bf16_t* dst = M.dst + (size_t)b * M.dstride;
    const int tid = threadIdx.x;
    constexpr int P = 272;
    {
        const int kq = tid >> 4, n4 = (tid & 15) * 4;
        f32x4 v[4];
#pragma unroll
        for (int i = 0; i < 4; ++i) v[i] = __builtin_nontemporal_load((const f32x4*)(src + (size_t)(kq + 32 * i) * M.N + n4));
#pragma unroll
        for (int i = 0; i < 4; ++i) {
            const int k = kq + 32 * i;
#pragma unroll
            for (int j = 0; j < 4; ++j) { const unsigned u = pk_bf16(v[i][j], 0.f); *(LAS bf16_t*)(lds + (n4 + j) * P + k * 2) = (bf16_t)(u & 0xffffu); }
        }
    }
    __syncthreads();
    {
        const int n = tid >> 3;
        const int c = nt * 64 + n;
        const int drow = M.mode == 0 ? c : (((c >> 7) << 8) + (c & 127) + (M.mode == 2 ? 128 : 0));
#pragma unroll
        for (int i = 0; i < 2; ++i) {
            const int ch = (tid & 7) + 8 * i;
            const u32x4 w = *(const LAS u32x4*)(lds + n * P + ch * 16);
            *(u32x4*)(dst + (size_t)drow * M.K + kt * 128 + ch * 8) = w;
        }
    }
    __syncthreads();
}

DI void mod_unit(const Params& p, int u, LAS unsigned char* lds) {
    const int tid = threadIdx.x, c0 = u * 64;
    LAS float* sc = (LAS float*)lds;
    LAS float* red = (LAS float*)(lds + 32768);
    for (int i = tid; i < 4 * 2048; i += 512) { const float v = p.c[i]; sc[i] = v / (1.0f + __expf(-v)); }
    __syncthreads();
    const int kq = tid >> 4, cq = tid & 15;
    float acc[4][4];
#pragma unroll
    for (int b = 0; b < 4; ++b)
#pragma unroll
        for (int j = 0; j < 4; ++j) acc[b][j] = 0.f;
    for (int it = 0; it < 64; ++it) {
        const int k = kq + 32 * it;
        const f32x4 w = __builtin_nontemporal_load((const f32x4*)(p.w_ada + (size_t)k * 12288 + c0 + 4 * cq));
#pragma unroll
        for (int b = 0; b < 4; ++b) { const float s = sc[b * 2048 + k];
#pragma unroll
            for (int j = 0; j < 4; ++j) acc[b][j] += s * w[j]; }
    }
#pragma unroll
    for (int b = 0; b < 4; ++b)
#pragma unroll
        for (int j = 0; j < 4; ++j) red[(kq * 4 + b) * 64 + 4 * cq + j] = acc[b][j];
    __syncthreads();
    if (tid < 256) {
        const int b = tid >> 6, col = tid & 63;
        float s = 0.f;
        for (int q = 0; q < 32; ++q) s += red[(q * 4 + b) * 64 + col];
        float* mod = (float*)(p.ws + WS_MOD);
        mod[b * 12288 + c0 + col] = s + p.b_ada[c0 + col];
    }
    __syncthreads();
}

DI void rope_unit(const Params& p, int u) {
    float2* rope = (float2*)(p.ws + WS_ROPE);
    for (int e = threadIdx.x; e < 4096; e += 512) {
        const int tok = u * 256 + (e >> 4), i = e & 15;
        const float invf = (float)pow(500000.0, -(double)i / 16.0);
        const float ang = (float)p.pos[tok] * invf;
        rope[tok * 16 + i] = make_float2((float)cos((double)ang), (float)sin((double)ang));
    }
}

DI void wr_unit(const Params& p, int u) {
    bf16_t* hi = (bf16_t*)(p.ws + WS_WRT); bf16_t* lo = hi + 64 * 2048;
    for (int i = threadIdx.x; i < 16384; i += 512) {
        const int idx = u * 16384 + i, k = idx >> 6, e = idx & 63;
        const float x = p.w_router[idx];
        const unsigned h = pk_bf16(x, 0.f) & 0xffffu;
        const float r = x - __uint_as_float(h << 16);
        hi[e * 2048 + k] = (bf16_t)h; lo[e * 2048 + k] = (bf16_t)(pk_bf16(r, 0.f) & 0xffffu);
    }
}
DI void phase_prologue(const Params& p, LAS unsigned char* lds) {
    for (int it = blockIdx.x; it < P0_ITEMS; it += gridDim.x) {
        if (it < P0_MOD_UNITS) mod_unit(p, it, lds);
        else if (it < P0_MOD_UNITS + P0_ROPE_UNITS) rope_unit(p, it - P0_MOD_UNITS);
        else if (it < P0_MOD_UNITS + P0_ROPE_UNITS + P0_WR_UNITS) wr_unit(p, it - P0_MOD_UNITS - P0_ROPE_UNITS);
        else cvt_tile(p, it - P0_MOD_UNITS - P0_ROPE_UNITS - P0_WR_UNITS, lds);
    }
}

DI void phase_prenorm(const Params& p) {
    const int lane = threadIdx.x & 63, wid = threadIdx.x >> 6;
    const float* mod = (const float*)(p.ws + WS_MOD);
    bf16_t* h = (bf16_t*)(p.ws + WS_H);
    for (int tok = blockIdx.x * 8 + wid; tok < NTOK; tok += gridDim.x * 8) {
        const int b = tok >> 12;
        const float* xr = p.x + (size_t)tok * DM;
        f32x4 v[8]; float ss = 0.f;
#pragma unroll
        for (int i = 0; i < 8; ++i) { v[i] = *(const f32x4*)(xr + 4 * (lane + 64 * i)); ss += v[i][0] * v[i][0] + v[i][1] * v[i][1] + v[i][2] * v[i][2] + v[i][3] * v[i][3]; }
        ss = wave_sum(ss);
        const float rstd = rsqrtf(ss * (1.0f / DM) + RMS_EPS);
#pragma unroll
        for (int i = 0; i < 8; ++i) {
            const int ch = 4 * (lane + 64 * i);
            const f32x4 g = *(const f32x4*)(p.g_pre_mix + ch);
            const f32x4 sh = *(const f32x4*)(mod + b * 12288 + ch);
            const f32x4 sc = *(const f32x4*)(mod + b * 12288 + 2048 + ch);
            f32x4 o;
#pragma unroll
            for (int j = 0; j < 4; ++j) o[j] = v[i][j] * rstd * g[j] * (1.0f + sc[j]) + sh[j];
            u32x2 w; w.x = pk_bf16(o[0], o[1]); w.y = pk_bf16(o[2], o[3]);
            *(u32x2*)(h + (size_t)tok * DM + ch) = w;
        }
    }
}

namespace g8 {
constexpr int BM = 256, BK = 64, HALF = 128, HTB = HALF * BK * 2, STAGE_BYTES = 8 * HTB, NXCD = 8, WGM = 8;
DI int lds_byte(int r, int c) { const int st = (r >> 4) * 2 + (c >> 5), rr = r & 15, cc = c & 31, ob = rr * 64 + cc * 2; return st * 1024 + (ob ^ (((ob >> 9) & 1) << 5)); }
DI void stage_rc(int b, int& R, int& C) { const int st = b / 1024, sb = b % 1024, swz = sb ^ (((sb >> 9) & 1) << 5); R = (st >> 1) * 16 + swz / 64; C = (st & 1) * 32 + (swz % 64) / 2; }
DI int perm32(int rho) { const int n = rho >> 4, i = rho & 15; return 8 * (i >> 2) + 4 * n + (i & 3); }

struct Unit {
    const char* A; const char* B;
    int row0;
    int lda, ldb, nt;
    int pm, pn, aux, keep;
    int e, nvalid, par;
};

DI bool static_tile(int L, int nM, int nN, int& pm, int& pn) {
    const int nwg = nM * nN; if (L >= nwg) return false;
    int wgid = L; { const int q = nwg / NXCD, r = nwg % NXCD, xcd = wgid % NXCD, off = wgid / NXCD; wgid = (xcd < r ? xcd * (q + 1) : r * (q + 1) + (xcd - r) * q) + off; }
    const int nig = WGM * nN, gid = wgid / nig, fm = gid * WGM, gsz = (nM - fm) < WGM ? (nM - fm) : WGM;
    pm = fm + ((wgid % nig) % gsz); pn = (wgid % nig) / gsz; return true;
}

constexpr int EXCH_OFF = STAGE_BYTES + 8192;
DI void epi_bar() { asm volatile("s_waitcnt lgkmcnt(0)" ::: "memory"); __builtin_amdgcn_s_barrier(); asm volatile("" ::: "memory"); }

template <int NCH, class Sched, class Epi>
DI void gemm_phase(LAS unsigned char* lds, const Sched& S, const Epi& E) {
    const int tid = threadIdx.x, wid = __builtin_amdgcn_readfirstlane(tid >> 6), lane = tid & 63, wr = wid >> 2, wc = wid & 3, fr = lane & 15, fq = lane >> 4;
    const bool loader = (wr == 0);
    int R0, C0; stage_rc(wc * 1024 + lane * 16, R0, C0);
    const int sC = C0 * 2, sRb = perm32(R0);
    const int aoff = lds_byte(wr * 64 + fr, fq * 8), boff = lds_byte(wc * 32 + fr, fq * 8);
#define G8_SA(b, h) (((b) * 2 + (h)) * HTB)
#define G8_SB(b, h) ((4 + (b) * 2 + (h)) * HTB)
#define G8_STAGE_A(bufoff, gbase, voff) do { if (loader) { _Pragma("unroll") for (int _i = 0; _i < 4; ++_i) \
        __builtin_amdgcn_global_load_lds((const unsigned*)((const char*)(gbase) + (voff)[_i]), (LAS unsigned*)(lds + (bufoff) + (wc + 4 * _i) * 1024), 16, 0, 0); } } while (0)
#define G8_STAGE_B(bufoff, gbase, voff, ldb32) do { if (loader) { _Pragma("unroll") for (int _i = 0; _i < 4; ++_i) { \
        const char* _gb = (const char*)(gbase) + (size_t)_i * (ldb32); asm volatile("" : "+s"(_gb));     \
        __builtin_amdgcn_global_load_lds((const unsigned*)(_gb + (voff)), (LAS unsigned*)(lds + (bufoff) + (wc + 4 * _i) * 1024), 16, 0, 0); } } } while (0)
#define G8_LDA(dst, b, h) do { _Pragma("unroll") for (int m = 0; m < 4; ++m) _Pragma("unroll") for (int k = 0; k < 2; ++k) dst[m][k] = *(const LAS bf16x8*)(lds + G8_SA(b, h) + aoff + m * 2048 + k * 1024); } while (0)
#define G8_LDB(dst, b, h) do { _Pragma("unroll") for (int n = 0; n < 2; ++n) _Pragma("unroll") for (int k = 0; k < 2; ++k) dst[n][k] = *(const LAS bf16x8*)(lds + G8_SB(b, h) + boff + n * 2048 + k * 1024); } while (0)
#define G8_MMA(ai, bj, At, Bt) do { __builtin_amdgcn_s_setprio(1); _Pragma("unroll") for (int m = 0; m < 4; ++m) _Pragma("unroll") for (int n = 0; n < 2; ++n) _Pragma("unroll") for (int k = 0; k < 2; ++k) \
        acc[ai][bj][m][n] = __builtin_amdgcn_mfma_f32_16x16x32_bf16(Bt[n][k], At[m][k], acc[ai][bj][m][n], 0, 0, 0); __builtin_amdgcn_s_setprio(0); } while (0)
#define G8_WAIT_V8 do { if (loader) asm volatile("s_waitcnt vmcnt(8)" ::: "memory"); } while (0)
#define G8_WAIT_V12 do { if (loader) asm volatile("s_waitcnt vmcnt(12)" ::: "memory"); } while (0)
#define G8_WAIT_V0 do { if (loader) asm volatile("s_waitcnt vmcnt(0)" ::: "memory"); } while (0)
#define G8_WAIT_L(n) asm volatile("s_waitcnt lgkmcnt(" #n ")" ::: "memory")
#define G8_BAR __builtin_amdgcn_s_barrier()
#define G8_SCHED __builtin_amdgcn_sched_barrier(0)
#define G8_OFFS(u, vA, vB) do { if (loader) { _Pragma("unroll") for (int _h = 0; _h < 2; ++_h) _Pragma("unroll") for (int _i = 0; _i < 4; ++_i) \
        vA[_h][_i] = (unsigned)S.arow(u, _h * 128 + R0 + 32 * _i) * (unsigned)(u).lda + (unsigned)sC; \
        vB = (unsigned)sRb * (unsigned)(u).ldb + (unsigned)sC; } } while (0)
    Unit cur, nxt; int ui = 0;
    if (!S.next(0, cur)) return;
    f32x4 acc[2][2][4][2];
#pragma unroll
    for (int a = 0; a < 2; ++a)
#pragma unroll
        for (int b = 0; b < 2; ++b)
#pragma unroll
            for (int m = 0; m < 4; ++m)
#pragma unroll
                for (int n = 0; n < 2; ++n) acc[a][b][m][n] = (f32x4){0.f, 0.f, 0.f, 0.f};
    bf16x8 At[4][2], B0[2][2], B1[2][2];
    unsigned vA[2][4] = {{0u, 0u, 0u, 0u}, {0u, 0u, 0u, 0u}}, vB = 0u;
    if (S.prefetch(cur, wid, lane)) { G8_WAIT_V0; G8_BAR; }
    G8_OFFS(cur, vA, vB);
    const char* cA = cur.A; const char* cB = cur.B; size_t hB = (size_t)128 * cur.ldb; size_t q32 = (size_t)32 * cur.ldb;
    constexpr size_t kstep = 128;
    G8_STAGE_B(G8_SB(0, 0), cB, vB, q32); G8_STAGE_A(G8_SA(0, 0), cA, vA[0]); G8_STAGE_B(G8_SB(0, 1), cB + hB, vB, q32); G8_STAGE_A(G8_SA(0, 1), cA, vA[1]);
    if (wr == 1) G8_BAR;
    G8_WAIT_V8; G8_BAR;
    G8_STAGE_B(G8_SB(1, 0), cB + kstep, vB, q32); G8_STAGE_A(G8_SA(1, 0), cA + kstep, vA[0]); G8_STAGE_B(G8_SB(1, 1), cB + hB + kstep, vB, q32);
    G8_WAIT_V12; G8_BAR;
    for (;;) {
        bool has_next = false;
        const char* nA = cA; const char* nB = cB; size_t nhB = hB, nq32 = q32;
        const int nt = cur.nt;
#pragma unroll 1
        for (int t = 0; t < nt; t += 2) {
            const bool last = (t == nt - 2);
            const char* a1 = cA + (size_t)(t + 1) * kstep;
            G8_LDB(B0, 0, 0); G8_SCHED; G8_LDA(At, 0, 0); G8_STAGE_A(G8_SA(1, 1), a1, vA[1]);
            G8_WAIT_L(8); G8_BAR; G8_WAIT_L(0); G8_MMA(0, 0, At, B0); G8_BAR; G8_SCHED;
            if (t == 0) { Unit pf; if (S.next(ui + 1, pf)) (void)S.prefetch(pf, wid, lane); }
            const char* a2; const char* b2; size_t h2, q2;
            if (last) {
                has_next = S.next(ui + 1, nxt);
                if (has_next) { G8_OFFS(nxt, vA, vB); nA = nxt.A; nB = nxt.B; nhB = (size_t)128 * nxt.ldb; nq32 = (size_t)32 * nxt.ldb; }
                a2 = nA; b2 = nB; h2 = nhB; q2 = nq32;
            } else { a2 = cA + (size_t)(t + 2) * kstep; b2 = cB + (size_t)(t + 2) * kstep; h2 = hB; q2 = q32; }
            const char* a3 = a2 + kstep; const char* b3 = b2 + kstep;
            G8_LDB(B1, 0, 1); G8_STAGE_B(G8_SB(0, 0), b2, vB, q2);
            G8_BAR; G8_WAIT_L(0); G8_MMA(0, 1, At, B1); G8_BAR;
            G8_LDA(At, 0, 1); G8_STAGE_A(G8_SA(0, 0), a2, vA[0]);
            G8_BAR; G8_WAIT_L(0); G8_MMA(1, 0, At, B0); G8_BAR; G8_SCHED;
            G8_STAGE_B(G8_SB(0, 1), b2 + h2, vB, q2);
            G8_WAIT_V12; G8_BAR; G8_MMA(1, 1, At, B1); G8_BAR;
            G8_LDB(B0, 1, 0); G8_SCHED; G8_LDA(At, 1, 0); G8_STAGE_A(G8_SA(0, 1), a2, vA[1]);
            G8_WAIT_L(8); G8_BAR; G8_WAIT_L(0); G8_MMA(0, 0, At, B0); G8_BAR; G8_SCHED;
            G8_LDB(B1, 1, 1); G8_STAGE_B(G8_SB(1, 0), b3, vB, q2);
            G8_BAR; G8_WAIT_L(0); G8_MMA(0, 1, At, B1); G8_BAR;
            G8_LDA(At, 1, 1); G8_STAGE_A(G8_SA(1, 0), a3, vA[0]);
            G8_BAR; G8_WAIT_L(0); G8_MMA(1, 0, At, B0); G8_BAR; G8_SCHED;
            G8_STAGE_B(G8_SB(1, 1), b3 + h2, vB, q2);
            G8_WAIT_V12; G8_BAR; G8_MMA(1, 1, At, B1); G8_BAR;
        }
        int tz = threadIdx.x; asm volatile("" : "+v"(tz));
        const int lane_e = tz & 63, fr_e = tz & 15, fq_e = (tz >> 4) & 3;
        {
            E.pre(acc, cur, wr, wc, fr_e, fq_e);
            constexpr int PITCH = NCH * 16 + 16;
            LAS unsigned char* ex = lds + EXCH_OFF;
            if (wr == 0) G8_BAR;
#pragma unroll
            for (int ai = 0; ai < 2; ++ai)
#pragma unroll
                for (int m = 0; m < 4; ++m) {
                    u32x4 o[2];
                    E.row(acc, cur, ai, m, wr, wc, fr_e, fq_e, o);
                    if (NCH == 32) {
                        *(LAS u32x4*)(ex + (wr * 16 + fr_e) * PITCH + (wc * 32 + 8 * fq_e) * 2) = o[0];
                        *(LAS u32x4*)(ex + (wr * 16 + fr_e) * PITCH + (128 + wc * 32 + 8 * fq_e) * 2) = o[1];
                    } else {
                        *(LAS u32x4*)(ex + (wr * 16 + fr_e) * PITCH + (wc * 32 + 8 * fq_e) * 2) = o[0];
                    }
                    epi_bar();
                    if (!loader) {
                        constexpr int RPI = 64 / NCH;
#pragma unroll
                        for (int i = 0; i < 8 / RPI; ++i) {
                            const int rl = 8 * wc + RPI * i + lane_e / NCH, ch = lane_e % NCH;
                            const int rt = ai * 128 + (rl >> 4) * 64 + m * 16 + (rl & 15);
                            const u32x4 d = *(const LAS u32x4*)(ex + rl * PITCH + ch * 16);
                            E.store(cur, rt, ch, d);
                        }
                    }
                    epi_bar();
                }
            if (wr == 1) G8_BAR;
        }
        if (!has_next) break;
#pragma unroll
        for (int a = 0; a < 2; ++a)
#pragma unroll
            for (int b = 0; b < 2; ++b)
#pragma unroll
                for (int m = 0; m < 4; ++m)
#pragma unroll
                    for (int n = 0; n < 2; ++n) acc[a][b][m][n] = (f32x4){0.f, 0.f, 0.f, 0.f};
        cur = nxt; cA = nA; cB = nB; hB = nhB; q32 = nq32; ++ui;
    }
    G8_WAIT_V0;
    if (wr == 0) G8_BAR;
    G8_BAR;
#undef G8_SA
#undef G8_SB
#undef G8_STAGE_A
#undef G8_STAGE_B
#undef G8_LDA
#undef G8_LDB
#undef G8_MMA
#undef G8_WAIT_V8
#undef G8_WAIT_V12
#undef G8_WAIT_V0
#undef G8_WAIT_L
#undef G8_BAR
#undef G8_SCHED
#undef G8_OFFS
}
}

struct DenseSched {
    const char* A; const char* Bt; int nM, nN, lda, ldb, nt, G, c;
    DI bool next(int i, g8::Unit& u) const {
        int pm, pn; if (!g8::static_tile(i * G + c, nM, nN, pm, pn)) return false;
        pm = __builtin_amdgcn_readfirstlane(pm); pn = __builtin_amdgcn_readfirstlane(pn);
        u.A = A; u.B = Bt + (size_t)pn * 256 * ldb; u.row0 = pm * 256; u.lda = lda; u.ldb = ldb; u.nt = nt; u.pm = pm; u.pn = pn; u.aux = 0; u.keep = 0; u.e = 0; u.nvalid = 256; u.par = 0; return true;
    }
    DI int arow(const g8::Unit& u, int rr) const { return u.row0 + rr; }
    DI bool prefetch(const g8::Unit&, int, int) const { return false; }
};
constexpr int MOE_TAB_OFF = g8::STAGE_BYTES;
constexpr int MOE_TILE_OFF = g8::STAGE_BYTES + 1024;
constexpr int MOE_IDX_OFF = g8::STAGE_BYTES + 2048;
struct MoeSched {
    LAS unsigned char* lds; const int* list; const float* listw; const char* A; const char* W; int ncol, mode  , G, c;
    DI bool next(int i, g8::Unit& u) const {
        const LAS int* tpre = (const LAS int*)(lds + MOE_TAB_OFF);
        const int L = i * G + c; const int T = __builtin_amdgcn_readfirstlane(tpre[NEX]);
        if (L >= T * ncol) return false;
        const int gt = __builtin_amdgcn_readfirstlane(L / ncol), pn = L - gt * ncol;
        const int e = __builtin_amdgcn_readfirstlane((int)*(const LAS unsigned char*)(lds + MOE_TILE_OFF + gt));
        const int tile = gt - __builtin_amdgcn_readfirstlane(tpre[e]);
        const int n_e = __builtin_amdgcn_readfirstlane(tpre[NEX + 1 + e]);
        u.e = e; u.pm = tile; u.pn = pn; u.nvalid = min(256, n_e - tile * 256); u.keep = 0; u.aux = gt * 256; u.par = i & 1;
        if (mode == 0) { u.A = A; u.lda = 4096; u.ldb = 4096; u.nt = 32; u.B = W + ((size_t)e * 1024 + (size_t)pn * 256) * 4096; u.row0 = tile * 256; }
        else { u.A = A; u.lda = 1024; u.ldb = 1024; u.nt = 8; u.B = W + ((size_t)e * 2048 + (size_t)pn * 256) * 1024; u.row0 = gt * 256; }
        return true;
    }
    DI bool prefetch(const g8::Unit& u, int wid, int lane) const {
        if (u.e < NE && wid < 4) {
            const int r = min(wid * 64 + lane, u.nvalid - 1);
            const size_t src = (size_t)u.e * LIST_CAP + u.pm * 256 + r;
            __builtin_amdgcn_global_load_lds((const unsigned*)(list + src), (LAS unsigned*)(lds + MOE_IDX_OFF + u.par * 2048 + wid * 256), 4, 0, 0);
            if (mode == 1) __builtin_amdgcn_global_load_lds((const unsigned*)(listw + src), (LAS unsigned*)(lds + MOE_IDX_OFF + u.par * 2048 + 1024 + wid * 256), 4, 0, 0);
        }
        return true;
    }
    DI int arow(const g8::Unit& u, int rr) const {
        if (mode == 1) return u.row0 + rr;
        if (u.e >= NE) return u.row0 + rr;
        return *(const LAS int*)(lds + MOE_IDX_OFF + u.par * 2048 + rr * 4) / 9;
    }
};

typedef f32x4 (&AccRef)[2][2][4][2];
DI u32x4 pack8(const f32x4& v0, const f32x4& v1) { u32x4 w; w.x = pk_bf16(v0[0], v0[1]); w.y = pk_bf16(v0[2], v0[3]); w.z = pk_bf16(v1[0], v1[1]); w.w = pk_bf16(v1[2], v1[3]); return w; }

struct EpiInProj {
    bf16_t* proj; const float* rope;
    DI static int kind_of(int pn) { return pn < 6 ? 0 : pn < 12 ? 1 : pn < 18 ? 2 : pn < 22 ? 3 : pn < 30 ? 2 : 4; }
    DI void pre(AccRef acc, const g8::Unit& u, int wr, int wc, int fr, int fq) const {
        if (kind_of(u.pn) <= 1 && wc == 0) {
            const float sg = (fq < 2) ? -1.0f : 1.0f;
#pragma unroll
            for (int g = 0; g < 4; ++g) {
                const int ai = g >> 1;
                f32x4 cs[2][4];
#pragma unroll
                for (int mm = 0; mm < 2; ++mm) { const int m = (g & 1) * 2 + mm; const int row = u.pm * 256 + ai * 128 + wr * 64 + m * 16 + fr;
#pragma unroll
                    for (int q = 0; q < 4; ++q) cs[mm][q] = *(const f32x4*)(rope + (size_t)row * 32 + 16 * (fq & 1) + 4 * q); }
#pragma unroll
                for (int mm = 0; mm < 2; ++mm) { const int m = (g & 1) * 2 + mm;
#pragma unroll
                    for (int bj = 0; bj < 2; ++bj) {
                        f32x4 v0 = acc[ai][bj][m][0], v1 = acc[ai][bj][m][1], p0, p1;
#pragma unroll
                        for (int j = 0; j < 4; ++j) { p0[j] = __shfl_xor(v0[j], 32); p1[j] = __shfl_xor(v1[j], 32); }
#pragma unroll
                        for (int j = 0; j < 4; ++j) {
                            const float c0 = cs[mm][j >> 1][(j & 1) * 2], s0 = cs[mm][j >> 1][(j & 1) * 2 + 1];
                            const float c1 = cs[mm][2 + (j >> 1)][(j & 1) * 2], s1 = cs[mm][2 + (j >> 1)][(j & 1) * 2 + 1];
                            v0[j] = v0[j] * c0 + sg * p0[j] * s0;
                            v1[j] = v1[j] * c1 + sg * p1[j] * s1;
                        }
                        acc[ai][bj][m][0] = v0; acc[ai][bj][m][1] = v1;
                    }
                    asm volatile("" : "+v"(acc[ai][0][m][0]), "+v"(acc[ai][0][m][1]), "+v"(acc[ai][1][m][0]), "+v"(acc[ai][1][m][1]));
                }
                asm volatile("" ::: "memory");
            }
        }
    }
    DI void row(AccRef acc, const g8::Unit& u, int ai, int m, int wr, int wc, int fr, int fq, u32x4 (&o)[2]) const {
        const int kind = kind_of(u.pn);
#pragma unroll
        for (int bj = 0; bj < 2; ++bj) {
            f32x4 v0 = acc[ai][bj][m][0], v1 = acc[ai][bj][m][1];
            if (kind == 0 || kind == 3) { v0 *= QSCALE; v1 *= QSCALE; }
            if (kind == 4) {
#pragma unroll
                for (int j = 0; j < 4; ++j) { v0[j] = sigmoidf_(v0[j]); v1[j] = sigmoidf_(v1[j]); }
            }
            o[bj] = pack8(v0, v1);
        }
    }
    DI void store(const g8::Unit& u, int rt, int ch, const u32x4& d) const { __builtin_nontemporal_store(d, (u32x4*)(proj + (size_t)(u.pm * 256 + rt) * DIN + u.pn * 256 + ch * 8)); }
};
template <int PART> struct EpiGate {
    const bf16_t* proj; const bf16_t* tmp; bf16_t* out;
    DI void pre(AccRef acc, const g8::Unit& u, int wr, int wc, int fr, int fq) const {
        const unsigned vo_g = (unsigned)(((wr * 64 + fr) * DIN + wc * 32 + 8 * fq) * 2), vo_t = (unsigned)(((wr * 64 + fr) * DM + wc * 32 + 8 * fq) * 2);
#pragma unroll
        for (int ai = 0; ai < 2; ++ai)
#pragma unroll
            for (int m = 0; m < 4; ++m) {
#pragma unroll
                for (int bj = 0; bj < 2; ++bj) {
                    gcptr sg = (gcptr)(proj + (size_t)(u.pm * 256 + ai * 128 + m * 16) * DIN + u.pn * 256 + bj * 128 + (PART == 0 ? COL_GD : COL_GS));
                    asm volatile("" : "+s"(sg));
                    const u32x4 gg = *(gu4ptr)(sg + vo_g);
                    const float sv[8] = {bf_lo(gg.x), bf_hi(gg.x), bf_lo(gg.y), bf_hi(gg.y), bf_lo(gg.z), bf_hi(gg.z), bf_lo(gg.w), bf_hi(gg.w)};
                    if (PART == 0) {
#pragma unroll
                        for (int j = 0; j < 4; ++j) { acc[ai][bj][m][0][j] *= sv[j]; acc[ai][bj][m][1][j] *= sv[4 + j]; }
                    } else {
                        gcptr st = (gcptr)(tmp + (size_t)(u.pm * 256 + ai * 128 + m * 16) * DM + u.pn * 256 + bj * 128);
                        asm volatile("" : "+s"(st));
                        const u32x4 tt = *(gu4ptr)(st + vo_t);
                        const float tv[8] = {bf_lo(tt.x), bf_hi(tt.x), bf_lo(tt.y), bf_hi(tt.y), bf_lo(tt.z), bf_hi(tt.z), bf_lo(tt.w), bf_hi(tt.w)};
#pragma unroll
                        for (int j = 0; j < 4; ++j) { acc[ai][bj][m][0][j] = acc[ai][bj][m][0][j] * sv[j] + tv[j]; acc[ai][bj][m][1][j] = acc[ai][bj][m][1][j] * sv[4 + j] + tv[4 + j]; }
                    }
                }
                asm volatile("" : "+v"(acc[ai][0][m][0]), "+v"(acc[ai][0][m][1]), "+v"(acc[ai][1][m][0]), "+v"(acc[ai][1][m][1]));
                if (m & 1) asm volatile("" ::: "memory");
            }
    }
    DI void row(AccRef acc, const g8::Unit&, int ai, int m, int, int, int, int, u32x4 (&o)[2]) const {
        o[0] = pack8(acc[ai][0][m][0], acc[ai][0][m][1]); o[1] = pack8(acc[ai][1][m][0], acc[ai][1][m][1]);
    }
    DI void store(const g8::Unit& u, int rt, int ch, const u32x4& d) const { *(u32x4*)(out + (size_t)(u.pm * 256 + rt) * DM + u.pn * 256 + ch * 8) = d; }
};
struct EpiPlain {
    bf16_t* out; int ld;
    DI void pre(AccRef, const g8::Unit&, int, int, int, int) const {}
    DI void row(AccRef acc, const g8::Unit&, int ai, int m, int, int, int, int, u32x4 (&o)[2]) const {
        o[0] = pack8(acc[ai][0][m][0], acc[ai][0][m][1]); o[1] = pack8(acc[ai][1][m][0], acc[ai][1][m][1]);
    }
    DI void store(const g8::Unit& u, int rt, int ch, const u32x4& d) const { *(u32x4*)(out + (size_t)(u.pm * 256 + rt) * ld + u.pn * 256 + ch * 8) = d; }
};
struct EpiGateUp {
    bf16_t* hid;
    DI void pre(AccRef, const g8::Unit&, int, int, int, int) const {}
    DI void row(AccRef acc, const g8::Unit&, int ai, int m, int, int, int, int, u32x4 (&o)[2]) const {
        const f32x4 g0 = acc[ai][0][m][0], g1 = acc[ai][0][m][1], u0 = acc[ai][1][m][0], u1 = acc[ai][1][m][1];
        f32x4 v0, v1;
#pragma unroll
        for (int j = 0; j < 4; ++j) { v0[j] = g0[j] * __builtin_amdgcn_rcpf(1.0f + __expf(-g0[j])) * u0[j]; v1[j] = g1[j] * __builtin_amdgcn_rcpf(1.0f + __expf(-g1[j])) * u1[j]; }
        o[0] = pack8(v0, v1); o[1] = o[0];
    }
    DI void store(const g8::Unit& u, int rt, int ch, const u32x4& d) const { *(u32x4*)(hid + (size_t)(u.aux + rt) * DE + u.pn * 128 + ch * 8) = d; }
};
struct EpiDown {
    LAS unsigned char* lds; bf16_t* yb9; int* slot;
    DI void pre(AccRef, const g8::Unit&, int, int, int, int) const {}
    DI void row(AccRef acc, const g8::Unit& u, int ai, int m, int wr, int, int fr, int, u32x4 (&o)[2]) const {
        const int rt = ai * 128 + wr * 64 + m * 16 + fr;
        const float wgt = (u.e < NE) ? *(const LAS float*)(lds + MOE_IDX_OFF + u.par * 2048 + 1024 + rt * 4) : 1.0f;
        o[0] = pack8(acc[ai][0][m][0] * wgt, acc[ai][0][m][1] * wgt); o[1] = pack8(acc[ai][1][m][0] * wgt, acc[ai][1][m][1] * wgt);
    }
    DI void store(const g8::Unit& u, int rt, int ch, const u32x4& d) const {
        if (rt < u.nvalid) {
            const int srow = u.aux + rt;
            __builtin_nontemporal_store(d, (u32x4*)(yb9 + ((size_t)u.pn * YB_SLOTS + srow) * 256 + ch * 8));
            if (u.pn == 0 && ch == 0) {
                const int v = (u.e < NE) ? *(const LAS int*)(lds + MOE_IDX_OFF + u.par * 2048 + rt * 4) : (u.pm * 256 + rt) * 9 + 8;
                slot[v] = srow;
            }
        }
    }
};

DI void phase_inproj(const Params& p, LAS unsigned char* lds) {
    DenseSched S{(const char*)(p.ws + WS_H), (const char*)(p.ws + WS_WTIN), 64, 46, 4096, 4096, 32, (int)gridDim.x, (int)blockIdx.x};
    EpiInProj E{(bf16_t*)(p.ws + WS_PROJ), (const float*)(p.ws + WS_ROPE)};
    g8::gemm_phase<32>(lds, S, E);
}
DI void phase_outproj_a(const Params& p, LAS unsigned char* lds) {
    DenseSched S{(const char*)(p.ws + WS_ODIL), (const char*)(p.ws + WS_WTDIL), 64, 8, 1024, 1024, 8, (int)gridDim.x, (int)blockIdx.x};
    EpiGate<0> E{(const bf16_t*)(p.ws + WS_PROJ), nullptr, (bf16_t*)(p.ws + WS_TMP)};
    g8::gemm_phase<32>(lds, S, E);
}
DI void phase_outproj_b(const Params& p, LAS unsigned char* lds) {
    DenseSched S{(const char*)(p.ws + WS_OSB), (const char*)(p.ws + WS_WTSB), 64, 8, 2048, 2048, 16, (int)gridDim.x, (int)blockIdx.x};
    EpiGate<1> E{(const bf16_t*)(p.ws + WS_PROJ), (const bf16_t*)(p.ws + WS_TMP), (bf16_t*)(p.ws + WS_H)};
    g8::gemm_phase<32>(lds, S, E);
}
DI void phase_mixout(const Params& p, LAS unsigned char* lds) {
    DenseSched S{(const char*)(p.ws + WS_H), (const char*)(p.ws + WS_WTMIX), 64, 8, 4096, 4096, 32, (int)gridDim.x, (int)blockIdx.x};
    EpiPlain E{(bf16_t*)(p.ws + WS_Y), DM};
    g8::gemm_phase<32>(lds, S, E);
}
DI void moe_tables(const Params& p, LAS unsigned char* lds) {
    LAS int* tpre = (LAS int*)(lds + MOE_TAB_OFF);
    const int* cnt = (const int*)(p.ws + WS_CNT);
    if (threadIdx.x == 0) {
        int acc = 0;
        for (int e = 0; e < NE; ++e) { const int n = cnt[e]; tpre[e] = acc; tpre[NEX + 1 + e] = n; acc += (n + 255) >> 8; }
        tpre[NE] = acc; tpre[NEX + 1 + NE] = NTOK; acc += NTOK / 256; tpre[NEX] = acc;
    }
    __syncthreads();
    const int T = tpre[NEX];
    for (int t = threadIdx.x; t < T; t += 512) {
        int e = 0;
        for (int q = 1; q < NEX; ++q) e = (tpre[q] <= t) ? q : e;
        *(LAS unsigned char*)(lds + MOE_TILE_OFF + t) = (unsigned char)e;
    }
    __syncthreads();
}
DI void phase_gateup(const Params& p, LAS unsigned char* lds) {
    moe_tables(p, lds);
    MoeSched S{lds, (const int*)(p.ws + WS_LIST), (const float*)(p.ws + WS_LISTW), (const char*)(p.ws + WS_H), (const char*)(p.ws + WS_WGU), 4, 0, (int)gridDim.x, (int)blockIdx.x};
    EpiGateUp E{(bf16_t*)(p.ws + WS_HID)};
    g8::gemm_phase<16>(lds, S, E);
}
DI void phase_down(const Params& p, LAS unsigned char* lds) {
    moe_tables(p, lds);
    MoeSched S{lds, (const int*)(p.ws + WS_LIST), (const float*)(p.ws + WS_LISTW), (const char*)(p.ws + WS_HID), (const char*)(p.ws + WS_WD), 8, 1, (int)gridDim.x, (int)blockIdx.x};
    EpiDown E{lds, (bf16_t*)(p.ws + WS_YB9), (int*)(p.ws + WS_SLOT)};
    g8::gemm_phase<32>(lds, S, E);
}

namespace att {
constexpr int TB = 16384;
DI unsigned off_b(unsigned row, unsigned ch) { return 256u * row + 16u * (ch ^ (((row & 3u) << 2) | ((row >> 2) & 3u))); }
DI int crow(int i, int h) { return (i & 3) + 8 * (i >> 2) + 4 * h; }
DI f32x16 mfma32(bf16x8 a, bf16x8 b, f32x16 c) { return __builtin_amdgcn_mfma_f32_32x32x16_bf16(a, b, c, 0, 0, 0); }
DI bf16x8 pack8(const f32x16& x, int s) {
    u32x4 w; w.x = pk_bf16(x[8 * s + 0], x[8 * s + 1]); w.y = pk_bf16(x[8 * s + 2], x[8 * s + 3]); w.z = pk_bf16(x[8 * s + 4], x[8 * s + 5]); w.w = pk_bf16(x[8 * s + 6], x[8 * s + 7]);
    return __builtin_bit_cast(bf16x8, w);
}
DI void qk_tile(LAS const unsigned char* Kb, const bf16x8 (&qf)[8], f32x16& x0, f32x16& x1, int r, int h) {
#pragma unroll
    for (int i = 0; i < 16; ++i) { x0[i] = 0.f; x1[i] = 0.f; }
#pragma unroll
    for (int s = 0; s < 8; ++s) {
        const bf16x8 a0 = *(const LAS bf16x8*)(Kb + off_b(r, 2 * s + h));
        const bf16x8 a1 = *(const LAS bf16x8*)(Kb + off_b(32 + r, 2 * s + h));
        x0 = mfma32(a0, qf[s], x0); x1 = mfma32(a1, qf[s], x1);
    }
}
DI void pv_tile(LAS const unsigned char* Vb, const f32x16& p0, const f32x16& p1, f32x16 (&o)[4], int lane) {
    const int h = lane >> 5, blk = (lane >> 4) & 1, q = (lane & 15) >> 2, pp = lane & 3;
#pragma unroll
    for (int kb = 0; kb < 2; ++kb)
#pragma unroll
        for (int s = 0; s < 2; ++s) {
            const bf16x8 pf = pack8(kb ? p1 : p0, s);
#pragma unroll
            for (int db = 0; db < 4; ++db) {
                const unsigned row0 = 32 * kb + 16 * s + 4 * h + q;
                const unsigned ch = 4 * db + 2 * blk + (pp >> 1);
                const s16x4 t0 = __builtin_amdgcn_ds_read_tr16_b64_v4i16((LAS s16x4*)(Vb + off_b(row0, ch) + 8 * (pp & 1)));
                const s16x4 t1 = __builtin_amdgcn_ds_read_tr16_b64_v4i16((LAS s16x4*)(Vb + off_b(row0 + 8, ch) + 8 * (pp & 1)));
                const bf16x8 vf = {t0[0], t0[1], t0[2], t0[3], t1[0], t1[1], t1[2], t1[3]};
                o[db] = mfma32(vf, pf, o[db]);
            }
        }
}
DI void store_o(bf16_t* orow, const f32x16 (&o)[4], float scale, int h) {
#pragma unroll
    for (int db = 0; db < 4; ++db)
#pragma unroll
        for (int g = 0; g < 4; ++g) {
            u32x2 w; w.x = pk_bf16(o[db][4 * g] * scale, o[db][4 * g + 1] * scale); w.y = pk_bf16(o[db][4 * g + 2] * scale, o[db][4 * g + 3] * scale);
            *(u32x2*)(orow + 32 * db + 8 * g + 4 * h) = w;
        }
}

DI void sb_item(const Params& p, LAS unsigned char* lds, int b, int hd, int Q) {
    const bf16_t* proj = (const bf16_t*)(p.ws + WS_PROJ);
    bf16_t* osb = (bf16_t*)(p.ws + WS_OSB);
    const int tid = threadIdx.x, wid = __builtin_amdgcn_readfirstlane(tid >> 6), lane = tid & 63, r = lane & 31, h = lane >> 5;
    const size_t tokbase = (size_t)b * SEQ;
    const int wq0 = Q * 256 + 32 * wid;
    const int myq = wq0 + r;
    bf16x8 qf[8];
    f32x16 o[4];
#pragma unroll
    for (int db = 0; db < 4; ++db)
#pragma unroll
        for (int i = 0; i < 16; ++i) o[db][i] = 0.f;
    float R = 0.f;
    unsigned goff[2];
#pragma unroll
    for (int i = 0; i < 2; ++i) { const unsigned row = 4 * (wid * 2 + i) + (lane >> 4), cp = lane & 15, ch = cp ^ (((row & 3u) << 2) | ((row >> 2) & 3u)); goff[i] = (row * DIN + ch * 8) * 2; }
    const char* kbase = (const char*)(proj + tokbase * DIN + COL_KS + hd * 128);
    const char* vbase = (const char*)(proj + tokbase * DIN + COL_VS + hd * 128);
#define ATT_ISSUE(key0_, buf_) do { const size_t _ko = (size_t)(key0_) * DIN * 2; _Pragma("unroll") for (int _i = 0; _i < 2; ++_i) { \
        __builtin_amdgcn_global_load_lds((const unsigned*)(kbase + _ko + goff[_i]), (LAS unsigned*)(lds + (buf_) * TB + 1024 * (wid * 2 + _i)), 16, 0, 0); \
        __builtin_amdgcn_global_load_lds((const unsigned*)(vbase + _ko + goff[_i]), (LAS unsigned*)(lds + 3 * TB + (buf_) * TB + 1024 * (wid * 2 + _i)), 16, 0, 0); } } while (0)
    int j = 4 * Q + 3;
    ATT_ISSUE(64 * j, 0);
    ATT_ISSUE(64 * (j - 1), 1);
    {
        const bf16_t* qrow = proj + (tokbase + myq) * DIN + COL_QS + hd * 128;
#pragma unroll
        for (int s = 0; s < 8; ++s) qf[s] = *(const bf16x8*)(qrow + 16 * s + 8 * h);
#pragma unroll
        for (int s = 0; s < 8; ++s) asm volatile("" : "+v"(qf[s]));
    }
    int cur = 0;
    for (; j >= 0; --j) {
        LAS unsigned char* Kb = lds + cur * TB; LAS unsigned char* Vb = lds + 3 * TB + cur * TB;
        if (j > 0) asm volatile("s_waitcnt vmcnt(4)" ::: "memory"); else asm volatile("s_waitcnt vmcnt(0)" ::: "memory");
        __builtin_amdgcn_s_barrier(); asm volatile("" ::: "memory");
        if (j > 1) ATT_ISSUE(64 * (j - 2), cur == 0 ? 2 : cur - 1);
        const int key0 = 64 * j;
        if (key0 < wq0 + 31) {
            const bool need_mask = (key0 + 63 >= wq0);
            f32x16 x0, x1;
            qk_tile(Kb, qf, x0, x1, r, h);
            f32x16 l0, l1;
#pragma unroll
            for (int i = 0; i < 16; ++i) {
                l0[i] = __builtin_amdgcn_logf(1.0f + __builtin_amdgcn_exp2f(x0[i]));
                l1[i] = __builtin_amdgcn_logf(1.0f + __builtin_amdgcn_exp2f(x1[i]));
            }
            if (need_mask) {
#pragma unroll
                for (int i = 0; i < 16; ++i) { const int kk = key0 + crow(i, h); if (kk >= myq) l0[i] = 0.f; if (kk + 32 >= myq) l1[i] = 0.f; }
            }
#pragma unroll
            for (int g = 0; g < 4; ++g) {
                l0[4 * g + 2] += l0[4 * g + 3]; l0[4 * g + 1] += l0[4 * g + 2]; l0[4 * g] += l0[4 * g + 1];
                l1[4 * g + 2] += l1[4 * g + 3]; l1[4 * g + 1] += l1[4 * g + 2]; l1[4 * g] += l1[4 * g + 1];
            }
            float Tlo[8], Thi[8];
#pragma unroll
            for (int g = 0; g < 4; ++g) {
                { const unsigned t = __float_as_uint(l0[4 * g]); auto sw = __builtin_amdgcn_permlane32_swap(t, t, false, false); Tlo[g] = __uint_as_float(sw[0]); Thi[g] = __uint_as_float(sw[1]); }
                { const unsigned t = __float_as_uint(l1[4 * g]); auto sw = __builtin_amdgcn_permlane32_swap(t, t, false, false); Tlo[4 + g] = __uint_as_float(sw[0]); Thi[4 + g] = __uint_as_float(sw[1]); }
            }
            float offR[8];
            float run = 0.f;
#pragma unroll
            for (int g = 7; g >= 0; --g) { offR[g] = run + (h == 0 ? Thi[g] : 0.f) + R; run += Tlo[g] + Thi[g]; }
            f32x16 p0, p1;
#pragma unroll
            for (int i = 0; i < 16; ++i) {
                p0[i] = __builtin_amdgcn_exp2f(x0[i] - (l0[i] + offR[i >> 2]));
                p1[i] = __builtin_amdgcn_exp2f(x1[i] - (l1[i] + offR[4 + (i >> 2)]));
            }
            if (need_mask) {
#pragma unroll
                for (int i = 0; i < 16; ++i) { const int kk = key0 + crow(i, h); if (kk >= myq) p0[i] = 0.f; if (kk + 32 >= myq) p1[i] = 0.f; }
            }
            R += run;
            pv_tile(Vb, p0, p1, o, lane);
        }
        cur = (cur == 2) ? 0 : cur + 1;
    }
    store_o(osb + (tokbase + myq) * 1024 + hd * 128, o, 1.0f, h);
    __syncthreads();
}

DI void dil_item(const Params& p, LAS unsigned char* lds, int di) {
    const bf16_t* proj = (const bf16_t*)(p.ws + WS_PROJ);
    bf16_t* og = (bf16_t*)(p.ws + WS_OG);
    float* lse = (float*)(p.ws + WS_LSE);
    const int b = di / 192; const int rem = di - b * 192; const int head = rem >> 4, sub = rem & 15;
    const int grp = head >> 2;
    const int dil = grp == 0 ? 1 : grp == 1 ? 4 : 16;
    const int nblk = 16 / dil;
    const int res = sub / nblk, Qb = sub - res * nblk;
    const int i0 = Qb * 256;
    const int tid = threadIdx.x, wid = __builtin_amdgcn_readfirstlane(tid >> 6), lane = tid & 63, r = lane & 31, h = lane >> 5;
    const size_t tokbase = (size_t)b * SEQ;
    const int wq0 = i0 + 32 * wid;
    const int myqi = wq0 + r;
    const size_t mytok = tokbase + (size_t)myqi * dil + res;
    bf16x8 qf[8];
    f32x16 o[4];
#pragma unroll
    for (int db = 0; db < 4; ++db)
#pragma unroll
        for (int i = 0; i < 16; ++i) o[db][i] = 0.f;
    float mrun = -1e30f, lrun = 0.f;
    unsigned goff[2];
#pragma unroll
    for (int i = 0; i < 2; ++i) { const unsigned row = 4 * (wid * 2 + i) + (lane >> 4), cp = lane & 15, ch = cp ^ (((row & 3u) << 2) | ((row >> 2) & 3u)); goff[i] = (row * dil * DIN + ch * 8) * 2; }
    const char* kbase = (const char*)(proj + (tokbase + res) * DIN + COL_KA + head * 128);
    const char* vbase = (const char*)(proj + (tokbase + res) * DIN + COL_VA + head * 128);
    const int jt0 = (i0 == 0) ? 2 : 0;
    ATT_ISSUE((i0 - 128 + 64 * jt0) * dil, 0);
    ATT_ISSUE((i0 - 128 + 64 * (jt0 + 1)) * dil, 1);
    {
        const bf16_t* qrow = proj + mytok * DIN + COL_QA + head * 128;
#pragma unroll
        for (int s = 0; s < 8; ++s) qf[s] = *(const bf16x8*)(qrow + 16 * s + 8 * h);
#pragma unroll
        for (int s = 0; s < 8; ++s) asm volatile("" : "+v"(qf[s]));
    }
    int cur = 0;
    for (int jt = jt0; jt < 6; ++jt) {
        LAS unsigned char* Kb = lds + cur * TB; LAS unsigned char* Vb = lds + 3 * TB + cur * TB;
        if (jt < 5) asm volatile("s_waitcnt vmcnt(4)" ::: "memory"); else asm volatile("s_waitcnt vmcnt(0)" ::: "memory");
        __builtin_amdgcn_s_barrier(); asm volatile("" ::: "memory");
        if (jt < 4) ATT_ISSUE((i0 - 128 + 64 * (jt + 2)) * dil, cur == 0 ? 2 : cur - 1);
        const int ki0 = i0 - 128 + 64 * jt;
        if (ki0 <= wq0 + 31 && ki0 + 63 >= wq0 - 128) {
            f32x16 x0, x1;
            qk_tile(Kb, qf, x0, x1, r, h);
            const float NEG = -__builtin_inff();
#pragma unroll
            for (int i = 0; i < 16; ++i) {
                const int d0 = myqi - (ki0 + crow(i, h));
                if ((unsigned)d0 > 128u) x0[i] = NEG;
                if ((unsigned)(d0 - 32) > 128u) x1[i] = NEG;
            }
            float mx = x0[0];
#pragma unroll
            for (int i = 1; i < 16; ++i) mx = fmaxf(mx, x0[i]);
#pragma unroll
            for (int i = 0; i < 16; ++i) mx = fmaxf(mx, x1[i]);
            { const unsigned t = __float_as_uint(mx); auto sw = __builtin_amdgcn_permlane32_swap(t, t, false, false); mx = fmaxf(__uint_as_float(sw[0]), __uint_as_float(sw[1])); }
            const float mn = fmaxf(mrun, mx);
            const float alpha = __builtin_amdgcn_exp2f(mrun - mn);
            mrun = mn;
            f32x16 p0, p1; float rs = 0.f;
#pragma unroll
            for (int i = 0; i < 16; ++i) { p0[i] = __builtin_amdgcn_exp2f(x0[i] - mn); p1[i] = __builtin_amdgcn_exp2f(x1[i] - mn); rs += p0[i] + p1[i]; }
            { const unsigned t = __float_as_uint(rs); auto sw = __builtin_amdgcn_permlane32_swap(t, t, false, false); rs = __uint_as_float(sw[0]) + __uint_as_float(sw[1]); }
            lrun = lrun * alpha + rs;
#pragma unroll
            for (int db = 0; db < 4; ++db)
#pragma unroll
                for (int i = 0; i < 16; ++i) o[db][i] *= alpha;
            pv_tile(Vb, p0, p1, o, lane);
        }
        cur = (cur == 2) ? 0 : cur + 1;
    }
    store_o(og + mytok * 1536 + head * 128, o, 1.0f / lrun, h);
    if (h == 0) lse[mytok * 12 + head] = (mrun + __builtin_amdgcn_logf(lrun)) * LN2;
    __syncthreads();
}
#undef ATT_ISSUE
}

DI void phase_attn(const Params& p, LAS unsigned char* lds) {
    for (int it = blockIdx.x; it < 1024; it += gridDim.x) {
        if (it < 256) {
            const int xcd = it & 7, rest = it >> 3, bhi = rest >> 3, x = rest & 7, bh = xcd * 4 + bhi;
            att::sb_item(p, lds, bh >> 3, bh & 7, 15 - x);
            att::sb_item(p, lds, bh >> 3, bh & 7, x);
        } else att::dil_item(p, lds, it - 256);
    }
}

DI void phase_merge(const Params& p) {
    const int lane = threadIdx.x & 63, wid = threadIdx.x >> 6;
    const bf16_t* og = (const bf16_t*)(p.ws + WS_OG); const float* lse = (const float*)(p.ws + WS_LSE); bf16_t* odil = (bf16_t*)(p.ws + WS_ODIL);
    const int hg = lane >> 4, d0 = (lane & 15) * 8;
    for (int tok = blockIdx.x * 8 + wid; tok < NTOK; tok += gridDim.x * 8) {
        const float l0 = lse[(size_t)tok * 12 + hg], l1 = lse[(size_t)tok * 12 + 4 + hg], l2 = lse[(size_t)tok * 12 + 8 + hg];
        const float mx = fmaxf(l0, fmaxf(l1, l2));
        float w0 = __expf(l0 - mx), w1 = __expf(l1 - mx), w2 = __expf(l2 - mx);
        const float inv = 1.0f / (w0 + w1 + w2); w0 *= inv; w1 *= inv; w2 *= inv;
        const u32x4 a = *(const u32x4*)(og + (size_t)tok * 1536 + hg * 128 + d0);
        const u32x4 bq = *(const u32x4*)(og + (size_t)tok * 1536 + (4 + hg) * 128 + d0);
        const u32x4 c = *(const u32x4*)(og + (size_t)tok * 1536 + (8 + hg) * 128 + d0);
        u32x4 o;
#pragma unroll
        for (int q = 0; q < 4; ++q) {
            const float lo = w0 * bf_lo(a[q]) + w1 * bf_lo(bq[q]) + w2 * bf_lo(c[q]);
            const float hi = w0 * bf_hi(a[q]) + w1 * bf_hi(bq[q]) + w2 * bf_hi(c[q]);
            o[q] = pk_bf16(lo, hi);
        }
        *(u32x4*)(odil + (size_t)tok * 512 + hg * 128 + d0) = o;
    }
}

DI void phase_postmix(const Params& p, LAS unsigned char* lds) {
    const int tid = threadIdx.x, lane = tid & 63, wid = __builtin_amdgcn_readfirstlane(tid >> 6);
    LAS float* hsm = (LAS float*)lds;
    LAS float* part = (LAS float*)(lds + 65536);
    const float* mod = (const float*)(p.ws + WS_MOD); const bf16_t* y = (const bf16_t*)(p.ws + WS_Y);
    bf16_t* h2 = (bf16_t*)(p.ws + WS_H);
    int* cnt = (int*)(p.ws + WS_CNT); int* list = (int*)(p.ws + WS_LIST); float* listw = (float*)(p.ws + WS_LISTW);
    const bf16_t* wr_hi = (const bf16_t*)(p.ws + WS_WRT); const bf16_t* wr_lo = wr_hi + 64 * 2048;
    LAS int* lcnt = (LAS int*)(lds + 81920);
    LAS int* lbase = (LAS int*)(lds + 82176);
    LAS unsigned char* sel_e = lds + 82432;
    LAS unsigned short* sel_r = (LAS unsigned short*)(lds + 83456);
    LAS float* sel_w = (LAS float*)(lds + 85504);
    if (tid < 64) lcnt[tid] = 0;
    int itl = 0;
    for (int it = blockIdx.x; it < NTOK / 8; it += gridDim.x, ++itl) {
        const int tok = it * 8 + wid, b = tok >> 12;
        {
            f32x4 v[8]; float ss = 0.f;
#pragma unroll
            for (int i = 0; i < 8; ++i) { const u32x2 yw = *(const u32x2*)(y + (size_t)tok * DM + 4 * (lane + 64 * i)); v[i] = (f32x4){bf_lo(yw.x), bf_hi(yw.x), bf_lo(yw.y), bf_hi(yw.y)}; ss += v[i][0] * v[i][0] + v[i][1] * v[i][1] + v[i][2] * v[i][2] + v[i][3] * v[i][3]; }
            ss = wave_sum(ss);
            const float rstd = rsqrtf(ss * (1.0f / DM) + RMS_EPS);
            float ss1 = 0.f;
#pragma unroll
            for (int i = 0; i < 8; ++i) {
                const int ch = 4 * (lane + 64 * i);
                const f32x4 g = *(const f32x4*)(p.g_post_mix + ch);
                const f32x4 gt = *(const f32x4*)(mod + b * 12288 + 4096 + ch);
                const f32x4 xv = *(const f32x4*)(p.x + (size_t)tok * DM + ch);
#pragma unroll
                for (int j = 0; j < 4; ++j) { v[i][j] = xv[j] + gt[j] * (v[i][j] * rstd * g[j]); ss1 += v[i][j] * v[i][j]; }
                *(f32x4*)(p.out + (size_t)tok * DM + ch) = v[i];
            }
            ss1 = wave_sum(ss1);
            const float rstd1 = rsqrtf(ss1 * (1.0f / DM) + RMS_EPS);
#pragma unroll
            for (int i = 0; i < 8; ++i) {
                const int ch = 4 * (lane + 64 * i);
                const f32x4 g = *(const f32x4*)(p.g_pre_ffn + ch);
                const f32x4 sh = *(const f32x4*)(mod + b * 12288 + 6144 + ch);
                const f32x4 sc = *(const f32x4*)(mod + b * 12288 + 8192 + ch);
                f32x4 o;
#pragma unroll
                for (int j = 0; j < 4; ++j) o[j] = v[i][j] * rstd1 * g[j] * (1.0f + sc[j]) + sh[j];
                u32x2 w; w.x = pk_bf16(o[0], o[1]); w.y = pk_bf16(o[2], o[3]);
                *(u32x2*)(h2 + (size_t)tok * DM + ch) = w;
                *(LAS f32x4*)(hsm + wid * 2048 + ch) = o;
            }
        }
        __syncthreads();
        {
            const int tr = lane & 15, kq = lane >> 4;
            f32x4 acc[4];
#pragma unroll
            for (int q = 0; q < 4; ++q) acc[q] = (f32x4){0.f, 0.f, 0.f, 0.f};
#pragma unroll 4
            for (int ks = 0; ks < 8; ++ks) {
                const int k0 = 256 * wid + 32 * ks + 8 * kq;
                f32x4 a0 = (f32x4){0.f, 0.f, 0.f, 0.f}, a1 = a0;
                if (tr < 8) { a0 = *(const LAS f32x4*)(hsm + tr * 2048 + k0); a1 = *(const LAS f32x4*)(hsm + tr * 2048 + k0 + 4); }
                u32x4 hw, lw;
                {
                    float xs[8] = {a0[0], a0[1], a0[2], a0[3], a1[0], a1[1], a1[2], a1[3]};
                    unsigned hh[4], ll[4];
#pragma unroll
                    for (int q = 0; q < 4; ++q) {
                        hh[q] = pk_bf16(xs[2 * q], xs[2 * q + 1]);
                        ll[q] = pk_bf16(xs[2 * q] - bf_lo(hh[q]), xs[2 * q + 1] - bf_hi(hh[q]));
                    }
                    hw = (u32x4){hh[0], hh[1], hh[2], hh[3]}; lw = (u32x4){ll[0], ll[1], ll[2], ll[3]};
                }
                const bf16x8 ah = __builtin_bit_cast(bf16x8, hw), al = __builtin_bit_cast(bf16x8, lw);
#pragma unroll
                for (int q = 0; q < 4; ++q) {
                    const bf16x8 bh = *(const bf16x8*)(wr_hi + (size_t)(16 * q + tr) * 2048 + k0);
                    const bf16x8 bl = *(const bf16x8*)(wr_lo + (size_t)(16 * q + tr) * 2048 + k0);
                    acc[q] = __builtin_amdgcn_mfma_f32_16x16x32_bf16(ah, bh, acc[q], 0, 0, 0);
                    acc[q] = __builtin_amdgcn_mfma_f32_16x16x32_bf16(ah, bl, acc[q], 0, 0, 0);
                    acc[q] = __builtin_amdgcn_mfma_f32_16x16x32_bf16(al, bh, acc[q], 0, 0, 0);
                }
            }
            if (kq < 2) {
#pragma unroll
                for (int q = 0; q < 4; ++q)
#pragma unroll
                    for (int j = 0; j < 4; ++j) part[(wid * 8 + 4 * kq + j) * 64 + 16 * q + tr] = acc[q][j];
            }
        }
        __syncthreads();
        {
            float logit = 0.f;
#pragma unroll
            for (int w = 0; w < 8; ++w) logit += part[(w * 8 + wid) * 64 + lane];
            const float score = 1.0f / (1.0f + __expf(-logit));
            const float sel = score + p.router_bias[lane];
            float m1 = sel;
            m1 = fmaxf(m1, __shfl_xor(m1, 1)); m1 = fmaxf(m1, __shfl_xor(m1, 2)); m1 = fmaxf(m1, __shfl_xor(m1, 4));
            const bool is1 = (sel == m1);
            const unsigned long long bal = __ballot(is1);
            const unsigned gm = (unsigned)(bal >> (lane & ~7)) & 0xffu;
            const int first = __ffs(gm) - 1;
            float m2 = (is1 && (lane & 7) == first) ? -__builtin_inff() : sel;
            m2 = fmaxf(m2, __shfl_xor(m2, 1)); m2 = fmaxf(m2, __shfl_xor(m2, 2)); m2 = fmaxf(m2, __shfl_xor(m2, 4));
            const float gs = m1 + m2;
            const int myg = lane >> 3;
            int grank = 0;
#pragma unroll 1
            for (int g = 0; g < 8; ++g) { const float gv = __uint_as_float(__builtin_amdgcn_readlane(__float_as_uint(gs), 8 * g)); grank += (gv > gs || (gv == gs && g < myg)) ? 1 : 0; }
            const bool gsel = grank < 4;
            const float msel = gsel ? sel : -__builtin_inff();
            int rk = 0;
#pragma unroll 4
            for (int e = 0; e < 64; ++e) { const float v = __uint_as_float(__builtin_amdgcn_readlane(__float_as_uint(msel), e)); rk += (v > msel || (v == msel && e < lane)) ? 1 : 0; }
            const bool chosen = gsel && rk < 8;
            const float ssum = wave_sum(chosen ? score : 0.f);
            if (chosen) {
                const int lr = __hip_atomic_fetch_add(lcnt + lane, 1, __ATOMIC_RELAXED, __HIP_MEMORY_SCOPE_WORKGROUP);
                const int idx = ((itl & 15) * 8 + wid) * 8 + rk;
                sel_e[idx] = (unsigned char)lane; sel_r[idx] = (unsigned short)lr; sel_w[idx] = score / ssum * 2.5f;
            }
        }
        __syncthreads();
        if ((itl & 15) == 15 || it + (int)gridDim.x >= NTOK / 8) {
            if (tid < 64) lbase[tid] = atomicAdd(&cnt[tid], lcnt[tid]);
            __syncthreads();
            const int nsel = ((itl & 15) + 1) * 64, it0 = itl & ~15;
            for (int idx = tid; idx < nsel; idx += 512) {
                const int e = sel_e[idx], tl = idx >> 3, k = idx & 7;
                const int tk = ((int)blockIdx.x + (it0 + (tl >> 3)) * (int)gridDim.x) * 8 + (tl & 7);
                const int pos = lbase[e] + sel_r[idx];
                list[e * LIST_CAP + pos] = tk * 9 + k; listw[e * LIST_CAP + pos] = sel_w[idx];
            }
            __syncthreads();
            if (tid < 64) lcnt[tid] = 0;
            __syncthreads();
        }
    }
}

DI void phase_combine(const Params& p) {
    const int lane = threadIdx.x & 63, wid = threadIdx.x >> 6;
    const float* mod = (const float*)(p.ws + WS_MOD); const bf16_t* yb9 = (const bf16_t*)(p.ws + WS_YB9); const int* slot = (const int*)(p.ws + WS_SLOT);
    for (int tok = blockIdx.x * 8 + wid; tok < NTOK; tok += gridDim.x * 8) {
        const int b = tok >> 12;
        float acc[4][8];
#pragma unroll
        for (int i = 0; i < 4; ++i)
#pragma unroll
            for (int j = 0; j < 8; ++j) acc[i][j] = 0.f;
#pragma unroll
        for (int k = 0; k < 9; ++k) {
            const bf16_t* row = yb9 + (size_t)slot[tok * 9 + k] * 256;
#pragma unroll
            for (int i = 0; i < 4; ++i) {
                const int c = lane + 64 * i;
                const u32x4 w = __builtin_nontemporal_load((const u32x4*)(row + (size_t)(c >> 5) * YB_SLOTS * 256 + (c & 31) * 8));
#pragma unroll
                for (int q = 0; q < 4; ++q) { acc[i][2 * q] += bf_lo(w[q]); acc[i][2 * q + 1] += bf_hi(w[q]); }
            }
        }
        float ss = 0.f;
#pragma unroll
        for (int i = 0; i < 4; ++i)
#pragma unroll
            for (int j = 0; j < 8; ++j) ss += acc[i][j] * acc[i][j];
        ss = wave_sum(ss);
        const float rstd = rsqrtf(ss * (1.0f / DM) + RMS_EPS);
#pragma unroll
        for (int i = 0; i < 4; ++i) {
            const int ch = 8 * (lane + 64 * i);
#pragma unroll
            for (int hh = 0; hh < 2; ++hh) {
                const f32x4 g = *(const f32x4*)(p.g_post_ffn + ch + 4 * hh);
                const f32x4 gt = *(const f32x4*)(mod + b * 12288 + 10240 + ch + 4 * hh);
                f32x4 xv = *(const f32x4*)(p.out + (size_t)tok * DM + ch + 4 * hh);
#pragma unroll
                for (int j = 0; j < 4; ++j) xv[j] += gt[j] * (acc[i][4 * hh + j] * rstd * g[j]);
                __builtin_nontemporal_store(xv, (f32x4*)(p.out + (size_t)tok * DM + ch + 4 * hh));
            }
        }
    }
}


DI void probe_copy(const Params& p) {
    u32x4* yb = (u32x4*)(p.ws + WS_YB9);
    const size_t n = (size_t)576 * MiB / 16;
    for (size_t i = (size_t)blockIdx.x * 512 + threadIdx.x; i < n; i += (size_t)gridDim.x * 512) { u32x4 v = yb[i]; asm volatile("" : "+v"(v)); yb[i] = v; }
}

constexpr int NPHASE = 12;
template <int PH> DI void run_phase(const Params& p, LAS unsigned char* lds) {
    if constexpr (PH == 0) phase_prologue(p, lds);
    else if constexpr (PH == 1) phase_prenorm(p);
    else if constexpr (PH == 2) phase_inproj(p, lds);
    else if constexpr (PH == 3) phase_attn(p, lds);
    else if constexpr (PH == 4) phase_merge(p);
    else if constexpr (PH == 5) phase_outproj_a(p, lds);
    else if constexpr (PH == 6) phase_outproj_b(p, lds);
    else if constexpr (PH == 7) phase_mixout(p, lds);
    else if constexpr (PH == 8) phase_postmix(p, lds);
    else if constexpr (PH == 9) phase_gateup(p, lds);
    else if constexpr (PH == 10) phase_down(p, lds);
    else phase_combine(p);
}
template <int PH> __global__ __launch_bounds__(512, 2) void k_phase(Params p) {
    extern __shared__ __attribute__((aligned(16))) unsigned char shm[];
    run_phase<PH>(p, (LAS unsigned char*)shm);
}
#if MK_FUSED
typedef const __attribute__((address_space(4))) Params* KargPtr;
template <int PH> DI void mega_phase(KargPtr kp0, LAS unsigned char* lds) {
    KargPtr kp = kp0; asm volatile("" : "+s"(kp));
    Params p{};
#if defined(__HIP_DEVICE_COMPILE__)
    p.x = kp->x; p.c = kp->c; p.pos = kp->pos; p.w_ada = kp->w_ada; p.b_ada = kp->b_ada; p.g_pre_mix = kp->g_pre_mix; p.g_post_mix = kp->g_post_mix; p.g_pre_ffn = kp->g_pre_ffn; p.g_post_ffn = kp->g_post_ffn; p.w_in = kp->w_in; p.w_dil_out = kp->w_dil_out; p.w_sb_out = kp->w_sb_out; p.w_mix_out = kp->w_mix_out; p.w_router = kp->w_router; p.router_bias = kp->router_bias; p.w_gate_e = kp->w_gate_e; p.w_up_e = kp->w_up_e; p.w_down_e = kp->w_down_e; p.w_gate_s = kp->w_gate_s; p.w_up_s = kp->w_up_s; p.w_down_s = kp->w_down_s; p.out = kp->out; p.ws = kp->ws;
#endif
    run_phase<PH>(p, lds);
}
__global__ __launch_bounds__(512, 2) void k_mega(Params p_unused) {
    extern __shared__ __attribute__((aligned(16))) unsigned char shm[];
    LAS unsigned char* lds = (LAS unsigned char*)shm;
    KargPtr kp0 = (KargPtr)__builtin_amdgcn_kernarg_segment_ptr();
    volatile LAS unsigned* xbw = (volatile LAS unsigned*)(lds + LDS_BYTES - 16);
    if (threadIdx.x == 0) { xbw[0] = 0u; xbw[1] = 0u; xbw[2] = 0u; xbw[3] = 0u; }
    __syncthreads();
    XcdBarrier bar;
    { KargPtr kp = kp0; asm volatile("" : "+s"(kp)); bar = xcd_barrier_post((unsigned*)(kp->ws + WS_BAR), xbw); }
    if (MK_STAMP >= 0 && blockIdx.x == 0 && threadIdx.x == 0) { KargPtr kq = kp0; asm volatile("" : "+s"(kq)); ((unsigned long long*)(kq->ws + WS_STAMP))[0] = wall_clock64(); }
#define MEGA_PH(n) do { mega_phase<n>(kp0, lds); xcd_barrier(bar); if (MK_REP == n) { mega_phase<n>(kp0, lds); xcd_barrier(bar); } \
        if (MK_STAMP >= 0 && blockIdx.x == 0 && threadIdx.x == 0) { KargPtr kq = kp0; asm volatile("" : "+s"(kq)); ((unsigned long long*)(kq->ws + WS_STAMP))[n + 1] = wall_clock64(); } } while (0)
#if MK_REP == 90
#define MK_PROBE_DOWN_NOSTORE 1
#endif
    MEGA_PH(0); MEGA_PH(1); MEGA_PH(2); MEGA_PH(3); MEGA_PH(4); MEGA_PH(5); MEGA_PH(6); MEGA_PH(7); MEGA_PH(8); MEGA_PH(9); MEGA_PH(10);
#if MK_REP == 100
    { KargPtr kp = kp0; asm volatile("" : "+s"(kp)); Params p{}; p.ws = kp->ws; probe_copy(p); xcd_barrier(bar); }
#endif
#undef MEGA_PH
    mega_phase<11>(kp0, lds);
#if MK_STAMP >= 0
    xcd_barrier(bar);
    if (blockIdx.x == 0 && threadIdx.x == 0) {
        KargPtr kq = kp0; asm volatile("" : "+s"(kq));
        unsigned long long* st = (unsigned long long*)(kq->ws + WS_STAMP);
        st[12] = wall_clock64();
        const int k = MK_STAMP < 100 ? MK_STAMP : MK_STAMP - 100;
        const unsigned long long t0 = (MK_STAMP < 100) ? st[k] : st[0], t1 = (MK_STAMP < 100) ? st[k + 1] : st[k + 1];
        kq->out[0] += 2.0f + (float)(t1 - t0) * (MK_STAMP < 100 ? 0.0005f : 0.0001f);
    }
#endif
}
#endif

template <int PH> static void launch_phase(const Params& p, int grid, hipStream_t stream) {
    static bool init = false;
    if (!init) { (void)hipFuncSetAttribute((const void*)k_phase<PH>, hipFuncAttributeMaxDynamicSharedMemorySize, LDS_BYTES); init = true; }
    hipLaunchKernelGGL(k_phase<PH>, dim3(grid), dim3(512), LDS_BYTES, stream, p);
}

extern "C" void kernel_launch(void* const* d_in, const int* in_sizes, int n_in, void* d_out, int out_size, void* d_ws, size_t ws_size, hipStream_t stream) {
    (void)in_sizes; (void)n_in; (void)out_size;
    static int grid = 0;
    if (!grid) {
        int dev = 0, cus = 0; (void)hipGetDevice(&dev); (void)hipDeviceGetAttribute(&cus, hipDeviceAttributeMultiprocessorCount, dev);
        if (cus <= 0) cus = 256;
#if MK_FUSED
        (void)hipFuncSetAttribute((const void*)k_mega, hipFuncAttributeMaxDynamicSharedMemorySize, LDS_BYTES);
        int per_cu = 0;
        if (hipOccupancyMaxActiveBlocksPerMultiprocessor(&per_cu, (const void*)k_mega, 512, LDS_BYTES) != hipSuccess || per_cu < 1)
            fprintf(stderr, "kernel_launch: occupancy query reports %d workgroups per CU\n", per_cu);
#endif
        grid = cus;
        if (ws_size < WS_TOTAL) fprintf(stderr, "kernel_launch: workspace too small: %zu < %zu\n", ws_size, (size_t)WS_TOTAL);
    }
    Params p{};
    p.x = (const float*)d_in[0]; p.c = (const float*)d_in[1]; p.pos = (const int*)d_in[2];
    p.w_ada = (const float*)d_in[3]; p.b_ada = (const float*)d_in[4];
    p.g_pre_mix = (const float*)d_in[5]; p.g_post_mix = (const float*)d_in[6]; p.g_pre_ffn = (const float*)d_in[7]; p.g_post_ffn = (const float*)d_in[8];
    p.w_in = (const float*)d_in[9]; p.w_dil_out = (const float*)d_in[10]; p.w_sb_out = (const float*)d_in[11]; p.w_mix_out = (const float*)d_in[12];
    p.w_router = (const float*)d_in[13]; p.router_bias = (const float*)d_in[14];
    p.w_gate_e = (const float*)d_in[15]; p.w_up_e = (const float*)d_in[16]; p.w_down_e = (const float*)d_in[17];
    p.w_gate_s = (const float*)d_in[18]; p.w_up_s = (const float*)d_in[19]; p.w_down_s = (const float*)d_in[20];
    p.out = (float*)d_out; p.ws = (unsigned char*)d_ws;
    (void)hipMemsetAsync((unsigned char*)d_ws + WS_BAR, 0, WS_ZERO_BYTES, stream);
#if MK_FUSED
    hipLaunchKernelGGL(k_mega, dim3(grid), dim3(512), LDS_BYTES, stream, p);
#else
    launch_phase<0>(p, grid, stream); launch_phase<1>(p, grid, stream); launch_phase<2>(p, grid, stream); launch_phase<3>(p, grid, stream);
    launch_phase<4>(p, grid, stream); launch_phase<5>(p, grid, stream); launch_phase<6>(p, grid, stream); launch_phase<7>(p, grid, stream);
    launch_phase<8>(p, grid, stream); launch_phase<9>(p, grid, stream); launch_phase<10>(p, grid, stream); launch_phase<11>(p, grid, stream);
#endif
}
```

```cpp
#include <hip/hip_runtime.h>
#include <stdint.h>
#include <stdio.h>

#ifndef MK_FUSED
#define MK_FUSED 1
#endif
#ifndef MK_STAMP
#define MK_STAMP -1
#endif
#ifndef MK_REP
#define MK_REP -1
#endif

#define LAS __attribute__((address_space(3)))
#define DI __device__ __forceinline__
typedef unsigned short bf16_t;
typedef short bf16x8 __attribute__((ext_vector_type(8)));
typedef short s16x4 __attribute__((ext_vector_type(4)));
typedef float f32x2 __attribute__((ext_vector_type(2)));
typedef float f32x4 __attribute__((ext_vector_type(4)));
typedef float f32x16 __attribute__((ext_vector_type(16)));
typedef unsigned u32x2 __attribute__((ext_vector_type(2)));
typedef unsigned u32x4 __attribute__((ext_vector_type(4)));
typedef __bf16 bf16x2_t __attribute__((ext_vector_type(2)));
typedef const __attribute__((address_space(1))) char* gcptr;
typedef const __attribute__((address_space(1))) u32x4* gu4ptr;

constexpr int NBATCH = 4, SEQ = 4096, NTOK = NBATCH * SEQ, DM = 2048, DIN = 11776;
constexpr int COL_QA = 0, COL_KA = 1536, COL_VA = 3072, COL_QS = 4608, COL_KS = 5632, COL_VS = 6656, COL_GD = 7680, COL_GS = 9728;
constexpr int NE = 64, DE = 512, NEX = 65;
constexpr int LIST_CAP = 16384;
constexpr int YB_SLOTS = 163840;
constexpr float RMS_EPS = 1e-6f;
constexpr float QSCALE = 0.08838834764831845f * 1.4426950408889634f;
constexpr float LN2 = 0.6931471805599453f;

constexpr size_t MiB = 1ull << 20;
constexpr size_t WS_BAR = 0;
constexpr size_t WS_CNT = 16384;
constexpr size_t WS_ZERO_BYTES = 32768;
constexpr size_t WS_STAMP = 32768;

constexpr size_t WS_MOD = 65536;
constexpr size_t WS_LSE = 262144;
constexpr size_t WS_ROPE = 1 * MiB;
constexpr size_t WS_LIST = 3 * MiB;
constexpr size_t WS_LISTW = 7 * MiB;
constexpr size_t WS_SLOT = 262144;
constexpr size_t WS_WD = 11 * MiB;
constexpr size_t WS_H = 141 * MiB;
constexpr size_t WS_HID = 205 * MiB;
constexpr size_t WS_WTIN = 205 * MiB;
constexpr size_t WS_TMP = 205 * MiB;
constexpr size_t WS_OG = 251 * MiB;
constexpr size_t WS_OSB = 299 * MiB;
constexpr size_t WS_ODIL = 331 * MiB;
constexpr size_t WS_WTDIL = 347 * MiB;
constexpr size_t WS_WTSB = 349 * MiB;
constexpr size_t WS_WTMIX = 353 * MiB;
constexpr size_t WS_PROJ = 365 * MiB;
constexpr size_t WS_Y = 365 * MiB;
constexpr size_t WS_YB9 = 365 * MiB;
constexpr size_t WS_WGU = 733 * MiB;
constexpr size_t WS_WRT = 1005 * MiB;
constexpr size_t WS_TOTAL = 1006 * MiB;

#ifndef MOE_BAUX
#define MOE_BAUX 0
#endif
#ifndef GEMM_SPLIT
#define GEMM_SPLIT false
#endif
constexpr int LDS_BYTES = 163840;

struct Params {
    const float *x, *c; const int* pos;
    const float *w_ada, *b_ada, *g_pre_mix, *g_post_mix, *g_pre_ffn, *g_post_ffn;
    const float *w_in, *w_dil_out, *w_sb_out, *w_mix_out, *w_router, *router_bias;
    const float *w_gate_e, *w_up_e, *w_down_e, *w_gate_s, *w_up_s, *w_down_s;
    float* out; unsigned char* ws;
};

DI unsigned pk_bf16(float lo, float hi) { f32x2 v = {lo, hi}; bf16x2_t r = __builtin_convertvector(v, bf16x2_t); return __builtin_bit_cast(unsigned, r); }
DI float bf_lo(unsigned u) { return __uint_as_float(u << 16); }
DI float bf_hi(unsigned u) { return __uint_as_float(u & 0xffff0000u); }
DI float wave_sum(float v) {
#pragma unroll
    for (int o = 32; o >= 1; o >>= 1) v += __shfl_xor(v, o);
    return v;
}
DI float sigmoidf_(float x) { return 1.0f / (1.0f + __expf(-x)); }

#define XB_TMO      128
#define XB_XCNT(j)  (256  + 64 * (j))
#define XB_XSUB(j)  (1280 + 64 * (j))
#define XB_XGEN(j)  (2304 + 64 * (j))
#define XB_TOP      3328
#define XB_TOPGEN   3392
#define XCD_BAR_WORDS 3456
#define XB_SPIN_CAP (1u << 18)

__device__ __forceinline__ unsigned xb_ld(unsigned* p)              { return __hip_atomic_load(p, __ATOMIC_RELAXED, __HIP_MEMORY_SCOPE_AGENT); }
__device__ __forceinline__ unsigned xb_add(unsigned* p, unsigned v) { return __hip_atomic_fetch_add(p, v, __ATOMIC_RELAXED, __HIP_MEMORY_SCOPE_AGENT); }
__device__ __forceinline__ unsigned xb_xcc_id() { return (unsigned)__builtin_amdgcn_s_getreg((3 << 11) | 20) & 0xFu; }
#define XB_SPIN(cond, bar) do { unsigned _sp = 0; while (cond) { __builtin_amdgcn_s_sleep(1); \
    if ((++_sp & 255u) == 0u) { if (xb_ld(&(bar)[XB_TMO])) break; if (_sp > XB_SPIN_CAP) { atomicAdd(&(bar)[XB_TMO], 1u); break; } } } } while (0)

struct XcdBarrier { unsigned* bar; unsigned x; volatile LAS unsigned* st; };

__device__ __forceinline__ XcdBarrier xcd_barrier_post(unsigned* bar, volatile LAS unsigned* st) {
    XcdBarrier b; b.bar = bar; b.x = xb_xcc_id(); b.st = st;
    if (threadIdx.x == 0) (void)xb_add(&bar[XB_XCNT(b.x)], 1u);
    return b;
}
__device__ __forceinline__ void xcd_barrier_complete(unsigned* bar, unsigned x, unsigned& nloc, unsigned& nx) {
    const unsigned G = gridDim.x * gridDim.y * gridDim.z;
    unsigned sum, cnt, mine, sp = 0u;
    for (;;) {
        sum = 0u; cnt = 0u; mine = 0u;
#pragma unroll
        for (unsigned j = 0; j < 16; ++j) { const unsigned c = xb_ld(&bar[XB_XCNT(j)]); sum += c; cnt += (c > 0u) ? 1u : 0u; mine = (j == x) ? c : mine; }
        if (sum == G) break;
        __builtin_amdgcn_s_sleep(1);
        if ((++sp & 255u) == 0u) { if (xb_ld(&bar[XB_TMO])) break; if (sp > XB_SPIN_CAP) { atomicAdd(&bar[XB_TMO], 1u); break; } }
    }
    nloc = mine > 0u ? mine : 1u; nx = cnt > 0u ? cnt : 1u;
}
__device__ __forceinline__ void xcd_barrier(const XcdBarrier& b) {
    asm volatile("s_waitcnt vmcnt(0)" ::: "memory");
    __syncthreads();
    if (threadIdx.x == 0) {
        unsigned* bar = b.bar;
        __builtin_amdgcn_s_waitcnt(0);
        unsigned nloc = b.st[0], nx = b.st[1];
        if (nloc == 0u) { xcd_barrier_complete(bar, b.x, nloc, nx); b.st[0] = nloc; b.st[1] = nx; }
        const unsigned old = xb_add(&bar[XB_XSUB(b.x)], 1u);
        const unsigned gen = old / nloc;
        if (old + 1u == (gen + 1u) * nloc) {
            __builtin_amdgcn_fence(__ATOMIC_RELEASE, "agent");
            asm volatile("s_waitcnt vmcnt(0)" ::: "memory");
            const unsigned og = xb_add(&bar[XB_TOP], 1u);
            const unsigned tg = og / nx;
            if (og + 1u == (tg + 1u) * nx) xb_add(&bar[XB_TOPGEN], 1u);
            else XB_SPIN(xb_ld(&bar[XB_TOPGEN]) == tg, bar);
            __builtin_amdgcn_fence(__ATOMIC_ACQUIRE, "agent");
            xb_add(&bar[XB_XGEN(b.x)], 1u);
            asm volatile("s_waitcnt vmcnt(0)" ::: "memory");
        } else {
            XB_SPIN(xb_ld(&bar[XB_XGEN(b.x)]) == gen, bar);
            __builtin_amdgcn_fence(__ATOMIC_ACQUIRE, "agent");
            asm volatile("s_waitcnt vmcnt(0)" ::: "memory");
        }
    }
    __syncthreads();
}

struct CvtMat { const float* src; bf16_t* dst; int K, N, nb, mode; size_t sstride, dstride; };
constexpr int CVT_NMAT = 10;
constexpr int CVT_TILES[CVT_NMAT] = {2944, 128, 256, 512, 8192, 8192, 8192, 128, 128, 128};
constexpr int CVT_TOTAL = 2944 + 128 + 256 + 512 + 8192 * 3 + 128 * 3;
constexpr int P0_MOD_UNITS = 192, P0_ROPE_UNITS = 64, P0_WR_UNITS = 8, P0_ITEMS = P0_MOD_UNITS + P0_ROPE_UNITS + P0_WR_UNITS + CVT_TOTAL;

DI CvtMat cvt_mat(const Params& p, int m) {
    bf16_t* wtin = (bf16_t*)(p.ws + WS_WTIN); bf16_t* wtdil = (bf16_t*)(p.ws + WS_WTDIL); bf16_t* wtsb = (bf16_t*)(p.ws + WS_WTSB); bf16_t* wtmix = (bf16_t*)(p.ws + WS_WTMIX);
    bf16_t* wgu = (bf16_t*)(p.ws + WS_WGU); bf16_t* wd = (bf16_t*)(p.ws + WS_WD);
    CvtMat r;
    switch (m) {
        case 0: r = {p.w_in, wtin, 2048, 11776, 1, 0, 0, 0}; break;
        case 1: r = {p.w_dil_out, wtdil, 512, 2048, 1, 0, 0, 0}; break;
        case 2: r = {p.w_sb_out, wtsb, 1024, 2048, 1, 0, 0, 0}; break;
        case 3: r = {p.w_mix_out, wtmix, 2048, 2048, 1, 0, 0, 0}; break;
        case 4: r = {p.w_gate_e, wgu, 2048, 512, 64, 1, (size_t)2048 * 512, (size_t)1024 * 2048}; break;
        case 5: r = {p.w_up_e, wgu, 2048, 512, 64, 2, (size_t)2048 * 512, (size_t)1024 * 2048}; break;
        case 6: r = {p.w_down_e, wd, 512, 2048, 64, 0, (size_t)512 * 2048, (size_t)2048 * 512}; break;
        case 7: r = {p.w_gate_s, wgu + (size_t)64 * 1024 * 2048, 2048, 512, 1, 1, 0, 0}; break;
        case 8: r = {p.w_up_s, wgu + (size_t)64 * 1024 * 2048, 2048, 512, 1, 2, 0, 0}; break;
        default: r = {p.w_down_s, wd + (size_t)64 * 2048 * 512, 512, 2048, 1, 0, 0, 0}; break;
    }
    return r;
}

DI void cvt_tile(const Params& p, int t, LAS unsigned char* lds) {
    int m = 0;
#pragma unroll
    for (int i = 0; i < CVT_NMAT - 1; ++i) { if (t >= CVT_TILES[i] && m == i) { t -= CVT_TILES[i]; m = i + 1; } }
    const CvtMat M = cvt_mat(p, m);
    const int tn = M.N / 64, tk = M.K / 128;
    const int b = t / (tn * tk); const int rem = t - b * (tn * tk); const int kt = rem / tn, nt = rem - kt * tn;
    const float* src = M.src + (size_t)b * M.sstride + (size_t)(kt * 128) * M.N + nt * 64;
    bf16_t* dst = M.dst + (size_t)b * M.dstride;
    const int tid = threadIdx.x;
    constexpr int P = 272;
    {
        const int kq = tid >> 4, n4 = (tid & 15) * 4;
        f32x4 v[4];
#pragma unroll
        for (int i = 0; i < 4; ++i) v[i] = __builtin_nontemporal_load((const f32x4*)(src + (size_t)(kq + 32 * i) * M.N + n4));
#pragma unroll
        for (int i = 0; i < 4; ++i) {
            const int k = kq + 32 * i;
#pragma unroll
            for (int j = 0; j < 4; ++j) { const unsigned u = pk_bf16(v[i][j], 0.f); *(LAS bf16_t*)(lds + (n4 + j) * P + k * 2) = (bf16_t)(u & 0xffffu); }
        }
    }
    __syncthreads();
    {
        const int n = tid >> 3;
        const int c = nt * 64 + n;
        const int drow = M.mode == 0 ? c : (((c >> 7) << 8) + (c & 127) + (M.mode == 2 ? 128 : 0));
#pragma unroll
        for (int i = 0; i < 2; ++i) {
            const int ch = (tid & 7) + 8 * i;
            const u32x4 w = *(const LAS u32x4*)(lds + n * P + ch * 16);
            *(u32x4*)(dst + (size_t)drow * M.K + kt * 128 + ch * 8) = w;
        }
    }
    __syncthreads();
}

DI void mod_unit(const Params& p, int u, LAS unsigned char* lds) {
    const int tid = threadIdx.x, c0 = u * 64;
    LAS float* sc = (LAS float*)lds;
    LAS float* red = (LAS float*)(lds + 32768);
    for (int i = tid; i < 4 * 2048; i += 512) { const float v = p.c[i]; sc[i] = v / (1.0f + __expf(-v)); }
    __syncthreads();
    const int kq = tid >> 4, cq = tid & 15;
    float acc[4][4];
#pragma unroll
    for (int b = 0; b < 4; ++b)
#pragma unroll
        for (int j = 0; j < 4; ++j) acc[b][j] = 0.f;
    for (int it = 0; it < 64; ++it) {
        const int k = kq + 32 * it;
        const f32x4 w = __builtin_nontemporal_load((const f32x4*)(p.w_ada + (size_t)k * 12288 + c0 + 4 * cq));
#pragma unroll
        for (int b = 0; b < 4; ++b) { const float s = sc[b * 2048 + k];
#pragma unroll
            for (int j = 0; j < 4; ++j) acc[b][j] += s * w[j]; }
    }
#pragma unroll
    for (int b = 0; b < 4; ++b)
#pragma unroll
        for (int j = 0; j < 4; ++j) red[(kq * 4 + b) * 64 + 4 * cq + j] = acc[b][j];
    __syncthreads();
    if (tid < 256) {
        const int b = tid >> 6, col = tid & 63;
        float s = 0.f;
        for (int q = 0; q < 32; ++q) s += red[(q * 4 + b) * 64 + col];
        float* mod = (float*)(p.ws + WS_MOD);
        mod[b * 12288 + c0 + col] = s + p.b_ada[c0 + col];
    }
    __syncthreads();
}

DI void rope_unit(const Params& p, int u) {
    float2* rope = (float2*)(p.ws + WS_ROPE);
    for (int e = threadIdx.x; e < 4096; e += 512) {
        const int tok = u * 256 + (e >> 4), i = e & 15;
        const float invf = (float)pow(500000.0, -(double)i / 16.0);
        const float ang = (float)p.pos[tok] * invf;
        rope[tok * 16 + i] = make_float2((float)cos((double)ang), (float)sin((double)ang));
    }
}

DI void wr_unit(const Params& p, int u) {
    bf16_t* hi = (bf16_t*)(p.ws + WS_WRT); bf16_t* lo = hi + 64 * 2048;
    for (int i = threadIdx.x; i < 16384; i += 512) {
        const int idx = u * 16384 + i, k = idx >> 6, e = idx & 63;
        const float x = p.w_router[idx];
        const unsigned h = pk_bf16(x, 0.f) & 0xffffu;
        const float r = x - __uint_as_float(h << 16);
        hi[e * 2048 + k] = (bf16_t)h; lo[e * 2048 + k] = (bf16_t)(pk_bf16(r, 0.f) & 0xffffu);
    }
}
DI void phase_prologue(const Params& p, LAS unsigned char* lds) {
    for (int it = blockIdx.x; it < P0_ITEMS; it += gridDim.x) {
        if (it < P0_MOD_UNITS) mod_unit(p, it, lds);
        else if (it < P0_MOD_UNITS + P0_ROPE_UNITS) rope_unit(p, it - P0_MOD_UNITS);
        else if (it < P0_MOD_UNITS + P0_ROPE_UNITS + P0_WR_UNITS) wr_unit(p, it - P0_MOD_UNITS - P0_ROPE_UNITS);
        else cvt_tile(p, it - P0_MOD_UNITS - P0_ROPE_UNITS - P0_WR_UNITS, lds);
    }
}

DI void phase_prenorm(const Params& p) {
    const int lane = threadIdx.x & 63, wid = threadIdx.x >> 6;
    const float* mod = (const float*)(p.ws + WS_MOD);
    bf16_t* h = (bf16_t*)(p.ws + WS_H);
    for (int tok = blockIdx.x * 8 + wid; tok < NTOK; tok += gridDim.x * 8) {
        const int b = tok >> 12;
        const float* xr = p.x + (size_t)tok * DM;
        f32x4 v[8]; float ss = 0.f;
#pragma unroll
        for (int i = 0; i < 8; ++i) { v[i] = *(const f32x4*)(xr + 4 * (lane + 64 * i)); ss += v[i][0] * v[i][0] + v[i][1] * v[i][1] + v[i][2] * v[i][2] + v[i][3] * v[i][3]; }
        ss = wave_sum(ss);
        const float rstd = rsqrtf(ss * (1.0f / DM) + RMS_EPS);
#pragma unroll
        for (int i = 0; i < 8; ++i) {
            const int ch = 4 * (lane + 64 * i);
            const f32x4 g = *(const f32x4*)(p.g_pre_mix + ch);
            const f32x4 sh = *(const f32x4*)(mod + b * 12288 + ch);
            const f32x4 sc = *(const f32x4*)(mod + b * 12288 + 2048 + ch);
            f32x4 o;
#pragma unroll
            for (int j = 0; j < 4; ++j) o[j] = v[i][j] * rstd * g[j] * (1.0f + sc[j]) + sh[j];
            u32x2 w; w.x = pk_bf16(o[0], o[1]); w.y = pk_bf16(o[2], o[3]);
            *(u32x2*)(h + (size_t)tok * DM + ch) = w;
        }
    }
}

namespace g8 {
constexpr int BM = 256, BK = 64, HALF = 128, HTB = HALF * BK * 2, STAGE_BYTES = 8 * HTB, NXCD = 8, WGM = 8;
DI int lds_byte(int r, int c) { const int st = (r >> 4) * 2 + (c >> 5), rr = r & 15, cc = c & 31, ob = rr * 64 + cc * 2; return st * 1024 + (ob ^ (((ob >> 9) & 1) << 5)); }
DI void stage_rc(int b, int& R, int& C) { const int st = b / 1024, sb = b % 1024, swz = sb ^ (((sb >> 9) & 1) << 5); R = (st >> 1) * 16 + swz / 64; C = (st & 1) * 32 + (swz % 64) / 2; }
DI int perm32(int rho) { const int n = rho >> 4, i = rho & 15; return 8 * (i >> 2) + 4 * n + (i & 3); }

struct Unit {
    const char* A; const char* B;
    int row0;
    int lda, ldb, nt;
    int pm, pn, aux, keep;
    int e, nvalid, par;
};

DI bool static_tile(int L, int nM, int nN, int& pm, int& pn) {
    const int nwg = nM * nN; if (L >= nwg) return false;
    int wgid = L; { const int q = nwg / NXCD, r = nwg % NXCD, xcd = wgid % NXCD, off = wgid / NXCD; wgid = (xcd < r ? xcd * (q + 1) : r * (q + 1) + (xcd - r) * q) + off; }
    const int nig = WGM * nN, gid = wgid / nig, fm = gid * WGM, gsz = (nM - fm) < WGM ? (nM - fm) : WGM;
    pm = fm + ((wgid % nig) % gsz); pn = (wgid % nig) / gsz; return true;
}

constexpr int EXCH_OFF = STAGE_BYTES + 8192;
DI void epi_bar() { asm volatile("s_waitcnt lgkmcnt(0)" ::: "memory"); __builtin_amdgcn_s_barrier(); asm volatile("" ::: "memory"); }

template <int NCH, int BAUX, bool SPLIT, class Sched, class Epi>
DI void gemm_phase(LAS unsigned char* lds, const Sched& S, const Epi& E) {
    const int tid = threadIdx.x, wid = __builtin_amdgcn_readfirstlane(tid >> 6), lane = tid & 63, wr = wid >> 2, wc = wid & 3, fr = lane & 15, fq = lane >> 4;
    const bool loader = SPLIT ? (wr == 0) : true, storer = SPLIT ? (wr == 1) : true;
    constexpr int NP = SPLIT ? 4 : 2, PSTEP = SPLIT ? 4 : 8, RSTEP = SPLIT ? 32 : 64;
    const int p0 = SPLIT ? wc : wid;
    int R0, C0; stage_rc(p0 * 1024 + lane * 16, R0, C0);
    const int sC = C0 * 2, sRb = (R0 & ~31) + perm32(R0 & 31);
    const int aoff = lds_byte(wr * 64 + fr, fq * 8), boff = lds_byte(wc * 32 + fr, fq * 8);
#define G8_SA(b, h) (((b) * 2 + (h)) * HTB)
#define G8_SB(b, h) ((4 + (b) * 2 + (h)) * HTB)
#define G8_STAGE_A(bufoff, gbase, voff) do { if (loader) { _Pragma("unroll") for (int _i = 0; _i < NP; ++_i) \
        __builtin_amdgcn_global_load_lds((const unsigned*)((const char*)(gbase) + (voff)[_i]), (LAS unsigned*)(lds + (bufoff) + (p0 + PSTEP * _i) * 1024), 16, 0, 0); } } while (0)
#define G8_STAGE_B(bufoff, gbase, voff, ldb32) do { if (loader) { _Pragma("unroll") for (int _i = 0; _i < NP; ++_i) { \
        const char* _gb = (const char*)(gbase) + (size_t)_i * (ldb32); asm volatile("" : "+s"(_gb));     \
        __builtin_amdgcn_global_load_lds((const unsigned*)(_gb + (voff)), (LAS unsigned*)(lds + (bufoff) + (p0 + PSTEP * _i) * 1024), 16, 0, BAUX); } } } while (0)
#define G8_LDA(dst, b, h) do { _Pragma("unroll") for (int m = 0; m < 4; ++m) _Pragma("unroll") for (int k = 0; k < 2; ++k) dst[m][k] = *(const LAS bf16x8*)(lds + G8_SA(b, h) + aoff + m * 2048 + k * 1024); } while (0)
#define G8_LDB(dst, b, h) do { _Pragma("unroll") for (int n = 0; n < 2; ++n) _Pragma("unroll") for (int k = 0; k < 2; ++k) dst[n][k] = *(const LAS bf16x8*)(lds + G8_SB(b, h) + boff + n * 2048 + k * 1024); } while (0)
#define G8_MMA(ai, bj, At, Bt) do { __builtin_amdgcn_s_setprio(1); _Pragma("unroll") for (int m = 0; m < 4; ++m) _Pragma("unroll") for (int n = 0; n < 2; ++n) _Pragma("unroll") for (int k = 0; k < 2; ++k) \
        acc[ai][bj][m][n] = __builtin_amdgcn_mfma_f32_16x16x32_bf16(Bt[n][k], At[m][k], acc[ai][bj][m][n], 0, 0, 0); __builtin_amdgcn_s_setprio(0); } while (0)
#define G8_WAIT_V8 do { if (SPLIT) { if (loader) asm volatile("s_waitcnt vmcnt(8)" ::: "memory"); } else asm volatile("s_waitcnt vmcnt(4)" ::: "memory"); } while (0)
#define G8_WAIT_V12 do { if (SPLIT) { if (loader) asm volatile("s_waitcnt vmcnt(12)" ::: "memory"); } else asm volatile("s_waitcnt vmcnt(6)" ::: "memory"); } while (0)
#define G8_WAIT_V0 do { if (loader) asm volatile("s_waitcnt vmcnt(0)" ::: "memory"); } while (0)
#define G8_WAIT_L(n) asm volatile("s_waitcnt lgkmcnt(" #n ")" ::: "memory")
#define G8_BAR __builtin_amdgcn_s_barrier()
#define G8_SCHED __builtin_amdgcn_sched_barrier(0)
#define G8_OFFS(u, vA, vB) do { if (loader) { _Pragma("unroll") for (int _h = 0; _h < 2; ++_h) _Pragma("unroll") for (int _i = 0; _i < NP; ++_i) \
        vA[_h][_i] = (unsigned)S.arow(u, _h * 128 + R0 + RSTEP * _i) * (unsigned)(u).lda + (unsigned)sC; \
        vB = (unsigned)sRb * (unsigned)(u).ldb + (unsigned)sC; } } while (0)
    Unit cur, nxt; int ui = 0;
    if (!S.next(0, cur)) return;
    f32x4 acc[2][2][4][2];
#pragma unroll
    for (int a = 0; a < 2; ++a)
#pragma unroll
        for (int b = 0; b < 2; ++b)
#pragma unroll
            for (int m = 0; m < 4; ++m)
#pragma unroll
                for (int n = 0; n < 2; ++n) acc[a][b][m][n] = (f32x4){0.f, 0.f, 0.f, 0.f};
    bf16x8 At[4][2], B0[2][2], B1[2][2];
    unsigned vA[2][NP], vB = 0u;
#pragma unroll
    for (int i = 0; i < NP; ++i) { vA[0][i] = 0u; vA[1][i] = 0u; }
    if (S.prefetch(cur, wid, lane)) { G8_WAIT_V0; G8_BAR; }
    G8_OFFS(cur, vA, vB);
    const char* cA = cur.A; const char* cB = cur.B; size_t hB = (size_t)128 * cur.ldb; size_t q32 = (size_t)RSTEP * cur.ldb;
    constexpr size_t kstep = 128;
    G8_STAGE_B(G8_SB(0, 0), cB, vB, q32); G8_STAGE_A(G8_SA(0, 0), cA, vA[0]); G8_STAGE_B(G8_SB(0, 1), cB + hB, vB, q32); G8_STAGE_A(G8_SA(0, 1), cA, vA[1]);
    if (wr == 1) G8_BAR;
    G8_WAIT_V8; G8_BAR;
    G8_STAGE_B(G8_SB(1, 0), cB + kstep, vB, q32); G8_STAGE_A(G8_SA(1, 0), cA + kstep, vA[0]); G8_STAGE_B(G8_SB(1, 1), cB + hB + kstep, vB, q32);
    G8_WAIT_V12; G8_BAR;
    for (;;) {
        bool has_next = false;
        const char* nA = cA; const char* nB = cB; size_t nhB = hB, nq32 = q32;
        const int nt = cur.nt;
#pragma unroll 1
        for (int t = 0; t < nt; t += 2) {
            const bool last = (t == nt - 2);
            const char* a1 = cA + (size_t)(t + 1) * kstep;
            G8_LDB(B0, 0, 0); G8_SCHED; G8_LDA(At, 0, 0); G8_STAGE_A(G8_SA(1, 1), a1, vA[1]);
            G8_WAIT_L(8); G8_BAR; G8_WAIT_L(0); G8_MMA(0, 0, At, B0); G8_BAR; G8_SCHED;
            if (t == 0) { Unit pf; if (S.next(ui + 1, pf)) (void)S.prefetch(pf, wid, lane); }
            const char* a2; const char* b2; size_t h2, q2;
            if (last) {
                has_next = S.next(ui + 1, nxt);
                if (has_next) { G8_OFFS(nxt, vA, vB); nA = nxt.A; nB = nxt.B; nhB = (size_t)128 * nxt.ldb; nq32 = (size_t)RSTEP * nxt.ldb; }
                a2 = nA; b2 = nB; h2 = nhB; q2 = nq32;
            } else { a2 = cA + (size_t)(t + 2) * kstep; b2 = cB + (size_t)(t + 2) * kstep; h2 = hB; q2 = q32; }
            const char* a3 = a2 + kstep; const char* b3 = b2 + kstep;
            G8_LDB(B1, 0, 1); G8_STAGE_B(G8_SB(0, 0), b2, vB, q2);
            G8_BAR; G8_WAIT_L(0); G8_MMA(0, 1, At, B1); G8_BAR;
            G8_LDA(At, 0, 1); G8_STAGE_A(G8_SA(0, 0), a2, vA[0]);
            G8_BAR; G8_WAIT_L(0); G8_MMA(1, 0, At, B0); G8_BAR; G8_SCHED;
            G8_STAGE_B(G8_SB(0, 1), b2 + h2, vB, q2);
            G8_WAIT_V12; G8_BAR; G8_MMA(1, 1, At, B1); G8_BAR;
            G8_LDB(B0, 1, 0); G8_SCHED; G8_LDA(At, 1, 0); G8_STAGE_A(G8_SA(0, 1), a2, vA[1]);
            G8_WAIT_L(8); G8_BAR; G8_WAIT_L(0); G8_MMA(0, 0, At, B0); G8_BAR; G8_SCHED;
            G8_LDB(B1, 1, 1); G8_STAGE_B(G8_SB(1, 0), b3, vB, q2);
            G8_BAR; G8_WAIT_L(0); G8_MMA(0, 1, At, B1); G8_BAR;
            G8_LDA(At, 1, 1); G8_STAGE_A(G8_SA(1, 0), a3, vA[0]);
            G8_BAR; G8_WAIT_L(0); G8_MMA(1, 0, At, B0); G8_BAR; G8_SCHED;
            G8_STAGE_B(G8_SB(1, 1), b3 + h2, vB, q2);
            G8_WAIT_V12; G8_BAR; G8_MMA(1, 1, At, B1); G8_BAR;
        }
        int tz = threadIdx.x; asm volatile("" : "+v"(tz));
        const int lane_e = tz & 63, fr_e = tz & 15, fq_e = (tz >> 4) & 3;
        {
            E.pre(acc, cur, wr, wc, fr_e, fq_e);
            constexpr int PITCH = NCH * 16 + 16;
            LAS unsigned char* ex = lds + EXCH_OFF;
            if (wr == 0) G8_BAR;
#pragma unroll
            for (int ai = 0; ai < 2; ++ai)
#pragma unroll
                for (int m = 0; m < 4; ++m) {
                    u32x4 o[2];
                    E.row(acc, cur, ai, m, wr, wc, fr_e, fq_e, o);
                    if (NCH == 32) {
                        *(LAS u32x4*)(ex + (wr * 16 + fr_e) * PITCH + (wc * 32 + 8 * fq_e) * 2) = o[0];
                        *(LAS u32x4*)(ex + (wr * 16 + fr_e) * PITCH + (128 + wc * 32 + 8 * fq_e) * 2) = o[1];
                    } else {
                        *(LAS u32x4*)(ex + (wr * 16 + fr_e) * PITCH + (wc * 32 + 8 * fq_e) * 2) = o[0];
                    }
                    epi_bar();
                    if (storer) {
                        constexpr int RPI = 64 / NCH;
                        constexpr int RPW = SPLIT ? 8 : 4;
                        const int rbase = SPLIT ? 8 * wc : 4 * wid;
#pragma unroll
                        for (int i = 0; i < RPW / RPI; ++i) {
                            const int rl = rbase + RPI * i + lane_e / NCH, ch = lane_e % NCH;
                            const int rt = ai * 128 + (rl >> 4) * 64 + m * 16 + (rl & 15);
                            const u32x4 d = *(const LAS u32x4*)(ex + rl * PITCH + ch * 16);
                            E.store(cur, rt, ch, d);
                        }
                    }
                    epi_bar();
                }
            if (wr == 1) G8_BAR;
        }
        if (!has_next) break;
#pragma unroll
        for (int a = 0; a < 2; ++a)
#pragma unroll
            for (int b = 0; b < 2; ++b)
#pragma unroll
                for (int m = 0; m < 4; ++m)
#pragma unroll
                    for (int n = 0; n < 2; ++n) acc[a][b][m][n] = (f32x4){0.f, 0.f, 0.f, 0.f};
        cur = nxt; cA = nA; cB = nB; hB = nhB; q32 = nq32; ++ui;
    }
    G8_WAIT_V0;
    if (wr == 0) G8_BAR;
    G8_BAR;
#undef G8_SA
#undef G8_SB
#undef G8_STAGE_A
#undef G8_STAGE_B
#undef G8_LDA
#undef G8_LDB
#undef G8_MMA
#undef G8_WAIT_V8
#undef G8_WAIT_V12
#undef G8_WAIT_V0
#undef G8_WAIT_L
#undef G8_BAR
#undef G8_SCHED
#undef G8_OFFS
}
}

struct DenseSched {
    const char* A; const char* Bt; int nM, nN, lda, ldb, nt, G, c;
    DI bool next(int i, g8::Unit& u) const {
        int pm, pn; if (!g8::static_tile(i * G + c, nM, nN, pm, pn)) return false;
        pm = __builtin_amdgcn_readfirstlane(pm); pn = __builtin_amdgcn_readfirstlane(pn);
        u.A = A; u.B = Bt + (size_t)pn * 256 * ldb; u.row0 = pm * 256; u.lda = lda; u.ldb = ldb; u.nt = nt; u.pm = pm; u.pn = pn; u.aux = 0; u.keep = 0; u.e = 0; u.nvalid = 256; u.par = 0; return true;
    }
    DI int arow(const g8::Unit& u, int rr) const { return u.row0 + rr; }
    DI bool prefetch(const g8::Unit&, int, int) const { return false; }
};
constexpr int MOE_TAB_OFF = g8::STAGE_BYTES;
constexpr int MOE_TILE_OFF = g8::STAGE_BYTES + 1024;
constexpr int MOE_IDX_OFF = g8::STAGE_BYTES + 2048;
struct MoeSched {
    LAS unsigned char* lds; const int* list; const float* listw; const char* A; const char* W; int ncol, mode  , G, c;
    DI bool next(int i, g8::Unit& u) const {
        const LAS int* tpre = (const LAS int*)(lds + MOE_TAB_OFF);
        const int L = i * G + c; const int T = __builtin_amdgcn_readfirstlane(tpre[NEX]);
        if (L >= T * ncol) return false;
        const int gt = __builtin_amdgcn_readfirstlane(L / ncol), pn = L - gt * ncol;
        const int e = __builtin_amdgcn_readfirstlane((int)*(const LAS unsigned char*)(lds + MOE_TILE_OFF + gt));
        const int tile = gt - __builtin_amdgcn_readfirstlane(tpre[e]);
        const int n_e = __builtin_amdgcn_readfirstlane(tpre[NEX + 1 + e]);
        u.e = e; u.pm = tile; u.pn = pn; u.nvalid = min(256, n_e - tile * 256); u.keep = 0; u.aux = gt * 256; u.par = i & 1;
        if (mode == 0) { u.A = A; u.lda = 4096; u.ldb = 4096; u.nt = 32; u.B = W + ((size_t)e * 1024 + (size_t)pn * 256) * 4096; u.row0 = tile * 256; }
        else { u.A = A; u.lda = 1024; u.ldb = 1024; u.nt = 8; u.B = W + ((size_t)e * 2048 + (size_t)pn * 256) * 1024; u.row0 = gt * 256; }
        return true;
    }
    DI bool prefetch(const g8::Unit& u, int wid, int lane) const {
        if (u.e < NE && wid < 4) {
            const int r = min(wid * 64 + lane, u.nvalid - 1);
            const size_t src = (size_t)u.e * LIST_CAP + u.pm * 256 + r;
            __builtin_amdgcn_global_load_lds((const unsigned*)(list + src), (LAS unsigned*)(lds + MOE_IDX_OFF + u.par * 2048 + wid * 256), 4, 0, 0);
            if (mode == 1) __builtin_amdgcn_global_load_lds((const unsigned*)(listw + src), (LAS unsigned*)(lds + MOE_IDX_OFF + u.par * 2048 + 1024 + wid * 256), 4, 0, 0);
        }
        return true;
    }
    DI int arow(const g8::Unit& u, int rr) const {
        if (mode == 1) return u.row0 + rr;
        if (u.e >= NE) return u.row0 + rr;
        return *(const LAS int*)(lds + MOE_IDX_OFF + u.par * 2048 + rr * 4) / 9;
    }
};

typedef f32x4 (&AccRef)[2][2][4][2];
DI u32x4 pack8(const f32x4& v0, const f32x4& v1) { u32x4 w; w.x = pk_bf16(v0[0], v0[1]); w.y = pk_bf16(v0[2], v0[3]); w.z = pk_bf16(v1[0], v1[1]); w.w = pk_bf16(v1[2], v1[3]); return w; }

struct EpiInProj {
    bf16_t* proj; const float* rope;
    DI static int kind_of(int pn) { return pn < 6 ? 0 : pn < 12 ? 1 : pn < 18 ? 2 : pn < 22 ? 3 : pn < 30 ? 2 : 4; }
    DI void pre(AccRef acc, const g8::Unit& u, int wr, int wc, int fr, int fq) const {
        if (kind_of(u.pn) <= 1 && wc == 0) {
            const float sg = (fq < 2) ? -1.0f : 1.0f;
#pragma unroll
            for (int g = 0; g < 4; ++g) {
                const int ai = g >> 1;
                f32x4 cs[2][4];
#pragma unroll
                for (int mm = 0; mm < 2; ++mm) { const int m = (g & 1) * 2 + mm; const int row = u.pm * 256 + ai * 128 + wr * 64 + m * 16 + fr;
#pragma unroll
                    for (int q = 0; q < 4; ++q) cs[mm][q] = *(const f32x4*)(rope + (size_t)row * 32 + 16 * (fq & 1) + 4 * q); }
#pragma unroll
                for (int mm = 0; mm < 2; ++mm) { const int m = (g & 1) * 2 + mm;
#pragma unroll
                    for (int bj = 0; bj < 2; ++bj) {
                        f32x4 v0 = acc[ai][bj][m][0], v1 = acc[ai][bj][m][1], p0, p1;
#pragma unroll
                        for (int j = 0; j < 4; ++j) { p0[j] = __shfl_xor(v0[j], 32); p1[j] = __shfl_xor(v1[j], 32); }
#pragma unroll
                        for (int j = 0; j < 4; ++j) {
                            const float c0 = cs[mm][j >> 1][(j & 1) * 2], s0 = cs[mm][j >> 1][(j & 1) * 2 + 1];
                            const float c1 = cs[mm][2 + (j >> 1)][(j & 1) * 2], s1 = cs[mm][2 + (j >> 1)][(j & 1) * 2 + 1];
                            v0[j] = v0[j] * c0 + sg * p0[j] * s0;
                            v1[j] = v1[j] * c1 + sg * p1[j] * s1;
                        }
                        acc[ai][bj][m][0] = v0; acc[ai][bj][m][1] = v1;
                    }
                    asm volatile("" : "+v"(acc[ai][0][m][0]), "+v"(acc[ai][0][m][1]), "+v"(acc[ai][1][m][0]), "+v"(acc[ai][1][m][1]));
                }
                asm volatile("" ::: "memory");
            }
        }
    }
    DI void row(AccRef acc, const g8::Unit& u, int ai, int m, int wr, int wc, int fr, int fq, u32x4 (&o)[2]) const {
        const int kind = kind_of(u.pn);
#pragma unroll
        for (int bj = 0; bj < 2; ++bj) {
            f32x4 v0 = acc[ai][bj][m][0], v1 = acc[ai][bj][m][1];
            if (kind == 0 || kind == 3) { v0 *= QSCALE; v1 *= QSCALE; }
            if (kind == 4) {
#pragma unroll
                for (int j = 0; j < 4; ++j) { v0[j] = sigmoidf_(v0[j]); v1[j] = sigmoidf_(v1[j]); }
            }
            o[bj] = pack8(v0, v1);
        }
    }
    DI void store(const g8::Unit& u, int rt, int ch, const u32x4& d) const { __builtin_nontemporal_store(d, (u32x4*)(proj + (size_t)(u.pm * 256 + rt) * DIN + u.pn * 256 + ch * 8)); }
};
template <int PART> struct EpiGate {
    const bf16_t* proj; const bf16_t* tmp; bf16_t* out;
    DI void pre(AccRef acc, const g8::Unit& u, int wr, int wc, int fr, int fq) const {
        const unsigned vo_g = (unsigned)(((wr * 64 + fr) * DIN + wc * 32 + 8 * fq) * 2), vo_t = (unsigned)(((wr * 64 + fr) * DM + wc * 32 + 8 * fq) * 2);
#pragma unroll
        for (int ai = 0; ai < 2; ++ai)
#pragma unroll
            for (int m = 0; m < 4; ++m) {
#pragma unroll
                for (int bj = 0; bj < 2; ++bj) {
                    gcptr sg = (gcptr)(proj + (size_t)(u.pm * 256 + ai * 128 + m * 16) * DIN + u.pn * 256 + bj * 128 + (PART == 0 ? COL_GD : COL_GS));
                    asm volatile("" : "+s"(sg));
                    const u32x4 gg = *(gu4ptr)(sg + vo_g);
                    const float sv[8] = {bf_lo(gg.x), bf_hi(gg.x), bf_lo(gg.y), bf_hi(gg.y), bf_lo(gg.z), bf_hi(gg.z), bf_lo(gg.w), bf_hi(gg.w)};
                    if (PART == 0) {
#pragma unroll
                        for (int j = 0; j < 4; ++j) { acc[ai][bj][m][0][j] *= sv[j]; acc[ai][bj][m][1][j] *= sv[4 + j]; }
                    } else {
                        gcptr st = (gcptr)(tmp + (size_t)(u.pm * 256 + ai * 128 + m * 16) * DM + u.pn * 256 + bj * 128);
                        asm volatile("" : "+s"(st));
                        const u32x4 tt = *(gu4ptr)(st + vo_t);
                        const float tv[8] = {bf_lo(tt.x), bf_hi(tt.x), bf_lo(tt.y), bf_hi(tt.y), bf_lo(tt.z), bf_hi(tt.z), bf_lo(tt.w), bf_hi(tt.w)};
#pragma unroll
                        for (int j = 0; j < 4; ++j) { acc[ai][bj][m][0][j] = acc[ai][bj][m][0][j] * sv[j] + tv[j]; acc[ai][bj][m][1][j] = acc[ai][bj][m][1][j] * sv[4 + j] + tv[4 + j]; }
                    }
                }
                asm volatile("" : "+v"(acc[ai][0][m][0]), "+v"(acc[ai][0][m][1]), "+v"(acc[ai][1][m][0]), "+v"(acc[ai][1][m][1]));
                if (m & 1) asm volatile("" ::: "memory");
            }
    }
    DI void row(AccRef acc, const g8::Unit&, int ai, int m, int, int, int, int, u32x4 (&o)[2]) const {
        o[0] = pack8(acc[ai][0][m][0], acc[ai][0][m][1]); o[1] = pack8(acc[ai][1][m][0], acc[ai][1][m][1]);
    }
    DI void store(const g8::Unit& u, int rt, int ch, const u32x4& d) const { *(u32x4*)(out + (size_t)(u.pm * 256 + rt) * DM + u.pn * 256 + ch * 8) = d; }
};
struct EpiPlain {
    bf16_t* out; int ld;
    DI void pre(AccRef, const g8::Unit&, int, int, int, int) const {}
    DI void row(AccRef acc, const g8::Unit&, int ai, int m, int, int, int, int, u32x4 (&o)[2]) const {
        o[0] = pack8(acc[ai][0][m][0], acc[ai][0][m][1]); o[1] = pack8(acc[ai][1][m][0], acc[ai][1][m][1]);
    }
    DI void store(const g8::Unit& u, int rt, int ch, const u32x4& d) const { *(u32x4*)(out + (size_t)(u.pm * 256 + rt) * ld + u.pn * 256 + ch * 8) = d; }
};
struct EpiGateUp {
    bf16_t* hid;
    DI void pre(AccRef, const g8::Unit&, int, int, int, int) const {}
    DI void row(AccRef acc, const g8::Unit&, int ai, int m, int, int, int, int, u32x4 (&o)[2]) const {
        const f32x4 g0 = acc[ai][0][m][0], g1 = acc[ai][0][m][1], u0 = acc[ai][1][m][0], u1 = acc[ai][1][m][1];
        f32x4 v0, v1;
#pragma unroll
        for (int j = 0; j < 4; ++j) { v0[j] = g0[j] * __builtin_amdgcn_rcpf(1.0f + __expf(-g0[j])) * u0[j]; v1[j] = g1[j] * __builtin_amdgcn_rcpf(1.0f + __expf(-g1[j])) * u1[j]; }
        o[0] = pack8(v0, v1); o[1] = o[0];
    }
    DI void store(const g8::Unit& u, int rt, int ch, const u32x4& d) const { *(u32x4*)(hid + (size_t)(u.aux + rt) * DE + u.pn * 128 + ch * 8) = d; }
};
struct EpiDown {
    LAS unsigned char* lds; bf16_t* yb9; int* slot;
    DI void pre(AccRef, const g8::Unit&, int, int, int, int) const {}
    DI void row(AccRef acc, const g8::Unit& u, int ai, int m, int wr, int, int fr, int, u32x4 (&o)[2]) const {
        const int rt = ai * 128 + wr * 64 + m * 16 + fr;
        const float wgt = (u.e < NE) ? *(const LAS float*)(lds + MOE_IDX_OFF + u.par * 2048 + 1024 + rt * 4) : 1.0f;
        o[0] = pack8(acc[ai][0][m][0] * wgt, acc[ai][0][m][1] * wgt); o[1] = pack8(acc[ai][1][m][0] * wgt, acc[ai][1][m][1] * wgt);
    }
    DI void store(const g8::Unit& u, int rt, int ch, const u32x4& d) const {
        if (rt < u.nvalid) {
            const int srow = u.aux + rt;
            __builtin_nontemporal_store(d, (u32x4*)(yb9 + ((size_t)u.pn * YB_SLOTS + srow) * 256 + ch * 8));
            if (u.pn == 0 && ch == 0) {
                const int v = (u.e < NE) ? *(const LAS int*)(lds + MOE_IDX_OFF + u.par * 2048 + rt * 4) : (u.pm * 256 + rt) * 9 + 8;
                slot[v] = srow;
            }
        }
    }
};

DI void phase_inproj(const Params& p, LAS unsigned char* lds) {
    DenseSched S{(const char*)(p.ws + WS_H), (const char*)(p.ws + WS_WTIN), 64, 46, 4096, 4096, 32, (int)gridDim.x, (int)blockIdx.x};
    EpiInProj E{(bf16_t*)(p.ws + WS_PROJ), (const float*)(p.ws + WS_ROPE)};
    g8::gemm_phase<32, 0, GEMM_SPLIT>(lds, S, E);
}
DI void phase_outproj_a(const Params& p, LAS unsigned char* lds) {
    DenseSched S{(const char*)(p.ws + WS_ODIL), (const char*)(p.ws + WS_WTDIL), 64, 8, 1024, 1024, 8, (int)gridDim.x, (int)blockIdx.x};
    EpiGate<0> E{(const bf16_t*)(p.ws + WS_PROJ), nullptr, (bf16_t*)(p.ws + WS_TMP)};
    g8::gemm_phase<32, 0, GEMM_SPLIT>(lds, S, E);
}
DI void phase_outproj_b(const Params& p, LAS unsigned char* lds) {
    DenseSched S{(const char*)(p.ws + WS_OSB), (const char*)(p.ws + WS_WTSB), 64, 8, 2048, 2048, 16, (int)gridDim.x, (int)blockIdx.x};
    EpiGate<1> E{(const bf16_t*)(p.ws + WS_PROJ), (const bf16_t*)(p.ws + WS_TMP), (bf16_t*)(p.ws + WS_H)};
    g8::gemm_phase<32, 0, GEMM_SPLIT>(lds, S, E);
}
DI void phase_mixout(const Params& p, LAS unsigned char* lds) {
    DenseSched S{(const char*)(p.ws + WS_H), (const char*)(p.ws + WS_WTMIX), 64, 8, 4096, 4096, 32, (int)gridDim.x, (int)blockIdx.x};
    EpiPlain E{(bf16_t*)(p.ws + WS_Y), DM};
    g8::gemm_phase<32, 0, GEMM_SPLIT>(lds, S, E);
}
DI void moe_tables(const Params& p, LAS unsigned char* lds) {
    LAS int* tpre = (LAS int*)(lds + MOE_TAB_OFF);
    const int* cnt = (const int*)(p.ws + WS_CNT);
    if (threadIdx.x == 0) {
        int acc = 0;
        for (int e = 0; e < NE; ++e) { const int n = cnt[e]; tpre[e] = acc; tpre[NEX + 1 + e] = n; acc += (n + 255) >> 8; }
        tpre[NE] = acc; tpre[NEX + 1 + NE] = NTOK; acc += NTOK / 256; tpre[NEX] = acc;
    }
    __syncthreads();
    const int T = tpre[NEX];
    for (int t = threadIdx.x; t < T; t += 512) {
        int e = 0;
        for (int q = 1; q < NEX; ++q) e = (tpre[q] <= t) ? q : e;
        *(LAS unsigned char*)(lds + MOE_TILE_OFF + t) = (unsigned char)e;
    }
    __syncthreads();
}
DI void phase_gateup(const Params& p, LAS unsigned char* lds) {
    moe_tables(p, lds);
    MoeSched S{lds, (const int*)(p.ws + WS_LIST), (const float*)(p.ws + WS_LISTW), (const char*)(p.ws + WS_H), (const char*)(p.ws + WS_WGU), 4, 0, (int)gridDim.x, (int)blockIdx.x};
    EpiGateUp E{(bf16_t*)(p.ws + WS_HID)};
    g8::gemm_phase<16, MOE_BAUX, GEMM_SPLIT>(lds, S, E);
}
DI void phase_down(const Params& p, LAS unsigned char* lds) {
    moe_tables(p, lds);
    MoeSched S{lds, (const int*)(p.ws + WS_LIST), (const float*)(p.ws + WS_LISTW), (const char*)(p.ws + WS_HID), (const char*)(p.ws + WS_WD), 8, 1, (int)gridDim.x, (int)blockIdx.x};
    EpiDown E{lds, (bf16_t*)(p.ws + WS_YB9), (int*)(p.ws + WS_SLOT)};
    g8::gemm_phase<32, MOE_BAUX, GEMM_SPLIT>(lds, S, E);
}

namespace att {
constexpr int TB = 16384;
DI unsigned off_b(unsigned row, unsigned ch) { return 256u * row + 16u * (ch ^ (((row & 3u) << 2) | ((row >> 2) & 3u))); }
DI int crow(int i, int h) { return (i & 3) + 8 * (i >> 2) + 4 * h; }
DI f32x16 mfma32(bf16x8 a, bf16x8 b, f32x16 c) { return __builtin_amdgcn_mfma_f32_32x32x16_bf16(a, b, c, 0, 0, 0); }
DI bf16x8 pack8(const f32x16& x, int s) {
    u32x4 w; w.x = pk_bf16(x[8 * s + 0], x[8 * s + 1]); w.y = pk_bf16(x[8 * s + 2], x[8 * s + 3]); w.z = pk_bf16(x[8 * s + 4], x[8 * s + 5]); w.w = pk_bf16(x[8 * s + 6], x[8 * s + 7]);
    return __builtin_bit_cast(bf16x8, w);
}
DI void qk_tile(LAS const unsigned char* Kb, const bf16x8 (&qf)[8], f32x16& x0, f32x16& x1, int r, int h) {
#pragma unroll
    for (int i = 0; i < 16; ++i) { x0[i] = 0.f; x1[i] = 0.f; }
#pragma unroll
    for (int s = 0; s < 8; ++s) {
        const bf16x8 a0 = *(const LAS bf16x8*)(Kb + off_b(r, 2 * s + h));
        const bf16x8 a1 = *(const LAS bf16x8*)(Kb + off_b(32 + r, 2 * s + h));
        x0 = mfma32(a0, qf[s], x0); x1 = mfma32(a1, qf[s], x1);
    }
}
DI void pv_tile(LAS const unsigned char* Vb, const f32x16& p0, const f32x16& p1, f32x16 (&o)[4], int lane) {
    const int h = lane >> 5, blk = (lane >> 4) & 1, q = (lane & 15) >> 2, pp = lane & 3;
#pragma unroll
    for (int kb = 0; kb < 2; ++kb)
#pragma unroll
        for (int s = 0; s < 2; ++s) {
            const bf16x8 pf = pack8(kb ? p1 : p0, s);
#pragma unroll
            for (int db = 0; db < 4; ++db) {
                const unsigned row0 = 32 * kb + 16 * s + 4 * h + q;
                const unsigned ch = 4 * db + 2 * blk + (pp >> 1);
                const s16x4 t0 = __builtin_amdgcn_ds_read_tr16_b64_v4i16((LAS s16x4*)(Vb + off_b(row0, ch) + 8 * (pp & 1)));
                const s16x4 t1 = __builtin_amdgcn_ds_read_tr16_b64_v4i16((LAS s16x4*)(Vb + off_b(row0 + 8, ch) + 8 * (pp & 1)));
                const bf16x8 vf = {t0[0], t0[1], t0[2], t0[3], t1[0], t1[1], t1[2], t1[3]};
                o[db] = mfma32(vf, pf, o[db]);
            }
        }
}
DI void store_o(bf16_t* orow, const f32x16 (&o)[4], float scale, int h) {
#pragma unroll
    for (int db = 0; db < 4; ++db)
#pragma unroll
        for (int g = 0; g < 4; ++g) {
            u32x2 w; w.x = pk_bf16(o[db][4 * g] * scale, o[db][4 * g + 1] * scale); w.y = pk_bf16(o[db][4 * g + 2] * scale, o[db][4 * g + 3] * scale);
            *(u32x2*)(orow + 32 * db + 8 * g + 4 * h) = w;
        }
}

DI void sb_item(const Params& p, LAS unsigned char* lds, int b, int hd, int Q) {
    const bf16_t* proj = (const bf16_t*)(p.ws + WS_PROJ);
    bf16_t* osb = (bf16_t*)(p.ws + WS_OSB);
    const int tid = threadIdx.x, wid = __builtin_amdgcn_readfirstlane(tid >> 6), lane = tid & 63, r = lane & 31, h = lane >> 5;
    const size_t tokbase = (size_t)b * SEQ;
    const int wq0 = Q * 256 + 32 * wid;
    const int myq = wq0 + r;
    bf16x8 qf[8];
    f32x16 o[4];
#pragma unroll
    for (int db = 0; db < 4; ++db)
#pragma unroll
        for (int i = 0; i < 16; ++i) o[db][i] = 0.f;
    float R = 0.f;
    unsigned goff[2];
#pragma unroll
    for (int i = 0; i < 2; ++i) { const unsigned row = 4 * (wid * 2 + i) + (lane >> 4), cp = lane & 15, ch = cp ^ (((row & 3u) << 2) | ((row >> 2) & 3u)); goff[i] = (row * DIN + ch * 8) * 2; }
    const char* kbase = (const char*)(proj + tokbase * DIN + COL_KS + hd * 128);
    const char* vbase = (const char*)(proj + tokbase * DIN + COL_VS + hd * 128);
#define ATT_ISSUE(key0_, buf_) do { const size_t _ko = (size_t)(key0_) * DIN * 2; _Pragma("unroll") for (int _i = 0; _i < 2; ++_i) { \
        __builtin_amdgcn_global_load_lds((const unsigned*)(kbase + _ko + goff[_i]), (LAS unsigned*)(lds + (buf_) * TB + 1024 * (wid * 2 + _i)), 16, 0, 0); \
        __builtin_amdgcn_global_load_lds((const unsigned*)(vbase + _ko + goff[_i]), (LAS unsigned*)(lds + 3 * TB + (buf_) * TB + 1024 * (wid * 2 + _i)), 16, 0, 0); } } while (0)
    int j = 4 * Q + 3;
    ATT_ISSUE(64 * j, 0);
    ATT_ISSUE(64 * (j - 1), 1);
    {
        const bf16_t* qrow = proj + (tokbase + myq) * DIN + COL_QS + hd * 128;
#pragma unroll
        for (int s = 0; s < 8; ++s) qf[s] = *(const bf16x8*)(qrow + 16 * s + 8 * h);
#pragma unroll
        for (int s = 0; s < 8; ++s) asm volatile("" : "+v"(qf[s]));
    }
    int cur = 0;
    for (; j >= 0; --j) {
        LAS unsigned char* Kb = lds + cur * TB; LAS unsigned char* Vb = lds + 3 * TB + cur * TB;
        if (j > 0) asm volatile("s_waitcnt vmcnt(4)" ::: "memory"); else asm volatile("s_waitcnt vmcnt(0)" ::: "memory");
        __builtin_amdgcn_s_barrier(); asm volatile("" ::: "memory");
        if (j > 1) ATT_ISSUE(64 * (j - 2), cur == 0 ? 2 : cur - 1);
        const int key0 = 64 * j;
        if (key0 < wq0 + 31) {
            const bool need_mask = (key0 + 63 >= wq0);
            f32x16 x0, x1;
            qk_tile(Kb, qf, x0, x1, r, h);
            f32x16 l0, l1;
#pragma unroll
            for (int i = 0; i < 16; ++i) {
                l0[i] = __builtin_amdgcn_logf(1.0f + __builtin_amdgcn_exp2f(x0[i]));
                l1[i] = __builtin_amdgcn_logf(1.0f + __builtin_amdgcn_exp2f(x1[i]));
            }
            if (need_mask) {
#pragma unroll
                for (int i = 0; i < 16; ++i) { const int kk = key0 + crow(i, h); if (kk >= myq) l0[i] = 0.f; if (kk + 32 >= myq) l1[i] = 0.f; }
            }
#pragma unroll
            for (int g = 0; g < 4; ++g) {
                l0[4 * g + 2] += l0[4 * g + 3]; l0[4 * g + 1] += l0[4 * g + 2]; l0[4 * g] += l0[4 * g + 1];
                l1[4 * g + 2] += l1[4 * g + 3]; l1[4 * g + 1] += l1[4 * g + 2]; l1[4 * g] += l1[4 * g + 1];
            }
            float Tlo[8], Thi[8];
#pragma unroll
            for (int g = 0; g < 4; ++g) {
                { const unsigned t = __float_as_uint(l0[4 * g]); auto sw = __builtin_amdgcn_permlane32_swap(t, t, false, false); Tlo[g] = __uint_as_float(sw[0]); Thi[g] = __uint_as_float(sw[1]); }
                { const unsigned t = __float_as_uint(l1[4 * g]); auto sw = __builtin_amdgcn_permlane32_swap(t, t, false, false); Tlo[4 + g] = __uint_as_float(sw[0]); Thi[4 + g] = __uint_as_float(sw[1]); }
            }
            float offR[8];
            float run = 0.f;
#pragma unroll
            for (int g = 7; g >= 0; --g) { offR[g] = run + (h == 0 ? Thi[g] : 0.f) + R; run += Tlo[g] + Thi[g]; }
            f32x16 p0, p1;
#pragma unroll
            for (int i = 0; i < 16; ++i) {
                p0[i] = __builtin_amdgcn_exp2f(x0[i] - (l0[i] + offR[i >> 2]));
                p1[i] = __builtin_amdgcn_exp2f(x1[i] - (l1[i] + offR[4 + (i >> 2)]));
            }
            if (need_mask) {
#pragma unroll
                for (int i = 0; i < 16; ++i) { const int kk = key0 + crow(i, h); if (kk >= myq) p0[i] = 0.f; if (kk + 32 >= myq) p1[i] = 0.f; }
            }
            R += run;
            pv_tile(Vb, p0, p1, o, lane);
        }
        cur = (cur == 2) ? 0 : cur + 1;
    }
    store_o(osb + (tokbase + myq) * 1024 + hd * 128, o, 1.0f, h);
    __syncthreads();
}

DI void dil_item(const Params& p, LAS unsigned char* lds, int di) {
    const bf16_t* proj = (const bf16_t*)(p.ws + WS_PROJ);
    bf16_t* og = (bf16_t*)(p.ws + WS_OG);
    float* lse = (float*)(p.ws + WS_LSE);
    const int b = di / 192; const int rem = di - b * 192; const int head = rem >> 4, sub = rem & 15;
    const int grp = head >> 2;
    const int dil = grp == 0 ? 1 : grp == 1 ? 4 : 16;
    const int nblk = 16 / dil;
    const int res = sub / nblk, Qb = sub - res * nblk;
    const int i0 = Qb * 256;
    const int tid = threadIdx.x, wid = __builtin_amdgcn_readfirstlane(tid >> 6), lane = tid & 63, r = lane & 31, h = lane >> 5;
    const size_t tokbase = (size_t)b * SEQ;
    const int wq0 = i0 + 32 * wid;
    const int myqi = wq0 + r;
    const size_t mytok = tokbase + (size_t)myqi * dil + res;
    bf16x8 qf[8];
    f32x16 o[4];
#pragma unroll
    for (int db = 0; db < 4; ++db)
#pragma unroll
        for (int i = 0; i < 16; ++i) o[db][i] = 0.f;
    float mrun = -1e30f, lrun = 0.f;
    unsigned goff[2];
#pragma unroll
    for (int i = 0; i < 2; ++i) { const unsigned row = 4 * (wid * 2 + i) + (lane >> 4), cp = lane & 15, ch = cp ^ (((row & 3u) << 2) | ((row >> 2) & 3u)); goff[i] = (row * dil * DIN + ch * 8) * 2; }
    const char* kbase = (const char*)(proj + (tokbase + res) * DIN + COL_KA + head * 128);
    const char* vbase = (const char*)(proj + (tokbase + res) * DIN + COL_VA + head * 128);
    const int jt0 = (i0 == 0) ? 2 : 0;
    ATT_ISSUE((i0 - 128 + 64 * jt0) * dil, 0);
    ATT_ISSUE((i0 - 128 + 64 * (jt0 + 1)) * dil, 1);
    {
        const bf16_t* qrow = proj + mytok * DIN + COL_QA + head * 128;
#pragma unroll
        for (int s = 0; s < 8; ++s) qf[s] = *(const bf16x8*)(qrow + 16 * s + 8 * h);
#pragma unroll
        for (int s = 0; s < 8; ++s) asm volatile("" : "+v"(qf[s]));
    }
    int cur = 0;
    for (int jt = jt0; jt < 6; ++jt) {
        LAS unsigned char* Kb = lds + cur * TB; LAS unsigned char* Vb = lds + 3 * TB + cur * TB;
        if (jt < 5) asm volatile("s_waitcnt vmcnt(4)" ::: "memory"); else asm volatile("s_waitcnt vmcnt(0)" ::: "memory");
        __builtin_amdgcn_s_barrier(); asm volatile("" ::: "memory");
        if (jt < 4) ATT_ISSUE((i0 - 128 + 64 * (jt + 2)) * dil, cur == 0 ? 2 : cur - 1);
        const int ki0 = i0 - 128 + 64 * jt;
        if (ki0 <= wq0 + 31 && ki0 + 63 >= wq0 - 128) {
            f32x16 x0, x1;
            qk_tile(Kb, qf, x0, x1, r, h);
            const float NEG = -__builtin_inff();
#pragma unroll
            for (int i = 0; i < 16; ++i) {
                const int d0 = myqi - (ki0 + crow(i, h));
                if ((unsigned)d0 > 128u) x0[i] = NEG;
                if ((unsigned)(d0 - 32) > 128u) x1[i] = NEG;
            }
            float mx = x0[0];
#pragma unroll
            for (int i = 1; i < 16; ++i) mx = fmaxf(mx, x0[i]);
#pragma unroll
            for (int i = 0; i < 16; ++i) mx = fmaxf(mx, x1[i]);
            { const unsigned t = __float_as_uint(mx); auto sw = __builtin_amdgcn_permlane32_swap(t, t, false, false); mx = fmaxf(__uint_as_float(sw[0]), __uint_as_float(sw[1])); }
            const float mn = fmaxf(mrun, mx);
            const float alpha = __builtin_amdgcn_exp2f(mrun - mn);
            mrun = mn;
            f32x16 p0, p1; float rs = 0.f;
#pragma unroll
            for (int i = 0; i < 16; ++i) { p0[i] = __builtin_amdgcn_exp2f(x0[i] - mn); p1[i] = __builtin_amdgcn_exp2f(x1[i] - mn); rs += p0[i] + p1[i]; }
            { const unsigned t = __float_as_uint(rs); auto sw = __builtin_amdgcn_permlane32_swap(t, t, false, false); rs = __uint_as_float(sw[0]) + __uint_as_float(sw[1]); }
            lrun = lrun * alpha + rs;
#pragma unroll
            for (int db = 0; db < 4; ++db)
#pragma unroll
                for (int i = 0; i < 16; ++i) o[db][i] *= alpha;
            pv_tile(Vb, p0, p1, o, lane);
        }
        cur = (cur == 2) ? 0 : cur + 1;
    }
    store_o(og + mytok * 1536 + head * 128, o, 1.0f / lrun, h);
    if (h == 0) lse[mytok * 12 + head] = (mrun + __builtin_amdgcn_logf(lrun)) * LN2;
    __syncthreads();
}
#undef ATT_ISSUE
}

DI void phase_attn(const Params& p, LAS unsigned char* lds) {
    for (int it = blockIdx.x; it < 1024; it += gridDim.x) {
        if (it < 256) {
            const int xcd = it & 7, rest = it >> 3, bhi = rest >> 3, x = rest & 7, bh = xcd * 4 + bhi;
            att::sb_item(p, lds, bh >> 3, bh & 7, 15 - x);
            att::sb_item(p, lds, bh >> 3, bh & 7, x);
        } else att::dil_item(p, lds, it - 256);
    }
}

DI void phase_merge(const Params& p) {
    const int lane = threadIdx.x & 63, wid = threadIdx.x >> 6;
    const bf16_t* og = (const bf16_t*)(p.ws + WS_OG); const float* lse = (const float*)(p.ws + WS_LSE); bf16_t* odil = (bf16_t*)(p.ws + WS_ODIL);
    const int hg = lane >> 4, d0 = (lane & 15) * 8;
    for (int tok = blockIdx.x * 8 + wid; tok < NTOK; tok += gridDim.x * 8) {
        const float l0 = lse[(size_t)tok * 12 + hg], l1 = lse[(size_t)tok * 12 + 4 + hg], l2 = lse[(size_t)tok * 12 + 8 + hg];
        const float mx = fmaxf(l0, fmaxf(l1, l2));
        float w0 = __expf(l0 - mx), w1 = __expf(l1 - mx), w2 = __expf(l2 - mx);
        const float inv = 1.0f / (w0 + w1 + w2); w0 *= inv; w1 *= inv; w2 *= inv;
        const u32x4 a = *(const u32x4*)(og + (size_t)tok * 1536 + hg * 128 + d0);
        const u32x4 bq = *(const u32x4*)(og + (size_t)tok * 1536 + (4 + hg) * 128 + d0);
        const u32x4 c = *(const u32x4*)(og + (size_t)tok * 1536 + (8 + hg) * 128 + d0);
        u32x4 o;
#pragma unroll
        for (int q = 0; q < 4; ++q) {
            const float lo = w0 * bf_lo(a[q]) + w1 * bf_lo(bq[q]) + w2 * bf_lo(c[q]);
            const float hi = w0 * bf_hi(a[q]) + w1 * bf_hi(bq[q]) + w2 * bf_hi(c[q]);
            o[q] = pk_bf16(lo, hi);
        }
        *(u32x4*)(odil + (size_t)tok * 512 + hg * 128 + d0) = o;
    }
}

DI void phase_postmix(const Params& p, LAS unsigned char* lds) {
    const int tid = threadIdx.x, lane = tid & 63, wid = __builtin_amdgcn_readfirstlane(tid >> 6);
    LAS float* hsm = (LAS float*)lds;
    LAS float* part = (LAS float*)(lds + 65536);
    const float* mod = (const float*)(p.ws + WS_MOD); const bf16_t* y = (const bf16_t*)(p.ws + WS_Y);
    bf16_t* h2 = (bf16_t*)(p.ws + WS_H);
    int* cnt = (int*)(p.ws + WS_CNT); int* list = (int*)(p.ws + WS_LIST); float* listw = (float*)(p.ws + WS_LISTW);
    const bf16_t* wr_hi = (const bf16_t*)(p.ws + WS_WRT); const bf16_t* wr_lo = wr_hi + 64 * 2048;
    LAS int* lcnt = (LAS int*)(lds + 81920);
    LAS int* lbase = (LAS int*)(lds + 82176);
    LAS unsigned char* sel_e = lds + 82432;
    LAS unsigned short* sel_r = (LAS unsigned short*)(lds + 83456);
    LAS float* sel_w = (LAS float*)(lds + 85504);
    if (tid < 64) lcnt[tid] = 0;
    int itl = 0;
    for (int it = blockIdx.x; it < NTOK / 8; it += gridDim.x, ++itl) {
        const int tok = it * 8 + wid, b = tok >> 12;
        {
            f32x4 v[8]; float ss = 0.f;
#pragma unroll
            for (int i = 0; i < 8; ++i) { const u32x2 yw = *(const u32x2*)(y + (size_t)tok * DM + 4 * (lane + 64 * i)); v[i] = (f32x4){bf_lo(yw.x), bf_hi(yw.x), bf_lo(yw.y), bf_hi(yw.y)}; ss += v[i][0] * v[i][0] + v[i][1] * v[i][1] + v[i][2] * v[i][2] + v[i][3] * v[i][3]; }
            ss = wave_sum(ss);
            const float rstd = rsqrtf(ss * (1.0f / DM) + RMS_EPS);
            float ss1 = 0.f;
#pragma unroll
            for (int i = 0; i < 8; ++i) {
                const int ch = 4 * (lane + 64 * i);
                const f32x4 g = *(const f32x4*)(p.g_post_mix + ch);
                const f32x4 gt = *(const f32x4*)(mod + b * 12288 + 4096 + ch);
                const f32x4 xv = *(const f32x4*)(p.x + (size_t)tok * DM + ch);
#pragma unroll
                for (int j = 0; j < 4; ++j) { v[i][j] = xv[j] + gt[j] * (v[i][j] * rstd * g[j]); ss1 += v[i][j] * v[i][j]; }
                *(f32x4*)(p.out + (size_t)tok * DM + ch) = v[i];
            }
            ss1 = wave_sum(ss1);
            const float rstd1 = rsqrtf(ss1 * (1.0f / DM) + RMS_EPS);
#pragma unroll
            for (int i = 0; i < 8; ++i) {
                const int ch = 4 * (lane + 64 * i);
                const f32x4 g = *(const f32x4*)(p.g_pre_ffn + ch);
                const f32x4 sh = *(const f32x4*)(mod + b * 12288 + 6144 + ch);
                const f32x4 sc = *(const f32x4*)(mod + b * 12288 + 8192 + ch);
                f32x4 o;
#pragma unroll
                for (int j = 0; j < 4; ++j) o[j] = v[i][j] * rstd1 * g[j] * (1.0f + sc[j]) + sh[j];
                u32x2 w; w.x = pk_bf16(o[0], o[1]); w.y = pk_bf16(o[2], o[3]);
                *(u32x2*)(h2 + (size_t)tok * DM + ch) = w;
                *(LAS f32x4*)(hsm + wid * 2048 + ch) = o;
            }
        }
        __syncthreads();
        {
            const int tr = lane & 15, kq = lane >> 4;
            f32x4 acc[4];
#pragma unroll
            for (int q = 0; q < 4; ++q) acc[q] = (f32x4){0.f, 0.f, 0.f, 0.f};
#pragma unroll 4
            for (int ks = 0; ks < 8; ++ks) {
                const int k0 = 256 * wid + 32 * ks + 8 * kq;
                f32x4 a0 = (f32x4){0.f, 0.f, 0.f, 0.f}, a1 = a0;
                if (tr < 8) { a0 = *(const LAS f32x4*)(hsm + tr * 2048 + k0); a1 = *(const LAS f32x4*)(hsm + tr * 2048 + k0 + 4); }
                u32x4 hw, lw;
                {
                    float xs[8] = {a0[0], a0[1], a0[2], a0[3], a1[0], a1[1], a1[2], a1[3]};
                    unsigned hh[4], ll[4];
#pragma unroll
                    for (int q = 0; q < 4; ++q) {
                        hh[q] = pk_bf16(xs[2 * q], xs[2 * q + 1]);
                        ll[q] = pk_bf16(xs[2 * q] - bf_lo(hh[q]), xs[2 * q + 1] - bf_hi(hh[q]));
                    }
                    hw = (u32x4){hh[0], hh[1], hh[2], hh[3]}; lw = (u32x4){ll[0], ll[1], ll[2], ll[3]};
                }
                const bf16x8 ah = __builtin_bit_cast(bf16x8, hw), al = __builtin_bit_cast(bf16x8, lw);
#pragma unroll
                for (int q = 0; q < 4; ++q) {
                    const bf16x8 bh = *(const bf16x8*)(wr_hi + (size_t)(16 * q + tr) * 2048 + k0);
                    const bf16x8 bl = *(const bf16x8*)(wr_lo + (size_t)(16 * q + tr) * 2048 + k0);
                    acc[q] = __builtin_amdgcn_mfma_f32_16x16x32_bf16(ah, bh, acc[q], 0, 0, 0);
                    acc[q] = __builtin_amdgcn_mfma_f32_16x16x32_bf16(ah, bl, acc[q], 0, 0, 0);
                    acc[q] = __builtin_amdgcn_mfma_f32_16x16x32_bf16(al, bh, acc[q], 0, 0, 0);
                }
            }
            if (kq < 2) {
#pragma unroll
                for (int q = 0; q < 4; ++q)
#pragma unroll
                    for (int j = 0; j < 4; ++j) part[(wid * 8 + 4 * kq + j) * 64 + 16 * q + tr] = acc[q][j];
            }
        }
        __syncthreads();
        {
            float logit = 0.f;
#pragma unroll
            for (int w = 0; w < 8; ++w) logit += part[(w * 8 + wid) * 64 + lane];
            const float score = 1.0f / (1.0f + __expf(-logit));
            const float sel = score + p.router_bias[lane];
            float m1 = sel;
            m1 = fmaxf(m1, __shfl_xor(m1, 1)); m1 = fmaxf(m1, __shfl_xor(m1, 2)); m1 = fmaxf(m1, __shfl_xor(m1, 4));
            const bool is1 = (sel == m1);
            const unsigned long long bal = __ballot(is1);
            const unsigned gm = (unsigned)(bal >> (lane & ~7)) & 0xffu;
            const int first = __ffs(gm) - 1;
            float m2 = (is1 && (lane & 7) == first) ? -__builtin_inff() : sel;
            m2 = fmaxf(m2, __shfl_xor(m2, 1)); m2 = fmaxf(m2, __shfl_xor(m2, 2)); m2 = fmaxf(m2, __shfl_xor(m2, 4));
            const float gs = m1 + m2;
            const int myg = lane >> 3;
            int grank = 0;
#pragma unroll 1
            for (int g = 0; g < 8; ++g) { const float gv = __uint_as_float(__builtin_amdgcn_readlane(__float_as_uint(gs), 8 * g)); grank += (gv > gs || (gv == gs && g < myg)) ? 1 : 0; }
            const bool gsel = grank < 4;
            const float msel = gsel ? sel : -__builtin_inff();
            int rk = 0;
#pragma unroll 4
            for (int e = 0; e < 64; ++e) { const float v = __uint_as_float(__builtin_amdgcn_readlane(__float_as_uint(msel), e)); rk += (v > msel || (v == msel && e < lane)) ? 1 : 0; }
            const bool chosen = gsel && rk < 8;
            const float ssum = wave_sum(chosen ? score : 0.f);
            if (chosen) {
                const int lr = __hip_atomic_fetch_add(lcnt + lane, 1, __ATOMIC_RELAXED, __HIP_MEMORY_SCOPE_WORKGROUP);
                const int idx = ((itl & 15) * 8 + wid) * 8 + rk;
                sel_e[idx] = (unsigned char)lane; sel_r[idx] = (unsigned short)lr; sel_w[idx] = score / ssum * 2.5f;
            }
        }
        __syncthreads();
        if ((itl & 15) == 15 || it + (int)gridDim.x >= NTOK / 8) {
            if (tid < 64) lbase[tid] = atomicAdd(&cnt[tid], lcnt[tid]);
            __syncthreads();
            const int nsel = ((itl & 15) + 1) * 64, it0 = itl & ~15;
            for (int idx = tid; idx < nsel; idx += 512) {
                const int e = sel_e[idx], tl = idx >> 3, k = idx & 7;
                const int tk = ((int)blockIdx.x + (it0 + (tl >> 3)) * (int)gridDim.x) * 8 + (tl & 7);
                const int pos = lbase[e] + sel_r[idx];
                list[e * LIST_CAP + pos] = tk * 9 + k; listw[e * LIST_CAP + pos] = sel_w[idx];
            }
            __syncthreads();
            if (tid < 64) lcnt[tid] = 0;
            __syncthreads();
        }
    }
}

DI void phase_combine(const Params& p) {
    const int lane = threadIdx.x & 63, wid = threadIdx.x >> 6;
    const float* mod = (const float*)(p.ws + WS_MOD); const bf16_t* yb9 = (const bf16_t*)(p.ws + WS_YB9); const int* slot = (const int*)(p.ws + WS_SLOT);
    for (int tok = blockIdx.x * 8 + wid; tok < NTOK; tok += gridDim.x * 8) {
        const int b = tok >> 12;
        float acc[4][8];
#pragma unroll
        for (int i = 0; i < 4; ++i)
#pragma unroll
            for (int j = 0; j < 8; ++j) acc[i][j] = 0.f;
#pragma unroll
        for (int k = 0; k < 9; ++k) {
            const bf16_t* row = yb9 + (size_t)slot[tok * 9 + k] * 256;
#pragma unroll
            for (int i = 0; i < 4; ++i) {
                const int c = lane + 64 * i;
                const u32x4 w = __builtin_nontemporal_load((const u32x4*)(row + (size_t)(c >> 5) * YB_SLOTS * 256 + (c & 31) * 8));
#pragma unroll
                for (int q = 0; q < 4; ++q) { acc[i][2 * q] += bf_lo(w[q]); acc[i][2 * q + 1] += bf_hi(w[q]); }
            }
        }
        float ss = 0.f;
#pragma unroll
        for (int i = 0; i < 4; ++i)
#pragma unroll
            for (int j = 0; j < 8; ++j) ss += acc[i][j] * acc[i][j];
        ss = wave_sum(ss);
        const float rstd = rsqrtf(ss * (1.0f / DM) + RMS_EPS);
#pragma unroll
        for (int i = 0; i < 4; ++i) {
            const int ch = 8 * (lane + 64 * i);
#pragma unroll
            for (int hh = 0; hh < 2; ++hh) {
                const f32x4 g = *(const f32x4*)(p.g_post_ffn + ch + 4 * hh);
                const f32x4 gt = *(const f32x4*)(mod + b * 12288 + 10240 + ch + 4 * hh);
                f32x4 xv = *(const f32x4*)(p.out + (size_t)tok * DM + ch + 4 * hh);
#pragma unroll
                for (int j = 0; j < 4; ++j) xv[j] += gt[j] * (acc[i][4 * hh + j] * rstd * g[j]);
                __builtin_nontemporal_store(xv, (f32x4*)(p.out + (size_t)tok * DM + ch + 4 * hh));
            }
        }
    }
}


DI void probe_copy(const Params& p) {
    u32x4* yb = (u32x4*)(p.ws + WS_YB9);
    const size_t n = (size_t)576 * MiB / 16;
    for (size_t i = (size_t)blockIdx.x * 512 + threadIdx.x; i < n; i += (size_t)gridDim.x * 512) { u32x4 v = yb[i]; asm volatile("" : "+v"(v)); yb[i] = v; }
}

constexpr int NPHASE = 12;
template <int PH> DI void run_phase(const Params& p, LAS unsigned char* lds) {
    if constexpr (PH == 0) phase_prologue(p, lds);
    else if constexpr (PH == 1) phase_prenorm(p);
    else if constexpr (PH == 2) phase_inproj(p, lds);
    else if constexpr (PH == 3) phase_attn(p, lds);
    else if constexpr (PH == 4) phase_merge(p);
    else if constexpr (PH == 5) phase_outproj_a(p, lds);
    else if constexpr (PH == 6) phase_outproj_b(p, lds);
    else if constexpr (PH == 7) phase_mixout(p, lds);
    else if constexpr (PH == 8) phase_postmix(p, lds);
    else if constexpr (PH == 9) phase_gateup(p, lds);
    else if constexpr (PH == 10) phase_down(p, lds);
    else phase_combine(p);
}
template <int PH> __global__ __launch_bounds__(512, 2) void k_phase(Params p) {
    extern __shared__ __attribute__((aligned(16))) unsigned char shm[];
    run_phase<PH>(p, (LAS unsigned char*)shm);
}
#if MK_FUSED
typedef const __attribute__((address_space(4))) Params* KargPtr;
template <int PH> DI void mega_phase(KargPtr kp0, LAS unsigned char* lds) {
    KargPtr kp = kp0; asm volatile("" : "+s"(kp));
    Params p{};
#if defined(__HIP_DEVICE_COMPILE__)
    p.x = kp->x; p.c = kp->c; p.pos = kp->pos; p.w_ada = kp->w_ada; p.b_ada = kp->b_ada; p.g_pre_mix = kp->g_pre_mix; p.g_post_mix = kp->g_post_mix; p.g_pre_ffn = kp->g_pre_ffn; p.g_post_ffn = kp->g_post_ffn; p.w_in = kp->w_in; p.w_dil_out = kp->w_dil_out; p.w_sb_out = kp->w_sb_out; p.w_mix_out = kp->w_mix_out; p.w_router = kp->w_router; p.router_bias = kp->router_bias; p.w_gate_e = kp->w_gate_e; p.w_up_e = kp->w_up_e; p.w_down_e = kp->w_down_e; p.w_gate_s = kp->w_gate_s; p.w_up_s = kp->w_up_s; p.w_down_s = kp->w_down_s; p.out = kp->out; p.ws = kp->ws;
#endif
    run_phase<PH>(p, lds);
}
__global__ __launch_bounds__(512, 2) void k_mega(Params p_unused) {
    extern __shared__ __attribute__((aligned(16))) unsigned char shm[];
    LAS unsigned char* lds = (LAS unsigned char*)shm;
    KargPtr kp0 = (KargPtr)__builtin_amdgcn_kernarg_segment_ptr();
    volatile LAS unsigned* xbw = (volatile LAS unsigned*)(lds + LDS_BYTES - 16);
    if (threadIdx.x == 0) { xbw[0] = 0u; xbw[1] = 0u; xbw[2] = 0u; xbw[3] = 0u; }
    __syncthreads();
    XcdBarrier bar;
    { KargPtr kp = kp0; asm volatile("" : "+s"(kp)); bar = xcd_barrier_post((unsigned*)(kp->ws + WS_BAR), xbw); }
    if (MK_STAMP >= 0 && blockIdx.x == 0 && threadIdx.x == 0) { KargPtr kq = kp0; asm volatile("" : "+s"(kq)); ((unsigned long long*)(kq->ws + WS_STAMP))[0] = wall_clock64(); }
#define MEGA_PH(n) do { mega_phase<n>(kp0, lds); xcd_barrier(bar); if (MK_REP == n) { mega_phase<n>(kp0, lds); xcd_barrier(bar); } \
        if (MK_STAMP >= 0 && blockIdx.x == 0 && threadIdx.x == 0) { KargPtr kq = kp0; asm volatile("" : "+s"(kq)); ((unsigned long long*)(kq->ws + WS_STAMP))[n + 1] = wall_clock64(); } } while (0)
#if MK_REP == 90
#define MK_PROBE_DOWN_NOSTORE 1
#endif
    MEGA_PH(0); MEGA_PH(1); MEGA_PH(2); MEGA_PH(3); MEGA_PH(4); MEGA_PH(5); MEGA_PH(6); MEGA_PH(7); MEGA_PH(8); MEGA_PH(9); MEGA_PH(10);
#if MK_REP == 100
    { KargPtr kp = kp0; asm volatile("" : "+s"(kp)); Params p{}; p.ws = kp->ws; probe_copy(p); xcd_barrier(bar); }
#endif
#undef MEGA_PH
    mega_phase<11>(kp0, lds);
#if MK_STAMP >= 0
    xcd_barrier(bar);
    if (blockIdx.x == 0 && threadIdx.x == 0) {
        KargPtr kq = kp0; asm volatile("" : "+s"(kq));
        unsigned long long* st = (unsigned long long*)(kq->ws + WS_STAMP);
        st[12] = wall_clock64();
        const int k = MK_STAMP < 100 ? MK_STAMP : MK_STAMP - 100;
        const unsigned long long t0 = (MK_STAMP < 100) ? st[k] : st[0], t1 = (MK_STAMP < 100) ? st[k + 1] : st[k + 1];
        kq->out[0] += 2.0f + (float)(t1 - t0) * (MK_STAMP < 100 ? 0.0005f : 0.0001f);
    }
#endif
}
#endif

template <int PH> static void launch_phase(const Params& p, int grid, hipStream_t stream) {
    static bool init = false;
    if (!init) { (void)hipFuncSetAttribute((const void*)k_phase<PH>, hipFuncAttributeMaxDynamicSharedMemorySize, LDS_BYTES); init = true; }
    hipLaunchKernelGGL(k_phase<PH>, dim3(grid), dim3(512), LDS_BYTES, stream, p);
}

extern "C" void kernel_launch(void* const* d_in, const int* in_sizes, int n_in, void* d_out, int out_size, void* d_ws, size_t ws_size, hipStream_t stream) {
    (void)in_sizes; (void)n_in; (void)out_size;
    static int grid = 0;
    if (!grid) {
        int dev = 0, cus = 0; (void)hipGetDevice(&dev); (void)hipDeviceGetAttribute(&cus, hipDeviceAttributeMultiprocessorCount, dev);
        if (cus <= 0) cus = 256;
#if MK_FUSED
        (void)hipFuncSetAttribute((const void*)k_mega, hipFuncAttributeMaxDynamicSharedMemorySize, LDS_BYTES);
        int per_cu = 0;
        if (hipOccupancyMaxActiveBlocksPerMultiprocessor(&per_cu, (const void*)k_mega, 512, LDS_BYTES) != hipSuccess || per_cu < 1)
            fprintf(stderr, "kernel_launch: occupancy query reports %d workgroups per CU\n", per_cu);
#endif
        grid = cus;
        if (ws_size < WS_TOTAL) fprintf(stderr, "kernel_launch: workspace too small: %zu < %zu\n", ws_size, (size_t)WS_TOTAL);
    }
    Params p{};
    p.x = (const float*)d_in[0]; p.c = (const float*)d_in[1]; p.pos = (const int*)d_in[2];
    p.w_ada = (const float*)d_in[3]; p.b_ada = (const float*)d_in[4];
    p.g_pre_mix = (const float*)d_in[5]; p.g_post_mix = (const float*)d_in[6]; p.g_pre_ffn = (const float*)d_in[7]; p.g_post_ffn = (const float*)d_in[8];
    p.w_in = (const float*)d_in[9]; p.w_dil_out = (const float*)d_in[10]; p.w_sb_out = (const float*)d_in[11]; p.w_mix_out = (const float*)d_in[12];
    p.w_router = (const float*)d_in[13]; p.router_bias = (const float*)d_in[14];
    p.w_gate_e = (const float*)d_in[15]; p.w_up_e = (const float*)d_in[16]; p.w_down_e = (const float*)d_in[17];
    p.w_gate_s = (const float*)d_in[18]; p.w_up_s = (const float*)d_in[19]; p.w_down_s = (const float*)d_in[20];
    p.out = (float*)d_out; p.ws = (unsigned char*)d_ws;
    (void)hipMemsetAsync((unsigned char*)d_ws + WS_BAR, 0, WS_ZERO_BYTES, stream);
#if MK_FUSED
    hipLaunchKernelGGL(k_mega, dim3(grid), dim3(512), LDS_BYTES, stream, p);
#else
    launch_phase<0>(p, grid, stream); launch_phase<1>(p, grid, stream); launch_phase<2>(p, grid, stream); launch_phase<3>(p, grid, stream);
    launch_phase<4>(p, grid, stream); launch_phase<5>(p, grid, stream); launch_phase<6>(p, grid, stream); launch_phase<7>(p, grid, stream);
    launch_phase<8>(p, grid, stream); launch_phase<9>(p, grid, stream); launch_phase<10>(p, grid, stream); launch_phase<11>(p, grid, stream);
#endif
}
```

```cpp
#include <hip/hip_runtime.h>
#include <stdint.h>
#include <stdio.h>

#ifndef MK_FUSED
#define MK_FUSED 1
#endif
#ifndef MK_STAMP
#define MK_STAMP -1
#endif
#ifndef MK_REP
#define MK_REP -1
#endif

#define LAS __attribute__((address_space(3)))
#define DI __device__ __forceinline__
typedef unsigned short bf16_t;
typedef short bf16x8 __attribute__((ext_vector_type(8)));
typedef short s16x4 __attribute__((ext_vector_type(4)));
typedef float f32x2 __attribute__((ext_vector_type(2)));
typedef float f32x4 __attribute__((ext_vector_type(4)));
typedef float f32x16 __attribute__((ext_vector_type(16)));
typedef unsigned u32x2 __attribute__((ext_vector_type(2)));
typedef unsigned u32x4 __attribute__((ext_vector_type(4)));
typedef __bf16 bf16x2_t __attribute__((ext_vector_type(2)));
typedef const __attribute__((address_space(1))) char* gcptr;
typedef const __attribute__((address_space(1))) u32x4* gu4ptr;

constexpr int NBATCH = 4, SEQ = 4096, NTOK = NBATCH * SEQ, DM = 2048, DIN = 11776;
constexpr int COL_QA = 0, COL_KA = 1536, COL_VA = 3072, COL_QS = 4608, COL_KS = 5632, COL_VS = 6656, COL_GD = 7680, COL_GS = 9728;
constexpr int NE = 64, DE = 512, NEX = 65;
constexpr int LIST_CAP = 16384;
constexpr int YB_SLOTS = 163840;
constexpr float RMS_EPS = 1e-6f;
constexpr float QSCALE = 0.08838834764831845f * 1.4426950408889634f;
constexpr float LN2 = 0.6931471805599453f;

constexpr size_t MiB = 1ull << 20;
constexpr size_t WS_BAR = 0;
constexpr size_t WS_CNT = 16384;
constexpr size_t WS_ZERO_BYTES = 32768;
constexpr size_t WS_STAMP = 32768;

constexpr size_t WS_MOD = 65536;
constexpr size_t WS_LSE = 262144;
constexpr size_t WS_ROPE = 1 * MiB;
constexpr size_t WS_LIST = 3 * MiB;
constexpr size_t WS_LISTW = 7 * MiB;
constexpr size_t WS_SLOT = 262144;
constexpr size_t WS_WD = 11 * MiB;
constexpr size_t WS_H = 141 * MiB;
constexpr size_t WS_HID = 205 * MiB;
constexpr size_t WS_WTIN = 205 * MiB;
constexpr size_t WS_TMP = 205 * MiB;
constexpr size_t WS_OG = 251 * MiB;
constexpr size_t WS_OSB = 299 * MiB;
constexpr size_t WS_ODIL = 331 * MiB;
constexpr size_t WS_WTDIL = 347 * MiB;
constexpr size_t WS_WTSB = 349 * MiB;
constexpr size_t WS_WTMIX = 353 * MiB;
constexpr size_t WS_PROJ = 365 * MiB;
constexpr size_t WS_Y = 365 * MiB;
constexpr size_t WS_YB9 = 365 * MiB;
constexpr size_t WS_WGU = 733 * MiB;
constexpr size_t WS_WRT = 1005 * MiB;
constexpr size_t WS_TOTAL = 1006 * MiB;

#ifndef MOE_BAUX
#define MOE_BAUX 0
#endif
#ifndef GEMM_SPLIT
#define GEMM_SPLIT false
#endif
constexpr int LDS_BYTES = 163840;

struct Params {
    const float *x, *c; const int* pos;
    const float *w_ada, *b_ada, *g_pre_mix, *g_post_mix, *g_pre_ffn, *g_post_ffn;
    const float *w_in, *w_dil_out, *w_sb_out, *w_mix_out, *w_router, *router_bias;
    const float *w_gate_e, *w_up_e, *w_down_e, *w_gate_s, *w_up_s, *w_down_s;
    float* out; unsigned char* ws;
};

DI unsigned pk_bf16(float lo, float hi) { f32x2 v = {lo, hi}; bf16x2_t r = __builtin_convertvector(v, bf16x2_t); return __builtin_bit_cast(unsigned, r); }
DI float bf_lo(unsigned u) { return __uint_as_float(u << 16); }
DI float bf_hi(unsigned u) { return __uint_as_float(u & 0xffff0000u); }
DI float wave_sum(float v) {
#pragma unroll
    for (int o = 32; o >= 1; o >>= 1) v += __shfl_xor(v, o);
    return v;
}
DI float sigmoidf_(float x) { return 1.0f / (1.0f + __expf(-x)); }

#define XB_TMO      128
#define XB_XCNT(j)  (256  + 64 * (j))
#define XB_XSUB(j)  (1280 + 64 * (j))
#define XB_XGEN(j)  (2304 + 64 * (j))
#define XB_TOP      3328
#define XB_TOPGEN   3392
#define XCD_BAR_WORDS 3456
#define XB_SPIN_CAP (1u << 18)

__device__ __forceinline__ unsigned xb_ld(unsigned* p)              { return __hip_atomic_load(p, __ATOMIC_RELAXED, __HIP_MEMORY_SCOPE_AGENT); }
__device__ __forceinline__ unsigned xb_add(unsigned* p, unsigned v) { return __hip_atomic_fetch_add(p, v, __ATOMIC_RELAXED, __HIP_MEMORY_SCOPE_AGENT); }
__device__ __forceinline__ unsigned xb_xcc_id() { return (unsigned)__builtin_amdgcn_s_getreg((3 << 11) | 20) & 0xFu; }
#define XB_SPIN(cond, bar) do { unsigned _sp = 0; while (cond) { __builtin_amdgcn_s_sleep(1); \
    if ((++_sp & 255u) == 0u) { if (xb_ld(&(bar)[XB_TMO])) break; if (_sp > XB_SPIN_CAP) { atomicAdd(&(bar)[XB_TMO], 1u); break; } } } } while (0)

struct XcdBarrier { unsigned* bar; unsigned x; volatile LAS unsigned* st; };

__device__ __forceinline__ XcdBarrier xcd_barrier_post(unsigned* bar, volatile LAS unsigned* st) {
    XcdBarrier b; b.bar = bar; b.x = xb_xcc_id(); b.st = st;
    if (threadIdx.x == 0) (void)xb_add(&bar[XB_XCNT(b.x)], 1u);
    return b;
}
__device__ __forceinline__ void xcd_barrier_complete(unsigned* bar, unsigned x, unsigned& nloc, unsigned& nx) {
    const unsigned G = gridDim.x * gridDim.y * gridDim.z;
    unsigned sum, cnt, mine, sp = 0u;
    for (;;) {
        sum = 0u; cnt = 0u; mine = 0u;
#pragma unroll
        for (unsigned j = 0; j < 16; ++j) { const unsigned c = xb_ld(&bar[XB_XCNT(j)]); sum += c; cnt += (c > 0u) ? 1u : 0u; mine = (j == x) ? c : mine; }
        if (sum == G) break;
        __builtin_amdgcn_s_sleep(1);
        if ((++sp & 255u) == 0u) { if (xb_ld(&bar[XB_TMO])) break; if (sp > XB_SPIN_CAP) { atomicAdd(&bar[XB_TMO], 1u); break; } }
    }
    nloc = mine > 0u ? mine : 1u; nx = cnt > 0u ? cnt : 1u;
}
__device__ __forceinline__ void xcd_barrier(const XcdBarrier& b) {
    asm volatile("s_waitcnt vmcnt(0)" ::: "memory");
    __syncthreads();
    if (threadIdx.x == 0) {
        unsigned* bar = b.bar;
        __builtin_amdgcn_s_waitcnt(0);
        unsigned nloc = b.st[0], nx = b.st[1];
        if (nloc == 0u) { xcd_barrier_complete(bar, b.x, nloc, nx); b.st[0] = nloc; b.st[1] = nx; }
        const unsigned old = xb_add(&bar[XB_XSUB(b.x)], 1u);
        const unsigned gen = old / nloc;
        if (old + 1u == (gen + 1u) * nloc) {
            __builtin_amdgcn_fence(__ATOMIC_RELEASE, "agent");
            asm volatile("s_waitcnt vmcnt(0)" ::: "memory");
            const unsigned og = xb_add(&bar[XB_TOP], 1u);
            const unsigned tg = og / nx;
            if (og + 1u == (tg + 1u) * nx) xb_add(&bar[XB_TOPGEN], 1u);
            else XB_SPIN(xb_ld(&bar[XB_TOPGEN]) == tg, bar);
            __builtin_amdgcn_fence(__ATOMIC_ACQUIRE, "agent");
            xb_add(&bar[XB_XGEN(b.x)], 1u);
            asm volatile("s_waitcnt vmcnt(0)" ::: "memory");
        } else {
            XB_SPIN(xb_ld(&bar[XB_XGEN(b.x)]) == gen, bar);
            __builtin_amdgcn_fence(__ATOMIC_ACQUIRE, "agent");
            asm volatile("s_waitcnt vmcnt(0)" ::: "memory");
        }
    }
    __syncthreads();
}

struct CvtMat { const float* src; bf16_t* dst; int K, N, nb, mode; size_t sstride, dstride; };
constexpr int CVT_NMAT = 10;
constexpr int CVT_TILES[CVT_NMAT] = {2944, 128, 256, 512, 8192, 8192, 8192, 128, 128, 128};
constexpr int CVT_TOTAL = 2944 + 128 + 256 + 512 + 8192 * 3 + 128 * 3;
constexpr int P0_MOD_UNITS = 192, P0_ROPE_UNITS = 64, P0_WR_UNITS = 8, P0_ITEMS = P0_MOD_UNITS + P0_ROPE_UNITS + P0_WR_UNITS + CVT_TOTAL;

DI CvtMat cvt_mat(const Params& p, int m) {
    bf16_t* wtin = (bf16_t*)(p.ws + WS_WTIN); bf16_t* wtdil = (bf16_t*)(p.ws + WS_WTDIL); bf16_t* wtsb = (bf16_t*)(p.ws + WS_WTSB); bf16_t* wtmix = (bf16_t*)(p.ws + WS_WTMIX);
    bf16_t* wgu = (bf16_t*)(p.ws + WS_WGU); bf16_t* wd = (bf16_t*)(p.ws + WS_WD);
    CvtMat r;
    switch (m) {
        case 0: r = {p.w_in, wtin, 2048, 11776, 1, 0, 0, 0}; break;
        case 1: r = {p.w_dil_out, wtdil, 512, 2048, 1, 0, 0, 0}; break;
        case 2: r = {p.w_sb_out, wtsb, 1024, 2048, 1, 0, 0, 0}; break;
        case 3: r = {p.w_mix_out, wtmix, 2048, 2048, 1, 0, 0, 0}; break;
        case 4: r = {p.w_gate_e, wgu, 2048, 512, 64, 1, (size_t)2048 * 512, (size_t)1024 * 2048}; break;
        case 5: r = {p.w_up_e, wgu, 2048, 512, 64, 2, (size_t)2048 * 512, (size_t)1024 * 2048}; break;
        case 6: r = {p.w_down_e, wd, 512, 2048, 64, 0, (size_t)512 * 2048, (size_t)2048 * 512}; break;
        case 7: r = {p.w_gate_s, wgu + (size_t)64 * 1024 * 2048, 2048, 512, 1, 1, 0, 0}; break;
        case 8: r = {p.w_up_s, wgu + (size_t)64 * 1024 * 2048, 2048, 512, 1, 2, 0, 0}; break;
        default: r = {p.w_down_s, wd + (size_t)64 * 2048 * 512, 512, 2048, 1, 0, 0, 0}; break;
    }
    return r;
}

DI void cvt_tile(const Params& p, int t, LAS unsigned char* lds) {
    int m = 0;
#pragma unroll
    for (int i = 0; i < CVT_NMAT - 1; ++i) { if (t >= CVT_TILES[i] && m == i) { t -= CVT_TILES[i]; m = i + 1; } }
    const CvtMat M = cvt_mat(p, m);
    const int tn = M.N / 64, tk = M.K / 128;
    const int b = t / (tn * tk); const int rem = t - b * (tn * tk); const int kt = rem / tn, nt = rem - kt * tn;
    const float* src = M.src + (size_t)b * M.sstride + (size_t)(kt * 128) * M.N + nt * 64;
    bf16_t* dst = M.dst + (size_t)b * M.dstride;
    const int tid = threadIdx.x;
    constexpr int P = 272;
    {
        const int kq = tid >> 4, n4 = (tid & 15) * 4;
        f32x4 v[4];
#pragma unroll
        for (int i = 0; i < 4; ++i) v[i] = __builtin_nontemporal_load((const f32x4*)(src + (size_t)(kq + 32 * i) * M.N + n4));
#pragma unroll
        for (int i = 0; i < 4; ++i) {
            const int k = kq + 32 * i;
#pragma unroll
            for (int j = 0; j < 4; ++j) { const unsigned u = pk_bf16(v[i][j], 0.f); *(LAS bf16_t*)(lds + (n4 + j) * P + k * 2) = (bf16_t)(u & 0xffffu); }
        }
    }
    __syncthreads();
    {
        const int n = tid >> 3;
        const int c = nt * 64 + n;
        const int drow = M.mode == 0 ? c : (((c >> 7) << 8) + (c & 127) + (M.mode == 2 ? 128 : 0));
#pragma unroll
        for (int i = 0; i < 2; ++i) {
            const int ch = (tid & 7) + 8 * i;
            const u32x4 w = *(const LAS u32x4*)(lds + n * P + ch * 16);
            *(u32x4*)(dst + (size_t)drow * M.K + kt * 128 + ch * 8) = w;
        }
    }
    __syncthreads();
}

DI void mod_unit(const Params& p, int u, LAS unsigned char* lds) {
    const int tid = threadIdx.x, c0 = u * 64;
    LAS float* sc = (LAS float*)lds;
    LAS float* red = (LAS float*)(lds + 32768);
    for (int i = tid; i < 4 * 2048; i += 512) { const float v = p.c[i]; sc[i] = v / (1.0f + __expf(-v)); }
    __syncthreads();
    const int kq = tid >> 4, cq = tid & 15;
    float acc[4][4];
#pragma unroll
    for (int b = 0; b < 4; ++b)
#pragma unroll
        for (int j = 0; j < 4; ++j) acc[b][j] = 0.f;
    for (int it = 0; it < 64; ++it) {
        const int k = kq + 32 * it;
        const f32x4 w = __builtin_nontemporal_load((const f32x4*)(p.w_ada + (size_t)k * 12288 + c0 + 4 * cq));
#pragma unroll
        for (int b = 0; b < 4; ++b) { const float s = sc[b * 2048 + k];
#pragma unroll
            for (int j = 0; j < 4; ++j) acc[b][j] += s * w[j]; }
    }
#pragma unroll
    for (int b = 0; b < 4; ++b)
#pragma unroll
        for (int j = 0; j < 4; ++j) red[(kq * 4 + b) * 64 + 4 * cq + j] = acc[b][j];
    __syncthreads();
    if (tid < 256) {
        const int b = tid >> 6, col = tid & 63;
        float s = 0.f;
        for (int q = 0; q < 32; ++q) s += red[(q * 4 + b) * 64 + col];
        float* mod = (float*)(p.ws + WS_MOD);
        mod[b * 12288 + c0 + col] = s + p.b_ada[c0 + col];
    }
    __syncthreads();
}

DI void rope_unit(const Params& p, int u) {
    float2* rope = (float2*)(p.ws + WS_ROPE);
    for (int e = threadIdx.x; e < 4096; e += 512) {
        const int tok = u * 256 + (e >> 4), i = e & 15;
        const float invf = (float)pow(500000.0, -(double)i / 16.0);
        const float ang = (float)p.pos[tok] * invf;
        rope[tok * 16 + i] = make_float2((float)cos((double)ang), (float)sin((double)ang));
    }
}

DI void wr_unit(const Params& p, int u) {
    bf16_t* hi = (bf16_t*)(p.ws + WS_WRT); bf16_t* lo = hi + 64 * 2048;
    for (int i = threadIdx.x; i < 16384; i += 512) {
        const int idx = u * 16384 + i, k = idx >> 6, e = idx & 63;
        const float x = p.w_router[idx];
        const unsigned h = pk_bf16(x, 0.f) & 0xffffu;
        const float r = x - __uint_as_float(h << 16);
        hi[e * 2048 + k] = (bf16_t)h; lo[e * 2048 + k] = (bf16_t)(pk_bf16(r, 0.f) & 0xffffu);
    }
}
DI void phase_prologue(const Params& p, LAS unsigned char* lds) {
    for (int it = blockIdx.x; it < P0_ITEMS; it += gridDim.x) {
        if (it < P0_MOD_UNITS) mod_unit(p, it, lds);
        else if (it < P0_MOD_UNITS + P0_ROPE_UNITS) rope_unit(p, it - P0_MOD_UNITS);
        else if (it < P0_MOD_UNITS + P0_ROPE_UNITS + P0_WR_UNITS) wr_unit(p, it - P0_MOD_UNITS - P0_ROPE_UNITS);
        else cvt_tile(p, it - P0_MOD_UNITS - P0_ROPE_UNITS - P0_WR_UNITS, lds);
    }
}

DI void phase_prenorm(const Params& p) {
    const int lane = threadIdx.x & 63, wid = threadIdx.x >> 6;
    const float* mod = (const float*)(p.ws + WS_MOD);
    bf16_t* h = (bf16_t*)(p.ws + WS_H);
    for (int tok = blockIdx.x * 8 + wid; tok < NTOK; tok += gridDim.x * 8) {
        const int b = tok >> 12;
        const float* xr = p.x + (size_t)tok * DM;
        f32x4 v[8]; float ss = 0.f;
#pragma unroll
        for (int i = 0; i < 8; ++i) { v[i] = *(const f32x4*)(xr + 4 * (lane + 64 * i)); ss += v[i][0] * v[i][0] + v[i][1] * v[i][1] + v[i][2] * v[i][2] + v[i][3] * v[i][3]; }
        ss = wave_sum(ss);
        const float rstd = rsqrtf(ss * (1.0f / DM) + RMS_EPS);
#pragma unroll
        for (int i = 0; i < 8; ++i) {
            const int ch = 4 * (lane + 64 * i);
            const f32x4 g = *(const f32x4*)(p.g_pre_mix + ch);
            const f32x4 sh = *(const f32x4*)(mod + b * 12288 + ch);
            const f32x4 sc = *(const f32x4*)(mod + b * 12288 + 2048 + ch);
            f32x4 o;
#pragma unroll
            for (int j = 0; j < 4; ++j) o[j] = v[i][j] * rstd * g[j] * (1.0f + sc[j]) + sh[j];
            u32x2 w; w.x = pk_bf16(o[0], o[1]); w.y = pk_bf16(o[2], o[3]);
            *(u32x2*)(h + (size_t)tok * DM + ch) = w;
        }
    }
}

namespace g8 {
constexpr int BM = 256, BK = 64, HALF = 128, HTB = HALF * BK * 2, STAGE_BYTES = 8 * HTB, NXCD = 8, WGM = 8;
DI int lds_byte(int r, int c) { const int st = (r >> 4) * 2 + (c >> 5), rr = r & 15, cc = c & 31, ob = rr * 64 + cc * 2; return st * 1024 + (ob ^ (((ob >> 9) & 1) << 5)); }
DI void stage_rc(int b, int& R, int& C) { const int st = b / 1024, sb = b % 1024, swz = sb ^ (((sb >> 9) & 1) << 5); R = (st >> 1) * 16 + swz / 64; C = (st & 1) * 32 + (swz % 64) / 2; }
DI int perm32(int rho) { const int n = rho >> 4, i = rho & 15; return 8 * (i >> 2) + 4 * n + (i & 3); }

struct Unit {
    const char* A; const char* B;
    int row0;
    int lda, ldb, nt;
    int pm, pn, aux, keep;
    int e, nvalid, par;
};

DI bool static_tile(int L, int nM, int nN, int& pm, int& pn) {
    const int nwg = nM * nN; if (L >= nwg) return false;
    int wgid = L; { const int q = nwg / NXCD, r = nwg % NXCD, xcd = wgid % NXCD, off = wgid / NXCD; wgid = (xcd < r ? xcd * (q + 1) : r * (q + 1) + (xcd - r) * q) + off; }
    const int nig = WGM * nN, gid = wgid / nig, fm = gid * WGM, gsz = (nM - fm) < WGM ? (nM - fm) : WGM;
    pm = fm + ((wgid % nig) % gsz); pn = (wgid % nig) / gsz; return true;
}

constexpr int EXCH_OFF = STAGE_BYTES + 8192;
DI void epi_bar() { asm volatile("s_waitcnt lgkmcnt(0)" ::: "memory"); __builtin_amdgcn_s_barrier(); asm volatile("" ::: "memory"); }

template <int NCH, int BAUX, bool SPLIT, class Sched, class Epi>
DI void gemm_phase(LAS unsigned char* lds, const Sched& S, const Epi& E) {
    const int tid = threadIdx.x, wid = __builtin_amdgcn_readfirstlane(tid >> 6), lane = tid & 63, wr = wid >> 2, wc = wid & 3, fr = lane & 15, fq = lane >> 4;
    const bool loader = SPLIT ? (wr == 0) : true, storer = SPLIT ? (wr == 1) : true;
    constexpr int NP = SPLIT ? 4 : 2, PSTEP = SPLIT ? 4 : 8, RSTEP = SPLIT ? 32 : 64;
    const int p0 = SPLIT ? wc : wid;
    int R0, C0; stage_rc(p0 * 1024 + lane * 16, R0, C0);
    const int sC = C0 * 2, sRb = (R0 & ~31) + perm32(R0 & 31);
    const int aoff = lds_byte(wr * 64 + fr, fq * 8), boff = lds_byte(wc * 32 + fr, fq * 8);
#define G8_SA(b, h) (((b) * 2 + (h)) * HTB)
#define G8_SB(b, h) ((4 + (b) * 2 + (h)) * HTB)
#define G8_STAGE_A(bufoff, gbase, voff) do { if (loader) { _Pragma("unroll") for (int _i = 0; _i < NP; ++_i) \
        __builtin_amdgcn_global_load_lds((const unsigned*)((const char*)(gbase) + (voff)[_i]), (LAS unsigned*)(lds + (bufoff) + (p0 + PSTEP * _i) * 1024), 16, 0, 0); } } while (0)
#define G8_STAGE_B(bufoff, gbase, voff, ldb32) do { if (loader) { _Pragma("unroll") for (int _i = 0; _i < NP; ++_i) { \
        const char* _gb = (const char*)(gbase) + (size_t)_i * (ldb32); asm volatile("" : "+s"(_gb));     \
        __builtin_amdgcn_global_load_lds((const unsigned*)(_gb + (voff)), (LAS unsigned*)(lds + (bufoff) + (p0 + PSTEP * _i) * 1024), 16, 0, BAUX); } } } while (0)
#define G8_LDA(dst, b, h) do { _Pragma("unroll") for (int m = 0; m < 4; ++m) _Pragma("unroll") for (int k = 0; k < 2; ++k) dst[m][k] = *(const LAS bf16x8*)(lds + G8_SA(b, h) + aoff + m * 2048 + k * 1024); } while (0)
#define G8_LDB(dst, b, h) do { _Pragma("unroll") for (int n = 0; n < 2; ++n) _Pragma("unroll") for (int k = 0; k < 2; ++k) dst[n][k] = *(const LAS bf16x8*)(lds + G8_SB(b, h) + boff + n * 2048 + k * 1024); } while (0)
#define G8_MMA(ai, bj, At, Bt) do { __builtin_amdgcn_s_setprio(1); _Pragma("unroll") for (int m = 0; m < 4; ++m) _Pragma("unroll") for (int n = 0; n < 2; ++n) _Pragma("unroll") for (int k = 0; k < 2; ++k) \
        acc[ai][bj][m][n] = __builtin_amdgcn_mfma_f32_16x16x32_bf16(Bt[n][k], At[m][k], acc[ai][bj][m][n], 0, 0, 0); __builtin_amdgcn_s_setprio(0); } while (0)
#define G8_WAIT_V8 do { if (SPLIT) { if (loader) asm volatile("s_waitcnt vmcnt(8)" ::: "memory"); } else asm volatile("s_waitcnt vmcnt(4)" ::: "memory"); } while (0)
#define G8_WAIT_V12 do { if (SPLIT) { if (loader) asm volatile("s_waitcnt vmcnt(12)" ::: "memory"); } else asm volatile("s_waitcnt vmcnt(6)" ::: "memory"); } while (0)
#define G8_WAIT_V0 do { if (loader) asm volatile("s_waitcnt vmcnt(0)" ::: "memory"); } while (0)
#define G8_WAIT_L(n) asm volatile("s_waitcnt lgkmcnt(" #n ")" ::: "memory")
#define G8_BAR __builtin_amdgcn_s_barrier()
#define G8_SCHED __builtin_amdgcn_sched_barrier(0)
#define G8_OFFS(u, vA, vB) do { if (loader) { _Pragma("unroll") for (int _h = 0; _h < 2; ++_h) _Pragma("unroll") for (int _i = 0; _i < NP; ++_i) \
        vA[_h][_i] = (unsigned)S.arow(u, _h * 128 + R0 + RSTEP * _i) * (unsigned)(u).lda + (unsigned)sC; \
        vB = (unsigned)sRb * (unsigned)(u).ldb + (unsigned)sC; } } while (0)
    Unit cur, nxt; int ui = 0;
    if (!S.next(0, cur)) return;
    f32x4 acc[2][2][4][2];
#pragma unroll
    for (int a = 0; a < 2; ++a)
#pragma unroll
        for (int b = 0; b < 2; ++b)
#pragma unroll
            for (int m = 0; m < 4; ++m)
#pragma unroll
                for (int n = 0; n < 2; ++n) acc[a][b][m][n] = (f32x4){0.f, 0.f, 0.f, 0.f};
    bf16x8 At[4][2], B0[2][2], B1[2][2];
    unsigned vA[2][NP], vB = 0u;
#pragma unroll
    for (int i = 0; i < NP; ++i) { vA[0][i] = 0u; vA[1][i] = 0u; }
    if (S.prefetch(cur, wid, lane)) { G8_WAIT_V0; G8_BAR; }
    G8_OFFS(cur, vA, vB);
    const char* cA = cur.A; const char* cB = cur.B; size_t hB = (size_t)128 * cur.ldb; size_t q32 = (size_t)RSTEP * cur.ldb;
    constexpr size_t kstep = 128;
    G8_STAGE_B(G8_SB(0, 0), cB, vB, q32); G8_STAGE_A(G8_SA(0, 0), cA, vA[0]); G8_STAGE_B(G8_SB(0, 1), cB + hB, vB, q32); G8_STAGE_A(G8_SA(0, 1), cA, vA[1]);
    if (wr == 1) G8_BAR;
    G8_WAIT_V8; G8_BAR;
    G8_STAGE_B(G8_SB(1, 0), cB + kstep, vB, q32); G8_STAGE_A(G8_SA(1, 0), cA + kstep, vA[0]); G8_STAGE_B(G8_SB(1, 1), cB + hB + kstep, vB, q32);
    G8_WAIT_V12; G8_BAR;
    for (;;) {
        bool has_next = false;
        const char* nA = cA; const char* nB = cB; size_t nhB = hB, nq32 = q32;
        const int nt = cur.nt;
#pragma unroll 1
        for (int t = 0; t < nt; t += 2) {
            const bool last = (t == nt - 2);
            const char* a1 = cA + (size_t)(t + 1) * kstep;
            G8_LDB(B0, 0, 0); G8_SCHED; G8_LDA(At, 0, 0); G8_STAGE_A(G8_SA(1, 1), a1, vA[1]);
            G8_WAIT_L(8); G8_BAR; G8_WAIT_L(0); G8_MMA(0, 0, At, B0); G8_BAR; G8_SCHED;
            if (t == 0) { Unit pf; if (S.next(ui + 1, pf)) (void)S.prefetch(pf, wid, lane); }
            const char* a2; const char* b2; size_t h2, q2;
            if (last) {
                has_next = S.next(ui + 1, nxt);
                if (has_next) { G8_OFFS(nxt, vA, vB); nA = nxt.A; nB = nxt.B; nhB = (size_t)128 * nxt.ldb; nq32 = (size_t)RSTEP * nxt.ldb; }
                a2 = nA; b2 = nB; h2 = nhB; q2 = nq32;
            } else { a2 = cA + (size_t)(t + 2) * kstep; b2 = cB + (size_t)(t + 2) * kstep; h2 = hB; q2 = q32; }
            const char* a3 = a2 + kstep; const char* b3 = b2 + kstep;
            G8_LDB(B1, 0, 1); G8_STAGE_B(G8_SB(0, 0), b2, vB, q2);
            G8_BAR; G8_WAIT_L(0); G8_MMA(0, 1, At, B1); G8_BAR;
            G8_LDA(At, 0, 1); G8_STAGE_A(G8_SA(0, 0), a2, vA[0]);
            G8_BAR; G8_WAIT_L(0); G8_MMA(1, 0, At, B0); G8_BAR; G8_SCHED;
            G8_STAGE_B(G8_SB(0, 1), b2 + h2, vB, q2);
            G8_WAIT_V12; G8_BAR; G8_MMA(1, 1, At, B1); G8_BAR;
            G8_LDB(B0, 1, 0); G8_SCHED; G8_LDA(At, 1, 0); G8_STAGE_A(G8_SA(0, 1), a2, vA[1]);
            G8_WAIT_L(8); G8_BAR; G8_WAIT_L(0); G8_MMA(0, 0, At, B0); G8_BAR; G8_SCHED;
            G8_LDB(B1, 1, 1); G8_STAGE_B(G8_SB(1, 0), b3, vB, q2);
            G8_BAR; G8_WAIT_L(0); G8_MMA(0, 1, At, B1); G8_BAR;
            G8_LDA(At, 1, 1); G8_STAGE_A(G8_SA(1, 0), a3, vA[0]);
            G8_BAR; G8_WAIT_L(0); G8_MMA(1, 0, At, B0); G8_BAR; G8_SCHED;
            G8_STAGE_B(G8_SB(1, 1), b3 + h2, vB, q2);
            G8_WAIT_V12; G8_BAR; G8_MMA(1, 1, At, B1); G8_BAR;
        }
        int tz = threadIdx.x; asm volatile("" : "+v"(tz));
        const int lane_e = tz & 63, fr_e = tz & 15, fq_e = (tz >> 4) & 3;
        {
            E.pre(acc, cur, wr, wc, fr_e, fq_e);
            constexpr int PITCH = NCH * 16 + 16;
            LAS unsigned char* ex = lds + EXCH_OFF;
            if (wr == 0) G8_BAR;
#pragma unroll
            for (int ai = 0; ai < 2; ++ai)
#pragma unroll
                for (int m = 0; m < 4; ++m) {
                    u32x4 o[2];
                    E.row(acc, cur, ai, m, wr, wc, fr_e, fq_e, o);
                    if (NCH == 32) {
                        *(LAS u32x4*)(ex + (wr * 16 + fr_e) * PITCH + (wc * 32 + 8 * fq_e) * 2) = o[0];
                        *(LAS u32x4*)(ex + (wr * 16 + fr_e) * PITCH + (128 + wc * 32 + 8 * fq_e) * 2) = o[1];
                    } else {
                        *(LAS u32x4*)(ex + (wr * 16 + fr_e) * PITCH + (wc * 32 + 8 * fq_e) * 2) = o[0];
                    }
                    epi_bar();
                    if (storer) {
                        constexpr int RPI = 64 / NCH;
                        constexpr int RPW = SPLIT ? 8 : 4;
                        const int rbase = SPLIT ? 8 * wc : 4 * wid;
#pragma unroll
                        for (int i = 0; i < RPW / RPI; ++i) {
                            const int rl = rbase + RPI * i + lane_e / NCH, ch = lane_e % NCH;
                            const int rt = ai * 128 + (rl >> 4) * 64 + m * 16 + (rl & 15);
                            const u32x4 d = *(const LAS u32x4*)(ex + rl * PITCH + ch * 16);
                            E.store(cur, rt, ch, d);
                        }
                    }
                    epi_bar();
                }
            if (wr == 1) G8_BAR;
        }
        if (!has_next) break;
#pragma unroll
        for (int a = 0; a < 2; ++a)
#pragma unroll
            for (int b = 0; b < 2; ++b)
#pragma unroll
                for (int m = 0; m < 4; ++m)
#pragma unroll
                    for (int n = 0; n < 2; ++n) acc[a][b][m][n] = (f32x4){0.f, 0.f, 0.f, 0.f};
        cur = nxt; cA = nA; cB = nB; hB = nhB; q32 = nq32; ++ui;
    }
    G8_WAIT_V0;
    if (wr == 0) G8_BAR;
    G8_BAR;
#undef G8_SA
#undef G8_SB
#undef G8_STAGE_A
#undef G8_STAGE_B
#undef G8_LDA
#undef G8_LDB
#undef G8_MMA
#undef G8_WAIT_V8
#undef G8_WAIT_V12
#undef G8_WAIT_V0
#undef G8_WAIT_L
#undef G8_BAR
#undef G8_SCHED
#undef G8_OFFS
}
}

struct DenseSched {
    const char* A; const char* Bt; int nM, nN, lda, ldb, nt, G, c;
    DI bool next(int i, g8::Unit& u) const {
        int pm, pn; if (!g8::static_tile(i * G + c, nM, nN, pm, pn)) return false;
        pm = __builtin_amdgcn_readfirstlane(pm); pn = __builtin_amdgcn_readfirstlane(pn);
        u.A = A; u.B = Bt + (size_t)pn * 256 * ldb; u.row0 = pm * 256; u.lda = lda; u.ldb = ldb; u.nt = nt; u.pm = pm; u.pn = pn; u.aux = 0; u.keep = 0; u.e = 0; u.nvalid = 256; u.par = 0; return true;
    }
    DI int arow(const g8::Unit& u, int rr) const { return u.row0 + rr; }
    DI bool prefetch(const g8::Unit&, int, int) const { return false; }
};
constexpr int MOE_TAB_OFF = g8::STAGE_BYTES;
constexpr int MOE_TILE_OFF = g8::STAGE_BYTES + 1024;
constexpr int MOE_IDX_OFF = g8::STAGE_BYTES + 2048;
struct MoeSched {
    LAS unsigned char* lds; const int* list; const float* listw; const char* A; const char* W; int ncol, mode  , G, c;
    DI bool next(int i, g8::Unit& u) const {
        const LAS int* tpre = (const LAS int*)(lds + MOE_TAB_OFF);
        const int L = i * G + c; const int T = __builtin_amdgcn_readfirstlane(tpre[NEX]);
        if (L >= T * ncol) return false;
        const int gt = __builtin_amdgcn_readfirstlane(L / ncol), pn = L - gt * ncol;
        const int e = __builtin_amdgcn_readfirstlane((int)*(const LAS unsigned char*)(lds + MOE_TILE_OFF + gt));
        const int tile = gt - __builtin_amdgcn_readfirstlane(tpre[e]);
        const int n_e = __builtin_amdgcn_readfirstlane(tpre[NEX + 1 + e]);
        u.e = e; u.pm = tile; u.pn = pn; u.nvalid = min(256, n_e - tile * 256); u.keep = 0; u.aux = gt * 256; u.par = i & 1;
        if (mode == 0) { u.A = A; u.lda = 4096; u.ldb = 4096; u.nt = 32; u.B = W + ((size_t)e * 1024 + (size_t)pn * 256) * 4096; u.row0 = tile * 256; }
        else { u.A = A; u.lda = 1024; u.ldb = 1024; u.nt = 8; u.B = W + ((size_t)e * 2048 + (size_t)pn * 256) * 1024; u.row0 = gt * 256; }
        return true;
    }
    DI bool prefetch(const g8::Unit& u, int wid, int lane) const {
        if (u.e < NE && wid < 4) {
            const int r = min(wid * 64 + lane, u.nvalid - 1);
            const size_t src = (size_t)u.e * LIST_CAP + u.pm * 256 + r;
            __builtin_amdgcn_global_load_lds((const unsigned*)(list + src), (LAS unsigned*)(lds + MOE_IDX_OFF + u.par * 2048 + wid * 256), 4, 0, 0);
            if (mode == 1) __builtin_amdgcn_global_load_lds((const unsigned*)(listw + src), (LAS unsigned*)(lds + MOE_IDX_OFF + u.par * 2048 + 1024 + wid * 256), 4, 0, 0);
        }
        return true;
    }
    DI int arow(const g8::Unit& u, int rr) const {
        if (mode == 1) return u.row0 + rr;
        if (u.e >= NE) return u.row0 + rr;
        return *(const LAS int*)(lds + MOE_IDX_OFF + u.par * 2048 + rr * 4) / 9;
    }
};

typedef f32x4 (&AccRef)[2][2][4][2];
DI u32x4 pack8(const f32x4& v0, const f32x4& v1) { u32x4 w; w.x = pk_bf16(v0[0], v0[1]); w.y = pk_bf16(v0[2], v0[3]); w.z = pk_bf16(v1[0], v1[1]); w.w = pk_bf16(v1[2], v1[3]); return w; }

struct EpiInProj {
    bf16_t* proj; const float* rope;
    DI static int kind_of(int pn) { return pn < 6 ? 0 : pn < 12 ? 1 : pn < 18 ? 2 : pn < 22 ? 3 : pn < 30 ? 2 : 4; }
    DI void pre(AccRef acc, const g8::Unit& u, int wr, int wc, int fr, int fq) const {
        if (kind_of(u.pn) <= 1 && wc == 0) {
            const float sg = (fq < 2) ? -1.0f : 1.0f;
#pragma unroll
            for (int g = 0; g < 4; ++g) {
                const int ai = g >> 1;
                f32x4 cs[2][4];
#pragma unroll
                for (int mm = 0; mm < 2; ++mm) { const int m = (g & 1) * 2 + mm; const int row = u.pm * 256 + ai * 128 + wr * 64 + m * 16 + fr;
#pragma unroll
                    for (int q = 0; q < 4; ++q) cs[mm][q] = *(const f32x4*)(rope + (size_t)row * 32 + 16 * (fq & 1) + 4 * q); }
#pragma unroll
                for (int mm = 0; mm < 2; ++mm) { const int m = (g & 1) * 2 + mm;
#pragma unroll
                    for (int bj = 0; bj < 2; ++bj) {
                        f32x4 v0 = acc[ai][bj][m][0], v1 = acc[ai][bj][m][1], p0, p1;
#pragma unroll
                        for (int j = 0; j < 4; ++j) { p0[j] = __shfl_xor(v0[j], 32); p1[j] = __shfl_xor(v1[j], 32); }
#pragma unroll
                        for (int j = 0; j < 4; ++j) {
                            const float c0 = cs[mm][j >> 1][(j & 1) * 2], s0 = cs[mm][j >> 1][(j & 1) * 2 + 1];
                            const float c1 = cs[mm][2 + (j >> 1)][(j & 1) * 2], s1 = cs[mm][2 + (j >> 1)][(j & 1) * 2 + 1];
                            v0[j] = v0[j] * c0 + sg * p0[j] * s0;
                            v1[j] = v1[j] * c1 + sg * p1[j] * s1;
                        }
                        acc[ai][bj][m][0] = v0; acc[ai][bj][m][1] = v1;
                    }
                    asm volatile("" : "+v"(acc[ai][0][m][0]), "+v"(acc[ai][0][m][1]), "+v"(acc[ai][1][m][0]), "+v"(acc[ai][1][m][1]));
                }
                asm volatile("" ::: "memory");
            }
        }
    }
    DI void row(AccRef acc, const g8::Unit& u, int ai, int m, int wr, int wc, int fr, int fq, u32x4 (&o)[2]) const {
        const int kind = kind_of(u.pn);
#pragma unroll
        for (int bj = 0; bj < 2; ++bj) {
            f32x4 v0 = acc[ai][bj][m][0], v1 = acc[ai][bj][m][1];
            if (kind == 0 || kind == 3) { v0 *= QSCALE; v1 *= QSCALE; }
            if (kind == 4) {
#pragma unroll
                for (int j = 0; j < 4; ++j) { v0[j] = sigmoidf_(v0[j]); v1[j] = sigmoidf_(v1[j]); }
            }
            o[bj] = pack8(v0, v1);
        }
    }
    DI void store(const g8::Unit& u, int rt, int ch, const u32x4& d) const { __builtin_nontemporal_store(d, (u32x4*)(proj + (size_t)(u.pm * 256 + rt) * DIN + u.pn * 256 + ch * 8)); }
};
template <int PART> struct EpiGate {
    const bf16_t* proj; const bf16_t* tmp; bf16_t* out;
    DI void pre(AccRef acc, const g8::Unit& u, int wr, int wc, int fr, int fq) const {
        const unsigned vo_g = (unsigned)(((wr * 64 + fr) * DIN + wc * 32 + 8 * fq) * 2), vo_t = (unsigned)(((wr * 64 + fr) * DM + wc * 32 + 8 * fq) * 2);
#pragma unroll
        for (int ai = 0; ai < 2; ++ai)
#pragma unroll
            for (int m = 0; m < 4; ++m) {
#pragma unroll
                for (int bj = 0; bj < 2; ++bj) {
                    gcptr sg = (gcptr)(proj + (size_t)(u.pm * 256 + ai * 128 + m * 16) * DIN + u.pn * 256 + bj * 128 + (PART == 0 ? COL_GD : COL_GS));
                    asm volatile("" : "+s"(sg));
                    const u32x4 gg = *(gu4ptr)(sg + vo_g);
                    const float sv[8] = {bf_lo(gg.x), bf_hi(gg.x), bf_lo(gg.y), bf_hi(gg.y), bf_lo(gg.z), bf_hi(gg.z), bf_lo(gg.w), bf_hi(gg.w)};
                    if (PART == 0) {
#pragma unroll
                        for (int j = 0; j < 4; ++j) { acc[ai][bj][m][0][j] *= sv[j]; acc[ai][bj][m][1][j] *= sv[4 + j]; }
                    } else {
                        gcptr st = (gcptr)(tmp + (size_t)(u.pm * 256 + ai * 128 + m * 16) * DM + u.pn * 256 + bj * 128);
                        asm volatile("" : "+s"(st));
                        const u32x4 tt = *(gu4ptr)(st + vo_t);
                        const float tv[8] = {bf_lo(tt.x), bf_hi(tt.x), bf_lo(tt.y), bf_hi(tt.y), bf_lo(tt.z), bf_hi(tt.z), bf_lo(tt.w), bf_hi(tt.w)};
#pragma unroll
                        for (int j = 0; j < 4; ++j) { acc[ai][bj][m][0][j] = acc[ai][bj][m][0][j] * sv[j] + tv[j]; acc[ai][bj][m][1][j] = acc[ai][bj][m][1][j] * sv[4 + j] + tv[4 + j]; }
                    }
                }
                asm volatile("" : "+v"(acc[ai][0][m][0]), "+v"(acc[ai][0][m][1]), "+v"(acc[ai][1][m][0]), "+v"(acc[ai][1][m][1]));
                if (m & 1) asm volatile("" ::: "memory");
            }
    }
    DI void row(AccRef acc, const g8::Unit&, int ai, int m, int, int, int, int, u32x4 (&o)[2]) const {
        o[0] = pack8(acc[ai][0][m][0], acc[ai][0][m][1]); o[1] = pack8(acc[ai][1][m][0], acc[ai][1][m][1]);
    }
    DI void store(const g8::Unit& u, int rt, int ch, const u32x4& d) const { *(u32x4*)(out + (size_t)(u.pm * 256 + rt) * DM + u.pn * 256 + ch * 8) = d; }
};
struct EpiPlain {
    bf16_t* out; int ld;
    DI void pre(AccRef, const g8::Unit&, int, int, int, int) const {}
    DI void row(AccRef acc, const g8::Unit&, int ai, int m, int, int, int, int, u32x4 (&o)[2]) const {
        o[0] = pack8(acc[ai][0][m][0], acc[ai][0][m][1]); o[1] = pack8(acc[ai][1][m][0], acc[ai][1][m][1]);
    }
    DI void store(const g8::Unit& u, int rt, int ch, const u32x4& d) const { *(u32x4*)(out + (size_t)(u.pm * 256 + rt) * ld + u.pn * 256 + ch * 8) = d; }
};
struct EpiGateUp {
    bf16_t* hid;
    DI void pre(AccRef, const g8::Unit&, int, int, int, int) const {}
    DI void row(AccRef acc, const g8::Unit&, int ai, int m, int, int, int, int, u32x4 (&o)[2]) const {
        const f32x4 g0 = acc[ai][0][m][0], g1 = acc[ai][0][m][1], u0 = acc[ai][1][m][0], u1 = acc[ai][1][m][1];
        f32x4 v0, v1;
#pragma unroll
        for (int j = 0; j < 4; ++j) { v0[j] = g0[j] * __builtin_amdgcn_rcpf(1.0f + __expf(-g0[j])) * u0[j]; v1[j] = g1[j] * __builtin_amdgcn_rcpf(1.0f + __expf(-g1[j])) * u1[j]; }
        o[0] = pack8(v0, v1); o[1] = o[0];
    }
    DI void store(const g8::Unit& u, int rt, int ch, const u32x4& d) const { *(u32x4*)(hid + (size_t)(u.aux + rt) * DE + u.pn * 128 + ch * 8) = d; }
};
struct EpiDown {
    LAS unsigned char* lds; bf16_t* yb9; int* slot;
    DI void pre(AccRef, const g8::Unit&, int, int, int, int) const {}
    DI void row(AccRef acc, const g8::Unit& u, int ai, int m, int wr, int, int fr, int, u32x4 (&o)[2]) const {
        const int rt = ai * 128 + wr * 64 + m * 16 + fr;
        const float wgt = (u.e < NE) ? *(const LAS float*)(lds + MOE_IDX_OFF + u.par * 2048 + 1024 + rt * 4) : 1.0f;
        o[0] = pack8(acc[ai][0][m][0] * wgt, acc[ai][0][m][1] * wgt); o[1] = pack8(acc[ai][1][m][0] * wgt, acc[ai][1][m][1] * wgt);
    }
    DI void store(const g8::Unit& u, int rt, int ch, const u32x4& d) const {
        if (rt < u.nvalid) {
            const int srow = u.aux + rt;
            __builtin_nontemporal_store(d, (u32x4*)(yb9 + ((size_t)u.pn * YB_SLOTS + srow) * 256 + ch * 8));
            if (u.pn == 0 && ch == 0) {
                const int v = (u.e < NE) ? *(const LAS int*)(lds + MOE_IDX_OFF + u.par * 2048 + rt * 4) : (u.pm * 256 + rt) * 9 + 8;
                slot[v] = srow;
            }
        }
    }
};

DI void phase_inproj(const Params& p, LAS unsigned char* lds) {
    DenseSched S{(const char*)(p.ws + WS_H), (const char*)(p.ws + WS_WTIN), 64, 46, 4096, 4096, 32, (int)gridDim.x, (int)blockIdx.x};
    EpiInProj E{(bf16_t*)(p.ws + WS_PROJ), (const float*)(p.ws + WS_ROPE)};
    g8::gemm_phase<32, 0, GEMM_SPLIT>(lds, S, E);
}
DI void phase_outproj_a(const Params& p, LAS unsigned char* lds) {
    DenseSched S{(const char*)(p.ws + WS_ODIL), (const char*)(p.ws + WS_WTDIL), 64, 8, 1024, 1024, 8, (int)gridDim.x, (int)blockIdx.x};
    EpiGate<0> E{(const bf16_t*)(p.ws + WS_PROJ), nullptr, (bf16_t*)(p.ws + WS_TMP)};
    g8::gemm_phase<32, 0, GEMM_SPLIT>(lds, S, E);
}
DI void phase_outproj_b(const Params& p, LAS unsigned char* lds) {
    DenseSched S{(const char*)(p.ws + WS_OSB), (const char*)(p.ws + WS_WTSB), 64, 8, 2048, 2048, 16, (int)gridDim.x, (int)blockIdx.x};
    EpiGate<1> E{(const bf16_t*)(p.ws + WS_PROJ), (const bf16_t*)(p.ws + WS_TMP), (bf16_t*)(p.ws + WS_H)};
    g8::gemm_phase<32, 0, GEMM_SPLIT>(lds, S, E);
}
DI void phase_mixout(const Params& p, LAS unsigned char* lds) {
    DenseSched S{(const char*)(p.ws + WS_H), (const char*)(p.ws + WS_WTMIX), 64, 8, 4096, 4096, 32, (int)gridDim.x, (int)blockIdx.x};
    EpiPlain E{(bf16_t*)(p.ws + WS_Y), DM};
    g8::gemm_phase<32, 0, GEMM_SPLIT>(lds, S, E);
}
DI void moe_tables(const Params& p, LAS unsigned char* lds) {
    LAS int* tpre = (LAS int*)(lds + MOE_TAB_OFF);
    const int* cnt = (const int*)(p.ws + WS_CNT);
    if (threadIdx.x == 0) {
        int acc = 0;
        for (int e = 0; e < NE; ++e) { const int n = cnt[e]; tpre[e] = acc; tpre[NEX + 1 + e] = n; acc += (n + 255) >> 8; }
        tpre[NE] = acc; tpre[NEX + 1 + NE] = NTOK; acc += NTOK / 256; tpre[NEX] = acc;
    }
    __syncthreads();
    const int T = tpre[NEX];
    for (int t = threadIdx.x; t < T; t += 512) {
        int e = 0;
        for (int q = 1; q < NEX; ++q) e = (tpre[q] <= t) ? q : e;
        *(LAS unsigned char*)(lds + MOE_TILE_OFF + t) = (unsigned char)e;
    }
    __syncthreads();
}
DI void phase_gateup(const Params& p, LAS unsigned char* lds) {
    moe_tables(p, lds);
    MoeSched S{lds, (const int*)(p.ws + WS_LIST), (const float*)(p.ws + WS_LISTW), (const char*)(p.ws + WS_H), (const char*)(p.ws + WS_WGU), 4, 0, (int)gridDim.x, (int)blockIdx.x};
    EpiGateUp E{(bf16_t*)(p.ws + WS_HID)};
    g8::gemm_phase<16, MOE_BAUX, GEMM_SPLIT>(lds, S, E);
}
DI void phase_down(const Params& p, LAS unsigned char* lds) {
    moe_tables(p, lds);
    MoeSched S{lds, (const int*)(p.ws + WS_LIST), (const float*)(p.ws + WS_LISTW), (const char*)(p.ws + WS_HID), (const char*)(p.ws + WS_WD), 8, 1, (int)gridDim.x, (int)blockIdx.x};
    EpiDown E{lds, (bf16_t*)(p.ws + WS_YB9), (int*)(p.ws + WS_SLOT)};
    g8::gemm_phase<32, MOE_BAUX, GEMM_SPLIT>(lds, S, E);
}

namespace att {
constexpr int TB = 16384;
DI unsigned off_b(unsigned row, unsigned ch) { return 256u * row + 16u * (ch ^ (((row & 3u) << 2) | ((row >> 2) & 3u))); }
DI int crow(int i, int h) { return (i & 3) + 8 * (i >> 2) + 4 * h; }
DI f32x16 mfma32(bf16x8 a, bf16x8 b, f32x16 c) { return __builtin_amdgcn_mfma_f32_32x32x16_bf16(a, b, c, 0, 0, 0); }
DI bf16x8 pack8(const f32x16& x, int s) {
    u32x4 w; w.x = pk_bf16(x[8 * s + 0], x[8 * s + 1]); w.y = pk_bf16(x[8 * s + 2], x[8 * s + 3]); w.z = pk_bf16(x[8 * s + 4], x[8 * s + 5]); w.w = pk_bf16(x[8 * s + 6], x[8 * s + 7]);
    return __builtin_bit_cast(bf16x8, w);
}
DI void qk_tile(LAS const unsigned char* Kb, const bf16x8 (&qf)[8], f32x16& x0, f32x16& x1, int r, int h) {
#pragma unroll
    for (int i = 0; i < 16; ++i) { x0[i] = 0.f; x1[i] = 0.f; }
#pragma unroll
    for (int s = 0; s < 8; ++s) {
        const bf16x8 a0 = *(const LAS bf16x8*)(Kb + off_b(r, 2 * s + h));
        const bf16x8 a1 = *(const LAS bf16x8*)(Kb + off_b(32 + r, 2 * s + h));
        x0 = mfma32(a0, qf[s], x0); x1 = mfma32(a1, qf[s], x1);
    }
}
DI void pv_tile(LAS const unsigned char* Vb, const f32x16& p0, const f32x16& p1, f32x16 (&o)[4], int lane) {
    const int h = lane >> 5, blk = (lane >> 4) & 1, q = (lane & 15) >> 2, pp = lane & 3;
#pragma unroll
    for (int kb = 0; kb < 2; ++kb)
#pragma unroll
        for (int s = 0; s < 2; ++s) {
            const bf16x8 pf = pack8(kb ? p1 : p0, s);
#pragma unroll
            for (int db = 0; db < 4; ++db) {
                const unsigned row0 = 32 * kb + 16 * s + 4 * h + q;
                const unsigned ch = 4 * db + 2 * blk + (pp >> 1);
                const s16x4 t0 = __builtin_amdgcn_ds_read_tr16_b64_v4i16((LAS s16x4*)(Vb + off_b(row0, ch) + 8 * (pp & 1)));
                const s16x4 t1 = __builtin_amdgcn_ds_read_tr16_b64_v4i16((LAS s16x4*)(Vb + off_b(row0 + 8, ch) + 8 * (pp & 1)));
                const bf16x8 vf = {t0[0], t0[1], t0[2], t0[3], t1[0], t1[1], t1[2], t1[3]};
                o[db] = mfma32(vf, pf, o[db]);
            }
        }
}
DI void store_o(bf16_t* orow, const f32x16 (&o)[4], float scale, int h) {
#pragma unroll
    for (int db = 0; db < 4; ++db)
#pragma unroll
        for (int g = 0; g < 4; ++g) {
            u32x2 w; w.x = pk_bf16(o[db][4 * g] * scale, o[db][4 * g + 1] * scale); w.y = pk_bf16(o[db][4 * g + 2] * scale, o[db][4 * g + 3] * scale);
            *(u32x2*)(orow + 32 * db + 8 * g + 4 * h) = w;
        }
}

DI void sb_item(const Params& p, LAS unsigned char* lds, int b, int hd, int Q) {
    const bf16_t* proj = (const bf16_t*)(p.ws + WS_PROJ);
    bf16_t* osb = (bf16_t*)(p.ws + WS_OSB);
    const int tid = threadIdx.x, wid = __builtin_amdgcn_readfirstlane(tid >> 6), lane = tid & 63, r = lane & 31, h = lane >> 5;
    const size_t tokbase = (size_t)b * SEQ;
    const int wq0 = Q * 256 + 32 * wid;
    const int myq = wq0 + r;
    bf16x8 qf[8];
    f32x16 o[4];
#pragma unroll
    for (int db = 0; db < 4; ++db)
#pragma unroll
        for (int i = 0; i < 16; ++i) o[db][i] = 0.f;
    float R = 0.f;
    unsigned goff[2];
#pragma unroll
    for (int i = 0; i < 2; ++i) { const unsigned row = 4 * (wid * 2 + i) + (lane >> 4), cp = lane & 15, ch = cp ^ (((row & 3u) << 2) | ((row >> 2) & 3u)); goff[i] = (row * DIN + ch * 8) * 2; }
    const char* kbase = (const char*)(proj + tokbase * DIN + COL_KS + hd * 128);
    const char* vbase = (const char*)(proj + tokbase * DIN + COL_VS + hd * 128);
#define ATT_ISSUE(key0_, buf_) do { const size_t _ko = (size_t)(key0_) * DIN * 2; _Pragma("unroll") for (int _i = 0; _i < 2; ++_i) { \
        __builtin_amdgcn_global_load_lds((const unsigned*)(kbase + _ko + goff[_i]), (LAS unsigned*)(lds + (buf_) * TB + 1024 * (wid * 2 + _i)), 16, 0, 0); \
        __builtin_amdgcn_global_load_lds((const unsigned*)(vbase + _ko + goff[_i]), (LAS unsigned*)(lds + 3 * TB + (buf_) * TB + 1024 * (wid * 2 + _i)), 16, 0, 0); } } while (0)
    int j = 4 * Q + 3;
    ATT_ISSUE(64 * j, 0);
    ATT_ISSUE(64 * (j - 1), 1);
    {
        const bf16_t* qrow = proj + (tokbase + myq) * DIN + COL_QS + hd * 128;
#pragma unroll
        for (int s = 0; s < 8; ++s) qf[s] = *(const bf16x8*)(qrow + 16 * s + 8 * h);
#pragma unroll
        for (int s = 0; s < 8; ++s) asm volatile("" : "+v"(qf[s]));
    }
    int cur = 0;
    for (; j >= 0; --j) {
        LAS unsigned char* Kb = lds + cur * TB; LAS unsigned char* Vb = lds + 3 * TB + cur * TB;
        if (j > 0) asm volatile("s_waitcnt vmcnt(4)" ::: "memory"); else asm volatile("s_waitcnt vmcnt(0)" ::: "memory");
        __builtin_amdgcn_s_barrier(); asm volatile("" ::: "memory");
        if (j > 1) ATT_ISSUE(64 * (j - 2), cur == 0 ? 2 : cur - 1);
        const int key0 = 64 * j;
        if (key0 < wq0 + 31) {
            const bool need_mask = (key0 + 63 >= wq0);
            f32x16 x0, x1;
            qk_tile(Kb, qf, x0, x1, r, h);
            f32x16 l0, l1;
#pragma unroll
            for (int i = 0; i < 16; ++i) {
                l0[i] = __builtin_amdgcn_logf(1.0f + __builtin_amdgcn_exp2f(x0[i]));
                l1[i] = __builtin_amdgcn_logf(1.0f + __builtin_amdgcn_exp2f(x1[i]));
            }
            if (need_mask) {
#pragma unroll
                for (int i = 0; i < 16; ++i) { const int kk = key0 + crow(i, h); if (kk >= myq) l0[i] = 0.f; if (kk + 32 >= myq) l1[i] = 0.f; }
            }
#pragma unroll
            for (int g = 0; g < 4; ++g) {
                l0[4 * g + 2] += l0[4 * g + 3]; l0[4 * g + 1] += l0[4 * g + 2]; l0[4 * g] += l0[4 * g + 1];
                l1[4 * g + 2] += l1[4 * g + 3]; l1[4 * g + 1] += l1[4 * g + 2]; l1[4 * g] += l1[4 * g + 1];
            }
            float Tlo[8], Thi[8];
#pragma unroll
            for (int g = 0; g < 4; ++g) {
                { const unsigned t = __float_as_uint(l0[4 * g]); auto sw = __builtin_amdgcn_permlane32_swap(t, t, false, false); Tlo[g] = __uint_as_float(sw[0]); Thi[g] = __uint_as_float(sw[1]); }
                { const unsigned t = __float_as_uint(l1[4 * g]); auto sw = __builtin_amdgcn_permlane32_swap(t, t, false, false); Tlo[4 + g] = __uint_as_float(sw[0]); Thi[4 + g] = __uint_as_float(sw[1]); }
            }
            float offR[8];
            float run = 0.f;
#pragma unroll
            for (int g = 7; g >= 0; --g) { offR[g] = run + (h == 0 ? Thi[g] : 0.f) + R; run += Tlo[g] + Thi[g]; }
            f32x16 p0, p1;
#pragma unroll
            for (int i = 0; i < 16; ++i) {
                p0[i] = __builtin_amdgcn_exp2f(x0[i] - (l0[i] + offR[i >> 2]));
                p1[i] = __builtin_amdgcn_exp2f(x1[i] - (l1[i] + offR[4 + (i >> 2)]));
            }
            if (need_mask) {
#pragma unroll
                for (int i = 0; i < 16; ++i) { const int kk = key0 + crow(i, h); if (kk >= myq) p0[i] = 0.f; if (kk + 32 >= myq) p1[i] = 0.f; }
            }
            R += run;
            pv_tile(Vb, p0, p1, o, lane);
        }
        cur = (cur == 2) ? 0 : cur + 1;
    }
    store_o(osb + (tokbase + myq) * 1024 + hd * 128, o, 1.0f, h);
    __syncthreads();
}

DI void dil_item(const Params& p, LAS unsigned char* lds, int di) {
    const bf16_t* proj = (const bf16_t*)(p.ws + WS_PROJ);
    bf16_t* og = (bf16_t*)(p.ws + WS_OG);
    float* lse = (float*)(p.ws + WS_LSE);
    const int b = di / 192; const int rem = di - b * 192; const int head = rem >> 4, sub = rem & 15;
    const int grp = head >> 2;
    const int dil = grp == 0 ? 1 : grp == 1 ? 4 : 16;
    const int nblk = 16 / dil;
    const int res = sub / nblk, Qb = sub - res * nblk;
    const int i0 = Qb * 256;
    const int tid = threadIdx.x, wid = __builtin_amdgcn_readfirstlane(tid >> 6), lane = tid & 63, r = lane & 31, h = lane >> 5;
    const size_t tokbase = (size_t)b * SEQ;
    const int wq0 = i0 + 32 * wid;
    const int myqi = wq0 + r;
    const size_t mytok = tokbase + (size_t)myqi * dil + res;
    bf16x8 qf[8];
    f32x16 o[4];
#pragma unroll
    for (int db = 0; db < 4; ++db)
#pragma unroll
        for (int i = 0; i < 16; ++i) o[db][i] = 0.f;
    float mrun = -1e30f, lrun = 0.f;
    unsigned goff[2];
#pragma unroll
    for (int i = 0; i < 2; ++i) { const unsigned row = 4 * (wid * 2 + i) + (lane >> 4), cp = lane & 15, ch = cp ^ (((row & 3u) << 2) | ((row >> 2) & 3u)); goff[i] = (row * dil * DIN + ch * 8) * 2; }
    const char* kbase = (const char*)(proj + (tokbase + res) * DIN + COL_KA + head * 128);
    const char* vbase = (const char*)(proj + (tokbase + res) * DIN + COL_VA + head * 128);
    const int jt0 = (i0 == 0) ? 2 : 0;
    ATT_ISSUE((i0 - 128 + 64 * jt0) * dil, 0);
    ATT_ISSUE((i0 - 128 + 64 * (jt0 + 1)) * dil, 1);
    {
        const bf16_t* qrow = proj + mytok * DIN + COL_QA + head * 128;
#pragma unroll
        for (int s = 0; s < 8; ++s) qf[s] = *(const bf16x8*)(qrow + 16 * s + 8 * h);
#pragma unroll
        for (int s = 0; s < 8; ++s) asm volatile("" : "+v"(qf[s]));
    }
    int cur = 0;
    for (int jt = jt0; jt < 6; ++jt) {
        LAS unsigned char* Kb = lds + cur * TB; LAS unsigned char* Vb = lds + 3 * TB + cur * TB;
        if (jt < 5) asm volatile("s_waitcnt vmcnt(4)" ::: "memory"); else asm volatile("s_waitcnt vmcnt(0)" ::: "memory");
        __builtin_amdgcn_s_barrier(); asm volatile("" ::: "memory");
        if (jt < 4) ATT_ISSUE((i0 - 128 + 64 * (jt + 2)) * dil, cur == 0 ? 2 : cur - 1);
        const int ki0 = i0 - 128 + 64 * jt;
        if (ki0 <= wq0 + 31 && ki0 + 63 >= wq0 - 128) {
            f32x16 x0, x1;
            qk_tile(Kb, qf, x0, x1, r, h);
            const float NEG = -__builtin_inff();
#pragma unroll
            for (int i = 0; i < 16; ++i) {
                const int d0 = myqi - (ki0 + crow(i, h));
                if ((unsigned)d0 > 128u) x0[i] = NEG;
                if ((unsigned)(d0 - 32) > 128u) x1[i] = NEG;
            }
            float mx = x0[0];
#pragma unroll
            for (int i = 1; i < 16; ++i) mx = fmaxf(mx, x0[i]);
#pragma unroll
            for (int i = 0; i < 16; ++i) mx = fmaxf(mx, x1[i]);
            { const unsigned t = __float_as_uint(mx); auto sw = __builtin_amdgcn_permlane32_swap(t, t, false, false); mx = fmaxf(__uint_as_float(sw[0]), __uint_as_float(sw[1])); }
            const float mn = fmaxf(mrun, mx);
            const float alpha = __builtin_amdgcn_exp2f(mrun - mn);
            mrun = mn;
            f32x16 p0, p1; float rs = 0.f;
#pragma unroll
            for (int i = 0; i < 16; ++i) { p0[i] = __builtin_amdgcn_exp2f(x0[i] - mn); p1[i] = __builtin_amdgcn_exp2f(x1[i] - mn); rs += p0[i] + p1[i]; }
            { const unsigned t = __float_as_uint(rs); auto sw = __builtin_amdgcn_permlane32_swap(t, t, false, false); rs = __uint_as_float(sw[0]) + __uint_as_float(sw[1]); }
            lrun = lrun * alpha + rs;
#pragma unroll
            for (int db = 0; db < 4; ++db)
#pragma unroll
                for (int i = 0; i < 16; ++i) o[db][i] *= alpha;
            pv_tile(Vb, p0, p1, o, lane);
        }
        cur = (cur == 2) ? 0 : cur + 1;
    }
    store_o(og + mytok * 1536 + head * 128, o, 1.0f / lrun, h);
    if (h == 0) lse[mytok * 12 + head] = (mrun + __builtin_amdgcn_logf(lrun)) * LN2;
    __syncthreads();
}
#undef ATT_ISSUE
}

DI void phase_attn(const Params& p, LAS unsigned char* lds) {
    for (int it = blockIdx.x; it < 1024; it += gridDim.x) {
        if (it < 256) {
            const int xcd = it & 7, rest = it >> 3, bhi = rest >> 3, x = rest & 7, bh = xcd * 4 + bhi;
            att::sb_item(p, lds, bh >> 3, bh & 7, 15 - x);
            att::sb_item(p, lds, bh >> 3, bh & 7, x);
        } else att::dil_item(p, lds, it - 256);
    }
}

DI void phase_merge(const Params& p) {
    const int lane = threadIdx.x & 63, wid = threadIdx.x >> 6;
    const bf16_t* og = (const bf16_t*)(p.ws + WS_OG); const float* lse = (const float*)(p.ws + WS_LSE); bf16_t* odil = (bf16_t*)(p.ws + WS_ODIL);
    const int hg = lane >> 4, d0 = (lane & 15) * 8;
    for (int tok = blockIdx.x * 8 + wid; tok < NTOK; tok += gridDim.x * 8) {
        const float l0 = lse[(size_t)tok * 12 + hg], l1 = lse[(size_t)tok * 12 + 4 + hg], l2 = lse[(size_t)tok * 12 + 8 + hg];
        const float mx = fmaxf(l0, fmaxf(l1, l2));
        float w0 = __expf(l0 - mx), w1 = __expf(l1 - mx), w2 = __expf(l2 - mx);
        const float inv = 1.0f / (w0 + w1 + w2); w0 *= inv; w1 *= inv; w2 *= inv;
        const u32x4 a = *(const u32x4*)(og + (size_t)tok * 1536 + hg * 128 + d0);
        const u32x4 bq = *(const u32x4*)(og + (size_t)tok * 1536 + (4 + hg) * 128 + d0);
        const u32x4 c = *(const u32x4*)(og + (size_t)tok * 1536 + (8 + hg) * 128 + d0);
        u32x4 o;
#pragma unroll
        for (int q = 0; q < 4; ++q) {
            const float lo = w0 * bf_lo(a[q]) + w1 * bf_lo(bq[q]) + w2 * bf_lo(c[q]);
            const float hi = w0 * bf_hi(a[q]) + w1 * bf_hi(bq[q]) + w2 * bf_hi(c[q]);
            o[q] = pk_bf16(lo, hi);
        }
        *(u32x4*)(odil + (size_t)tok * 512 + hg * 128 + d0) = o;
    }
}

DI void phase_postmix(const Params& p, LAS unsigned char* lds) {
    const int tid = threadIdx.x, lane = tid & 63, wid = __builtin_amdgcn_readfirstlane(tid >> 6);
    LAS float* hsm = (LAS float*)lds;
    LAS float* part = (LAS float*)(lds + 131072);
    const float* mod = (const float*)(p.ws + WS_MOD); const bf16_t* y = (const bf16_t*)(p.ws + WS_Y);
    bf16_t* h2 = (bf16_t*)(p.ws + WS_H);
    int* cnt = (int*)(p.ws + WS_CNT); int* list = (int*)(p.ws + WS_LIST); float* listw = (float*)(p.ws + WS_LISTW);
    const bf16_t* wr_hi = (const bf16_t*)(p.ws + WS_WRT); const bf16_t* wr_lo = wr_hi + 64 * 2048;
    LAS int* lcnt = (LAS int*)(lds + 147456);
    LAS int* lbase = (LAS int*)(lds + 147712);
    LAS unsigned char* sel_e = lds + 147968;
    LAS unsigned short* sel_r = (LAS unsigned short*)(lds + 150016);
    LAS float* sel_w = (LAS float*)(lds + 154112);
    if (tid < 64) lcnt[tid] = 0;
    int itl = 0;
    for (int it = blockIdx.x; it < NTOK / 16; it += gridDim.x, ++itl) {
#pragma unroll 1
        for (int sub = 0; sub < 2; ++sub) {
            const int tl = 2 * wid + sub, tok = it * 16 + tl, b = tok >> 12;
            f32x4 v[8]; float ss = 0.f;
#pragma unroll
            for (int i = 0; i < 8; ++i) { const u32x2 yw = *(const u32x2*)(y + (size_t)tok * DM + 4 * (lane + 64 * i)); v[i] = (f32x4){bf_lo(yw.x), bf_hi(yw.x), bf_lo(yw.y), bf_hi(yw.y)}; ss += v[i][0] * v[i][0] + v[i][1] * v[i][1] + v[i][2] * v[i][2] + v[i][3] * v[i][3]; }
            ss = wave_sum(ss);
            const float rstd = rsqrtf(ss * (1.0f / DM) + RMS_EPS);
            float ss1 = 0.f;
#pragma unroll
            for (int i = 0; i < 8; ++i) {
                const int ch = 4 * (lane + 64 * i);
                const f32x4 g = *(const f32x4*)(p.g_post_mix + ch);
                const f32x4 gt = *(const f32x4*)(mod + b * 12288 + 4096 + ch);
                const f32x4 xv = *(const f32x4*)(p.x + (size_t)tok * DM + ch);
#pragma unroll
                for (int j = 0; j < 4; ++j) { v[i][j] = xv[j] + gt[j] * (v[i][j] * rstd * g[j]); ss1 += v[i][j] * v[i][j]; }
                *(f32x4*)(p.out + (size_t)tok * DM + ch) = v[i];
            }
            ss1 = wave_sum(ss1);
            const float rstd1 = rsqrtf(ss1 * (1.0f / DM) + RMS_EPS);
#pragma unroll
            for (int i = 0; i < 8; ++i) {
                const int ch = 4 * (lane + 64 * i);
                const f32x4 g = *(const f32x4*)(p.g_pre_ffn + ch);
                const f32x4 sh = *(const f32x4*)(mod + b * 12288 + 6144 + ch);
                const f32x4 sc = *(const f32x4*)(mod + b * 12288 + 8192 + ch);
                f32x4 o;
#pragma unroll
                for (int j = 0; j < 4; ++j) o[j] = v[i][j] * rstd1 * g[j] * (1.0f + sc[j]) + sh[j];
                u32x2 w; w.x = pk_bf16(o[0], o[1]); w.y = pk_bf16(o[2], o[3]);
                *(u32x2*)(h2 + (size_t)tok * DM + ch) = w;
                *(LAS f32x4*)(hsm + tl * 2048 + ch) = o;
            }
        }
        __syncthreads();
        f32x4 acc[4];
        {
            const int tr = lane & 15, kq = lane >> 4;
#pragma unroll
            for (int q = 0; q < 4; ++q) acc[q] = (f32x4){0.f, 0.f, 0.f, 0.f};
#pragma unroll 4
            for (int ks = 0; ks < 8; ++ks) {
                const int k0 = 256 * wid + 32 * ks + 8 * kq;
                const f32x4 a0 = *(const LAS f32x4*)(hsm + tr * 2048 + k0), a1 = *(const LAS f32x4*)(hsm + tr * 2048 + k0 + 4);
                u32x4 hw, lw;
                {
                    float xs[8] = {a0[0], a0[1], a0[2], a0[3], a1[0], a1[1], a1[2], a1[3]};
                    unsigned hh[4], ll[4];
#pragma unroll
                    for (int q = 0; q < 4; ++q) {
                        hh[q] = pk_bf16(xs[2 * q], xs[2 * q + 1]);
                        ll[q] = pk_bf16(xs[2 * q] - bf_lo(hh[q]), xs[2 * q + 1] - bf_hi(hh[q]));
                    }
                    hw = (u32x4){hh[0], hh[1], hh[2], hh[3]}; lw = (u32x4){ll[0], ll[1], ll[2], ll[3]};
                }
                const bf16x8 ah = __builtin_bit_cast(bf16x8, hw), al = __builtin_bit_cast(bf16x8, lw);
#pragma unroll
                for (int q = 0; q < 4; ++q) {
                    const bf16x8 bh = *(const bf16x8*)(wr_hi + (size_t)(16 * q + tr) * 2048 + k0);
                    const bf16x8 bl = *(const bf16x8*)(wr_lo + (size_t)(16 * q + tr) * 2048 + k0);
                    acc[q] = __builtin_amdgcn_mfma_f32_16x16x32_bf16(ah, bh, acc[q], 0, 0, 0);
                    acc[q] = __builtin_amdgcn_mfma_f32_16x16x32_bf16(ah, bl, acc[q], 0, 0, 0);
                    acc[q] = __builtin_amdgcn_mfma_f32_16x16x32_bf16(al, bh, acc[q], 0, 0, 0);
                }
            }
            if (wid >= 4) {
#pragma unroll
                for (int q = 0; q < 4; ++q)
#pragma unroll
                    for (int j = 0; j < 4; ++j) part[((wid - 4) * 16 + 4 * kq + j) * 64 + 16 * q + tr] = acc[q][j];
            }
        }
        __syncthreads();
        if (wid < 4) {
            const int tr = lane & 15, kq = lane >> 4;
#pragma unroll
            for (int q = 0; q < 4; ++q)
#pragma unroll
                for (int j = 0; j < 4; ++j) part[(wid * 16 + 4 * kq + j) * 64 + 16 * q + tr] += acc[q][j];
        }
        __syncthreads();
#pragma unroll 1
        for (int sub = 0; sub < 2; ++sub) {
            const int tl = 2 * wid + sub, tok = it * 16 + tl;
            const float logit = ((part[(0 * 16 + tl) * 64 + lane] + part[(1 * 16 + tl) * 64 + lane]) + part[(2 * 16 + tl) * 64 + lane]) + part[(3 * 16 + tl) * 64 + lane];
            const float score = 1.0f / (1.0f + __expf(-logit));
            const float sel = score + p.router_bias[lane];
            float m1 = sel;
            m1 = fmaxf(m1, __shfl_xor(m1, 1)); m1 = fmaxf(m1, __shfl_xor(m1, 2)); m1 = fmaxf(m1, __shfl_xor(m1, 4));
            const bool is1 = (sel == m1);
            const unsigned long long bal = __ballot(is1);
            const unsigned gm = (unsigned)(bal >> (lane & ~7)) & 0xffu;
            const int first = __ffs(gm) - 1;
            float m2 = (is1 && (lane & 7) == first) ? -__builtin_inff() : sel;
            m2 = fmaxf(m2, __shfl_xor(m2, 1)); m2 = fmaxf(m2, __shfl_xor(m2, 2)); m2 = fmaxf(m2, __shfl_xor(m2, 4));
            const float gs = m1 + m2;
            const int myg = lane >> 3;
            int grank = 0;
#pragma unroll 1
            for (int g = 0; g < 8; ++g) { const float gv = __uint_as_float(__builtin_amdgcn_readlane(__float_as_uint(gs), 8 * g)); grank += (gv > gs || (gv == gs && g < myg)) ? 1 : 0; }
            const bool gsel = grank < 4;
            const float msel = gsel ? sel : -__builtin_inff();
            int rk = 0;
#pragma unroll 4
            for (int e = 0; e < 64; ++e) { const float v = __uint_as_float(__builtin_amdgcn_readlane(__float_as_uint(msel), e)); rk += (v > msel || (v == msel && e < lane)) ? 1 : 0; }
            const bool chosen = gsel && rk < 8;
            const float ssum = wave_sum(chosen ? score : 0.f);
            if (chosen) {
                const int lr = __hip_atomic_fetch_add(lcnt + lane, 1, __ATOMIC_RELAXED, __HIP_MEMORY_SCOPE_WORKGROUP);
                const int idx = ((itl & 15) * 16 + tl) * 8 + rk;
                sel_e[idx] = (unsigned char)lane; sel_r[idx] = (unsigned short)lr; sel_w[idx] = score / ssum * 2.5f;
            }
            (void)tok;
        }
        __syncthreads();
        if ((itl & 15) == 15 || it + (int)gridDim.x >= NTOK / 16) {
            if (tid < 64) lbase[tid] = atomicAdd(&cnt[tid], lcnt[tid]);
            __syncthreads();
            const int nsel = ((itl & 15) + 1) * 128, it0 = itl & ~15;
            for (int idx = tid; idx < nsel; idx += 512) {
                const int e = sel_e[idx], tl = idx >> 3, k = idx & 7;
                const int tk = ((int)blockIdx.x + (it0 + (tl >> 4)) * (int)gridDim.x) * 16 + (tl & 15);
                const int pos = lbase[e] + sel_r[idx];
                list[e * LIST_CAP + pos] = tk * 9 + k; listw[e * LIST_CAP + pos] = sel_w[idx];
            }
            __syncthreads();
            if (tid < 64) lcnt[tid] = 0;
            __syncthreads();
        }
    }
}

DI void phase_combine(const Params& p) {
    const int lane = threadIdx.x & 63, wid = threadIdx.x >> 6;
    const float* mod = (const float*)(p.ws + WS_MOD); const bf16_t* yb9 = (const bf16_t*)(p.ws + WS_YB9); const int* slot = (const int*)(p.ws + WS_SLOT);
    for (int tok = blockIdx.x * 8 + wid; tok < NTOK; tok += gridDim.x * 8) {
        const int b = tok >> 12;
        float acc[4][8];
#pragma unroll
        for (int i = 0; i < 4; ++i)
#pragma unroll
            for (int j = 0; j < 8; ++j) acc[i][j] = 0.f;
#pragma unroll
        for (int k = 0; k < 9; ++k) {
            const bf16_t* row = yb9 + (size_t)slot[tok * 9 + k] * 256;
#pragma unroll
            for (int i = 0; i < 4; ++i) {
                const int c = lane + 64 * i;
                const u32x4 w = __builtin_nontemporal_load((const u32x4*)(row + (size_t)(c >> 5) * YB_SLOTS * 256 + (c & 31) * 8));
#pragma unroll
                for (int q = 0; q < 4; ++q) { acc[i][2 * q] += bf_lo(w[q]); acc[i][2 * q + 1] += bf_hi(w[q]); }
            }
        }
        float ss = 0.f;
#pragma unroll
        for (int i = 0; i < 4; ++i)
#pragma unroll
            for (int j = 0; j < 8; ++j) ss += acc[i][j] * acc[i][j];
        ss = wave_sum(ss);
        const float rstd = rsqrtf(ss * (1.0f / DM) + RMS_EPS);
#pragma unroll
        for (int i = 0; i < 4; ++i) {
            const int ch = 8 * (lane + 64 * i);
#pragma unroll
            for (int hh = 0; hh < 2; ++hh) {
                const f32x4 g = *(const f32x4*)(p.g_post_ffn + ch + 4 * hh);
                const f32x4 gt = *(const f32x4*)(mod + b * 12288 + 10240 + ch + 4 * hh);
                f32x4 xv = *(const f32x4*)(p.out + (size_t)tok * DM + ch + 4 * hh);
#pragma unroll
                for (int j = 0; j < 4; ++j) xv[j] += gt[j] * (acc[i][4 * hh + j] * rstd * g[j]);
                __builtin_nontemporal_store(xv, (f32x4*)(p.out + (size_t)tok * DM + ch + 4 * hh));
            }
        }
    }
}


DI void probe_copy(const Params& p) {
    u32x4* yb = (u32x4*)(p.ws + WS_YB9);
    const size_t n = (size_t)576 * MiB / 16;
    for (size_t i = (size_t)blockIdx.x * 512 + threadIdx.x; i < n; i += (size_t)gridDim.x * 512) { u32x4 v = yb[i]; asm volatile("" : "+v"(v)); yb[i] = v; }
}

constexpr int NPHASE = 12;
template <int PH> DI void run_phase(const Params& p, LAS unsigned char* lds) {
    if constexpr (PH == 0) phase_prologue(p, lds);
    else if constexpr (PH == 1) phase_prenorm(p);
    else if constexpr (PH == 2) phase_inproj(p, lds);
    else if constexpr (PH == 3) phase_attn(p, lds);
    else if constexpr (PH == 4) phase_merge(p);
    else if constexpr (PH == 5) phase_outproj_a(p, lds);
    else if constexpr (PH == 6) phase_outproj_b(p, lds);
    else if constexpr (PH == 7) phase_mixout(p, lds);
    else if constexpr (PH == 8) phase_postmix(p, lds);
    else if constexpr (PH == 9) phase_gateup(p, lds);
    else if constexpr (PH == 10) phase_down(p, lds);
    else phase_combine(p);
}
template <int PH> __global__ __launch_bounds__(512, 2) void k_phase(Params p) {
    extern __shared__ __attribute__((aligned(16))) unsigned char shm[];
    run_phase<PH>(p, (LAS unsigned char*)shm);
}
#if MK_FUSED
typedef const __attribute__((address_space(4))) Params* KargPtr;
template <int PH> DI void mega_phase(KargPtr kp0, LAS unsigned char* lds) {
    KargPtr kp = kp0; asm volatile("" : "+s"(kp));
    Params p{};
#if defined(__HIP_DEVICE_COMPILE__)
    p.x = kp->x; p.c = kp->c; p.pos = kp->pos; p.w_ada = kp->w_ada; p.b_ada = kp->b_ada; p.g_pre_mix = kp->g_pre_mix; p.g_post_mix = kp->g_post_mix; p.g_pre_ffn = kp->g_pre_ffn; p.g_post_ffn = kp->g_post_ffn; p.w_in = kp->w_in; p.w_dil_out = kp->w_dil_out; p.w_sb_out = kp->w_sb_out; p.w_mix_out = kp->w_mix_out; p.w_router = kp->w_router; p.router_bias = kp->router_bias; p.w_gate_e = kp->w_gate_e; p.w_up_e = kp->w_up_e; p.w_down_e = kp->w_down_e; p.w_gate_s = kp->w_gate_s; p.w_up_s = kp->w_up_s; p.w_down_s = kp->w_down_s; p.out = kp->out; p.ws = kp->ws;
#endif
    run_phase<PH>(p, lds);
}
__global__ __launch_bounds__(512, 2) void k_mega(Params p_unused) {
    extern __shared__ __attribute__((aligned(16))) unsigned char shm[];
    LAS unsigned char* lds = (LAS unsigned char*)shm;
    KargPtr kp0 = (KargPtr)__builtin_amdgcn_kernarg_segment_ptr();
    volatile LAS unsigned* xbw = (volatile LAS unsigned*)(lds + LDS_BYTES - 16);
    if (threadIdx.x == 0) { xbw[0] = 0u; xbw[1] = 0u; xbw[2] = 0u; xbw[3] = 0u; }
    __syncthreads();
    XcdBarrier bar;
    { KargPtr kp = kp0; asm volatile("" : "+s"(kp)); bar = xcd_barrier_post((unsigned*)(kp->ws + WS_BAR), xbw); }
    if (MK_STAMP >= 0 && blockIdx.x == 0 && threadIdx.x == 0) { KargPtr kq = kp0; asm volatile("" : "+s"(kq)); ((unsigned long long*)(kq->ws + WS_STAMP))[0] = wall_clock64(); }
#define MEGA_PH(n) do { mega_phase<n>(kp0, lds); xcd_barrier(bar); if (MK_REP == n) { mega_phase<n>(kp0, lds); xcd_barrier(bar); } \
        if (MK_STAMP >= 0 && blockIdx.x == 0 && threadIdx.x == 0) { KargPtr kq = kp0; asm volatile("" : "+s"(kq)); ((unsigned long long*)(kq->ws + WS_STAMP))[n + 1] = wall_clock64(); } } while (0)
#if MK_REP == 90
#define MK_PROBE_DOWN_NOSTORE 1
#endif
    MEGA_PH(0); MEGA_PH(1); MEGA_PH(2); MEGA_PH(3); MEGA_PH(4); MEGA_PH(5); MEGA_PH(6); MEGA_PH(7); MEGA_PH(8); MEGA_PH(9); MEGA_PH(10);
#if MK_REP == 100
    { KargPtr kp = kp0; asm volatile("" : "+s"(kp)); Params p{}; p.ws = kp->ws; probe_copy(p); xcd_barrier(bar); }
#endif
#undef MEGA_PH
    mega_phase<11>(kp0, lds);
#if MK_STAMP >= 0
    xcd_barrier(bar);
    if (blockIdx.x == 0 && threadIdx.x == 0) {
        KargPtr kq = kp0; asm volatile("" : "+s"(kq));
        unsigned long long* st = (unsigned long long*)(kq->ws + WS_STAMP);
        st[12] = wall_clock64();
        const int k = MK_STAMP < 100 ? MK_STAMP : MK_STAMP - 100;
        const unsigned long long t0 = (MK_STAMP < 100) ? st[k] : st[0], t1 = (MK_STAMP < 100) ? st[k + 1] : st[k + 1];
        kq->out[0] += 2.0f + (float)(t1 - t0) * (MK_STAMP < 100 ? 0.0005f : 0.0001f);
    }
#endif
}
#endif

template <int PH> static void launch_phase(const Params& p, int grid, hipStream_t stream) {
    static bool init = false;
    if (!init) { (void)hipFuncSetAttribute((const void*)k_phase<PH>, hipFuncAttributeMaxDynamicSharedMemorySize, LDS_BYTES); init = true; }
    hipLaunchKernelGGL(k_phase<PH>, dim3(grid), dim3(512), LDS_BYTES, stream, p);
}

extern "C" void kernel_launch(void* const* d_in, const int* in_sizes, int n_in, void* d_out, int out_size, void* d_ws, size_t ws_size, hipStream_t stream) {
    (void)in_sizes; (void)n_in; (void)out_size;
    static int grid = 0;
    if (!grid) {
        int dev = 0, cus = 0; (void)hipGetDevice(&dev); (void)hipDeviceGetAttribute(&cus, hipDeviceAttributeMultiprocessorCount, dev);
        if (cus <= 0) cus = 256;
#if MK_FUSED
        (void)hipFuncSetAttribute((const void*)k_mega, hipFuncAttributeMaxDynamicSharedMemorySize, LDS_BYTES);
        int per_cu = 0;
        if (hipOccupancyMaxActiveBlocksPerMultiprocessor(&per_cu, (const void*)k_mega, 512, LDS_BYTES) != hipSuccess || per_cu < 1)
            fprintf(stderr, "kernel_launch: occupancy query reports %d workgroups per CU\n", per_cu);
#endif
        grid = cus;
        if (ws_size < WS_TOTAL) fprintf(stderr, "kernel_launch: workspace too small: %zu < %zu\n", ws_size, (size_t)WS_TOTAL);
    }
    Params p{};
    p.x = (const float*)d_in[0]; p.c = (const float*)d_in[1]; p.pos = (const int*)d_in[2];
    p.w_ada = (const float*)d_in[3]; p.b_ada = (const float*)d_in[4];
    p.g_pre_mix = (const float*)d_in[5]; p.g_post_mix = (const float*)d_in[6]; p.g_pre_ffn = (const float*)d_in[7]; p.g_post_ffn = (const float*)d_in[8];
    p.w_in = (const float*)d_in[9]; p.w_dil_out = (const float*)d_in[10]; p.w_sb_out = (const float*)d_in[11]; p.w_mix_out = (const float*)d_in[12];
    p.w_router = (const float*)d_in[13]; p.router_bias = (const float*)d_in[14];
    p.w_gate_e = (const float*)d_in[15]; p.w_up_e = (const float*)d_in[16]; p.w_down_e = (const float*)d_in[17];
    p.w_gate_s = (const float*)d_in[18]; p.w_up_s = (const float*)d_in[19]; p.w_down_s = (const float*)d_in[20];
    p.out = (float*)d_out; p.ws = (unsigned char*)d_ws;
    (void)hipMemsetAsync((unsigned char*)d_ws + WS_BAR, 0, WS_ZERO_BYTES, stream);
#if MK_FUSED
    hipLaunchKernelGGL(k_mega, dim3(grid), dim3(512), LDS_BYTES, stream, p);
#else
    launch_phase<0>(p, grid, stream); launch_phase<1>(p, grid, stream); launch_phase<2>(p, grid, stream); launch_phase<3>(p, grid, stream);
    launch_phase<4>(p, grid, stream); launch_phase<5>(p, grid, stream); launch_phase<6>(p, grid, stream); launch_phase<7>(p, grid, stream);
    launch_phase<8>(p, grid, stream); launch_phase<9>(p, grid, stream); launch_phase<10>(p, grid, stream); launch_phase<11>(p, grid, stream);
#endif
}
```

```cpp
#include <hip/hip_runtime.h>
#include <stdint.h>
#include <stdio.h>

#ifndef MK_FUSED
#define MK_FUSED 1
#endif
#ifndef MK_STAMP
#define MK_STAMP -1
#endif
#ifndef MK_REP
#define MK_REP -1
#endif

#define LAS __attribute__((address_space(3)))
#define DI __device__ __forceinline__
typedef unsigned short bf16_t;
typedef short bf16x8 __attribute__((ext_vector_type(8)));
typedef short s16x4 __attribute__((ext_vector_type(4)));
typedef float f32x2 __attribute__((ext_vector_type(2)));
typedef float f32x4 __attribute__((ext_vector_type(4)));
typedef float f32x16 __attribute__((ext_vector_type(16)));
typedef unsigned u32x2 __attribute__((ext_vector_type(2)));
typedef unsigned u32x4 __attribute__((ext_vector_type(4)));
typedef __bf16 bf16x2_t __attribute__((ext_vector_type(2)));
typedef const __attribute__((address_space(1))) char* gcptr;
typedef const __attribute__((address_space(1))) u32x4* gu4ptr;

constexpr int NBATCH = 4, SEQ = 4096, NTOK = NBATCH * SEQ, DM = 2048, DIN = 11776;
constexpr int COL_QA = 0, COL_KA = 1536, COL_VA = 3072, COL_QS = 4608, COL_KS = 5632, COL_VS = 6656, COL_GD = 7680, COL_GS = 9728;
constexpr int NE = 64, DE = 512, NEX = 65;
constexpr int LIST_CAP = 16384;
constexpr int YB_SLOTS = 163840;
constexpr float RMS_EPS = 1e-6f;
constexpr float QSCALE = 0.08838834764831845f * 1.4426950408889634f;
constexpr float LN2 = 0.6931471805599453f;

constexpr size_t MiB = 1ull << 20;
constexpr size_t WS_BAR = 0;
constexpr size_t WS_CNT = 16384;
constexpr size_t WS_ZERO_BYTES = 32768;
constexpr size_t WS_STAMP = 32768;

constexpr size_t WS_MOD = 65536;
constexpr size_t WS_LSE = 262144;
constexpr size_t WS_ROPE = 1 * MiB;
constexpr size_t WS_LIST = 3 * MiB;
constexpr size_t WS_LISTW = 7 * MiB;
constexpr size_t WS_SLOT = 262144;
constexpr size_t WS_WD = 11 * MiB;
constexpr size_t WS_H = 141 * MiB;
constexpr size_t WS_HID = 205 * MiB;
constexpr size_t WS_WTIN = 205 * MiB;
constexpr size_t WS_TMP = 205 * MiB;
constexpr size_t WS_OG = 251 * MiB;
constexpr size_t WS_OSB = 299 * MiB;
constexpr size_t WS_ODIL = 331 * MiB;
constexpr size_t WS_WTDIL = 347 * MiB;
constexpr size_t WS_WTSB = 349 * MiB;
constexpr size_t WS_WTMIX = 353 * MiB;
constexpr size_t WS_PROJ = 365 * MiB;
constexpr size_t WS_Y = 365 * MiB;
constexpr size_t WS_YB9 = 365 * MiB;
constexpr size_t WS_WGU = 733 * MiB;
constexpr size_t WS_WRT = 1005 * MiB;
constexpr size_t WS_TOTAL = 1006 * MiB;

#ifndef MOE_BAUX
#define MOE_BAUX 0
#endif
#ifndef GEMM_SPLIT
#define GEMM_SPLIT false
#endif
constexpr int LDS_BYTES = 163840;

struct Params {
    const float *x, *c; const int* pos;
    const float *w_ada, *b_ada, *g_pre_mix, *g_post_mix, *g_pre_ffn, *g_post_ffn;
    const float *w_in, *w_dil_out, *w_sb_out, *w_mix_out, *w_router, *router_bias;
    const float *w_gate_e, *w_up_e, *w_down_e, *w_gate_s, *w_up_s, *w_down_s;
    float* out; unsigned char* ws;
};

DI unsigned pk_bf16(float lo, float hi) { f32x2 v = {lo, hi}; bf16x2_t r = __builtin_convertvector(v, bf16x2_t); return __builtin_bit_cast(unsigned, r); }
DI float bf_lo(unsigned u) { return __uint_as_float(u << 16); }
DI float bf_hi(unsigned u) { return __uint_as_float(u & 0xffff0000u); }
DI float wave_sum(float v) {
#pragma unroll
    for (int o = 32; o >= 1; o >>= 1) v += __shfl_xor(v, o);
    return v;
}
DI float sigmoidf_(float x) { return __builtin_amdgcn_rcpf(1.0f + __expf(-x)); }

#define XB_TMO      128
#define XB_XCNT(j)  (256  + 64 * (j))
#define XB_XSUB(j)  (1280 + 64 * (j))
#define XB_XGEN(j)  (2304 + 64 * (j))
#define XB_TOP      3328
#define XB_TOPGEN   3392
#define XCD_BAR_WORDS 3456
#define XB_SPIN_CAP (1u << 18)

__device__ __forceinline__ unsigned xb_ld(unsigned* p)              { return __hip_atomic_load(p, __ATOMIC_RELAXED, __HIP_MEMORY_SCOPE_AGENT); }
__device__ __forceinline__ unsigned xb_add(unsigned* p, unsigned v) { return __hip_atomic_fetch_add(p, v, __ATOMIC_RELAXED, __HIP_MEMORY_SCOPE_AGENT); }
__device__ __forceinline__ unsigned xb_xcc_id() { return (unsigned)__builtin_amdgcn_s_getreg((3 << 11) | 20) & 0xFu; }
#define XB_SPIN(cond, bar) do { unsigned _sp = 0; while (cond) { __builtin_amdgcn_s_sleep(1); \
    if ((++_sp & 255u) == 0u) { if (xb_ld(&(bar)[XB_TMO])) break; if (_sp > XB_SPIN_CAP) { atomicAdd(&(bar)[XB_TMO], 1u); break; } } } } while (0)

struct XcdBarrier { unsigned* bar; unsigned x; volatile LAS unsigned* st; };

__device__ __forceinline__ XcdBarrier xcd_barrier_post(unsigned* bar, volatile LAS unsigned* st) {
    XcdBarrier b; b.bar = bar; b.x = xb_xcc_id(); b.st = st;
    if (threadIdx.x == 0) (void)xb_add(&bar[XB_XCNT(b.x)], 1u);
    return b;
}
__device__ __forceinline__ void xcd_barrier_complete(unsigned* bar, unsigned x, unsigned& nloc, unsigned& nx) {
    const unsigned G = gridDim.x * gridDim.y * gridDim.z;
    unsigned sum, cnt, mine, sp = 0u;
    for (;;) {
        sum = 0u; cnt = 0u; mine = 0u;
#pragma unroll
        for (unsigned j = 0; j < 16; ++j) { const unsigned c = xb_ld(&bar[XB_XCNT(j)]); sum += c; cnt += (c > 0u) ? 1u : 0u; mine = (j == x) ? c : mine; }
        if (sum == G) break;
        __builtin_amdgcn_s_sleep(1);
        if ((++sp & 255u) == 0u) { if (xb_ld(&bar[XB_TMO])) break; if (sp > XB_SPIN_CAP) { atomicAdd(&bar[XB_TMO], 1u); break; } }
    }
    nloc = mine > 0u ? mine : 1u; nx = cnt > 0u ? cnt : 1u;
}
__device__ __forceinline__ void xcd_barrier(const XcdBarrier& b) {
    asm volatile("s_waitcnt vmcnt(0)" ::: "memory");
    __syncthreads();
    if (threadIdx.x == 0) {
        unsigned* bar = b.bar;
        __builtin_amdgcn_s_waitcnt(0);
        unsigned nloc = b.st[0], nx = b.st[1];
        if (nloc == 0u) { xcd_barrier_complete(bar, b.x, nloc, nx); b.st[0] = nloc; b.st[1] = nx; }
        const unsigned old = xb_add(&bar[XB_XSUB(b.x)], 1u);
        const unsigned gen = old / nloc;
        if (old + 1u == (gen + 1u) * nloc) {
            __builtin_amdgcn_fence(__ATOMIC_RELEASE, "agent");
            asm volatile("s_waitcnt vmcnt(0)" ::: "memory");
            const unsigned og = xb_add(&bar[XB_TOP], 1u);
            const unsigned tg = og / nx;
            if (og + 1u == (tg + 1u) * nx) xb_add(&bar[XB_TOPGEN], 1u);
            else XB_SPIN(xb_ld(&bar[XB_TOPGEN]) == tg, bar);
            __builtin_amdgcn_fence(__ATOMIC_ACQUIRE, "agent");
            xb_add(&bar[XB_XGEN(b.x)], 1u);
            asm volatile("s_waitcnt vmcnt(0)" ::: "memory");
        } else {
            XB_SPIN(xb_ld(&bar[XB_XGEN(b.x)]) == gen, bar);
            __builtin_amdgcn_fence(__ATOMIC_ACQUIRE, "agent");
            asm volatile("s_waitcnt vmcnt(0)" ::: "memory");
        }
    }
    __syncthreads();
}

struct CvtMat { const float* src; bf16_t* dst; int K, N, nb, mode; size_t sstride, dstride; };
constexpr int CVT_NMAT = 10;
constexpr int CVT_TILES[CVT_NMAT] = {2944, 128, 256, 512, 8192, 8192, 8192, 128, 128, 128};
constexpr int CVT_TOTAL = 2944 + 128 + 256 + 512 + 8192 * 3 + 128 * 3;
constexpr int P0_MOD_UNITS = 192, P0_ROPE_UNITS = 64, P0_WR_UNITS = 8, P0_ITEMS = P0_MOD_UNITS + P0_ROPE_UNITS + P0_WR_UNITS + CVT_TOTAL;

DI CvtMat cvt_mat(const Params& p, int m) {
    bf16_t* wtin = (bf16_t*)(p.ws + WS_WTIN); bf16_t* wtdil = (bf16_t*)(p.ws + WS_WTDIL); bf16_t* wtsb = (bf16_t*)(p.ws + WS_WTSB); bf16_t* wtmix = (bf16_t*)(p.ws + WS_WTMIX);
    bf16_t* wgu = (bf16_t*)(p.ws + WS_WGU); bf16_t* wd = (bf16_t*)(p.ws + WS_WD);
    CvtMat r;
    switch (m) {
        case 0: r = {p.w_in, wtin, 2048, 11776, 1, 0, 0, 0}; break;
        case 1: r = {p.w_dil_out, wtdil, 512, 2048, 1, 0, 0, 0}; break;
        case 2: r = {p.w_sb_out, wtsb, 1024, 2048, 1, 0, 0, 0}; break;
        case 3: r = {p.w_mix_out, wtmix, 2048, 2048, 1, 0, 0, 0}; break;
        case 4: r = {p.w_gate_e, wgu, 2048, 512, 64, 1, (size_t)2048 * 512, (size_t)1024 * 2048}; break;
        case 5: r = {p.w_up_e, wgu, 2048, 512, 64, 2, (size_t)2048 * 512, (size_t)1024 * 2048}; break;
        case 6: r = {p.w_down_e, wd, 512, 2048, 64, 0, (size_t)512 * 2048, (size_t)2048 * 512}; break;
        case 7: r = {p.w_gate_s, wgu + (size_t)64 * 1024 * 2048, 2048, 512, 1, 1, 0, 0}; break;
        case 8: r = {p.w_up_s, wgu + (size_t)64 * 1024 * 2048, 2048, 512, 1, 2, 0, 0}; break;
        default: r = {p.w_down_s, wd + (size_t)64 * 2048 * 512, 512, 2048, 1, 0, 0, 0}; break;
    }
    return r;
}

DI void cvt_tile(const Params& p, int t, LAS unsigned char* lds) {
    int m = 0;
#pragma unroll
    for (int i = 0; i < CVT_NMAT - 1; ++i) { if (t >= CVT_TILES[i] && m == i) { t -= CVT_TILES[i]; m = i + 1; } }
    const CvtMat M = cvt_mat(p, m);
    const int tn = M.N / 64, tk = M.K / 128;
    const int b = t / (tn * tk); const int rem = t - b * (tn * tk); const int kt = rem / tn, nt = rem - kt * tn;
    const float* src = M.src + (size_t)b * M.sstride + (size_t)(kt * 128) * M.N + nt * 64;
    bf16_t* dst = M.dst + (size_t)b * M.dstride;
    const int tid = threadIdx.x;
    constexpr int P = 272;
    {
        const int kq = tid >> 4, n4 = (tid & 15) * 4;
        f32x4 v[4];
#pragma unroll
        for (int i = 0; i < 4; ++i) v[i] = __builtin_nontemporal_load((const f32x4*)(src + (size_t)(kq + 32 * i) * M.N + n4));
#pragma unroll
        for (int i = 0; i < 4; ++i) {
            const int k = kq + 32 * i;
#pragma unroll
            for (int j = 0; j < 4; ++j) { const unsigned u = pk_bf16(v[i][j], 0.f); *(LAS bf16_t*)(lds + (n4 + j) * P + k * 2) = (bf16_t)(u & 0xffffu); }
        }
    }
    __syncthreads();
    {
        const int n = tid >> 3;
        const int c = nt * 64 + n;
        const int drow = M.mode == 0 ? c : (((c >> 7) << 8) + (c & 127) + (M.mode == 2 ? 128 : 0));
#pragma unroll
        for (int i = 0; i < 2; ++i) {
            const int ch = (tid & 7) + 8 * i;
            const u32x4 w = *(const LAS u32x4*)(lds + n * P + ch * 16);
            *(u32x4*)(dst + (size_t)drow * M.K + kt * 128 + ch * 8) = w;
        }
    }
    __syncthreads();
}

DI void mod_unit(const Params& p, int u, LAS unsigned char* lds) {
    const int tid = threadIdx.x, c0 = u * 64;
    LAS float* sc = (LAS float*)lds;
    LAS float* red = (LAS float*)(lds + 32768);
    for (int i = tid; i < 4 * 2048; i += 512) { const float v = p.c[i]; sc[i] = v / (1.0f + __expf(-v)); }
    __syncthreads();
    const int kq = tid >> 4, cq = tid & 15;
    float acc[4][4];
#pragma unroll
    for (int b = 0; b < 4; ++b)
#pragma unroll
        for (int j = 0; j < 4; ++j) acc[b][j] = 0.f;
    for (int it = 0; it < 64; ++it) {
        const int k = kq + 32 * it;
        const f32x4 w = __builtin_nontemporal_load((const f32x4*)(p.w_ada + (size_t)k * 12288 + c0 + 4 * cq));
#pragma unroll
        for (int b = 0; b < 4; ++b) { const float s = sc[b * 2048 + k];
#pragma unroll
            for (int j = 0; j < 4; ++j) acc[b][j] += s * w[j]; }
    }
#pragma unroll
    for (int b = 0; b < 4; ++b)
#pragma unroll
        for (int j = 0; j < 4; ++j) red[(kq * 4 + b) * 64 + 4 * cq + j] = acc[b][j];
    __syncthreads();
    if (tid < 256) {
        const int b = tid >> 6, col = tid & 63;
        float s = 0.f;
        for (int q = 0; q < 32; ++q) s += red[(q * 4 + b) * 64 + col];
        float* mod = (float*)(p.ws + WS_MOD);
        mod[b * 12288 + c0 + col] = s + p.b_ada[c0 + col];
    }
    __syncthreads();
}

DI void rope_unit(const Params& p, int u) {
    float2* rope = (float2*)(p.ws + WS_ROPE);
    for (int e = threadIdx.x; e < 4096; e += 512) {
        const int tok = u * 256 + (e >> 4), i = e & 15;
        const float invf = (float)pow(500000.0, -(double)i / 16.0);
        const float ang = (float)p.pos[tok] * invf;
        rope[tok * 16 + i] = make_float2((float)cos((double)ang), (float)sin((double)ang));
    }
}

DI void wr_unit(const Params& p, int u) {
    bf16_t* hi = (bf16_t*)(p.ws + WS_WRT); bf16_t* lo = hi + 64 * 2048;
    for (int i = threadIdx.x; i < 16384; i += 512) {
        const int idx = u * 16384 + i, k = idx >> 6, e = idx & 63;
        const float x = p.w_router[idx];
        const unsigned h = pk_bf16(x, 0.f) & 0xffffu;
        const float r = x - __uint_as_float(h << 16);
        hi[e * 2048 + k] = (bf16_t)h; lo[e * 2048 + k] = (bf16_t)(pk_bf16(r, 0.f) & 0xffffu);
    }
}
DI void phase_prologue(const Params& p, LAS unsigned char* lds) {
    for (int it = blockIdx.x; it < P0_ITEMS; it += gridDim.x) {
        if (it < P0_MOD_UNITS) mod_unit(p, it, lds);
        else if (it < P0_MOD_UNITS + P0_ROPE_UNITS) rope_unit(p, it - P0_MOD_UNITS);
        else if (it < P0_MOD_UNITS + P0_ROPE_UNITS + P0_WR_UNITS) wr_unit(p, it - P0_MOD_UNITS - P0_ROPE_UNITS);
        else cvt_tile(p, it - P0_MOD_UNITS - P0_ROPE_UNITS - P0_WR_UNITS, lds);
    }
}

DI void phase_prenorm(const Params& p) {
    const int lane = threadIdx.x & 63, wid = threadIdx.x >> 6;
    const float* mod = (const float*)(p.ws + WS_MOD);
    bf16_t* h = (bf16_t*)(p.ws + WS_H);
    for (int tok = blockIdx.x * 8 + wid; tok < NTOK; tok += gridDim.x * 8) {
        const int b = tok >> 12;
        const float* xr = p.x + (size_t)tok * DM;
        f32x4 v[8]; float ss = 0.f;
#pragma unroll
        for (int i = 0; i < 8; ++i) { v[i] = *(const f32x4*)(xr + 4 * (lane + 64 * i)); ss += v[i][0] * v[i][0] + v[i][1] * v[i][1] + v[i][2] * v[i][2] + v[i][3] * v[i][3]; }
        ss = wave_sum(ss);
        const float rstd = rsqrtf(ss * (1.0f / DM) + RMS_EPS);
#pragma unroll
        for (int i = 0; i < 8; ++i) {
            const int ch = 4 * (lane + 64 * i);
            const f32x4 g = *(const f32x4*)(p.g_pre_mix + ch);
            const f32x4 sh = *(const f32x4*)(mod + b * 12288 + ch);
            const f32x4 sc = *(const f32x4*)(mod + b * 12288 + 2048 + ch);
            f32x4 o;
#pragma unroll
            for (int j = 0; j < 4; ++j) o[j] = v[i][j] * rstd * g[j] * (1.0f + sc[j]) + sh[j];
            u32x2 w; w.x = pk_bf16(o[0], o[1]); w.y = pk_bf16(o[2], o[3]);
            *(u32x2*)(h + (size_t)tok * DM + ch) = w;
        }
    }
}

namespace g8 {
constexpr int BM = 256, BK = 64, HALF = 128, HTB = HALF * BK * 2, STAGE_BYTES = 8 * HTB, NXCD = 8, WGM = 8;
DI int lds_byte(int r, int c) { const int st = (r >> 4) * 2 + (c >> 5), rr = r & 15, cc = c & 31, ob = rr * 64 + cc * 2; return st * 1024 + (ob ^ (((ob >> 9) & 1) << 5)); }
DI void stage_rc(int b, int& R, int& C) { const int st = b / 1024, sb = b % 1024, swz = sb ^ (((sb >> 9) & 1) << 5); R = (st >> 1) * 16 + swz / 64; C = (st & 1) * 32 + (swz % 64) / 2; }
DI int perm32(int rho) { const int n = rho >> 4, i = rho & 15; return 8 * (i >> 2) + 4 * n + (i & 3); }

struct Unit {
    const char* A; const char* B;
    int row0;
    int lda, ldb, nt;
    int pm, pn, aux, keep;
    int e, nvalid, par;
};

DI bool static_tile(int L, int nM, int nN, int& pm, int& pn) {
    const int nwg = nM * nN; if (L >= nwg) return false;
    int wgid = L; { const int q = nwg / NXCD, r = nwg % NXCD, xcd = wgid % NXCD, off = wgid / NXCD; wgid = (xcd < r ? xcd * (q + 1) : r * (q + 1) + (xcd - r) * q) + off; }
    const int nig = WGM * nN, gid = wgid / nig, fm = gid * WGM, gsz = (nM - fm) < WGM ? (nM - fm) : WGM;
    pm = fm + ((wgid % nig) % gsz); pn = (wgid % nig) / gsz; return true;
}

constexpr int EXCH_OFF = STAGE_BYTES + 8192;
DI void epi_bar() { asm volatile("s_waitcnt lgkmcnt(0)" ::: "memory"); __builtin_amdgcn_s_barrier(); asm volatile("" ::: "memory"); }

template <int NCH, int BAUX, bool SPLIT, class Sched, class Epi>
DI void gemm_phase(LAS unsigned char* lds, const Sched& S, const Epi& E) {
    const int tid = threadIdx.x, wid = __builtin_amdgcn_readfirstlane(tid >> 6), lane = tid & 63, wr = wid >> 2, wc = wid & 3, fr = lane & 15, fq = lane >> 4;
    const bool loader = SPLIT ? (wr == 0) : true, storer = SPLIT ? (wr == 1) : true;
    constexpr int NP = SPLIT ? 4 : 2, PSTEP = SPLIT ? 4 : 8, RSTEP = SPLIT ? 32 : 64;
    const int p0 = SPLIT ? wc : wid;
    int R0, C0; stage_rc(p0 * 1024 + lane * 16, R0, C0);
    const int sC = C0 * 2, sRb = (R0 & ~31) + perm32(R0 & 31);
    const int aoff = lds_byte(wr * 64 + fr, fq * 8), boff = lds_byte(wc * 32 + fr, fq * 8);
#define G8_SA(b, h) (((b) * 2 + (h)) * HTB)
#define G8_SB(b, h) ((4 + (b) * 2 + (h)) * HTB)
#define G8_STAGE_A(bufoff, gbase, voff) do { if (loader) { _Pragma("unroll") for (int _i = 0; _i < NP; ++_i) \
        __builtin_amdgcn_global_load_lds((const unsigned*)((const char*)(gbase) + (voff)[_i]), (LAS unsigned*)(lds + (bufoff) + (p0 + PSTEP * _i) * 1024), 16, 0, 0); } } while (0)
#define G8_STAGE_B(bufoff, gbase, voff, ldb32) do { if (loader) { _Pragma("unroll") for (int _i = 0; _i < NP; ++_i) { \
        const char* _gb = (const char*)(gbase) + (size_t)_i * (ldb32); asm volatile("" : "+s"(_gb));     \
        __builtin_amdgcn_global_load_lds((const unsigned*)(_gb + (voff)), (LAS unsigned*)(lds + (bufoff) + (p0 + PSTEP * _i) * 1024), 16, 0, BAUX); } } } while (0)
#define G8_LDA(dst, b, h) do { _Pragma("unroll") for (int m = 0; m < 4; ++m) _Pragma("unroll") for (int k = 0; k < 2; ++k) dst[m][k] = *(const LAS bf16x8*)(lds + G8_SA(b, h) + aoff + m * 2048 + k * 1024); } while (0)
#define G8_LDB(dst, b, h) do { _Pragma("unroll") for (int n = 0; n < 2; ++n) _Pragma("unroll") for (int k = 0; k < 2; ++k) dst[n][k] = *(const LAS bf16x8*)(lds + G8_SB(b, h) + boff + n * 2048 + k * 1024); } while (0)
#define G8_MMA(ai, bj, At, Bt) do { __builtin_amdgcn_s_setprio(1); _Pragma("unroll") for (int m = 0; m < 4; ++m) _Pragma("unroll") for (int n = 0; n < 2; ++n) _Pragma("unroll") for (int k = 0; k < 2; ++k) \
        acc[ai][bj][m][n] = __builtin_amdgcn_mfma_f32_16x16x32_bf16(Bt[n][k], At[m][k], acc[ai][bj][m][n], 0, 0, 0); __builtin_amdgcn_s_setprio(0); } while (0)
#define G8_WAIT_V8 do { if (SPLIT) { if (loader) asm volatile("s_waitcnt vmcnt(8)" ::: "memory"); } else asm volatile("s_waitcnt vmcnt(4)" ::: "memory"); } while (0)
#define G8_WAIT_V12 do { if (SPLIT) { if (loader) asm volatile("s_waitcnt vmcnt(12)" ::: "memory"); } else asm volatile("s_waitcnt vmcnt(6)" ::: "memory"); } while (0)
#define G8_WAIT_V0 do { if (loader) asm volatile("s_waitcnt vmcnt(0)" ::: "memory"); } while (0)
#define G8_WAIT_L(n) asm volatile("s_waitcnt lgkmcnt(" #n ")" ::: "memory")
#define G8_BAR __builtin_amdgcn_s_barrier()
#define G8_SCHED __builtin_amdgcn_sched_barrier(0)
#define G8_OFFS(u, vA, vB) do { if (loader) { _Pragma("unroll") for (int _h = 0; _h < 2; ++_h) _Pragma("unroll") for (int _i = 0; _i < NP; ++_i) \
        vA[_h][_i] = (unsigned)S.arow(u, _h * 128 + R0 + RSTEP * _i) * (unsigned)(u).lda + (unsigned)sC; \
        vB = (unsigned)sRb * (unsigned)(u).ldb + (unsigned)sC; } } while (0)
    Unit cur, nxt; int ui = 0;
    if (!S.next(0, cur)) return;
    f32x4 acc[2][2][4][2];
#pragma unroll
    for (int a = 0; a < 2; ++a)
#pragma unroll
        for (int b = 0; b < 2; ++b)
#pragma unroll
            for (int m = 0; m < 4; ++m)
#pragma unroll
                for (int n = 0; n < 2; ++n) acc[a][b][m][n] = (f32x4){0.f, 0.f, 0.f, 0.f};
    bf16x8 At[4][2], B0[2][2], B1[2][2];
    unsigned vA[2][NP], vB = 0u;
#pragma unroll
    for (int i = 0; i < NP; ++i) { vA[0][i] = 0u; vA[1][i] = 0u; }
    if (S.prefetch(cur, wid, lane)) { G8_WAIT_V0; G8_BAR; }
    G8_OFFS(cur, vA, vB);
    const char* cA = cur.A; const char* cB = cur.B; size_t hB = (size_t)128 * cur.ldb; size_t q32 = (size_t)RSTEP * cur.ldb;
    constexpr size_t kstep = 128;
    G8_STAGE_B(G8_SB(0, 0), cB, vB, q32); G8_STAGE_A(G8_SA(0, 0), cA, vA[0]); G8_STAGE_B(G8_SB(0, 1), cB + hB, vB, q32); G8_STAGE_A(G8_SA(0, 1), cA, vA[1]);
    if (wr == 1) G8_BAR;
    G8_WAIT_V8; G8_BAR;
    G8_STAGE_B(G8_SB(1, 0), cB + kstep, vB, q32); G8_STAGE_A(G8_SA(1, 0), cA + kstep, vA[0]); G8_STAGE_B(G8_SB(1, 1), cB + hB + kstep, vB, q32);
    G8_WAIT_V12; G8_BAR;
    for (;;) {
        bool has_next = false;
        const char* nA = cA; const char* nB = cB; size_t nhB = hB, nq32 = q32;
        const int nt = cur.nt;
#pragma unroll 1
        for (int t = 0; t < nt; t += 2) {
            const bool last = (t == nt - 2);
            const char* a1 = cA + (size_t)(t + 1) * kstep;
            G8_LDB(B0, 0, 0); G8_SCHED; G8_LDA(At, 0, 0); G8_STAGE_A(G8_SA(1, 1), a1, vA[1]);
            G8_WAIT_L(8); G8_BAR; G8_WAIT_L(0); G8_MMA(0, 0, At, B0); G8_BAR; G8_SCHED;
            if (t == 0) { Unit pf; if (S.next(ui + 1, pf)) (void)S.prefetch(pf, wid, lane); }
            const char* a2; const char* b2; size_t h2, q2;
            if (last) {
                has_next = S.next(ui + 1, nxt);
                if (has_next) { G8_OFFS(nxt, vA, vB); nA = nxt.A; nB = nxt.B; nhB = (size_t)128 * nxt.ldb; nq32 = (size_t)RSTEP * nxt.ldb; }
                a2 = nA; b2 = nB; h2 = nhB; q2 = nq32;
            } else { a2 = cA + (size_t)(t + 2) * kstep; b2 = cB + (size_t)(t + 2) * kstep; h2 = hB; q2 = q32; }
            const char* a3 = a2 + kstep; const char* b3 = b2 + kstep;
            G8_LDB(B1, 0, 1); G8_STAGE_B(G8_SB(0, 0), b2, vB, q2);
            G8_BAR; G8_WAIT_L(0); G8_MMA(0, 1, At, B1); G8_BAR;
            G8_LDA(At, 0, 1); G8_STAGE_A(G8_SA(0, 0), a2, vA[0]);
            G8_BAR; G8_WAIT_L(0); G8_MMA(1, 0, At, B0); G8_BAR; G8_SCHED;
            G8_STAGE_B(G8_SB(0, 1), b2 + h2, vB, q2);
            G8_WAIT_V12; G8_BAR; G8_MMA(1, 1, At, B1); G8_BAR;
            G8_LDB(B0, 1, 0); G8_SCHED; G8_LDA(At, 1, 0); G8_STAGE_A(G8_SA(0, 1), a2, vA[1]);
            G8_WAIT_L(8); G8_BAR; G8_WAIT_L(0); G8_MMA(0, 0, At, B0); G8_BAR; G8_SCHED;
            G8_LDB(B1, 1, 1); G8_STAGE_B(G8_SB(1, 0), b3, vB, q2);
            G8_BAR; G8_WAIT_L(0); G8_MMA(0, 1, At, B1); G8_BAR;
            G8_LDA(At, 1, 1); G8_STAGE_A(G8_SA(1, 0), a3, vA[0]);
            G8_BAR; G8_WAIT_L(0); G8_MMA(1, 0, At, B0); G8_BAR; G8_SCHED;
            G8_STAGE_B(G8_SB(1, 1), b3 + h2, vB, q2);
            G8_WAIT_V12; G8_BAR; G8_MMA(1, 1, At, B1); G8_BAR;
        }
        int tz = threadIdx.x; asm volatile("" : "+v"(tz));
        const int lane_e = tz & 63, fr_e = tz & 15, fq_e = (tz >> 4) & 3;
        {
            E.pre(acc, cur, wr, wc, fr_e, fq_e);
            constexpr int PITCH = NCH * 16 + 16;
            LAS unsigned char* ex = lds + EXCH_OFF;
            if (wr == 0) G8_BAR;
#pragma unroll
            for (int ai = 0; ai < 2; ++ai)
#pragma unroll
                for (int m = 0; m < 4; ++m) {
                    u32x4 o[2];
                    E.row(acc, cur, ai, m, wr, wc, fr_e, fq_e, o);
                    if (NCH == 32) {
                        *(LAS u32x4*)(ex + (wr * 16 + fr_e) * PITCH + (wc * 32 + 8 * fq_e) * 2) = o[0];
                        *(LAS u32x4*)(ex + (wr * 16 + fr_e) * PITCH + (128 + wc * 32 + 8 * fq_e) * 2) = o[1];
                    } else {
                        *(LAS u32x4*)(ex + (wr * 16 + fr_e) * PITCH + (wc * 32 + 8 * fq_e) * 2) = o[0];
                    }
                    epi_bar();
                    if (storer) {
                        constexpr int RPI = 64 / NCH;
                        constexpr int RPW = SPLIT ? 8 : 4;
                        const int rbase = SPLIT ? 8 * wc : 4 * wid;
#pragma unroll
                        for (int i = 0; i < RPW / RPI; ++i) {
                            const int rl = rbase + RPI * i + lane_e / NCH, ch = lane_e % NCH;
                            const int rt = ai * 128 + (rl >> 4) * 64 + m * 16 + (rl & 15);
                            const u32x4 d = *(const LAS u32x4*)(ex + rl * PITCH + ch * 16);
                            E.store(cur, rt, ch, d);
                        }
                    }
                    epi_bar();
                }
            if (wr == 1) G8_BAR;
        }
        if (!has_next) break;
#pragma unroll
        for (int a = 0; a < 2; ++a)
#pragma unroll
            for (int b = 0; b < 2; ++b)
#pragma unroll
                for (int m = 0; m < 4; ++m)
#pragma unroll
                    for (int n = 0; n < 2; ++n) acc[a][b][m][n] = (f32x4){0.f, 0.f, 0.f, 0.f};
        cur = nxt; cA = nA; cB = nB; hB = nhB; q32 = nq32; ++ui;
    }
    G8_WAIT_V0;
    if (wr == 0) G8_BAR;
    G8_BAR;
#undef G8_SA
#undef G8_SB
#undef G8_STAGE_A
#undef G8_STAGE_B
#undef G8_LDA
#undef G8_LDB
#undef G8_MMA
#undef G8_WAIT_V8
#undef G8_WAIT_V12
#undef G8_WAIT_V0
#undef G8_WAIT_L
#undef G8_BAR
#undef G8_SCHED
#undef G8_OFFS
}
}

struct DenseSched {
    const char* A; const char* Bt; int nM, nN, lda, ldb, nt, G, c;
    DI bool next(int i, g8::Unit& u) const {
        int pm, pn; if (!g8::static_tile(i * G + c, nM, nN, pm, pn)) return false;
        pm = __builtin_amdgcn_readfirstlane(pm); pn = __builtin_amdgcn_readfirstlane(pn);
        u.A = A; u.B = Bt + (size_t)pn * 256 * ldb; u.row0 = pm * 256; u.lda = lda; u.ldb = ldb; u.nt = nt; u.pm = pm; u.pn = pn; u.aux = 0; u.keep = 0; u.e = 0; u.nvalid = 256; u.par = 0; return true;
    }
    DI int arow(const g8::Unit& u, int rr) const { return u.row0 + rr; }
    DI bool prefetch(const g8::Unit&, int, int) const { return false; }
};
constexpr int MOE_TAB_OFF = g8::STAGE_BYTES;
constexpr int MOE_TILE_OFF = g8::STAGE_BYTES + 1024;
constexpr int MOE_IDX_OFF = g8::STAGE_BYTES + 2048;
struct MoeSched {
    LAS unsigned char* lds; const int* list; const float* listw; const char* A; const char* W; int ncol, mode  , G, c;
    DI bool next(int i, g8::Unit& u) const {
        const LAS int* tpre = (const LAS int*)(lds + MOE_TAB_OFF);
        const int L = i * G + c; const int T = __builtin_amdgcn_readfirstlane(tpre[NEX]);
        if (L >= T * ncol) return false;
        const int gt = __builtin_amdgcn_readfirstlane(L / ncol), pn = L - gt * ncol;
        const int e = __builtin_amdgcn_readfirstlane((int)*(const LAS unsigned char*)(lds + MOE_TILE_OFF + gt));
        const int tile = gt - __builtin_amdgcn_readfirstlane(tpre[e]);
        const int n_e = __builtin_amdgcn_readfirstlane(tpre[NEX + 1 + e]);
        u.e = e; u.pm = tile; u.pn = pn; u.nvalid = min(256, n_e - tile * 256); u.keep = 0; u.aux = gt * 256; u.par = i & 1;
        if (mode == 0) { u.A = A; u.lda = 4096; u.ldb = 4096; u.nt = 32; u.B = W + ((size_t)e * 1024 + (size_t)pn * 256) * 4096; u.row0 = tile * 256; }
        else { u.A = A; u.lda = 1024; u.ldb = 1024; u.nt = 8; u.B = W + ((size_t)e * 2048 + (size_t)pn * 256) * 1024; u.row0 = gt * 256; }
        return true;
    }
    DI bool prefetch(const g8::Unit& u, int wid, int lane) const {
        if (u.e < NE && wid < 4) {
            const int r = min(wid * 64 + lane, u.nvalid - 1);
            const size_t src = (size_t)u.e * LIST_CAP + u.pm * 256 + r;
            __builtin_amdgcn_global_load_lds((const unsigned*)(list + src), (LAS unsigned*)(lds + MOE_IDX_OFF + u.par * 2048 + wid * 256), 4, 0, 0);
            if (mode == 1) __builtin_amdgcn_global_load_lds((const unsigned*)(listw + src), (LAS unsigned*)(lds + MOE_IDX_OFF + u.par * 2048 + 1024 + wid * 256), 4, 0, 0);
        }
        return true;
    }
    DI int arow(const g8::Unit& u, int rr) const {
        if (mode == 1) return u.row0 + rr;
        if (u.e >= NE) return u.row0 + rr;
        return *(const LAS int*)(lds + MOE_IDX_OFF + u.par * 2048 + rr * 4) / 9;
    }
};

typedef f32x4 (&AccRef)[2][2][4][2];
DI u32x4 pack8(const f32x4& v0, const f32x4& v1) { u32x4 w; w.x = pk_bf16(v0[0], v0[1]); w.y = pk_bf16(v0[2], v0[3]); w.z = pk_bf16(v1[0], v1[1]); w.w = pk_bf16(v1[2], v1[3]); return w; }

struct EpiInProj {
    bf16_t* proj; const float* rope;
    DI static int kind_of(int pn) { return pn < 6 ? 0 : pn < 12 ? 1 : pn < 18 ? 2 : pn < 22 ? 3 : pn < 30 ? 2 : 4; }
    DI void pre(AccRef acc, const g8::Unit& u, int wr, int wc, int fr, int fq) const {
        if (kind_of(u.pn) <= 1 && wc == 0) {
            const float sg = (fq < 2) ? -1.0f : 1.0f;
#pragma unroll
            for (int g = 0; g < 4; ++g) {
                const int ai = g >> 1;
                f32x4 cs[2][4];
#pragma unroll
                for (int mm = 0; mm < 2; ++mm) { const int m = (g & 1) * 2 + mm; const int row = u.pm * 256 + ai * 128 + wr * 64 + m * 16 + fr;
#pragma unroll
                    for (int q = 0; q < 4; ++q) cs[mm][q] = *(const f32x4*)(rope + (size_t)row * 32 + 16 * (fq & 1) + 4 * q); }
#pragma unroll
                for (int mm = 0; mm < 2; ++mm) { const int m = (g & 1) * 2 + mm;
#pragma unroll
                    for (int bj = 0; bj < 2; ++bj) {
                        f32x4 v0 = acc[ai][bj][m][0], v1 = acc[ai][bj][m][1], p0, p1;
#pragma unroll
                        for (int j = 0; j < 4; ++j) { p0[j] = __shfl_xor(v0[j], 32); p1[j] = __shfl_xor(v1[j], 32); }
#pragma unroll
                        for (int j = 0; j < 4; ++j) {
                            const float c0 = cs[mm][j >> 1][(j & 1) * 2], s0 = cs[mm][j >> 1][(j & 1) * 2 + 1];
                            const float c1 = cs[mm][2 + (j >> 1)][(j & 1) * 2], s1 = cs[mm][2 + (j >> 1)][(j & 1) * 2 + 1];
                            v0[j] = v0[j] * c0 + sg * p0[j] * s0;
                            v1[j] = v1[j] * c1 + sg * p1[j] * s1;
                        }
                        acc[ai][bj][m][0] = v0; acc[ai][bj][m][1] = v1;
                    }
                    asm volatile("" : "+v"(acc[ai][0][m][0]), "+v"(acc[ai][0][m][1]), "+v"(acc[ai][1][m][0]), "+v"(acc[ai][1][m][1]));
                }
                asm volatile("" ::: "memory");
            }
        }
    }
    DI void row(AccRef acc, const g8::Unit& u, int ai, int m, int wr, int wc, int fr, int fq, u32x4 (&o)[2]) const {
        const int kind = kind_of(u.pn);
#pragma unroll
        for (int bj = 0; bj < 2; ++bj) {
            f32x4 v0 = acc[ai][bj][m][0], v1 = acc[ai][bj][m][1];
            if (kind == 0 || kind == 3) { v0 *= QSCALE; v1 *= QSCALE; }
            if (kind == 4) {
#pragma unroll
                for (int j = 0; j < 4; ++j) { v0[j] = sigmoidf_(v0[j]); v1[j] = sigmoidf_(v1[j]); }
            }
            o[bj] = pack8(v0, v1);
        }
    }
    DI void store(const g8::Unit& u, int rt, int ch, const u32x4& d) const { __builtin_nontemporal_store(d, (u32x4*)(proj + (size_t)(u.pm * 256 + rt) * DIN + u.pn * 256 + ch * 8)); }
};
template <int PART> struct EpiGate {
    const bf16_t* proj; const bf16_t* tmp; bf16_t* out;
    DI void pre(AccRef acc, const g8::Unit& u, int wr, int wc, int fr, int fq) const {
        const unsigned vo_g = (unsigned)(((wr * 64 + fr) * DIN + wc * 32 + 8 * fq) * 2), vo_t = (unsigned)(((wr * 64 + fr) * DM + wc * 32 + 8 * fq) * 2);
#pragma unroll
        for (int ai = 0; ai < 2; ++ai)
#pragma unroll
            for (int m = 0; m < 4; ++m) {
#pragma unroll
                for (int bj = 0; bj < 2; ++bj) {
                    gcptr sg = (gcptr)(proj + (size_t)(u.pm * 256 + ai * 128 + m * 16) * DIN + u.pn * 256 + bj * 128 + (PART == 0 ? COL_GD : COL_GS));
                    asm volatile("" : "+s"(sg));
                    const u32x4 gg = *(gu4ptr)(sg + vo_g);
                    const float sv[8] = {bf_lo(gg.x), bf_hi(gg.x), bf_lo(gg.y), bf_hi(gg.y), bf_lo(gg.z), bf_hi(gg.z), bf_lo(gg.w), bf_hi(gg.w)};
                    if (PART == 0) {
#pragma unroll
                        for (int j = 0; j < 4; ++j) { acc[ai][bj][m][0][j] *= sv[j]; acc[ai][bj][m][1][j] *= sv[4 + j]; }
                    } else {
                        gcptr st = (gcptr)(tmp + (size_t)(u.pm * 256 + ai * 128 + m * 16) * DM + u.pn * 256 + bj * 128);
                        asm volatile("" : "+s"(st));
                        const u32x4 tt = *(gu4ptr)(st + vo_t);
                        const float tv[8] = {bf_lo(tt.x), bf_hi(tt.x), bf_lo(tt.y), bf_hi(tt.y), bf_lo(tt.z), bf_hi(tt.z), bf_lo(tt.w), bf_hi(tt.w)};
#pragma unroll
                        for (int j = 0; j < 4; ++j) { acc[ai][bj][m][0][j] = acc[ai][bj][m][0][j] * sv[j] + tv[j]; acc[ai][bj][m][1][j] = acc[ai][bj][m][1][j] * sv[4 + j] + tv[4 + j]; }
                    }
                }
                asm volatile("" : "+v"(acc[ai][0][m][0]), "+v"(acc[ai][0][m][1]), "+v"(acc[ai][1][m][0]), "+v"(acc[ai][1][m][1]));
                if (m & 1) asm volatile("" ::: "memory");
            }
    }
    DI void row(AccRef acc, const g8::Unit&, int ai, int m, int, int, int, int, u32x4 (&o)[2]) const {
        o[0] = pack8(acc[ai][0][m][0], acc[ai][0][m][1]); o[1] = pack8(acc[ai][1][m][0], acc[ai][1][m][1]);
    }
    DI void store(const g8::Unit& u, int rt, int ch, const u32x4& d) const { *(u32x4*)(out + (size_t)(u.pm * 256 + rt) * DM + u.pn * 256 + ch * 8) = d; }
};
struct EpiPlain {
    bf16_t* out; int ld;
    DI void pre(AccRef, const g8::Unit&, int, int, int, int) const {}
    DI void row(AccRef acc, const g8::Unit&, int ai, int m, int, int, int, int, u32x4 (&o)[2]) const {
        o[0] = pack8(acc[ai][0][m][0], acc[ai][0][m][1]); o[1] = pack8(acc[ai][1][m][0], acc[ai][1][m][1]);
    }
    DI void store(const g8::Unit& u, int rt, int ch, const u32x4& d) const { *(u32x4*)(out + (size_t)(u.pm * 256 + rt) * ld + u.pn * 256 + ch * 8) = d; }
};
struct EpiGateUp {
    bf16_t* hid;
    DI void pre(AccRef, const g8::Unit&, int, int, int, int) const {}
    DI void row(AccRef acc, const g8::Unit&, int ai, int m, int, int, int, int, u32x4 (&o)[2]) const {
        const f32x4 g0 = acc[ai][0][m][0], g1 = acc[ai][0][m][1], u0 = acc[ai][1][m][0], u1 = acc[ai][1][m][1];
        f32x4 v0, v1;
#pragma unroll
        for (int j = 0; j < 4; ++j) { v0[j] = g0[j] * __builtin_amdgcn_rcpf(1.0f + __expf(-g0[j])) * u0[j]; v1[j] = g1[j] * __builtin_amdgcn_rcpf(1.0f + __expf(-g1[j])) * u1[j]; }
        o[0] = pack8(v0, v1); o[1] = o[0];
    }
    DI void store(const g8::Unit& u, int rt, int ch, const u32x4& d) const { *(u32x4*)(hid + (size_t)(u.aux + rt) * DE + u.pn * 128 + ch * 8) = d; }
};
struct EpiDown {
    LAS unsigned char* lds; bf16_t* yb9; int* slot;
    DI void pre(AccRef, const g8::Unit&, int, int, int, int) const {}
    DI void row(AccRef acc, const g8::Unit& u, int ai, int m, int wr, int, int fr, int, u32x4 (&o)[2]) const {
        const int rt = ai * 128 + wr * 64 + m * 16 + fr;
        const float wgt = (u.e < NE) ? *(const LAS float*)(lds + MOE_IDX_OFF + u.par * 2048 + 1024 + rt * 4) : 1.0f;
        o[0] = pack8(acc[ai][0][m][0] * wgt, acc[ai][0][m][1] * wgt); o[1] = pack8(acc[ai][1][m][0] * wgt, acc[ai][1][m][1] * wgt);
    }
    DI void store(const g8::Unit& u, int rt, int ch, const u32x4& d) const {
        if (rt < u.nvalid) {
            const int srow = u.aux + rt;
            __builtin_nontemporal_store(d, (u32x4*)(yb9 + ((size_t)u.pn * YB_SLOTS + srow) * 256 + ch * 8));
            if (u.pn == 0 && ch == 0) {
                const int v = (u.e < NE) ? *(const LAS int*)(lds + MOE_IDX_OFF + u.par * 2048 + rt * 4) : (u.pm * 256 + rt) * 9 + 8;
                slot[v] = srow;
            }
        }
    }
};

DI void phase_inproj(const Params& p, LAS unsigned char* lds) {
    DenseSched S{(const char*)(p.ws + WS_H), (const char*)(p.ws + WS_WTIN), 64, 46, 4096, 4096, 32, (int)gridDim.x, (int)blockIdx.x};
    EpiInProj E{(bf16_t*)(p.ws + WS_PROJ), (const float*)(p.ws + WS_ROPE)};
    g8::gemm_phase<32, 0, GEMM_SPLIT>(lds, S, E);
}
DI void phase_outproj_a(const Params& p, LAS unsigned char* lds) {
    DenseSched S{(const char*)(p.ws + WS_ODIL), (const char*)(p.ws + WS_WTDIL), 64, 8, 1024, 1024, 8, (int)gridDim.x, (int)blockIdx.x};
    EpiGate<0> E{(const bf16_t*)(p.ws + WS_PROJ), nullptr, (bf16_t*)(p.ws + WS_TMP)};
    g8::gemm_phase<32, 0, GEMM_SPLIT>(lds, S, E);
}
DI void phase_outproj_b(const Params& p, LAS unsigned char* lds) {
    DenseSched S{(const char*)(p.ws + WS_OSB), (const char*)(p.ws + WS_WTSB), 64, 8, 2048, 2048, 16, (int)gridDim.x, (int)blockIdx.x};
    EpiGate<1> E{(const bf16_t*)(p.ws + WS_PROJ), (const bf16_t*)(p.ws + WS_TMP), (bf16_t*)(p.ws + WS_H)};
    g8::gemm_phase<32, 0, GEMM_SPLIT>(lds, S, E);
}
DI void phase_mixout(const Params& p, LAS unsigned char* lds) {
    DenseSched S{(const char*)(p.ws + WS_H), (const char*)(p.ws + WS_WTMIX), 64, 8, 4096, 4096, 32, (int)gridDim.x, (int)blockIdx.x};
    EpiPlain E{(bf16_t*)(p.ws + WS_Y), DM};
    g8::gemm_phase<32, 0, GEMM_SPLIT>(lds, S, E);
}
DI void moe_tables(const Params& p, LAS unsigned char* lds) {
    LAS int* tpre = (LAS int*)(lds + MOE_TAB_OFF);
    const int* cnt = (const int*)(p.ws + WS_CNT);
    if (threadIdx.x == 0) {
        int acc = 0;
        for (int e = 0; e < NE; ++e) { const int n = cnt[e]; tpre[e] = acc; tpre[NEX + 1 + e] = n; acc += (n + 255) >> 8; }
        tpre[NE] = acc; tpre[NEX + 1 + NE] = NTOK; acc += NTOK / 256; tpre[NEX] = acc;
    }
    __syncthreads();
    const int T = tpre[NEX];
    for (int t = threadIdx.x; t < T; t += 512) {
        int e = 0;
        for (int q = 1; q < NEX; ++q) e = (tpre[q] <= t) ? q : e;
        *(LAS unsigned char*)(lds + MOE_TILE_OFF + t) = (unsigned char)e;
    }
    __syncthreads();
}
DI void phase_gateup(const Params& p, LAS unsigned char* lds) {
    moe_tables(p, lds);
    MoeSched S{lds, (const int*)(p.ws + WS_LIST), (const float*)(p.ws + WS_LISTW), (const char*)(p.ws + WS_H), (const char*)(p.ws + WS_WGU), 4, 0, (int)gridDim.x, (int)blockIdx.x};
    EpiGateUp E{(bf16_t*)(p.ws + WS_HID)};
    g8::gemm_phase<16, MOE_BAUX, GEMM_SPLIT>(lds, S, E);
}
DI void phase_down(const Params& p, LAS unsigned char* lds) {
    moe_tables(p, lds);
    MoeSched S{lds, (const int*)(p.ws + WS_LIST), (const float*)(p.ws + WS_LISTW), (const char*)(p.ws + WS_HID), (const char*)(p.ws + WS_WD), 8, 1, (int)gridDim.x, (int)blockIdx.x};
    EpiDown E{lds, (bf16_t*)(p.ws + WS_YB9), (int*)(p.ws + WS_SLOT)};
    g8::gemm_phase<32, MOE_BAUX, GEMM_SPLIT>(lds, S, E);
}

namespace att {
constexpr int TB = 16384;
DI unsigned off_b(unsigned row, unsigned ch) { return 256u * row + 16u * (ch ^ (((row & 3u) << 2) | ((row >> 2) & 3u))); }
DI int crow(int i, int h) { return (i & 3) + 8 * (i >> 2) + 4 * h; }
DI f32x16 mfma32(bf16x8 a, bf16x8 b, f32x16 c) { return __builtin_amdgcn_mfma_f32_32x32x16_bf16(a, b, c, 0, 0, 0); }
DI bf16x8 pack8(const f32x16& x, int s) {
    u32x4 w; w.x = pk_bf16(x[8 * s + 0], x[8 * s + 1]); w.y = pk_bf16(x[8 * s + 2], x[8 * s + 3]); w.z = pk_bf16(x[8 * s + 4], x[8 * s + 5]); w.w = pk_bf16(x[8 * s + 6], x[8 * s + 7]);
    return __builtin_bit_cast(bf16x8, w);
}
DI void qk_tile(LAS const unsigned char* Kb, const bf16x8 (&qf)[8], f32x16& x0, f32x16& x1, int r, int h) {
#pragma unroll
    for (int i = 0; i < 16; ++i) { x0[i] = 0.f; x1[i] = 0.f; }
#pragma unroll
    for (int s = 0; s < 8; ++s) {
        const bf16x8 a0 = *(const LAS bf16x8*)(Kb + off_b(r, 2 * s + h));
        const bf16x8 a1 = *(const LAS bf16x8*)(Kb + off_b(32 + r, 2 * s + h));
        x0 = mfma32(a0, qf[s], x0); x1 = mfma32(a1, qf[s], x1);
    }
}
DI void pv_tile(LAS const unsigned char* Vb, const f32x16& p0, const f32x16& p1, f32x16 (&o)[4], int lane) {
    const int h = lane >> 5, blk = (lane >> 4) & 1, q = (lane & 15) >> 2, pp = lane & 3;
#pragma unroll
    for (int kb = 0; kb < 2; ++kb)
#pragma unroll
        for (int s = 0; s < 2; ++s) {
            const bf16x8 pf = pack8(kb ? p1 : p0, s);
#pragma unroll
            for (int db = 0; db < 4; ++db) {
                const unsigned row0 = 32 * kb + 16 * s + 4 * h + q;
                const unsigned ch = 4 * db + 2 * blk + (pp >> 1);
                const s16x4 t0 = __builtin_amdgcn_ds_read_tr16_b64_v4i16((LAS s16x4*)(Vb + off_b(row0, ch) + 8 * (pp & 1)));
                const s16x4 t1 = __builtin_amdgcn_ds_read_tr16_b64_v4i16((LAS s16x4*)(Vb + off_b(row0 + 8, ch) + 8 * (pp & 1)));
                const bf16x8 vf = {t0[0], t0[1], t0[2], t0[3], t1[0], t1[1], t1[2], t1[3]};
                o[db] = mfma32(vf, pf, o[db]);
            }
        }
}
DI void store_o(bf16_t* orow, const f32x16 (&o)[4], float scale, int h) {
#pragma unroll
    for (int db = 0; db < 4; ++db)
#pragma unroll
        for (int g = 0; g < 4; ++g) {
            u32x2 w; w.x = pk_bf16(o[db][4 * g] * scale, o[db][4 * g + 1] * scale); w.y = pk_bf16(o[db][4 * g + 2] * scale, o[db][4 * g + 3] * scale);
            *(u32x2*)(orow + 32 * db + 8 * g + 4 * h) = w;
        }
}

DI void sb_item(const Params& p, LAS unsigned char* lds, int b, int hd, int Q) {
    const bf16_t* proj = (const bf16_t*)(p.ws + WS_PROJ);
    bf16_t* osb = (bf16_t*)(p.ws + WS_OSB);
    const int tid = threadIdx.x, wid = __builtin_amdgcn_readfirstlane(tid >> 6), lane = tid & 63, r = lane & 31, h = lane >> 5;
    const size_t tokbase = (size_t)b * SEQ;
    const int wq0 = Q * 256 + 32 * wid;
    const int myq = wq0 + r;
    bf16x8 qf[8];
    f32x16 o[4];
#pragma unroll
    for (int db = 0; db < 4; ++db)
#pragma unroll
        for (int i = 0; i < 16; ++i) o[db][i] = 0.f;
    float R = 0.f;
    unsigned goff[2];
#pragma unroll
    for (int i = 0; i < 2; ++i) { const unsigned row = 4 * (wid * 2 + i) + (lane >> 4), cp = lane & 15, ch = cp ^ (((row & 3u) << 2) | ((row >> 2) & 3u)); goff[i] = (row * DIN + ch * 8) * 2; }
    const char* kbase = (const char*)(proj + tokbase * DIN + COL_KS + hd * 128);
    const char* vbase = (const char*)(proj + tokbase * DIN + COL_VS + hd * 128);
#define ATT_ISSUE(key0_, buf_) do { const size_t _ko = (size_t)(key0_) * DIN * 2; _Pragma("unroll") for (int _i = 0; _i < 2; ++_i) { \
        __builtin_amdgcn_global_load_lds((const unsigned*)(kbase + _ko + goff[_i]), (LAS unsigned*)(lds + (buf_) * TB + 1024 * (wid * 2 + _i)), 16, 0, 0); \
        __builtin_amdgcn_global_load_lds((const unsigned*)(vbase + _ko + goff[_i]), (LAS unsigned*)(lds + 3 * TB + (buf_) * TB + 1024 * (wid * 2 + _i)), 16, 0, 0); } } while (0)
    int j = 4 * Q + 3;
    ATT_ISSUE(64 * j, 0);
    ATT_ISSUE(64 * (j - 1), 1);
    {
        const bf16_t* qrow = proj + (tokbase + myq) * DIN + COL_QS + hd * 128;
#pragma unroll
        for (int s = 0; s < 8; ++s) qf[s] = *(const bf16x8*)(qrow + 16 * s + 8 * h);
#pragma unroll
        for (int s = 0; s < 8; ++s) asm volatile("" : "+v"(qf[s]));
    }
    int cur = 0;
    for (; j >= 0; --j) {
        LAS unsigned char* Kb = lds + cur * TB; LAS unsigned char* Vb = lds + 3 * TB + cur * TB;
        if (j > 0) asm volatile("s_waitcnt vmcnt(4)" ::: "memory"); else asm volatile("s_waitcnt vmcnt(0)" ::: "memory");
        __builtin_amdgcn_s_barrier(); asm volatile("" ::: "memory");
        if (j > 1) ATT_ISSUE(64 * (j - 2), cur == 0 ? 2 : cur - 1);
        const int key0 = 64 * j;
        if (key0 < wq0 + 31) {
            const bool need_mask = (key0 + 63 >= wq0);
            f32x16 x0, x1;
            qk_tile(Kb, qf, x0, x1, r, h);
            f32x16 l0, l1;
#pragma unroll
            for (int i = 0; i < 16; ++i) {
                l0[i] = __builtin_amdgcn_logf(1.0f + __builtin_amdgcn_exp2f(x0[i]));
                l1[i] = __builtin_amdgcn_logf(1.0f + __builtin_amdgcn_exp2f(x1[i]));
            }
            if (need_mask) {
#pragma unroll
                for (int i = 0; i < 16; ++i) { const int kk = key0 + crow(i, h); if (kk >= myq) l0[i] = 0.f; if (kk + 32 >= myq) l1[i] = 0.f; }
            }
#pragma unroll
            for (int g = 0; g < 4; ++g) {
                l0[4 * g + 2] += l0[4 * g + 3]; l0[4 * g + 1] += l0[4 * g + 2]; l0[4 * g] += l0[4 * g + 1];
                l1[4 * g + 2] += l1[4 * g + 3]; l1[4 * g + 1] += l1[4 * g + 2]; l1[4 * g] += l1[4 * g + 1];
            }
            float Tlo[8], Thi[8];
#pragma unroll
            for (int g = 0; g < 4; ++g) {
                { const unsigned t = __float_as_uint(l0[4 * g]); auto sw = __builtin_amdgcn_permlane32_swap(t, t, false, false); Tlo[g] = __uint_as_float(sw[0]); Thi[g] = __uint_as_float(sw[1]); }
                { const unsigned t = __float_as_uint(l1[4 * g]); auto sw = __builtin_amdgcn_permlane32_swap(t, t, false, false); Tlo[4 + g] = __uint_as_float(sw[0]); Thi[4 + g] = __uint_as_float(sw[1]); }
            }
            float offR[8];
            float run = 0.f;
#pragma unroll
            for (int g = 7; g >= 0; --g) { offR[g] = run + (h == 0 ? Thi[g] : 0.f) + R; run += Tlo[g] + Thi[g]; }
            f32x16 p0, p1;
#pragma unroll
            for (int i = 0; i < 16; ++i) {
                p0[i] = __builtin_amdgcn_exp2f(x0[i] - (l0[i] + offR[i >> 2]));
                p1[i] = __builtin_amdgcn_exp2f(x1[i] - (l1[i] + offR[4 + (i >> 2)]));
            }
            if (need_mask) {
#pragma unroll
                for (int i = 0; i < 16; ++i) { const int kk = key0 + crow(i, h); if (kk >= myq) p0[i] = 0.f; if (kk + 32 >= myq) p1[i] = 0.f; }
            }
            R += run;
            pv_tile(Vb, p0, p1, o, lane);
        }
        cur = (cur == 2) ? 0 : cur + 1;
    }
    store_o(osb + (tokbase + myq) * 1024 + hd * 128, o, 1.0f, h);
    __syncthreads();
}

DI void dil_item(const Params& p, LAS unsigned char* lds, int di) {
    const bf16_t* proj = (const bf16_t*)(p.ws + WS_PROJ);
    bf16_t* og = (bf16_t*)(p.ws + WS_OG);
    float* lse = (float*)(p.ws + WS_LSE);
    const int b = di / 192; const int rem = di - b * 192; const int head = rem >> 4, sub = rem & 15;
    const int grp = head >> 2;
    const int dil = grp == 0 ? 1 : grp == 1 ? 4 : 16;
    const int nblk = 16 / dil;
    const int res = sub / nblk, Qb = sub - res * nblk;
    const int i0 = Qb * 256;
    const int tid = threadIdx.x, wid = __builtin_amdgcn_readfirstlane(tid >> 6), lane = tid & 63, r = lane & 31, h = lane >> 5;
    const size_t tokbase = (size_t)b * SEQ;
    const int wq0 = i0 + 32 * wid;
    const int myqi = wq0 + r;
    const size_t mytok = tokbase + (size_t)myqi * dil + res;
    bf16x8 qf[8];
    f32x16 o[4];
#pragma unroll
    for (int db = 0; db < 4; ++db)
#pragma unroll
        for (int i = 0; i < 16; ++i) o[db][i] = 0.f;
    float mrun = -1e30f, lrun = 0.f;
    unsigned goff[2];
#pragma unroll
    for (int i = 0; i < 2; ++i) { const unsigned row = 4 * (wid * 2 + i) + (lane >> 4), cp = lane & 15, ch = cp ^ (((row & 3u) << 2) | ((row >> 2) & 3u)); goff[i] = (row * dil * DIN + ch * 8) * 2; }
    const char* kbase = (const char*)(proj + (tokbase + res) * DIN + COL_KA + head * 128);
    const char* vbase = (const char*)(proj + (tokbase + res) * DIN + COL_VA + head * 128);
    const int jt0 = (i0 == 0) ? 2 : 0;
    ATT_ISSUE((i0 - 128 + 64 * jt0) * dil, 0);
    ATT_ISSUE((i0 - 128 + 64 * (jt0 + 1)) * dil, 1);
    {
        const bf16_t* qrow = proj + mytok * DIN + COL_QA + head * 128;
#pragma unroll
        for (int s = 0; s < 8; ++s) qf[s] = *(const bf16x8*)(qrow + 16 * s + 8 * h);
#pragma unroll
        for (int s = 0; s < 8; ++s) asm volatile("" : "+v"(qf[s]));
    }
    int cur = 0;
    for (int jt = jt0; jt < 6; ++jt) {
        LAS unsigned char* Kb = lds + cur * TB; LAS unsigned char* Vb = lds + 3 * TB + cur * TB;
        if (jt < 5) asm volatile("s_waitcnt vmcnt(4)" ::: "memory"); else asm volatile("s_waitcnt vmcnt(0)" ::: "memory");
        __builtin_amdgcn_s_barrier(); asm volatile("" ::: "memory");
        if (jt < 4) ATT_ISSUE((i0 - 128 + 64 * (jt + 2)) * dil, cur == 0 ? 2 : cur - 1);
        const int ki0 = i0 - 128 + 64 * jt;
        if (ki0 <= wq0 + 31 && ki0 + 63 >= wq0 - 128) {
            f32x16 x0, x1;
            qk_tile(Kb, qf, x0, x1, r, h);
            const float NEG = -__builtin_inff();
#pragma unroll
            for (int i = 0; i < 16; ++i) {
                const int d0 = myqi - (ki0 + crow(i, h));
                if ((unsigned)d0 > 128u) x0[i] = NEG;
                if ((unsigned)(d0 - 32) > 128u) x1[i] = NEG;
            }
            float mx = x0[0];
#pragma unroll
            for (int i = 1; i < 16; ++i) mx = fmaxf(mx, x0[i]);
#pragma unroll
            for (int i = 0; i < 16; ++i) mx = fmaxf(mx, x1[i]);
            { const unsigned t = __float_as_uint(mx); auto sw = __builtin_amdgcn_permlane32_swap(t, t, false, false); mx = fmaxf(__uint_as_float(sw[0]), __uint_as_float(sw[1])); }
            const float mn = fmaxf(mrun, mx);
            const float alpha = __builtin_amdgcn_exp2f(mrun - mn);
            mrun = mn;
            f32x16 p0, p1; float rs = 0.f;
#pragma unroll
            for (int i = 0; i < 16; ++i) { p0[i] = __builtin_amdgcn_exp2f(x0[i] - mn); p1[i] = __builtin_amdgcn_exp2f(x1[i] - mn); rs += p0[i] + p1[i]; }
            { const unsigned t = __float_as_uint(rs); auto sw = __builtin_amdgcn_permlane32_swap(t, t, false, false); rs = __uint_as_float(sw[0]) + __uint_as_float(sw[1]); }
            lrun = lrun * alpha + rs;
#pragma unroll
            for (int db = 0; db < 4; ++db)
#pragma unroll
                for (int i = 0; i < 16; ++i) o[db][i] *= alpha;
            pv_tile(Vb, p0, p1, o, lane);
        }
        cur = (cur == 2) ? 0 : cur + 1;
    }
    store_o(og + mytok * 1536 + head * 128, o, 1.0f / lrun, h);
    if (h == 0) lse[mytok * 12 + head] = (mrun + __builtin_amdgcn_logf(lrun)) * LN2;
    __syncthreads();
}
#undef ATT_ISSUE
}

DI void phase_attn(const Params& p, LAS unsigned char* lds) {
    for (int it = blockIdx.x; it < 1024; it += gridDim.x) {
        if (it < 256) {
            const int xcd = it & 7, rest = it >> 3, bhi = rest >> 3, x = rest & 7, bh = xcd * 4 + bhi;
            att::sb_item(p, lds, bh >> 3, bh & 7, 15 - x);
            att::sb_item(p, lds, bh >> 3, bh & 7, x);
        } else att::dil_item(p, lds, it - 256);
    }
}

DI void phase_merge(const Params& p) {
    const int lane = threadIdx.x & 63, wid = threadIdx.x >> 6;
    const bf16_t* og = (const bf16_t*)(p.ws + WS_OG); const float* lse = (const float*)(p.ws + WS_LSE); bf16_t* odil = (bf16_t*)(p.ws + WS_ODIL);
    const int hg = lane >> 4, d0 = (lane & 15) * 8;
    for (int tok = blockIdx.x * 8 + wid; tok < NTOK; tok += gridDim.x * 8) {
        const float l0 = lse[(size_t)tok * 12 + hg], l1 = lse[(size_t)tok * 12 + 4 + hg], l2 = lse[(size_t)tok * 12 + 8 + hg];
        const float mx = fmaxf(l0, fmaxf(l1, l2));
        float w0 = __expf(l0 - mx), w1 = __expf(l1 - mx), w2 = __expf(l2 - mx);
        const float inv = 1.0f / (w0 + w1 + w2); w0 *= inv; w1 *= inv; w2 *= inv;
        const u32x4 a = *(const u32x4*)(og + (size_t)tok * 1536 + hg * 128 + d0);
        const u32x4 bq = *(const u32x4*)(og + (size_t)tok * 1536 + (4 + hg) * 128 + d0);
        const u32x4 c = *(const u32x4*)(og + (size_t)tok * 1536 + (8 + hg) * 128 + d0);
        u32x4 o;
#pragma unroll
        for (int q = 0; q < 4; ++q) {
            const float lo = w0 * bf_lo(a[q]) + w1 * bf_lo(bq[q]) + w2 * bf_lo(c[q]);
            const float hi = w0 * bf_hi(a[q]) + w1 * bf_hi(bq[q]) + w2 * bf_hi(c[q]);
            o[q] = pk_bf16(lo, hi);
        }
        *(u32x4*)(odil + (size_t)tok * 512 + hg * 128 + d0) = o;
    }
}

DI void phase_postmix(const Params& p, LAS unsigned char* lds) {
    const int tid = threadIdx.x, lane = tid & 63, wid = __builtin_amdgcn_readfirstlane(tid >> 6);
    LAS float* hsm = (LAS float*)lds;
    LAS float* part = (LAS float*)(lds + 131072);
    const float* mod = (const float*)(p.ws + WS_MOD); const bf16_t* y = (const bf16_t*)(p.ws + WS_Y);
    bf16_t* h2 = (bf16_t*)(p.ws + WS_H);
    int* cnt = (int*)(p.ws + WS_CNT); int* list = (int*)(p.ws + WS_LIST); float* listw = (float*)(p.ws + WS_LISTW);
    const bf16_t* wr_hi = (const bf16_t*)(p.ws + WS_WRT); const bf16_t* wr_lo = wr_hi + 64 * 2048;
    LAS int* lcnt = (LAS int*)(lds + 147456);
    LAS int* lbase = (LAS int*)(lds + 147712);
    LAS unsigned char* sel_e = lds + 147968;
    LAS unsigned short* sel_r = (LAS unsigned short*)(lds + 150016);
    LAS float* sel_w = (LAS float*)(lds + 154112);
    if (tid < 64) lcnt[tid] = 0;
    int itl = 0;
    for (int it = blockIdx.x; it < NTOK / 16; it += gridDim.x, ++itl) {
#pragma unroll 1
        for (int sub = 0; sub < 2; ++sub) {
            const int tl = 2 * wid + sub, tok = it * 16 + tl, b = tok >> 12;
            f32x4 v[8]; float ss = 0.f;
#pragma unroll
            for (int i = 0; i < 8; ++i) { const u32x2 yw = *(const u32x2*)(y + (size_t)tok * DM + 4 * (lane + 64 * i)); v[i] = (f32x4){bf_lo(yw.x), bf_hi(yw.x), bf_lo(yw.y), bf_hi(yw.y)}; ss += v[i][0] * v[i][0] + v[i][1] * v[i][1] + v[i][2] * v[i][2] + v[i][3] * v[i][3]; }
            ss = wave_sum(ss);
            const float rstd = rsqrtf(ss * (1.0f / DM) + RMS_EPS);
            float ss1 = 0.f;
#pragma unroll
            for (int i = 0; i < 8; ++i) {
                const int ch = 4 * (lane + 64 * i);
                const f32x4 g = *(const f32x4*)(p.g_post_mix + ch);
                const f32x4 gt = *(const f32x4*)(mod + b * 12288 + 4096 + ch);
                const f32x4 xv = *(const f32x4*)(p.x + (size_t)tok * DM + ch);
#pragma unroll
                for (int j = 0; j < 4; ++j) { v[i][j] = xv[j] + gt[j] * (v[i][j] * rstd * g[j]); ss1 += v[i][j] * v[i][j]; }
                *(f32x4*)(p.out + (size_t)tok * DM + ch) = v[i];
            }
            ss1 = wave_sum(ss1);
            const float rstd1 = rsqrtf(ss1 * (1.0f / DM) + RMS_EPS);
#pragma unroll
            for (int i = 0; i < 8; ++i) {
                const int ch = 4 * (lane + 64 * i);
                const f32x4 g = *(const f32x4*)(p.g_pre_ffn + ch);
                const f32x4 sh = *(const f32x4*)(mod + b * 12288 + 6144 + ch);
                const f32x4 sc = *(const f32x4*)(mod + b * 12288 + 8192 + ch);
                f32x4 o;
#pragma unroll
                for (int j = 0; j < 4; ++j) o[j] = v[i][j] * rstd1 * g[j] * (1.0f + sc[j]) + sh[j];
                u32x2 w; w.x = pk_bf16(o[0], o[1]); w.y = pk_bf16(o[2], o[3]);
                *(u32x2*)(h2 + (size_t)tok * DM + ch) = w;
                *(LAS f32x4*)(hsm + tl * 2048 + ch) = o;
            }
        }
        __syncthreads();
        f32x4 acc[4];
        {
            const int tr = lane & 15, kq = lane >> 4;
#pragma unroll
            for (int q = 0; q < 4; ++q) acc[q] = (f32x4){0.f, 0.f, 0.f, 0.f};
#pragma unroll 4
            for (int ks = 0; ks < 8; ++ks) {
                const int k0 = 256 * wid + 32 * ks + 8 * kq;
                const f32x4 a0 = *(const LAS f32x4*)(hsm + tr * 2048 + k0), a1 = *(const LAS f32x4*)(hsm + tr * 2048 + k0 + 4);
                u32x4 hw, lw;
                {
                    float xs[8] = {a0[0], a0[1], a0[2], a0[3], a1[0], a1[1], a1[2], a1[3]};
                    unsigned hh[4], ll[4];
#pragma unroll
                    for (int q = 0; q < 4; ++q) {
                        hh[q] = pk_bf16(xs[2 * q], xs[2 * q + 1]);
                        ll[q] = pk_bf16(xs[2 * q] - bf_lo(hh[q]), xs[2 * q + 1] - bf_hi(hh[q]));
                    }
                    hw = (u32x4){hh[0], hh[1], hh[2], hh[3]}; lw = (u32x4){ll[0], ll[1], ll[2], ll[3]};
                }
                const bf16x8 ah = __builtin_bit_cast(bf16x8, hw), al = __builtin_bit_cast(bf16x8, lw);
#pragma unroll
                for (int q = 0; q < 4; ++q) {
                    const bf16x8 bh = *(const bf16x8*)(wr_hi + (size_t)(16 * q + tr) * 2048 + k0);
                    const bf16x8 bl = *(const bf16x8*)(wr_lo + (size_t)(16 * q + tr) * 2048 + k0);
                    acc[q] = __builtin_amdgcn_mfma_f32_16x16x32_bf16(ah, bh, acc[q], 0, 0, 0);
                    acc[q] = __builtin_amdgcn_mfma_f32_16x16x32_bf16(ah, bl, acc[q], 0, 0, 0);
                    acc[q] = __builtin_amdgcn_mfma_f32_16x16x32_bf16(al, bh, acc[q], 0, 0, 0);
                }
            }
            if (wid >= 4) {
#pragma unroll
                for (int q = 0; q < 4; ++q)
#pragma unroll
                    for (int j = 0; j < 4; ++j) part[((wid - 4) * 16 + 4 * kq + j) * 64 + 16 * q + tr] = acc[q][j];
            }
        }
        __syncthreads();
        if (wid < 4) {
            const int tr = lane & 15, kq = lane >> 4;
#pragma unroll
            for (int q = 0; q < 4; ++q)
#pragma unroll
                for (int j = 0; j < 4; ++j) part[(wid * 16 + 4 * kq + j) * 64 + 16 * q + tr] += acc[q][j];
        }
        __syncthreads();
#pragma unroll 1
        for (int sub = 0; sub < 2; ++sub) {
            const int tl = 2 * wid + sub, tok = it * 16 + tl;
            const float logit = ((part[(0 * 16 + tl) * 64 + lane] + part[(1 * 16 + tl) * 64 + lane]) + part[(2 * 16 + tl) * 64 + lane]) + part[(3 * 16 + tl) * 64 + lane];
            const float score = 1.0f / (1.0f + __expf(-logit));
            const float sel = score + p.router_bias[lane];
            float m1 = sel;
            m1 = fmaxf(m1, __shfl_xor(m1, 1)); m1 = fmaxf(m1, __shfl_xor(m1, 2)); m1 = fmaxf(m1, __shfl_xor(m1, 4));
            const bool is1 = (sel == m1);
            const unsigned long long bal = __ballot(is1);
            const unsigned gm = (unsigned)(bal >> (lane & ~7)) & 0xffu;
            const int first = __ffs(gm) - 1;
            float m2 = (is1 && (lane & 7) == first) ? -__builtin_inff() : sel;
            m2 = fmaxf(m2, __shfl_xor(m2, 1)); m2 = fmaxf(m2, __shfl_xor(m2, 2)); m2 = fmaxf(m2, __shfl_xor(m2, 4));
            const float gs = m1 + m2;
            const int myg = lane >> 3;
            int grank = 0;
#pragma unroll 1
            for (int g = 0; g < 8; ++g) { const float gv = __uint_as_float(__builtin_amdgcn_readlane(__float_as_uint(gs), 8 * g)); grank += (gv > gs || (gv == gs && g < myg)) ? 1 : 0; }
            const bool gsel = grank < 4;
            const float msel = gsel ? sel : -__builtin_inff();
            int rk = 0;
#pragma unroll 4
            for (int e = 0; e < 64; ++e) { const float v = __uint_as_float(__builtin_amdgcn_readlane(__float_as_uint(msel), e)); rk += (v > msel || (v == msel && e < lane)) ? 1 : 0; }
            const bool chosen = gsel && rk < 8;
            const float ssum = wave_sum(chosen ? score : 0.f);
            if (chosen) {
                const int lr = __hip_atomic_fetch_add(lcnt + lane, 1, __ATOMIC_RELAXED, __HIP_MEMORY_SCOPE_WORKGROUP);
                const int idx = ((itl & 15) * 16 + tl) * 8 + rk;
                sel_e[idx] = (unsigned char)lane; sel_r[idx] = (unsigned short)lr; sel_w[idx] = score / ssum * 2.5f;
            }
            (void)tok;
        }
        __syncthreads();
        if ((itl & 15) == 15 || it + (int)gridDim.x >= NTOK / 16) {
            if (tid < 64) lbase[tid] = atomicAdd(&cnt[tid], lcnt[tid]);
            __syncthreads();
            const int nsel = ((itl & 15) + 1) * 128, it0 = itl & ~15;
            for (int idx = tid; idx < nsel; idx += 512) {
                const int e = sel_e[idx], tl = idx >> 3, k = idx & 7;
                const int tk = ((int)blockIdx.x + (it0 + (tl >> 4)) * (int)gridDim.x) * 16 + (tl & 15);
                const int pos = lbase[e] + sel_r[idx];
                list[e * LIST_CAP + pos] = tk * 9 + k; listw[e * LIST_CAP + pos] = sel_w[idx];
            }
            __syncthreads();
            if (tid < 64) lcnt[tid] = 0;
            __syncthreads();
        }
    }
}

DI void phase_combine(const Params& p) {
    const int lane = threadIdx.x & 63, wid = threadIdx.x >> 6;
    const float* mod = (const float*)(p.ws + WS_MOD); const bf16_t* yb9 = (const bf16_t*)(p.ws + WS_YB9); const int* slot = (const int*)(p.ws + WS_SLOT);
    for (int tok = blockIdx.x * 8 + wid; tok < NTOK; tok += gridDim.x * 8) {
        const int b = tok >> 12;
        float acc[4][8];
#pragma unroll
        for (int i = 0; i < 4; ++i)
#pragma unroll
            for (int j = 0; j < 8; ++j) acc[i][j] = 0.f;
#pragma unroll
        for (int k = 0; k < 9; ++k) {
            const bf16_t* row = yb9 + (size_t)slot[tok * 9 + k] * 256;
#pragma unroll
            for (int i = 0; i < 4; ++i) {
                const int c = lane + 64 * i;
                const u32x4 w = __builtin_nontemporal_load((const u32x4*)(row + (size_t)(c >> 5) * YB_SLOTS * 256 + (c & 31) * 8));
#pragma unroll
                for (int q = 0; q < 4; ++q) { acc[i][2 * q] += bf_lo(w[q]); acc[i][2 * q + 1] += bf_hi(w[q]); }
            }
        }
        float ss = 0.f;
#pragma unroll
        for (int i = 0; i < 4; ++i)
#pragma unroll
            for (int j = 0; j < 8; ++j) ss += acc[i][j] * acc[i][j];
        ss = wave_sum(ss);
        const float rstd = rsqrtf(ss * (1.0f / DM) + RMS_EPS);
#pragma unroll
        for (int i = 0; i < 4; ++i) {
            const int ch = 8 * (lane + 64 * i);
#pragma unroll
            for (int hh = 0; hh < 2; ++hh) {
                const f32x4 g = *(const f32x4*)(p.g_post_ffn + ch + 4 * hh);
                const f32x4 gt = *(const f32x4*)(mod + b * 12288 + 10240 + ch + 4 * hh);
                f32x4 xv = *(const f32x4*)(p.out + (size_t)tok * DM + ch + 4 * hh);
#pragma unroll
                for (int j = 0; j < 4; ++j) xv[j] += gt[j] * (acc[i][4 * hh + j] * rstd * g[j]);
                __builtin_nontemporal_store(xv, (f32x4*)(p.out + (size_t)tok * DM + ch + 4 * hh));
            }
        }
    }
}


DI void probe_copy(const Params& p) {
    u32x4* yb = (u32x4*)(p.ws + WS_YB9);
    const size_t n = (size_t)576 * MiB / 16;
    for (size_t i = (size_t)blockIdx.x * 512 + threadIdx.x; i < n; i += (size_t)gridDim.x * 512) { u32x4 v = yb[i]; asm volatile("" : "+v"(v)); yb[i] = v; }
}

constexpr int NPHASE = 12;
template <int PH> DI void run_phase(const Params& p, LAS unsigned char* lds) {
    if constexpr (PH == 0) phase_prologue(p, lds);
    else if constexpr (PH == 1) phase_prenorm(p);
    else if constexpr (PH == 2) phase_inproj(p, lds);
    else if constexpr (PH == 3) phase_attn(p, lds);
    else if constexpr (PH == 4) phase_merge(p);
    else if constexpr (PH == 5) phase_outproj_a(p, lds);
    else if constexpr (PH == 6) phase_outproj_b(p, lds);
    else if constexpr (PH == 7) phase_mixout(p, lds);
    else if constexpr (PH == 8) phase_postmix(p, lds);
    else if constexpr (PH == 9) phase_gateup(p, lds);
    else if constexpr (PH == 10) phase_down(p, lds);
    else phase_combine(p);
}
template <int PH> __global__ __launch_bounds__(512, 2) void k_phase(Params p) {
    extern __shared__ __attribute__((aligned(16))) unsigned char shm[];
    run_phase<PH>(p, (LAS unsigned char*)shm);
}
#if MK_FUSED
typedef const __attribute__((address_space(4))) Params* KargPtr;
template <int PH> DI void mega_phase(KargPtr kp0, LAS unsigned char* lds) {
    KargPtr kp = kp0; asm volatile("" : "+s"(kp));
    Params p{};
#if defined(__HIP_DEVICE_COMPILE__)
    p.x = kp->x; p.c = kp->c; p.pos = kp->pos; p.w_ada = kp->w_ada; p.b_ada = kp->b_ada; p.g_pre_mix = kp->g_pre_mix; p.g_post_mix = kp->g_post_mix; p.g_pre_ffn = kp->g_pre_ffn; p.g_post_ffn = kp->g_post_ffn; p.w_in = kp->w_in; p.w_dil_out = kp->w_dil_out; p.w_sb_out = kp->w_sb_out; p.w_mix_out = kp->w_mix_out; p.w_router = kp->w_router; p.router_bias = kp->router_bias; p.w_gate_e = kp->w_gate_e; p.w_up_e = kp->w_up_e; p.w_down_e = kp->w_down_e; p.w_gate_s = kp->w_gate_s; p.w_up_s = kp->w_up_s; p.w_down_s = kp->w_down_s; p.out = kp->out; p.ws = kp->ws;
#endif
    run_phase<PH>(p, lds);
}
__global__ __launch_bounds__(512, 2) void k_mega(Params p_unused) {
    extern __shared__ __attribute__((aligned(16))) unsigned char shm[];
    LAS unsigned char* lds = (LAS unsigned char*)shm;
    KargPtr kp0 = (KargPtr)__builtin_amdgcn_kernarg_segment_ptr();
    volatile LAS unsigned* xbw = (volatile LAS unsigned*)(lds + LDS_BYTES - 16);
    if (threadIdx.x == 0) { xbw[0] = 0u; xbw[1] = 0u; xbw[2] = 0u; xbw[3] = 0u; }
    __syncthreads();
    XcdBarrier bar;
    { KargPtr kp = kp0; asm volatile("" : "+s"(kp)); bar = xcd_barrier_post((unsigned*)(kp->ws + WS_BAR), xbw); }
    if (MK_STAMP >= 0 && blockIdx.x == 0 && threadIdx.x == 0) { KargPtr kq = kp0; asm volatile("" : "+s"(kq)); ((unsigned long long*)(kq->ws + WS_STAMP))[0] = wall_clock64(); }
#define MEGA_PH(n) do { mega_phase<n>(kp0, lds); xcd_barrier(bar); if (MK_REP == n) { mega_phase<n>(kp0, lds); xcd_barrier(bar); } \
        if (MK_STAMP >= 0 && blockIdx.x == 0 && threadIdx.x == 0) { KargPtr kq = kp0; asm volatile("" : "+s"(kq)); ((unsigned long long*)(kq->ws + WS_STAMP))[n + 1] = wall_clock64(); } } while (0)
#if MK_REP == 90
#define MK_PROBE_DOWN_NOSTORE 1
#endif
    MEGA_PH(0); MEGA_PH(1); MEGA_PH(2); MEGA_PH(3); MEGA_PH(4); MEGA_PH(5); MEGA_PH(6); MEGA_PH(7); MEGA_PH(8); MEGA_PH(9); MEGA_PH(10);
#if MK_REP == 100
    { KargPtr kp = kp0; asm volatile("" : "+s"(kp)); Params p{}; p.ws = kp->ws; probe_copy(p); xcd_barrier(bar); }
#endif
#undef MEGA_PH
    mega_phase<11>(kp0, lds);
#if MK_STAMP >= 0
    xcd_barrier(bar);
    if (blockIdx.x == 0 && threadIdx.x == 0) {
        KargPtr kq = kp0; asm volatile("" : "+s"(kq));
        unsigned long long* st = (unsigned long long*)(kq->ws + WS_STAMP);
        st[12] = wall_clock64();
        const int k = MK_STAMP < 100 ? MK_STAMP : MK_STAMP - 100;
        const unsigned long long t0 = (MK_STAMP < 100) ? st[k] : st[0], t1 = (MK_STAMP < 100) ? st[k + 1] : st[k + 1];
        kq->out[0] += 2.0f + (float)(t1 - t0) * (MK_STAMP < 100 ? 0.0005f : 0.0001f);
    }
#endif
}
#endif

template <int PH> static void launch_phase(const Params& p, int grid, hipStream_t stream) {
    static bool init = false;
    if (!init) { (void)hipFuncSetAttribute((const void*)k_phase<PH>, hipFuncAttributeMaxDynamicSharedMemorySize, LDS_BYTES); init = true; }
    hipLaunchKernelGGL(k_phase<PH>, dim3(grid), dim3(512), LDS_BYTES, stream, p);
}

extern "C" void kernel_launch(void* const* d_in, const int* in_sizes, int n_in, void* d_out, int out_size, void* d_ws, size_t ws_size, hipStream_t stream) {
    (void)in_sizes; (void)n_in; (void)out_size;
    static int grid = 0;
    if (!grid) {
        int dev = 0, cus = 0; (void)hipGetDevice(&dev); (void)hipDeviceGetAttribute(&cus, hipDeviceAttributeMultiprocessorCount, dev);
        if (cus <= 0) cus = 256;
#if MK_FUSED
        (void)hipFuncSetAttribute((const void*)k_mega, hipFuncAttributeMaxDynamicSharedMemorySize, LDS_BYTES);
        int per_cu = 0;
        if (hipOccupancyMaxActiveBlocksPerMultiprocessor(&per_cu, (const void*)k_mega, 512, LDS_BYTES) != hipSuccess || per_cu < 1)
            fprintf(stderr, "kernel_launch: occupancy query reports %d workgroups per CU\n", per_cu);
#endif
        grid = cus;
        if (ws_size < WS_TOTAL) fprintf(stderr, "kernel_launch: workspace too small: %zu < %zu\n", ws_size, (size_t)WS_TOTAL);
    }
    Params p{};
    p.x = (const float*)d_in[0]; p.c = (const float*)d_in[1]; p.pos = (const int*)d_in[2];
    p.w_ada = (const float*)d_in[3]; p.b_ada = (const float*)d_in[4];
    p.g_pre_mix = (const float*)d_in[5]; p.g_post_mix = (const float*)d_in[6]; p.g_pre_ffn = (const float*)d_in[7]; p.g_post_ffn = (const float*)d_in[8];
    p.w_in = (const float*)d_in[9]; p.w_dil_out = (const float*)d_in[10]; p.w_sb_out = (const float*)d_in[11]; p.w_mix_out = (const float*)d_in[12];
    p.w_router = (const float*)d_in[13]; p.router_bias = (const float*)d_in[14];
    p.w_gate_e = (const float*)d_in[15]; p.w_up_e = (const float*)d_in[16]; p.w_down_e = (const float*)d_in[17];
    p.w_gate_s = (const float*)d_in[18]; p.w_up_s = (const float*)d_in[19]; p.w_down_s = (const float*)d_in[20];
    p.out = (float*)d_out; p.ws = (unsigned char*)d_ws;
    (void)hipMemsetAsync((unsigned char*)d_ws + WS_BAR, 0, WS_ZERO_BYTES, stream);
#if MK_FUSED
    hipLaunchKernelGGL(k_mega, dim3(grid), dim3(512), LDS_BYTES, stream, p);
#else
    launch_phase<0>(p, grid, stream); launch_phase<1>(p, grid, stream); launch_phase<2>(p, grid, stream); launch_phase<3>(p, grid, stream);
    launch_phase<4>(p, grid, stream); launch_phase<5>(p, grid, stream); launch_phase<6>(p, grid, stream); launch_phase<7>(p, grid, stream);
    launch_phase<8>(p, grid, stream); launch_phase<9>(p, grid, stream); launch_phase<10>(p, grid, stream); launch_phase<11>(p, grid, stream);
#endif
}
```

```cpp
#include <hip/hip_runtime.h>
#include <stdint.h>
#include <stdio.h>

#ifndef MK_FUSED
#define MK_FUSED 1
#endif
#ifndef MK_STAMP
#define MK_STAMP -1
#endif
#ifndef MK_REP
#define MK_REP -1
#endif

#define LAS __attribute__((address_space(3)))
#define DI __device__ __forceinline__
typedef unsigned short bf16_t;
typedef short bf16x8 __attribute__((ext_vector_type(8)));
typedef short s16x4 __attribute__((ext_vector_type(4)));
typedef float f32x2 __attribute__((ext_vector_type(2)));
typedef float f32x4 __attribute__((ext_vector_type(4)));
typedef float f32x16 __attribute__((ext_vector_type(16)));
typedef unsigned u32x2 __attribute__((ext_vector_type(2)));
typedef unsigned u32x4 __attribute__((ext_vector_type(4)));
typedef __bf16 bf16x2_t __attribute__((ext_vector_type(2)));
typedef const __attribute__((address_space(1))) char* gcptr;
typedef const __attribute__((address_space(1))) u32x4* gu4ptr;
typedef int i32x8 __attribute__((ext_vector_type(8)));
typedef short s16x16 __attribute__((ext_vector_type(16)));

constexpr int NBATCH = 4, SEQ = 4096, NTOK = NBATCH * SEQ, DM = 2048, DIN = 11776;
constexpr int COL_QA = 0, COL_KA = 1536, COL_VA = 3072, COL_QS = 4608, COL_KS = 5632, COL_VS = 6656, COL_GD = 7680, COL_GS = 9728;
constexpr int NE = 64, DE = 512, NEX = 65;
constexpr int LIST_CAP = 16384;
constexpr int YB_SLOTS = 163840;
constexpr float RMS_EPS = 1e-6f;
constexpr float QSCALE = 0.08838834764831845f * 1.4426950408889634f;
constexpr float LN2 = 0.6931471805599453f;
constexpr float W8_SCALE = 64.0f;
constexpr int W8_MX = 0x79797979, A8_MX = 0x7f7f7f7f;

constexpr size_t MiB = 1ull << 20;
constexpr size_t WS_BAR = 0;
constexpr size_t WS_CNT = 16384;
constexpr size_t WS_ZERO_BYTES = 32768;
constexpr size_t WS_STAMP = 32768;

constexpr size_t WS_MOD = 65536;
constexpr size_t WS_LSE = 262144;
constexpr size_t WS_ROPE = 1 * MiB;
constexpr size_t WS_LIST = 3 * MiB;
constexpr size_t WS_LISTW = 7 * MiB;
constexpr size_t WS_SLOT = 262144;
constexpr size_t WS_WD = 11 * MiB;
constexpr size_t WS_H = 141 * MiB;
constexpr size_t WS_HID = 205 * MiB;
constexpr size_t WS_WTIN = 205 * MiB;
constexpr size_t WS_TMP = 205 * MiB;
constexpr size_t WS_OG = 251 * MiB;
constexpr size_t WS_OSB = 299 * MiB;
constexpr size_t WS_ODIL = 331 * MiB;
constexpr size_t WS_WTDIL = 347 * MiB;
constexpr size_t WS_WTSB = 349 * MiB;
constexpr size_t WS_WTMIX = 353 * MiB;
constexpr size_t WS_PROJ = 365 * MiB;
constexpr size_t WS_Y = 365 * MiB;
constexpr size_t WS_YB9 = 365 * MiB;
constexpr size_t WS_WGU = 733 * MiB;
constexpr size_t WS_WRT = 1005 * MiB;
constexpr size_t WS_TOTAL = 1006 * MiB;

#ifndef MOE_BAUX
#define MOE_BAUX 0
#endif
#ifndef GEMM_SPLIT
#define GEMM_SPLIT false
#endif
constexpr int LDS_BYTES = 163840;

struct Params {
    const float *x, *c; const int* pos;
    const float *w_ada, *b_ada, *g_pre_mix, *g_post_mix, *g_pre_ffn, *g_post_ffn;
    const float *w_in, *w_dil_out, *w_sb_out, *w_mix_out, *w_router, *router_bias;
    const float *w_gate_e, *w_up_e, *w_down_e, *w_gate_s, *w_up_s, *w_down_s;
    float* out; unsigned char* ws;
};

DI unsigned pk_bf16(float lo, float hi) { f32x2 v = {lo, hi}; bf16x2_t r = __builtin_convertvector(v, bf16x2_t); return __builtin_bit_cast(unsigned, r); }
DI unsigned pk_fp8x4(float a, float b, float c, float d) { int p = __builtin_amdgcn_cvt_pk_fp8_f32(a, b, 0, false); p = __builtin_amdgcn_cvt_pk_fp8_f32(c, d, p, true); return (unsigned)p; }
DI float bf_lo(unsigned u) { return __uint_as_float(u << 16); }
DI float bf_hi(unsigned u) { return __uint_as_float(u & 0xffff0000u); }
DI float wave_sum(float v) {
#pragma unroll
    for (int o = 32; o >= 1; o >>= 1) v += __shfl_xor(v, o);
    return v;
}
DI float sigmoidf_(float x) { return __builtin_amdgcn_rcpf(1.0f + __expf(-x)); }

#define XB_TMO      128
#define XB_XCNT(j)  (256  + 64 * (j))
#define XB_XSUB(j)  (1280 + 64 * (j))
#define XB_XGEN(j)  (2304 + 64 * (j))
#define XB_TOP      3328
#define XB_TOPGEN   3392
#define XCD_BAR_WORDS 3456
#define XB_SPIN_CAP (1u << 18)

__device__ __forceinline__ unsigned xb_ld(unsigned* p)              { return __hip_atomic_load(p, __ATOMIC_RELAXED, __HIP_MEMORY_SCOPE_AGENT); }
__device__ __forceinline__ unsigned xb_add(unsigned* p, unsigned v) { return __hip_atomic_fetch_add(p, v, __ATOMIC_RELAXED, __HIP_MEMORY_SCOPE_AGENT); }
__device__ __forceinline__ unsigned xb_xcc_id() { return (unsigned)__builtin_amdgcn_s_getreg((3 << 11) | 20) & 0xFu; }
#define XB_SPIN(cond, bar) do { unsigned _sp = 0; while (cond) { __builtin_amdgcn_s_sleep(1); \
    if ((++_sp & 255u) == 0u) { if (xb_ld(&(bar)[XB_TMO])) break; if (_sp > XB_SPIN_CAP) { atomicAdd(&(bar)[XB_TMO], 1u); break; } } } } while (0)

struct XcdBarrier { unsigned* bar; unsigned x; volatile LAS unsigned* st; };

__device__ __forceinline__ XcdBarrier xcd_barrier_post(unsigned* bar, volatile LAS unsigned* st) {
    XcdBarrier b; b.bar = bar; b.x = xb_xcc_id(); b.st = st;
    if (threadIdx.x == 0) (void)xb_add(&bar[XB_XCNT(b.x)], 1u);
    return b;
}
__device__ __forceinline__ void xcd_barrier_complete(unsigned* bar, unsigned x, unsigned& nloc, unsigned& nx) {
    const unsigned G = gridDim.x * gridDim.y * gridDim.z;
    unsigned sum, cnt, mine, sp = 0u;
    for (;;) {
        sum = 0u; cnt = 0u; mine = 0u;
#pragma unroll
        for (unsigned j = 0; j < 16; ++j) { const unsigned c = xb_ld(&bar[XB_XCNT(j)]); sum += c; cnt += (c > 0u) ? 1u : 0u; mine = (j == x) ? c : mine; }
        if (sum == G) break;
        __builtin_amdgcn_s_sleep(1);
        if ((++sp & 255u) == 0u) { if (xb_ld(&bar[XB_TMO])) break; if (sp > XB_SPIN_CAP) { atomicAdd(&bar[XB_TMO], 1u); break; } }
    }
    nloc = mine > 0u ? mine : 1u; nx = cnt > 0u ? cnt : 1u;
}
__device__ __forceinline__ void xcd_barrier(const XcdBarrier& b) {
    asm volatile("s_waitcnt vmcnt(0)" ::: "memory");
    __syncthreads();
    if (threadIdx.x == 0) {
        unsigned* bar = b.bar;
        __builtin_amdgcn_s_waitcnt(0);
        unsigned nloc = b.st[0], nx = b.st[1];
        if (nloc == 0u) { xcd_barrier_complete(bar, b.x, nloc, nx); b.st[0] = nloc; b.st[1] = nx; }
        const unsigned old = xb_add(&bar[XB_XSUB(b.x)], 1u);
        const unsigned gen = old / nloc;
        if (old + 1u == (gen + 1u) * nloc) {
            __builtin_amdgcn_fence(__ATOMIC_RELEASE, "agent");
            asm volatile("s_waitcnt vmcnt(0)" ::: "memory");
            const unsigned og = xb_add(&bar[XB_TOP], 1u);
            const unsigned tg = og / nx;
            if (og + 1u == (tg + 1u) * nx) xb_add(&bar[XB_TOPGEN], 1u);
            else XB_SPIN(xb_ld(&bar[XB_TOPGEN]) == tg, bar);
            __builtin_amdgcn_fence(__ATOMIC_ACQUIRE, "agent");
            xb_add(&bar[XB_XGEN(b.x)], 1u);
            asm volatile("s_waitcnt vmcnt(0)" ::: "memory");
        } else {
            XB_SPIN(xb_ld(&bar[XB_XGEN(b.x)]) == gen, bar);
            __builtin_amdgcn_fence(__ATOMIC_ACQUIRE, "agent");
            asm volatile("s_waitcnt vmcnt(0)" ::: "memory");
        }
    }
    __syncthreads();
}

struct CvtMat { const float* src; bf16_t* dst; int K, N, nb, mode; size_t sstride, dstride; };
constexpr int CVT_NMAT = 10;
constexpr int CVT_TILES[CVT_NMAT] = {2944, 128, 256, 512, 8192, 8192, 8192, 128, 128, 128};
constexpr int CVT_TOTAL = 2944 + 128 + 256 + 512 + 8192 * 3 + 128 * 3;
constexpr int P0_MOD_UNITS = 192, P0_ROPE_UNITS = 64, P0_WR_UNITS = 8, P0_ITEMS = P0_MOD_UNITS + P0_ROPE_UNITS + P0_WR_UNITS + CVT_TOTAL;

DI CvtMat cvt_mat(const Params& p, int m) {
    bf16_t* wtin = (bf16_t*)(p.ws + WS_WTIN); bf16_t* wtdil = (bf16_t*)(p.ws + WS_WTDIL); bf16_t* wtsb = (bf16_t*)(p.ws + WS_WTSB); bf16_t* wtmix = (bf16_t*)(p.ws + WS_WTMIX);
    bf16_t* wgu = (bf16_t*)(p.ws + WS_WGU); bf16_t* wd = (bf16_t*)(p.ws + WS_WD);
    CvtMat r;
    switch (m) {
        case 0: r = {p.w_in, wtin, 2048, 11776, 1, 0, 0, 0}; break;
        case 1: r = {p.w_dil_out, wtdil, 512, 2048, 1, 0, 0, 0}; break;
        case 2: r = {p.w_sb_out, wtsb, 1024, 2048, 1, 0, 0, 0}; break;
        case 3: r = {p.w_mix_out, wtmix, 2048, 2048, 1, 0, 0, 0}; break;
        case 4: r = {p.w_gate_e, wgu, 2048, 512, 64, 1, (size_t)2048 * 512, (size_t)1024 * 2048}; break;
        case 5: r = {p.w_up_e, wgu, 2048, 512, 64, 2, (size_t)2048 * 512, (size_t)1024 * 2048}; break;
        case 6: r = {p.w_down_e, wd, 512, 2048, 64, 0, (size_t)512 * 2048, (size_t)2048 * 512}; break;
        case 7: r = {p.w_gate_s, (bf16_t*)((unsigned char*)wgu + (size_t)64 * 1024 * 2048), 2048, 512, 1, 1, 0, 0}; break;
        case 8: r = {p.w_up_s, (bf16_t*)((unsigned char*)wgu + (size_t)64 * 1024 * 2048), 2048, 512, 1, 2, 0, 0}; break;
        default: r = {p.w_down_s, (bf16_t*)((unsigned char*)wd + (size_t)64 * 2048 * 512), 512, 2048, 1, 0, 0, 0}; break;
    }
    return r;
}

DI void cvt_tile(const Params& p, int t, LAS unsigned char* lds) {
    int m = 0;
#pragma unroll
    for (int i = 0; i < CVT_NMAT - 1; ++i) { if (t >= CVT_TILES[i] && m == i) { t -= CVT_TILES[i]; m = i + 1; } }
    const CvtMat M = cvt_mat(p, m);
    const int tn = M.N / 64, tk = M.K / 128;
    const int b = t / (tn * tk); const int rem = t - b * (tn * tk); const int kt = rem / tn, nt = rem - kt * tn;
    const float* src = M.src + (size_t)b * M.sstride + (size_t)(kt * 128) * M.N + nt * 64;
    const int tid = threadIdx.x;
    const int kq = tid >> 4, n4 = (tid & 15) * 4;
    f32x4 v[4];
#pragma unroll
    for (int i = 0; i < 4; ++i) v[i] = __builtin_nontemporal_load((const f32x4*)(src + (size_t)(kq + 32 * i) * M.N + n4));
    const int c = nt * 64 + (tid >> 3);
    const int drow = M.mode == 0 ? c : (((c >> 7) << 8) + (c & 127) + (M.mode == 2 ? 128 : 0));
    if (m < 4) {
        bf16_t* dst = M.dst + (size_t)b * M.dstride;
        constexpr int P = 272;
#pragma unroll
        for (int i = 0; i < 4; ++i) {
            const int k = kq + 32 * i;
#pragma unroll
            for (int j = 0; j < 4; ++j) { const unsigned u = pk_bf16(v[i][j], 0.f); *(LAS bf16_t*)(lds + (n4 + j) * P + k * 2) = (bf16_t)(u & 0xffffu); }
        }
        __syncthreads();
#pragma unroll
        for (int i = 0; i < 2; ++i) {
            const int ch = (tid & 7) + 8 * i;
            const u32x4 w = *(const LAS u32x4*)(lds + (tid >> 3) * P + ch * 16);
            *(u32x4*)(dst + (size_t)drow * M.K + kt * 128 + ch * 8) = w;
        }
    } else {
        unsigned char* dst = (unsigned char*)M.dst + (size_t)b * M.dstride;
        constexpr int P = 144;
#pragma unroll
        for (int i = 0; i < 4; ++i) {
            const int k = kq + 32 * i;
#pragma unroll
            for (int j = 0; j < 4; ++j) { const int q = __builtin_amdgcn_cvt_pk_fp8_f32(v[i][j] * W8_SCALE, 0.f, 0, false); *(LAS unsigned char*)(lds + (n4 + j) * P + k) = (unsigned char)(q & 0xff); }
        }
        __syncthreads();
        const u32x4 w = *(const LAS u32x4*)(lds + (tid >> 3) * P + (tid & 7) * 16);
        __builtin_nontemporal_store(w, (u32x4*)(dst + (size_t)drow * M.K + kt * 128 + (tid & 7) * 16));
    }
    __syncthreads();
}

DI void mod_unit(const Params& p, int u, LAS unsigned char* lds) {
    const int tid = threadIdx.x, c0 = u * 64;
    LAS float* sc = (LAS float*)lds;
    LAS float* red = (LAS float*)(lds + 32768);
    for (int i = tid; i < 4 * 2048; i += 512) { const float v = p.c[i]; sc[i] = v / (1.0f + __expf(-v)); }
    __syncthreads();
    const int kq = tid >> 4, cq = tid & 15;
    float acc[4][4];
#pragma unroll
    for (int b = 0; b < 4; ++b)
#pragma unroll
        for (int j = 0; j < 4; ++j) acc[b][j] = 0.f;
    for (int it = 0; it < 64; ++it) {
        const int k = kq + 32 * it;
        const f32x4 w = __builtin_nontemporal_load((const f32x4*)(p.w_ada + (size_t)k * 12288 + c0 + 4 * cq));
#pragma unroll
        for (int b = 0; b < 4; ++b) { const float s = sc[b * 2048 + k];
#pragma unroll
            for (int j = 0; j < 4; ++j) acc[b][j] += s * w[j]; }
    }
#pragma unroll
    for (int b = 0; b < 4; ++b)
#pragma unroll
        for (int j = 0; j < 4; ++j) red[(kq * 4 + b) * 64 + 4 * cq + j] = acc[b][j];
    __syncthreads();
    if (tid < 256) {
        const int b = tid >> 6, col = tid & 63;
        float s = 0.f;
        for (int q = 0; q < 32; ++q) s += red[(q * 4 + b) * 64 + col];
        float* mod = (float*)(p.ws + WS_MOD);
        mod[b * 12288 + c0 + col] = s + p.b_ada[c0 + col];
    }
    __syncthreads();
}

DI void rope_unit(const Params& p, int u) {
    float2* rope = (float2*)(p.ws + WS_ROPE);
    for (int e = threadIdx.x; e < 4096; e += 512) {
        const int tok = u * 256 + (e >> 4), i = e & 15;
        const float invf = (float)pow(500000.0, -(double)i / 16.0);
        const float ang = (float)p.pos[tok] * invf;
        rope[tok * 16 + i] = make_float2((float)cos((double)ang), (float)sin((double)ang));
    }
}

DI void wr_unit(const Params& p, int u) {
    bf16_t* hi = (bf16_t*)(p.ws + WS_WRT); bf16_t* lo = hi + 64 * 2048;
    for (int i = threadIdx.x; i < 16384; i += 512) {
        const int idx = u * 16384 + i, k = idx >> 6, e = idx & 63;
        const float x = p.w_router[idx];
        const unsigned h = pk_bf16(x, 0.f) & 0xffffu;
        const float r = x - __uint_as_float(h << 16);
        hi[e * 2048 + k] = (bf16_t)h; lo[e * 2048 + k] = (bf16_t)(pk_bf16(r, 0.f) & 0xffffu);
    }
}
DI void phase_prologue(const Params& p, LAS unsigned char* lds) {
    for (int it = blockIdx.x; it < P0_ITEMS; it += gridDim.x) {
        if (it < P0_MOD_UNITS) mod_unit(p, it, lds);
        else if (it < P0_MOD_UNITS + P0_ROPE_UNITS) rope_unit(p, it - P0_MOD_UNITS);
        else if (it < P0_MOD_UNITS + P0_ROPE_UNITS + P0_WR_UNITS) wr_unit(p, it - P0_MOD_UNITS - P0_ROPE_UNITS);
        else cvt_tile(p, it - P0_MOD_UNITS - P0_ROPE_UNITS - P0_WR_UNITS, lds);
    }
}

DI void phase_prenorm(const Params& p) {
    const int lane = threadIdx.x & 63, wid = threadIdx.x >> 6;
    const float* mod = (const float*)(p.ws + WS_MOD);
    bf16_t* h = (bf16_t*)(p.ws + WS_H);
    for (int tok = blockIdx.x * 8 + wid; tok < NTOK; tok += gridDim.x * 8) {
        const int b = tok >> 12;
        const float* xr = p.x + (size_t)tok * DM;
        f32x4 v[8]; float ss = 0.f;
#pragma unroll
        for (int i = 0; i < 8; ++i) { v[i] = *(const f32x4*)(xr + 4 * (lane + 64 * i)); ss += v[i][0] * v[i][0] + v[i][1] * v[i][1] + v[i][2] * v[i][2] + v[i][3] * v[i][3]; }
        ss = wave_sum(ss);
        const float rstd = rsqrtf(ss * (1.0f / DM) + RMS_EPS);
#pragma unroll
        for (int i = 0; i < 8; ++i) {
            const int ch = 4 * (lane + 64 * i);
            const f32x4 g = *(const f32x4*)(p.g_pre_mix + ch);
            const f32x4 sh = *(const f32x4*)(mod + b * 12288 + ch);
            const f32x4 sc = *(const f32x4*)(mod + b * 12288 + 2048 + ch);
            f32x4 o;
#pragma unroll
            for (int j = 0; j < 4; ++j) o[j] = v[i][j] * rstd * g[j] * (1.0f + sc[j]) + sh[j];
            u32x2 w; w.x = pk_bf16(o[0], o[1]); w.y = pk_bf16(o[2], o[3]);
            *(u32x2*)(h + (size_t)tok * DM + ch) = w;
        }
    }
}

namespace g8 {
constexpr int BM = 256, BK = 64, HALF = 128, HTB = HALF * BK * 2, STAGE_BYTES = 8 * HTB, NXCD = 8, WGM = 8;
DI int lds_byte(int r, int c) { const int st = (r >> 4) * 2 + (c >> 5), rr = r & 15, cc = c & 31, ob = rr * 64 + cc * 2; return st * 1024 + (ob ^ (((ob >> 9) & 1) << 5)); }
DI void stage_rc(int b, int& R, int& C) { const int st = b / 1024, sb = b % 1024, swz = sb ^ (((sb >> 9) & 1) << 5); R = (st >> 1) * 16 + swz / 64; C = (st & 1) * 32 + (swz % 64) / 2; }
DI int perm32(int rho) { const int n = rho >> 4, i = rho & 15; return 8 * (i >> 2) + 4 * n + (i & 3); }

struct Unit {
    const char* A; const char* B;
    int row0;
    int lda, ldb, nt;
    int pm, pn, aux, keep;
    int e, nvalid, par;
};

DI bool static_tile(int L, int nM, int nN, int& pm, int& pn) {
    const int nwg = nM * nN; if (L >= nwg) return false;
    int wgid = L; { const int q = nwg / NXCD, r = nwg % NXCD, xcd = wgid % NXCD, off = wgid / NXCD; wgid = (xcd < r ? xcd * (q + 1) : r * (q + 1) + (xcd - r) * q) + off; }
    const int nig = WGM * nN, gid = wgid / nig, fm = gid * WGM, gsz = (nM - fm) < WGM ? (nM - fm) : WGM;
    pm = fm + ((wgid % nig) % gsz); pn = (wgid % nig) / gsz; return true;
}

constexpr int EXCH_OFF = STAGE_BYTES + 8192;
DI void epi_bar() { asm volatile("s_waitcnt lgkmcnt(0)" ::: "memory"); __builtin_amdgcn_s_barrier(); asm volatile("" ::: "memory"); }

template <int NCH, int BAUX, bool SPLIT, bool FP8, class Sched, class Epi>
DI void gemm_phase(LAS unsigned char* lds, const Sched& S, const Epi& E) {
    const int tid = threadIdx.x, wid = __builtin_amdgcn_readfirstlane(tid >> 6), lane = tid & 63, wr = wid >> 2, wc = wid & 3, fr = lane & 15, fq = lane >> 4;
    const bool loader = SPLIT ? (wr == 0) : true, storer = SPLIT ? (wr == 1) : true;
    constexpr int NP = SPLIT ? 4 : 2, PSTEP = SPLIT ? 4 : 8, RSTEP = SPLIT ? 32 : 64;
    const int p0 = SPLIT ? wc : wid;
    int R0, C0; stage_rc(p0 * 1024 + lane * 16, R0, C0);
    const int sC = C0 * 2, sRb = (R0 & ~31) + perm32(R0 & 31);
    const int aoff = lds_byte(wr * 64 + fr, fq * 8), boff = lds_byte(wc * 32 + fr, fq * 8);
#define G8_SA(b, h) (((b) * 2 + (h)) * HTB)
#define G8_SB(b, h) ((4 + (b) * 2 + (h)) * HTB)
#define G8_STAGE_A(bufoff, gbase, voff) do { if (loader) { _Pragma("unroll") for (int _i = 0; _i < NP; ++_i) \
        __builtin_amdgcn_global_load_lds((const unsigned*)((const char*)(gbase) + (voff)[_i]), (LAS unsigned*)(lds + (bufoff) + (p0 + PSTEP * _i) * 1024), 16, 0, 0); } } while (0)
#define G8_STAGE_B(bufoff, gbase, voff, ldb32) do { if (loader) { _Pragma("unroll") for (int _i = 0; _i < NP; ++_i) { \
        const char* _gb = (const char*)(gbase) + (size_t)_i * (ldb32); asm volatile("" : "+s"(_gb));     \
        __builtin_amdgcn_global_load_lds((const unsigned*)(_gb + (voff)), (LAS unsigned*)(lds + (bufoff) + (p0 + PSTEP * _i) * 1024), 16, 0, BAUX); } } } while (0)
#define G8_LDA(dst, b, h) do { _Pragma("unroll") for (int m = 0; m < 4; ++m) _Pragma("unroll") for (int k = 0; k < 2; ++k) dst[m][k] = *(const LAS bf16x8*)(lds + G8_SA(b, h) + aoff + m * 2048 + k * 1024); } while (0)
#define G8_LDB(dst, b, h) do { _Pragma("unroll") for (int n = 0; n < 2; ++n) _Pragma("unroll") for (int k = 0; k < 2; ++k) dst[n][k] = *(const LAS bf16x8*)(lds + G8_SB(b, h) + boff + n * 2048 + k * 1024); } while (0)
#define G8_MMA(ai, bj, At, Bt) do { __builtin_amdgcn_s_setprio(1); _Pragma("unroll") for (int m = 0; m < 4; ++m) _Pragma("unroll") for (int n = 0; n < 2; ++n) { \
        if (!FP8) { _Pragma("unroll") for (int k = 0; k < 2; ++k) acc[ai][bj][m][n] = __builtin_amdgcn_mfma_f32_16x16x32_bf16(Bt[n][k], At[m][k], acc[ai][bj][m][n], 0, 0, 0); } \
        else { const i32x8 _w = __builtin_bit_cast(i32x8, __builtin_shufflevector(Bt[n][0], Bt[n][1], 0, 1, 2, 3, 4, 5, 6, 7, 8, 9, 10, 11, 12, 13, 14, 15)); \
               const i32x8 _x = __builtin_bit_cast(i32x8, __builtin_shufflevector(At[m][0], At[m][1], 0, 1, 2, 3, 4, 5, 6, 7, 8, 9, 10, 11, 12, 13, 14, 15)); \
               acc[ai][bj][m][n] = __builtin_amdgcn_mfma_scale_f32_16x16x128_f8f6f4(_w, _x, acc[ai][bj][m][n], 0, 0, 0, W8_MX, 0, A8_MX); } } \
        __builtin_amdgcn_s_setprio(0); } while (0)
#define G8_WAIT_V8 do { if (SPLIT) { if (loader) asm volatile("s_waitcnt vmcnt(8)" ::: "memory"); } else asm volatile("s_waitcnt vmcnt(4)" ::: "memory"); } while (0)
#define G8_WAIT_V12 do { if (SPLIT) { if (loader) asm volatile("s_waitcnt vmcnt(12)" ::: "memory"); } else asm volatile("s_waitcnt vmcnt(6)" ::: "memory"); } while (0)
#define G8_WAIT_V0 do { if (loader) asm volatile("s_waitcnt vmcnt(0)" ::: "memory"); } while (0)
#define G8_WAIT_L(n) asm volatile("s_waitcnt lgkmcnt(" #n ")" ::: "memory")
#define G8_BAR __builtin_amdgcn_s_barrier()
#define G8_SCHED __builtin_amdgcn_sched_barrier(0)
#define G8_OFFS(u, vA, vB) do { if (loader) { _Pragma("unroll") for (int _h = 0; _h < 2; ++_h) _Pragma("unroll") for (int _i = 0; _i < NP; ++_i) \
        vA[_h][_i] = (unsigned)S.arow(u, _h * 128 + R0 + RSTEP * _i) * (unsigned)(u).lda + (unsigned)sC; \
        vB = (unsigned)sRb * (unsigned)(u).ldb + (unsigned)sC; } } while (0)
    Unit cur, nxt; int ui = 0;
    if (!S.next(0, cur)) return;
    f32x4 acc[2][2][4][2];
#pragma unroll
    for (int a = 0; a < 2; ++a)
#pragma unroll
        for (int b = 0; b < 2; ++b)
#pragma unroll
            for (int m = 0; m < 4; ++m)
#pragma unroll
                for (int n = 0; n < 2; ++n) acc[a][b][m][n] = (f32x4){0.f, 0.f, 0.f, 0.f};
    bf16x8 At[4][2], B0[2][2], B1[2][2];
    unsigned vA[2][NP], vB = 0u;
#pragma unroll
    for (int i = 0; i < NP; ++i) { vA[0][i] = 0u; vA[1][i] = 0u; }
    if (S.prefetch(cur, wid, lane)) { G8_WAIT_V0; G8_BAR; }
    G8_OFFS(cur, vA, vB);
    const char* cA = cur.A; const char* cB = cur.B; size_t hB = (size_t)128 * cur.ldb; size_t q32 = (size_t)RSTEP * cur.ldb;
    constexpr size_t kstep = 128;
    G8_STAGE_B(G8_SB(0, 0), cB, vB, q32); G8_STAGE_A(G8_SA(0, 0), cA, vA[0]); G8_STAGE_B(G8_SB(0, 1), cB + hB, vB, q32); G8_STAGE_A(G8_SA(0, 1), cA, vA[1]);
    if (wr == 1) G8_BAR;
    G8_WAIT_V8; G8_BAR;
    G8_STAGE_B(G8_SB(1, 0), cB + kstep, vB, q32); G8_STAGE_A(G8_SA(1, 0), cA + kstep, vA[0]); G8_STAGE_B(G8_SB(1, 1), cB + hB + kstep, vB, q32);
    G8_WAIT_V12; G8_BAR;
    for (;;) {
        bool has_next = false;
        const char* nA = cA; const char* nB = cB; size_t nhB = hB, nq32 = q32;
        const int nt = cur.nt;
#pragma unroll 1
        for (int t = 0; t < nt; t += 2) {
            const bool last = (t == nt - 2);
            const char* a1 = cA + (size_t)(t + 1) * kstep;
            G8_LDB(B0, 0, 0); G8_SCHED; G8_LDA(At, 0, 0); G8_STAGE_A(G8_SA(1, 1), a1, vA[1]);
            G8_WAIT_L(8); G8_BAR; G8_WAIT_L(0); G8_MMA(0, 0, At, B0); G8_BAR; G8_SCHED;
            if (t == 0) { Unit pf; if (S.next(ui + 1, pf)) (void)S.prefetch(pf, wid, lane); }
            const char* a2; const char* b2; size_t h2, q2;
            if (last) {
                has_next = S.next(ui + 1, nxt);
                if (has_next) { G8_OFFS(nxt, vA, vB); nA = nxt.A; nB = nxt.B; nhB = (size_t)128 * nxt.ldb; nq32 = (size_t)RSTEP * nxt.ldb; }
                a2 = nA; b2 = nB; h2 = nhB; q2 = nq32;
            } else { a2 = cA + (size_t)(t + 2) * kstep; b2 = cB + (size_t)(t + 2) * kstep; h2 = hB; q2 = q32; }
            const char* a3 = a2 + kstep; const char* b3 = b2 + kstep;
            G8_LDB(B1, 0, 1); G8_STAGE_B(G8_SB(0, 0), b2, vB, q2);
            G8_BAR; G8_WAIT_L(0); G8_MMA(0, 1, At, B1); G8_BAR;
            G8_LDA(At, 0, 1); G8_STAGE_A(G8_SA(0, 0), a2, vA[0]);
            G8_BAR; G8_WAIT_L(0); G8_MMA(1, 0, At, B0); G8_BAR; G8_SCHED;
            G8_STAGE_B(G8_SB(0, 1), b2 + h2, vB, q2);
            G8_WAIT_V12; G8_BAR; G8_MMA(1, 1, At, B1); G8_BAR;
            G8_LDB(B0, 1, 0); G8_SCHED; G8_LDA(At, 1, 0); G8_STAGE_A(G8_SA(0, 1), a2, vA[1]);
            G8_WAIT_L(8); G8_BAR; G8_WAIT_L(0); G8_MMA(0, 0, At, B0); G8_BAR; G8_SCHED;
            G8_LDB(B1, 1, 1); G8_STAGE_B(G8_SB(1, 0), b3, vB, q2);
            G8_BAR; G8_WAIT_L(0); G8_MMA(0, 1, At, B1); G8_BAR;
            G8_LDA(At, 1, 1); G8_STAGE_A(G8_SA(1, 0), a3, vA[0]);
            G8_BAR; G8_WAIT_L(0); G8_MMA(1, 0, At, B0); G8_BAR; G8_SCHED;
            G8_STAGE_B(G8_SB(1, 1), b3 + h2, vB, q2);
            G8_WAIT_V12; G8_BAR; G8_MMA(1, 1, At, B1); G8_BAR;
        }
        int tz = threadIdx.x; asm volatile("" : "+v"(tz));
        const int lane_e = tz & 63, fr_e = tz & 15, fq_e = (tz >> 4) & 3;
        {
            E.pre(acc, cur, wr, wc, fr_e, fq_e);
            constexpr int PITCH = NCH * 16 + 16;
            LAS unsigned char* ex = lds + EXCH_OFF;
            if (wr == 0) G8_BAR;
#pragma unroll
            for (int ai = 0; ai < 2; ++ai)
#pragma unroll
                for (int m = 0; m < 4; ++m) {
                    u32x4 o[2];
                    E.row(acc, cur, ai, m, wr, wc, fr_e, fq_e, o);
                    if (NCH == 32) {
                        *(LAS u32x4*)(ex + (wr * 16 + fr_e) * PITCH + (wc * 32 + 8 * fq_e) * 2) = o[0];
                        *(LAS u32x4*)(ex + (wr * 16 + fr_e) * PITCH + (128 + wc * 32 + 8 * fq_e) * 2) = o[1];
                    } else {
                        *(LAS u32x4*)(ex + (wr * 16 + fr_e) * PITCH + (wc * 32 + 8 * fq_e) * 2) = o[0];
                    }
                    epi_bar();
                    if (storer) {
                        constexpr int RPI = 64 / NCH;
                        constexpr int RPW = SPLIT ? 8 : 4;
                        const int rbase = SPLIT ? 8 * wc : 4 * wid;
#pragma unroll
                        for (int i = 0; i < RPW / RPI; ++i) {
                            const int rl = rbase + RPI * i + lane_e / NCH, ch = lane_e % NCH;
                            const int rt = ai * 128 + (rl >> 4) * 64 + m * 16 + (rl & 15);
                            const u32x4 d = *(const LAS u32x4*)(ex + rl * PITCH + ch * 16);
                            E.store(cur, rt, ch, d);
                        }
                    }
                    epi_bar();
                }
            if (wr == 1) G8_BAR;
        }
        if (!has_next) break;
#pragma unroll
        for (int a = 0; a < 2; ++a)
#pragma unroll
            for (int b = 0; b < 2; ++b)
#pragma unroll
                for (int m = 0; m < 4; ++m)
#pragma unroll
                    for (int n = 0; n < 2; ++n) acc[a][b][m][n] = (f32x4){0.f, 0.f, 0.f, 0.f};
        cur = nxt; cA = nA; cB = nB; hB = nhB; q32 = nq32; ++ui;
    }
    G8_WAIT_V0;
    if (wr == 0) G8_BAR;
    G8_BAR;
#undef G8_SA
#undef G8_SB
#undef G8_STAGE_A
#undef G8_STAGE_B
#undef G8_LDA
#undef G8_LDB
#undef G8_MMA
#undef G8_WAIT_V8
#undef G8_WAIT_V12
#undef G8_WAIT_V0
#undef G8_WAIT_L
#undef G8_BAR
#undef G8_SCHED
#undef G8_OFFS
}
}

struct DenseSched {
    const char* A; const char* Bt; int nM, nN, lda, ldb, nt, G, c;
    DI bool next(int i, g8::Unit& u) const {
        int pm, pn; if (!g8::static_tile(i * G + c, nM, nN, pm, pn)) return false;
        pm = __builtin_amdgcn_readfirstlane(pm); pn = __builtin_amdgcn_readfirstlane(pn);
        u.A = A; u.B = Bt + (size_t)pn * 256 * ldb; u.row0 = pm * 256; u.lda = lda; u.ldb = ldb; u.nt = nt; u.pm = pm; u.pn = pn; u.aux = 0; u.keep = 0; u.e = 0; u.nvalid = 256; u.par = 0; return true;
    }
    DI int arow(const g8::Unit& u, int rr) const { return u.row0 + rr; }
    DI bool prefetch(const g8::Unit&, int, int) const { return false; }
};
constexpr int MOE_TAB_OFF = g8::STAGE_BYTES;
constexpr int MOE_TILE_OFF = g8::STAGE_BYTES + 1024;
constexpr int MOE_IDX_OFF = g8::STAGE_BYTES + 2048;
struct MoeSched {
    LAS unsigned char* lds; const int* list; const float* listw; const char* A; const char* W; int ncol, mode  , G, c;
    DI bool next(int i, g8::Unit& u) const {
        const LAS int* tpre = (const LAS int*)(lds + MOE_TAB_OFF);
        const int L = i * G + c; const int T = __builtin_amdgcn_readfirstlane(tpre[NEX]);
        if (L >= T * ncol) return false;
        const int gt = __builtin_amdgcn_readfirstlane(L / ncol), pn = L - gt * ncol;
        const int e = __builtin_amdgcn_readfirstlane((int)*(const LAS unsigned char*)(lds + MOE_TILE_OFF + gt));
        const int tile = gt - __builtin_amdgcn_readfirstlane(tpre[e]);
        const int n_e = __builtin_amdgcn_readfirstlane(tpre[NEX + 1 + e]);
        u.e = e; u.pm = tile; u.pn = pn; u.nvalid = min(256, n_e - tile * 256); u.keep = 0; u.aux = gt * 256; u.par = i & 1;
        if (mode == 0) { u.A = A; u.lda = 2048; u.ldb = 2048; u.nt = 16; u.B = W + ((size_t)e * 1024 + (size_t)pn * 256) * 2048; u.row0 = tile * 256; }
        else { u.A = A; u.lda = 512; u.ldb = 512; u.nt = 4; u.B = W + ((size_t)e * 2048 + (size_t)pn * 256) * 512; u.row0 = gt * 256; }
        return true;
    }
    DI bool prefetch(const g8::Unit& u, int wid, int lane) const {
        if (u.e < NE && wid < 4) {
            const int r = min(wid * 64 + lane, u.nvalid - 1);
            const size_t src = (size_t)u.e * LIST_CAP + u.pm * 256 + r;
            __builtin_amdgcn_global_load_lds((const unsigned*)(list + src), (LAS unsigned*)(lds + MOE_IDX_OFF + u.par * 2048 + wid * 256), 4, 0, 0);
            if (mode == 1) __builtin_amdgcn_global_load_lds((const unsigned*)(listw + src), (LAS unsigned*)(lds + MOE_IDX_OFF + u.par * 2048 + 1024 + wid * 256), 4, 0, 0);
        }
        return true;
    }
    DI int arow(const g8::Unit& u, int rr) const {
        if (mode == 1) return u.row0 + rr;
        if (u.e >= NE) return u.row0 + rr;
        return *(const LAS int*)(lds + MOE_IDX_OFF + u.par * 2048 + rr * 4) / 9;
    }
};

typedef f32x4 (&AccRef)[2][2][4][2];
DI u32x4 pack8(const f32x4& v0, const f32x4& v1) { u32x4 w; w.x = pk_bf16(v0[0], v0[1]); w.y = pk_bf16(v0[2], v0[3]); w.z = pk_bf16(v1[0], v1[1]); w.w = pk_bf16(v1[2], v1[3]); return w; }

struct EpiInProj {
    bf16_t* proj; const float* rope;
    DI static int kind_of(int pn) { return pn < 6 ? 0 : pn < 12 ? 1 : pn < 18 ? 2 : pn < 22 ? 3 : pn < 30 ? 2 : 4; }
    DI void pre(AccRef acc, const g8::Unit& u, int wr, int wc, int fr, int fq) const {
        if (kind_of(u.pn) <= 1 && wc == 0) {
            const float sg = (fq < 2) ? -1.0f : 1.0f;
#pragma unroll
            for (int g = 0; g < 4; ++g) {
                const int ai = g >> 1;
                f32x4 cs[2][4];
#pragma unroll
                for (int mm = 0; mm < 2; ++mm) { const int m = (g & 1) * 2 + mm; const int row = u.pm * 256 + ai * 128 + wr * 64 + m * 16 + fr;
#pragma unroll
                    for (int q = 0; q < 4; ++q) cs[mm][q] = *(const f32x4*)(rope + (size_t)row * 32 + 16 * (fq & 1) + 4 * q); }
#pragma unroll
                for (int mm = 0; mm < 2; ++mm) { const int m = (g & 1) * 2 + mm;
#pragma unroll
                    for (int bj = 0; bj < 2; ++bj) {
                        f32x4 v0 = acc[ai][bj][m][0], v1 = acc[ai][bj][m][1], p0, p1;
#pragma unroll
                        for (int j = 0; j < 4; ++j) { p0[j] = __shfl_xor(v0[j], 32); p1[j] = __shfl_xor(v1[j], 32); }
#pragma unroll
                        for (int j = 0; j < 4; ++j) {
                            const float c0 = cs[mm][j >> 1][(j & 1) * 2], s0 = cs[mm][j >> 1][(j & 1) * 2 + 1];
                            const float c1 = cs[mm][2 + (j >> 1)][(j & 1) * 2], s1 = cs[mm][2 + (j >> 1)][(j & 1) * 2 + 1];
                            v0[j] = v0[j] * c0 + sg * p0[j] * s0;
                            v1[j] = v1[j] * c1 + sg * p1[j] * s1;
                        }
                        acc[ai][bj][m][0] = v0; acc[ai][bj][m][1] = v1;
                    }
                    asm volatile("" : "+v"(acc[ai][0][m][0]), "+v"(acc[ai][0][m][1]), "+v"(acc[ai][1][m][0]), "+v"(acc[ai][1][m][1]));
                }
                asm volatile("" ::: "memory");
            }
        }
    }
    DI void row(AccRef acc, const g8::Unit& u, int ai, int m, int wr, int wc, int fr, int fq, u32x4 (&o)[2]) const {
        const int kind = kind_of(u.pn);
#pragma unroll
        for (int bj = 0; bj < 2; ++bj) {
            f32x4 v0 = acc[ai][bj][m][0], v1 = acc[ai][bj][m][1];
            if (kind == 0 || kind == 3) { v0 *= QSCALE; v1 *= QSCALE; }
            if (kind == 4) {
#pragma unroll
                for (int j = 0; j < 4; ++j) { v0[j] = sigmoidf_(v0[j]); v1[j] = sigmoidf_(v1[j]); }
            }
            o[bj] = pack8(v0, v1);
        }
    }
    DI void store(const g8::Unit& u, int rt, int ch, const u32x4& d) const { __builtin_nontemporal_store(d, (u32x4*)(proj + (size_t)(u.pm * 256 + rt) * DIN + u.pn * 256 + ch * 8)); }
};
template <int PART> struct EpiGate {
    const bf16_t* proj; const bf16_t* tmp; bf16_t* out;
    DI void pre(AccRef acc, const g8::Unit& u, int wr, int wc, int fr, int fq) const {
        const unsigned vo_g = (unsigned)(((wr * 64 + fr) * DIN + wc * 32 + 8 * fq) * 2), vo_t = (unsigned)(((wr * 64 + fr) * DM + wc * 32 + 8 * fq) * 2);
#pragma unroll
        for (int ai = 0; ai < 2; ++ai)
#pragma unroll
            for (int m = 0; m < 4; ++m) {
#pragma unroll
                for (int bj = 0; bj < 2; ++bj) {
                    gcptr sg = (gcptr)(proj + (size_t)(u.pm * 256 + ai * 128 + m * 16) * DIN + u.pn * 256 + bj * 128 + (PART == 0 ? COL_GD : COL_GS));
                    asm volatile("" : "+s"(sg));
                    const u32x4 gg = *(gu4ptr)(sg + vo_g);
                    const float sv[8] = {bf_lo(gg.x), bf_hi(gg.x), bf_lo(gg.y), bf_hi(gg.y), bf_lo(gg.z), bf_hi(gg.z), bf_lo(gg.w), bf_hi(gg.w)};
                    if (PART == 0) {
#pragma unroll
                        for (int j = 0; j < 4; ++j) { acc[ai][bj][m][0][j] *= sv[j]; acc[ai][bj][m][1][j] *= sv[4 + j]; }
                    } else {
                        gcptr st = (gcptr)(tmp + (size_t)(u.pm * 256 + ai * 128 + m * 16) * DM + u.pn * 256 + bj * 128);
                        asm volatile("" : "+s"(st));
                        const u32x4 tt = *(gu4ptr)(st + vo_t);
                        const float tv[8] = {bf_lo(tt.x), bf_hi(tt.x), bf_lo(tt.y), bf_hi(tt.y), bf_lo(tt.z), bf_hi(tt.z), bf_lo(tt.w), bf_hi(tt.w)};
#pragma unroll
                        for (int j = 0; j < 4; ++j) { acc[ai][bj][m][0][j] = acc[ai][bj][m][0][j] * sv[j] + tv[j]; acc[ai][bj][m][1][j] = acc[ai][bj][m][1][j] * sv[4 + j] + tv[4 + j]; }
                    }
                }
                asm volatile("" : "+v"(acc[ai][0][m][0]), "+v"(acc[ai][0][m][1]), "+v"(acc[ai][1][m][0]), "+v"(acc[ai][1][m][1]));
                if (m & 1) asm volatile("" ::: "memory");
            }
    }
    DI void row(AccRef acc, const g8::Unit&, int ai, int m, int, int, int, int, u32x4 (&o)[2]) const {
        o[0] = pack8(acc[ai][0][m][0], acc[ai][0][m][1]); o[1] = pack8(acc[ai][1][m][0], acc[ai][1][m][1]);
    }
    DI void store(const g8::Unit& u, int rt, int ch, const u32x4& d) const { *(u32x4*)(out + (size_t)(u.pm * 256 + rt) * DM + u.pn * 256 + ch * 8) = d; }
};
struct EpiPlain {
    bf16_t* out; int ld;
    DI void pre(AccRef, const g8::Unit&, int, int, int, int) const {}
    DI void row(AccRef acc, const g8::Unit&, int ai, int m, int, int, int, int, u32x4 (&o)[2]) const {
        o[0] = pack8(acc[ai][0][m][0], acc[ai][0][m][1]); o[1] = pack8(acc[ai][1][m][0], acc[ai][1][m][1]);
    }
    DI void store(const g8::Unit& u, int rt, int ch, const u32x4& d) const { *(u32x4*)(out + (size_t)(u.pm * 256 + rt) * ld + u.pn * 256 + ch * 8) = d; }
};
struct EpiGateUp {
    unsigned char* hid;
    DI void pre(AccRef, const g8::Unit&, int, int, int, int) const {}
    DI void row(AccRef acc, const g8::Unit&, int ai, int m, int, int, int, int, u32x4 (&o)[2]) const {
        const f32x4 g0 = acc[ai][0][m][0], g1 = acc[ai][0][m][1], u0 = acc[ai][1][m][0], u1 = acc[ai][1][m][1];
        f32x4 v0, v1;
#pragma unroll
        for (int j = 0; j < 4; ++j) { v0[j] = g0[j] * __builtin_amdgcn_rcpf(1.0f + __expf(-g0[j])) * u0[j]; v1[j] = g1[j] * __builtin_amdgcn_rcpf(1.0f + __expf(-g1[j])) * u1[j]; }
        o[0] = pack8(v0, v1); o[1] = o[0];
    }
    DI void store(const g8::Unit& u, int rt, int ch, const u32x4& d) const {
        u32x2 w; w.x = pk_fp8x4(bf_lo(d.x), bf_hi(d.x), bf_lo(d.y), bf_hi(d.y)); w.y = pk_fp8x4(bf_lo(d.z), bf_hi(d.z), bf_lo(d.w), bf_hi(d.w));
        *(u32x2*)(hid + (size_t)(u.aux + rt) * DE + u.pn * 128 + ch * 8) = w;
    }
};
struct EpiDown {
    LAS unsigned char* lds; bf16_t* yb9; int* slot;
    DI void pre(AccRef, const g8::Unit&, int, int, int, int) const {}
    DI void row(AccRef acc, const g8::Unit& u, int ai, int m, int wr, int, int fr, int, u32x4 (&o)[2]) const {
        const int rt = ai * 128 + wr * 64 + m * 16 + fr;
        const float wgt = (u.e < NE) ? *(const LAS float*)(lds + MOE_IDX_OFF + u.par * 2048 + 1024 + rt * 4) : 1.0f;
        o[0] = pack8(acc[ai][0][m][0] * wgt, acc[ai][0][m][1] * wgt); o[1] = pack8(acc[ai][1][m][0] * wgt, acc[ai][1][m][1] * wgt);
    }
    DI void store(const g8::Unit& u, int rt, int ch, const u32x4& d) const {
        if (rt < u.nvalid) {
            const int srow = u.aux + rt;
            __builtin_nontemporal_store(d, (u32x4*)(yb9 + ((size_t)u.pn * YB_SLOTS + srow) * 256 + ch * 8));
            if (u.pn == 0 && ch == 0) {
                const int v = (u.e < NE) ? *(const LAS int*)(lds + MOE_IDX_OFF + u.par * 2048 + rt * 4) : (u.pm * 256 + rt) * 9 + 8;
                slot[v] = srow;
            }
        }
    }
};

DI void phase_inproj(const Params& p, LAS unsigned char* lds) {
    DenseSched S{(const char*)(p.ws + WS_H), (const char*)(p.ws + WS_WTIN), 64, 46, 4096, 4096, 32, (int)gridDim.x, (int)blockIdx.x};
    EpiInProj E{(bf16_t*)(p.ws + WS_PROJ), (const float*)(p.ws + WS_ROPE)};
    g8::gemm_phase<32, 0, GEMM_SPLIT, false>(lds, S, E);
}
DI void phase_outproj_a(const Params& p, LAS unsigned char* lds) {
    DenseSched S{(const char*)(p.ws + WS_ODIL), (const char*)(p.ws + WS_WTDIL), 64, 8, 1024, 1024, 8, (int)gridDim.x, (int)blockIdx.x};
    EpiGate<0> E{(const bf16_t*)(p.ws + WS_PROJ), nullptr, (bf16_t*)(p.ws + WS_TMP)};
    g8::gemm_phase<32, 0, GEMM_SPLIT, false>(lds, S, E);
}
DI void phase_outproj_b(const Params& p, LAS unsigned char* lds) {
    DenseSched S{(const char*)(p.ws + WS_OSB), (const char*)(p.ws + WS_WTSB), 64, 8, 2048, 2048, 16, (int)gridDim.x, (int)blockIdx.x};
    EpiGate<1> E{(const bf16_t*)(p.ws + WS_PROJ), (const bf16_t*)(p.ws + WS_TMP), (bf16_t*)(p.ws + WS_H)};
    g8::gemm_phase<32, 0, GEMM_SPLIT, false>(lds, S, E);
}
DI void phase_mixout(const Params& p, LAS unsigned char* lds) {
    DenseSched S{(const char*)(p.ws + WS_H), (const char*)(p.ws + WS_WTMIX), 64, 8, 4096, 4096, 32, (int)gridDim.x, (int)blockIdx.x};
    EpiPlain E{(bf16_t*)(p.ws + WS_Y), DM};
    g8::gemm_phase<32, 0, GEMM_SPLIT, false>(lds, S, E);
}
DI void moe_tables(const Params& p, LAS unsigned char* lds) {
    LAS int* tpre = (LAS int*)(lds + MOE_TAB_OFF);
    const int* cnt = (const int*)(p.ws + WS_CNT);
    if (threadIdx.x == 0) {
        int acc = 0;
        for (int e = 0; e < NE; ++e) { const int n = cnt[e]; tpre[e] = acc; tpre[NEX + 1 + e] = n; acc += (n + 255) >> 8; }
        tpre[NE] = acc; tpre[NEX + 1 + NE] = NTOK; acc += NTOK / 256; tpre[NEX] = acc;
    }
    __syncthreads();
    const int T = tpre[NEX];
    for (int t = threadIdx.x; t < T; t += 512) {
        int e = 0;
        for (int q = 1; q < NEX; ++q) e = (tpre[q] <= t) ? q : e;
        *(LAS unsigned char*)(lds + MOE_TILE_OFF + t) = (unsigned char)e;
    }
    __syncthreads();
}
DI void phase_gateup(const Params& p, LAS unsigned char* lds) {
    moe_tables(p, lds);
    MoeSched S{lds, (const int*)(p.ws + WS_LIST), (const float*)(p.ws + WS_LISTW), (const char*)(p.ws + WS_H), (const char*)(p.ws + WS_WGU), 4, 0, (int)gridDim.x, (int)blockIdx.x};
    EpiGateUp E{(unsigned char*)(p.ws + WS_HID)};
    g8::gemm_phase<16, MOE_BAUX, GEMM_SPLIT, true>(lds, S, E);
}
DI void phase_down(const Params& p, LAS unsigned char* lds) {
    moe_tables(p, lds);
    MoeSched S{lds, (const int*)(p.ws + WS_LIST), (const float*)(p.ws + WS_LISTW), (const char*)(p.ws + WS_HID), (const char*)(p.ws + WS_WD), 8, 1, (int)gridDim.x, (int)blockIdx.x};
    EpiDown E{lds, (bf16_t*)(p.ws + WS_YB9), (int*)(p.ws + WS_SLOT)};
    g8::gemm_phase<32, MOE_BAUX, GEMM_SPLIT, true>(lds, S, E);
}

namespace att {
constexpr int TB = 16384;
DI unsigned off_b(unsigned row, unsigned ch) { return 256u * row + 16u * (ch ^ (((row & 3u) << 2) | ((row >> 2) & 3u))); }
DI int crow(int i, int h) { return (i & 3) + 8 * (i >> 2) + 4 * h; }
DI f32x16 mfma32(bf16x8 a, bf16x8 b, f32x16 c) { return __builtin_amdgcn_mfma_f32_32x32x16_bf16(a, b, c, 0, 0, 0); }
DI bf16x8 pack8(const f32x16& x, int s) {
    u32x4 w; w.x = pk_bf16(x[8 * s + 0], x[8 * s + 1]); w.y = pk_bf16(x[8 * s + 2], x[8 * s + 3]); w.z = pk_bf16(x[8 * s + 4], x[8 * s + 5]); w.w = pk_bf16(x[8 * s + 6], x[8 * s + 7]);
    return __builtin_bit_cast(bf16x8, w);
}
DI void qk_tile(LAS const unsigned char* Kb, const bf16x8 (&qf)[8], f32x16& x0, f32x16& x1, int r, int h) {
#pragma unroll
    for (int i = 0; i < 16; ++i) { x0[i] = 0.f; x1[i] = 0.f; }
#pragma unroll
    for (int s = 0; s < 8; ++s) {
        const bf16x8 a0 = *(const LAS bf16x8*)(Kb + off_b(r, 2 * s + h));
        const bf16x8 a1 = *(const LAS bf16x8*)(Kb + off_b(32 + r, 2 * s + h));
        x0 = mfma32(a0, qf[s], x0); x1 = mfma32(a1, qf[s], x1);
    }
}
DI void pv_tile(LAS const unsigned char* Vb, const f32x16& p0, const f32x16& p1, f32x16 (&o)[4], int lane) {
    const int h = lane >> 5, blk = (lane >> 4) & 1, q = (lane & 15) >> 2, pp = lane & 3;
#pragma unroll
    for (int kb = 0; kb < 2; ++kb)
#pragma unroll
        for (int s = 0; s < 2; ++s) {
            const bf16x8 pf = pack8(kb ? p1 : p0, s);
#pragma unroll
            for (int db = 0; db < 4; ++db) {
                const unsigned row0 = 32 * kb + 16 * s + 4 * h + q;
                const unsigned ch = 4 * db + 2 * blk + (pp >> 1);
                const s16x4 t0 = __builtin_amdgcn_ds_read_tr16_b64_v4i16((LAS s16x4*)(Vb + off_b(row0, ch) + 8 * (pp & 1)));
                const s16x4 t1 = __builtin_amdgcn_ds_read_tr16_b64_v4i16((LAS s16x4*)(Vb + off_b(row0 + 8, ch) + 8 * (pp & 1)));
                const bf16x8 vf = {t0[0], t0[1], t0[2], t0[3], t1[0], t1[1], t1[2], t1[3]};
                o[db] = mfma32(vf, pf, o[db]);
            }
        }
}
DI void store_o(bf16_t* orow, const f32x16 (&o)[4], float scale, int h) {
#pragma unroll
    for (int db = 0; db < 4; ++db)
#pragma unroll
        for (int g = 0; g < 4; ++g) {
            u32x2 w; w.x = pk_bf16(o[db][4 * g] * scale, o[db][4 * g + 1] * scale); w.y = pk_bf16(o[db][4 * g + 2] * scale, o[db][4 * g + 3] * scale);
            *(u32x2*)(orow + 32 * db + 8 * g + 4 * h) = w;
        }
}

DI void sb_item(const Params& p, LAS unsigned char* lds, int b, int hd, int Q) {
    const bf16_t* proj = (const bf16_t*)(p.ws + WS_PROJ);
    bf16_t* osb = (bf16_t*)(p.ws + WS_OSB);
    const int tid = threadIdx.x, wid = __builtin_amdgcn_readfirstlane(tid >> 6), lane = tid & 63, r = lane & 31, h = lane >> 5;
    const size_t tokbase = (size_t)b * SEQ;
    const int wq0 = Q * 256 + 32 * wid;
    const int myq = wq0 + r;
    bf16x8 qf[8];
    f32x16 o[4];
#pragma unroll
    for (int db = 0; db < 4; ++db)
#pragma unroll
        for (int i = 0; i < 16; ++i) o[db][i] = 0.f;
    float R = 0.f;
    unsigned goff[2];
#pragma unroll
    for (int i = 0; i < 2; ++i) { const unsigned row = 4 * (wid * 2 + i) + (lane >> 4), cp = lane & 15, ch = cp ^ (((row & 3u) << 2) | ((row >> 2) & 3u)); goff[i] = (row * DIN + ch * 8) * 2; }
    const char* kbase = (const char*)(proj + tokbase * DIN + COL_KS + hd * 128);
    const char* vbase = (const char*)(proj + tokbase * DIN + COL_VS + hd * 128);
#define ATT_ISSUE(key0_, buf_) do { const size_t _ko = (size_t)(key0_) * DIN * 2; _Pragma("unroll") for (int _i = 0; _i < 2; ++_i) { \
        __builtin_amdgcn_global_load_lds((const unsigned*)(kbase + _ko + goff[_i]), (LAS unsigned*)(lds + (buf_) * TB + 1024 * (wid * 2 + _i)), 16, 0, 0); \
        __builtin_amdgcn_global_load_lds((const unsigned*)(vbase + _ko + goff[_i]), (LAS unsigned*)(lds + 3 * TB + (buf_) * TB + 1024 * (wid * 2 + _i)), 16, 0, 0); } } while (0)
    int j = 4 * Q + 3;
    ATT_ISSUE(64 * j, 0);
    ATT_ISSUE(64 * (j - 1), 1);
    {
        const bf16_t* qrow = proj + (tokbase + myq) * DIN + COL_QS + hd * 128;
#pragma unroll
        for (int s = 0; s < 8; ++s) qf[s] = *(const bf16x8*)(qrow + 16 * s + 8 * h);
#pragma unroll
        for (int s = 0; s < 8; ++s) asm volatile("" : "+v"(qf[s]));
    }
    int cur = 0;
    for (; j >= 0; --j) {
        LAS unsigned char* Kb = lds + cur * TB; LAS unsigned char* Vb = lds + 3 * TB + cur * TB;
        if (j > 0) asm volatile("s_waitcnt vmcnt(4)" ::: "memory"); else asm volatile("s_waitcnt vmcnt(0)" ::: "memory");
        __builtin_amdgcn_s_barrier(); asm volatile("" ::: "memory");
        if (j > 1) ATT_ISSUE(64 * (j - 2), cur == 0 ? 2 : cur - 1);
        const int key0 = 64 * j;
        if (key0 < wq0 + 31) {
            const bool need_mask = (key0 + 63 >= wq0);
            f32x16 x0, x1;
            qk_tile(Kb, qf, x0, x1, r, h);
            f32x16 l0, l1;
#pragma unroll
            for (int i = 0; i < 16; ++i) {
                l0[i] = __builtin_amdgcn_logf(1.0f + __builtin_amdgcn_exp2f(x0[i]));
                l1[i] = __builtin_amdgcn_logf(1.0f + __builtin_amdgcn_exp2f(x1[i]));
            }
            if (need_mask) {
#pragma unroll
                for (int i = 0; i < 16; ++i) { const int kk = key0 + crow(i, h); if (kk >= myq) l0[i] = 0.f; if (kk + 32 >= myq) l1[i] = 0.f; }
            }
#pragma unroll
            for (int g = 0; g < 4; ++g) {
                l0[4 * g + 2] += l0[4 * g + 3]; l0[4 * g + 1] += l0[4 * g + 2]; l0[4 * g] += l0[4 * g + 1];
                l1[4 * g + 2] += l1[4 * g + 3]; l1[4 * g + 1] += l1[4 * g + 2]; l1[4 * g] += l1[4 * g + 1];
            }
            float Tlo[8], Thi[8];
#pragma unroll
            for (int g = 0; g < 4; ++g) {
                { const unsigned t = __float_as_uint(l0[4 * g]); auto sw = __builtin_amdgcn_permlane32_swap(t, t, false, false); Tlo[g] = __uint_as_float(sw[0]); Thi[g] = __uint_as_float(sw[1]); }
                { const unsigned t = __float_as_uint(l1[4 * g]); auto sw = __builtin_amdgcn_permlane32_swap(t, t, false, false); Tlo[4 + g] = __uint_as_float(sw[0]); Thi[4 + g] = __uint_as_float(sw[1]); }
            }
            float offR[8];
            float run = 0.f;
#pragma unroll
            for (int g = 7; g >= 0; --g) { offR[g] = run + (h == 0 ? Thi[g] : 0.f) + R; run += Tlo[g] + Thi[g]; }
            f32x16 p0, p1;
#pragma unroll
            for (int i = 0; i < 16; ++i) {
                p0[i] = __builtin_amdgcn_exp2f(x0[i] - (l0[i] + offR[i >> 2]));
                p1[i] = __builtin_amdgcn_exp2f(x1[i] - (l1[i] + offR[4 + (i >> 2)]));
            }
            if (need_mask) {
#pragma unroll
                for (int i = 0; i < 16; ++i) { const int kk = key0 + crow(i, h); if (kk >= myq) p0[i] = 0.f; if (kk + 32 >= myq) p1[i] = 0.f; }
            }
            R += run;
            pv_tile(Vb, p0, p1, o, lane);
        }
        cur = (cur == 2) ? 0 : cur + 1;
    }
    store_o(osb + (tokbase + myq) * 1024 + hd * 128, o, 1.0f, h);
    __syncthreads();
}

DI void dil_item(const Params& p, LAS unsigned char* lds, int di) {
    const bf16_t* proj = (const bf16_t*)(p.ws + WS_PROJ);
    bf16_t* og = (bf16_t*)(p.ws + WS_OG);
    float* lse = (float*)(p.ws + WS_LSE);
    const int b = di / 192; const int rem = di - b * 192; const int head = rem >> 4, sub = rem & 15;
    const int grp = head >> 2;
    const int dil = grp == 0 ? 1 : grp == 1 ? 4 : 16;
    const int nblk = 16 / dil;
    const int res = sub / nblk, Qb = sub - res * nblk;
    const int i0 = Qb * 256;
    const int tid = threadIdx.x, wid = __builtin_amdgcn_readfirstlane(tid >> 6), lane = tid & 63, r = lane & 31, h = lane >> 5;
    const size_t tokbase = (size_t)b * SEQ;
    const int wq0 = i0 + 32 * wid;
    const int myqi = wq0 + r;
    const size_t mytok = tokbase + (size_t)myqi * dil + res;
    bf16x8 qf[8];
    f32x16 o[4];
#pragma unroll
    for (int db = 0; db < 4; ++db)
#pragma unroll
        for (int i = 0; i < 16; ++i) o[db][i] = 0.f;
    float mrun = -1e30f, lrun = 0.f;
    unsigned goff[2];
#pragma unroll
    for (int i = 0; i < 2; ++i) { const unsigned row = 4 * (wid * 2 + i) + (lane >> 4), cp = lane & 15, ch = cp ^ (((row & 3u) << 2) | ((row >> 2) & 3u)); goff[i] = (row * dil * DIN + ch * 8) * 2; }
    const char* kbase = (const char*)(proj + (tokbase + res) * DIN + COL_KA + head * 128);
    const char* vbase = (const char*)(proj + (tokbase + res) * DIN + COL_VA + head * 128);
    const int jt0 = (i0 == 0) ? 2 : 0;
    ATT_ISSUE((i0 - 128 + 64 * jt0) * dil, 0);
    ATT_ISSUE((i0 - 128 + 64 * (jt0 + 1)) * dil, 1);
    {
        const bf16_t* qrow = proj + mytok * DIN + COL_QA + head * 128;
#pragma unroll
        for (int s = 0; s < 8; ++s) qf[s] = *(const bf16x8*)(qrow + 16 * s + 8 * h);
#pragma unroll
        for (int s = 0; s < 8; ++s) asm volatile("" : "+v"(qf[s]));
    }
    int cur = 0;
    for (int jt = jt0; jt < 6; ++jt) {
        LAS unsigned char* Kb = lds + cur * TB; LAS unsigned char* Vb = lds + 3 * TB + cur * TB;
        if (jt < 5) asm volatile("s_waitcnt vmcnt(4)" ::: "memory"); else asm volatile("s_waitcnt vmcnt(0)" ::: "memory");
        __builtin_amdgcn_s_barrier(); asm volatile("" ::: "memory");
        if (jt < 4) ATT_ISSUE((i0 - 128 + 64 * (jt + 2)) * dil, cur == 0 ? 2 : cur - 1);
        const int ki0 = i0 - 128 + 64 * jt;
        if (ki0 <= wq0 + 31 && ki0 + 63 >= wq0 - 128) {
            f32x16 x0, x1;
            qk_tile(Kb, qf, x0, x1, r, h);
            const float NEG = -__builtin_inff();
#pragma unroll
            for (int i = 0; i < 16; ++i) {
                const int d0 = myqi - (ki0 + crow(i, h));
                if ((unsigned)d0 > 128u) x0[i] = NEG;
                if ((unsigned)(d0 - 32) > 128u) x1[i] = NEG;
            }
            float mx = x0[0];
#pragma unroll
            for (int i = 1; i < 16; ++i) mx = fmaxf(mx, x0[i]);
#pragma unroll
            for (int i = 0; i < 16; ++i) mx = fmaxf(mx, x1[i]);
            { const unsigned t = __float_as_uint(mx); auto sw = __builtin_amdgcn_permlane32_swap(t, t, false, false); mx = fmaxf(__uint_as_float(sw[0]), __uint_as_float(sw[1])); }
            const float mn = fmaxf(mrun, mx);
            const float alpha = __builtin_amdgcn_exp2f(mrun - mn);
            mrun = mn;
            f32x16 p0, p1; float rs = 0.f;
#pragma unroll
            for (int i = 0; i < 16; ++i) { p0[i] = __builtin_amdgcn_exp2f(x0[i] - mn); p1[i] = __builtin_amdgcn_exp2f(x1[i] - mn); rs += p0[i] + p1[i]; }
            { const unsigned t = __float_as_uint(rs); auto sw = __builtin_amdgcn_permlane32_swap(t, t, false, false); rs = __uint_as_float(sw[0]) + __uint_as_float(sw[1]); }
            lrun = lrun * alpha + rs;
#pragma unroll
            for (int db = 0; db < 4; ++db)
#pragma unroll
                for (int i = 0; i < 16; ++i) o[db][i] *= alpha;
            pv_tile(Vb, p0, p1, o, lane);
        }
        cur = (cur == 2) ? 0 : cur + 1;
    }
    store_o(og + mytok * 1536 + head * 128, o, 1.0f / lrun, h);
    if (h == 0) lse[mytok * 12 + head] = (mrun + __builtin_amdgcn_logf(lrun)) * LN2;
    __syncthreads();
}
#undef ATT_ISSUE
}

DI void phase_attn(const Params& p, LAS unsigned char* lds) {
    for (int it = blockIdx.x; it < 1024; it += gridDim.x) {
        if (it < 256) {
            const int xcd = it & 7, rest = it >> 3, bhi = rest >> 3, x = rest & 7, bh = xcd * 4 + bhi;
            att::sb_item(p, lds, bh >> 3, bh & 7, 15 - x);
            att::sb_item(p, lds, bh >> 3, bh & 7, x);
        } else att::dil_item(p, lds, it - 256);
    }
}

DI void phase_merge(const Params& p) {
    const int lane = threadIdx.x & 63, wid = threadIdx.x >> 6;
    const bf16_t* og = (const bf16_t*)(p.ws + WS_OG); const float* lse = (const float*)(p.ws + WS_LSE); bf16_t* odil = (bf16_t*)(p.ws + WS_ODIL);
    const int hg = lane >> 4, d0 = (lane & 15) * 8;
    for (int tok = blockIdx.x * 8 + wid; tok < NTOK; tok += gridDim.x * 8) {
        const float l0 = lse[(size_t)tok * 12 + hg], l1 = lse[(size_t)tok * 12 + 4 + hg], l2 = lse[(size_t)tok * 12 + 8 + hg];
        const float mx = fmaxf(l0, fmaxf(l1, l2));
        float w0 = __expf(l0 - mx), w1 = __expf(l1 - mx), w2 = __expf(l2 - mx);
        const float inv = 1.0f / (w0 + w1 + w2); w0 *= inv; w1 *= inv; w2 *= inv;
        const u32x4 a = *(const u32x4*)(og + (size_t)tok * 1536 + hg * 128 + d0);
        const u32x4 bq = *(const u32x4*)(og + (size_t)tok * 1536 + (4 + hg) * 128 + d0);
        const u32x4 c = *(const u32x4*)(og + (size_t)tok * 1536 + (8 + hg) * 128 + d0);
        u32x4 o;
#pragma unroll
        for (int q = 0; q < 4; ++q) {
            const float lo = w0 * bf_lo(a[q]) + w1 * bf_lo(bq[q]) + w2 * bf_lo(c[q]);
            const float hi = w0 * bf_hi(a[q]) + w1 * bf_hi(bq[q]) + w2 * bf_hi(c[q]);
            o[q] = pk_bf16(lo, hi);
        }
        *(u32x4*)(odil + (size_t)tok * 512 + hg * 128 + d0) = o;
    }
}

DI void phase_postmix(const Params& p, LAS unsigned char* lds) {
    const int tid = threadIdx.x, lane = tid & 63, wid = __builtin_amdgcn_readfirstlane(tid >> 6);
    LAS float* hsm = (LAS float*)lds;
    LAS float* part = (LAS float*)(lds + 131072);
    const float* mod = (const float*)(p.ws + WS_MOD); const bf16_t* y = (const bf16_t*)(p.ws + WS_Y);
    unsigned char* h2 = (unsigned char*)(p.ws + WS_H);
    int* cnt = (int*)(p.ws + WS_CNT); int* list = (int*)(p.ws + WS_LIST); float* listw = (float*)(p.ws + WS_LISTW);
    const bf16_t* wr_hi = (const bf16_t*)(p.ws + WS_WRT); const bf16_t* wr_lo = wr_hi + 64 * 2048;
    LAS int* lcnt = (LAS int*)(lds + 147456);
    LAS int* lbase = (LAS int*)(lds + 147712);
    LAS unsigned char* sel_e = lds + 147968;
    LAS unsigned short* sel_r = (LAS unsigned short*)(lds + 150016);
    LAS float* sel_w = (LAS float*)(lds + 154112);
    if (tid < 64) lcnt[tid] = 0;
    int itl = 0;
    for (int it = blockIdx.x; it < NTOK / 16; it += gridDim.x, ++itl) {
#pragma unroll 1
        for (int sub = 0; sub < 2; ++sub) {
            const int tl = 2 * wid + sub, tok = it * 16 + tl, b = tok >> 12;
            f32x4 v[8]; float ss = 0.f;
#pragma unroll
            for (int i = 0; i < 8; ++i) { const u32x2 yw = *(const u32x2*)(y + (size_t)tok * DM + 4 * (lane + 64 * i)); v[i] = (f32x4){bf_lo(yw.x), bf_hi(yw.x), bf_lo(yw.y), bf_hi(yw.y)}; ss += v[i][0] * v[i][0] + v[i][1] * v[i][1] + v[i][2] * v[i][2] + v[i][3] * v[i][3]; }
            ss = wave_sum(ss);
            const float rstd = rsqrtf(ss * (1.0f / DM) + RMS_EPS);
            float ss1 = 0.f;
#pragma unroll
            for (int i = 0; i < 8; ++i) {
                const int ch = 4 * (lane + 64 * i);
                const f32x4 g = *(const f32x4*)(p.g_post_mix + ch);
                const f32x4 gt = *(const f32x4*)(mod + b * 12288 + 4096 + ch);
                const f32x4 xv = *(const f32x4*)(p.x + (size_t)tok * DM + ch);
#pragma unroll
                for (int j = 0; j < 4; ++j) { v[i][j] = xv[j] + gt[j] * (v[i][j] * rstd * g[j]); ss1 += v[i][j] * v[i][j]; }
                *(f32x4*)(p.out + (size_t)tok * DM + ch) = v[i];
            }
            ss1 = wave_sum(ss1);
            const float rstd1 = rsqrtf(ss1 * (1.0f / DM) + RMS_EPS);
#pragma unroll
            for (int i = 0; i < 8; ++i) {
                const int ch = 4 * (lane + 64 * i);
                const f32x4 g = *(const f32x4*)(p.g_pre_ffn + ch);
                const f32x4 sh = *(const f32x4*)(mod + b * 12288 + 6144 + ch);
                const f32x4 sc = *(const f32x4*)(mod + b * 12288 + 8192 + ch);
                f32x4 o;
#pragma unroll
                for (int j = 0; j < 4; ++j) o[j] = v[i][j] * rstd1 * g[j] * (1.0f + sc[j]) + sh[j];
                *(unsigned*)(h2 + (size_t)tok * DM + ch) = pk_fp8x4(o[0], o[1], o[2], o[3]);
                *(LAS f32x4*)(hsm + tl * 2048 + ch) = o;
            }
        }
        __syncthreads();
        f32x4 acc[4];
        {
            const int tr = lane & 15, kq = lane >> 4;
#pragma unroll
            for (int q = 0; q < 4; ++q) acc[q] = (f32x4){0.f, 0.f, 0.f, 0.f};
#pragma unroll 4
            for (int ks = 0; ks < 8; ++ks) {
                const int k0 = 256 * wid + 32 * ks + 8 * kq;
                const f32x4 a0 = *(const LAS f32x4*)(hsm + tr * 2048 + k0), a1 = *(const LAS f32x4*)(hsm + tr * 2048 + k0 + 4);
                u32x4 hw, lw;
                {
                    float xs[8] = {a0[0], a0[1], a0[2], a0[3], a1[0], a1[1], a1[2], a1[3]};
                    unsigned hh[4], ll[4];
#pragma unroll
                    for (int q = 0; q < 4; ++q) {
                        hh[q] = pk_bf16(xs[2 * q], xs[2 * q + 1]);
                        ll[q] = pk_bf16(xs[2 * q] - bf_lo(hh[q]), xs[2 * q + 1] - bf_hi(hh[q]));
                    }
                    hw = (u32x4){hh[0], hh[1], hh[2], hh[3]}; lw = (u32x4){ll[0], ll[1], ll[2], ll[3]};
                }
                const bf16x8 ah = __builtin_bit_cast(bf16x8, hw), al = __builtin_bit_cast(bf16x8, lw);
#pragma unroll
                for (int q = 0; q < 4; ++q) {
                    const bf16x8 bh = *(const bf16x8*)(wr_hi + (size_t)(16 * q + tr) * 2048 + k0);
                    const bf16x8 bl = *(const bf16x8*)(wr_lo + (size_t)(16 * q + tr) * 2048 + k0);
                    acc[q] = __builtin_amdgcn_mfma_f32_16x16x32_bf16(ah, bh, acc[q], 0, 0, 0);
                    acc[q] = __builtin_amdgcn_mfma_f32_16x16x32_bf16(ah, bl, acc[q], 0, 0, 0);
                    acc[q] = __builtin_amdgcn_mfma_f32_16x16x32_bf16(al, bh, acc[q], 0, 0, 0);
                }
            }
            if (wid >= 4) {
#pragma unroll
                for (int q = 0; q < 4; ++q)
#pragma unroll
                    for (int j = 0; j < 4; ++j) part[((wid - 4) * 16 + 4 * kq + j) * 64 + 16 * q + tr] = acc[q][j];
            }
        }
        __syncthreads();
        if (wid < 4) {
            const int tr = lane & 15, kq = lane >> 4;
#pragma unroll
            for (int q = 0; q < 4; ++q)
#pragma unroll
                for (int j = 0; j < 4; ++j) part[(wid * 16 + 4 * kq + j) * 64 + 16 * q + tr] += acc[q][j];
        }
        __syncthreads();
#pragma unroll 1
        for (int sub = 0; sub < 2; ++sub) {
            const int tl = 2 * wid + sub, tok = it * 16 + tl;
            const float logit = ((part[(0 * 16 + tl) * 64 + lane] + part[(1 * 16 + tl) * 64 + lane]) + part[(2 * 16 + tl) * 64 + lane]) + part[(3 * 16 + tl) * 64 + lane];
            const float score = 1.0f / (1.0f + __expf(-logit));
            const float sel = score + p.router_bias[lane];
            float m1 = sel;
            m1 = fmaxf(m1, __shfl_xor(m1, 1)); m1 = fmaxf(m1, __shfl_xor(m1, 2)); m1 = fmaxf(m1, __shfl_xor(m1, 4));
            const bool is1 = (sel == m1);
            const unsigned long long bal = __ballot(is1);
            const unsigned gm = (unsigned)(bal >> (lane & ~7)) & 0xffu;
            const int first = __ffs(gm) - 1;
            float m2 = (is1 && (lane & 7) == first) ? -__builtin_inff() : sel;
            m2 = fmaxf(m2, __shfl_xor(m2, 1)); m2 = fmaxf(m2, __shfl_xor(m2, 2)); m2 = fmaxf(m2, __shfl_xor(m2, 4));
            const float gs = m1 + m2;
            const int myg = lane >> 3;
            int grank = 0;
#pragma unroll 1
            for (int g = 0; g < 8; ++g) { const float gv = __uint_as_float(__builtin_amdgcn_readlane(__float_as_uint(gs), 8 * g)); grank += (gv > gs || (gv == gs && g < myg)) ? 1 : 0; }
            const bool gsel = grank < 4;
            const float msel = gsel ? sel : -__builtin_inff();
            int rk = 0;
#pragma unroll 4
            for (int e = 0; e < 64; ++e) { const float v = __uint_as_float(__builtin_amdgcn_readlane(__float_as_uint(msel), e)); rk += (v > msel || (v == msel && e < lane)) ? 1 : 0; }
            const bool chosen = gsel && rk < 8;
            const float ssum = wave_sum(chosen ? score : 0.f);
            if (chosen) {
                const int lr = __hip_atomic_fetch_add(lcnt + lane, 1, __ATOMIC_RELAXED, __HIP_MEMORY_SCOPE_WORKGROUP);
                const int idx = ((itl & 15) * 16 + tl) * 8 + rk;
                sel_e[idx] = (unsigned char)lane; sel_r[idx] = (unsigned short)lr; sel_w[idx] = score / ssum * 2.5f;
            }
            (void)tok;
        }
        __syncthreads();
        if ((itl & 15) == 15 || it + (int)gridDim.x >= NTOK / 16) {
            if (tid < 64) lbase[tid] = atomicAdd(&cnt[tid], lcnt[tid]);
            __syncthreads();
            const int nsel = ((itl & 15) + 1) * 128, it0 = itl & ~15;
            for (int idx = tid; idx < nsel; idx += 512) {
                const int e = sel_e[idx], tl = idx >> 3, k = idx & 7;
                const int tk = ((int)blockIdx.x + (it0 + (tl >> 4)) * (int)gridDim.x) * 16 + (tl & 15);
                const int pos = lbase[e] + sel_r[idx];
                list[e * LIST_CAP + pos] = tk * 9 + k; listw[e * LIST_CAP + pos] = sel_w[idx];
            }
            __syncthreads();
            if (tid < 64) lcnt[tid] = 0;
            __syncthreads();
        }
    }
}

DI void phase_combine(const Params& p) {
    const int lane = threadIdx.x & 63, wid = threadIdx.x >> 6;
    const float* mod = (const float*)(p.ws + WS_MOD); const bf16_t* yb9 = (const bf16_t*)(p.ws + WS_YB9); const int* slot = (const int*)(p.ws + WS_SLOT);
    for (int tok = blockIdx.x * 8 + wid; tok < NTOK; tok += gridDim.x * 8) {
        const int b = tok >> 12;
        float acc[4][8];
#pragma unroll
        for (int i = 0; i < 4; ++i)
#pragma unroll
            for (int j = 0; j < 8; ++j) acc[i][j] = 0.f;
#pragma unroll
        for (int k = 0; k < 9; ++k) {
            const bf16_t* row = yb9 + (size_t)slot[tok * 9 + k] * 256;
#pragma unroll
            for (int i = 0; i < 4; ++i) {
                const int c = lane + 64 * i;
                const u32x4 w = __builtin_nontemporal_load((const u32x4*)(row + (size_t)(c >> 5) * YB_SLOTS * 256 + (c & 31) * 8));
#pragma unroll
                for (int q = 0; q < 4; ++q) { acc[i][2 * q] += bf_lo(w[q]); acc[i][2 * q + 1] += bf_hi(w[q]); }
            }
        }
        float ss = 0.f;
#pragma unroll
        for (int i = 0; i < 4; ++i)
#pragma unroll
            for (int j = 0; j < 8; ++j) ss += acc[i][j] * acc[i][j];
        ss = wave_sum(ss);
        const float rstd = rsqrtf(ss * (1.0f / DM) + RMS_EPS);
#pragma unroll
        for (int i = 0; i < 4; ++i) {
            const int ch = 8 * (lane + 64 * i);
#pragma unroll
            for (int hh = 0; hh < 2; ++hh) {
                const f32x4 g = *(const f32x4*)(p.g_post_ffn + ch + 4 * hh);
                const f32x4 gt = *(const f32x4*)(mod + b * 12288 + 10240 + ch + 4 * hh);
                f32x4 xv = *(const f32x4*)(p.out + (size_t)tok * DM + ch + 4 * hh);
#pragma unroll
                for (int j = 0; j < 4; ++j) xv[j] += gt[j] * (acc[i][4 * hh + j] * rstd * g[j]);
                __builtin_nontemporal_store(xv, (f32x4*)(p.out + (size_t)tok * DM + ch + 4 * hh));
            }
        }
    }
}


DI void probe_copy(const Params& p) {
    u32x4* yb = (u32x4*)(p.ws + WS_YB9);
    const size_t n = (size_t)576 * MiB / 16;
    for (size_t i = (size_t)blockIdx.x * 512 + threadIdx.x; i < n; i += (size_t)gridDim.x * 512) { u32x4 v = yb[i]; asm volatile("" : "+v"(v)); yb[i] = v; }
}

constexpr int NPHASE = 12;
template <int PH> DI void run_phase(const Params& p, LAS unsigned char* lds) {
    if constexpr (PH == 0) phase_prologue(p, lds);
    else if constexpr (PH == 1) phase_prenorm(p);
    else if constexpr (PH == 2) phase_inproj(p, lds);
    else if constexpr (PH == 3) phase_attn(p, lds);
    else if constexpr (PH == 4) phase_merge(p);
    else if constexpr (PH == 5) phase_outproj_a(p, lds);
    else if constexpr (PH == 6) phase_outproj_b(p, lds);
    else if constexpr (PH == 7) phase_mixout(p, lds);
    else if constexpr (PH == 8) phase_postmix(p, lds);
    else if constexpr (PH == 9) phase_gateup(p, lds);
    else if constexpr (PH == 10) phase_down(p, lds);
    else phase_combine(p);
}
template <int PH> __global__ __launch_bounds__(512, 2) void k_phase(Params p) {
    extern __shared__ __attribute__((aligned(16))) unsigned char shm[];
    run_phase<PH>(p, (LAS unsigned char*)shm);
}
#if MK_FUSED
typedef const __attribute__((address_space(4))) Params* KargPtr;
template <int PH> DI void mega_phase(KargPtr kp0, LAS unsigned char* lds) {
    KargPtr kp = kp0; asm volatile("" : "+s"(kp));
    Params p{};
#if defined(__HIP_DEVICE_COMPILE__)
    p.x = kp->x; p.c = kp->c; p.pos = kp->pos; p.w_ada = kp->w_ada; p.b_ada = kp->b_ada; p.g_pre_mix = kp->g_pre_mix; p.g_post_mix = kp->g_post_mix; p.g_pre_ffn = kp->g_pre_ffn; p.g_post_ffn = kp->g_post_ffn; p.w_in = kp->w_in; p.w_dil_out = kp->w_dil_out; p.w_sb_out = kp->w_sb_out; p.w_mix_out = kp->w_mix_out; p.w_router = kp->w_router; p.router_bias = kp->router_bias; p.w_gate_e = kp->w_gate_e; p.w_up_e = kp->w_up_e; p.w_down_e = kp->w_down_e; p.w_gate_s = kp->w_gate_s; p.w_up_s = kp->w_up_s; p.w_down_s = kp->w_down_s; p.out = kp->out; p.ws = kp->ws;
#endif
    run_phase<PH>(p, lds);
}
__global__ __launch_bounds__(512, 2) void k_mega(Params p_unused) {
    extern __shared__ __attribute__((aligned(16))) unsigned char shm[];
    LAS unsigned char* lds = (LAS unsigned char*)shm;
    KargPtr kp0 = (KargPtr)__builtin_amdgcn_kernarg_segment_ptr();
    volatile LAS unsigned* xbw = (volatile LAS unsigned*)(lds + LDS_BYTES - 16);
    if (threadIdx.x == 0) { xbw[0] = 0u; xbw[1] = 0u; xbw[2] = 0u; xbw[3] = 0u; }
    __syncthreads();
    XcdBarrier bar;
    { KargPtr kp = kp0; asm volatile("" : "+s"(kp)); bar = xcd_barrier_post((unsigned*)(kp->ws + WS_BAR), xbw); }
    if (MK_STAMP >= 0 && blockIdx.x == 0 && threadIdx.x == 0) { KargPtr kq = kp0; asm volatile("" : "+s"(kq)); ((unsigned long long*)(kq->ws + WS_STAMP))[0] = wall_clock64(); }
#define MEGA_PH(n) do { mega_phase<n>(kp0, lds); xcd_barrier(bar); if (MK_REP == n) { mega_phase<n>(kp0, lds); xcd_barrier(bar); } \
        if (MK_STAMP >= 0 && blockIdx.x == 0 && threadIdx.x == 0) { KargPtr kq = kp0; asm volatile("" : "+s"(kq)); ((unsigned long long*)(kq->ws + WS_STAMP))[n + 1] = wall_clock64(); } } while (0)
#if MK_REP == 90
#define MK_PROBE_DOWN_NOSTORE 1
#endif
    MEGA_PH(0); MEGA_PH(1); MEGA_PH(2); MEGA_PH(3); MEGA_PH(4); MEGA_PH(5); MEGA_PH(6); MEGA_PH(7); MEGA_PH(8); MEGA_PH(9); MEGA_PH(10);
#if MK_REP == 100
    { KargPtr kp = kp0; asm volatile("" : "+s"(kp)); Params p{}; p.ws = kp->ws; probe_copy(p); xcd_barrier(bar); }
#endif
#undef MEGA_PH
    mega_phase<11>(kp0, lds);
#if MK_STAMP >= 0
    xcd_barrier(bar);
    if (blockIdx.x == 0 && threadIdx.x == 0) {
        KargPtr kq = kp0; asm volatile("" : "+s"(kq));
        unsigned long long* st = (unsigned long long*)(kq->ws + WS_STAMP);
        st[12] = wall_clock64();
        const int k = MK_STAMP < 100 ? MK_STAMP : MK_STAMP - 100;
        const unsigned long long t0 = (MK_STAMP < 100) ? st[k] : st[0], t1 = (MK_STAMP < 100) ? st[k + 1] : st[k + 1];
        kq->out[0] += 2.0f + (float)(t1 - t0) * (MK_STAMP < 100 ? 0.0005f : 0.0001f);
    }
#endif
}
#endif

template <int PH> static void launch_phase(const Params& p, int grid, hipStream_t stream) {
    static bool init = false;
    if (!init) { (void)hipFuncSetAttribute((const void*)k_phase<PH>, hipFuncAttributeMaxDynamicSharedMemorySize, LDS_BYTES); init = true; }
    hipLaunchKernelGGL(k_phase<PH>, dim3(grid), dim3(512), LDS_BYTES, stream, p);
}

extern "C" void kernel_launch(void* const* d_in, const int* in_sizes, int n_in, void* d_out, int out_size, void* d_ws, size_t ws_size, hipStream_t stream) {
    (void)in_sizes; (void)n_in; (void)out_size;
    static int grid = 0;
    if (!grid) {
        int dev = 0, cus = 0; (void)hipGetDevice(&dev); (void)hipDeviceGetAttribute(&cus, hipDeviceAttributeMultiprocessorCount, dev);
        if (cus <= 0) cus = 256;
#if MK_FUSED
        (void)hipFuncSetAttribute((const void*)k_mega, hipFuncAttributeMaxDynamicSharedMemorySize, LDS_BYTES);
        int per_cu = 0;
        if (hipOccupancyMaxActiveBlocksPerMultiprocessor(&per_cu, (const void*)k_mega, 512, LDS_BYTES) != hipSuccess || per_cu < 1)
            fprintf(stderr, "kernel_launch: occupancy query reports %d workgroups per CU\n", per_cu);
#endif
        grid = cus;
        if (ws_size < WS_TOTAL) fprintf(stderr, "kernel_launch: workspace too small: %zu < %zu\n", ws_size, (size_t)WS_TOTAL);
    }
    Params p{};
    p.x = (const float*)d_in[0]; p.c = (const float*)d_in[1]; p.pos = (const int*)d_in[2];
    p.w_ada = (const float*)d_in[3]; p.b_ada = (const float*)d_in[4];
    p.g_pre_mix = (const float*)d_in[5]; p.g_post_mix = (const float*)d_in[6]; p.g_pre_ffn = (const float*)d_in[7]; p.g_post_ffn = (const float*)d_in[8];
    p.w_in = (const float*)d_in[9]; p.w_dil_out = (const float*)d_in[10]; p.w_sb_out = (const float*)d_in[11]; p.w_mix_out = (const float*)d_in[12];
    p.w_router = (const float*)d_in[13]; p.router_bias = (const float*)d_in[14];
    p.w_gate_e = (const float*)d_in[15]; p.w_up_e = (const float*)d_in[16]; p.w_down_e = (const float*)d_in[17];
    p.w_gate_s = (const float*)d_in[18]; p.w_up_s = (const float*)d_in[19]; p.w_down_s = (const float*)d_in[20];
    p.out = (float*)d_out; p.ws = (unsigned char*)d_ws;
    (void)hipMemsetAsync((unsigned char*)d_ws + WS_BAR, 0, WS_ZERO_BYTES, stream);
#if MK_FUSED
    hipLaunchKernelGGL(k_mega, dim3(grid), dim3(512), LDS_BYTES, stream, p);
#else
    launch_phase<0>(p, grid, stream); launch_phase<1>(p, grid, stream); launch_phase<2>(p, grid, stream); launch_phase<3>(p, grid, stream);
    launch_phase<4>(p, grid, stream); launch_phase<5>(p, grid, stream); launch_phase<6>(p, grid, stream); launch_phase<7>(p, grid, stream);
    launch_phase<8>(p, grid, stream); launch_phase<9>(p, grid, stream); launch_phase<10>(p, grid, stream); launch_phase<11>(p, grid, stream);
#endif
}
```

```cpp
#include <hip/hip_runtime.h>
#include <stdint.h>
#include <stdio.h>

#ifndef MK_FUSED
#define MK_FUSED 1
#endif
#ifndef MK_STAMP
#define MK_STAMP -1
#endif
#ifndef MK_REP
#define MK_REP -1
#endif

#define LAS __attribute__((address_space(3)))
#define DI __device__ __forceinline__
typedef unsigned short bf16_t;
typedef short bf16x8 __attribute__((ext_vector_type(8)));
typedef short s16x4 __attribute__((ext_vector_type(4)));
typedef float f32x2 __attribute__((ext_vector_type(2)));
typedef float f32x4 __attribute__((ext_vector_type(4)));
typedef float f32x16 __attribute__((ext_vector_type(16)));
typedef unsigned u32x2 __attribute__((ext_vector_type(2)));
typedef unsigned u32x4 __attribute__((ext_vector_type(4)));
typedef __bf16 bf16x2_t __attribute__((ext_vector_type(2)));
typedef const __attribute__((address_space(1))) char* gcptr;
typedef const __attribute__((address_space(1))) u32x4* gu4ptr;
typedef int i32x8 __attribute__((ext_vector_type(8)));
typedef short s16x16 __attribute__((ext_vector_type(16)));

constexpr int NBATCH = 4, SEQ = 4096, NTOK = NBATCH * SEQ, DM = 2048, DIN = 11776;
constexpr int COL_QA = 0, COL_KA = 1536, COL_VA = 3072, COL_QS = 4608, COL_KS = 5632, COL_VS = 6656, COL_GD = 7680, COL_GS = 9728;
constexpr int NE = 64, DE = 512, NEX = 65;
constexpr int LIST_CAP = 16384;
constexpr int YB_SLOTS = 163840;
constexpr float RMS_EPS = 1e-6f;
constexpr float QSCALE = 0.08838834764831845f * 1.4426950408889634f;
constexpr float LN2 = 0.6931471805599453f;
constexpr float W8_SCALE = 64.0f;
constexpr int W8_MX = 0x79797979, A8_MX = 0x7f7f7f7f;

constexpr size_t MiB = 1ull << 20;
constexpr size_t WS_BAR = 0;
constexpr size_t WS_CNT = 16384;
constexpr size_t WS_ZERO_BYTES = 32768;
constexpr size_t WS_STAMP = 32768;

constexpr size_t WS_MOD = 65536;
constexpr size_t WS_LSE = 262144;
constexpr size_t WS_ROPE = 1 * MiB;
constexpr size_t WS_LIST = 3 * MiB;
constexpr size_t WS_LISTW = 7 * MiB;
constexpr size_t WS_SLOT = 262144;
constexpr size_t WS_WD = 11 * MiB;
constexpr size_t WS_H = 141 * MiB;
constexpr size_t WS_HID = 205 * MiB;
constexpr size_t WS_WTIN = 205 * MiB;
constexpr size_t WS_TMP = 205 * MiB;
constexpr size_t WS_OG = 251 * MiB;
constexpr size_t WS_OSB = 299 * MiB;
constexpr size_t WS_ODIL = 331 * MiB;
constexpr size_t WS_WTDIL = 347 * MiB;
constexpr size_t WS_WTSB = 349 * MiB;
constexpr size_t WS_WTMIX = 353 * MiB;
constexpr size_t WS_PROJ = 365 * MiB;
constexpr size_t WS_Y = 365 * MiB;
constexpr size_t WS_YB9 = 365 * MiB;
constexpr size_t WS_WGU = 733 * MiB;
constexpr size_t WS_WRT = 1005 * MiB;
constexpr size_t WS_TOTAL = 1006 * MiB;

#ifndef MOE_BAUX
#define MOE_BAUX 0
#endif
#ifndef GEMM_SPLIT
#define GEMM_SPLIT false
#endif
constexpr int LDS_BYTES = 163840;

struct Params {
    const float *x, *c; const int* pos;
    const float *w_ada, *b_ada, *g_pre_mix, *g_post_mix, *g_pre_ffn, *g_post_ffn;
    const float *w_in, *w_dil_out, *w_sb_out, *w_mix_out, *w_router, *router_bias;
    const float *w_gate_e, *w_up_e, *w_down_e, *w_gate_s, *w_up_s, *w_down_s;
    float* out; unsigned char* ws;
};

DI unsigned pk_bf16(float lo, float hi) { f32x2 v = {lo, hi}; bf16x2_t r = __builtin_convertvector(v, bf16x2_t); return __builtin_bit_cast(unsigned, r); }
DI unsigned pk_fp8x4(float a, float b, float c, float d) { int p = __builtin_amdgcn_cvt_pk_fp8_f32(a, b, 0, false); p = __builtin_amdgcn_cvt_pk_fp8_f32(c, d, p, true); return (unsigned)p; }
DI float bf_lo(unsigned u) { return __uint_as_float(u << 16); }
DI float bf_hi(unsigned u) { return __uint_as_float(u & 0xffff0000u); }
DI float wave_sum(float v) {
#pragma unroll
    for (int o = 32; o >= 1; o >>= 1) v += __shfl_xor(v, o);
    return v;
}
DI float sigmoidf_(float x) { return __builtin_amdgcn_rcpf(1.0f + __expf(-x)); }

#define XB_TMO      128
#define XB_XCNT(j)  (256  + 64 * (j))
#define XB_XSUB(j)  (1280 + 64 * (j))
#define XB_XGEN(j)  (2304 + 64 * (j))
#define XB_TOP      3328
#define XB_TOPGEN   3392
#define XCD_BAR_WORDS 3456
#define XB_SPIN_CAP (1u << 18)

__device__ __forceinline__ unsigned xb_ld(unsigned* p)              { return __hip_atomic_load(p, __ATOMIC_RELAXED, __HIP_MEMORY_SCOPE_AGENT); }
__device__ __forceinline__ unsigned xb_add(unsigned* p, unsigned v) { return __hip_atomic_fetch_add(p, v, __ATOMIC_RELAXED, __HIP_MEMORY_SCOPE_AGENT); }
__device__ __forceinline__ unsigned xb_xcc_id() { return (unsigned)__builtin_amdgcn_s_getreg((3 << 11) | 20) & 0xFu; }
#define XB_SPIN(cond, bar) do { unsigned _sp = 0; while (cond) { __builtin_amdgcn_s_sleep(1); \
    if ((++_sp & 255u) == 0u) { if (xb_ld(&(bar)[XB_TMO])) break; if (_sp > XB_SPIN_CAP) { atomicAdd(&(bar)[XB_TMO], 1u); break; } } } } while (0)

struct XcdBarrier { unsigned* bar; unsigned x; volatile LAS unsigned* st; };

__device__ __forceinline__ XcdBarrier xcd_barrier_post(unsigned* bar, volatile LAS unsigned* st) {
    XcdBarrier b; b.bar = bar; b.x = xb_xcc_id(); b.st = st;
    if (threadIdx.x == 0) (void)xb_add(&bar[XB_XCNT(b.x)], 1u);
    return b;
}
__device__ __forceinline__ void xcd_barrier_complete(unsigned* bar, unsigned x, unsigned& nloc, unsigned& nx) {
    const unsigned G = gridDim.x * gridDim.y * gridDim.z;
    unsigned sum, cnt, mine, sp = 0u;
    for (;;) {
        sum = 0u; cnt = 0u; mine = 0u;
#pragma unroll
        for (unsigned j = 0; j < 16; ++j) { const unsigned c = xb_ld(&bar[XB_XCNT(j)]); sum += c; cnt += (c > 0u) ? 1u : 0u; mine = (j == x) ? c : mine; }
        if (sum == G) break;
        __builtin_amdgcn_s_sleep(1);
        if ((++sp & 255u) == 0u) { if (xb_ld(&bar[XB_TMO])) break; if (sp > XB_SPIN_CAP) { atomicAdd(&bar[XB_TMO], 1u); break; } }
    }
    nloc = mine > 0u ? mine : 1u; nx = cnt > 0u ? cnt : 1u;
}
__device__ __forceinline__ void xcd_barrier(const XcdBarrier& b) {
    asm volatile("s_waitcnt vmcnt(0)" ::: "memory");
    __syncthreads();
    if (threadIdx.x == 0) {
        unsigned* bar = b.bar;
        __builtin_amdgcn_s_waitcnt(0);
        unsigned nloc = b.st[0], nx = b.st[1];
        if (nloc == 0u) { xcd_barrier_complete(bar, b.x, nloc, nx); b.st[0] = nloc; b.st[1] = nx; }
        const unsigned old = xb_add(&bar[XB_XSUB(b.x)], 1u);
        const unsigned gen = old / nloc;
        if (old + 1u == (gen + 1u) * nloc) {
            __builtin_amdgcn_fence(__ATOMIC_RELEASE, "agent");
            asm volatile("s_waitcnt vmcnt(0)" ::: "memory");
            const unsigned og = xb_add(&bar[XB_TOP], 1u);
            const unsigned tg = og / nx;
            if (og + 1u == (tg + 1u) * nx) xb_add(&bar[XB_TOPGEN], 1u);
            else XB_SPIN(xb_ld(&bar[XB_TOPGEN]) == tg, bar);
            __builtin_amdgcn_fence(__ATOMIC_ACQUIRE, "agent");
            xb_add(&bar[XB_XGEN(b.x)], 1u);
            asm volatile("s_waitcnt vmcnt(0)" ::: "memory");
        } else {
            XB_SPIN(xb_ld(&bar[XB_XGEN(b.x)]) == gen, bar);
            __builtin_amdgcn_fence(__ATOMIC_ACQUIRE, "agent");
            asm volatile("s_waitcnt vmcnt(0)" ::: "memory");
        }
    }
    __syncthreads();
}

struct CvtMat { const float* src; bf16_t* dst; int K, N, nb, mode; size_t sstride, dstride; };
constexpr int CVT_NMAT = 10;
constexpr int CVT_TILES[CVT_NMAT] = {2944, 128, 256, 512, 8192, 8192, 8192, 128, 128, 128};
constexpr int CVT_TOTAL = 2944 + 128 + 256 + 512 + 8192 * 3 + 128 * 3;
constexpr int P0_MOD_UNITS = 192, P0_ROPE_UNITS = 64, P0_WR_UNITS = 8, P0_ITEMS = P0_MOD_UNITS + P0_ROPE_UNITS + P0_WR_UNITS + CVT_TOTAL;

DI CvtMat cvt_mat(const Params& p, int m) {
    bf16_t* wtin = (bf16_t*)(p.ws + WS_WTIN); bf16_t* wtdil = (bf16_t*)(p.ws + WS_WTDIL); bf16_t* wtsb = (bf16_t*)(p.ws + WS_WTSB); bf16_t* wtmix = (bf16_t*)(p.ws + WS_WTMIX);
    bf16_t* wgu = (bf16_t*)(p.ws + WS_WGU); bf16_t* wd = (bf16_t*)(p.ws + WS_WD);
    CvtMat r;
    switch (m) {
        case 0: r = {p.w_in, wtin, 2048, 11776, 1, 0, 0, 0}; break;
        case 1: r = {p.w_dil_out, wtdil, 512, 2048, 1, 0, 0, 0}; break;
        case 2: r = {p.w_sb_out, wtsb, 1024, 2048, 1, 0, 0, 0}; break;
        case 3: r = {p.w_mix_out, wtmix, 2048, 2048, 1, 0, 0, 0}; break;
        case 4: r = {p.w_gate_e, wgu, 2048, 512, 64, 1, (size_t)2048 * 512, (size_t)1024 * 2048}; break;
        case 5: r = {p.w_up_e, wgu, 2048, 512, 64, 2, (size_t)2048 * 512, (size_t)1024 * 2048}; break;
        case 6: r = {p.w_down_e, wd, 512, 2048, 64, 0, (size_t)512 * 2048, (size_t)2048 * 512}; break;
        case 7: r = {p.w_gate_s, (bf16_t*)((unsigned char*)wgu + (size_t)64 * 1024 * 2048), 2048, 512, 1, 1, 0, 0}; break;
        case 8: r = {p.w_up_s, (bf16_t*)((unsigned char*)wgu + (size_t)64 * 1024 * 2048), 2048, 512, 1, 2, 0, 0}; break;
        default: r = {p.w_down_s, (bf16_t*)((unsigned char*)wd + (size_t)64 * 2048 * 512), 512, 2048, 1, 0, 0, 0}; break;
    }
    return r;
}

DI void cvt_tile(const Params& p, int t, LAS unsigned char* lds) {
    int m = 0;
#pragma unroll
    for (int i = 0; i < CVT_NMAT - 1; ++i) { if (t >= CVT_TILES[i] && m == i) { t -= CVT_TILES[i]; m = i + 1; } }
    const CvtMat M = cvt_mat(p, m);
    const int tn = M.N / 64, tk = M.K / 128;
    const int b = t / (tn * tk); const int rem = t - b * (tn * tk); const int kt = rem / tn, nt = rem - kt * tn;
    const float* src = M.src + (size_t)b * M.sstride + (size_t)(kt * 128) * M.N + nt * 64;
    const int tid = threadIdx.x;
    const int k4 = (tid >> 4) * 4, n4 = (tid & 15) * 4;
    f32x4 v[4];
#pragma unroll
    for (int i = 0; i < 4; ++i) v[i] = __builtin_nontemporal_load((const f32x4*)(src + (size_t)(k4 + i) * M.N + n4));
    const int c = nt * 64 + (tid >> 3);
    const int drow = M.mode == 0 ? c : (((c >> 7) << 8) + (c & 127) + (M.mode == 2 ? 128 : 0));
    if (m < 4) {
        bf16_t* dst = M.dst + (size_t)b * M.dstride;
        constexpr int P = 272;
#pragma unroll
        for (int j = 0; j < 4; ++j) { u32x2 w; w.x = pk_bf16(v[0][j], v[1][j]); w.y = pk_bf16(v[2][j], v[3][j]); *(LAS u32x2*)(lds + (n4 + j) * P + k4 * 2) = w; }
        __syncthreads();
#pragma unroll
        for (int i = 0; i < 2; ++i) {
            const int ch = (tid & 7) + 8 * i;
            const u32x4 w = *(const LAS u32x4*)(lds + (tid >> 3) * P + ch * 16);
            *(u32x4*)(dst + (size_t)drow * M.K + kt * 128 + ch * 8) = w;
        }
    } else {
        unsigned char* dst = (unsigned char*)M.dst + (size_t)b * M.dstride;
        constexpr int P = 144;
#pragma unroll
        for (int j = 0; j < 4; ++j) *(LAS unsigned*)(lds + (n4 + j) * P + k4) = pk_fp8x4(v[0][j] * W8_SCALE, v[1][j] * W8_SCALE, v[2][j] * W8_SCALE, v[3][j] * W8_SCALE);
        __syncthreads();
        const u32x4 w = *(const LAS u32x4*)(lds + (tid >> 3) * P + (tid & 7) * 16);
        __builtin_nontemporal_store(w, (u32x4*)(dst + (size_t)drow * M.K + kt * 128 + (tid & 7) * 16));
    }
    __syncthreads();
}

DI void mod_unit(const Params& p, int u, LAS unsigned char* lds) {
    const int tid = threadIdx.x, c0 = u * 64;
    LAS float* sc = (LAS float*)lds;
    LAS float* red = (LAS float*)(lds + 32768);
    for (int i = tid; i < 4 * 2048; i += 512) { const float v = p.c[i]; sc[i] = v / (1.0f + __expf(-v)); }
    __syncthreads();
    const int kq = tid >> 4, cq = tid & 15;
    float acc[4][4];
#pragma unroll
    for (int b = 0; b < 4; ++b)
#pragma unroll
        for (int j = 0; j < 4; ++j) acc[b][j] = 0.f;
    for (int it = 0; it < 64; ++it) {
        const int k = kq + 32 * it;
        const f32x4 w = __builtin_nontemporal_load((const f32x4*)(p.w_ada + (size_t)k * 12288 + c0 + 4 * cq));
#pragma unroll
        for (int b = 0; b < 4; ++b) { const float s = sc[b * 2048 + k];
#pragma unroll
            for (int j = 0; j < 4; ++j) acc[b][j] += s * w[j]; }
    }
#pragma unroll
    for (int b = 0; b < 4; ++b)
#pragma unroll
        for (int j = 0; j < 4; ++j) red[(kq * 4 + b) * 64 + 4 * cq + j] = acc[b][j];
    __syncthreads();
    if (tid < 256) {
        const int b = tid >> 6, col = tid & 63;
        float s = 0.f;
        for (int q = 0; q < 32; ++q) s += red[(q * 4 + b) * 64 + col];
        float* mod = (float*)(p.ws + WS_MOD);
        mod[b * 12288 + c0 + col] = s + p.b_ada[c0 + col];
    }
    __syncthreads();
}

DI void rope_unit(const Params& p, int u) {
    float2* rope = (float2*)(p.ws + WS_ROPE);
    for (int e = threadIdx.x; e < 4096; e += 512) {
        const int tok = u * 256 + (e >> 4), i = e & 15;
        const float invf = (float)pow(500000.0, -(double)i / 16.0);
        const float ang = (float)p.pos[tok] * invf;
        rope[tok * 16 + i] = make_float2((float)cos((double)ang), (float)sin((double)ang));
    }
}

DI void wr_unit(const Params& p, int u) {
    bf16_t* hi = (bf16_t*)(p.ws + WS_WRT); bf16_t* lo = hi + 64 * 2048;
    for (int i = threadIdx.x; i < 16384; i += 512) {
        const int idx = u * 16384 + i, k = idx >> 6, e = idx & 63;
        const float x = p.w_router[idx];
        const unsigned h = pk_bf16(x, 0.f) & 0xffffu;
        const float r = x - __uint_as_float(h << 16);
        hi[e * 2048 + k] = (bf16_t)h; lo[e * 2048 + k] = (bf16_t)(pk_bf16(r, 0.f) & 0xffffu);
    }
}
DI void phase_prologue(const Params& p, LAS unsigned char* lds) {
    for (int it = blockIdx.x; it < P0_ITEMS; it += gridDim.x) {
        if (it < P0_MOD_UNITS) mod_unit(p, it, lds);
        else if (it < P0_MOD_UNITS + P0_ROPE_UNITS) rope_unit(p, it - P0_MOD_UNITS);
        else if (it < P0_MOD_UNITS + P0_ROPE_UNITS + P0_WR_UNITS) wr_unit(p, it - P0_MOD_UNITS - P0_ROPE_UNITS);
        else cvt_tile(p, it - P0_MOD_UNITS - P0_ROPE_UNITS - P0_WR_UNITS, lds);
    }
}

DI void phase_prenorm(const Params& p) {
    const int lane = threadIdx.x & 63, wid = threadIdx.x >> 6;
    const float* mod = (const float*)(p.ws + WS_MOD);
    bf16_t* h = (bf16_t*)(p.ws + WS_H);
    for (int tok = blockIdx.x * 8 + wid; tok < NTOK; tok += gridDim.x * 8) {
        const int b = tok >> 12;
        const float* xr = p.x + (size_t)tok * DM;
        f32x4 v[8]; float ss = 0.f;
#pragma unroll
        for (int i = 0; i < 8; ++i) { v[i] = *(const f32x4*)(xr + 4 * (lane + 64 * i)); ss += v[i][0] * v[i][0] + v[i][1] * v[i][1] + v[i][2] * v[i][2] + v[i][3] * v[i][3]; }
        ss = wave_sum(ss);
        const float rstd = rsqrtf(ss * (1.0f / DM) + RMS_EPS);
#pragma unroll
        for (int i = 0; i < 8; ++i) {
            const int ch = 4 * (lane + 64 * i);
            const f32x4 g = *(const f32x4*)(p.g_pre_mix + ch);
            const f32x4 sh = *(const f32x4*)(mod + b * 12288 + ch);
            const f32x4 sc = *(const f32x4*)(mod + b * 12288 + 2048 + ch);
            f32x4 o;
#pragma unroll
            for (int j = 0; j < 4; ++j) o[j] = v[i][j] * rstd * g[j] * (1.0f + sc[j]) + sh[j];
            u32x2 w; w.x = pk_bf16(o[0], o[1]); w.y = pk_bf16(o[2], o[3]);
            *(u32x2*)(h + (size_t)tok * DM + ch) = w;
        }
    }
}

namespace g8 {
constexpr int BM = 256, BK = 64, HALF = 128, HTB = HALF * BK * 2, STAGE_BYTES = 8 * HTB, NXCD = 8, WGM = 8;
DI int lds_byte(int r, int c) { const int st = (r >> 4) * 2 + (c >> 5), rr = r & 15, cc = c & 31, ob = rr * 64 + cc * 2; return st * 1024 + (ob ^ (((ob >> 9) & 1) << 5)); }
DI void stage_rc(int b, int& R, int& C) { const int st = b / 1024, sb = b % 1024, swz = sb ^ (((sb >> 9) & 1) << 5); R = (st >> 1) * 16 + swz / 64; C = (st & 1) * 32 + (swz % 64) / 2; }
DI int perm32(int rho) { const int n = rho >> 4, i = rho & 15; return 8 * (i >> 2) + 4 * n + (i & 3); }

struct Unit {
    const char* A; const char* B;
    int row0;
    int lda, ldb, nt;
    int pm, pn, aux, keep;
    int e, nvalid, par;
};

DI bool static_tile(int L, int nM, int nN, int& pm, int& pn) {
    const int nwg = nM * nN; if (L >= nwg) return false;
    int wgid = L; { const int q = nwg / NXCD, r = nwg % NXCD, xcd = wgid % NXCD, off = wgid / NXCD; wgid = (xcd < r ? xcd * (q + 1) : r * (q + 1) + (xcd - r) * q) + off; }
    const int nig = WGM * nN, gid = wgid / nig, fm = gid * WGM, gsz = (nM - fm) < WGM ? (nM - fm) : WGM;
    pm = fm + ((wgid % nig) % gsz); pn = (wgid % nig) / gsz; return true;
}

constexpr int EXCH_OFF = STAGE_BYTES + 8192;
DI void epi_bar() { asm volatile("s_waitcnt lgkmcnt(0)" ::: "memory"); __builtin_amdgcn_s_barrier(); asm volatile("" ::: "memory"); }

template <int NCH, int BAUX, bool SPLIT, bool FP8, class Sched, class Epi>
DI void gemm_phase(LAS unsigned char* lds, const Sched& S, const Epi& E) {
    const int tid = threadIdx.x, wid = __builtin_amdgcn_readfirstlane(tid >> 6), lane = tid & 63, wr = wid >> 2, wc = wid & 3, fr = lane & 15, fq = lane >> 4;
    const bool loader = SPLIT ? (wr == 0) : true, storer = SPLIT ? (wr == 1) : true;
    constexpr int NP = SPLIT ? 4 : 2, PSTEP = SPLIT ? 4 : 8, RSTEP = SPLIT ? 32 : 64;
    const int p0 = SPLIT ? wc : wid;
    int R0, C0; stage_rc(p0 * 1024 + lane * 16, R0, C0);
    const int sC = C0 * 2, sRb = (R0 & ~31) + perm32(R0 & 31);
    const int aoff = lds_byte(wr * 64 + fr, fq * 8), boff = lds_byte(wc * 32 + fr, fq * 8);
#define G8_SA(b, h) (((b) * 2 + (h)) * HTB)
#define G8_SB(b, h) ((4 + (b) * 2 + (h)) * HTB)
#define G8_STAGE_A(bufoff, gbase, voff) do { if (loader) { _Pragma("unroll") for (int _i = 0; _i < NP; ++_i) \
        __builtin_amdgcn_global_load_lds((const unsigned*)((const char*)(gbase) + (voff)[_i]), (LAS unsigned*)(lds + (bufoff) + (p0 + PSTEP * _i) * 1024), 16, 0, 0); } } while (0)
#define G8_STAGE_B(bufoff, gbase, voff, ldb32) do { if (loader) { _Pragma("unroll") for (int _i = 0; _i < NP; ++_i) { \
        const char* _gb = (const char*)(gbase) + (size_t)_i * (ldb32); asm volatile("" : "+s"(_gb));     \
        __builtin_amdgcn_global_load_lds((const unsigned*)(_gb + (voff)), (LAS unsigned*)(lds + (bufoff) + (p0 + PSTEP * _i) * 1024), 16, 0, BAUX); } } } while (0)
#define G8_LDA(dst, b, h) do { _Pragma("unroll") for (int m = 0; m < 4; ++m) _Pragma("unroll") for (int k = 0; k < 2; ++k) dst[m][k] = *(const LAS bf16x8*)(lds + G8_SA(b, h) + aoff + m * 2048 + k * 1024); } while (0)
#define G8_LDB(dst, b, h) do { _Pragma("unroll") for (int n = 0; n < 2; ++n) _Pragma("unroll") for (int k = 0; k < 2; ++k) dst[n][k] = *(const LAS bf16x8*)(lds + G8_SB(b, h) + boff + n * 2048 + k * 1024); } while (0)
#define G8_MMA(ai, bj, At, Bt) do { __builtin_amdgcn_s_setprio(1); _Pragma("unroll") for (int m = 0; m < 4; ++m) _Pragma("unroll") for (int n = 0; n < 2; ++n) { \
        if (!FP8) { _Pragma("unroll") for (int k = 0; k < 2; ++k) acc[ai][bj][m][n] = __builtin_amdgcn_mfma_f32_16x16x32_bf16(Bt[n][k], At[m][k], acc[ai][bj][m][n], 0, 0, 0); } \
        else { const i32x8 _w = __builtin_bit_cast(i32x8, __builtin_shufflevector(Bt[n][0], Bt[n][1], 0, 1, 2, 3, 4, 5, 6, 7, 8, 9, 10, 11, 12, 13, 14, 15)); \
               const i32x8 _x = __builtin_bit_cast(i32x8, __builtin_shufflevector(At[m][0], At[m][1], 0, 1, 2, 3, 4, 5, 6, 7, 8, 9, 10, 11, 12, 13, 14, 15)); \
               acc[ai][bj][m][n] = __builtin_amdgcn_mfma_scale_f32_16x16x128_f8f6f4(_w, _x, acc[ai][bj][m][n], 0, 0, 0, W8_MX, 0, A8_MX); } } \
        __builtin_amdgcn_s_setprio(0); } while (0)
#define G8_WAIT_V8 do { if (SPLIT) { if (loader) asm volatile("s_waitcnt vmcnt(8)" ::: "memory"); } else asm volatile("s_waitcnt vmcnt(4)" ::: "memory"); } while (0)
#define G8_WAIT_V12 do { if (SPLIT) { if (loader) asm volatile("s_waitcnt vmcnt(12)" ::: "memory"); } else asm volatile("s_waitcnt vmcnt(6)" ::: "memory"); } while (0)
#define G8_WAIT_V0 do { if (loader) asm volatile("s_waitcnt vmcnt(0)" ::: "memory"); } while (0)
#define G8_WAIT_L(n) asm volatile("s_waitcnt lgkmcnt(" #n ")" ::: "memory")
#define G8_BAR __builtin_amdgcn_s_barrier()
#define G8_SCHED __builtin_amdgcn_sched_barrier(0)
#define G8_OFFS(u, vA, vB) do { if (loader) { _Pragma("unroll") for (int _h = 0; _h < 2; ++_h) _Pragma("unroll") for (int _i = 0; _i < NP; ++_i) \
        vA[_h][_i] = (unsigned)S.arow(u, _h * 128 + R0 + RSTEP * _i) * (unsigned)(u).lda + (unsigned)sC; \
        vB = (unsigned)sRb * (unsigned)(u).ldb + (unsigned)sC; } } while (0)
    Unit cur, nxt; int ui = 0;
    if (!S.next(0, cur)) return;
    f32x4 acc[2][2][4][2];
#pragma unroll
    for (int a = 0; a < 2; ++a)
#pragma unroll
        for (int b = 0; b < 2; ++b)
#pragma unroll
            for (int m = 0; m < 4; ++m)
#pragma unroll
                for (int n = 0; n < 2; ++n) acc[a][b][m][n] = (f32x4){0.f, 0.f, 0.f, 0.f};
    bf16x8 At[4][2], B0[2][2], B1[2][2];
    unsigned vA[2][NP], vB = 0u;
#pragma unroll
    for (int i = 0; i < NP; ++i) { vA[0][i] = 0u; vA[1][i] = 0u; }
    if (S.prefetch(cur, wid, lane)) { G8_WAIT_V0; G8_BAR; }
    G8_OFFS(cur, vA, vB);
    const char* cA = cur.A; const char* cB = cur.B; size_t hB = (size_t)128 * cur.ldb; size_t q32 = (size_t)RSTEP * cur.ldb;
    constexpr size_t kstep = 128;
    G8_STAGE_B(G8_SB(0, 0), cB, vB, q32); G8_STAGE_A(G8_SA(0, 0), cA, vA[0]); G8_STAGE_B(G8_SB(0, 1), cB + hB, vB, q32); G8_STAGE_A(G8_SA(0, 1), cA, vA[1]);
    if (wr == 1) G8_BAR;
    G8_WAIT_V8; G8_BAR;
    G8_STAGE_B(G8_SB(1, 0), cB + kstep, vB, q32); G8_STAGE_A(G8_SA(1, 0), cA + kstep, vA[0]); G8_STAGE_B(G8_SB(1, 1), cB + hB + kstep, vB, q32);
    G8_WAIT_V12; G8_BAR;
    for (;;) {
        bool has_next = false;
        const char* nA = cA; const char* nB = cB; size_t nhB = hB, nq32 = q32;
        const int nt = cur.nt;
#pragma unroll 1
        for (int t = 0; t < nt; t += 2) {
            const bool last = (t == nt - 2);
            const char* a1 = cA + (size_t)(t + 1) * kstep;
            G8_LDB(B0, 0, 0); G8_SCHED; G8_LDA(At, 0, 0); G8_STAGE_A(G8_SA(1, 1), a1, vA[1]);
            G8_WAIT_L(8); G8_BAR; G8_WAIT_L(0); G8_MMA(0, 0, At, B0); G8_BAR; G8_SCHED;
            if (t == 0) { Unit pf; if (S.next(ui + 1, pf)) (void)S.prefetch(pf, wid, lane); }
            const char* a2; const char* b2; size_t h2, q2;
            if (last) {
                has_next = S.next(ui + 1, nxt);
                if (has_next) { G8_OFFS(nxt, vA, vB); nA = nxt.A; nB = nxt.B; nhB = (size_t)128 * nxt.ldb; nq32 = (size_t)RSTEP * nxt.ldb; }
                a2 = nA; b2 = nB; h2 = nhB; q2 = nq32;
            } else { a2 = cA + (size_t)(t + 2) * kstep; b2 = cB + (size_t)(t + 2) * kstep; h2 = hB; q2 = q32; }
            const char* a3 = a2 + kstep; const char* b3 = b2 + kstep;
            G8_LDB(B1, 0, 1); G8_STAGE_B(G8_SB(0, 0), b2, vB, q2);
            G8_BAR; G8_WAIT_L(0); G8_MMA(0, 1, At, B1); G8_BAR;
            G8_LDA(At, 0, 1); G8_STAGE_A(G8_SA(0, 0), a2, vA[0]);
            G8_BAR; G8_WAIT_L(0); G8_MMA(1, 0, At, B0); G8_BAR; G8_SCHED;
            G8_STAGE_B(G8_SB(0, 1), b2 + h2, vB, q2);
            G8_WAIT_V12; G8_BAR; G8_MMA(1, 1, At, B1); G8_BAR;
            G8_LDB(B0, 1, 0); G8_SCHED; G8_LDA(At, 1, 0); G8_STAGE_A(G8_SA(0, 1), a2, vA[1]);
            G8_WAIT_L(8); G8_BAR; G8_WAIT_L(0); G8_MMA(0, 0, At, B0); G8_BAR; G8_SCHED;
            G8_LDB(B1, 1, 1); G8_STAGE_B(G8_SB(1, 0), b3, vB, q2);
            G8_BAR; G8_WAIT_L(0); G8_MMA(0, 1, At, B1); G8_BAR;
            G8_LDA(At, 1, 1); G8_STAGE_A(G8_SA(1, 0), a3, vA[0]);
            G8_BAR; G8_WAIT_L(0); G8_MMA(1, 0, At, B0); G8_BAR; G8_SCHED;
            G8_STAGE_B(G8_SB(1, 1), b3 + h2, vB, q2);
            G8_WAIT_V12; G8_BAR; G8_MMA(1, 1, At, B1); G8_BAR;
        }
        int tz = threadIdx.x; asm volatile("" : "+v"(tz));
        const int lane_e = tz & 63, fr_e = tz & 15, fq_e = (tz >> 4) & 3;
        {
            E.pre(acc, cur, wr, wc, fr_e, fq_e);
            constexpr int PITCH = NCH * 16 + 16;
            LAS unsigned char* ex = lds + EXCH_OFF;
            if (wr == 0) G8_BAR;
            if constexpr (Epi::OUT8) {
                constexpr int RB = NCH * 8, P8 = RB + 16;
#pragma unroll
                for (int ai = 0; ai < 2; ++ai)
#pragma unroll
                    for (int mh = 0; mh < 2; ++mh) {
#pragma unroll
                        for (int mm = 0; mm < 2; ++mm) {
                            u32x2 o8[2];
                            E.row8(acc, cur, ai, 2 * mh + mm, wr, wc, fr_e, fq_e, o8);
                            LAS unsigned char* rp = ex + (mm * 32 + wr * 16 + fr_e) * P8 + wc * 32 + 8 * fq_e;
                            *(LAS u32x2*)rp = o8[0];
                            if (NCH == 32) *(LAS u32x2*)(rp + 128) = o8[1];
                        }
                        epi_bar();
                        {
                            constexpr int CPR = RB / 16, RPI = 64 / CPR;
#pragma unroll
                            for (int i = 0; i < 8 / RPI; ++i) {
                                const int rl = 8 * wid + RPI * i + lane_e / CPR, ch = lane_e % CPR;
                                const int rt = ai * 128 + ((rl >> 4) & 1) * 64 + (2 * mh + (rl >> 5)) * 16 + (rl & 15);
                                const u32x4 d = *(const LAS u32x4*)(ex + rl * P8 + ch * 16);
                                E.store8(cur, rt, ch, d);
                            }
                        }
                        epi_bar();
                    }
            } else
#pragma unroll
            for (int ai = 0; ai < 2; ++ai)
#pragma unroll
                for (int m = 0; m < 4; ++m) {
                    u32x4 o[2];
                    E.row(acc, cur, ai, m, wr, wc, fr_e, fq_e, o);
                    if (NCH == 32) {
                        *(LAS u32x4*)(ex + (wr * 16 + fr_e) * PITCH + (wc * 32 + 8 * fq_e) * 2) = o[0];
                        *(LAS u32x4*)(ex + (wr * 16 + fr_e) * PITCH + (128 + wc * 32 + 8 * fq_e) * 2) = o[1];
                    } else {
                        *(LAS u32x4*)(ex + (wr * 16 + fr_e) * PITCH + (wc * 32 + 8 * fq_e) * 2) = o[0];
                    }
                    epi_bar();
                    if (storer) {
                        constexpr int RPI = 64 / NCH;
                        constexpr int RPW = SPLIT ? 8 : 4;
                        const int rbase = SPLIT ? 8 * wc : 4 * wid;
#pragma unroll
                        for (int i = 0; i < RPW / RPI; ++i) {
                            const int rl = rbase + RPI * i + lane_e / NCH, ch = lane_e % NCH;
                            const int rt = ai * 128 + (rl >> 4) * 64 + m * 16 + (rl & 15);
                            const u32x4 d = *(const LAS u32x4*)(ex + rl * PITCH + ch * 16);
                            E.store(cur, rt, ch, d);
                        }
                    }
                    epi_bar();
                }
            if (wr == 1) G8_BAR;
        }
        if (!has_next) break;
#pragma unroll
        for (int a = 0; a < 2; ++a)
#pragma unroll
            for (int b = 0; b < 2; ++b)
#pragma unroll
                for (int m = 0; m < 4; ++m)
#pragma unroll
                    for (int n = 0; n < 2; ++n) acc[a][b][m][n] = (f32x4){0.f, 0.f, 0.f, 0.f};
        cur = nxt; cA = nA; cB = nB; hB = nhB; q32 = nq32; ++ui;
    }
    G8_WAIT_V0;
    if (wr == 0) G8_BAR;
    G8_BAR;
#undef G8_SA
#undef G8_SB
#undef G8_STAGE_A
#undef G8_STAGE_B
#undef G8_LDA
#undef G8_LDB
#undef G8_MMA
#undef G8_WAIT_V8
#undef G8_WAIT_V12
#undef G8_WAIT_V0
#undef G8_WAIT_L
#undef G8_BAR
#undef G8_SCHED
#undef G8_OFFS
}
}

struct DenseSched {
    const char* A; const char* Bt; int nM, nN, lda, ldb, nt, G, c;
    DI bool next(int i, g8::Unit& u) const {
        int pm, pn; if (!g8::static_tile(i * G + c, nM, nN, pm, pn)) return false;
        pm = __builtin_amdgcn_readfirstlane(pm); pn = __builtin_amdgcn_readfirstlane(pn);
        u.A = A; u.B = Bt + (size_t)pn * 256 * ldb; u.row0 = pm * 256; u.lda = lda; u.ldb = ldb; u.nt = nt; u.pm = pm; u.pn = pn; u.aux = 0; u.keep = 0; u.e = 0; u.nvalid = 256; u.par = 0; return true;
    }
    DI int arow(const g8::Unit& u, int rr) const { return u.row0 + rr; }
    DI bool prefetch(const g8::Unit&, int, int) const { return false; }
};
constexpr int MOE_TAB_OFF = g8::STAGE_BYTES;
constexpr int MOE_TILE_OFF = g8::STAGE_BYTES + 1024;
constexpr int MOE_IDX_OFF = g8::STAGE_BYTES + 2048;
struct MoeSched {
    LAS unsigned char* lds; const int* list; const float* listw; const char* A; const char* W; int ncol, mode  , G, c;
    DI bool next(int i, g8::Unit& u) const {
        const LAS int* tpre = (const LAS int*)(lds + MOE_TAB_OFF);
        const int L = i * G + c; const int T = __builtin_amdgcn_readfirstlane(tpre[NEX]);
        if (L >= T * ncol) return false;
        const int gt = __builtin_amdgcn_readfirstlane(L / ncol), pn = L - gt * ncol;
        const int e = __builtin_amdgcn_readfirstlane((int)*(const LAS unsigned char*)(lds + MOE_TILE_OFF + gt));
        const int tile = gt - __builtin_amdgcn_readfirstlane(tpre[e]);
        const int n_e = __builtin_amdgcn_readfirstlane(tpre[NEX + 1 + e]);
        u.e = e; u.pm = tile; u.pn = pn; u.nvalid = min(256, n_e - tile * 256); u.keep = 0; u.aux = gt * 256; u.par = i & 1;
        if (mode == 0) { u.A = A; u.lda = 2048; u.ldb = 2048; u.nt = 16; u.B = W + ((size_t)e * 1024 + (size_t)pn * 256) * 2048; u.row0 = tile * 256; }
        else { u.A = A; u.lda = 512; u.ldb = 512; u.nt = 4; u.B = W + ((size_t)e * 2048 + (size_t)pn * 256) * 512; u.row0 = gt * 256; }
        return true;
    }
    DI bool prefetch(const g8::Unit& u, int wid, int lane) const {
        if (u.e < NE && wid < 4) {
            const int r = min(wid * 64 + lane, u.nvalid - 1);
            const size_t src = (size_t)u.e * LIST_CAP + u.pm * 256 + r;
            __builtin_amdgcn_global_load_lds((const unsigned*)(list + src), (LAS unsigned*)(lds + MOE_IDX_OFF + u.par * 2048 + wid * 256), 4, 0, 0);
            if (mode == 1) __builtin_amdgcn_global_load_lds((const unsigned*)(listw + src), (LAS unsigned*)(lds + MOE_IDX_OFF + u.par * 2048 + 1024 + wid * 256), 4, 0, 0);
        }
        return true;
    }
    DI int arow(const g8::Unit& u, int rr) const {
        if (mode == 1) return u.row0 + rr;
        if (u.e >= NE) return u.row0 + rr;
        return *(const LAS int*)(lds + MOE_IDX_OFF + u.par * 2048 + rr * 4) / 9;
    }
};

typedef f32x4 (&AccRef)[2][2][4][2];
DI u32x4 pack8(const f32x4& v0, const f32x4& v1) { u32x4 w; w.x = pk_bf16(v0[0], v0[1]); w.y = pk_bf16(v0[2], v0[3]); w.z = pk_bf16(v1[0], v1[1]); w.w = pk_bf16(v1[2], v1[3]); return w; }

struct EpiInProj { static constexpr bool OUT8 = false;
    bf16_t* proj; const float* rope;
    DI static int kind_of(int pn) { return pn < 6 ? 0 : pn < 12 ? 1 : pn < 18 ? 2 : pn < 22 ? 3 : pn < 30 ? 2 : 4; }
    DI void pre(AccRef acc, const g8::Unit& u, int wr, int wc, int fr, int fq) const {
        if (kind_of(u.pn) <= 1 && wc == 0) {
            const float sg = (fq < 2) ? -1.0f : 1.0f;
#pragma unroll
            for (int g = 0; g < 4; ++g) {
                const int ai = g >> 1;
                f32x4 cs[2][4];
#pragma unroll
                for (int mm = 0; mm < 2; ++mm) { const int m = (g & 1) * 2 + mm; const int row = u.pm * 256 + ai * 128 + wr * 64 + m * 16 + fr;
#pragma unroll
                    for (int q = 0; q < 4; ++q) cs[mm][q] = *(const f32x4*)(rope + (size_t)row * 32 + 16 * (fq & 1) + 4 * q); }
#pragma unroll
                for (int mm = 0; mm < 2; ++mm) { const int m = (g & 1) * 2 + mm;
#pragma unroll
                    for (int bj = 0; bj < 2; ++bj) {
                        f32x4 v0 = acc[ai][bj][m][0], v1 = acc[ai][bj][m][1], p0, p1;
#pragma unroll
                        for (int j = 0; j < 4; ++j) { p0[j] = __shfl_xor(v0[j], 32); p1[j] = __shfl_xor(v1[j], 32); }
#pragma unroll
                        for (int j = 0; j < 4; ++j) {
                            const float c0 = cs[mm][j >> 1][(j & 1) * 2], s0 = cs[mm][j >> 1][(j & 1) * 2 + 1];
                            const float c1 = cs[mm][2 + (j >> 1)][(j & 1) * 2], s1 = cs[mm][2 + (j >> 1)][(j & 1) * 2 + 1];
                            v0[j] = v0[j] * c0 + sg * p0[j] * s0;
                            v1[j] = v1[j] * c1 + sg * p1[j] * s1;
                        }
                        acc[ai][bj][m][0] = v0; acc[ai][bj][m][1] = v1;
                    }
                    asm volatile("" : "+v"(acc[ai][0][m][0]), "+v"(acc[ai][0][m][1]), "+v"(acc[ai][1][m][0]), "+v"(acc[ai][1][m][1]));
                }
                asm volatile("" ::: "memory");
            }
        }
    }
    DI void row(AccRef acc, const g8::Unit& u, int ai, int m, int wr, int wc, int fr, int fq, u32x4 (&o)[2]) const {
        const int kind = kind_of(u.pn);
#pragma unroll
        for (int bj = 0; bj < 2; ++bj) {
            f32x4 v0 = acc[ai][bj][m][0], v1 = acc[ai][bj][m][1];
            if (kind == 0 || kind == 3) { v0 *= QSCALE; v1 *= QSCALE; }
            if (kind == 4) {
#pragma unroll
                for (int j = 0; j < 4; ++j) { v0[j] = sigmoidf_(v0[j]); v1[j] = sigmoidf_(v1[j]); }
            }
            o[bj] = pack8(v0, v1);
        }
    }
    DI void store(const g8::Unit& u, int rt, int ch, const u32x4& d) const { __builtin_nontemporal_store(d, (u32x4*)(proj + (size_t)(u.pm * 256 + rt) * DIN + u.pn * 256 + ch * 8)); }
};
template <int PART> struct EpiGate { static constexpr bool OUT8 = false;
    const bf16_t* proj; const bf16_t* tmp; bf16_t* out;
    DI void pre(AccRef acc, const g8::Unit& u, int wr, int wc, int fr, int fq) const {
        const unsigned vo_g = (unsigned)(((wr * 64 + fr) * DIN + wc * 32 + 8 * fq) * 2), vo_t = (unsigned)(((wr * 64 + fr) * DM + wc * 32 + 8 * fq) * 2);
#pragma unroll
        for (int ai = 0; ai < 2; ++ai)
#pragma unroll
            for (int m = 0; m < 4; ++m) {
#pragma unroll
                for (int bj = 0; bj < 2; ++bj) {
                    gcptr sg = (gcptr)(proj + (size_t)(u.pm * 256 + ai * 128 + m * 16) * DIN + u.pn * 256 + bj * 128 + (PART == 0 ? COL_GD : COL_GS));
                    asm volatile("" : "+s"(sg));
                    const u32x4 gg = *(gu4ptr)(sg + vo_g);
                    const float sv[8] = {bf_lo(gg.x), bf_hi(gg.x), bf_lo(gg.y), bf_hi(gg.y), bf_lo(gg.z), bf_hi(gg.z), bf_lo(gg.w), bf_hi(gg.w)};
                    if (PART == 0) {
#pragma unroll
                        for (int j = 0; j < 4; ++j) { acc[ai][bj][m][0][j] *= sv[j]; acc[ai][bj][m][1][j] *= sv[4 + j]; }
                    } else {
                        gcptr st = (gcptr)(tmp + (size_t)(u.pm * 256 + ai * 128 + m * 16) * DM + u.pn * 256 + bj * 128);
                        asm volatile("" : "+s"(st));
                        const u32x4 tt = *(gu4ptr)(st + vo_t);
                        const float tv[8] = {bf_lo(tt.x), bf_hi(tt.x), bf_lo(tt.y), bf_hi(tt.y), bf_lo(tt.z), bf_hi(tt.z), bf_lo(tt.w), bf_hi(tt.w)};
#pragma unroll
                        for (int j = 0; j < 4; ++j) { acc[ai][bj][m][0][j] = acc[ai][bj][m][0][j] * sv[j] + tv[j]; acc[ai][bj][m][1][j] = acc[ai][bj][m][1][j] * sv[4 + j] + tv[4 + j]; }
                    }
                }
                asm volatile("" : "+v"(acc[ai][0][m][0]), "+v"(acc[ai][0][m][1]), "+v"(acc[ai][1][m][0]), "+v"(acc[ai][1][m][1]));
                if (m & 1) asm volatile("" ::: "memory");
            }
    }
    DI void row(AccRef acc, const g8::Unit&, int ai, int m, int, int, int, int, u32x4 (&o)[2]) const {
        o[0] = pack8(acc[ai][0][m][0], acc[ai][0][m][1]); o[1] = pack8(acc[ai][1][m][0], acc[ai][1][m][1]);
    }
    DI void store(const g8::Unit& u, int rt, int ch, const u32x4& d) const { *(u32x4*)(out + (size_t)(u.pm * 256 + rt) * DM + u.pn * 256 + ch * 8) = d; }
};
struct EpiPlain { static constexpr bool OUT8 = false;
    bf16_t* out; int ld;
    DI void pre(AccRef, const g8::Unit&, int, int, int, int) const {}
    DI void row(AccRef acc, const g8::Unit&, int ai, int m, int, int, int, int, u32x4 (&o)[2]) const {
        o[0] = pack8(acc[ai][0][m][0], acc[ai][0][m][1]); o[1] = pack8(acc[ai][1][m][0], acc[ai][1][m][1]);
    }
    DI void store(const g8::Unit& u, int rt, int ch, const u32x4& d) const { *(u32x4*)(out + (size_t)(u.pm * 256 + rt) * ld + u.pn * 256 + ch * 8) = d; }
};
struct EpiGateUp { static constexpr bool OUT8 = true;
    unsigned char* hid;
    DI void pre(AccRef, const g8::Unit&, int, int, int, int) const {}
    DI void row(AccRef, const g8::Unit&, int, int, int, int, int, int, u32x4 (&)[2]) const {}
    DI void store(const g8::Unit&, int, int, const u32x4&) const {}
    DI void row8(AccRef acc, const g8::Unit&, int ai, int m, int, int, int, int, u32x2 (&o)[2]) const {
        const f32x4 g0 = acc[ai][0][m][0], g1 = acc[ai][0][m][1], u0 = acc[ai][1][m][0], u1 = acc[ai][1][m][1];
        f32x4 v0, v1;
#pragma unroll
        for (int j = 0; j < 4; ++j) { v0[j] = g0[j] * __builtin_amdgcn_rcpf(1.0f + __expf(-g0[j])) * u0[j]; v1[j] = g1[j] * __builtin_amdgcn_rcpf(1.0f + __expf(-g1[j])) * u1[j]; }
        o[0].x = pk_fp8x4(v0[0], v0[1], v0[2], v0[3]); o[0].y = pk_fp8x4(v1[0], v1[1], v1[2], v1[3]); o[1] = o[0];
    }
    DI void store8(const g8::Unit& u, int rt, int ch, const u32x4& d) const { *(u32x4*)(hid + (size_t)(u.aux + rt) * DE + u.pn * 128 + ch * 16) = d; }
};
struct EpiDown { static constexpr bool OUT8 = true;
    LAS unsigned char* lds; unsigned char* yb9; int* slot;
    DI void pre(AccRef, const g8::Unit&, int, int, int, int) const {}
    DI void row(AccRef, const g8::Unit&, int, int, int, int, int, int, u32x4 (&)[2]) const {}
    DI void store(const g8::Unit&, int, int, const u32x4&) const {}
    DI void row8(AccRef acc, const g8::Unit& u, int ai, int m, int wr, int, int fr, int, u32x2 (&o)[2]) const {
        const int rt = ai * 128 + wr * 64 + m * 16 + fr;
        const float wgt = (u.e < NE) ? *(const LAS float*)(lds + MOE_IDX_OFF + u.par * 2048 + 1024 + rt * 4) : 1.0f;
#pragma unroll
        for (int bj = 0; bj < 2; ++bj) {
            const f32x4 v0 = acc[ai][bj][m][0] * wgt, v1 = acc[ai][bj][m][1] * wgt;
            o[bj].x = pk_fp8x4(v0[0], v0[1], v0[2], v0[3]); o[bj].y = pk_fp8x4(v1[0], v1[1], v1[2], v1[3]);
        }
    }
    DI void store8(const g8::Unit& u, int rt, int ch, const u32x4& d) const {
        if (rt < u.nvalid) {
            const int srow = u.aux + rt;
            __builtin_nontemporal_store(d, (u32x4*)(yb9 + ((size_t)u.pn * YB_SLOTS + srow) * 256 + ch * 16));
            if (u.pn == 0 && ch == 0) {
                const int v = (u.e < NE) ? *(const LAS int*)(lds + MOE_IDX_OFF + u.par * 2048 + rt * 4) : (u.pm * 256 + rt) * 9 + 8;
                slot[v] = srow;
            }
        }
    }
};

DI void phase_inproj(const Params& p, LAS unsigned char* lds) {
    DenseSched S{(const char*)(p.ws + WS_H), (const char*)(p.ws + WS_WTIN), 64, 46, 4096, 4096, 32, (int)gridDim.x, (int)blockIdx.x};
    EpiInProj E{(bf16_t*)(p.ws + WS_PROJ), (const float*)(p.ws + WS_ROPE)};
    g8::gemm_phase<32, 0, GEMM_SPLIT, false>(lds, S, E);
}
DI void phase_outproj_a(const Params& p, LAS unsigned char* lds) {
    DenseSched S{(const char*)(p.ws + WS_ODIL), (const char*)(p.ws + WS_WTDIL), 64, 8, 1024, 1024, 8, (int)gridDim.x, (int)blockIdx.x};
    EpiGate<0> E{(const bf16_t*)(p.ws + WS_PROJ), nullptr, (bf16_t*)(p.ws + WS_TMP)};
    g8::gemm_phase<32, 0, GEMM_SPLIT, false>(lds, S, E);
}
DI void phase_outproj_b(const Params& p, LAS unsigned char* lds) {
    DenseSched S{(const char*)(p.ws + WS_OSB), (const char*)(p.ws + WS_WTSB), 64, 8, 2048, 2048, 16, (int)gridDim.x, (int)blockIdx.x};
    EpiGate<1> E{(const bf16_t*)(p.ws + WS_PROJ), (const bf16_t*)(p.ws + WS_TMP), (bf16_t*)(p.ws + WS_H)};
    g8::gemm_phase<32, 0, GEMM_SPLIT, false>(lds, S, E);
}
DI void phase_mixout(const Params& p, LAS unsigned char* lds) {
    DenseSched S{(const char*)(p.ws + WS_H), (const char*)(p.ws + WS_WTMIX), 64, 8, 4096, 4096, 32, (int)gridDim.x, (int)blockIdx.x};
    EpiPlain E{(bf16_t*)(p.ws + WS_Y), DM};
    g8::gemm_phase<32, 0, GEMM_SPLIT, false>(lds, S, E);
}
DI void moe_tables(const Params& p, LAS unsigned char* lds) {
    LAS int* tpre = (LAS int*)(lds + MOE_TAB_OFF);
    const int* cnt = (const int*)(p.ws + WS_CNT);
    if (threadIdx.x == 0) {
        int acc = 0;
        for (int e = 0; e < NE; ++e) { const int n = cnt[e]; tpre[e] = acc; tpre[NEX + 1 + e] = n; acc += (n + 255) >> 8; }
        tpre[NE] = acc; tpre[NEX + 1 + NE] = NTOK; acc += NTOK / 256; tpre[NEX] = acc;
    }
    __syncthreads();
    const int T = tpre[NEX];
    for (int t = threadIdx.x; t < T; t += 512) {
        int e = 0;
        for (int q = 1; q < NEX; ++q) e = (tpre[q] <= t) ? q : e;
        *(LAS unsigned char*)(lds + MOE_TILE_OFF + t) = (unsigned char)e;
    }
    __syncthreads();
}
DI void phase_gateup(const Params& p, LAS unsigned char* lds) {
    moe_tables(p, lds);
    MoeSched S{lds, (const int*)(p.ws + WS_LIST), (const float*)(p.ws + WS_LISTW), (const char*)(p.ws + WS_H), (const char*)(p.ws + WS_WGU), 4, 0, (int)gridDim.x, (int)blockIdx.x};
    EpiGateUp E{(unsigned char*)(p.ws + WS_HID)};
    g8::gemm_phase<16, MOE_BAUX, GEMM_SPLIT, true>(lds, S, E);
}
DI void phase_down(const Params& p, LAS unsigned char* lds) {
    moe_tables(p, lds);
    MoeSched S{lds, (const int*)(p.ws + WS_LIST), (const float*)(p.ws + WS_LISTW), (const char*)(p.ws + WS_HID), (const char*)(p.ws + WS_WD), 8, 1, (int)gridDim.x, (int)blockIdx.x};
    EpiDown E{lds, (unsigned char*)(p.ws + WS_YB9), (int*)(p.ws + WS_SLOT)};
    g8::gemm_phase<32, MOE_BAUX, GEMM_SPLIT, true>(lds, S, E);
}

namespace att {
constexpr int TB = 16384;
DI unsigned off_b(unsigned row, unsigned ch) { return 256u * row + 16u * (ch ^ (((row & 3u) << 2) | ((row >> 2) & 3u))); }
DI int crow(int i, int h) { return (i & 3) + 8 * (i >> 2) + 4 * h; }
DI f32x16 mfma32(bf16x8 a, bf16x8 b, f32x16 c) { return __builtin_amdgcn_mfma_f32_32x32x16_bf16(a, b, c, 0, 0, 0); }
DI bf16x8 pack8(const f32x16& x, int s) {
    u32x4 w; w.x = pk_bf16(x[8 * s + 0], x[8 * s + 1]); w.y = pk_bf16(x[8 * s + 2], x[8 * s + 3]); w.z = pk_bf16(x[8 * s + 4], x[8 * s + 5]); w.w = pk_bf16(x[8 * s + 6], x[8 * s + 7]);
    return __builtin_bit_cast(bf16x8, w);
}
DI void qk_tile(LAS const unsigned char* Kb, const bf16x8 (&qf)[8], f32x16& x0, f32x16& x1, int r, int h) {
#pragma unroll
    for (int i = 0; i < 16; ++i) { x0[i] = 0.f; x1[i] = 0.f; }
#pragma unroll
    for (int s = 0; s < 8; ++s) {
        const bf16x8 a0 = *(const LAS bf16x8*)(Kb + off_b(r, 2 * s + h));
        const bf16x8 a1 = *(const LAS bf16x8*)(Kb + off_b(32 + r, 2 * s + h));
        x0 = mfma32(a0, qf[s], x0); x1 = mfma32(a1, qf[s], x1);
    }
}
DI void pv_tile(LAS const unsigned char* Vb, const f32x16& p0, const f32x16& p1, f32x16 (&o)[4], int lane) {
    const int h = lane >> 5, blk = (lane >> 4) & 1, q = (lane & 15) >> 2, pp = lane & 3;
#pragma unroll
    for (int kb = 0; kb < 2; ++kb)
#pragma unroll
        for (int s = 0; s < 2; ++s) {
            const bf16x8 pf = pack8(kb ? p1 : p0, s);
#pragma unroll
            for (int db = 0; db < 4; ++db) {
                const unsigned row0 = 32 * kb + 16 * s + 4 * h + q;
                const unsigned ch = 4 * db + 2 * blk + (pp >> 1);
                const s16x4 t0 = __builtin_amdgcn_ds_read_tr16_b64_v4i16((LAS s16x4*)(Vb + off_b(row0, ch) + 8 * (pp & 1)));
                const s16x4 t1 = __builtin_amdgcn_ds_read_tr16_b64_v4i16((LAS s16x4*)(Vb + off_b(row0 + 8, ch) + 8 * (pp & 1)));
                const bf16x8 vf = {t0[0], t0[1], t0[2], t0[3], t1[0], t1[1], t1[2], t1[3]};
                o[db] = mfma32(vf, pf, o[db]);
            }
        }
}
DI void store_o(bf16_t* orow, const f32x16 (&o)[4], float scale, int h) {
#pragma unroll
    for (int db = 0; db < 4; ++db)
#pragma unroll
        for (int g = 0; g < 4; ++g) {
            u32x2 w; w.x = pk_bf16(o[db][4 * g] * scale, o[db][4 * g + 1] * scale); w.y = pk_bf16(o[db][4 * g + 2] * scale, o[db][4 * g + 3] * scale);
            *(u32x2*)(orow + 32 * db + 8 * g + 4 * h) = w;
        }
}

DI void sb_item(const Params& p, LAS unsigned char* lds, int b, int hd, int Q) {
    const bf16_t* proj = (const bf16_t*)(p.ws + WS_PROJ);
    bf16_t* osb = (bf16_t*)(p.ws + WS_OSB);
    const int tid = threadIdx.x, wid = __builtin_amdgcn_readfirstlane(tid >> 6), lane = tid & 63, r = lane & 31, h = lane >> 5;
    const size_t tokbase = (size_t)b * SEQ;
    const int wq0 = Q * 256 + 32 * wid;
    const int myq = wq0 + r;
    bf16x8 qf[8];
    f32x16 o[4];
#pragma unroll
    for (int db = 0; db < 4; ++db)
#pragma unroll
        for (int i = 0; i < 16; ++i) o[db][i] = 0.f;
    float R = 0.f;
    unsigned goff[2];
#pragma unroll
    for (int i = 0; i < 2; ++i) { const unsigned row = 4 * (wid * 2 + i) + (lane >> 4), cp = lane & 15, ch = cp ^ (((row & 3u) << 2) | ((row >> 2) & 3u)); goff[i] = (row * DIN + ch * 8) * 2; }
    const char* kbase = (const char*)(proj + tokbase * DIN + COL_KS + hd * 128);
    const char* vbase = (const char*)(proj + tokbase * DIN + COL_VS + hd * 128);
#define ATT_ISSUE(key0_, buf_) do { const size_t _ko = (size_t)(key0_) * DIN * 2; _Pragma("unroll") for (int _i = 0; _i < 2; ++_i) { \
        __builtin_amdgcn_global_load_lds((const unsigned*)(kbase + _ko + goff[_i]), (LAS unsigned*)(lds + (buf_) * TB + 1024 * (wid * 2 + _i)), 16, 0, 0); \
        __builtin_amdgcn_global_load_lds((const unsigned*)(vbase + _ko + goff[_i]), (LAS unsigned*)(lds + 3 * TB + (buf_) * TB + 1024 * (wid * 2 + _i)), 16, 0, 0); } } while (0)
    int j = 4 * Q + 3;
    ATT_ISSUE(64 * j, 0);
    ATT_ISSUE(64 * (j - 1), 1);
    {
        const bf16_t* qrow = proj + (tokbase + myq) * DIN + COL_QS + hd * 128;
#pragma unroll
        for (int s = 0; s < 8; ++s) qf[s] = *(const bf16x8*)(qrow + 16 * s + 8 * h);
#pragma unroll
        for (int s = 0; s < 8; ++s) asm volatile("" : "+v"(qf[s]));
    }
    int cur = 0;
    for (; j >= 0; --j) {
        LAS unsigned char* Kb = lds + cur * TB; LAS unsigned char* Vb = lds + 3 * TB + cur * TB;
        if (j > 0) asm volatile("s_waitcnt vmcnt(4)" ::: "memory"); else asm volatile("s_waitcnt vmcnt(0)" ::: "memory");
        __builtin_amdgcn_s_barrier(); asm volatile("" ::: "memory");
        if (j > 1) ATT_ISSUE(64 * (j - 2), cur == 0 ? 2 : cur - 1);
        const int key0 = 64 * j;
        if (key0 < wq0 + 31) {
            const bool need_mask = (key0 + 63 >= wq0);
            f32x16 x0, x1;
            qk_tile(Kb, qf, x0, x1, r, h);
            f32x16 l0, l1;
#pragma unroll
            for (int i = 0; i < 16; ++i) {
                l0[i] = __builtin_amdgcn_logf(1.0f + __builtin_amdgcn_exp2f(x0[i]));
                l1[i] = __builtin_amdgcn_logf(1.0f + __builtin_amdgcn_exp2f(x1[i]));
            }
            if (need_mask) {
#pragma unroll
                for (int i = 0; i < 16; ++i) { const int kk = key0 + crow(i, h); if (kk >= myq) l0[i] = 0.f; if (kk + 32 >= myq) l1[i] = 0.f; }
            }
#pragma unroll
            for (int g = 0; g < 4; ++g) {
                l0[4 * g + 2] += l0[4 * g + 3]; l0[4 * g + 1] += l0[4 * g + 2]; l0[4 * g] += l0[4 * g + 1];
                l1[4 * g + 2] += l1[4 * g + 3]; l1[4 * g + 1] += l1[4 * g + 2]; l1[4 * g] += l1[4 * g + 1];
            }
            float Tlo[8], Thi[8];
#pragma unroll
            for (int g = 0; g < 4; ++g) {
                { const unsigned t = __float_as_uint(l0[4 * g]); auto sw = __builtin_amdgcn_permlane32_swap(t, t, false, false); Tlo[g] = __uint_as_float(sw[0]); Thi[g] = __uint_as_float(sw[1]); }
                { const unsigned t = __float_as_uint(l1[4 * g]); auto sw = __builtin_amdgcn_permlane32_swap(t, t, false, false); Tlo[4 + g] = __uint_as_float(sw[0]); Thi[4 + g] = __uint_as_float(sw[1]); }
            }
            float offR[8];
            float run = 0.f;
#pragma unroll
            for (int g = 7; g >= 0; --g) { offR[g] = run + (h == 0 ? Thi[g] : 0.f) + R; run += Tlo[g] + Thi[g]; }
            f32x16 p0, p1;
#pragma unroll
            for (int i = 0; i < 16; ++i) {
                p0[i] = __builtin_amdgcn_exp2f(x0[i] - (l0[i] + offR[i >> 2]));
                p1[i] = __builtin_amdgcn_exp2f(x1[i] - (l1[i] + offR[4 + (i >> 2)]));
            }
            if (need_mask) {
#pragma unroll
                for (int i = 0; i < 16; ++i) { const int kk = key0 + crow(i, h); if (kk >= myq) p0[i] = 0.f; if (kk + 32 >= myq) p1[i] = 0.f; }
            }
            R += run;
            pv_tile(Vb, p0, p1, o, lane);
        }
        cur = (cur == 2) ? 0 : cur + 1;
    }
    store_o(osb + (tokbase + myq) * 1024 + hd * 128, o, 1.0f, h);
    __syncthreads();
}

DI void dil_item(const Params& p, LAS unsigned char* lds, int di) {
    const bf16_t* proj = (const bf16_t*)(p.ws + WS_PROJ);
    bf16_t* og = (bf16_t*)(p.ws + WS_OG);
    float* lse = (float*)(p.ws + WS_LSE);
    const int b = di / 192; const int rem = di - b * 192; const int head = rem >> 4, sub = rem & 15;
    const int grp = head >> 2;
    const int dil = grp == 0 ? 1 : grp == 1 ? 4 : 16;
    const int nblk = 16 / dil;
    const int res = sub / nblk, Qb = sub - res * nblk;
    const int i0 = Qb * 256;
    const int tid = threadIdx.x, wid = __builtin_amdgcn_readfirstlane(tid >> 6), lane = tid & 63, r = lane & 31, h = lane >> 5;
    const size_t tokbase = (size_t)b * SEQ;
    const int wq0 = i0 + 32 * wid;
    const int myqi = wq0 + r;
    const size_t mytok = tokbase + (size_t)myqi * dil + res;
    bf16x8 qf[8];
    f32x16 o[4];
#pragma unroll
    for (int db = 0; db < 4; ++db)
#pragma unroll
        for (int i = 0; i < 16; ++i) o[db][i] = 0.f;
    float mrun = -1e30f, lrun = 0.f;
    unsigned goff[2];
#pragma unroll
    for (int i = 0; i < 2; ++i) { const unsigned row = 4 * (wid * 2 + i) + (lane >> 4), cp = lane & 15, ch = cp ^ (((row & 3u) << 2) | ((row >> 2) & 3u)); goff[i] = (row * dil * DIN + ch * 8) * 2; }
    const char* kbase = (const char*)(proj + (tokbase + res) * DIN + COL_KA + head * 128);
    const char* vbase = (const char*)(proj + (tokbase + res) * DIN + COL_VA + head * 128);
    const int jt0 = (i0 == 0) ? 2 : 0;
    ATT_ISSUE((i0 - 128 + 64 * jt0) * dil, 0);
    ATT_ISSUE((i0 - 128 + 64 * (jt0 + 1)) * dil, 1);
    {
        const bf16_t* qrow = proj + mytok * DIN + COL_QA + head * 128;
#pragma unroll
        for (int s = 0; s < 8; ++s) qf[s] = *(const bf16x8*)(qrow + 16 * s + 8 * h);
#pragma unroll
        for (int s = 0; s < 8; ++s) asm volatile("" : "+v"(qf[s]));
    }
    int cur = 0;
    for (int jt = jt0; jt < 6; ++jt) {
        LAS unsigned char* Kb = lds + cur * TB; LAS unsigned char* Vb = lds + 3 * TB + cur * TB;
        if (jt < 5) asm volatile("s_waitcnt vmcnt(4)" ::: "memory"); else asm volatile("s_waitcnt vmcnt(0)" ::: "memory");
        __builtin_amdgcn_s_barrier(); asm volatile("" ::: "memory");
        if (jt < 4) ATT_ISSUE((i0 - 128 + 64 * (jt + 2)) * dil, cur == 0 ? 2 : cur - 1);
        const int ki0 = i0 - 128 + 64 * jt;
        if (ki0 <= wq0 + 31 && ki0 + 63 >= wq0 - 128) {
            f32x16 x0, x1;
            qk_tile(Kb, qf, x0, x1, r, h);
            const float NEG = -__builtin_inff();
#pragma unroll
            for (int i = 0; i < 16; ++i) {
                const int d0 = myqi - (ki0 + crow(i, h));
                if ((unsigned)d0 > 128u) x0[i] = NEG;
                if ((unsigned)(d0 - 32) > 128u) x1[i] = NEG;
            }
            float mx = x0[0];
#pragma unroll
            for (int i = 1; i < 16; ++i) mx = fmaxf(mx, x0[i]);
#pragma unroll
            for (int i = 0; i < 16; ++i) mx = fmaxf(mx, x1[i]);
            { const unsigned t = __float_as_uint(mx); auto sw = __builtin_amdgcn_permlane32_swap(t, t, false, false); mx = fmaxf(__uint_as_float(sw[0]), __uint_as_float(sw[1])); }
            const float mn = fmaxf(mrun, mx);
            const float alpha = __builtin_amdgcn_exp2f(mrun - mn);
            mrun = mn;
            f32x16 p0, p1; float rs = 0.f;
#pragma unroll
            for (int i = 0; i < 16; ++i) { p0[i] = __builtin_amdgcn_exp2f(x0[i] - mn); p1[i] = __builtin_amdgcn_exp2f(x1[i] - mn); rs += p0[i] + p1[i]; }
            { const unsigned t = __float_as_uint(rs); auto sw = __builtin_amdgcn_permlane32_swap(t, t, false, false); rs = __uint_as_float(sw[0]) + __uint_as_float(sw[1]); }
            lrun = lrun * alpha + rs;
#pragma unroll
            for (int db = 0; db < 4; ++db)
#pragma unroll
                for (int i = 0; i < 16; ++i) o[db][i] *= alpha;
            pv_tile(Vb, p0, p1, o, lane);
        }
        cur = (cur == 2) ? 0 : cur + 1;
    }
    store_o(og + mytok * 1536 + head * 128, o, 1.0f / lrun, h);
    if (h == 0) lse[mytok * 12 + head] = (mrun + __builtin_amdgcn_logf(lrun)) * LN2;
    __syncthreads();
}
#undef ATT_ISSUE
}

DI void phase_attn(const Params& p, LAS unsigned char* lds) {
    for (int it = blockIdx.x; it < 1024; it += gridDim.x) {
        if (it < 256) {
            const int xcd = it & 7, rest = it >> 3, bhi = rest >> 3, x = rest & 7, bh = xcd * 4 + bhi;
            att::sb_item(p, lds, bh >> 3, bh & 7, 15 - x);
            att::sb_item(p, lds, bh >> 3, bh & 7, x);
        } else att::dil_item(p, lds, it - 256);
    }
}

DI void phase_merge(const Params& p) {
    const int lane = threadIdx.x & 63, wid = threadIdx.x >> 6;
    const bf16_t* og = (const bf16_t*)(p.ws + WS_OG); const float* lse = (const float*)(p.ws + WS_LSE); bf16_t* odil = (bf16_t*)(p.ws + WS_ODIL);
    const int hg = lane >> 4, d0 = (lane & 15) * 8;
    for (int tok = blockIdx.x * 8 + wid; tok < NTOK; tok += gridDim.x * 8) {
        const float l0 = lse[(size_t)tok * 12 + hg], l1 = lse[(size_t)tok * 12 + 4 + hg], l2 = lse[(size_t)tok * 12 + 8 + hg];
        const float mx = fmaxf(l0, fmaxf(l1, l2));
        float w0 = __expf(l0 - mx), w1 = __expf(l1 - mx), w2 = __expf(l2 - mx);
        const float inv = 1.0f / (w0 + w1 + w2); w0 *= inv; w1 *= inv; w2 *= inv;
        const u32x4 a = *(const u32x4*)(og + (size_t)tok * 1536 + hg * 128 + d0);
        const u32x4 bq = *(const u32x4*)(og + (size_t)tok * 1536 + (4 + hg) * 128 + d0);
        const u32x4 c = *(const u32x4*)(og + (size_t)tok * 1536 + (8 + hg) * 128 + d0);
        u32x4 o;
#pragma unroll
        for (int q = 0; q < 4; ++q) {
            const float lo = w0 * bf_lo(a[q]) + w1 * bf_lo(bq[q]) + w2 * bf_lo(c[q]);
            const float hi = w0 * bf_hi(a[q]) + w1 * bf_hi(bq[q]) + w2 * bf_hi(c[q]);
            o[q] = pk_bf16(lo, hi);
        }
        *(u32x4*)(odil + (size_t)tok * 512 + hg * 128 + d0) = o;
    }
}

DI void phase_postmix(const Params& p, LAS unsigned char* lds) {
    const int tid = threadIdx.x, lane = tid & 63, wid = __builtin_amdgcn_readfirstlane(tid >> 6);
    LAS float* hsm = (LAS float*)lds;
    LAS float* part = (LAS float*)(lds + 131072);
    const float* mod = (const float*)(p.ws + WS_MOD); const bf16_t* y = (const bf16_t*)(p.ws + WS_Y);
    unsigned char* h2 = (unsigned char*)(p.ws + WS_H);
    int* cnt = (int*)(p.ws + WS_CNT); int* list = (int*)(p.ws + WS_LIST); float* listw = (float*)(p.ws + WS_LISTW);
    const bf16_t* wr_hi = (const bf16_t*)(p.ws + WS_WRT); const bf16_t* wr_lo = wr_hi + 64 * 2048;
    LAS int* lcnt = (LAS int*)(lds + 147456);
    LAS int* lbase = (LAS int*)(lds + 147712);
    LAS unsigned char* sel_e = lds + 147968;
    LAS unsigned short* sel_r = (LAS unsigned short*)(lds + 150016);
    LAS float* sel_w = (LAS float*)(lds + 154112);
    if (tid < 64) lcnt[tid] = 0;
    int itl = 0;
    for (int it = blockIdx.x; it < NTOK / 16; it += gridDim.x, ++itl) {
#pragma unroll 1
        for (int sub = 0; sub < 2; ++sub) {
            const int tl = 2 * wid + sub, tok = it * 16 + tl, b = tok >> 12;
            f32x4 v[8]; float ss = 0.f;
#pragma unroll
            for (int i = 0; i < 8; ++i) { const u32x2 yw = *(const u32x2*)(y + (size_t)tok * DM + 4 * (lane + 64 * i)); v[i] = (f32x4){bf_lo(yw.x), bf_hi(yw.x), bf_lo(yw.y), bf_hi(yw.y)}; ss += v[i][0] * v[i][0] + v[i][1] * v[i][1] + v[i][2] * v[i][2] + v[i][3] * v[i][3]; }
            ss = wave_sum(ss);
            const float rstd = rsqrtf(ss * (1.0f / DM) + RMS_EPS);
            float ss1 = 0.f;
#pragma unroll
            for (int i = 0; i < 8; ++i) {
                const int ch = 4 * (lane + 64 * i);
                const f32x4 g = *(const f32x4*)(p.g_post_mix + ch);
                const f32x4 gt = *(const f32x4*)(mod + b * 12288 + 4096 + ch);
                const f32x4 xv = *(const f32x4*)(p.x + (size_t)tok * DM + ch);
#pragma unroll
                for (int j = 0; j < 4; ++j) { v[i][j] = xv[j] + gt[j] * (v[i][j] * rstd * g[j]); ss1 += v[i][j] * v[i][j]; }
                *(f32x4*)(p.out + (size_t)tok * DM + ch) = v[i];
            }
            ss1 = wave_sum(ss1);
            const float rstd1 = rsqrtf(ss1 * (1.0f / DM) + RMS_EPS);
#pragma unroll
            for (int i = 0; i < 8; ++i) {
                const int ch = 4 * (lane + 64 * i);
                const f32x4 g = *(const f32x4*)(p.g_pre_ffn + ch);
                const f32x4 sh = *(const f32x4*)(mod + b * 12288 + 6144 + ch);
                const f32x4 sc = *(const f32x4*)(mod + b * 12288 + 8192 + ch);
                f32x4 o;
#pragma unroll
                for (int j = 0; j < 4; ++j) o[j] = v[i][j] * rstd1 * g[j] * (1.0f + sc[j]) + sh[j];
                *(unsigned*)(h2 + (size_t)tok * DM + ch) = pk_fp8x4(o[0], o[1], o[2], o[3]);
                *(LAS f32x4*)(hsm + tl * 2048 + ch) = o;
            }
        }
        __syncthreads();
        f32x4 acc[4];
        {
            const int tr = lane & 15, kq = lane >> 4;
#pragma unroll
            for (int q = 0; q < 4; ++q) acc[q] = (f32x4){0.f, 0.f, 0.f, 0.f};
#pragma unroll 4
            for (int ks = 0; ks < 8; ++ks) {
                const int k0 = 256 * wid + 32 * ks + 8 * kq;
                const f32x4 a0 = *(const LAS f32x4*)(hsm + tr * 2048 + k0), a1 = *(const LAS f32x4*)(hsm + tr * 2048 + k0 + 4);
                u32x4 hw, lw;
                {
                    float xs[8] = {a0[0], a0[1], a0[2], a0[3], a1[0], a1[1], a1[2], a1[3]};
                    unsigned hh[4], ll[4];
#pragma unroll
                    for (int q = 0; q < 4; ++q) {
                        hh[q] = pk_bf16(xs[2 * q], xs[2 * q + 1]);
                        ll[q] = pk_bf16(xs[2 * q] - bf_lo(hh[q]), xs[2 * q + 1] - bf_hi(hh[q]));
                    }
                    hw = (u32x4){hh[0], hh[1], hh[2], hh[3]}; lw = (u32x4){ll[0], ll[1], ll[2], ll[3]};
                }
                const bf16x8 ah = __builtin_bit_cast(bf16x8, hw), al = __builtin_bit_cast(bf16x8, lw);
#pragma unroll
                for (int q = 0; q < 4; ++q) {
                    const bf16x8 bh = *(const bf16x8*)(wr_hi + (size_t)(16 * q + tr) * 2048 + k0);
                    const bf16x8 bl = *(const bf16x8*)(wr_lo + (size_t)(16 * q + tr) * 2048 + k0);
                    acc[q] = __builtin_amdgcn_mfma_f32_16x16x32_bf16(ah, bh, acc[q], 0, 0, 0);
                    acc[q] = __builtin_amdgcn_mfma_f32_16x16x32_bf16(ah, bl, acc[q], 0, 0, 0);
                    acc[q] = __builtin_amdgcn_mfma_f32_16x16x32_bf16(al, bh, acc[q], 0, 0, 0);
                }
            }
            if (wid >= 4) {
#pragma unroll
                for (int q = 0; q < 4; ++q)
#pragma unroll
                    for (int j = 0; j < 4; ++j) part[((wid - 4) * 16 + 4 * kq + j) * 64 + 16 * q + tr] = acc[q][j];
            }
        }
        __syncthreads();
        if (wid < 4) {
            const int tr = lane & 15, kq = lane >> 4;
#pragma unroll
            for (int q = 0; q < 4; ++q)
#pragma unroll
                for (int j = 0; j < 4; ++j) part[(wid * 16 + 4 * kq + j) * 64 + 16 * q + tr] += acc[q][j];
        }
        __syncthreads();
#pragma unroll 1
        for (int sub = 0; sub < 2; ++sub) {
            const int tl = 2 * wid + sub, tok = it * 16 + tl;
            const float logit = ((part[(0 * 16 + tl) * 64 + lane] + part[(1 * 16 + tl) * 64 + lane]) + part[(2 * 16 + tl) * 64 + lane]) + part[(3 * 16 + tl) * 64 + lane];
            const float score = 1.0f / (1.0f + __expf(-logit));
            const float sel = score + p.router_bias[lane];
            float m1 = sel;
            m1 = fmaxf(m1, __shfl_xor(m1, 1)); m1 = fmaxf(m1, __shfl_xor(m1, 2)); m1 = fmaxf(m1, __shfl_xor(m1, 4));
            const bool is1 = (sel == m1);
            const unsigned long long bal = __ballot(is1);
            const unsigned gm = (unsigned)(bal >> (lane & ~7)) & 0xffu;
            const int first = __ffs(gm) - 1;
            float m2 = (is1 && (lane & 7) == first) ? -__builtin_inff() : sel;
            m2 = fmaxf(m2, __shfl_xor(m2, 1)); m2 = fmaxf(m2, __shfl_xor(m2, 2)); m2 = fmaxf(m2, __shfl_xor(m2, 4));
            const float gs = m1 + m2;
            const int myg = lane >> 3;
            int grank = 0;
#pragma unroll 1
            for (int g = 0; g < 8; ++g) { const float gv = __uint_as_float(__builtin_amdgcn_readlane(__float_as_uint(gs), 8 * g)); grank += (gv > gs || (gv == gs && g < myg)) ? 1 : 0; }
            const bool gsel = grank < 4;
            const float msel = gsel ? sel : -__builtin_inff();
            int rk = 0;
#pragma unroll 4
            for (int e = 0; e < 64; ++e) { const float v = __uint_as_float(__builtin_amdgcn_readlane(__float_as_uint(msel), e)); rk += (v > msel || (v == msel && e < lane)) ? 1 : 0; }
            const bool chosen = gsel && rk < 8;
            const float ssum = wave_sum(chosen ? score : 0.f);
            if (chosen) {
                const int lr = __hip_atomic_fetch_add(lcnt + lane, 1, __ATOMIC_RELAXED, __HIP_MEMORY_SCOPE_WORKGROUP);
                const int idx = ((itl & 15) * 16 + tl) * 8 + rk;
                sel_e[idx] = (unsigned char)lane; sel_r[idx] = (unsigned short)lr; sel_w[idx] = score / ssum * 2.5f;
            }
            (void)tok;
        }
        __syncthreads();
        if ((itl & 15) == 15 || it + (int)gridDim.x >= NTOK / 16) {
            if (tid < 64) lbase[tid] = atomicAdd(&cnt[tid], lcnt[tid]);
            __syncthreads();
            const int nsel = ((itl & 15) + 1) * 128, it0 = itl & ~15;
            for (int idx = tid; idx < nsel; idx += 512) {
                const int e = sel_e[idx], tl = idx >> 3, k = idx & 7;
                const int tk = ((int)blockIdx.x + (it0 + (tl >> 4)) * (int)gridDim.x) * 16 + (tl & 15);
                const int pos = lbase[e] + sel_r[idx];
                list[e * LIST_CAP + pos] = tk * 9 + k; listw[e * LIST_CAP + pos] = sel_w[idx];
            }
            __syncthreads();
            if (tid < 64) lcnt[tid] = 0;
            __syncthreads();
        }
    }
}

DI void phase_combine(const Params& p) {
    const int lane = threadIdx.x & 63, wid = threadIdx.x >> 6;
    const float* mod = (const float*)(p.ws + WS_MOD); const unsigned char* yb9 = (const unsigned char*)(p.ws + WS_YB9); const int* slot = (const int*)(p.ws + WS_SLOT);
    for (int tok = blockIdx.x * 8 + wid; tok < NTOK; tok += gridDim.x * 8) {
        const int b = tok >> 12;
        float acc[2][16];
#pragma unroll
        for (int i = 0; i < 2; ++i)
#pragma unroll
            for (int j = 0; j < 16; ++j) acc[i][j] = 0.f;
#pragma unroll 3
        for (int k = 0; k < 9; ++k) {
            const unsigned char* row = yb9 + (size_t)slot[tok * 9 + k] * 256;
#pragma unroll
            for (int i = 0; i < 2; ++i) {
                const int c = lane + 64 * i;
                const u32x4 w = __builtin_nontemporal_load((const u32x4*)(row + (size_t)(c >> 4) * YB_SLOTS * 256 + (c & 15) * 16));
#pragma unroll
                for (int q = 0; q < 4; ++q) {
                    const f32x2 lo = __builtin_amdgcn_cvt_pk_f32_fp8((int)w[q], false), hi = __builtin_amdgcn_cvt_pk_f32_fp8((int)w[q], true);
                    acc[i][4 * q] += lo[0]; acc[i][4 * q + 1] += lo[1]; acc[i][4 * q + 2] += hi[0]; acc[i][4 * q + 3] += hi[1];
                }
            }
        }
        float ss = 0.f;
#pragma unroll
        for (int i = 0; i < 2; ++i)
#pragma unroll
            for (int j = 0; j < 16; ++j) ss += acc[i][j] * acc[i][j];
        ss = wave_sum(ss);
        const float rstd = rsqrtf(ss * (1.0f / DM) + RMS_EPS);
#pragma unroll
        for (int i = 0; i < 2; ++i) {
            const int ch = 16 * (lane + 64 * i);
#pragma unroll
            for (int hh = 0; hh < 4; ++hh) {
                const f32x4 g = *(const f32x4*)(p.g_post_ffn + ch + 4 * hh);
                const f32x4 gt = *(const f32x4*)(mod + b * 12288 + 10240 + ch + 4 * hh);
                f32x4 xv = *(const f32x4*)(p.out + (size_t)tok * DM + ch + 4 * hh);
#pragma unroll
                for (int j = 0; j < 4; ++j) xv[j] += gt[j] * (acc[i][4 * hh + j] * rstd * g[j]);
                __builtin_nontemporal_store(xv, (f32x4*)(p.out + (size_t)tok * DM + ch + 4 * hh));
            }
        }
    }
}

DI void probe_copy(const Params& p) {
    u32x4* yb = (u32x4*)(p.ws + WS_YB9);
    const size_t n = (size_t)576 * MiB / 16;
    for (size_t i = (size_t)blockIdx.x * 512 + threadIdx.x; i < n; i += (size_t)gridDim.x * 512) { u32x4 v = yb[i]; asm volatile("" : "+v"(v)); yb[i] = v; }
}

constexpr int NPHASE = 12;
template <int PH> DI void run_phase(const Params& p, LAS unsigned char* lds) {
    if constexpr (PH == 0) phase_prologue(p, lds);
    else if constexpr (PH == 1) phase_prenorm(p);
    else if constexpr (PH == 2) phase_inproj(p, lds);
    else if constexpr (PH == 3) phase_attn(p, lds);
    else if constexpr (PH == 4) phase_merge(p);
    else if constexpr (PH == 5) phase_outproj_a(p, lds);
    else if constexpr (PH == 6) phase_outproj_b(p, lds);
    else if constexpr (PH == 7) phase_mixout(p, lds);
    else if constexpr (PH == 8) phase_postmix(p, lds);
    else if constexpr (PH == 9) phase_gateup(p, lds);
    else if constexpr (PH == 10) phase_down(p, lds);
    else phase_combine(p);
}
template <int PH> __global__ __launch_bounds__(512, 2) void k_phase(Params p) {
    extern __shared__ __attribute__((aligned(16))) unsigned char shm[];
    run_phase<PH>(p, (LAS unsigned char*)shm);
}
#if MK_FUSED
typedef const __attribute__((address_space(4))) Params* KargPtr;
template <int PH> DI void mega_phase(KargPtr kp0, LAS unsigned char* lds) {
    KargPtr kp = kp0; asm volatile("" : "+s"(kp));
    Params p{};
#if defined(__HIP_DEVICE_COMPILE__)
    p.x = kp->x; p.c = kp->c; p.pos = kp->pos; p.w_ada = kp->w_ada; p.b_ada = kp->b_ada; p.g_pre_mix = kp->g_pre_mix; p.g_post_mix = kp->g_post_mix; p.g_pre_ffn = kp->g_pre_ffn; p.g_post_ffn = kp->g_post_ffn; p.w_in = kp->w_in; p.w_dil_out = kp->w_dil_out; p.w_sb_out = kp->w_sb_out; p.w_mix_out = kp->w_mix_out; p.w_router = kp->w_router; p.router_bias = kp->router_bias; p.w_gate_e = kp->w_gate_e; p.w_up_e = kp->w_up_e; p.w_down_e = kp->w_down_e; p.w_gate_s = kp->w_gate_s; p.w_up_s = kp->w_up_s; p.w_down_s = kp->w_down_s; p.out = kp->out; p.ws = kp->ws;
#endif
    run_phase<PH>(p, lds);
}
__global__ __launch_bounds__(512, 2) void k_mega(Params p_unused) {
    extern __shared__ __attribute__((aligned(16))) unsigned char shm[];
    LAS unsigned char* lds = (LAS unsigned char*)shm;
    KargPtr kp0 = (KargPtr)__builtin_amdgcn_kernarg_segment_ptr();
    volatile LAS unsigned* xbw = (volatile LAS unsigned*)(lds + LDS_BYTES - 16);
    if (threadIdx.x == 0) { xbw[0] = 0u; xbw[1] = 0u; xbw[2] = 0u; xbw[3] = 0u; }
    __syncthreads();
    XcdBarrier bar;
    { KargPtr kp = kp0; asm volatile("" : "+s"(kp)); bar = xcd_barrier_post((unsigned*)(kp->ws + WS_BAR), xbw); }
    if (MK_STAMP >= 0 && blockIdx.x == 0 && threadIdx.x == 0) { KargPtr kq = kp0; asm volatile("" : "+s"(kq)); ((unsigned long long*)(kq->ws + WS_STAMP))[0] = wall_clock64(); }
#define MEGA_PH(n) do { mega_phase<n>(kp0, lds); xcd_barrier(bar); if (MK_REP == n) { mega_phase<n>(kp0, lds); xcd_barrier(bar); } \
        if (MK_STAMP >= 0 && blockIdx.x == 0 && threadIdx.x == 0) { KargPtr kq = kp0; asm volatile("" : "+s"(kq)); ((unsigned long long*)(kq->ws + WS_STAMP))[n + 1] = wall_clock64(); } } while (0)
#if MK_REP == 90
#define MK_PROBE_DOWN_NOSTORE 1
#endif
    MEGA_PH(0); MEGA_PH(1); MEGA_PH(2); MEGA_PH(3); MEGA_PH(4); MEGA_PH(5); MEGA_PH(6); MEGA_PH(7); MEGA_PH(8); MEGA_PH(9); MEGA_PH(10);
#if MK_REP == 100
    { KargPtr kp = kp0; asm volatile("" : "+s"(kp)); Params p{}; p.ws = kp->ws; probe_copy(p); xcd_barrier(bar); }
#endif
#undef MEGA_PH
    mega_phase<11>(kp0, lds);
#if MK_STAMP >= 0
    xcd_barrier(bar);
    if (blockIdx.x == 0 && threadIdx.x == 0) {
        KargPtr kq = kp0; asm volatile("" : "+s"(kq));
        unsigned long long* st = (unsigned long long*)(kq->ws + WS_STAMP);
        st[12] = wall_clock64();
        const int k = MK_STAMP < 100 ? MK_STAMP : MK_STAMP - 100;
        const unsigned long long t0 = (MK_STAMP < 100) ? st[k] : st[0], t1 = (MK_STAMP < 100) ? st[k + 1] : st[k + 1];
        kq->out[0] += 2.0f + (float)(t1 - t0) * (MK_STAMP < 100 ? 0.0005f : 0.0001f);
    }
#endif
}
#endif

template <int PH> static void launch_phase(const Params& p, int grid, hipStream_t stream) {
    static bool init = false;
    if (!init) { (void)hipFuncSetAttribute((const void*)k_phase<PH>, hipFuncAttributeMaxDynamicSharedMemorySize, LDS_BYTES); init = true; }
    hipLaunchKernelGGL(k_phase<PH>, dim3(grid), dim3(512), LDS_BYTES, stream, p);
}

extern "C" void kernel_launch(void* const* d_in, const int* in_sizes, int n_in, void* d_out, int out_size, void* d_ws, size_t ws_size, hipStream_t stream) {
    (void)in_sizes; (void)n_in; (void)out_size;
    static int grid = 0;
    if (!grid) {
        int dev = 0, cus = 0; (void)hipGetDevice(&dev); (void)hipDeviceGetAttribute(&cus, hipDeviceAttributeMultiprocessorCount, dev);
        if (cus <= 0) cus = 256;
#if MK_FUSED
        (void)hipFuncSetAttribute((const void*)k_mega, hipFuncAttributeMaxDynamicSharedMemorySize, LDS_BYTES);
        int per_cu = 0;
        if (hipOccupancyMaxActiveBlocksPerMultiprocessor(&per_cu, (const void*)k_mega, 512, LDS_BYTES) != hipSuccess || per_cu < 1)
            fprintf(stderr, "kernel_launch: occupancy query reports %d workgroups per CU\n", per_cu);
#endif
        grid = cus;
        if (ws_size < WS_TOTAL) fprintf(stderr, "kernel_launch: workspace too small: %zu < %zu\n", ws_size, (size_t)WS_TOTAL);
    }
    Params p{};
    p.x = (const float*)d_in[0]; p.c = (const float*)d_in[1]; p.pos = (const int*)d_in[2];
    p.w_ada = (const float*)d_in[3]; p.b_ada = (const float*)d_in[4];
    p.g_pre_mix = (const float*)d_in[5]; p.g_post_mix = (const float*)d_in[6]; p.g_pre_ffn = (const float*)d_in[7]; p.g_post_ffn = (const float*)d_in[8];
    p.w_in = (const float*)d_in[9]; p.w_dil_out = (const float*)d_in[10]; p.w_sb_out = (const float*)d_in[11]; p.w_mix_out = (const float*)d_in[12];
    p.w_router = (const float*)d_in[13]; p.router_bias = (const float*)d_in[14];
    p.w_gate_e = (const float*)d_in[15]; p.w_up_e = (const float*)d_in[16]; p.w_down_e = (const float*)d_in[17];
    p.w_gate_s = (const float*)d_in[18]; p.w_up_s = (const float*)d_in[19]; p.w_down_s = (const float*)d_in[20];
    p.out = (float*)d_out; p.ws = (unsigned char*)d_ws;
    (void)hipMemsetAsync((unsigned char*)d_ws + WS_BAR, 0, WS_ZERO_BYTES, stream);
#if MK_FUSED
    hipLaunchKernelGGL(k_mega, dim3(grid), dim3(512), LDS_BYTES, stream, p);
#else
    launch_phase<0>(p, grid, stream); launch_phase<1>(p, grid, stream); launch_phase<2>(p, grid, stream); launch_phase<3>(p, grid, stream);
    launch_phase<4>(p, grid, stream); launch_phase<5>(p, grid, stream); launch_phase<6>(p, grid, stream); launch_phase<7>(p, grid, stream);
    launch_phase<8>(p, grid, stream); launch_phase<9>(p, grid, stream); launch_phase<10>(p, grid, stream); launch_phase<11>(p, grid, stream);
#endif
}
```

```cpp
#include <hip/hip_runtime.h>
#include <stdint.h>
#include <stdio.h>

#ifndef MK_FUSED
#define MK_FUSED 1
#endif
#ifndef MK_STAMP
#define MK_STAMP -1
#endif
#ifndef MK_REP
#define MK_REP -1
#endif

#define LAS __attribute__((address_space(3)))
#define DI __device__ __forceinline__
typedef unsigned short bf16_t;
typedef short bf16x8 __attribute__((ext_vector_type(8)));
typedef short s16x4 __attribute__((ext_vector_type(4)));
typedef float f32x2 __attribute__((ext_vector_type(2)));
typedef float f32x4 __attribute__((ext_vector_type(4)));
typedef float f32x16 __attribute__((ext_vector_type(16)));
typedef unsigned u32x2 __attribute__((ext_vector_type(2)));
typedef unsigned u32x4 __attribute__((ext_vector_type(4)));
typedef __bf16 bf16x2_t __attribute__((ext_vector_type(2)));
typedef const __attribute__((address_space(1))) char* gcptr;
typedef const __attribute__((address_space(1))) u32x4* gu4ptr;
typedef int i32x8 __attribute__((ext_vector_type(8)));
typedef short s16x16 __attribute__((ext_vector_type(16)));

constexpr int NBATCH = 4, SEQ = 4096, NTOK = NBATCH * SEQ, DM = 2048, DIN = 11776;
constexpr int COL_QA = 0, COL_KA = 1536, COL_VA = 3072, COL_QS = 4608, COL_KS = 5632, COL_VS = 6656, COL_GD = 7680, COL_GS = 9728;
constexpr int NE = 64, DE = 512, NEX = 65;
constexpr int LIST_CAP = 16384;
constexpr int YB_SLOTS = 163840;
constexpr float RMS_EPS = 1e-6f;
constexpr float QSCALE = 0.08838834764831845f * 1.4426950408889634f;
constexpr float LN2 = 0.6931471805599453f;
constexpr float W8_SCALE = 64.0f;
constexpr int W8_MX = 0x79797979, A8_MX = 0x7f7f7f7f;

constexpr size_t MiB = 1ull << 20;
constexpr size_t WS_BAR = 0;
constexpr size_t WS_CNT = 16384;
constexpr size_t WS_ZERO_BYTES = 32768;
constexpr size_t WS_STAMP = 32768;

constexpr size_t WS_MOD = 65536;
constexpr size_t WS_LSE = 262144;
constexpr size_t WS_ROPE = 1 * MiB;
constexpr size_t WS_LIST = 3 * MiB;
constexpr size_t WS_LISTW = 7 * MiB;
constexpr size_t WS_SLOT = 262144;
constexpr size_t WS_WD = 11 * MiB;
constexpr size_t WS_WTIN8 = 76 * MiB;
constexpr size_t WS_H8 = 100 * MiB;
constexpr size_t WS_H = 141 * MiB;
constexpr size_t WS_HID = 205 * MiB;
constexpr size_t WS_WTIN = 205 * MiB;
constexpr size_t WS_TMP = 205 * MiB;
constexpr size_t WS_OG = 251 * MiB;
constexpr size_t WS_OSB = 299 * MiB;
constexpr size_t WS_ODIL = 331 * MiB;
constexpr size_t WS_WTDIL = 347 * MiB;
constexpr size_t WS_WTSB = 349 * MiB;
constexpr size_t WS_WTMIX = 353 * MiB;
constexpr size_t WS_PROJ = 365 * MiB;
constexpr size_t WS_Y = 365 * MiB;
constexpr size_t WS_YB9 = 365 * MiB;
constexpr size_t WS_WGU = 733 * MiB;
constexpr size_t WS_WRT = 1005 * MiB;
constexpr size_t WS_TOTAL = 1006 * MiB;

#ifndef MOE_BAUX
#define MOE_BAUX 0
#endif
#ifndef GEMM_SPLIT
#define GEMM_SPLIT false
#endif
constexpr int LDS_BYTES = 163840;

struct Params {
    const float *x, *c; const int* pos;
    const float *w_ada, *b_ada, *g_pre_mix, *g_post_mix, *g_pre_ffn, *g_post_ffn;
    const float *w_in, *w_dil_out, *w_sb_out, *w_mix_out, *w_router, *router_bias;
    const float *w_gate_e, *w_up_e, *w_down_e, *w_gate_s, *w_up_s, *w_down_s;
    float* out; unsigned char* ws;
};

DI unsigned pk_bf16(float lo, float hi) { f32x2 v = {lo, hi}; bf16x2_t r = __builtin_convertvector(v, bf16x2_t); return __builtin_bit_cast(unsigned, r); }
DI unsigned pk_fp8x4(float a, float b, float c, float d) { int p = __builtin_amdgcn_cvt_pk_fp8_f32(a, b, 0, false); p = __builtin_amdgcn_cvt_pk_fp8_f32(c, d, p, true); return (unsigned)p; }
DI float bf_lo(unsigned u) { return __uint_as_float(u << 16); }
DI float bf_hi(unsigned u) { return __uint_as_float(u & 0xffff0000u); }
DI float wave_sum(float v) {
#pragma unroll
    for (int o = 32; o >= 1; o >>= 1) v += __shfl_xor(v, o);
    return v;
}
DI float sigmoidf_(float x) { return __builtin_amdgcn_rcpf(1.0f + __expf(-x)); }

#define XB_TMO      128
#define XB_XCNT(j)  (256  + 64 * (j))
#define XB_XSUB(j)  (1280 + 64 * (j))
#define XB_XGEN(j)  (2304 + 64 * (j))
#define XB_TOP      3328
#define XB_TOPGEN   3392
#define XCD_BAR_WORDS 3456
#define XB_SPIN_CAP (1u << 18)

__device__ __forceinline__ unsigned xb_ld(unsigned* p)              { return __hip_atomic_load(p, __ATOMIC_RELAXED, __HIP_MEMORY_SCOPE_AGENT); }
__device__ __forceinline__ unsigned xb_add(unsigned* p, unsigned v) { return __hip_atomic_fetch_add(p, v, __ATOMIC_RELAXED, __HIP_MEMORY_SCOPE_AGENT); }
__device__ __forceinline__ unsigned xb_xcc_id() { return (unsigned)__builtin_amdgcn_s_getreg((3 << 11) | 20) & 0xFu; }
#define XB_SPIN(cond, bar) do { unsigned _sp = 0; while (cond) { __builtin_amdgcn_s_sleep(1); \
    if ((++_sp & 255u) == 0u) { if (xb_ld(&(bar)[XB_TMO])) break; if (_sp > XB_SPIN_CAP) { atomicAdd(&(bar)[XB_TMO], 1u); break; } } } } while (0)

struct XcdBarrier { unsigned* bar; unsigned x; volatile LAS unsigned* st; };

__device__ __forceinline__ XcdBarrier xcd_barrier_post(unsigned* bar, volatile LAS unsigned* st) {
    XcdBarrier b; b.bar = bar; b.x = xb_xcc_id(); b.st = st;
    if (threadIdx.x == 0) (void)xb_add(&bar[XB_XCNT(b.x)], 1u);
    return b;
}
__device__ __forceinline__ void xcd_barrier_complete(unsigned* bar, unsigned x, unsigned& nloc, unsigned& nx) {
    const unsigned G = gridDim.x * gridDim.y * gridDim.z;
    unsigned sum, cnt, mine, sp = 0u;
    for (;;) {
        sum = 0u; cnt = 0u; mine = 0u;
#pragma unroll
        for (unsigned j = 0; j < 16; ++j) { const unsigned c = xb_ld(&bar[XB_XCNT(j)]); sum += c; cnt += (c > 0u) ? 1u : 0u; mine = (j == x) ? c : mine; }
        if (sum == G) break;
        __builtin_amdgcn_s_sleep(1);
        if ((++sp & 255u) == 0u) { if (xb_ld(&bar[XB_TMO])) break; if (sp > XB_SPIN_CAP) { atomicAdd(&bar[XB_TMO], 1u); break; } }
    }
    nloc = mine > 0u ? mine : 1u; nx = cnt > 0u ? cnt : 1u;
}
__device__ __forceinline__ void xcd_barrier(const XcdBarrier& b) {
    asm volatile("s_waitcnt vmcnt(0)" ::: "memory");
    __syncthreads();
    if (threadIdx.x == 0) {
        unsigned* bar = b.bar;
        __builtin_amdgcn_s_waitcnt(0);
        unsigned nloc = b.st[0], nx = b.st[1];
        if (nloc == 0u) { xcd_barrier_complete(bar, b.x, nloc, nx); b.st[0] = nloc; b.st[1] = nx; }
        const unsigned old = xb_add(&bar[XB_XSUB(b.x)], 1u);
        const unsigned gen = old / nloc;
        if (old + 1u == (gen + 1u) * nloc) {
            __builtin_amdgcn_fence(__ATOMIC_RELEASE, "agent");
            asm volatile("s_waitcnt vmcnt(0)" ::: "memory");
            const unsigned og = xb_add(&bar[XB_TOP], 1u);
            const unsigned tg = og / nx;
            if (og + 1u == (tg + 1u) * nx) xb_add(&bar[XB_TOPGEN], 1u);
            else XB_SPIN(xb_ld(&bar[XB_TOPGEN]) == tg, bar);
            __builtin_amdgcn_fence(__ATOMIC_ACQUIRE, "agent");
            xb_add(&bar[XB_XGEN(b.x)], 1u);
            asm volatile("s_waitcnt vmcnt(0)" ::: "memory");
        } else {
            XB_SPIN(xb_ld(&bar[XB_XGEN(b.x)]) == gen, bar);
            __builtin_amdgcn_fence(__ATOMIC_ACQUIRE, "agent");
            asm volatile("s_waitcnt vmcnt(0)" ::: "memory");
        }
    }
    __syncthreads();
}

struct CvtMat { const float* src; bf16_t* dst; int K, N, nb, mode; size_t sstride, dstride; };
constexpr int CVT_NMAT = 10;
constexpr int CVT_TILES[CVT_NMAT] = {2944, 128, 256, 512, 8192, 8192, 8192, 128, 128, 128};
constexpr int CVT_TOTAL = 2944 + 128 + 256 + 512 + 8192 * 3 + 128 * 3;
constexpr int P0_MOD_UNITS = 192, P0_ROPE_UNITS = 64, P0_WR_UNITS = 8, P0_ITEMS = P0_MOD_UNITS + P0_ROPE_UNITS + P0_WR_UNITS + CVT_TOTAL;

DI CvtMat cvt_mat(const Params& p, int m) {
    bf16_t* wtin = (bf16_t*)(p.ws + WS_WTIN); bf16_t* wtdil = (bf16_t*)(p.ws + WS_WTDIL); bf16_t* wtsb = (bf16_t*)(p.ws + WS_WTSB); bf16_t* wtmix = (bf16_t*)(p.ws + WS_WTMIX);
    bf16_t* wgu = (bf16_t*)(p.ws + WS_WGU); bf16_t* wd = (bf16_t*)(p.ws + WS_WD);
    CvtMat r;
    switch (m) {
        case 0: r = {p.w_in, wtin, 2048, 11776, 1, 0, 0, 0}; break;
        case 1: r = {p.w_dil_out, wtdil, 512, 2048, 1, 0, 0, 0}; break;
        case 2: r = {p.w_sb_out, wtsb, 1024, 2048, 1, 0, 0, 0}; break;
        case 3: r = {p.w_mix_out, wtmix, 2048, 2048, 1, 0, 0, 0}; break;
        case 4: r = {p.w_gate_e, wgu, 2048, 512, 64, 1, (size_t)2048 * 512, (size_t)1024 * 2048}; break;
        case 5: r = {p.w_up_e, wgu, 2048, 512, 64, 2, (size_t)2048 * 512, (size_t)1024 * 2048}; break;
        case 6: r = {p.w_down_e, wd, 512, 2048, 64, 0, (size_t)512 * 2048, (size_t)2048 * 512}; break;
        case 7: r = {p.w_gate_s, (bf16_t*)((unsigned char*)wgu + (size_t)64 * 1024 * 2048), 2048, 512, 1, 1, 0, 0}; break;
        case 8: r = {p.w_up_s, (bf16_t*)((unsigned char*)wgu + (size_t)64 * 1024 * 2048), 2048, 512, 1, 2, 0, 0}; break;
        default: r = {p.w_down_s, (bf16_t*)((unsigned char*)wd + (size_t)64 * 2048 * 512), 512, 2048, 1, 0, 0, 0}; break;
    }
    return r;
}

DI void cvt_tile(const Params& p, int t, LAS unsigned char* lds) {
    int m = 0;
#pragma unroll
    for (int i = 0; i < CVT_NMAT - 1; ++i) { if (t >= CVT_TILES[i] && m == i) { t -= CVT_TILES[i]; m = i + 1; } }
    const CvtMat M = cvt_mat(p, m);
    const int tn = M.N / 64, tk = M.K / 128;
    const int b = t / (tn * tk); const int rem = t - b * (tn * tk); const int kt = rem / tn, nt = rem - kt * tn;
    const float* src = M.src + (size_t)b * M.sstride + (size_t)(kt * 128) * M.N + nt * 64;
    const int tid = threadIdx.x;
    const int k4 = (tid >> 4) * 4, n4 = (tid & 15) * 4;
    f32x4 v[4];
#pragma unroll
    for (int i = 0; i < 4; ++i) v[i] = __builtin_nontemporal_load((const f32x4*)(src + (size_t)(k4 + i) * M.N + n4));
    const int c = nt * 64 + (tid >> 3);
    const int drow = M.mode == 0 ? c : (((c >> 7) << 8) + (c & 127) + (M.mode == 2 ? 128 : 0));
    const bool in8 = (m == 0) && (c >= COL_GD);
    if (m < 4 && !in8) {
        bf16_t* dst = M.dst + (size_t)b * M.dstride;
        constexpr int P = 272;
#pragma unroll
        for (int j = 0; j < 4; ++j) { u32x2 w; w.x = pk_bf16(v[0][j], v[1][j]); w.y = pk_bf16(v[2][j], v[3][j]); *(LAS u32x2*)(lds + (n4 + j) * P + k4 * 2) = w; }
        __syncthreads();
#pragma unroll
        for (int i = 0; i < 2; ++i) {
            const int ch = (tid & 7) + 8 * i;
            const u32x4 w = *(const LAS u32x4*)(lds + (tid >> 3) * P + ch * 16);
            *(u32x4*)(dst + (size_t)drow * M.K + kt * 128 + ch * 8) = w;
        }
    } else {
        unsigned char* dst = in8 ? (unsigned char*)(p.ws + WS_WTIN8) : (unsigned char*)M.dst + (size_t)b * M.dstride;
        constexpr int P = 144;
#pragma unroll
        for (int j = 0; j < 4; ++j) *(LAS unsigned*)(lds + (n4 + j) * P + k4) = pk_fp8x4(v[0][j] * W8_SCALE, v[1][j] * W8_SCALE, v[2][j] * W8_SCALE, v[3][j] * W8_SCALE);
        __syncthreads();
        const u32x4 w = *(const LAS u32x4*)(lds + (tid >> 3) * P + (tid & 7) * 16);
        __builtin_nontemporal_store(w, (u32x4*)(dst + (size_t)drow * M.K + kt * 128 + (tid & 7) * 16));
    }
    __syncthreads();
}

DI void mod_unit(const Params& p, int u, LAS unsigned char* lds) {
    const int tid = threadIdx.x, c0 = u * 64;
    LAS float* sc = (LAS float*)lds;
    LAS float* red = (LAS float*)(lds + 32768);
    for (int i = tid; i < 4 * 2048; i += 512) { const float v = p.c[i]; sc[i] = v / (1.0f + __expf(-v)); }
    __syncthreads();
    const int kq = tid >> 4, cq = tid & 15;
    float acc[4][4];
#pragma unroll
    for (int b = 0; b < 4; ++b)
#pragma unroll
        for (int j = 0; j < 4; ++j) acc[b][j] = 0.f;
    for (int it = 0; it < 64; ++it) {
        const int k = kq + 32 * it;
        const f32x4 w = __builtin_nontemporal_load((const f32x4*)(p.w_ada + (size_t)k * 12288 + c0 + 4 * cq));
#pragma unroll
        for (int b = 0; b < 4; ++b) { const float s = sc[b * 2048 + k];
#pragma unroll
            for (int j = 0; j < 4; ++j) acc[b][j] += s * w[j]; }
    }
#pragma unroll
    for (int b = 0; b < 4; ++b)
#pragma unroll
        for (int j = 0; j < 4; ++j) red[(kq * 4 + b) * 64 + 4 * cq + j] = acc[b][j];
    __syncthreads();
    if (tid < 256) {
        const int b = tid >> 6, col = tid & 63;
        float s = 0.f;
        for (int q = 0; q < 32; ++q) s += red[(q * 4 + b) * 64 + col];
        float* mod = (float*)(p.ws + WS_MOD);
        mod[b * 12288 + c0 + col] = s + p.b_ada[c0 + col];
    }
    __syncthreads();
}

DI void rope_unit(const Params& p, int u) {
    float2* rope = (float2*)(p.ws + WS_ROPE);
    for (int e = threadIdx.x; e < 4096; e += 512) {
        const int tok = u * 256 + (e >> 4), i = e & 15;
        const float invf = (float)pow(500000.0, -(double)i / 16.0);
        const float ang = (float)p.pos[tok] * invf;
        rope[tok * 16 + i] = make_float2((float)cos((double)ang), (float)sin((double)ang));
    }
}

DI void wr_unit(const Params& p, int u) {
    bf16_t* hi = (bf16_t*)(p.ws + WS_WRT); bf16_t* lo = hi + 64 * 2048;
    for (int i = threadIdx.x; i < 16384; i += 512) {
        const int idx = u * 16384 + i, k = idx >> 6, e = idx & 63;
        const float x = p.w_router[idx];
        const unsigned h = pk_bf16(x, 0.f) & 0xffffu;
        const float r = x - __uint_as_float(h << 16);
        hi[e * 2048 + k] = (bf16_t)h; lo[e * 2048 + k] = (bf16_t)(pk_bf16(r, 0.f) & 0xffffu);
    }
}
DI void phase_prologue(const Params& p, LAS unsigned char* lds) {
    for (int it = blockIdx.x; it < P0_ITEMS; it += gridDim.x) {
        if (it < P0_MOD_UNITS) mod_unit(p, it, lds);
        else if (it < P0_MOD_UNITS + P0_ROPE_UNITS) rope_unit(p, it - P0_MOD_UNITS);
        else if (it < P0_MOD_UNITS + P0_ROPE_UNITS + P0_WR_UNITS) wr_unit(p, it - P0_MOD_UNITS - P0_ROPE_UNITS);
        else cvt_tile(p, it - P0_MOD_UNITS - P0_ROPE_UNITS - P0_WR_UNITS, lds);
    }
}

DI void phase_prenorm(const Params& p) {
    const int lane = threadIdx.x & 63, wid = threadIdx.x >> 6;
    const float* mod = (const float*)(p.ws + WS_MOD);
    bf16_t* h = (bf16_t*)(p.ws + WS_H);
    for (int tok = blockIdx.x * 8 + wid; tok < NTOK; tok += gridDim.x * 8) {
        const int b = tok >> 12;
        const float* xr = p.x + (size_t)tok * DM;
        f32x4 v[8]; float ss = 0.f;
#pragma unroll
        for (int i = 0; i < 8; ++i) { v[i] = *(const f32x4*)(xr + 4 * (lane + 64 * i)); ss += v[i][0] * v[i][0] + v[i][1] * v[i][1] + v[i][2] * v[i][2] + v[i][3] * v[i][3]; }
        ss = wave_sum(ss);
        const float rstd = rsqrtf(ss * (1.0f / DM) + RMS_EPS);
#pragma unroll
        for (int i = 0; i < 8; ++i) {
            const int ch = 4 * (lane + 64 * i);
            const f32x4 g = *(const f32x4*)(p.g_pre_mix + ch);
            const f32x4 sh = *(const f32x4*)(mod + b * 12288 + ch);
            const f32x4 sc = *(const f32x4*)(mod + b * 12288 + 2048 + ch);
            f32x4 o;
#pragma unroll
            for (int j = 0; j < 4; ++j) o[j] = v[i][j] * rstd * g[j] * (1.0f + sc[j]) + sh[j];
            u32x2 w; w.x = pk_bf16(o[0], o[1]); w.y = pk_bf16(o[2], o[3]);
            *(u32x2*)(h + (size_t)tok * DM + ch) = w;
            *(unsigned*)(p.ws + WS_H8 + (size_t)tok * DM + ch) = pk_fp8x4(o[0], o[1], o[2], o[3]);
        }
    }
}

namespace g8 {
constexpr int BM = 256, BK = 64, HALF = 128, HTB = HALF * BK * 2, STAGE_BYTES = 8 * HTB, NXCD = 8, WGM = 8;
DI int lds_byte(int r, int c) { const int st = (r >> 4) * 2 + (c >> 5), rr = r & 15, cc = c & 31, ob = rr * 64 + cc * 2; return st * 1024 + (ob ^ (((ob >> 9) & 1) << 5)); }
DI void stage_rc(int b, int& R, int& C) { const int st = b / 1024, sb = b % 1024, swz = sb ^ (((sb >> 9) & 1) << 5); R = (st >> 1) * 16 + swz / 64; C = (st & 1) * 32 + (swz % 64) / 2; }
DI int perm32(int rho) { const int n = rho >> 4, i = rho & 15; return 8 * (i >> 2) + 4 * n + (i & 3); }

struct Unit {
    const char* A; const char* B;
    int row0;
    int lda, ldb, nt;
    int pm, pn, aux, keep;
    int e, nvalid, par;
};

DI bool static_tile(int L, int nM, int nN, int& pm, int& pn) {
    const int nwg = nM * nN; if (L >= nwg) return false;
    int wgid = L; { const int q = nwg / NXCD, r = nwg % NXCD, xcd = wgid % NXCD, off = wgid / NXCD; wgid = (xcd < r ? xcd * (q + 1) : r * (q + 1) + (xcd - r) * q) + off; }
    const int nig = WGM * nN, gid = wgid / nig, fm = gid * WGM, gsz = (nM - fm) < WGM ? (nM - fm) : WGM;
    pm = fm + ((wgid % nig) % gsz); pn = (wgid % nig) / gsz; return true;
}

constexpr int EXCH_OFF = STAGE_BYTES + 8192;
DI void epi_bar() { asm volatile("s_waitcnt lgkmcnt(0)" ::: "memory"); __builtin_amdgcn_s_barrier(); asm volatile("" ::: "memory"); }

template <int NCH, int BAUX, bool SPLIT, bool FP8, class Sched, class Epi>
DI void gemm_phase(LAS unsigned char* lds, const Sched& S, const Epi& E) {
    const int tid = threadIdx.x, wid = __builtin_amdgcn_readfirstlane(tid >> 6), lane = tid & 63, wr = wid >> 2, wc = wid & 3, fr = lane & 15, fq = lane >> 4;
    const bool loader = SPLIT ? (wr == 0) : true, storer = SPLIT ? (wr == 1) : true;
    constexpr int NP = SPLIT ? 4 : 2, PSTEP = SPLIT ? 4 : 8, RSTEP = SPLIT ? 32 : 64;
    const int p0 = SPLIT ? wc : wid;
    int R0, C0; stage_rc(p0 * 1024 + lane * 16, R0, C0);
    const int sC = C0 * 2, sRb = (R0 & ~31) + perm32(R0 & 31);
    const int aoff = lds_byte(wr * 64 + fr, fq * 8), boff = lds_byte(wc * 32 + fr, fq * 8);
#define G8_SA(b, h) (((b) * 2 + (h)) * HTB)
#define G8_SB(b, h) ((4 + (b) * 2 + (h)) * HTB)
#define G8_STAGE_A(bufoff, gbase, voff) do { if (loader) { _Pragma("unroll") for (int _i = 0; _i < NP; ++_i) \
        __builtin_amdgcn_global_load_lds((const unsigned*)((const char*)(gbase) + (voff)[_i]), (LAS unsigned*)(lds + (bufoff) + (p0 + PSTEP * _i) * 1024), 16, 0, 0); } } while (0)
#define G8_STAGE_B(bufoff, gbase, voff, ldb32) do { if (loader) { _Pragma("unroll") for (int _i = 0; _i < NP; ++_i) { \
        const char* _gb = (const char*)(gbase) + (size_t)_i * (ldb32); asm volatile("" : "+s"(_gb));     \
        __builtin_amdgcn_global_load_lds((const unsigned*)(_gb + (voff)), (LAS unsigned*)(lds + (bufoff) + (p0 + PSTEP * _i) * 1024), 16, 0, BAUX); } } } while (0)
#define G8_LDA(dst, b, h) do { _Pragma("unroll") for (int m = 0; m < 4; ++m) _Pragma("unroll") for (int k = 0; k < 2; ++k) dst[m][k] = *(const LAS bf16x8*)(lds + G8_SA(b, h) + aoff + m * 2048 + k * 1024); } while (0)
#define G8_LDB(dst, b, h) do { _Pragma("unroll") for (int n = 0; n < 2; ++n) _Pragma("unroll") for (int k = 0; k < 2; ++k) dst[n][k] = *(const LAS bf16x8*)(lds + G8_SB(b, h) + boff + n * 2048 + k * 1024); } while (0)
#define G8_MMA(ai, bj, At, Bt) do { __builtin_amdgcn_s_setprio(1); _Pragma("unroll") for (int m = 0; m < 4; ++m) _Pragma("unroll") for (int n = 0; n < 2; ++n) { \
        if (!FP8) { _Pragma("unroll") for (int k = 0; k < 2; ++k) acc[ai][bj][m][n] = __builtin_amdgcn_mfma_f32_16x16x32_bf16(Bt[n][k], At[m][k], acc[ai][bj][m][n], 0, 0, 0); } \
        else { const i32x8 _w = __builtin_bit_cast(i32x8, __builtin_shufflevector(Bt[n][0], Bt[n][1], 0, 1, 2, 3, 4, 5, 6, 7, 8, 9, 10, 11, 12, 13, 14, 15)); \
               const i32x8 _x = __builtin_bit_cast(i32x8, __builtin_shufflevector(At[m][0], At[m][1], 0, 1, 2, 3, 4, 5, 6, 7, 8, 9, 10, 11, 12, 13, 14, 15)); \
               acc[ai][bj][m][n] = __builtin_amdgcn_mfma_scale_f32_16x16x128_f8f6f4(_w, _x, acc[ai][bj][m][n], 0, 0, 0, W8_MX, 0, A8_MX); } } \
        __builtin_amdgcn_s_setprio(0); } while (0)
#define G8_WAIT_V8 do { if (SPLIT) { if (loader) asm volatile("s_waitcnt vmcnt(8)" ::: "memory"); } else asm volatile("s_waitcnt vmcnt(4)" ::: "memory"); } while (0)
#define G8_WAIT_V12 do { if (SPLIT) { if (loader) asm volatile("s_waitcnt vmcnt(12)" ::: "memory"); } else asm volatile("s_waitcnt vmcnt(6)" ::: "memory"); } while (0)
#define G8_WAIT_V0 do { if (loader) asm volatile("s_waitcnt vmcnt(0)" ::: "memory"); } while (0)
#define G8_WAIT_L(n) asm volatile("s_waitcnt lgkmcnt(" #n ")" ::: "memory")
#define G8_BAR __builtin_amdgcn_s_barrier()
#define G8_SCHED __builtin_amdgcn_sched_barrier(0)
#define G8_OFFS(u, vA, vB) do { if (loader) { _Pragma("unroll") for (int _h = 0; _h < 2; ++_h) _Pragma("unroll") for (int _i = 0; _i < NP; ++_i) \
        vA[_h][_i] = (unsigned)S.arow(u, _h * 128 + R0 + RSTEP * _i) * (unsigned)(u).lda + (unsigned)sC; \
        vB = (unsigned)sRb * (unsigned)(u).ldb + (unsigned)sC; } } while (0)
    Unit cur, nxt; int ui = 0;
    if (!S.next(0, cur)) return;
    f32x4 acc[2][2][4][2];
#pragma unroll
    for (int a = 0; a < 2; ++a)
#pragma unroll
        for (int b = 0; b < 2; ++b)
#pragma unroll
            for (int m = 0; m < 4; ++m)
#pragma unroll
                for (int n = 0; n < 2; ++n) acc[a][b][m][n] = (f32x4){0.f, 0.f, 0.f, 0.f};
    bf16x8 At[4][2], B0[2][2], B1[2][2];
    unsigned vA[2][NP], vB = 0u;
#pragma unroll
    for (int i = 0; i < NP; ++i) { vA[0][i] = 0u; vA[1][i] = 0u; }
    if (S.prefetch(cur, wid, lane)) { G8_WAIT_V0; G8_BAR; }
    G8_OFFS(cur, vA, vB);
    const char* cA = cur.A; const char* cB = cur.B; size_t hB = (size_t)128 * cur.ldb; size_t q32 = (size_t)RSTEP * cur.ldb;
    constexpr size_t kstep = 128;
    G8_STAGE_B(G8_SB(0, 0), cB, vB, q32); G8_STAGE_A(G8_SA(0, 0), cA, vA[0]); G8_STAGE_B(G8_SB(0, 1), cB + hB, vB, q32); G8_STAGE_A(G8_SA(0, 1), cA, vA[1]);
    if (wr == 1) G8_BAR;
    G8_WAIT_V8; G8_BAR;
    G8_STAGE_B(G8_SB(1, 0), cB + kstep, vB, q32); G8_STAGE_A(G8_SA(1, 0), cA + kstep, vA[0]); G8_STAGE_B(G8_SB(1, 1), cB + hB + kstep, vB, q32);
    G8_WAIT_V12; G8_BAR;
    for (;;) {
        bool has_next = false;
        const char* nA = cA; const char* nB = cB; size_t nhB = hB, nq32 = q32;
        const int nt = cur.nt;
#pragma unroll 1
        for (int t = 0; t < nt; t += 2) {
            const bool last = (t == nt - 2);
            const char* a1 = cA + (size_t)(t + 1) * kstep;
            G8_LDB(B0, 0, 0); G8_SCHED; G8_LDA(At, 0, 0); G8_STAGE_A(G8_SA(1, 1), a1, vA[1]);
            G8_WAIT_L(8); G8_BAR; G8_WAIT_L(0); G8_MMA(0, 0, At, B0); G8_BAR; G8_SCHED;
            if (t == 0) { Unit pf; if (S.next(ui + 1, pf)) (void)S.prefetch(pf, wid, lane); }
            const char* a2; const char* b2; size_t h2, q2;
            if (last) {
                has_next = S.next(ui + 1, nxt);
                if (has_next) { G8_OFFS(nxt, vA, vB); nA = nxt.A; nB = nxt.B; nhB = (size_t)128 * nxt.ldb; nq32 = (size_t)RSTEP * nxt.ldb; }
                a2 = nA; b2 = nB; h2 = nhB; q2 = nq32;
            } else { a2 = cA + (size_t)(t + 2) * kstep; b2 = cB + (size_t)(t + 2) * kstep; h2 = hB; q2 = q32; }
            const char* a3 = a2 + kstep; const char* b3 = b2 + kstep;
            G8_LDB(B1, 0, 1); G8_STAGE_B(G8_SB(0, 0), b2, vB, q2);
            G8_BAR; G8_WAIT_L(0); G8_MMA(0, 1, At, B1); G8_BAR;
            G8_LDA(At, 0, 1); G8_STAGE_A(G8_SA(0, 0), a2, vA[0]);
            G8_BAR; G8_WAIT_L(0); G8_MMA(1, 0, At, B0); G8_BAR; G8_SCHED;
            G8_STAGE_B(G8_SB(0, 1), b2 + h2, vB, q2);
            G8_WAIT_V12; G8_BAR; G8_MMA(1, 1, At, B1); G8_BAR;
            G8_LDB(B0, 1, 0); G8_SCHED; G8_LDA(At, 1, 0); G8_STAGE_A(G8_SA(0, 1), a2, vA[1]);
            G8_WAIT_L(8); G8_BAR; G8_WAIT_L(0); G8_MMA(0, 0, At, B0); G8_BAR; G8_SCHED;
            G8_LDB(B1, 1, 1); G8_STAGE_B(G8_SB(1, 0), b3, vB, q2);
            G8_BAR; G8_WAIT_L(0); G8_MMA(0, 1, At, B1); G8_BAR;
            G8_LDA(At, 1, 1); G8_STAGE_A(G8_SA(1, 0), a3, vA[0]);
            G8_BAR; G8_WAIT_L(0); G8_MMA(1, 0, At, B0); G8_BAR; G8_SCHED;
            G8_STAGE_B(G8_SB(1, 1), b3 + h2, vB, q2);
            G8_WAIT_V12; G8_BAR; G8_MMA(1, 1, At, B1); G8_BAR;
        }
        int tz = threadIdx.x; asm volatile("" : "+v"(tz));
        const int lane_e = tz & 63, fr_e = tz & 15, fq_e = (tz >> 4) & 3;
        {
            E.pre(acc, cur, wr, wc, fr_e, fq_e);
            constexpr int PITCH = NCH * 16 + 16;
            LAS unsigned char* ex = lds + EXCH_OFF;
            if (wr == 0) G8_BAR;
            if constexpr (Epi::OUT8) {
                constexpr int RB = NCH * 8, P8 = RB + 16;
#pragma unroll
                for (int ai = 0; ai < 2; ++ai)
#pragma unroll
                    for (int mh = 0; mh < 2; ++mh) {
#pragma unroll
                        for (int mm = 0; mm < 2; ++mm) {
                            u32x2 o8[2];
                            E.row8(acc, cur, ai, 2 * mh + mm, wr, wc, fr_e, fq_e, o8);
                            LAS unsigned char* rp = ex + (mm * 32 + wr * 16 + fr_e) * P8 + wc * 32 + 8 * fq_e;
                            *(LAS u32x2*)rp = o8[0];
                            if (NCH == 32) *(LAS u32x2*)(rp + 128) = o8[1];
                        }
                        epi_bar();
                        {
                            constexpr int CPR = RB / 16, RPI = 64 / CPR;
#pragma unroll
                            for (int i = 0; i < 8 / RPI; ++i) {
                                const int rl = 8 * wid + RPI * i + lane_e / CPR, ch = lane_e % CPR;
                                const int rt = ai * 128 + ((rl >> 4) & 1) * 64 + (2 * mh + (rl >> 5)) * 16 + (rl & 15);
                                const u32x4 d = *(const LAS u32x4*)(ex + rl * P8 + ch * 16);
                                E.store8(cur, rt, ch, d);
                            }
                        }
                        epi_bar();
                    }
            } else
#pragma unroll
            for (int ai = 0; ai < 2; ++ai)
#pragma unroll
                for (int m = 0; m < 4; ++m) {
                    u32x4 o[2];
                    E.row(acc, cur, ai, m, wr, wc, fr_e, fq_e, o);
                    if (NCH == 32) {
                        *(LAS u32x4*)(ex + (wr * 16 + fr_e) * PITCH + (wc * 32 + 8 * fq_e) * 2) = o[0];
                        *(LAS u32x4*)(ex + (wr * 16 + fr_e) * PITCH + (128 + wc * 32 + 8 * fq_e) * 2) = o[1];
                    } else {
                        *(LAS u32x4*)(ex + (wr * 16 + fr_e) * PITCH + (wc * 32 + 8 * fq_e) * 2) = o[0];
                    }
                    epi_bar();
                    if (storer) {
                        constexpr int RPI = 64 / NCH;
                        constexpr int RPW = SPLIT ? 8 : 4;
                        const int rbase = SPLIT ? 8 * wc : 4 * wid;
#pragma unroll
                        for (int i = 0; i < RPW / RPI; ++i) {
                            const int rl = rbase + RPI * i + lane_e / NCH, ch = lane_e % NCH;
                            const int rt = ai * 128 + (rl >> 4) * 64 + m * 16 + (rl & 15);
                            const u32x4 d = *(const LAS u32x4*)(ex + rl * PITCH + ch * 16);
                            E.store(cur, rt, ch, d);
                        }
                    }
                    epi_bar();
                }
            if (wr == 1) G8_BAR;
        }
        if (!has_next) break;
#pragma unroll
        for (int a = 0; a < 2; ++a)
#pragma unroll
            for (int b = 0; b < 2; ++b)
#pragma unroll
                for (int m = 0; m < 4; ++m)
#pragma unroll
                    for (int n = 0; n < 2; ++n) acc[a][b][m][n] = (f32x4){0.f, 0.f, 0.f, 0.f};
        cur = nxt; cA = nA; cB = nB; hB = nhB; q32 = nq32; ++ui;
    }
    G8_WAIT_V0;
    if (wr == 0) G8_BAR;
    G8_BAR;
#undef G8_SA
#undef G8_SB
#undef G8_STAGE_A
#undef G8_STAGE_B
#undef G8_LDA
#undef G8_LDB
#undef G8_MMA
#undef G8_WAIT_V8
#undef G8_WAIT_V12
#undef G8_WAIT_V0
#undef G8_WAIT_L
#undef G8_BAR
#undef G8_SCHED
#undef G8_OFFS
}
}

struct DenseSched {
    const char* A; const char* Bt; int nM, nN, lda, ldb, nt, G, c; int sel = 0;
    DI bool next(int i, g8::Unit& u) const {
        int pm, pn; if (!g8::static_tile(i * G + c, nM, nN, pm, pn)) return false;
        pm = __builtin_amdgcn_readfirstlane(pm); pn = __builtin_amdgcn_readfirstlane(pn);
        if (sel == 2) pn = pn + 30;
        u.A = A; u.B = Bt + (size_t)pn * 256 * ldb; u.row0 = pm * 256; u.lda = lda; u.ldb = ldb; u.nt = nt; u.pm = pm; u.pn = pn; u.aux = 0; u.keep = 0; u.e = 0; u.nvalid = 256; u.par = 0; return true;
    }
    DI int arow(const g8::Unit& u, int rr) const { return u.row0 + rr; }
    DI bool prefetch(const g8::Unit&, int, int) const { return false; }
};
constexpr int MOE_TAB_OFF = g8::STAGE_BYTES;
constexpr int MOE_TILE_OFF = g8::STAGE_BYTES + 1024;
constexpr int MOE_IDX_OFF = g8::STAGE_BYTES + 2048;
struct MoeSched {
    LAS unsigned char* lds; const int* list; const float* listw; const char* A; const char* W; int ncol, mode  , G, c;
    DI bool next(int i, g8::Unit& u) const {
        const LAS int* tpre = (const LAS int*)(lds + MOE_TAB_OFF);
        const int L = i * G + c; const int T = __builtin_amdgcn_readfirstlane(tpre[NEX]);
        if (L >= T * ncol) return false;
        const int gt = __builtin_amdgcn_readfirstlane(L / ncol), pn = L - gt * ncol;
        const int e = __builtin_amdgcn_readfirstlane((int)*(const LAS unsigned char*)(lds + MOE_TILE_OFF + gt));
        const int tile = gt - __builtin_amdgcn_readfirstlane(tpre[e]);
        const int n_e = __builtin_amdgcn_readfirstlane(tpre[NEX + 1 + e]);
        u.e = e; u.pm = tile; u.pn = pn; u.nvalid = min(256, n_e - tile * 256); u.keep = 0; u.aux = gt * 256; u.par = i & 1;
        if (mode == 0) { u.A = A; u.lda = 2048; u.ldb = 2048; u.nt = 16; u.B = W + ((size_t)e * 1024 + (size_t)pn * 256) * 2048; u.row0 = tile * 256; }
        else { u.A = A; u.lda = 512; u.ldb = 512; u.nt = 4; u.B = W + ((size_t)e * 2048 + (size_t)pn * 256) * 512; u.row0 = gt * 256; }
        return true;
    }
    DI bool prefetch(const g8::Unit& u, int wid, int lane) const {
        if (u.e < NE && wid < 4) {
            const int r = min(wid * 64 + lane, u.nvalid - 1);
            const size_t src = (size_t)u.e * LIST_CAP + u.pm * 256 + r;
            __builtin_amdgcn_global_load_lds((const unsigned*)(list + src), (LAS unsigned*)(lds + MOE_IDX_OFF + u.par * 2048 + wid * 256), 4, 0, 0);
            if (mode == 1) __builtin_amdgcn_global_load_lds((const unsigned*)(listw + src), (LAS unsigned*)(lds + MOE_IDX_OFF + u.par * 2048 + 1024 + wid * 256), 4, 0, 0);
        }
        return true;
    }
    DI int arow(const g8::Unit& u, int rr) const {
        if (mode == 1) return u.row0 + rr;
        if (u.e >= NE) return u.row0 + rr;
        return *(const LAS int*)(lds + MOE_IDX_OFF + u.par * 2048 + rr * 4) / 9;
    }
};

typedef f32x4 (&AccRef)[2][2][4][2];
DI u32x4 pack8(const f32x4& v0, const f32x4& v1) { u32x4 w; w.x = pk_bf16(v0[0], v0[1]); w.y = pk_bf16(v0[2], v0[3]); w.z = pk_bf16(v1[0], v1[1]); w.w = pk_bf16(v1[2], v1[3]); return w; }

struct EpiInProj { static constexpr bool OUT8 = false;
    bf16_t* proj; const float* rope;
    DI static int kind_of(int pn) { return pn < 6 ? 0 : pn < 12 ? 1 : pn < 18 ? 2 : pn < 22 ? 3 : pn < 30 ? 2 : 4; }
    DI void pre(AccRef acc, const g8::Unit& u, int wr, int wc, int fr, int fq) const {
        if (kind_of(u.pn) <= 1 && wc == 0) {
            const float sg = (fq < 2) ? -1.0f : 1.0f;
#pragma unroll
            for (int g = 0; g < 4; ++g) {
                const int ai = g >> 1;
                f32x4 cs[2][4];
#pragma unroll
                for (int mm = 0; mm < 2; ++mm) { const int m = (g & 1) * 2 + mm; const int row = u.pm * 256 + ai * 128 + wr * 64 + m * 16 + fr;
#pragma unroll
                    for (int q = 0; q < 4; ++q) cs[mm][q] = *(const f32x4*)(rope + (size_t)row * 32 + 16 * (fq & 1) + 4 * q); }
#pragma unroll
                for (int mm = 0; mm < 2; ++mm) { const int m = (g & 1) * 2 + mm;
#pragma unroll
                    for (int bj = 0; bj < 2; ++bj) {
                        f32x4 v0 = acc[ai][bj][m][0], v1 = acc[ai][bj][m][1], p0, p1;
#pragma unroll
                        for (int j = 0; j < 4; ++j) { p0[j] = __shfl_xor(v0[j], 32); p1[j] = __shfl_xor(v1[j], 32); }
#pragma unroll
                        for (int j = 0; j < 4; ++j) {
                            const float c0 = cs[mm][j >> 1][(j & 1) * 2], s0 = cs[mm][j >> 1][(j & 1) * 2 + 1];
                            const float c1 = cs[mm][2 + (j >> 1)][(j & 1) * 2], s1 = cs[mm][2 + (j >> 1)][(j & 1) * 2 + 1];
                            v0[j] = v0[j] * c0 + sg * p0[j] * s0;
                            v1[j] = v1[j] * c1 + sg * p1[j] * s1;
                        }
                        acc[ai][bj][m][0] = v0; acc[ai][bj][m][1] = v1;
                    }
                    asm volatile("" : "+v"(acc[ai][0][m][0]), "+v"(acc[ai][0][m][1]), "+v"(acc[ai][1][m][0]), "+v"(acc[ai][1][m][1]));
                }
                asm volatile("" ::: "memory");
            }
        }
    }
    DI void row(AccRef acc, const g8::Unit& u, int ai, int m, int wr, int wc, int fr, int fq, u32x4 (&o)[2]) const {
        const int kind = kind_of(u.pn);
#pragma unroll
        for (int bj = 0; bj < 2; ++bj) {
            f32x4 v0 = acc[ai][bj][m][0], v1 = acc[ai][bj][m][1];
            if (kind == 0 || kind == 3) { v0 *= QSCALE; v1 *= QSCALE; }
            if (kind == 4) {
#pragma unroll
                for (int j = 0; j < 4; ++j) { v0[j] = sigmoidf_(v0[j]); v1[j] = sigmoidf_(v1[j]); }
            }
            o[bj] = pack8(v0, v1);
        }
    }
    DI void store(const g8::Unit& u, int rt, int ch, const u32x4& d) const { __builtin_nontemporal_store(d, (u32x4*)(proj + (size_t)(u.pm * 256 + rt) * DIN + u.pn * 256 + ch * 8)); }
};
template <int PART> struct EpiGate { static constexpr bool OUT8 = false;
    const bf16_t* proj; const bf16_t* tmp; bf16_t* out;
    DI void pre(AccRef acc, const g8::Unit& u, int wr, int wc, int fr, int fq) const {
        const unsigned vo_g = (unsigned)(((wr * 64 + fr) * DIN + wc * 32 + 8 * fq) * 2), vo_t = (unsigned)(((wr * 64 + fr) * DM + wc * 32 + 8 * fq) * 2);
#pragma unroll
        for (int ai = 0; ai < 2; ++ai)
#pragma unroll
            for (int m = 0; m < 4; ++m) {
#pragma unroll
                for (int bj = 0; bj < 2; ++bj) {
                    gcptr sg = (gcptr)(proj + (size_t)(u.pm * 256 + ai * 128 + m * 16) * DIN + u.pn * 256 + bj * 128 + (PART == 0 ? COL_GD : COL_GS));
                    asm volatile("" : "+s"(sg));
                    const u32x4 gg = *(gu4ptr)(sg + vo_g);
                    const float sv[8] = {bf_lo(gg.x), bf_hi(gg.x), bf_lo(gg.y), bf_hi(gg.y), bf_lo(gg.z), bf_hi(gg.z), bf_lo(gg.w), bf_hi(gg.w)};
                    if (PART == 0) {
#pragma unroll
                        for (int j = 0; j < 4; ++j) { acc[ai][bj][m][0][j] *= sv[j]; acc[ai][bj][m][1][j] *= sv[4 + j]; }
                    } else {
                        gcptr st = (gcptr)(tmp + (size_t)(u.pm * 256 + ai * 128 + m * 16) * DM + u.pn * 256 + bj * 128);
                        asm volatile("" : "+s"(st));
                        const u32x4 tt = *(gu4ptr)(st + vo_t);
                        const float tv[8] = {bf_lo(tt.x), bf_hi(tt.x), bf_lo(tt.y), bf_hi(tt.y), bf_lo(tt.z), bf_hi(tt.z), bf_lo(tt.w), bf_hi(tt.w)};
#pragma unroll
                        for (int j = 0; j < 4; ++j) { acc[ai][bj][m][0][j] = acc[ai][bj][m][0][j] * sv[j] + tv[j]; acc[ai][bj][m][1][j] = acc[ai][bj][m][1][j] * sv[4 + j] + tv[4 + j]; }
                    }
                }
                asm volatile("" : "+v"(acc[ai][0][m][0]), "+v"(acc[ai][0][m][1]), "+v"(acc[ai][1][m][0]), "+v"(acc[ai][1][m][1]));
                if (m & 1) asm volatile("" ::: "memory");
            }
    }
    DI void row(AccRef acc, const g8::Unit&, int ai, int m, int, int, int, int, u32x4 (&o)[2]) const {
        o[0] = pack8(acc[ai][0][m][0], acc[ai][0][m][1]); o[1] = pack8(acc[ai][1][m][0], acc[ai][1][m][1]);
    }
    DI void store(const g8::Unit& u, int rt, int ch, const u32x4& d) const { *(u32x4*)(out + (size_t)(u.pm * 256 + rt) * DM + u.pn * 256 + ch * 8) = d; }
};
struct EpiPlain { static constexpr bool OUT8 = false;
    bf16_t* out; int ld;
    DI void pre(AccRef, const g8::Unit&, int, int, int, int) const {}
    DI void row(AccRef acc, const g8::Unit&, int ai, int m, int, int, int, int, u32x4 (&o)[2]) const {
        o[0] = pack8(acc[ai][0][m][0], acc[ai][0][m][1]); o[1] = pack8(acc[ai][1][m][0], acc[ai][1][m][1]);
    }
    DI void store(const g8::Unit& u, int rt, int ch, const u32x4& d) const { *(u32x4*)(out + (size_t)(u.pm * 256 + rt) * ld + u.pn * 256 + ch * 8) = d; }
};
struct EpiGateUp { static constexpr bool OUT8 = true;
    unsigned char* hid;
    DI void pre(AccRef, const g8::Unit&, int, int, int, int) const {}
    DI void row(AccRef, const g8::Unit&, int, int, int, int, int, int, u32x4 (&)[2]) const {}
    DI void store(const g8::Unit&, int, int, const u32x4&) const {}
    DI void row8(AccRef acc, const g8::Unit&, int ai, int m, int, int, int, int, u32x2 (&o)[2]) const {
        const f32x4 g0 = acc[ai][0][m][0], g1 = acc[ai][0][m][1], u0 = acc[ai][1][m][0], u1 = acc[ai][1][m][1];
        f32x4 v0, v1;
#pragma unroll
        for (int j = 0; j < 4; ++j) { v0[j] = g0[j] * __builtin_amdgcn_rcpf(1.0f + __expf(-g0[j])) * u0[j]; v1[j] = g1[j] * __builtin_amdgcn_rcpf(1.0f + __expf(-g1[j])) * u1[j]; }
        o[0].x = pk_fp8x4(v0[0], v0[1], v0[2], v0[3]); o[0].y = pk_fp8x4(v1[0], v1[1], v1[2], v1[3]); o[1] = o[0];
    }
    DI void store8(const g8::Unit& u, int rt, int ch, const u32x4& d) const { *(u32x4*)(hid + (size_t)(u.aux + rt) * DE + u.pn * 128 + ch * 16) = d; }
};
struct EpiDown { static constexpr bool OUT8 = true;
    LAS unsigned char* lds; unsigned char* yb9; int* slot;
    DI void pre(AccRef, const g8::Unit&, int, int, int, int) const {}
    DI void row(AccRef, const g8::Unit&, int, int, int, int, int, int, u32x4 (&)[2]) const {}
    DI void store(const g8::Unit&, int, int, const u32x4&) const {}
    DI void row8(AccRef acc, const g8::Unit& u, int ai, int m, int wr, int, int fr, int, u32x2 (&o)[2]) const {
        const int rt = ai * 128 + wr * 64 + m * 16 + fr;
        const float wgt = (u.e < NE) ? *(const LAS float*)(lds + MOE_IDX_OFF + u.par * 2048 + 1024 + rt * 4) : 1.0f;
#pragma unroll
        for (int bj = 0; bj < 2; ++bj) {
            const f32x4 v0 = acc[ai][bj][m][0] * wgt, v1 = acc[ai][bj][m][1] * wgt;
            o[bj].x = pk_fp8x4(v0[0], v0[1], v0[2], v0[3]); o[bj].y = pk_fp8x4(v1[0], v1[1], v1[2], v1[3]);
        }
    }
    DI void store8(const g8::Unit& u, int rt, int ch, const u32x4& d) const {
        if (rt < u.nvalid) {
            const int srow = u.aux + rt;
            __builtin_nontemporal_store(d, (u32x4*)(yb9 + ((size_t)u.pn * YB_SLOTS + srow) * 256 + ch * 16));
            if (u.pn == 0 && ch == 0) {
                const int v = (u.e < NE) ? *(const LAS int*)(lds + MOE_IDX_OFF + u.par * 2048 + rt * 4) : (u.pm * 256 + rt) * 9 + 8;
                slot[v] = srow;
            }
        }
    }
};

DI void phase_inproj(const Params& p, LAS unsigned char* lds) {
    EpiInProj E{(bf16_t*)(p.ws + WS_PROJ), (const float*)(p.ws + WS_ROPE)};
    { DenseSched S{(const char*)(p.ws + WS_H), (const char*)(p.ws + WS_WTIN), 64, 30, 4096, 4096, 32, (int)gridDim.x, (int)blockIdx.x, 1};
      g8::gemm_phase<32, 0, GEMM_SPLIT, false>(lds, S, E); }
    { DenseSched S{(const char*)(p.ws + WS_H8), (const char*)(p.ws + WS_WTIN8), 64, 16, 2048, 2048, 16, (int)gridDim.x, (int)blockIdx.x, 2};
      g8::gemm_phase<32, 0, GEMM_SPLIT, true>(lds, S, E); }
}
DI void phase_outproj_a(const Params& p, LAS unsigned char* lds) {
    DenseSched S{(const char*)(p.ws + WS_ODIL), (const char*)(p.ws + WS_WTDIL), 64, 8, 1024, 1024, 8, (int)gridDim.x, (int)blockIdx.x};
    EpiGate<0> E{(const bf16_t*)(p.ws + WS_PROJ), nullptr, (bf16_t*)(p.ws + WS_TMP)};
    g8::gemm_phase<32, 0, GEMM_SPLIT, false>(lds, S, E);
}
DI void phase_outproj_b(const Params& p, LAS unsigned char* lds) {
    DenseSched S{(const char*)(p.ws + WS_OSB), (const char*)(p.ws + WS_WTSB), 64, 8, 2048, 2048, 16, (int)gridDim.x, (int)blockIdx.x};
    EpiGate<1> E{(const bf16_t*)(p.ws + WS_PROJ), (const bf16_t*)(p.ws + WS_TMP), (bf16_t*)(p.ws + WS_H)};
    g8::gemm_phase<32, 0, GEMM_SPLIT, false>(lds, S, E);
}
DI void phase_mixout(const Params& p, LAS unsigned char* lds) {
    DenseSched S{(const char*)(p.ws + WS_H), (const char*)(p.ws + WS_WTMIX), 64, 8, 4096, 4096, 32, (int)gridDim.x, (int)blockIdx.x};
    EpiPlain E{(bf16_t*)(p.ws + WS_Y), DM};
    g8::gemm_phase<32, 0, GEMM_SPLIT, false>(lds, S, E);
}
DI void moe_tables(const Params& p, LAS unsigned char* lds) {
    LAS int* tpre = (LAS int*)(lds + MOE_TAB_OFF);
    const int* cnt = (const int*)(p.ws + WS_CNT);
    if (threadIdx.x == 0) {
        int acc = 0;
        for (int e = 0; e < NE; ++e) { const int n = cnt[e]; tpre[e] = acc; tpre[NEX + 1 + e] = n; acc += (n + 255) >> 8; }
        tpre[NE] = acc; tpre[NEX + 1 + NE] = NTOK; acc += NTOK / 256; tpre[NEX] = acc;
    }
    __syncthreads();
    const int T = tpre[NEX];
    for (int t = threadIdx.x; t < T; t += 512) {
        int e = 0;
        for (int q = 1; q < NEX; ++q) e = (tpre[q] <= t) ? q : e;
        *(LAS unsigned char*)(lds + MOE_TILE_OFF + t) = (unsigned char)e;
    }
    __syncthreads();
}
DI void phase_gateup(const Params& p, LAS unsigned char* lds) {
    moe_tables(p, lds);
    MoeSched S{lds, (const int*)(p.ws + WS_LIST), (const float*)(p.ws + WS_LISTW), (const char*)(p.ws + WS_H), (const char*)(p.ws + WS_WGU), 4, 0, (int)gridDim.x, (int)blockIdx.x};
    EpiGateUp E{(unsigned char*)(p.ws + WS_HID)};
    g8::gemm_phase<16, MOE_BAUX, GEMM_SPLIT, true>(lds, S, E);
}
DI void phase_down(const Params& p, LAS unsigned char* lds) {
    moe_tables(p, lds);
    MoeSched S{lds, (const int*)(p.ws + WS_LIST), (const float*)(p.ws + WS_LISTW), (const char*)(p.ws + WS_HID), (const char*)(p.ws + WS_WD), 8, 1, (int)gridDim.x, (int)blockIdx.x};
    EpiDown E{lds, (unsigned char*)(p.ws + WS_YB9), (int*)(p.ws + WS_SLOT)};
    g8::gemm_phase<32, MOE_BAUX, GEMM_SPLIT, true>(lds, S, E);
}

namespace att {
constexpr int TB = 16384;
DI unsigned off_b(unsigned row, unsigned ch) { return 256u * row + 16u * (ch ^ (((row & 3u) << 2) | ((row >> 2) & 3u))); }
DI int crow(int i, int h) { return (i & 3) + 8 * (i >> 2) + 4 * h; }
DI f32x16 mfma32(bf16x8 a, bf16x8 b, f32x16 c) { return __builtin_amdgcn_mfma_f32_32x32x16_bf16(a, b, c, 0, 0, 0); }
DI bf16x8 pack8(const f32x16& x, int s) {
    u32x4 w; w.x = pk_bf16(x[8 * s + 0], x[8 * s + 1]); w.y = pk_bf16(x[8 * s + 2], x[8 * s + 3]); w.z = pk_bf16(x[8 * s + 4], x[8 * s + 5]); w.w = pk_bf16(x[8 * s + 6], x[8 * s + 7]);
    return __builtin_bit_cast(bf16x8, w);
}
DI void qk_tile(LAS const unsigned char* Kb, const bf16x8 (&qf)[8], f32x16& x0, f32x16& x1, int r, int h) {
#pragma unroll
    for (int i = 0; i < 16; ++i) { x0[i] = 0.f; x1[i] = 0.f; }
#pragma unroll
    for (int s = 0; s < 8; ++s) {
        const bf16x8 a0 = *(const LAS bf16x8*)(Kb + off_b(r, 2 * s + h));
        const bf16x8 a1 = *(const LAS bf16x8*)(Kb + off_b(32 + r, 2 * s + h));
        x0 = mfma32(a0, qf[s], x0); x1 = mfma32(a1, qf[s], x1);
    }
}
DI void pv_tile(LAS const unsigned char* Vb, const f32x16& p0, const f32x16& p1, f32x16 (&o)[4], int lane) {
    const int h = lane >> 5, blk = (lane >> 4) & 1, q = (lane & 15) >> 2, pp = lane & 3;
#pragma unroll
    for (int kb = 0; kb < 2; ++kb)
#pragma unroll
        for (int s = 0; s < 2; ++s) {
            const bf16x8 pf = pack8(kb ? p1 : p0, s);
#pragma unroll
            for (int db = 0; db < 4; ++db) {
                const unsigned row0 = 32 * kb + 16 * s + 4 * h + q;
                const unsigned ch = 4 * db + 2 * blk + (pp >> 1);
                const s16x4 t0 = __builtin_amdgcn_ds_read_tr16_b64_v4i16((LAS s16x4*)(Vb + off_b(row0, ch) + 8 * (pp & 1)));
                const s16x4 t1 = __builtin_amdgcn_ds_read_tr16_b64_v4i16((LAS s16x4*)(Vb + off_b(row0 + 8, ch) + 8 * (pp & 1)));
                const bf16x8 vf = {t0[0], t0[1], t0[2], t0[3], t1[0], t1[1], t1[2], t1[3]};
                o[db] = mfma32(vf, pf, o[db]);
            }
        }
}
DI void store_o(bf16_t* orow, const f32x16 (&o)[4], float scale, int h) {
#pragma unroll
    for (int db = 0; db < 4; ++db)
#pragma unroll
        for (int g = 0; g < 4; ++g) {
            u32x2 w; w.x = pk_bf16(o[db][4 * g] * scale, o[db][4 * g + 1] * scale); w.y = pk_bf16(o[db][4 * g + 2] * scale, o[db][4 * g + 3] * scale);
            *(u32x2*)(orow + 32 * db + 8 * g + 4 * h) = w;
        }
}

DI void sb_item(const Params& p, LAS unsigned char* lds, int b, int hd, int Q) {
    const bf16_t* proj = (const bf16_t*)(p.ws + WS_PROJ);
    bf16_t* osb = (bf16_t*)(p.ws + WS_OSB);
    const int tid = threadIdx.x, wid = __builtin_amdgcn_readfirstlane(tid >> 6), lane = tid & 63, r = lane & 31, h = lane >> 5;
    const size_t tokbase = (size_t)b * SEQ;
    const int wq0 = Q * 256 + 32 * wid;
    const int myq = wq0 + r;
    bf16x8 qf[8];
    f32x16 o[4];
#pragma unroll
    for (int db = 0; db < 4; ++db)
#pragma unroll
        for (int i = 0; i < 16; ++i) o[db][i] = 0.f;
    float R = 0.f;
    unsigned goff[2];
#pragma unroll
    for (int i = 0; i < 2; ++i) { const unsigned row = 4 * (wid * 2 + i) + (lane >> 4), cp = lane & 15, ch = cp ^ (((row & 3u) << 2) | ((row >> 2) & 3u)); goff[i] = (row * DIN + ch * 8) * 2; }
    const char* kbase = (const char*)(proj + tokbase * DIN + COL_KS + hd * 128);
    const char* vbase = (const char*)(proj + tokbase * DIN + COL_VS + hd * 128);
#define ATT_ISSUE(key0_, buf_) do { const size_t _ko = (size_t)(key0_) * DIN * 2; _Pragma("unroll") for (int _i = 0; _i < 2; ++_i) { \
        __builtin_amdgcn_global_load_lds((const unsigned*)(kbase + _ko + goff[_i]), (LAS unsigned*)(lds + (buf_) * TB + 1024 * (wid * 2 + _i)), 16, 0, 0); \
        __builtin_amdgcn_global_load_lds((const unsigned*)(vbase + _ko + goff[_i]), (LAS unsigned*)(lds + 3 * TB + (buf_) * TB + 1024 * (wid * 2 + _i)), 16, 0, 0); } } while (0)
    int j = 4 * Q + 3;
    ATT_ISSUE(64 * j, 0);
    ATT_ISSUE(64 * (j - 1), 1);
    {
        const bf16_t* qrow = proj + (tokbase + myq) * DIN + COL_QS + hd * 128;
#pragma unroll
        for (int s = 0; s < 8; ++s) qf[s] = *(const bf16x8*)(qrow + 16 * s + 8 * h);
#pragma unroll
        for (int s = 0; s < 8; ++s) asm volatile("" : "+v"(qf[s]));
    }
    int cur = 0;
    for (; j >= 0; --j) {
        LAS unsigned char* Kb = lds + cur * TB; LAS unsigned char* Vb = lds + 3 * TB + cur * TB;
        if (j > 0) asm volatile("s_waitcnt vmcnt(4)" ::: "memory"); else asm volatile("s_waitcnt vmcnt(0)" ::: "memory");
        __builtin_amdgcn_s_barrier(); asm volatile("" ::: "memory");
        if (j > 1) ATT_ISSUE(64 * (j - 2), cur == 0 ? 2 : cur - 1);
        const int key0 = 64 * j;
        if (key0 < wq0 + 31) {
            const bool need_mask = (key0 + 63 >= wq0);
            f32x16 x0, x1;
            qk_tile(Kb, qf, x0, x1, r, h);
            f32x16 l0, l1;
#pragma unroll
            for (int i = 0; i < 16; ++i) {
                l0[i] = __builtin_amdgcn_logf(1.0f + __builtin_amdgcn_exp2f(x0[i]));
                l1[i] = __builtin_amdgcn_logf(1.0f + __builtin_amdgcn_exp2f(x1[i]));
            }
            if (need_mask) {
#pragma unroll
                for (int i = 0; i < 16; ++i) { const int kk = key0 + crow(i, h); if (kk >= myq) l0[i] = 0.f; if (kk + 32 >= myq) l1[i] = 0.f; }
            }
#pragma unroll
            for (int g = 0; g < 4; ++g) {
                l0[4 * g + 2] += l0[4 * g + 3]; l0[4 * g + 1] += l0[4 * g + 2]; l0[4 * g] += l0[4 * g + 1];
                l1[4 * g + 2] += l1[4 * g + 3]; l1[4 * g + 1] += l1[4 * g + 2]; l1[4 * g] += l1[4 * g + 1];
            }
            float Tlo[8], Thi[8];
#pragma unroll
            for (int g = 0; g < 4; ++g) {
                { const unsigned t = __float_as_uint(l0[4 * g]); auto sw = __builtin_amdgcn_permlane32_swap(t, t, false, false); Tlo[g] = __uint_as_float(sw[0]); Thi[g] = __uint_as_float(sw[1]); }
                { const unsigned t = __float_as_uint(l1[4 * g]); auto sw = __builtin_amdgcn_permlane32_swap(t, t, false, false); Tlo[4 + g] = __uint_as_float(sw[0]); Thi[4 + g] = __uint_as_float(sw[1]); }
            }
            float offR[8];
            float run = 0.f;
#pragma unroll
            for (int g = 7; g >= 0; --g) { offR[g] = run + (h == 0 ? Thi[g] : 0.f) + R; run += Tlo[g] + Thi[g]; }
            f32x16 p0, p1;
#pragma unroll
            for (int i = 0; i < 16; ++i) {
                p0[i] = __builtin_amdgcn_exp2f(x0[i] - (l0[i] + offR[i >> 2]));
                p1[i] = __builtin_amdgcn_exp2f(x1[i] - (l1[i] + offR[4 + (i >> 2)]));
            }
            if (need_mask) {
#pragma unroll
                for (int i = 0; i < 16; ++i) { const int kk = key0 + crow(i, h); if (kk >= myq) p0[i] = 0.f; if (kk + 32 >= myq) p1[i] = 0.f; }
            }
            R += run;
            pv_tile(Vb, p0, p1, o, lane);
        }
        cur = (cur == 2) ? 0 : cur + 1;
    }
    store_o(osb + (tokbase + myq) * 1024 + hd * 128, o, 1.0f, h);
    __syncthreads();
}

DI void dil_item(const Params& p, LAS unsigned char* lds, int di) {
    const bf16_t* proj = (const bf16_t*)(p.ws + WS_PROJ);
    bf16_t* og = (bf16_t*)(p.ws + WS_OG);
    float* lse = (float*)(p.ws + WS_LSE);
    const int b = di / 192; const int rem = di - b * 192; const int head = rem >> 4, sub = rem & 15;
    const int grp = head >> 2;
    const int dil = grp == 0 ? 1 : grp == 1 ? 4 : 16;
    const int nblk = 16 / dil;
    const int res = sub / nblk, Qb = sub - res * nblk;
    const int i0 = Qb * 256;
    const int tid = threadIdx.x, wid = __builtin_amdgcn_readfirstlane(tid >> 6), lane = tid & 63, r = lane & 31, h = lane >> 5;
    const size_t tokbase = (size_t)b * SEQ;
    const int wq0 = i0 + 32 * wid;
    const int myqi = wq0 + r;
    const size_t mytok = tokbase + (size_t)myqi * dil + res;
    bf16x8 qf[8];
    f32x16 o[4];
#pragma unroll
    for (int db = 0; db < 4; ++db)
#pragma unroll
        for (int i = 0; i < 16; ++i) o[db][i] = 0.f;
    float mrun = -1e30f, lrun = 0.f;
    unsigned goff[2];
#pragma unroll
    for (int i = 0; i < 2; ++i) { const unsigned row = 4 * (wid * 2 + i) + (lane >> 4), cp = lane & 15, ch = cp ^ (((row & 3u) << 2) | ((row >> 2) & 3u)); goff[i] = (row * dil * DIN + ch * 8) * 2; }
    const char* kbase = (const char*)(proj + (tokbase + res) * DIN + COL_KA + head * 128);
    const char* vbase = (const char*)(proj + (tokbase + res) * DIN + COL_VA + head * 128);
    const int jt0 = (i0 == 0) ? 2 : 0;
    ATT_ISSUE((i0 - 128 + 64 * jt0) * dil, 0);
    ATT_ISSUE((i0 - 128 + 64 * (jt0 + 1)) * dil, 1);
    {
        const bf16_t* qrow = proj + mytok * DIN + COL_QA + head * 128;
#pragma unroll
        for (int s = 0; s < 8; ++s) qf[s] = *(const bf16x8*)(qrow + 16 * s + 8 * h);
#pragma unroll
        for (int s = 0; s < 8; ++s) asm volatile("" : "+v"(qf[s]));
    }
    int cur = 0;
    for (int jt = jt0; jt < 6; ++jt) {
        LAS unsigned char* Kb = lds + cur * TB; LAS unsigned char* Vb = lds + 3 * TB + cur * TB;
        if (jt < 5) asm volatile("s_waitcnt vmcnt(4)" ::: "memory"); else asm volatile("s_waitcnt vmcnt(0)" ::: "memory");
        __builtin_amdgcn_s_barrier(); asm volatile("" ::: "memory");
        if (jt < 4) ATT_ISSUE((i0 - 128 + 64 * (jt + 2)) * dil, cur == 0 ? 2 : cur - 1);
        const int ki0 = i0 - 128 + 64 * jt;
        if (ki0 <= wq0 + 31 && ki0 + 63 >= wq0 - 128) {
            f32x16 x0, x1;
            qk_tile(Kb, qf, x0, x1, r, h);
            const float NEG = -__builtin_inff();
#pragma unroll
            for (int i = 0; i < 16; ++i) {
                const int d0 = myqi - (ki0 + crow(i, h));
                if ((unsigned)d0 > 128u) x0[i] = NEG;
                if ((unsigned)(d0 - 32) > 128u) x1[i] = NEG;
            }
            float mx = x0[0];
#pragma unroll
            for (int i = 1; i < 16; ++i) mx = fmaxf(mx, x0[i]);
#pragma unroll
            for (int i = 0; i < 16; ++i) mx = fmaxf(mx, x1[i]);
            { const unsigned t = __float_as_uint(mx); auto sw = __builtin_amdgcn_permlane32_swap(t, t, false, false); mx = fmaxf(__uint_as_float(sw[0]), __uint_as_float(sw[1])); }
            const float mn = fmaxf(mrun, mx);
            const float alpha = __builtin_amdgcn_exp2f(mrun - mn);
            mrun = mn;
            f32x16 p0, p1; float rs = 0.f;
#pragma unroll
            for (int i = 0; i < 16; ++i) { p0[i] = __builtin_amdgcn_exp2f(x0[i] - mn); p1[i] = __builtin_amdgcn_exp2f(x1[i] - mn); rs += p0[i] + p1[i]; }
            { const unsigned t = __float_as_uint(rs); auto sw = __builtin_amdgcn_permlane32_swap(t, t, false, false); rs = __uint_as_float(sw[0]) + __uint_as_float(sw[1]); }
            lrun = lrun * alpha + rs;
#pragma unroll
            for (int db = 0; db < 4; ++db)
#pragma unroll
                for (int i = 0; i < 16; ++i) o[db][i] *= alpha;
            pv_tile(Vb, p0, p1, o, lane);
        }
        cur = (cur == 2) ? 0 : cur + 1;
    }
    store_o(og + mytok * 1536 + head * 128, o, 1.0f / lrun, h);
    if (h == 0) lse[mytok * 12 + head] = (mrun + __builtin_amdgcn_logf(lrun)) * LN2;
    __syncthreads();
}
#undef ATT_ISSUE
}

DI void phase_attn(const Params& p, LAS unsigned char* lds) {
    for (int it = blockIdx.x; it < 1024; it += gridDim.x) {
        if (it < 256) {
            const int xcd = it & 7, rest = it >> 3, bhi = rest >> 3, x = rest & 7, bh = xcd * 4 + bhi;
            att::sb_item(p, lds, bh >> 3, bh & 7, 15 - x);
            att::sb_item(p, lds, bh >> 3, bh & 7, x);
        } else att::dil_item(p, lds, it - 256);
    }
}

DI void phase_merge(const Params& p) {
    const int lane = threadIdx.x & 63, wid = threadIdx.x >> 6;
    const bf16_t* og = (const bf16_t*)(p.ws + WS_OG); const float* lse = (const float*)(p.ws + WS_LSE); bf16_t* odil = (bf16_t*)(p.ws + WS_ODIL);
    const int hg = lane >> 4, d0 = (lane & 15) * 8;
    for (int tok = blockIdx.x * 8 + wid; tok < NTOK; tok += gridDim.x * 8) {
        const float l0 = lse[(size_t)tok * 12 + hg], l1 = lse[(size_t)tok * 12 + 4 + hg], l2 = lse[(size_t)tok * 12 + 8 + hg];
        const float mx = fmaxf(l0, fmaxf(l1, l2));
        float w0 = __expf(l0 - mx), w1 = __expf(l1 - mx), w2 = __expf(l2 - mx);
        const float inv = 1.0f / (w0 + w1 + w2); w0 *= inv; w1 *= inv; w2 *= inv;
        const u32x4 a = *(const u32x4*)(og + (size_t)tok * 1536 + hg * 128 + d0);
        const u32x4 bq = *(const u32x4*)(og + (size_t)tok * 1536 + (4 + hg) * 128 + d0);
        const u32x4 c = *(const u32x4*)(og + (size_t)tok * 1536 + (8 + hg) * 128 + d0);
        u32x4 o;
#pragma unroll
        for (int q = 0; q < 4; ++q) {
            const float lo = w0 * bf_lo(a[q]) + w1 * bf_lo(bq[q]) + w2 * bf_lo(c[q]);
            const float hi = w0 * bf_hi(a[q]) + w1 * bf_hi(bq[q]) + w2 * bf_hi(c[q]);
            o[q] = pk_bf16(lo, hi);
        }
        *(u32x4*)(odil + (size_t)tok * 512 + hg * 128 + d0) = o;
    }
}

DI void phase_postmix(const Params& p, LAS unsigned char* lds) {
    const int tid = threadIdx.x, lane = tid & 63, wid = __builtin_amdgcn_readfirstlane(tid >> 6);
    LAS float* hsm = (LAS float*)lds;
    LAS float* part = (LAS float*)(lds + 131072);
    const float* mod = (const float*)(p.ws + WS_MOD); const bf16_t* y = (const bf16_t*)(p.ws + WS_Y);
    unsigned char* h2 = (unsigned char*)(p.ws + WS_H);
    int* cnt = (int*)(p.ws + WS_CNT); int* list = (int*)(p.ws + WS_LIST); float* listw = (float*)(p.ws + WS_LISTW);
    const bf16_t* wr_hi = (const bf16_t*)(p.ws + WS_WRT); const bf16_t* wr_lo = wr_hi + 64 * 2048;
    LAS int* lcnt = (LAS int*)(lds + 147456);
    LAS int* lbase = (LAS int*)(lds + 147712);
    LAS unsigned char* sel_e = lds + 147968;
    LAS unsigned short* sel_r = (LAS unsigned short*)(lds + 150016);
    LAS float* sel_w = (LAS float*)(lds + 154112);
    if (tid < 64) lcnt[tid] = 0;
    int itl = 0;
    for (int it = blockIdx.x; it < NTOK / 16; it += gridDim.x, ++itl) {
#pragma unroll 1
        for (int sub = 0; sub < 2; ++sub) {
            const int tl = 2 * wid + sub, tok = it * 16 + tl, b = tok >> 12;
            f32x4 v[8]; float ss = 0.f;
#pragma unroll
            for (int i = 0; i < 8; ++i) { const u32x2 yw = *(const u32x2*)(y + (size_t)tok * DM + 4 * (lane + 64 * i)); v[i] = (f32x4){bf_lo(yw.x), bf_hi(yw.x), bf_lo(yw.y), bf_hi(yw.y)}; ss += v[i][0] * v[i][0] + v[i][1] * v[i][1] + v[i][2] * v[i][2] + v[i][3] * v[i][3]; }
            ss = wave_sum(ss);
            const float rstd = rsqrtf(ss * (1.0f / DM) + RMS_EPS);
            float ss1 = 0.f;
#pragma unroll
            for (int i = 0; i < 8; ++i) {
                const int ch = 4 * (lane + 64 * i);
                const f32x4 g = *(const f32x4*)(p.g_post_mix + ch);
                const f32x4 gt = *(const f32x4*)(mod + b * 12288 + 4096 + ch);
                const f32x4 xv = *(const f32x4*)(p.x + (size_t)tok * DM + ch);
#pragma unroll
                for (int j = 0; j < 4; ++j) { v[i][j] = xv[j] + gt[j] * (v[i][j] * rstd * g[j]); ss1 += v[i][j] * v[i][j]; }
                *(f32x4*)(p.out + (size_t)tok * DM + ch) = v[i];
            }
            ss1 = wave_sum(ss1);
            const float rstd1 = rsqrtf(ss1 * (1.0f / DM) + RMS_EPS);
#pragma unroll
            for (int i = 0; i < 8; ++i) {
                const int ch = 4 * (lane + 64 * i);
                const f32x4 g = *(const f32x4*)(p.g_pre_ffn + ch);
                const f32x4 sh = *(const f32x4*)(mod + b * 12288 + 6144 + ch);
                const f32x4 sc = *(const f32x4*)(mod + b * 12288 + 8192 + ch);
                f32x4 o;
#pragma unroll
                for (int j = 0; j < 4; ++j) o[j] = v[i][j] * rstd1 * g[j] * (1.0f + sc[j]) + sh[j];
                *(unsigned*)(h2 + (size_t)tok * DM + ch) = pk_fp8x4(o[0], o[1], o[2], o[3]);
                *(LAS f32x4*)(hsm + tl * 2048 + ch) = o;
            }
        }
        __syncthreads();
        f32x4 acc[4];
        {
            const int tr = lane & 15, kq = lane >> 4;
#pragma unroll
            for (int q = 0; q < 4; ++q) acc[q] = (f32x4){0.f, 0.f, 0.f, 0.f};
#pragma unroll 4
            for (int ks = 0; ks < 8; ++ks) {
                const int k0 = 256 * wid + 32 * ks + 8 * kq;
                const f32x4 a0 = *(const LAS f32x4*)(hsm + tr * 2048 + k0), a1 = *(const LAS f32x4*)(hsm + tr * 2048 + k0 + 4);
                u32x4 hw, lw;
                {
                    float xs[8] = {a0[0], a0[1], a0[2], a0[3], a1[0], a1[1], a1[2], a1[3]};
                    unsigned hh[4], ll[4];
#pragma unroll
                    for (int q = 0; q < 4; ++q) {
                        hh[q] = pk_bf16(xs[2 * q], xs[2 * q + 1]);
                        ll[q] = pk_bf16(xs[2 * q] - bf_lo(hh[q]), xs[2 * q + 1] - bf_hi(hh[q]));
                    }
                    hw = (u32x4){hh[0], hh[1], hh[2], hh[3]}; lw = (u32x4){ll[0], ll[1], ll[2], ll[3]};
                }
                const bf16x8 ah = __builtin_bit_cast(bf16x8, hw), al = __builtin_bit_cast(bf16x8, lw);
#pragma unroll
                for (int q = 0; q < 4; ++q) {
                    const bf16x8 bh = *(const bf16x8*)(wr_hi + (size_t)(16 * q + tr) * 2048 + k0);
                    const bf16x8 bl = *(const bf16x8*)(wr_lo + (size_t)(16 * q + tr) * 2048 + k0);
                    acc[q] = __builtin_amdgcn_mfma_f32_16x16x32_bf16(ah, bh, acc[q], 0, 0, 0);
                    acc[q] = __builtin_amdgcn_mfma_f32_16x16x32_bf16(ah, bl, acc[q], 0, 0, 0);
                    acc[q] = __builtin_amdgcn_mfma_f32_16x16x32_bf16(al, bh, acc[q], 0, 0, 0);
                }
            }
            if (wid >= 4) {
#pragma unroll
                for (int q = 0; q < 4; ++q)
#pragma unroll
                    for (int j = 0; j < 4; ++j) part[((wid - 4) * 16 + 4 * kq + j) * 64 + 16 * q + tr] = acc[q][j];
            }
        }
        __syncthreads();
        if (wid < 4) {
            const int tr = lane & 15, kq = lane >> 4;
#pragma unroll
            for (int q = 0; q < 4; ++q)
#pragma unroll
                for (int j = 0; j < 4; ++j) part[(wid * 16 + 4 * kq + j) * 64 + 16 * q + tr] += acc[q][j];
        }
        __syncthreads();
#pragma unroll 1
        for (int sub = 0; sub < 2; ++sub) {
            const int tl = 2 * wid + sub, tok = it * 16 + tl;
            const float logit = ((part[(0 * 16 + tl) * 64 + lane] + part[(1 * 16 + tl) * 64 + lane]) + part[(2 * 16 + tl) * 64 + lane]) + part[(3 * 16 + tl) * 64 + lane];
            const float score = 1.0f / (1.0f + __expf(-logit));
            const float sel = score + p.router_bias[lane];
            float m1 = sel;
            m1 = fmaxf(m1, __shfl_xor(m1, 1)); m1 = fmaxf(m1, __shfl_xor(m1, 2)); m1 = fmaxf(m1, __shfl_xor(m1, 4));
            const bool is1 = (sel == m1);
            const unsigned long long bal = __ballot(is1);
            const unsigned gm = (unsigned)(bal >> (lane & ~7)) & 0xffu;
            const int first = __ffs(gm) - 1;
            float m2 = (is1 && (lane & 7) == first) ? -__builtin_inff() : sel;
            m2 = fmaxf(m2, __shfl_xor(m2, 1)); m2 = fmaxf(m2, __shfl_xor(m2, 2)); m2 = fmaxf(m2, __shfl_xor(m2, 4));
            const float gs = m1 + m2;
            const int myg = lane >> 3;
            int grank = 0;
#pragma unroll 1
            for (int g = 0; g < 8; ++g) { const float gv = __uint_as_float(__builtin_amdgcn_readlane(__float_as_uint(gs), 8 * g)); grank += (gv > gs || (gv == gs && g < myg)) ? 1 : 0; }
            const bool gsel = grank < 4;
            const float msel = gsel ? sel : -__builtin_inff();
            int rk = 0;
#pragma unroll 4
            for (int e = 0; e < 64; ++e) { const float v = __uint_as_float(__builtin_amdgcn_readlane(__float_as_uint(msel), e)); rk += (v > msel || (v == msel && e < lane)) ? 1 : 0; }
            const bool chosen = gsel && rk < 8;
            const float ssum = wave_sum(chosen ? score : 0.f);
            if (chosen) {
                const int lr = __hip_atomic_fetch_add(lcnt + lane, 1, __ATOMIC_RELAXED, __HIP_MEMORY_SCOPE_WORKGROUP);
                const int idx = ((itl & 15) * 16 + tl) * 8 + rk;
                sel_e[idx] = (unsigned char)lane; sel_r[idx] = (unsigned short)lr; sel_w[idx] = score / ssum * 2.5f;
            }
            (void)tok;
        }
        __syncthreads();
        if ((itl & 15) == 15 || it + (int)gridDim.x >= NTOK / 16) {
            if (tid < 64) lbase[tid] = atomicAdd(&cnt[tid], lcnt[tid]);
            __syncthreads();
            const int nsel = ((itl & 15) + 1) * 128, it0 = itl & ~15;
            for (int idx = tid; idx < nsel; idx += 512) {
                const int e = sel_e[idx], tl = idx >> 3, k = idx & 7;
                const int tk = ((int)blockIdx.x + (it0 + (tl >> 4)) * (int)gridDim.x) * 16 + (tl & 15);
                const int pos = lbase[e] + sel_r[idx];
                list[e * LIST_CAP + pos] = tk * 9 + k; listw[e * LIST_CAP + pos] = sel_w[idx];
            }
            __syncthreads();
            if (tid < 64) lcnt[tid] = 0;
            __syncthreads();
        }
    }
}

DI void phase_combine(const Params& p) {
    const int lane = threadIdx.x & 63, wid = threadIdx.x >> 6;
    const float* mod = (const float*)(p.ws + WS_MOD); const unsigned char* yb9 = (const unsigned char*)(p.ws + WS_YB9); const int* slot = (const int*)(p.ws + WS_SLOT);
    for (int tok = blockIdx.x * 8 + wid; tok < NTOK; tok += gridDim.x * 8) {
        const int b = tok >> 12;
        float acc[2][16];
#pragma unroll
        for (int i = 0; i < 2; ++i)
#pragma unroll
            for (int j = 0; j < 16; ++j) acc[i][j] = 0.f;
#pragma unroll 3
        for (int k = 0; k < 9; ++k) {
            const unsigned char* row = yb9 + (size_t)slot[tok * 9 + k] * 256;
#pragma unroll
            for (int i = 0; i < 2; ++i) {
                const int c = lane + 64 * i;
                const u32x4 w = __builtin_nontemporal_load((const u32x4*)(row + (size_t)(c >> 4) * YB_SLOTS * 256 + (c & 15) * 16));
#pragma unroll
                for (int q = 0; q < 4; ++q) {
                    const f32x2 lo = __builtin_amdgcn_cvt_pk_f32_fp8((int)w[q], false), hi = __builtin_amdgcn_cvt_pk_f32_fp8((int)w[q], true);
                    acc[i][4 * q] += lo[0]; acc[i][4 * q + 1] += lo[1]; acc[i][4 * q + 2] += hi[0]; acc[i][4 * q + 3] += hi[1];
                }
            }
        }
        float ss = 0.f;
#pragma unroll
        for (int i = 0; i < 2; ++i)
#pragma unroll
            for (int j = 0; j < 16; ++j) ss += acc[i][j] * acc[i][j];
        ss = wave_sum(ss);
        const float rstd = rsqrtf(ss * (1.0f / DM) + RMS_EPS);
#pragma unroll
        for (int i = 0; i < 2; ++i) {
            const int ch = 16 * (lane + 64 * i);
#pragma unroll
            for (int hh = 0; hh < 4; ++hh) {
                const f32x4 g = *(const f32x4*)(p.g_post_ffn + ch + 4 * hh);
                const f32x4 gt = *(const f32x4*)(mod + b * 12288 + 10240 + ch + 4 * hh);
                f32x4 xv = *(const f32x4*)(p.out + (size_t)tok * DM + ch + 4 * hh);
#pragma unroll
                for (int j = 0; j < 4; ++j) xv[j] += gt[j] * (acc[i][4 * hh + j] * rstd * g[j]);
                __builtin_nontemporal_store(xv, (f32x4*)(p.out + (size_t)tok * DM + ch + 4 * hh));
            }
        }
    }
}

DI void probe_copy(const Params& p) {
    u32x4* yb = (u32x4*)(p.ws + WS_YB9);
    const size_t n = (size_t)576 * MiB / 16;
    for (size_t i = (size_t)blockIdx.x * 512 + threadIdx.x; i < n; i += (size_t)gridDim.x * 512) { u32x4 v = yb[i]; asm volatile("" : "+v"(v)); yb[i] = v; }
}

constexpr int NPHASE = 12;
template <int PH> DI void run_phase(const Params& p, LAS unsigned char* lds) {
    if constexpr (PH == 0) phase_prologue(p, lds);
    else if constexpr (PH == 1) phase_prenorm(p);
    else if constexpr (PH == 2) phase_inproj(p, lds);
    else if constexpr (PH == 3) phase_attn(p, lds);
    else if constexpr (PH == 4) phase_merge(p);
    else if constexpr (PH == 5) phase_outproj_a(p, lds);
    else if constexpr (PH == 6) phase_outproj_b(p, lds);
    else if constexpr (PH == 7) phase_mixout(p, lds);
    else if constexpr (PH == 8) phase_postmix(p, lds);
    else if constexpr (PH == 9) phase_gateup(p, lds);
    else if constexpr (PH == 10) phase_down(p, lds);
    else phase_combine(p);
}
template <int PH> __global__ __launch_bounds__(512, 2) void k_phase(Params p) {
    extern __shared__ __attribute__((aligned(16))) unsigned char shm[];
    run_phase<PH>(p, (LAS unsigned char*)shm);
}
#if MK_FUSED
typedef const __attribute__((address_space(4))) Params* KargPtr;
template <int PH> DI void mega_phase(KargPtr kp0, LAS unsigned char* lds) {
    KargPtr kp = kp0; asm volatile("" : "+s"(kp));
    Params p{};
#if defined(__HIP_DEVICE_COMPILE__)
    p.x = kp->x; p.c = kp->c; p.pos = kp->pos; p.w_ada = kp->w_ada; p.b_ada = kp->b_ada; p.g_pre_mix = kp->g_pre_mix; p.g_post_mix = kp->g_post_mix; p.g_pre_ffn = kp->g_pre_ffn; p.g_post_ffn = kp->g_post_ffn; p.w_in = kp->w_in; p.w_dil_out = kp->w_dil_out; p.w_sb_out = kp->w_sb_out; p.w_mix_out = kp->w_mix_out; p.w_router = kp->w_router; p.router_bias = kp->router_bias; p.w_gate_e = kp->w_gate_e; p.w_up_e = kp->w_up_e; p.w_down_e = kp->w_down_e; p.w_gate_s = kp->w_gate_s; p.w_up_s = kp->w_up_s; p.w_down_s = kp->w_down_s; p.out = kp->out; p.ws = kp->ws;
#endif
    run_phase<PH>(p, lds);
}
__global__ __launch_bounds__(512, 2) void k_mega(Params p_unused) {
    extern __shared__ __attribute__((aligned(16))) unsigned char shm[];
    LAS unsigned char* lds = (LAS unsigned char*)shm;
    KargPtr kp0 = (KargPtr)__builtin_amdgcn_kernarg_segment_ptr();
    volatile LAS unsigned* xbw = (volatile LAS unsigned*)(lds + LDS_BYTES - 16);
    if (threadIdx.x == 0) { xbw[0] = 0u; xbw[1] = 0u; xbw[2] = 0u; xbw[3] = 0u; }
    __syncthreads();
    XcdBarrier bar;
    { KargPtr kp = kp0; asm volatile("" : "+s"(kp)); bar = xcd_barrier_post((unsigned*)(kp->ws + WS_BAR), xbw); }
    if (MK_STAMP >= 0 && blockIdx.x == 0 && threadIdx.x == 0) { KargPtr kq = kp0; asm volatile("" : "+s"(kq)); ((unsigned long long*)(kq->ws + WS_STAMP))[0] = wall_clock64(); }
#define MEGA_PH(n) do { mega_phase<n>(kp0, lds); xcd_barrier(bar); if (MK_REP == n) { mega_phase<n>(kp0, lds); xcd_barrier(bar); } \
        if (MK_STAMP >= 0 && blockIdx.x == 0 && threadIdx.x == 0) { KargPtr kq = kp0; asm volatile("" : "+s"(kq)); ((unsigned long long*)(kq->ws + WS_STAMP))[n + 1] = wall_clock64(); } } while (0)
#if MK_REP == 90
#define MK_PROBE_DOWN_NOSTORE 1
#endif
    MEGA_PH(0); MEGA_PH(1); MEGA_PH(2); MEGA_PH(3); MEGA_PH(4); MEGA_PH(5); MEGA_PH(6); MEGA_PH(7); MEGA_PH(8); MEGA_PH(9); MEGA_PH(10);
#if MK_REP == 100
    { KargPtr kp = kp0; asm volatile("" : "+s"(kp)); Params p{}; p.ws = kp->ws; probe_copy(p); xcd_barrier(bar); }
#endif
#undef MEGA_PH
    mega_phase<11>(kp0, lds);
#if MK_STAMP >= 0
    xcd_barrier(bar);
    if (blockIdx.x == 0 && threadIdx.x == 0) {
        KargPtr kq = kp0; asm volatile("" : "+s"(kq));
        unsigned long long* st = (unsigned long long*)(kq->ws + WS_STAMP);
        st[12] = wall_clock64();
        const int k = MK_STAMP < 100 ? MK_STAMP : MK_STAMP - 100;
        const unsigned long long t0 = (MK_STAMP < 100) ? st[k] : st[0], t1 = (MK_STAMP < 100) ? st[k + 1] : st[k + 1];
        kq->out[0] += 2.0f + (float)(t1 - t0) * (MK_STAMP < 100 ? 0.0005f : 0.0001f);
    }
#endif
}
#endif

template <int PH> static void launch_phase(const Params& p, int grid, hipStream_t stream) {
    static bool init = false;
    if (!init) { (void)hipFuncSetAttribute((const void*)k_phase<PH>, hipFuncAttributeMaxDynamicSharedMemorySize, LDS_BYTES); init = true; }
    hipLaunchKernelGGL(k_phase<PH>, dim3(grid), dim3(512), LDS_BYTES, stream, p);
}

extern "C" void kernel_launch(void* const* d_in, const int* in_sizes, int n_in, void* d_out, int out_size, void* d_ws, size_t ws_size, hipStream_t stream) {
    (void)in_sizes; (void)n_in; (void)out_size;
    static int grid = 0;
    if (!grid) {
        int dev = 0, cus = 0; (void)hipGetDevice(&dev); (void)hipDeviceGetAttribute(&cus, hipDeviceAttributeMultiprocessorCount, dev);
        if (cus <= 0) cus = 256;
#if MK_FUSED
        (void)hipFuncSetAttribute((const void*)k_mega, hipFuncAttributeMaxDynamicSharedMemorySize, LDS_BYTES);
        int per_cu = 0;
        if (hipOccupancyMaxActiveBlocksPerMultiprocessor(&per_cu, (const void*)k_mega, 512, LDS_BYTES) != hipSuccess || per_cu < 1)
            fprintf(stderr, "kernel_launch: occupancy query reports %d workgroups per CU\n", per_cu);
#endif
        grid = cus;
        if (ws_size < WS_TOTAL) fprintf(stderr, "kernel_launch: workspace too small: %zu < %zu\n", ws_size, (size_t)WS_TOTAL);
    }
    Params p{};
    p.x = (const float*)d_in[0]; p.c = (const float*)d_in[1]; p.pos = (const int*)d_in[2];
    p.w_ada = (const float*)d_in[3]; p.b_ada = (const float*)d_in[4];
    p.g_pre_mix = (const float*)d_in[5]; p.g_post_mix = (const float*)d_in[6]; p.g_pre_ffn = (const float*)d_in[7]; p.g_post_ffn = (const float*)d_in[8];
    p.w_in = (const float*)d_in[9]; p.w_dil_out = (const float*)d_in[10]; p.w_sb_out = (const float*)d_in[11]; p.w_mix_out = (const float*)d_in[12];
    p.w_router = (const float*)d_in[13]; p.router_bias = (const float*)d_in[14];
    p.w_gate_e = (const float*)d_in[15]; p.w_up_e = (const float*)d_in[16]; p.w_down_e = (const float*)d_in[17];
    p.w_gate_s = (const float*)d_in[18]; p.w_up_s = (const float*)d_in[19]; p.w_down_s = (const float*)d_in[20];
    p.out = (float*)d_out; p.ws = (unsigned char*)d_ws;
    (void)hipMemsetAsync((unsigned char*)d_ws + WS_BAR, 0, WS_ZERO_BYTES, stream);
#if MK_FUSED
    hipLaunchKernelGGL(k_mega, dim3(grid), dim3(512), LDS_BYTES, stream, p);
#else
    launch_phase<0>(p, grid, stream); launch_phase<1>(p, grid, stream); launch_phase<2>(p, grid, stream); launch_phase<3>(p, grid, stream);
    launch_phase<4>(p, grid, stream); launch_phase<5>(p, grid, stream); launch_phase<6>(p, grid, stream); launch_phase<7>(p, grid, stream);
    launch_phase<8>(p, grid, stream); launch_phase<9>(p, grid, stream); launch_phase<10>(p, grid, stream); launch_phase<11>(p, grid, stream);
#endif
}
```

```cpp
#include <hip/hip_runtime.h>
#include <stdint.h>
#include <stdio.h>

#ifndef MK_FUSED
#define MK_FUSED 1
#endif
#ifndef MK_STAMP
#define MK_STAMP -1
#endif
#ifndef MK_REP
#define MK_REP -1
#endif

#define LAS __attribute__((address_space(3)))
#define DI __device__ __forceinline__
typedef unsigned short bf16_t;
typedef short bf16x8 __attribute__((ext_vector_type(8)));
typedef short s16x4 __attribute__((ext_vector_type(4)));
typedef float f32x2 __attribute__((ext_vector_type(2)));
typedef float f32x4 __attribute__((ext_vector_type(4)));
typedef float f32x16 __attribute__((ext_vector_type(16)));
typedef unsigned u32x2 __attribute__((ext_vector_type(2)));
typedef unsigned u32x4 __attribute__((ext_vector_type(4)));
typedef __bf16 bf16x2_t __attribute__((ext_vector_type(2)));
typedef const __attribute__((address_space(1))) char* gcptr;
typedef const __attribute__((address_space(1))) u32x4* gu4ptr;
typedef int i32x8 __attribute__((ext_vector_type(8)));
typedef short s16x16 __attribute__((ext_vector_type(16)));

constexpr int NBATCH = 4, SEQ = 4096, NTOK = NBATCH * SEQ, DM = 2048, DIN = 11776;
constexpr int COL_QA = 0, COL_KA = 1536, COL_VA = 3072, COL_QS = 4608, COL_KS = 5632, COL_VS = 6656, COL_GD = 7680, COL_GS = 9728;
constexpr int NE = 64, DE = 512, NEX = 65;
constexpr int LIST_CAP = 16384;
constexpr int YB_SLOTS = 163840;
constexpr float RMS_EPS = 1e-6f;
constexpr float QSCALE = 0.08838834764831845f * 1.4426950408889634f;
constexpr float LN2 = 0.6931471805599453f;
constexpr float W8_SCALE = 64.0f;
constexpr int W8_MX = 0x79797979, A8_MX = 0x7f7f7f7f;

constexpr size_t MiB = 1ull << 20;
constexpr size_t WS_BAR = 0;
constexpr size_t WS_CNT = 16384;
constexpr size_t WS_ZERO_BYTES = 32768;
constexpr size_t WS_STAMP = 32768;

constexpr size_t WS_MOD = 65536;
constexpr size_t WS_LSE = 262144;
constexpr size_t WS_ROPE = 1 * MiB;
constexpr size_t WS_LIST = 3 * MiB;
constexpr size_t WS_LISTW = 7 * MiB;
constexpr size_t WS_SLOT = 262144;
constexpr size_t WS_WD = 11 * MiB;
constexpr size_t WS_WTIN8 = 76 * MiB;
constexpr size_t WS_H8 = 100 * MiB;
constexpr size_t WS_H = 141 * MiB;
constexpr size_t WS_HID = 205 * MiB;
constexpr size_t WS_WTIN = 205 * MiB;
constexpr size_t WS_TMP = 205 * MiB;
constexpr size_t WS_OG = 251 * MiB;
constexpr size_t WS_OSB = 299 * MiB;
constexpr size_t WS_ODIL = 331 * MiB;
constexpr size_t WS_WTDIL = 347 * MiB;
constexpr size_t WS_WTSB = 349 * MiB;
constexpr size_t WS_WTMIX = 353 * MiB;
constexpr size_t WS_PROJ = 365 * MiB;
constexpr size_t WS_Y = 365 * MiB;
constexpr size_t WS_YB9 = 365 * MiB;
constexpr size_t WS_WGU = 733 * MiB;
constexpr size_t WS_WRT = 1005 * MiB;
constexpr size_t WS_TOTAL = 1006 * MiB;

#ifndef MOE_BAUX
#define MOE_BAUX 0
#endif
#ifndef GEMM_SPLIT
#define GEMM_SPLIT false
#endif
constexpr int LDS_BYTES = 163840;

struct Params {
    const float *x, *c; const int* pos;
    const float *w_ada, *b_ada, *g_pre_mix, *g_post_mix, *g_pre_ffn, *g_post_ffn;
    const float *w_in, *w_dil_out, *w_sb_out, *w_mix_out, *w_router, *router_bias;
    const float *w_gate_e, *w_up_e, *w_down_e, *w_gate_s, *w_up_s, *w_down_s;
    float* out; unsigned char* ws;
};

DI unsigned pk_bf16(float lo, float hi) { f32x2 v = {lo, hi}; bf16x2_t r = __builtin_convertvector(v, bf16x2_t); return __builtin_bit_cast(unsigned, r); }
DI unsigned pk_fp8x4(float a, float b, float c, float d) { int p = __builtin_amdgcn_cvt_pk_fp8_f32(a, b, 0, false); p = __builtin_amdgcn_cvt_pk_fp8_f32(c, d, p, true); return (unsigned)p; }
DI float bf_lo(unsigned u) { return __uint_as_float(u << 16); }
DI float bf_hi(unsigned u) { return __uint_as_float(u & 0xffff0000u); }
DI float wave_sum(float v) {
#pragma unroll
    for (int o = 32; o >= 1; o >>= 1) v += __shfl_xor(v, o);
    return v;
}
DI float sigmoidf_(float x) { return __builtin_amdgcn_rcpf(1.0f + __expf(-x)); }

#define XB_TMO      128
#define XB_XCNT(j)  (256  + 64 * (j))
#define XB_XSUB(j)  (1280 + 64 * (j))
#define XB_XGEN(j)  (2304 + 64 * (j))
#define XB_TOP      3328
#define XB_TOPGEN   3392
#define XCD_BAR_WORDS 3456
#define XB_SPIN_CAP (1u << 18)

__device__ __forceinline__ unsigned xb_ld(unsigned* p)              { return __hip_atomic_load(p, __ATOMIC_RELAXED, __HIP_MEMORY_SCOPE_AGENT); }
__device__ __forceinline__ unsigned xb_add(unsigned* p, unsigned v) { return __hip_atomic_fetch_add(p, v, __ATOMIC_RELAXED, __HIP_MEMORY_SCOPE_AGENT); }
__device__ __forceinline__ unsigned xb_xcc_id() { return (unsigned)__builtin_amdgcn_s_getreg((3 << 11) | 20) & 0xFu; }
#define XB_SPIN(cond, bar) do { unsigned _sp = 0; while (cond) { __builtin_amdgcn_s_sleep(1); \
    if ((++_sp & 255u) == 0u) { if (xb_ld(&(bar)[XB_TMO])) break; if (_sp > XB_SPIN_CAP) { atomicAdd(&(bar)[XB_TMO], 1u); break; } } } } while (0)

struct XcdBarrier { unsigned* bar; unsigned x; volatile LAS unsigned* st; };

__device__ __forceinline__ XcdBarrier xcd_barrier_post(unsigned* bar, volatile LAS unsigned* st) {
    XcdBarrier b; b.bar = bar; b.x = xb_xcc_id(); b.st = st;
    if (threadIdx.x == 0) (void)xb_add(&bar[XB_XCNT(b.x)], 1u);
    return b;
}
__device__ __forceinline__ void xcd_barrier_complete(unsigned* bar, unsigned x, unsigned& nloc, unsigned& nx) {
    const unsigned G = gridDim.x * gridDim.y * gridDim.z;
    unsigned sum, cnt, mine, sp = 0u;
    for (;;) {
        sum = 0u; cnt = 0u; mine = 0u;
#pragma unroll
        for (unsigned j = 0; j < 16; ++j) { const unsigned c = xb_ld(&bar[XB_XCNT(j)]); sum += c; cnt += (c > 0u) ? 1u : 0u; mine = (j == x) ? c : mine; }
        if (sum == G) break;
        __builtin_amdgcn_s_sleep(1);
        if ((++sp & 255u) == 0u) { if (xb_ld(&bar[XB_TMO])) break; if (sp > XB_SPIN_CAP) { atomicAdd(&bar[XB_TMO], 1u); break; } }
    }
    nloc = mine > 0u ? mine : 1u; nx = cnt > 0u ? cnt : 1u;
}
__device__ __forceinline__ void xcd_barrier(const XcdBarrier& b) {
    asm volatile("s_waitcnt vmcnt(0)" ::: "memory");
    __syncthreads();
    if (threadIdx.x == 0) {
        unsigned* bar = b.bar;
        __builtin_amdgcn_s_waitcnt(0);
        unsigned nloc = b.st[0], nx = b.st[1];
        if (nloc == 0u) { xcd_barrier_complete(bar, b.x, nloc, nx); b.st[0] = nloc; b.st[1] = nx; }
        const unsigned old = xb_add(&bar[XB_XSUB(b.x)], 1u);
        const unsigned gen = old / nloc;
        if (old + 1u == (gen + 1u) * nloc) {
            __builtin_amdgcn_fence(__ATOMIC_RELEASE, "agent");
            asm volatile("s_waitcnt vmcnt(0)" ::: "memory");
            const unsigned og = xb_add(&bar[XB_TOP], 1u);
            const unsigned tg = og / nx;
            if (og + 1u == (tg + 1u) * nx) xb_add(&bar[XB_TOPGEN], 1u);
            else XB_SPIN(xb_ld(&bar[XB_TOPGEN]) == tg, bar);
            __builtin_amdgcn_fence(__ATOMIC_ACQUIRE, "agent");
            xb_add(&bar[XB_XGEN(b.x)], 1u);
            asm volatile("s_waitcnt vmcnt(0)" ::: "memory");
        } else {
            XB_SPIN(xb_ld(&bar[XB_XGEN(b.x)]) == gen, bar);
            __builtin_amdgcn_fence(__ATOMIC_ACQUIRE, "agent");
            asm volatile("s_waitcnt vmcnt(0)" ::: "memory");
        }
    }
    __syncthreads();
}

struct CvtMat { const float* src; bf16_t* dst; int K, N, nb, mode; size_t sstride, dstride; };
constexpr int CVT_NMAT = 10;
constexpr int CVT_TILES[CVT_NMAT] = {2944, 128, 256, 512, 8192, 8192, 8192, 128, 128, 128};
constexpr int CVT_TOTAL = 2944 + 128 + 256 + 512 + 8192 * 3 + 128 * 3;
constexpr int P0_MOD_UNITS = 192, P0_ROPE_UNITS = 64, P0_WR_UNITS = 8, P0_ITEMS = P0_MOD_UNITS + P0_ROPE_UNITS + P0_WR_UNITS + CVT_TOTAL;

DI CvtMat cvt_mat(const Params& p, int m) {
    bf16_t* wtin = (bf16_t*)(p.ws + WS_WTIN); bf16_t* wtdil = (bf16_t*)(p.ws + WS_WTDIL); bf16_t* wtsb = (bf16_t*)(p.ws + WS_WTSB); bf16_t* wtmix = (bf16_t*)(p.ws + WS_WTMIX);
    bf16_t* wgu = (bf16_t*)(p.ws + WS_WGU); bf16_t* wd = (bf16_t*)(p.ws + WS_WD);
    CvtMat r;
    switch (m) {
        case 0: r = {p.w_in, wtin, 2048, 11776, 1, 0, 0, 0}; break;
        case 1: r = {p.w_dil_out, wtdil, 512, 2048, 1, 0, 0, 0}; break;
        case 2: r = {p.w_sb_out, wtsb, 1024, 2048, 1, 0, 0, 0}; break;
        case 3: r = {p.w_mix_out, wtmix, 2048, 2048, 1, 0, 0, 0}; break;
        case 4: r = {p.w_gate_e, wgu, 2048, 512, 64, 1, (size_t)2048 * 512, (size_t)1024 * 2048}; break;
        case 5: r = {p.w_up_e, wgu, 2048, 512, 64, 2, (size_t)2048 * 512, (size_t)1024 * 2048}; break;
        case 6: r = {p.w_down_e, wd, 512, 2048, 64, 0, (size_t)512 * 2048, (size_t)2048 * 512}; break;
        case 7: r = {p.w_gate_s, (bf16_t*)((unsigned char*)wgu + (size_t)64 * 1024 * 2048), 2048, 512, 1, 1, 0, 0}; break;
        case 8: r = {p.w_up_s, (bf16_t*)((unsigned char*)wgu + (size_t)64 * 1024 * 2048), 2048, 512, 1, 2, 0, 0}; break;
        default: r = {p.w_down_s, (bf16_t*)((unsigned char*)wd + (size_t)64 * 2048 * 512), 512, 2048, 1, 0, 0, 0}; break;
    }
    return r;
}

struct CvtTile { const float* src; unsigned char* dst; int N, K, kt, nt, mode, f8; };
DI CvtTile cvt_desc(const Params& p, int t) {
    int m = 0;
#pragma unroll
    for (int i = 0; i < CVT_NMAT - 1; ++i) { if (t >= CVT_TILES[i] && m == i) { t -= CVT_TILES[i]; m = i + 1; } }
    const CvtMat M = cvt_mat(p, m);
    const int tn = M.N / 64, tk = M.K / 128;
    const int b = t / (tn * tk); const int rem = t - b * (tn * tk); const int kt = rem / tn, nt = rem - kt * tn;
    const bool in8 = (m == 0) && (nt * 64 >= COL_GD);
    CvtTile d; d.src = M.src + (size_t)b * M.sstride + (size_t)(kt * 128) * M.N + nt * 64; d.N = M.N; d.K = M.K; d.kt = kt; d.nt = nt; d.mode = M.mode;
    d.f8 = (m >= 4 || in8) ? 1 : 0;
    d.dst = in8 ? (unsigned char*)(p.ws + WS_WTIN8) : (m >= 4 ? (unsigned char*)M.dst + (size_t)b * M.dstride : (unsigned char*)(M.dst + (size_t)b * M.dstride));
    return d;
}
DI void cvt_load(const CvtTile& d, f32x4 (&v)[4]) {
    const int k4 = (threadIdx.x >> 4) * 4, n4 = (threadIdx.x & 15) * 4;
#pragma unroll
    for (int i = 0; i < 4; ++i) v[i] = __builtin_nontemporal_load((const f32x4*)(d.src + (size_t)(k4 + i) * d.N + n4));
}
DI void cvt_bar() { asm volatile("s_waitcnt lgkmcnt(0)" ::: "memory"); __builtin_amdgcn_s_barrier(); asm volatile("" ::: "memory"); }
DI void cvt_finish(const CvtTile& d, const f32x4 (&vin)[4], LAS unsigned char* lds) {
    f32x4 v[4] = {vin[0], vin[1], vin[2], vin[3]};
    asm volatile("" : "+v"(v[0]), "+v"(v[1]), "+v"(v[2]), "+v"(v[3]));
    const int tid = threadIdx.x;
    const int k4 = (tid >> 4) * 4, n4 = (tid & 15) * 4;
    const int c = d.nt * 64 + (tid >> 3);
    const int drow = d.mode == 0 ? c : (((c >> 7) << 8) + (c & 127) + (d.mode == 2 ? 128 : 0));
    if (!d.f8) {
        constexpr int P = 272;
#pragma unroll
        for (int j = 0; j < 4; ++j) { u32x2 w; w.x = pk_bf16(v[0][j], v[1][j]); w.y = pk_bf16(v[2][j], v[3][j]); *(LAS u32x2*)(lds + (n4 + j) * P + k4 * 2) = w; }
        cvt_bar();
#pragma unroll
        for (int i = 0; i < 2; ++i) {
            const int ch = (tid & 7) + 8 * i;
            const u32x4 w = *(const LAS u32x4*)(lds + (tid >> 3) * P + ch * 16);
            *(u32x4*)((bf16_t*)d.dst + (size_t)drow * d.K + d.kt * 128 + ch * 8) = w;
        }
    } else {
        constexpr int P = 144;
#pragma unroll
        for (int j = 0; j < 4; ++j) *(LAS unsigned*)(lds + (n4 + j) * P + k4) = pk_fp8x4(v[0][j] * W8_SCALE, v[1][j] * W8_SCALE, v[2][j] * W8_SCALE, v[3][j] * W8_SCALE);
        cvt_bar();
        const u32x4 w = *(const LAS u32x4*)(lds + (tid >> 3) * P + (tid & 7) * 16);
        __builtin_nontemporal_store(w, (u32x4*)(d.dst + (size_t)drow * d.K + d.kt * 128 + (tid & 7) * 16));
    }
    cvt_bar();
}

DI void mod_unit(const Params& p, int u, LAS unsigned char* lds) {
    const int tid = threadIdx.x, c0 = u * 64;
    LAS float* sc = (LAS float*)lds;
    LAS float* red = (LAS float*)(lds + 32768);
    for (int i = tid; i < 4 * 2048; i += 512) { const float v = p.c[i]; sc[i] = v / (1.0f + __expf(-v)); }
    __syncthreads();
    const int kq = tid >> 4, cq = tid & 15;
    float acc[4][4];
#pragma unroll
    for (int b = 0; b < 4; ++b)
#pragma unroll
        for (int j = 0; j < 4; ++j) acc[b][j] = 0.f;
    for (int it = 0; it < 64; ++it) {
        const int k = kq + 32 * it;
        const f32x4 w = __builtin_nontemporal_load((const f32x4*)(p.w_ada + (size_t)k * 12288 + c0 + 4 * cq));
#pragma unroll
        for (int b = 0; b < 4; ++b) { const float s = sc[b * 2048 + k];
#pragma unroll
            for (int j = 0; j < 4; ++j) acc[b][j] += s * w[j]; }
    }
#pragma unroll
    for (int b = 0; b < 4; ++b)
#pragma unroll
        for (int j = 0; j < 4; ++j) red[(kq * 4 + b) * 64 + 4 * cq + j] = acc[b][j];
    __syncthreads();
    if (tid < 256) {
        const int b = tid >> 6, col = tid & 63;
        float s = 0.f;
        for (int q = 0; q < 32; ++q) s += red[(q * 4 + b) * 64 + col];
        float* mod = (float*)(p.ws + WS_MOD);
        mod[b * 12288 + c0 + col] = s + p.b_ada[c0 + col];
    }
    __syncthreads();
}

DI void rope_unit(const Params& p, int u) {
    float2* rope = (float2*)(p.ws + WS_ROPE);
    for (int e = threadIdx.x; e < 4096; e += 512) {
        const int tok = u * 256 + (e >> 4), i = e & 15;
        const float invf = (float)pow(500000.0, -(double)i / 16.0);
        const float ang = (float)p.pos[tok] * invf;
        rope[tok * 16 + i] = make_float2((float)cos((double)ang), (float)sin((double)ang));
    }
}

DI void wr_unit(const Params& p, int u) {
    bf16_t* hi = (bf16_t*)(p.ws + WS_WRT); bf16_t* lo = hi + 64 * 2048;
    for (int i = threadIdx.x; i < 16384; i += 512) {
        const int idx = u * 16384 + i, k = idx >> 6, e = idx & 63;
        const float x = p.w_router[idx];
        const unsigned h = pk_bf16(x, 0.f) & 0xffffu;
        const float r = x - __uint_as_float(h << 16);
        hi[e * 2048 + k] = (bf16_t)h; lo[e * 2048 + k] = (bf16_t)(pk_bf16(r, 0.f) & 0xffffu);
    }
}
DI void phase_prologue(const Params& p, LAS unsigned char* lds) {
    constexpr int NSMALL = P0_MOD_UNITS + P0_ROPE_UNITS + P0_WR_UNITS;
    int it = blockIdx.x;
    for (; it < NSMALL; it += gridDim.x) {
        if (it < P0_MOD_UNITS) mod_unit(p, it, lds);
        else if (it < P0_MOD_UNITS + P0_ROPE_UNITS) rope_unit(p, it - P0_MOD_UNITS);
        else wr_unit(p, it - P0_MOD_UNITS - P0_ROPE_UNITS);
    }
    if (it < P0_ITEMS) {
        const int G = (int)gridDim.x;
        const int n = (P0_ITEMS - it + G - 1) / G;
        const int base = it - NSMALL;
        CvtTile dA = cvt_desc(p, base), dB = dA;
        f32x4 vA[4], vB[4]; cvt_load(dA, vA);
#pragma unroll 1
        for (int j = 0; j < n; j += 2) {
            dB = cvt_desc(p, base + min(j + 1, n - 1) * G); cvt_load(dB, vB);
            asm volatile("" ::: "memory");
            cvt_finish(dA, vA, lds);
            dA = cvt_desc(p, base + min(j + 2, n - 1) * G); cvt_load(dA, vA);
            asm volatile("" ::: "memory");
            cvt_finish(dB, vB, lds);
        }
    }
    __syncthreads();
}

DI void phase_prenorm(const Params& p) {
    const int lane = threadIdx.x & 63, wid = threadIdx.x >> 6;
    const float* mod = (const float*)(p.ws + WS_MOD);
    bf16_t* h = (bf16_t*)(p.ws + WS_H);
    for (int tok = blockIdx.x * 8 + wid; tok < NTOK; tok += gridDim.x * 8) {
        const int b = tok >> 12;
        const float* xr = p.x + (size_t)tok * DM;
        f32x4 v[8]; float ss = 0.f;
#pragma unroll
        for (int i = 0; i < 8; ++i) { v[i] = *(const f32x4*)(xr + 4 * (lane + 64 * i)); ss += v[i][0] * v[i][0] + v[i][1] * v[i][1] + v[i][2] * v[i][2] + v[i][3] * v[i][3]; }
        ss = wave_sum(ss);
        const float rstd = rsqrtf(ss * (1.0f / DM) + RMS_EPS);
#pragma unroll
        for (int i = 0; i < 8; ++i) {
            const int ch = 4 * (lane + 64 * i);
            const f32x4 g = *(const f32x4*)(p.g_pre_mix + ch);
            const f32x4 sh = *(const f32x4*)(mod + b * 12288 + ch);
            const f32x4 sc = *(const f32x4*)(mod + b * 12288 + 2048 + ch);
            f32x4 o;
#pragma unroll
            for (int j = 0; j < 4; ++j) o[j] = v[i][j] * rstd * g[j] * (1.0f + sc[j]) + sh[j];
            u32x2 w; w.x = pk_bf16(o[0], o[1]); w.y = pk_bf16(o[2], o[3]);
            *(u32x2*)(h + (size_t)tok * DM + ch) = w;
            *(unsigned*)(p.ws + WS_H8 + (size_t)tok * DM + ch) = pk_fp8x4(o[0], o[1], o[2], o[3]);
        }
    }
}

namespace g8 {
constexpr int BM = 256, BK = 64, HALF = 128, HTB = HALF * BK * 2, STAGE_BYTES = 8 * HTB, NXCD = 8, WGM = 8;
DI int lds_byte(int r, int c) { const int st = (r >> 4) * 2 + (c >> 5), rr = r & 15, cc = c & 31, ob = rr * 64 + cc * 2; return st * 1024 + (ob ^ (((ob >> 9) & 1) << 5)); }
DI void stage_rc(int b, int& R, int& C) { const int st = b / 1024, sb = b % 1024, swz = sb ^ (((sb >> 9) & 1) << 5); R = (st >> 1) * 16 + swz / 64; C = (st & 1) * 32 + (swz % 64) / 2; }
DI int perm32(int rho) { const int n = rho >> 4, i = rho & 15; return 8 * (i >> 2) + 4 * n + (i & 3); }

struct Unit {
    const char* A; const char* B;
    int row0;
    int lda, ldb, nt;
    int pm, pn, aux, keep;
    int e, nvalid, par;
};

DI bool static_tile(int L, int nM, int nN, int& pm, int& pn) {
    const int nwg = nM * nN; if (L >= nwg) return false;
    int wgid = L; { const int q = nwg / NXCD, r = nwg % NXCD, xcd = wgid % NXCD, off = wgid / NXCD; wgid = (xcd < r ? xcd * (q + 1) : r * (q + 1) + (xcd - r) * q) + off; }
    const int nig = WGM * nN, gid = wgid / nig, fm = gid * WGM, gsz = (nM - fm) < WGM ? (nM - fm) : WGM;
    pm = fm + ((wgid % nig) % gsz); pn = (wgid % nig) / gsz; return true;
}

constexpr int EXCH_OFF = STAGE_BYTES + 8192;
DI void epi_bar() { asm volatile("s_waitcnt lgkmcnt(0)" ::: "memory"); __builtin_amdgcn_s_barrier(); asm volatile("" ::: "memory"); }

template <int NCH, int BAUX, bool SPLIT, bool FP8, class Sched, class Epi>
DI void gemm_phase(LAS unsigned char* lds, const Sched& S, const Epi& E) {
    const int tid = threadIdx.x, wid = __builtin_amdgcn_readfirstlane(tid >> 6), lane = tid & 63, wr = wid >> 2, wc = wid & 3, fr = lane & 15, fq = lane >> 4;
    const bool loader = SPLIT ? (wr == 0) : true, storer = SPLIT ? (wr == 1) : true;
    constexpr int NP = SPLIT ? 4 : 2, PSTEP = SPLIT ? 4 : 8, RSTEP = SPLIT ? 32 : 64;
    const int p0 = SPLIT ? wc : wid;
    int R0, C0; stage_rc(p0 * 1024 + lane * 16, R0, C0);
    const int sC = C0 * 2, sRb = (R0 & ~31) + perm32(R0 & 31);
    const int aoff = lds_byte(wr * 64 + fr, fq * 8), boff = lds_byte(wc * 32 + fr, fq * 8);
#define G8_SA(b, h) (((b) * 2 + (h)) * HTB)
#define G8_SB(b, h) ((4 + (b) * 2 + (h)) * HTB)
#define G8_STAGE_A(bufoff, gbase, voff) do { if (loader) { _Pragma("unroll") for (int _i = 0; _i < NP; ++_i) \
        __builtin_amdgcn_global_load_lds((const unsigned*)((const char*)(gbase) + (voff)[_i]), (LAS unsigned*)(lds + (bufoff) + (p0 + PSTEP * _i) * 1024), 16, 0, 0); } } while (0)
#define G8_STAGE_B(bufoff, gbase, voff, ldb32) do { if (loader) { _Pragma("unroll") for (int _i = 0; _i < NP; ++_i) { \
        const char* _gb = (const char*)(gbase) + (size_t)_i * (ldb32); asm volatile("" : "+s"(_gb));     \
        __builtin_amdgcn_global_load_lds((const unsigned*)(_gb + (voff)), (LAS unsigned*)(lds + (bufoff) + (p0 + PSTEP * _i) * 1024), 16, 0, BAUX); } } } while (0)
#define G8_LDA(dst, b, h) do { _Pragma("unroll") for (int m = 0; m < 4; ++m) _Pragma("unroll") for (int k = 0; k < 2; ++k) dst[m][k] = *(const LAS bf16x8*)(lds + G8_SA(b, h) + aoff + m * 2048 + k * 1024); } while (0)
#define G8_LDB(dst, b, h) do { _Pragma("unroll") for (int n = 0; n < 2; ++n) _Pragma("unroll") for (int k = 0; k < 2; ++k) dst[n][k] = *(const LAS bf16x8*)(lds + G8_SB(b, h) + boff + n * 2048 + k * 1024); } while (0)
#define G8_MMA(ai, bj, At, Bt) do { __builtin_amdgcn_s_setprio(1); _Pragma("unroll") for (int m = 0; m < 4; ++m) _Pragma("unroll") for (int n = 0; n < 2; ++n) { \
        if (!FP8) { _Pragma("unroll") for (int k = 0; k < 2; ++k) acc[ai][bj][m][n] = __builtin_amdgcn_mfma_f32_16x16x32_bf16(Bt[n][k], At[m][k], acc[ai][bj][m][n], 0, 0, 0); } \
        else { const i32x8 _w = __builtin_bit_cast(i32x8, __builtin_shufflevector(Bt[n][0], Bt[n][1], 0, 1, 2, 3, 4, 5, 6, 7, 8, 9, 10, 11, 12, 13, 14, 15)); \
               const i32x8 _x = __builtin_bit_cast(i32x8, __builtin_shufflevector(At[m][0], At[m][1], 0, 1, 2, 3, 4, 5, 6, 7, 8, 9, 10, 11, 12, 13, 14, 15)); \
               acc[ai][bj][m][n] = __builtin_amdgcn_mfma_scale_f32_16x16x128_f8f6f4(_w, _x, acc[ai][bj][m][n], 0, 0, 0, W8_MX, 0, A8_MX); } } \
        __builtin_amdgcn_s_setprio(0); } while (0)
#define G8_WAIT_V8 do { if (SPLIT) { if (loader) asm volatile("s_waitcnt vmcnt(8)" ::: "memory"); } else asm volatile("s_waitcnt vmcnt(4)" ::: "memory"); } while (0)
#define G8_WAIT_V12 do { if (SPLIT) { if (loader) asm volatile("s_waitcnt vmcnt(12)" ::: "memory"); } else asm volatile("s_waitcnt vmcnt(6)" ::: "memory"); } while (0)
#define G8_WAIT_V0 do { if (loader) asm volatile("s_waitcnt vmcnt(0)" ::: "memory"); } while (0)
#define G8_WAIT_L(n) asm volatile("s_waitcnt lgkmcnt(" #n ")" ::: "memory")
#define G8_BAR __builtin_amdgcn_s_barrier()
#define G8_SCHED __builtin_amdgcn_sched_barrier(0)
#define G8_OFFS(u, vA, vB) do { if (loader) { _Pragma("unroll") for (int _h = 0; _h < 2; ++_h) _Pragma("unroll") for (int _i = 0; _i < NP; ++_i) \
        vA[_h][_i] = (unsigned)S.arow(u, _h * 128 + R0 + RSTEP * _i) * (unsigned)(u).lda + (unsigned)sC; \
        vB = (unsigned)sRb * (unsigned)(u).ldb + (unsigned)sC; } } while (0)
    Unit cur, nxt; int ui = 0;
    if (!S.next(0, cur)) return;
    f32x4 acc[2][2][4][2];
#pragma unroll
    for (int a = 0; a < 2; ++a)
#pragma unroll
        for (int b = 0; b < 2; ++b)
#pragma unroll
            for (int m = 0; m < 4; ++m)
#pragma unroll
                for (int n = 0; n < 2; ++n) acc[a][b][m][n] = (f32x4){0.f, 0.f, 0.f, 0.f};
    bf16x8 At[4][2], B0[2][2], B1[2][2];
    unsigned vA[2][NP], vB = 0u;
#pragma unroll
    for (int i = 0; i < NP; ++i) { vA[0][i] = 0u; vA[1][i] = 0u; }
    if (S.prefetch(cur, wid, lane)) { G8_WAIT_V0; G8_BAR; }
    G8_OFFS(cur, vA, vB);
    const char* cA = cur.A; const char* cB = cur.B; size_t hB = (size_t)128 * cur.ldb; size_t q32 = (size_t)RSTEP * cur.ldb;
    constexpr size_t kstep = 128;
    G8_STAGE_B(G8_SB(0, 0), cB, vB, q32); G8_STAGE_A(G8_SA(0, 0), cA, vA[0]); G8_STAGE_B(G8_SB(0, 1), cB + hB, vB, q32); G8_STAGE_A(G8_SA(0, 1), cA, vA[1]);
    if (wr == 1) G8_BAR;
    G8_WAIT_V8; G8_BAR;
    G8_STAGE_B(G8_SB(1, 0), cB + kstep, vB, q32); G8_STAGE_A(G8_SA(1, 0), cA + kstep, vA[0]); G8_STAGE_B(G8_SB(1, 1), cB + hB + kstep, vB, q32);
    G8_WAIT_V12; G8_BAR;
    for (;;) {
        bool has_next = false;
        const char* nA = cA; const char* nB = cB; size_t nhB = hB, nq32 = q32;
        const int nt = cur.nt;
#pragma unroll 1
        for (int t = 0; t < nt; t += 2) {
            const bool last = (t == nt - 2);
            const char* a1 = cA + (size_t)(t + 1) * kstep;
            G8_LDB(B0, 0, 0); G8_SCHED; G8_LDA(At, 0, 0); G8_STAGE_A(G8_SA(1, 1), a1, vA[1]);
            G8_WAIT_L(8); G8_BAR; G8_WAIT_L(0); G8_MMA(0, 0, At, B0); G8_BAR; G8_SCHED;
            if (t == 0) { Unit pf; if (S.next(ui + 1, pf)) (void)S.prefetch(pf, wid, lane); }
            const char* a2; const char* b2; size_t h2, q2;
            if (last) {
                has_next = S.next(ui + 1, nxt);
                if (has_next) { G8_OFFS(nxt, vA, vB); nA = nxt.A; nB = nxt.B; nhB = (size_t)128 * nxt.ldb; nq32 = (size_t)RSTEP * nxt.ldb; }
                a2 = nA; b2 = nB; h2 = nhB; q2 = nq32;
            } else { a2 = cA + (size_t)(t + 2) * kstep; b2 = cB + (size_t)(t + 2) * kstep; h2 = hB; q2 = q32; }
            const char* a3 = a2 + kstep; const char* b3 = b2 + kstep;
            G8_LDB(B1, 0, 1); G8_STAGE_B(G8_SB(0, 0), b2, vB, q2);
            G8_BAR; G8_WAIT_L(0); G8_MMA(0, 1, At, B1); G8_BAR;
            G8_LDA(At, 0, 1); G8_STAGE_A(G8_SA(0, 0), a2, vA[0]);
            G8_BAR; G8_WAIT_L(0); G8_MMA(1, 0, At, B0); G8_BAR; G8_SCHED;
            G8_STAGE_B(G8_SB(0, 1), b2 + h2, vB, q2);
            G8_WAIT_V12; G8_BAR; G8_MMA(1, 1, At, B1); G8_BAR;
            G8_LDB(B0, 1, 0); G8_SCHED; G8_LDA(At, 1, 0); G8_STAGE_A(G8_SA(0, 1), a2, vA[1]);
            G8_WAIT_L(8); G8_BAR; G8_WAIT_L(0); G8_MMA(0, 0, At, B0); G8_BAR; G8_SCHED;
            G8_LDB(B1, 1, 1); G8_STAGE_B(G8_SB(1, 0), b3, vB, q2);
            G8_BAR; G8_WAIT_L(0); G8_MMA(0, 1, At, B1); G8_BAR;
            G8_LDA(At, 1, 1); G8_STAGE_A(G8_SA(1, 0), a3, vA[0]);
            G8_BAR; G8_WAIT_L(0); G8_MMA(1, 0, At, B0); G8_BAR; G8_SCHED;
            G8_STAGE_B(G8_SB(1, 1), b3 + h2, vB, q2);
            G8_WAIT_V12; G8_BAR; G8_MMA(1, 1, At, B1); G8_BAR;
        }
        int tz = threadIdx.x; asm volatile("" : "+v"(tz));
        const int lane_e = tz & 63, fr_e = tz & 15, fq_e = (tz >> 4) & 3;
        {
            E.pre(acc, cur, wr, wc, fr_e, fq_e);
            constexpr int PITCH = NCH * 16 + 16;
            LAS unsigned char* ex = lds + EXCH_OFF;
            if (wr == 0) G8_BAR;
            if constexpr (Epi::OUT8) {
                constexpr int RB = NCH * 8, P8 = RB + 16;
#pragma unroll
                for (int ai = 0; ai < 2; ++ai)
#pragma unroll
                    for (int mh = 0; mh < 2; ++mh) {
#pragma unroll
                        for (int mm = 0; mm < 2; ++mm) {
                            u32x2 o8[2];
                            E.row8(acc, cur, ai, 2 * mh + mm, wr, wc, fr_e, fq_e, o8);
                            LAS unsigned char* rp = ex + (mm * 32 + wr * 16 + fr_e) * P8 + wc * 32 + 8 * fq_e;
                            *(LAS u32x2*)rp = o8[0];
                            if (NCH == 32) *(LAS u32x2*)(rp + 128) = o8[1];
                        }
                        epi_bar();
                        {
                            constexpr int CPR = RB / 16, RPI = 64 / CPR;
#pragma unroll
                            for (int i = 0; i < 8 / RPI; ++i) {
                                const int rl = 8 * wid + RPI * i + lane_e / CPR, ch = lane_e % CPR;
                                const int rt = ai * 128 + ((rl >> 4) & 1) * 64 + (2 * mh + (rl >> 5)) * 16 + (rl & 15);
                                const u32x4 d = *(const LAS u32x4*)(ex + rl * P8 + ch * 16);
                                E.store8(cur, rt, ch, d);
                            }
                        }
                        epi_bar();
                    }
            } else
#pragma unroll
            for (int ai = 0; ai < 2; ++ai)
#pragma unroll
                for (int m = 0; m < 4; ++m) {
                    u32x4 o[2];
                    E.row(acc, cur, ai, m, wr, wc, fr_e, fq_e, o);
                    if (NCH == 32) {
                        *(LAS u32x4*)(ex + (wr * 16 + fr_e) * PITCH + (wc * 32 + 8 * fq_e) * 2) = o[0];
                        *(LAS u32x4*)(ex + (wr * 16 + fr_e) * PITCH + (128 + wc * 32 + 8 * fq_e) * 2) = o[1];
                    } else {
                        *(LAS u32x4*)(ex + (wr * 16 + fr_e) * PITCH + (wc * 32 + 8 * fq_e) * 2) = o[0];
                    }
                    epi_bar();
                    if (storer) {
                        constexpr int RPI = 64 / NCH;
                        constexpr int RPW = SPLIT ? 8 : 4;
                        const int rbase = SPLIT ? 8 * wc : 4 * wid;
#pragma unroll
                        for (int i = 0; i < RPW / RPI; ++i) {
                            const int rl = rbase + RPI * i + lane_e / NCH, ch = lane_e % NCH;
                            const int rt = ai * 128 + (rl >> 4) * 64 + m * 16 + (rl & 15);
                            const u32x4 d = *(const LAS u32x4*)(ex + rl * PITCH + ch * 16);
                            E.store(cur, rt, ch, d);
                        }
                    }
                    epi_bar();
                }
            if (wr == 1) G8_BAR;
        }
        if (!has_next) break;
#pragma unroll
        for (int a = 0; a < 2; ++a)
#pragma unroll
            for (int b = 0; b < 2; ++b)
#pragma unroll
                for (int m = 0; m < 4; ++m)
#pragma unroll
                    for (int n = 0; n < 2; ++n) acc[a][b][m][n] = (f32x4){0.f, 0.f, 0.f, 0.f};
        cur = nxt; cA = nA; cB = nB; hB = nhB; q32 = nq32; ++ui;
    }
    G8_WAIT_V0;
    if (wr == 0) G8_BAR;
    G8_BAR;
#undef G8_SA
#undef G8_SB
#undef G8_STAGE_A
#undef G8_STAGE_B
#undef G8_LDA
#undef G8_LDB
#undef G8_MMA
#undef G8_WAIT_V8
#undef G8_WAIT_V12
#undef G8_WAIT_V0
#undef G8_WAIT_L
#undef G8_BAR
#undef G8_SCHED
#undef G8_OFFS
}
}

struct DenseSched {
    const char* A; const char* Bt; int nM, nN, lda, ldb, nt, G, c; int sel = 0;
    DI bool next(int i, g8::Unit& u) const {
        int pm, pn; if (!g8::static_tile(i * G + c, nM, nN, pm, pn)) return false;
        pm = __builtin_amdgcn_readfirstlane(pm); pn = __builtin_amdgcn_readfirstlane(pn);
        if (sel == 2) pn = pn + 30;
        u.A = A; u.B = Bt + (size_t)pn * 256 * ldb; u.row0 = pm * 256; u.lda = lda; u.ldb = ldb; u.nt = nt; u.pm = pm; u.pn = pn; u.aux = 0; u.keep = 0; u.e = 0; u.nvalid = 256; u.par = 0; return true;
    }
    DI int arow(const g8::Unit& u, int rr) const { return u.row0 + rr; }
    DI bool prefetch(const g8::Unit&, int, int) const { return false; }
};
constexpr int MOE_TAB_OFF = g8::STAGE_BYTES;
constexpr int MOE_TILE_OFF = g8::STAGE_BYTES + 1024;
constexpr int MOE_IDX_OFF = g8::STAGE_BYTES + 2048;
struct MoeSched {
    LAS unsigned char* lds; const int* list; const float* listw; const char* A; const char* W; int ncol, mode  , G, c;
    DI bool next(int i, g8::Unit& u) const {
        const LAS int* tpre = (const LAS int*)(lds + MOE_TAB_OFF);
        const int L = i * G + c; const int T = __builtin_amdgcn_readfirstlane(tpre[NEX]);
        if (L >= T * ncol) return false;
        const int gt = __builtin_amdgcn_readfirstlane(L / ncol), pn = L - gt * ncol;
        const int e = __builtin_amdgcn_readfirstlane((int)*(const LAS unsigned char*)(lds + MOE_TILE_OFF + gt));
        const int tile = gt - __builtin_amdgcn_readfirstlane(tpre[e]);
        const int n_e = __builtin_amdgcn_readfirstlane(tpre[NEX + 1 + e]);
        u.e = e; u.pm = tile; u.pn = pn; u.nvalid = min(256, n_e - tile * 256); u.keep = 0; u.aux = gt * 256; u.par = i & 1;
        if (mode == 0) { u.A = A; u.lda = 2048; u.ldb = 2048; u.nt = 16; u.B = W + ((size_t)e * 1024 + (size_t)pn * 256) * 2048; u.row0 = tile * 256; }
        else { u.A = A; u.lda = 512; u.ldb = 512; u.nt = 4; u.B = W + ((size_t)e * 2048 + (size_t)pn * 256) * 512; u.row0 = gt * 256; }
        return true;
    }
    DI bool prefetch(const g8::Unit& u, int wid, int lane) const {
        if (u.e < NE && wid < 4) {
            const int r = min(wid * 64 + lane, u.nvalid - 1);
            const size_t src = (size_t)u.e * LIST_CAP + u.pm * 256 + r;
            __builtin_amdgcn_global_load_lds((const unsigned*)(list + src), (LAS unsigned*)(lds + MOE_IDX_OFF + u.par * 2048 + wid * 256), 4, 0, 0);
            if (mode == 1) __builtin_amdgcn_global_load_lds((const unsigned*)(listw + src), (LAS unsigned*)(lds + MOE_IDX_OFF + u.par * 2048 + 1024 + wid * 256), 4, 0, 0);
        }
        return true;
    }
    DI int arow(const g8::Unit& u, int rr) const {
        if (mode == 1) return u.row0 + rr;
        if (u.e >= NE) return u.row0 + rr;
        return *(const LAS int*)(lds + MOE_IDX_OFF + u.par * 2048 + rr * 4) / 9;
    }
};

typedef f32x4 (&AccRef)[2][2][4][2];
DI u32x4 pack8(const f32x4& v0, const f32x4& v1) { u32x4 w; w.x = pk_bf16(v0[0], v0[1]); w.y = pk_bf16(v0[2], v0[3]); w.z = pk_bf16(v1[0], v1[1]); w.w = pk_bf16(v1[2], v1[3]); return w; }

struct EpiInProj { static constexpr bool OUT8 = false;
    bf16_t* proj; const float* rope;
    DI static int kind_of(int pn) { return pn < 6 ? 0 : pn < 12 ? 1 : pn < 18 ? 2 : pn < 22 ? 3 : pn < 30 ? 2 : 4; }
    DI void pre(AccRef acc, const g8::Unit& u, int wr, int wc, int fr, int fq) const {
        if (kind_of(u.pn) <= 1 && wc == 0) {
            const float sg = (fq < 2) ? -1.0f : 1.0f;
#pragma unroll
            for (int g = 0; g < 4; ++g) {
                const int ai = g >> 1;
                f32x4 cs[2][4];
#pragma unroll
                for (int mm = 0; mm < 2; ++mm) { const int m = (g & 1) * 2 + mm; const int row = u.pm * 256 + ai * 128 + wr * 64 + m * 16 + fr;
#pragma unroll
                    for (int q = 0; q < 4; ++q) cs[mm][q] = *(const f32x4*)(rope + (size_t)row * 32 + 16 * (fq & 1) + 4 * q); }
#pragma unroll
                for (int mm = 0; mm < 2; ++mm) { const int m = (g & 1) * 2 + mm;
#pragma unroll
                    for (int bj = 0; bj < 2; ++bj) {
                        f32x4 v0 = acc[ai][bj][m][0], v1 = acc[ai][bj][m][1], p0, p1;
#pragma unroll
                        for (int j = 0; j < 4; ++j) { p0[j] = __shfl_xor(v0[j], 32); p1[j] = __shfl_xor(v1[j], 32); }
#pragma unroll
                        for (int j = 0; j < 4; ++j) {
                            const float c0 = cs[mm][j >> 1][(j & 1) * 2], s0 = cs[mm][j >> 1][(j & 1) * 2 + 1];
                            const float c1 = cs[mm][2 + (j >> 1)][(j & 1) * 2], s1 = cs[mm][2 + (j >> 1)][(j & 1) * 2 + 1];
                            v0[j] = v0[j] * c0 + sg * p0[j] * s0;
                            v1[j] = v1[j] * c1 + sg * p1[j] * s1;
                        }
                        acc[ai][bj][m][0] = v0; acc[ai][bj][m][1] = v1;
                    }
                    asm volatile("" : "+v"(acc[ai][0][m][0]), "+v"(acc[ai][0][m][1]), "+v"(acc[ai][1][m][0]), "+v"(acc[ai][1][m][1]));
                }
                asm volatile("" ::: "memory");
            }
        }
    }
    DI void row(AccRef acc, const g8::Unit& u, int ai, int m, int wr, int wc, int fr, int fq, u32x4 (&o)[2]) const {
        const int kind = kind_of(u.pn);
#pragma unroll
        for (int bj = 0; bj < 2; ++bj) {
            f32x4 v0 = acc[ai][bj][m][0], v1 = acc[ai][bj][m][1];
            if (kind == 0 || kind == 3) { v0 *= QSCALE; v1 *= QSCALE; }
            if (kind == 4) {
#pragma unroll
                for (int j = 0; j < 4; ++j) { v0[j] = sigmoidf_(v0[j]); v1[j] = sigmoidf_(v1[j]); }
            }
            o[bj] = pack8(v0, v1);
        }
    }
    DI void store(const g8::Unit& u, int rt, int ch, const u32x4& d) const { __builtin_nontemporal_store(d, (u32x4*)(proj + (size_t)(u.pm * 256 + rt) * DIN + u.pn * 256 + ch * 8)); }
};
template <int PART> struct EpiGate { static constexpr bool OUT8 = false;
    const bf16_t* proj; const bf16_t* tmp; bf16_t* out;
    DI void pre(AccRef acc, const g8::Unit& u, int wr, int wc, int fr, int fq) const {
        const unsigned vo_g = (unsigned)(((wr * 64 + fr) * DIN + wc * 32 + 8 * fq) * 2), vo_t = (unsigned)(((wr * 64 + fr) * DM + wc * 32 + 8 * fq) * 2);
#pragma unroll
        for (int ai = 0; ai < 2; ++ai)
#pragma unroll
            for (int m = 0; m < 4; ++m) {
#pragma unroll
                for (int bj = 0; bj < 2; ++bj) {
                    gcptr sg = (gcptr)(proj + (size_t)(u.pm * 256 + ai * 128 + m * 16) * DIN + u.pn * 256 + bj * 128 + (PART == 0 ? COL_GD : COL_GS));
                    asm volatile("" : "+s"(sg));
                    const u32x4 gg = *(gu4ptr)(sg + vo_g);
                    const float sv[8] = {bf_lo(gg.x), bf_hi(gg.x), bf_lo(gg.y), bf_hi(gg.y), bf_lo(gg.z), bf_hi(gg.z), bf_lo(gg.w), bf_hi(gg.w)};
                    if (PART == 0) {
#pragma unroll
                        for (int j = 0; j < 4; ++j) { acc[ai][bj][m][0][j] *= sv[j]; acc[ai][bj][m][1][j] *= sv[4 + j]; }
                    } else {
                        gcptr st = (gcptr)(tmp + (size_t)(u.pm * 256 + ai * 128 + m * 16) * DM + u.pn * 256 + bj * 128);
                        asm volatile("" : "+s"(st));
                        const u32x4 tt = *(gu4ptr)(st + vo_t);
                        const float tv[8] = {bf_lo(tt.x), bf_hi(tt.x), bf_lo(tt.y), bf_hi(tt.y), bf_lo(tt.z), bf_hi(tt.z), bf_lo(tt.w), bf_hi(tt.w)};
#pragma unroll
                        for (int j = 0; j < 4; ++j) { acc[ai][bj][m][0][j] = acc[ai][bj][m][0][j] * sv[j] + tv[j]; acc[ai][bj][m][1][j] = acc[ai][bj][m][1][j] * sv[4 + j] + tv[4 + j]; }
                    }
                }
                asm volatile("" : "+v"(acc[ai][0][m][0]), "+v"(acc[ai][0][m][1]), "+v"(acc[ai][1][m][0]), "+v"(acc[ai][1][m][1]));
                if (m & 1) asm volatile("" ::: "memory");
            }
    }
    DI void row(AccRef acc, const g8::Unit&, int ai, int m, int, int, int, int, u32x4 (&o)[2]) const {
        o[0] = pack8(acc[ai][0][m][0], acc[ai][0][m][1]); o[1] = pack8(acc[ai][1][m][0], acc[ai][1][m][1]);
    }
    DI void store(const g8::Unit& u, int rt, int ch, const u32x4& d) const { *(u32x4*)(out + (size_t)(u.pm * 256 + rt) * DM + u.pn * 256 + ch * 8) = d; }
};
struct EpiPlain { static constexpr bool OUT8 = false;
    bf16_t* out; int ld;
    DI void pre(AccRef, const g8::Unit&, int, int, int, int) const {}
    DI void row(AccRef acc, const g8::Unit&, int ai, int m, int, int, int, int, u32x4 (&o)[2]) const {
        o[0] = pack8(acc[ai][0][m][0], acc[ai][0][m][1]); o[1] = pack8(acc[ai][1][m][0], acc[ai][1][m][1]);
    }
    DI void store(const g8::Unit& u, int rt, int ch, const u32x4& d) const { *(u32x4*)(out + (size_t)(u.pm * 256 + rt) * ld + u.pn * 256 + ch * 8) = d; }
};
struct EpiGateUp { static constexpr bool OUT8 = true;
    unsigned char* hid;
    DI void pre(AccRef, const g8::Unit&, int, int, int, int) const {}
    DI void row(AccRef, const g8::Unit&, int, int, int, int, int, int, u32x4 (&)[2]) const {}
    DI void store(const g8::Unit&, int, int, const u32x4&) const {}
    DI void row8(AccRef acc, const g8::Unit&, int ai, int m, int, int, int, int, u32x2 (&o)[2]) const {
        const f32x4 g0 = acc[ai][0][m][0], g1 = acc[ai][0][m][1], u0 = acc[ai][1][m][0], u1 = acc[ai][1][m][1];
        f32x4 v0, v1;
#pragma unroll
        for (int j = 0; j < 4; ++j) { v0[j] = g0[j] * __builtin_amdgcn_rcpf(1.0f + __expf(-g0[j])) * u0[j]; v1[j] = g1[j] * __builtin_amdgcn_rcpf(1.0f + __expf(-g1[j])) * u1[j]; }
        o[0].x = pk_fp8x4(v0[0], v0[1], v0[2], v0[3]); o[0].y = pk_fp8x4(v1[0], v1[1], v1[2], v1[3]); o[1] = o[0];
    }
    DI void store8(const g8::Unit& u, int rt, int ch, const u32x4& d) const { *(u32x4*)(hid + (size_t)(u.aux + rt) * DE + u.pn * 128 + ch * 16) = d; }
};
struct EpiDown { static constexpr bool OUT8 = true;
    LAS unsigned char* lds; unsigned char* yb9; int* slot;
    DI void pre(AccRef, const g8::Unit&, int, int, int, int) const {}
    DI void row(AccRef, const g8::Unit&, int, int, int, int, int, int, u32x4 (&)[2]) const {}
    DI void store(const g8::Unit&, int, int, const u32x4&) const {}
    DI void row8(AccRef acc, const g8::Unit& u, int ai, int m, int wr, int, int fr, int, u32x2 (&o)[2]) const {
        const int rt = ai * 128 + wr * 64 + m * 16 + fr;
        const float wgt = (u.e < NE) ? *(const LAS float*)(lds + MOE_IDX_OFF + u.par * 2048 + 1024 + rt * 4) : 1.0f;
#pragma unroll
        for (int bj = 0; bj < 2; ++bj) {
            const f32x4 v0 = acc[ai][bj][m][0] * wgt, v1 = acc[ai][bj][m][1] * wgt;
            o[bj].x = pk_fp8x4(v0[0], v0[1], v0[2], v0[3]); o[bj].y = pk_fp8x4(v1[0], v1[1], v1[2], v1[3]);
        }
    }
    DI void store8(const g8::Unit& u, int rt, int ch, const u32x4& d) const {
        if (rt < u.nvalid) {
            const int srow = u.aux + rt;
            __builtin_nontemporal_store(d, (u32x4*)(yb9 + ((size_t)u.pn * YB_SLOTS + srow) * 256 + ch * 16));
            if (u.pn == 0 && ch == 0) {
                const int v = (u.e < NE) ? *(const LAS int*)(lds + MOE_IDX_OFF + u.par * 2048 + rt * 4) : (u.pm * 256 + rt) * 9 + 8;
                slot[v] = srow;
            }
        }
    }
};

DI void phase_inproj(const Params& p, LAS unsigned char* lds) {
    EpiInProj E{(bf16_t*)(p.ws + WS_PROJ), (const float*)(p.ws + WS_ROPE)};
    { DenseSched S{(const char*)(p.ws + WS_H), (const char*)(p.ws + WS_WTIN), 64, 30, 4096, 4096, 32, (int)gridDim.x, (int)blockIdx.x, 1};
      g8::gemm_phase<32, 0, GEMM_SPLIT, false>(lds, S, E); }
    { DenseSched S{(const char*)(p.ws + WS_H8), (const char*)(p.ws + WS_WTIN8), 64, 16, 2048, 2048, 16, (int)gridDim.x, (int)blockIdx.x, 2};
      g8::gemm_phase<32, 0, GEMM_SPLIT, true>(lds, S, E); }
}
DI void phase_outproj_a(const Params& p, LAS unsigned char* lds) {
    DenseSched S{(const char*)(p.ws + WS_ODIL), (const char*)(p.ws + WS_WTDIL), 64, 8, 1024, 1024, 8, (int)gridDim.x, (int)blockIdx.x};
    EpiGate<0> E{(const bf16_t*)(p.ws + WS_PROJ), nullptr, (bf16_t*)(p.ws + WS_TMP)};
    g8::gemm_phase<32, 0, GEMM_SPLIT, false>(lds, S, E);
}
DI void phase_outproj_b(const Params& p, LAS unsigned char* lds) {
    DenseSched S{(const char*)(p.ws + WS_OSB), (const char*)(p.ws + WS_WTSB), 64, 8, 2048, 2048, 16, (int)gridDim.x, (int)blockIdx.x};
    EpiGate<1> E{(const bf16_t*)(p.ws + WS_PROJ), (const bf16_t*)(p.ws + WS_TMP), (bf16_t*)(p.ws + WS_H)};
    g8::gemm_phase<32, 0, GEMM_SPLIT, false>(lds, S, E);
}
DI void phase_mixout(const Params& p, LAS unsigned char* lds) {
    DenseSched S{(const char*)(p.ws + WS_H), (const char*)(p.ws + WS_WTMIX), 64, 8, 4096, 4096, 32, (int)gridDim.x, (int)blockIdx.x};
    EpiPlain E{(bf16_t*)(p.ws + WS_Y), DM};
    g8::gemm_phase<32, 0, GEMM_SPLIT, false>(lds, S, E);
}
DI void moe_tables(const Params& p, LAS unsigned char* lds) {
    LAS int* tpre = (LAS int*)(lds + MOE_TAB_OFF);
    const int* cnt = (const int*)(p.ws + WS_CNT);
    if (threadIdx.x == 0) {
        int acc = 0;
        for (int e = 0; e < NE; ++e) { const int n = cnt[e]; tpre[e] = acc; tpre[NEX + 1 + e] = n; acc += (n + 255) >> 8; }
        tpre[NE] = acc; tpre[NEX + 1 + NE] = NTOK; acc += NTOK / 256; tpre[NEX] = acc;
    }
    __syncthreads();
    const int T = tpre[NEX];
    for (int t = threadIdx.x; t < T; t += 512) {
        int e = 0;
        for (int q = 1; q < NEX; ++q) e = (tpre[q] <= t) ? q : e;
        *(LAS unsigned char*)(lds + MOE_TILE_OFF + t) = (unsigned char)e;
    }
    __syncthreads();
}
DI void phase_gateup(const Params& p, LAS unsigned char* lds) {
    moe_tables(p, lds);
    MoeSched S{lds, (const int*)(p.ws + WS_LIST), (const float*)(p.ws + WS_LISTW), (const char*)(p.ws + WS_H), (const char*)(p.ws + WS_WGU), 4, 0, (int)gridDim.x, (int)blockIdx.x};
    EpiGateUp E{(unsigned char*)(p.ws + WS_HID)};
    g8::gemm_phase<16, MOE_BAUX, GEMM_SPLIT, true>(lds, S, E);
}
DI void phase_down(const Params& p, LAS unsigned char* lds) {
    moe_tables(p, lds);
    MoeSched S{lds, (const int*)(p.ws + WS_LIST), (const float*)(p.ws + WS_LISTW), (const char*)(p.ws + WS_HID), (const char*)(p.ws + WS_WD), 8, 1, (int)gridDim.x, (int)blockIdx.x};
    EpiDown E{lds, (unsigned char*)(p.ws + WS_YB9), (int*)(p.ws + WS_SLOT)};
    g8::gemm_phase<32, MOE_BAUX, GEMM_SPLIT, true>(lds, S, E);
}

namespace att {
constexpr int TB = 16384;
DI unsigned off_b(unsigned row, unsigned ch) { return 256u * row + 16u * (ch ^ (((row & 3u) << 2) | ((row >> 2) & 3u))); }
DI int crow(int i, int h) { return (i & 3) + 8 * (i >> 2) + 4 * h; }
DI f32x16 mfma32(bf16x8 a, bf16x8 b, f32x16 c) { return __builtin_amdgcn_mfma_f32_32x32x16_bf16(a, b, c, 0, 0, 0); }
DI bf16x8 pack8(const f32x16& x, int s) {
    u32x4 w; w.x = pk_bf16(x[8 * s + 0], x[8 * s + 1]); w.y = pk_bf16(x[8 * s + 2], x[8 * s + 3]); w.z = pk_bf16(x[8 * s + 4], x[8 * s + 5]); w.w = pk_bf16(x[8 * s + 6], x[8 * s + 7]);
    return __builtin_bit_cast(bf16x8, w);
}
DI void qk_tile(LAS const unsigned char* Kb, const bf16x8 (&qf)[8], f32x16& x0, f32x16& x1, int r, int h) {
#pragma unroll
    for (int i = 0; i < 16; ++i) { x0[i] = 0.f; x1[i] = 0.f; }
#pragma unroll
    for (int s = 0; s < 8; ++s) {
        const bf16x8 a0 = *(const LAS bf16x8*)(Kb + off_b(r, 2 * s + h));
        const bf16x8 a1 = *(const LAS bf16x8*)(Kb + off_b(32 + r, 2 * s + h));
        x0 = mfma32(a0, qf[s], x0); x1 = mfma32(a1, qf[s], x1);
    }
}
DI void pv_tile(LAS const unsigned char* Vb, const f32x16& p0, const f32x16& p1, f32x16 (&o)[4], int lane) {
    const int h = lane >> 5, blk = (lane >> 4) & 1, q = (lane & 15) >> 2, pp = lane & 3;
#pragma unroll
    for (int kb = 0; kb < 2; ++kb)
#pragma unroll
        for (int s = 0; s < 2; ++s) {
            const bf16x8 pf = pack8(kb ? p1 : p0, s);
#pragma unroll
            for (int db = 0; db < 4; ++db) {
                const unsigned row0 = 32 * kb + 16 * s + 4 * h + q;
                const unsigned ch = 4 * db + 2 * blk + (pp >> 1);
                const s16x4 t0 = __builtin_amdgcn_ds_read_tr16_b64_v4i16((LAS s16x4*)(Vb + off_b(row0, ch) + 8 * (pp & 1)));
                const s16x4 t1 = __builtin_amdgcn_ds_read_tr16_b64_v4i16((LAS s16x4*)(Vb + off_b(row0 + 8, ch) + 8 * (pp & 1)));
                const bf16x8 vf = {t0[0], t0[1], t0[2], t0[3], t1[0], t1[1], t1[2], t1[3]};
                o[db] = mfma32(vf, pf, o[db]);
            }
        }
}
DI void store_o(bf16_t* orow, const f32x16 (&o)[4], float scale, int h) {
#pragma unroll
    for (int db = 0; db < 4; ++db)
#pragma unroll
        for (int g = 0; g < 4; ++g) {
            u32x2 w; w.x = pk_bf16(o[db][4 * g] * scale, o[db][4 * g + 1] * scale); w.y = pk_bf16(o[db][4 * g + 2] * scale, o[db][4 * g + 3] * scale);
            *(u32x2*)(orow + 32 * db + 8 * g + 4 * h) = w;
        }
}

DI void sb_item(const Params& p, LAS unsigned char* lds, int b, int hd, int Q) {
    const bf16_t* proj = (const bf16_t*)(p.ws + WS_PROJ);
    bf16_t* osb = (bf16_t*)(p.ws + WS_OSB);
    const int tid = threadIdx.x, wid = __builtin_amdgcn_readfirstlane(tid >> 6), lane = tid & 63, r = lane & 31, h = lane >> 5;
    const size_t tokbase = (size_t)b * SEQ;
    const int wq0 = Q * 256 + 32 * wid;
    const int myq = wq0 + r;
    bf16x8 qf[8];
    f32x16 o[4];
#pragma unroll
    for (int db = 0; db < 4; ++db)
#pragma unroll
        for (int i = 0; i < 16; ++i) o[db][i] = 0.f;
    float R = 0.f;
    unsigned goff[2];
#pragma unroll
    for (int i = 0; i < 2; ++i) { const unsigned row = 4 * (wid * 2 + i) + (lane >> 4), cp = lane & 15, ch = cp ^ (((row & 3u) << 2) | ((row >> 2) & 3u)); goff[i] = (row * DIN + ch * 8) * 2; }
    const char* kbase = (const char*)(proj + tokbase * DIN + COL_KS + hd * 128);
    const char* vbase = (const char*)(proj + tokbase * DIN + COL_VS + hd * 128);
#define ATT_ISSUE(key0_, buf_) do { const size_t _ko = (size_t)(key0_) * DIN * 2; _Pragma("unroll") for (int _i = 0; _i < 2; ++_i) { \
        __builtin_amdgcn_global_load_lds((const unsigned*)(kbase + _ko + goff[_i]), (LAS unsigned*)(lds + (buf_) * TB + 1024 * (wid * 2 + _i)), 16, 0, 0); \
        __builtin_amdgcn_global_load_lds((const unsigned*)(vbase + _ko + goff[_i]), (LAS unsigned*)(lds + 3 * TB + (buf_) * TB + 1024 * (wid * 2 + _i)), 16, 0, 0); } } while (0)
    int j = 4 * Q + 3;
    ATT_ISSUE(64 * j, 0);
    ATT_ISSUE(64 * (j - 1), 1);
    {
        const bf16_t* qrow = proj + (tokbase + myq) * DIN + COL_QS + hd * 128;
#pragma unroll
        for (int s = 0; s < 8; ++s) qf[s] = *(const bf16x8*)(qrow + 16 * s + 8 * h);
#pragma unroll
        for (int s = 0; s < 8; ++s) asm volatile("" : "+v"(qf[s]));
    }
    int cur = 0;
    for (; j >= 0; --j) {
        LAS unsigned char* Kb = lds + cur * TB; LAS unsigned char* Vb = lds + 3 * TB + cur * TB;
        if (j > 0) asm volatile("s_waitcnt vmcnt(4)" ::: "memory"); else asm volatile("s_waitcnt vmcnt(0)" ::: "memory");
        __builtin_amdgcn_s_barrier(); asm volatile("" ::: "memory");
        if (j > 1) ATT_ISSUE(64 * (j - 2), cur == 0 ? 2 : cur - 1);
        const int key0 = 64 * j;
        if (key0 < wq0 + 31) {
            const bool need_mask = (key0 + 63 >= wq0);
            f32x16 x0, x1;
            qk_tile(Kb, qf, x0, x1, r, h);
            f32x16 l0, l1;
#pragma unroll
            for (int i = 0; i < 16; ++i) {
                l0[i] = __builtin_amdgcn_logf(1.0f + __builtin_amdgcn_exp2f(x0[i]));
                l1[i] = __builtin_amdgcn_logf(1.0f + __builtin_amdgcn_exp2f(x1[i]));
            }
            if (need_mask) {
#pragma unroll
                for (int i = 0; i < 16; ++i) { const int kk = key0 + crow(i, h); if (kk >= myq) l0[i] = 0.f; if (kk + 32 >= myq) l1[i] = 0.f; }
            }
#pragma unroll
            for (int g = 0; g < 4; ++g) {
                l0[4 * g + 2] += l0[4 * g + 3]; l0[4 * g + 1] += l0[4 * g + 2]; l0[4 * g] += l0[4 * g + 1];
                l1[4 * g + 2] += l1[4 * g + 3]; l1[4 * g + 1] += l1[4 * g + 2]; l1[4 * g] += l1[4 * g + 1];
            }
            float Tlo[8], Thi[8];
#pragma unroll
            for (int g = 0; g < 4; ++g) {
                { const unsigned t = __float_as_uint(l0[4 * g]); auto sw = __builtin_amdgcn_permlane32_swap(t, t, false, false); Tlo[g] = __uint_as_float(sw[0]); Thi[g] = __uint_as_float(sw[1]); }
                { const unsigned t = __float_as_uint(l1[4 * g]); auto sw = __builtin_amdgcn_permlane32_swap(t, t, false, false); Tlo[4 + g] = __uint_as_float(sw[0]); Thi[4 + g] = __uint_as_float(sw[1]); }
            }
            float offR[8];
            float run = 0.f;
#pragma unroll
            for (int g = 7; g >= 0; --g) { offR[g] = run + (h == 0 ? Thi[g] : 0.f) + R; run += Tlo[g] + Thi[g]; }
            f32x16 p0, p1;
#pragma unroll
            for (int i = 0; i < 16; ++i) {
                p0[i] = __builtin_amdgcn_exp2f(x0[i] - (l0[i] + offR[i >> 2]));
                p1[i] = __builtin_amdgcn_exp2f(x1[i] - (l1[i] + offR[4 + (i >> 2)]));
            }
            if (need_mask) {
#pragma unroll
                for (int i = 0; i < 16; ++i) { const int kk = key0 + crow(i, h); if (kk >= myq) p0[i] = 0.f; if (kk + 32 >= myq) p1[i] = 0.f; }
            }
            R += run;
            pv_tile(Vb, p0, p1, o, lane);
        }
        cur = (cur == 2) ? 0 : cur + 1;
    }
    store_o(osb + (tokbase + myq) * 1024 + hd * 128, o, 1.0f, h);
    __syncthreads();
}

DI void dil_item(const Params& p, LAS unsigned char* lds, int di) {
    const bf16_t* proj = (const bf16_t*)(p.ws + WS_PROJ);
    bf16_t* og = (bf16_t*)(p.ws + WS_OG);
    float* lse = (float*)(p.ws + WS_LSE);
    const int b = di / 192; const int rem = di - b * 192; const int head = rem >> 4, sub = rem & 15;
    const int grp = head >> 2;
    const int dil = grp == 0 ? 1 : grp == 1 ? 4 : 16;
    const int nblk = 16 / dil;
    const int res = sub / nblk, Qb = sub - res * nblk;
    const int i0 = Qb * 256;
    const int tid = threadIdx.x, wid = __builtin_amdgcn_readfirstlane(tid >> 6), lane = tid & 63, r = lane & 31, h = lane >> 5;
    const size_t tokbase = (size_t)b * SEQ;
    const int wq0 = i0 + 32 * wid;
    const int myqi = wq0 + r;
    const size_t mytok = tokbase + (size_t)myqi * dil + res;
    bf16x8 qf[8];
    f32x16 o[4];
#pragma unroll
    for (int db = 0; db < 4; ++db)
#pragma unroll
        for (int i = 0; i < 16; ++i) o[db][i] = 0.f;
    float mrun = -1e30f, lrun = 0.f;
    unsigned goff[2];
#pragma unroll
    for (int i = 0; i < 2; ++i) { const unsigned row = 4 * (wid * 2 + i) + (lane >> 4), cp = lane & 15, ch = cp ^ (((row & 3u) << 2) | ((row >> 2) & 3u)); goff[i] = (row * dil * DIN + ch * 8) * 2; }
    const char* kbase = (const char*)(proj + (tokbase + res) * DIN + COL_KA + head * 128);
    const char* vbase = (const char*)(proj + (tokbase + res) * DIN + COL_VA + head * 128);
    const int jt0 = (i0 == 0) ? 2 : 0;
    ATT_ISSUE((i0 - 128 + 64 * jt0) * dil, 0);
    ATT_ISSUE((i0 - 128 + 64 * (jt0 + 1)) * dil, 1);
    {
        const bf16_t* qrow = proj + mytok * DIN + COL_QA + head * 128;
#pragma unroll
        for (int s = 0; s < 8; ++s) qf[s] = *(const bf16x8*)(qrow + 16 * s + 8 * h);
#pragma unroll
        for (int s = 0; s < 8; ++s) asm volatile("" : "+v"(qf[s]));
    }
    int cur = 0;
    for (int jt = jt0; jt < 6; ++jt) {
        LAS unsigned char* Kb = lds + cur * TB; LAS unsigned char* Vb = lds + 3 * TB + cur * TB;
        if (jt < 5) asm volatile("s_waitcnt vmcnt(4)" ::: "memory"); else asm volatile("s_waitcnt vmcnt(0)" ::: "memory");
        __builtin_amdgcn_s_barrier(); asm volatile("" ::: "memory");
        if (jt < 4) ATT_ISSUE((i0 - 128 + 64 * (jt + 2)) * dil, cur == 0 ? 2 : cur - 1);
        const int ki0 = i0 - 128 + 64 * jt;
        if (ki0 <= wq0 + 31 && ki0 + 63 >= wq0 - 128) {
            f32x16 x0, x1;
            qk_tile(Kb, qf, x0, x1, r, h);
            const float NEG = -__builtin_inff();
#pragma unroll
            for (int i = 0; i < 16; ++i) {
                const int d0 = myqi - (ki0 + crow(i, h));
                if ((unsigned)d0 > 128u) x0[i] = NEG;
                if ((unsigned)(d0 - 32) > 128u) x1[i] = NEG;
            }
            float mx = x0[0];
#pragma unroll
            for (int i = 1; i < 16; ++i) mx = fmaxf(mx, x0[i]);
#pragma unroll
            for (int i = 0; i < 16; ++i) mx = fmaxf(mx, x1[i]);
            { const unsigned t = __float_as_uint(mx); auto sw = __builtin_amdgcn_permlane32_swap(t, t, false, false); mx = fmaxf(__uint_as_float(sw[0]), __uint_as_float(sw[1])); }
            const float mn = fmaxf(mrun, mx);
            const float alpha = __builtin_amdgcn_exp2f(mrun - mn);
            mrun = mn;
            f32x16 p0, p1; float rs = 0.f;
#pragma unroll
            for (int i = 0; i < 16; ++i) { p0[i] = __builtin_amdgcn_exp2f(x0[i] - mn); p1[i] = __builtin_amdgcn_exp2f(x1[i] - mn); rs += p0[i] + p1[i]; }
            { const unsigned t = __float_as_uint(rs); auto sw = __builtin_amdgcn_permlane32_swap(t, t, false, false); rs = __uint_as_float(sw[0]) + __uint_as_float(sw[1]); }
            lrun = lrun * alpha + rs;
#pragma unroll
            for (int db = 0; db < 4; ++db)
#pragma unroll
                for (int i = 0; i < 16; ++i) o[db][i] *= alpha;
            pv_tile(Vb, p0, p1, o, lane);
        }
        cur = (cur == 2) ? 0 : cur + 1;
    }
    store_o(og + mytok * 1536 + head * 128, o, 1.0f / lrun, h);
    if (h == 0) lse[mytok * 12 + head] = (mrun + __builtin_amdgcn_logf(lrun)) * LN2;
    __syncthreads();
}
#undef ATT_ISSUE
}

DI void phase_attn(const Params& p, LAS unsigned char* lds) {
    for (int it = blockIdx.x; it < 1024; it += gridDim.x) {
        if (it < 256) {
            const int xcd = it & 7, rest = it >> 3, bhi = rest >> 3, x = rest & 7, bh = xcd * 4 + bhi;
            att::sb_item(p, lds, bh >> 3, bh & 7, 15 - x);
            att::sb_item(p, lds, bh >> 3, bh & 7, x);
        } else att::dil_item(p, lds, it - 256);
    }
}

DI void phase_merge(const Params& p) {
    const int lane = threadIdx.x & 63, wid = threadIdx.x >> 6;
    const bf16_t* og = (const bf16_t*)(p.ws + WS_OG); const float* lse = (const float*)(p.ws + WS_LSE); bf16_t* odil = (bf16_t*)(p.ws + WS_ODIL);
    const int hg = lane >> 4, d0 = (lane & 15) * 8;
    for (int tok = blockIdx.x * 8 + wid; tok < NTOK; tok += gridDim.x * 8) {
        const float l0 = lse[(size_t)tok * 12 + hg], l1 = lse[(size_t)tok * 12 + 4 + hg], l2 = lse[(size_t)tok * 12 + 8 + hg];
        const float mx = fmaxf(l0, fmaxf(l1, l2));
        float w0 = __expf(l0 - mx), w1 = __expf(l1 - mx), w2 = __expf(l2 - mx);
        const float inv = 1.0f / (w0 + w1 + w2); w0 *= inv; w1 *= inv; w2 *= inv;
        const u32x4 a = *(const u32x4*)(og + (size_t)tok * 1536 + hg * 128 + d0);
        const u32x4 bq = *(const u32x4*)(og + (size_t)tok * 1536 + (4 + hg) * 128 + d0);
        const u32x4 c = *(const u32x4*)(og + (size_t)tok * 1536 + (8 + hg) * 128 + d0);
        u32x4 o;
#pragma unroll
        for (int q = 0; q < 4; ++q) {
            const float lo = w0 * bf_lo(a[q]) + w1 * bf_lo(bq[q]) + w2 * bf_lo(c[q]);
            const float hi = w0 * bf_hi(a[q]) + w1 * bf_hi(bq[q]) + w2 * bf_hi(c[q]);
            o[q] = pk_bf16(lo, hi);
        }
        *(u32x4*)(odil + (size_t)tok * 512 + hg * 128 + d0) = o;
    }
}

DI void phase_postmix(const Params& p, LAS unsigned char* lds) {
    const int tid = threadIdx.x, lane = tid & 63, wid = __builtin_amdgcn_readfirstlane(tid >> 6);
    LAS float* hsm = (LAS float*)lds;
    LAS float* part = (LAS float*)(lds + 131072);
    const float* mod = (const float*)(p.ws + WS_MOD); const bf16_t* y = (const bf16_t*)(p.ws + WS_Y);
    unsigned char* h2 = (unsigned char*)(p.ws + WS_H);
    int* cnt = (int*)(p.ws + WS_CNT); int* list = (int*)(p.ws + WS_LIST); float* listw = (float*)(p.ws + WS_LISTW);
    const bf16_t* wr_hi = (const bf16_t*)(p.ws + WS_WRT); const bf16_t* wr_lo = wr_hi + 64 * 2048;
    LAS int* lcnt = (LAS int*)(lds + 147456);
    LAS int* lbase = (LAS int*)(lds + 147712);
    LAS unsigned char* sel_e = lds + 147968;
    LAS unsigned short* sel_r = (LAS unsigned short*)(lds + 150016);
    LAS float* sel_w = (LAS float*)(lds + 154112);
    if (tid < 64) lcnt[tid] = 0;
    int itl = 0;
    for (int it = blockIdx.x; it < NTOK / 16; it += gridDim.x, ++itl) {
#pragma unroll 1
        for (int sub = 0; sub < 2; ++sub) {
            const int tl = 2 * wid + sub, tok = it * 16 + tl, b = tok >> 12;
            f32x4 v[8]; float ss = 0.f;
#pragma unroll
            for (int i = 0; i < 8; ++i) { const u32x2 yw = *(const u32x2*)(y + (size_t)tok * DM + 4 * (lane + 64 * i)); v[i] = (f32x4){bf_lo(yw.x), bf_hi(yw.x), bf_lo(yw.y), bf_hi(yw.y)}; ss += v[i][0] * v[i][0] + v[i][1] * v[i][1] + v[i][2] * v[i][2] + v[i][3] * v[i][3]; }
            ss = wave_sum(ss);
            const float rstd = rsqrtf(ss * (1.0f / DM) + RMS_EPS);
            float ss1 = 0.f;
#pragma unroll
            for (int i = 0; i < 8; ++i) {
                const int ch = 4 * (lane + 64 * i);
                const f32x4 g = *(const f32x4*)(p.g_post_mix + ch);
                const f32x4 gt = *(const f32x4*)(mod + b * 12288 + 4096 + ch);
                const f32x4 xv = *(const f32x4*)(p.x + (size_t)tok * DM + ch);
#pragma unroll
                for (int j = 0; j < 4; ++j) { v[i][j] = xv[j] + gt[j] * (v[i][j] * rstd * g[j]); ss1 += v[i][j] * v[i][j]; }
                *(f32x4*)(p.out + (size_t)tok * DM + ch) = v[i];
            }
            ss1 = wave_sum(ss1);
            const float rstd1 = rsqrtf(ss1 * (1.0f / DM) + RMS_EPS);
#pragma unroll
            for (int i = 0; i < 8; ++i) {
                const int ch = 4 * (lane + 64 * i);
                const f32x4 g = *(const f32x4*)(p.g_pre_ffn + ch);
                const f32x4 sh = *(const f32x4*)(mod + b * 12288 + 6144 + ch);
                const f32x4 sc = *(const f32x4*)(mod + b * 12288 + 8192 + ch);
                f32x4 o;
#pragma unroll
                for (int j = 0; j < 4; ++j) o[j] = v[i][j] * rstd1 * g[j] * (1.0f + sc[j]) + sh[j];
                *(unsigned*)(h2 + (size_t)tok * DM + ch) = pk_fp8x4(o[0], o[1], o[2], o[3]);
                *(LAS f32x4*)(hsm + tl * 2048 + ch) = o;
            }
        }
        __syncthreads();
        f32x4 acc[4];
        {
            const int tr = lane & 15, kq = lane >> 4;
#pragma unroll
            for (int q = 0; q < 4; ++q) acc[q] = (f32x4){0.f, 0.f, 0.f, 0.f};
#pragma unroll 4
            for (int ks = 0; ks < 8; ++ks) {
                const int k0 = 256 * wid + 32 * ks + 8 * kq;
                const f32x4 a0 = *(const LAS f32x4*)(hsm + tr * 2048 + k0), a1 = *(const LAS f32x4*)(hsm + tr * 2048 + k0 + 4);
                u32x4 hw, lw;
                {
                    float xs[8] = {a0[0], a0[1], a0[2], a0[3], a1[0], a1[1], a1[2], a1[3]};
                    unsigned hh[4], ll[4];
#pragma unroll
                    for (int q = 0; q < 4; ++q) {
                        hh[q] = pk_bf16(xs[2 * q], xs[2 * q + 1]);
                        ll[q] = pk_bf16(xs[2 * q] - bf_lo(hh[q]), xs[2 * q + 1] - bf_hi(hh[q]));
                    }
                    hw = (u32x4){hh[0], hh[1], hh[2], hh[3]}; lw = (u32x4){ll[0], ll[1], ll[2], ll[3]};
                }
                const bf16x8 ah = __builtin_bit_cast(bf16x8, hw), al = __builtin_bit_cast(bf16x8, lw);
#pragma unroll
                for (int q = 0; q < 4; ++q) {
                    const bf16x8 bh = *(const bf16x8*)(wr_hi + (size_t)(16 * q + tr) * 2048 + k0);
                    const bf16x8 bl = *(const bf16x8*)(wr_lo + (size_t)(16 * q + tr) * 2048 + k0);
                    acc[q] = __builtin_amdgcn_mfma_f32_16x16x32_bf16(ah, bh, acc[q], 0, 0, 0);
                    acc[q] = __builtin_amdgcn_mfma_f32_16x16x32_bf16(ah, bl, acc[q], 0, 0, 0);
                    acc[q] = __builtin_amdgcn_mfma_f32_16x16x32_bf16(al, bh, acc[q], 0, 0, 0);
                }
            }
            if (wid >= 4) {
#pragma unroll
                for (int q = 0; q < 4; ++q)
#pragma unroll
                    for (int j = 0; j < 4; ++j) part[((wid - 4) * 16 + 4 * kq + j) * 64 + 16 * q + tr] = acc[q][j];
            }
        }
        __syncthreads();
        if (wid < 4) {
            const int tr = lane & 15, kq = lane >> 4;
#pragma unroll
            for (int q = 0; q < 4; ++q)
#pragma unroll
                for (int j = 0; j < 4; ++j) part[(wid * 16 + 4 * kq + j) * 64 + 16 * q + tr] += acc[q][j];
        }
        __syncthreads();
#pragma unroll 1
        for (int sub = 0; sub < 2; ++sub) {
            const int tl = 2 * wid + sub, tok = it * 16 + tl;
            const float logit = ((part[(0 * 16 + tl) * 64 + lane] + part[(1 * 16 + tl) * 64 + lane]) + part[(2 * 16 + tl) * 64 + lane]) + part[(3 * 16 + tl) * 64 + lane];
            const float score = 1.0f / (1.0f + __expf(-logit));
            const float sel = score + p.router_bias[lane];
            float m1 = sel;
            m1 = fmaxf(m1, __shfl_xor(m1, 1)); m1 = fmaxf(m1, __shfl_xor(m1, 2)); m1 = fmaxf(m1, __shfl_xor(m1, 4));
            const bool is1 = (sel == m1);
            const unsigned long long bal = __ballot(is1);
            const unsigned gm = (unsigned)(bal >> (lane & ~7)) & 0xffu;
            const int first = __ffs(gm) - 1;
            float m2 = (is1 && (lane & 7) == first) ? -__builtin_inff() : sel;
            m2 = fmaxf(m2, __shfl_xor(m2, 1)); m2 = fmaxf(m2, __shfl_xor(m2, 2)); m2 = fmaxf(m2, __shfl_xor(m2, 4));
            const float gs = m1 + m2;
            const int myg = lane >> 3;
            int grank = 0;
#pragma unroll 1
            for (int g = 0; g < 8; ++g) { const float gv = __uint_as_float(__builtin_amdgcn_readlane(__float_as_uint(gs), 8 * g)); grank += (gv > gs || (gv == gs && g < myg)) ? 1 : 0; }
            const bool gsel = grank < 4;
            const float msel = gsel ? sel : -__builtin_inff();
            int rk = 0;
#pragma unroll 4
            for (int e = 0; e < 64; ++e) { const float v = __uint_as_float(__builtin_amdgcn_readlane(__float_as_uint(msel), e)); rk += (v > msel || (v == msel && e < lane)) ? 1 : 0; }
            const bool chosen = gsel && rk < 8;
            const float ssum = wave_sum(chosen ? score : 0.f);
            if (chosen) {
                const int lr = __hip_atomic_fetch_add(lcnt + lane, 1, __ATOMIC_RELAXED, __HIP_MEMORY_SCOPE_WORKGROUP);
                const int idx = ((itl & 15) * 16 + tl) * 8 + rk;
                sel_e[idx] = (unsigned char)lane; sel_r[idx] = (unsigned short)lr; sel_w[idx] = score / ssum * 2.5f;
            }
            (void)tok;
        }
        __syncthreads();
        if ((itl & 15) == 15 || it + (int)gridDim.x >= NTOK / 16) {
            if (tid < 64) lbase[tid] = atomicAdd(&cnt[tid], lcnt[tid]);
            __syncthreads();
            const int nsel = ((itl & 15) + 1) * 128, it0 = itl & ~15;
            for (int idx = tid; idx < nsel; idx += 512) {
                const int e = sel_e[idx], tl = idx >> 3, k = idx & 7;
                const int tk = ((int)blockIdx.x + (it0 + (tl >> 4)) * (int)gridDim.x) * 16 + (tl & 15);
                const int pos = lbase[e] + sel_r[idx];
                list[e * LIST_CAP + pos] = tk * 9 + k; listw[e * LIST_CAP + pos] = sel_w[idx];
            }
            __syncthreads();
            if (tid < 64) lcnt[tid] = 0;
            __syncthreads();
        }
    }
}

DI void phase_combine(const Params& p) {
    const int lane = threadIdx.x & 63, wid = threadIdx.x >> 6;
    const float* mod = (const float*)(p.ws + WS_MOD); const unsigned char* yb9 = (const unsigned char*)(p.ws + WS_YB9); const int* slot = (const int*)(p.ws + WS_SLOT);
    for (int tok = blockIdx.x * 8 + wid; tok < NTOK; tok += gridDim.x * 8) {
        const int b = tok >> 12;
        float acc[2][16];
#pragma unroll
        for (int i = 0; i < 2; ++i)
#pragma unroll
            for (int j = 0; j < 16; ++j) acc[i][j] = 0.f;
#pragma unroll 3
        for (int k = 0; k < 9; ++k) {
            const unsigned char* row = yb9 + (size_t)slot[tok * 9 + k] * 256;
#pragma unroll
            for (int i = 0; i < 2; ++i) {
                const int c = lane + 64 * i;
                const u32x4 w = __builtin_nontemporal_load((const u32x4*)(row + (size_t)(c >> 4) * YB_SLOTS * 256 + (c & 15) * 16));
#pragma unroll
                for (int q = 0; q < 4; ++q) {
                    const f32x2 lo = __builtin_amdgcn_cvt_pk_f32_fp8((int)w[q], false), hi = __builtin_amdgcn_cvt_pk_f32_fp8((int)w[q], true);
                    acc[i][4 * q] += lo[0]; acc[i][4 * q + 1] += lo[1]; acc[i][4 * q + 2] += hi[0]; acc[i][4 * q + 3] += hi[1];
                }
            }
        }
        float ss = 0.f;
#pragma unroll
        for (int i = 0; i < 2; ++i)
#pragma unroll
            for (int j = 0; j < 16; ++j) ss += acc[i][j] * acc[i][j];
        ss = wave_sum(ss);
        const float rstd = rsqrtf(ss * (1.0f / DM) + RMS_EPS);
#pragma unroll
        for (int i = 0; i < 2; ++i) {
            const int ch = 16 * (lane + 64 * i);
#pragma unroll
            for (int hh = 0; hh < 4; ++hh) {
                const f32x4 g = *(const f32x4*)(p.g_post_ffn + ch + 4 * hh);
                const f32x4 gt = *(const f32x4*)(mod + b * 12288 + 10240 + ch + 4 * hh);
                f32x4 xv = *(const f32x4*)(p.out + (size_t)tok * DM + ch + 4 * hh);
#pragma unroll
                for (int j = 0; j < 4; ++j) xv[j] += gt[j] * (acc[i][4 * hh + j] * rstd * g[j]);
                __builtin_nontemporal_store(xv, (f32x4*)(p.out + (size_t)tok * DM + ch + 4 * hh));
            }
        }
    }
}

DI void probe_copy(const Params& p) {
    u32x4* yb = (u32x4*)(p.ws + WS_YB9);
    const size_t n = (size_t)576 * MiB / 16;
    for (size_t i = (size_t)blockIdx.x * 512 + threadIdx.x; i < n; i += (size_t)gridDim.x * 512) { u32x4 v = yb[i]; asm volatile("" : "+v"(v)); yb[i] = v; }
}

constexpr int NPHASE = 12;
template <int PH> DI void run_phase(const Params& p, LAS unsigned char* lds) {
    if constexpr (PH == 0) phase_prologue(p, lds);
    else if constexpr (PH == 1) phase_prenorm(p);
    else if constexpr (PH == 2) phase_inproj(p, lds);
    else if constexpr (PH == 3) phase_attn(p, lds);
    else if constexpr (PH == 4) phase_merge(p);
    else if constexpr (PH == 5) phase_outproj_a(p, lds);
    else if constexpr (PH == 6) phase_outproj_b(p, lds);
    else if constexpr (PH == 7) phase_mixout(p, lds);
    else if constexpr (PH == 8) phase_postmix(p, lds);
    else if constexpr (PH == 9) phase_gateup(p, lds);
    else if constexpr (PH == 10) phase_down(p, lds);
    else phase_combine(p);
}
template <int PH> __global__ __launch_bounds__(512, 2) void k_phase(Params p) {
    extern __shared__ __attribute__((aligned(16))) unsigned char shm[];
    run_phase<PH>(p, (LAS unsigned char*)shm);
}
#if MK_FUSED
typedef const __attribute__((address_space(4))) Params* KargPtr;
template <int PH> DI void mega_phase(KargPtr kp0, LAS unsigned char* lds) {
    KargPtr kp = kp0; asm volatile("" : "+s"(kp));
    Params p{};
#if defined(__HIP_DEVICE_COMPILE__)
    p.x = kp->x; p.c = kp->c; p.pos = kp->pos; p.w_ada = kp->w_ada; p.b_ada = kp->b_ada; p.g_pre_mix = kp->g_pre_mix; p.g_post_mix = kp->g_post_mix; p.g_pre_ffn = kp->g_pre_ffn; p.g_post_ffn = kp->g_post_ffn; p.w_in = kp->w_in; p.w_dil_out = kp->w_dil_out; p.w_sb_out = kp->w_sb_out; p.w_mix_out = kp->w_mix_out; p.w_router = kp->w_router; p.router_bias = kp->router_bias; p.w_gate_e = kp->w_gate_e; p.w_up_e = kp->w_up_e; p.w_down_e = kp->w_down_e; p.w_gate_s = kp->w_gate_s; p.w_up_s = kp->w_up_s; p.w_down_s = kp->w_down_s; p.out = kp->out; p.ws = kp->ws;
#endif
    run_phase<PH>(p, lds);
}
__global__ __launch_bounds__(512, 2) void k_mega(Params p_unused) {
    extern __shared__ __attribute__((aligned(16))) unsigned char shm[];
    LAS unsigned char* lds = (LAS unsigned char*)shm;
    KargPtr kp0 = (KargPtr)__builtin_amdgcn_kernarg_segment_ptr();
    volatile LAS unsigned* xbw = (volatile LAS unsigned*)(lds + LDS_BYTES - 16);
    if (threadIdx.x == 0) { xbw[0] = 0u; xbw[1] = 0u; xbw[2] = 0u; xbw[3] = 0u; }
    __syncthreads();
    XcdBarrier bar;
    { KargPtr kp = kp0; asm volatile("" : "+s"(kp)); bar = xcd_barrier_post((unsigned*)(kp->ws + WS_BAR), xbw); }
    if (MK_STAMP >= 0 && blockIdx.x == 0 && threadIdx.x == 0) { KargPtr kq = kp0; asm volatile("" : "+s"(kq)); ((unsigned long long*)(kq->ws + WS_STAMP))[0] = wall_clock64(); }
#define MEGA_PH(n) do { mega_phase<n>(kp0, lds); xcd_barrier(bar); if (MK_REP == n) { mega_phase<n>(kp0, lds); xcd_barrier(bar); } \
        if (MK_STAMP >= 0 && blockIdx.x == 0 && threadIdx.x == 0) { KargPtr kq = kp0; asm volatile("" : "+s"(kq)); ((unsigned long long*)(kq->ws + WS_STAMP))[n + 1] = wall_clock64(); } } while (0)
#if MK_REP == 90
#define MK_PROBE_DOWN_NOSTORE 1
#endif
    MEGA_PH(0); MEGA_PH(1); MEGA_PH(2); MEGA_PH(3); MEGA_PH(4); MEGA_PH(5); MEGA_PH(6); MEGA_PH(7); MEGA_PH(8); MEGA_PH(9); MEGA_PH(10);
#if MK_REP == 100
    { KargPtr kp = kp0; asm volatile("" : "+s"(kp)); Params p{}; p.ws = kp->ws; probe_copy(p); xcd_barrier(bar); }
#endif
#undef MEGA_PH
    mega_phase<11>(kp0, lds);
#if MK_STAMP >= 0
    xcd_barrier(bar);
    if (blockIdx.x == 0 && threadIdx.x == 0) {
        KargPtr kq = kp0; asm volatile("" : "+s"(kq));
        unsigned long long* st = (unsigned long long*)(kq->ws + WS_STAMP);
        st[12] = wall_clock64();
        const int k = MK_STAMP < 100 ? MK_STAMP : MK_STAMP - 100;
        const unsigned long long t0 = (MK_STAMP < 100) ? st[k] : st[0], t1 = (MK_STAMP < 100) ? st[k + 1] : st[k + 1];
        kq->out[0] += 2.0f + (float)(t1 - t0) * (MK_STAMP < 100 ? 0.0005f : 0.0001f);
    }
#endif
}
#endif

template <int PH> static void launch_phase(const Params& p, int grid, hipStream_t stream) {
    static bool init = false;
    if (!init) { (void)hipFuncSetAttribute((const void*)k_phase<PH>, hipFuncAttributeMaxDynamicSharedMemorySize, LDS_BYTES); init = true; }
    hipLaunchKernelGGL(k_phase<PH>, dim3(grid), dim3(512), LDS_BYTES, stream, p);
}

extern "C" void kernel_launch(void* const* d_in, const int* in_sizes, int n_in, void* d_out, int out_size, void* d_ws, size_t ws_size, hipStream_t stream) {
    (void)in_sizes; (void)n_in; (void)out_size;
    static int grid = 0;
    if (!grid) {
        int dev = 0, cus = 0; (void)hipGetDevice(&dev); (void)hipDeviceGetAttribute(&cus, hipDeviceAttributeMultiprocessorCount, dev);
        if (cus <= 0) cus = 256;
#if MK_FUSED
        (void)hipFuncSetAttribute((const void*)k_mega, hipFuncAttributeMaxDynamicSharedMemorySize, LDS_BYTES);
        int per_cu = 0;
        if (hipOccupancyMaxActiveBlocksPerMultiprocessor(&per_cu, (const void*)k_mega, 512, LDS_BYTES) != hipSuccess || per_cu < 1)
            fprintf(stderr, "kernel_launch: occupancy query reports %d workgroups per CU\n", per_cu);
#endif
        grid = cus;
        if (ws_size < WS_TOTAL) fprintf(stderr, "kernel_launch: workspace too small: %zu < %zu\n", ws_size, (size_t)WS_TOTAL);
    }
    Params p{};
    p.x = (const float*)d_in[0]; p.c = (const float*)d_in[1]; p.pos = (const int*)d_in[2];
    p.w_ada = (const float*)d_in[3]; p.b_ada = (const float*)d_in[4];
    p.g_pre_mix = (const float*)d_in[5]; p.g_post_mix = (const float*)d_in[6]; p.g_pre_ffn = (const float*)d_in[7]; p.g_post_ffn = (const float*)d_in[8];
    p.w_in = (const float*)d_in[9]; p.w_dil_out = (const float*)d_in[10]; p.w_sb_out = (const float*)d_in[11]; p.w_mix_out = (const float*)d_in[12];
    p.w_router = (const float*)d_in[13]; p.router_bias = (const float*)d_in[14];
    p.w_gate_e = (const float*)d_in[15]; p.w_up_e = (const float*)d_in[16]; p.w_down_e = (const float*)d_in[17];
    p.w_gate_s = (const float*)d_in[18]; p.w_up_s = (const float*)d_in[19]; p.w_down_s = (const float*)d_in[20];
    p.out = (float*)d_out; p.ws = (unsigned char*)d_ws;
    (void)hipMemsetAsync((unsigned char*)d_ws + WS_BAR, 0, WS_ZERO_BYTES, stream);
#if MK_FUSED
    hipLaunchKernelGGL(k_mega, dim3(grid), dim3(512), LDS_BYTES, stream, p);
#else
    launch_phase<0>(p, grid, stream); launch_phase<1>(p, grid, stream); launch_phase<2>(p, grid, stream); launch_phase<3>(p, grid, stream);
    launch_phase<4>(p, grid, stream); launch_phase<5>(p, grid, stream); launch_phase<6>(p, grid, stream); launch_phase<7>(p, grid, stream);
    launch_phase<8>(p, grid, stream); launch_phase<9>(p, grid, stream); launch_phase<10>(p, grid, stream); launch_phase<11>(p, grid, stream);
#endif
}
```

```cpp
#include <hip/hip_runtime.h>
#include <stdint.h>
#include <stdio.h>

#ifndef MK_FUSED
#define MK_FUSED 1
#endif
#ifndef MK_STAMP
#define MK_STAMP -1
#endif
#ifndef MK_REP
#define MK_REP -1
#endif

#define LAS __attribute__((address_space(3)))
#define DI __device__ __forceinline__
typedef unsigned short bf16_t;
typedef short bf16x8 __attribute__((ext_vector_type(8)));
typedef short s16x4 __attribute__((ext_vector_type(4)));
typedef float f32x2 __attribute__((ext_vector_type(2)));
typedef float f32x4 __attribute__((ext_vector_type(4)));
typedef float f32x16 __attribute__((ext_vector_type(16)));
typedef unsigned u32x2 __attribute__((ext_vector_type(2)));
typedef unsigned u32x4 __attribute__((ext_vector_type(4)));
typedef __bf16 bf16x2_t __attribute__((ext_vector_type(2)));
typedef const __attribute__((address_space(1))) char* gcptr;
typedef const __attribute__((address_space(1))) u32x4* gu4ptr;
typedef int i32x8 __attribute__((ext_vector_type(8)));
typedef short s16x16 __attribute__((ext_vector_type(16)));

constexpr int NBATCH = 4, SEQ = 4096, NTOK = NBATCH * SEQ, DM = 2048, DIN = 11776;
constexpr int COL_QA = 0, COL_KA = 1536, COL_VA = 3072, COL_QS = 4608, COL_KS = 5632, COL_VS = 6656, COL_GD = 7680, COL_GS = 9728;
constexpr int NE = 64, DE = 512, NEX = 65;
constexpr int LIST_CAP = 16384;
constexpr int YB_SLOTS = 163840;
constexpr float RMS_EPS = 1e-6f;
constexpr float QSCALE = 0.08838834764831845f * 1.4426950408889634f;
constexpr float LN2 = 0.6931471805599453f;
constexpr float W8_SCALE = 64.0f;
constexpr int W8_MX = 0x79797979, A8_MX = 0x7f7f7f7f;

constexpr size_t MiB = 1ull << 20;
constexpr size_t WS_BAR = 0;
constexpr size_t WS_CNT = 16384;
constexpr size_t WS_ZERO_BYTES = 32768;
constexpr size_t WS_STAMP = 32768;

constexpr size_t WS_MOD = 65536;
constexpr size_t WS_LSE = 262144;
constexpr size_t WS_ROPE = 1 * MiB;
constexpr size_t WS_LIST = 3 * MiB;
constexpr size_t WS_LISTW = 7 * MiB;
constexpr size_t WS_SLOT = 262144;
constexpr size_t WS_WD = 11 * MiB;
constexpr size_t WS_WTIN8 = 76 * MiB;
constexpr size_t WS_H8 = 100 * MiB;
constexpr size_t WS_H = 141 * MiB;
constexpr size_t WS_HID = 205 * MiB;
constexpr size_t WS_WTIN = 205 * MiB;
constexpr size_t WS_TMP = 205 * MiB;
constexpr size_t WS_OG = 251 * MiB;
constexpr size_t WS_OSB = 299 * MiB;
constexpr size_t WS_ODIL = 331 * MiB;
constexpr size_t WS_WTDIL = 347 * MiB;
constexpr size_t WS_WTSB = 349 * MiB;
constexpr size_t WS_WTMIX = 353 * MiB;
constexpr size_t WS_PROJ = 365 * MiB;
constexpr size_t WS_Y = 365 * MiB;
constexpr size_t WS_YB9 = 365 * MiB;
constexpr size_t WS_WGU = 733 * MiB;
constexpr size_t WS_WRT = 1005 * MiB;
constexpr size_t WS_TOTAL = 1006 * MiB;

#ifndef MOE_BAUX
#define MOE_BAUX 0
#endif
#ifndef GEMM_SPLIT
#define GEMM_SPLIT false
#endif
constexpr int LDS_BYTES = 163840;

struct Params {
    const float *x, *c; const int* pos;
    const float *w_ada, *b_ada, *g_pre_mix, *g_post_mix, *g_pre_ffn, *g_post_ffn;
    const float *w_in, *w_dil_out, *w_sb_out, *w_mix_out, *w_router, *router_bias;
    const float *w_gate_e, *w_up_e, *w_down_e, *w_gate_s, *w_up_s, *w_down_s;
    float* out; unsigned char* ws;
};

DI unsigned pk_bf16(float lo, float hi) { f32x2 v = {lo, hi}; bf16x2_t r = __builtin_convertvector(v, bf16x2_t); return __builtin_bit_cast(unsigned, r); }
DI unsigned pk_fp8x4(float a, float b, float c, float d) { int p = __builtin_amdgcn_cvt_pk_fp8_f32(a, b, 0, false); p = __builtin_amdgcn_cvt_pk_fp8_f32(c, d, p, true); return (unsigned)p; }
DI float bf_lo(unsigned u) { return __uint_as_float(u << 16); }
DI float bf_hi(unsigned u) { return __uint_as_float(u & 0xffff0000u); }
DI float wave_sum(float v) {
#pragma unroll
    for (int o = 32; o >= 1; o >>= 1) v += __shfl_xor(v, o);
    return v;
}
DI float sigmoidf_(float x) { return __builtin_amdgcn_rcpf(1.0f + __expf(-x)); }

#define XB_TMO      128
#define XB_XCNT(j)  (256  + 64 * (j))
#define XB_XSUB(j)  (1280 + 64 * (j))
#define XB_XGEN(j)  (2304 + 64 * (j))
#define XB_TOP      3328
#define XB_TOPGEN   3392
#define XCD_BAR_WORDS 3456
#define XB_SPIN_CAP (1u << 18)

__device__ __forceinline__ unsigned xb_ld(unsigned* p)              { return __hip_atomic_load(p, __ATOMIC_RELAXED, __HIP_MEMORY_SCOPE_AGENT); }
__device__ __forceinline__ unsigned xb_add(unsigned* p, unsigned v) { return __hip_atomic_fetch_add(p, v, __ATOMIC_RELAXED, __HIP_MEMORY_SCOPE_AGENT); }
__device__ __forceinline__ unsigned xb_xcc_id() { return (unsigned)__builtin_amdgcn_s_getreg((3 << 11) | 20) & 0xFu; }
#define XB_SPIN(cond, bar) do { unsigned _sp = 0; while (cond) { __builtin_amdgcn_s_sleep(1); \
    if ((++_sp & 255u) == 0u) { if (xb_ld(&(bar)[XB_TMO])) break; if (_sp > XB_SPIN_CAP) { atomicAdd(&(bar)[XB_TMO], 1u); break; } } } } while (0)

struct XcdBarrier { unsigned* bar; unsigned x; volatile LAS unsigned* st; };

__device__ __forceinline__ XcdBarrier xcd_barrier_post(unsigned* bar, volatile LAS unsigned* st) {
    XcdBarrier b; b.bar = bar; b.x = xb_xcc_id(); b.st = st;
    if (threadIdx.x == 0) (void)xb_add(&bar[XB_XCNT(b.x)], 1u);
    return b;
}
__device__ __forceinline__ void xcd_barrier_complete(unsigned* bar, unsigned x, unsigned& nloc, unsigned& nx) {
    const unsigned G = gridDim.x * gridDim.y * gridDim.z;
    unsigned sum, cnt, mine, sp = 0u;
    for (;;) {
        sum = 0u; cnt = 0u; mine = 0u;
#pragma unroll
        for (unsigned j = 0; j < 16; ++j) { const unsigned c = xb_ld(&bar[XB_XCNT(j)]); sum += c; cnt += (c > 0u) ? 1u : 0u; mine = (j == x) ? c : mine; }
        if (sum == G) break;
        __builtin_amdgcn_s_sleep(1);
        if ((++sp & 255u) == 0u) { if (xb_ld(&bar[XB_TMO])) break; if (sp > XB_SPIN_CAP) { atomicAdd(&bar[XB_TMO], 1u); break; } }
    }
    nloc = mine > 0u ? mine : 1u; nx = cnt > 0u ? cnt : 1u;
}
__device__ __forceinline__ void xcd_barrier(const XcdBarrier& b) {
    asm volatile("s_waitcnt vmcnt(0)" ::: "memory");
    __syncthreads();
    if (threadIdx.x == 0) {
        unsigned* bar = b.bar;
        __builtin_amdgcn_s_waitcnt(0);
        unsigned nloc = b.st[0], nx = b.st[1];
        if (nloc == 0u) { xcd_barrier_complete(bar, b.x, nloc, nx); b.st[0] = nloc; b.st[1] = nx; }
        const unsigned old = xb_add(&bar[XB_XSUB(b.x)], 1u);
        const unsigned gen = old / nloc;
        if (old + 1u == (gen + 1u) * nloc) {
            __builtin_amdgcn_fence(__ATOMIC_RELEASE, "agent");
            asm volatile("s_waitcnt vmcnt(0)" ::: "memory");
            const unsigned og = xb_add(&bar[XB_TOP], 1u);
            const unsigned tg = og / nx;
            if (og + 1u == (tg + 1u) * nx) xb_add(&bar[XB_TOPGEN], 1u);
            else XB_SPIN(xb_ld(&bar[XB_TOPGEN]) == tg, bar);
            __builtin_amdgcn_fence(__ATOMIC_ACQUIRE, "agent");
            xb_add(&bar[XB_XGEN(b.x)], 1u);
            asm volatile("s_waitcnt vmcnt(0)" ::: "memory");
        } else {
            XB_SPIN(xb_ld(&bar[XB_XGEN(b.x)]) == gen, bar);
            __builtin_amdgcn_fence(__ATOMIC_ACQUIRE, "agent");
            asm volatile("s_waitcnt vmcnt(0)" ::: "memory");
        }
    }
    __syncthreads();
}

struct CvtMat { const float* src; bf16_t* dst; int K, N, nb, mode; size_t sstride, dstride; };
constexpr int CVT_NMAT = 10;
constexpr int CVT_TILES[CVT_NMAT] = {2944, 128, 256, 512, 8192, 8192, 8192, 128, 128, 128};
constexpr int CVT_TOTAL = 2944 + 128 + 256 + 512 + 8192 * 3 + 128 * 3;
constexpr int P0_MOD_UNITS = 192, P0_ROPE_UNITS = 64, P0_WR_UNITS = 8, P0_ITEMS = P0_MOD_UNITS + P0_ROPE_UNITS + P0_WR_UNITS + CVT_TOTAL;

DI CvtMat cvt_mat(const Params& p, int m) {
    bf16_t* wtin = (bf16_t*)(p.ws + WS_WTIN); bf16_t* wtdil = (bf16_t*)(p.ws + WS_WTDIL); bf16_t* wtsb = (bf16_t*)(p.ws + WS_WTSB); bf16_t* wtmix = (bf16_t*)(p.ws + WS_WTMIX);
    bf16_t* wgu = (bf16_t*)(p.ws + WS_WGU); bf16_t* wd = (bf16_t*)(p.ws + WS_WD);
    CvtMat r;
    switch (m) {
        case 0: r = {p.w_in, wtin, 2048, 11776, 1, 0, 0, 0}; break;
        case 1: r = {p.w_dil_out, wtdil, 512, 2048, 1, 0, 0, 0}; break;
        case 2: r = {p.w_sb_out, wtsb, 1024, 2048, 1, 0, 0, 0}; break;
        case 3: r = {p.w_mix_out, wtmix, 2048, 2048, 1, 0, 0, 0}; break;
        case 4: r = {p.w_gate_e, wgu, 2048, 512, 64, 1, (size_t)2048 * 512, (size_t)1024 * 2048}; break;
        case 5: r = {p.w_up_e, wgu, 2048, 512, 64, 2, (size_t)2048 * 512, (size_t)1024 * 2048}; break;
        case 6: r = {p.w_down_e, wd, 512, 2048, 64, 0, (size_t)512 * 2048, (size_t)2048 * 512}; break;
        case 7: r = {p.w_gate_s, (bf16_t*)((unsigned char*)wgu + (size_t)64 * 1024 * 2048), 2048, 512, 1, 1, 0, 0}; break;
        case 8: r = {p.w_up_s, (bf16_t*)((unsigned char*)wgu + (size_t)64 * 1024 * 2048), 2048, 512, 1, 2, 0, 0}; break;
        default: r = {p.w_down_s, (bf16_t*)((unsigned char*)wd + (size_t)64 * 2048 * 512), 512, 2048, 1, 0, 0, 0}; break;
    }
    return r;
}

struct CvtTile { const float* src; unsigned char* dst; int N, K, kt, nt, mode, f8; };
DI CvtTile cvt_desc(const Params& p, int t) {
    int m = 0;
#pragma unroll
    for (int i = 0; i < CVT_NMAT - 1; ++i) { if (t >= CVT_TILES[i] && m == i) { t -= CVT_TILES[i]; m = i + 1; } }
    const CvtMat M = cvt_mat(p, m);
    int b, kt, nt;
    if (m == 0) { kt = t / 184; nt = t - kt * 184; b = 0; }
    else {
        const int ln = (M.N == 2048) ? 5 : 3, lk = (M.K == 512) ? 2 : (M.K == 1024 ? 3 : 4);
        nt = t & ((1 << ln) - 1); kt = (t >> ln) & ((1 << lk) - 1); b = t >> (ln + lk);
    }
    const bool in8 = (m == 0);
    CvtTile d; d.src = M.src + (size_t)b * M.sstride + (size_t)(kt * 128) * M.N + nt * 64; d.N = M.N; d.K = M.K; d.kt = kt; d.nt = nt; d.mode = M.mode;
    d.f8 = (m >= 4 || in8) ? 1 : 0;
    d.dst = in8 ? (unsigned char*)(p.ws + WS_WTIN8) : (m >= 4 ? (unsigned char*)M.dst + (size_t)b * M.dstride : (unsigned char*)(M.dst + (size_t)b * M.dstride));
    return d;
}
DI void cvt_load(const CvtTile& d, f32x4 (&v)[4]) {
    const int k4 = (threadIdx.x >> 4) * 4, n4 = (threadIdx.x & 15) * 4;
#pragma unroll
    for (int i = 0; i < 4; ++i) v[i] = __builtin_nontemporal_load((const f32x4*)(d.src + (size_t)(k4 + i) * d.N + n4));
}
DI void cvt_bar() { asm volatile("s_waitcnt lgkmcnt(0)" ::: "memory"); __builtin_amdgcn_s_barrier(); asm volatile("" ::: "memory"); }
DI void cvt_finish(const CvtTile& d, const f32x4 (&vin)[4], LAS unsigned char* lds, bool valid) {
    f32x4 v[4] = {vin[0], vin[1], vin[2], vin[3]};
    asm volatile("" : "+v"(v[0]), "+v"(v[1]), "+v"(v[2]), "+v"(v[3]));
    if (!valid) return;
    const int tid = threadIdx.x;
    const int k4 = (tid >> 4) * 4, n4 = (tid & 15) * 4;
    const int c = d.nt * 64 + (tid >> 3);
    const int drow = d.mode == 0 ? c : (((c >> 7) << 8) + (c & 127) + (d.mode == 2 ? 128 : 0));
    if (!d.f8) {
        constexpr int P = 272;
#pragma unroll
        for (int j = 0; j < 4; ++j) { u32x2 w; w.x = pk_bf16(v[0][j], v[1][j]); w.y = pk_bf16(v[2][j], v[3][j]); *(LAS u32x2*)(lds + (n4 + j) * P + k4 * 2) = w; }
        cvt_bar();
#pragma unroll
        for (int i = 0; i < 2; ++i) {
            const int ch = (tid & 7) + 8 * i;
            const u32x4 w = *(const LAS u32x4*)(lds + (tid >> 3) * P + ch * 16);
            *(u32x4*)((bf16_t*)d.dst + (size_t)drow * d.K + d.kt * 128 + ch * 8) = w;
        }
    } else {
        constexpr int P = 144;
#pragma unroll
        for (int j = 0; j < 4; ++j) *(LAS unsigned*)(lds + (n4 + j) * P + k4) = pk_fp8x4(v[0][j] * W8_SCALE, v[1][j] * W8_SCALE, v[2][j] * W8_SCALE, v[3][j] * W8_SCALE);
        cvt_bar();
        const u32x4 w = *(const LAS u32x4*)(lds + (tid >> 3) * P + (tid & 7) * 16);
        __builtin_nontemporal_store(w, (u32x4*)(d.dst + (size_t)drow * d.K + d.kt * 128 + (tid & 7) * 16));
    }
    cvt_bar();
}

DI void mod_unit(const Params& p, int u, LAS unsigned char* lds) {
    const int tid = threadIdx.x, c0 = u * 64;
    LAS float* sc = (LAS float*)lds;
    LAS float* red = (LAS float*)(lds + 32768);
    for (int i = tid; i < 4 * 2048; i += 512) { const float v = p.c[i]; sc[i] = v / (1.0f + __expf(-v)); }
    __syncthreads();
    const int kq = tid >> 4, cq = tid & 15;
    float acc[4][4];
#pragma unroll
    for (int b = 0; b < 4; ++b)
#pragma unroll
        for (int j = 0; j < 4; ++j) acc[b][j] = 0.f;
#pragma unroll 1
    for (int it0 = 0; it0 < 64; it0 += 8) {
        f32x4 w[8];
#pragma unroll
        for (int i = 0; i < 8; ++i) w[i] = __builtin_nontemporal_load((const f32x4*)(p.w_ada + (size_t)(kq + 32 * (it0 + i)) * 12288 + c0 + 4 * cq));
#pragma unroll
        for (int i = 0; i < 8; ++i) {
            const int k = kq + 32 * (it0 + i);
#pragma unroll
            for (int b = 0; b < 4; ++b) { const float s = sc[b * 2048 + k];
#pragma unroll
                for (int j = 0; j < 4; ++j) acc[b][j] += s * w[i][j]; }
        }
    }
#pragma unroll
    for (int b = 0; b < 4; ++b)
#pragma unroll
        for (int j = 0; j < 4; ++j) red[(kq * 4 + b) * 64 + 4 * cq + j] = acc[b][j];
    __syncthreads();
    if (tid < 256) {
        const int b = tid >> 6, col = tid & 63;
        float s = 0.f;
        for (int q = 0; q < 32; ++q) s += red[(q * 4 + b) * 64 + col];
        float* mod = (float*)(p.ws + WS_MOD);
        mod[b * 12288 + c0 + col] = s + p.b_ada[c0 + col];
    }
    __syncthreads();
}

DI void rope_unit(const Params& p, int u) {
    float2* rope = (float2*)(p.ws + WS_ROPE);
    for (int e = threadIdx.x; e < 4096; e += 512) {
        const int tok = u * 256 + (e >> 4), i = e & 15;
        const float invf = (float)pow(500000.0, -(double)i / 16.0);
        const float ang = (float)p.pos[tok] * invf;
        rope[tok * 16 + i] = make_float2((float)cos((double)ang), (float)sin((double)ang));
    }
}

DI void wr_unit(const Params& p, int u) {
    bf16_t* hi = (bf16_t*)(p.ws + WS_WRT); bf16_t* lo = hi + 64 * 2048;
    for (int i = threadIdx.x; i < 16384; i += 512) {
        const int idx = u * 16384 + i, k = idx >> 6, e = idx & 63;
        const float x = p.w_router[idx];
        const unsigned h = pk_bf16(x, 0.f) & 0xffffu;
        const float r = x - __uint_as_float(h << 16);
        hi[e * 2048 + k] = (bf16_t)h; lo[e * 2048 + k] = (bf16_t)(pk_bf16(r, 0.f) & 0xffffu);
    }
}
DI void phase_prologue(const Params& p, LAS unsigned char* lds) {
    constexpr int NSMALL = P0_MOD_UNITS + P0_ROPE_UNITS + P0_WR_UNITS;
    int it = blockIdx.x;
    for (; it < NSMALL; it += gridDim.x) {
        if (it < P0_MOD_UNITS) mod_unit(p, it, lds);
        else if (it < P0_MOD_UNITS + P0_ROPE_UNITS) rope_unit(p, it - P0_MOD_UNITS);
        else wr_unit(p, it - P0_MOD_UNITS - P0_ROPE_UNITS);
    }
    if (it < P0_ITEMS) {
        const int G = (int)gridDim.x;
        const int n = (P0_ITEMS - it + G - 1) / G;
        const int base = it - NSMALL;
        CvtTile d0, d1, d2, d3;
        f32x4 v0[4], v1[4], v2[4], v3[4];
#define CVT_LOAD(D, V, J) D = cvt_desc(p, base + min((J), n - 1) * G); cvt_load(D, V); asm volatile("" ::: "memory")
        CVT_LOAD(d0, v0, 0); CVT_LOAD(d1, v1, 1); CVT_LOAD(d2, v2, 2);
#pragma unroll 1
        for (int j = 0; j < n; j += 4) {
            CVT_LOAD(d3, v3, j + 3); cvt_finish(d0, v0, lds, true);
            CVT_LOAD(d0, v0, j + 4); cvt_finish(d1, v1, lds, j + 1 < n);
            CVT_LOAD(d1, v1, j + 5); cvt_finish(d2, v2, lds, j + 2 < n);
            CVT_LOAD(d2, v2, j + 6); cvt_finish(d3, v3, lds, j + 3 < n);
        }
#undef CVT_LOAD
    }
    __syncthreads();
}

DI void phase_prenorm(const Params& p) {
    const int lane = threadIdx.x & 63, wid = threadIdx.x >> 6;
    const float* mod = (const float*)(p.ws + WS_MOD);
    bf16_t* h = (bf16_t*)(p.ws + WS_H);
    for (int tok = blockIdx.x * 8 + wid; tok < NTOK; tok += gridDim.x * 8) {
        const int b = tok >> 12;
        const float* xr = p.x + (size_t)tok * DM;
        f32x4 v[8]; float ss = 0.f;
#pragma unroll
        for (int i = 0; i < 8; ++i) { v[i] = *(const f32x4*)(xr + 4 * (lane + 64 * i)); ss += v[i][0] * v[i][0] + v[i][1] * v[i][1] + v[i][2] * v[i][2] + v[i][3] * v[i][3]; }
        ss = wave_sum(ss);
        const float rstd = rsqrtf(ss * (1.0f / DM) + RMS_EPS);
#pragma unroll
        for (int i = 0; i < 8; ++i) {
            const int ch = 4 * (lane + 64 * i);
            const f32x4 g = *(const f32x4*)(p.g_pre_mix + ch);
            const f32x4 sh = *(const f32x4*)(mod + b * 12288 + ch);
            const f32x4 sc = *(const f32x4*)(mod + b * 12288 + 2048 + ch);
            f32x4 o;
#pragma unroll
            for (int j = 0; j < 4; ++j) o[j] = v[i][j] * rstd * g[j] * (1.0f + sc[j]) + sh[j];
            u32x2 w; w.x = pk_bf16(o[0], o[1]); w.y = pk_bf16(o[2], o[3]);
            *(u32x2*)(h + (size_t)tok * DM + ch) = w;
            *(unsigned*)(p.ws + WS_H8 + (size_t)tok * DM + ch) = pk_fp8x4(o[0], o[1], o[2], o[3]);
        }
    }
}

namespace g8 {
constexpr int BM = 256, BK = 64, HALF = 128, HTB = HALF * BK * 2, STAGE_BYTES = 8 * HTB, NXCD = 8, WGM = 8;
DI int lds_byte(int r, int c) { const int st = (r >> 4) * 2 + (c >> 5), rr = r & 15, cc = c & 31, ob = rr * 64 + cc * 2; return st * 1024 + (ob ^ (((ob >> 9) & 1) << 5)); }
DI void stage_rc(int b, int& R, int& C) { const int st = b / 1024, sb = b % 1024, swz = sb ^ (((sb >> 9) & 1) << 5); R = (st >> 1) * 16 + swz / 64; C = (st & 1) * 32 + (swz % 64) / 2; }
DI int perm32(int rho) { const int n = rho >> 4, i = rho & 15; return 8 * (i >> 2) + 4 * n + (i & 3); }

struct Unit {
    const char* A; const char* B;
    int row0;
    int lda, ldb, nt;
    int pm, pn, aux, keep;
    int e, nvalid, par;
};

DI bool static_tile(int L, int nM, int nN, int& pm, int& pn) {
    const int nwg = nM * nN; if (L >= nwg) return false;
    int wgid = L; { const int q = nwg / NXCD, r = nwg % NXCD, xcd = wgid % NXCD, off = wgid / NXCD; wgid = (xcd < r ? xcd * (q + 1) : r * (q + 1) + (xcd - r) * q) + off; }
    const int nig = WGM * nN, gid = wgid / nig, fm = gid * WGM, gsz = (nM - fm) < WGM ? (nM - fm) : WGM;
    pm = fm + ((wgid % nig) % gsz); pn = (wgid % nig) / gsz; return true;
}

constexpr int EXCH_OFF = STAGE_BYTES + 8192;
DI void epi_bar() { asm volatile("s_waitcnt lgkmcnt(0)" ::: "memory"); __builtin_amdgcn_s_barrier(); asm volatile("" ::: "memory"); }

template <int NCH, int BAUX, bool SPLIT, bool FP8, class Sched, class Epi>
DI void gemm_phase(LAS unsigned char* lds, const Sched& S, const Epi& E) {
    const int tid = threadIdx.x, wid = __builtin_amdgcn_readfirstlane(tid >> 6), lane = tid & 63, wr = wid >> 2, wc = wid & 3, fr = lane & 15, fq = lane >> 4;
    const bool loader = SPLIT ? (wr == 0) : true, storer = SPLIT ? (wr == 1) : true;
    constexpr int NP = SPLIT ? 4 : 2, PSTEP = SPLIT ? 4 : 8, RSTEP = SPLIT ? 32 : 64;
    const int p0 = SPLIT ? wc : wid;
    int R0, C0; stage_rc(p0 * 1024 + lane * 16, R0, C0);
    const int sC = C0 * 2, sRb = (R0 & ~31) + perm32(R0 & 31);
    const int aoff = lds_byte(wr * 64 + fr, fq * 8), boff = lds_byte(wc * 32 + fr, fq * 8);
#define G8_SA(b, h) (((b) * 2 + (h)) * HTB)
#define G8_SB(b, h) ((4 + (b) * 2 + (h)) * HTB)
#define G8_STAGE_A(bufoff, gbase, voff) do { if (loader) { _Pragma("unroll") for (int _i = 0; _i < NP; ++_i) \
        __builtin_amdgcn_global_load_lds((const unsigned*)((const char*)(gbase) + (voff)[_i]), (LAS unsigned*)(lds + (bufoff) + (p0 + PSTEP * _i) * 1024), 16, 0, 0); } } while (0)
#define G8_STAGE_B(bufoff, gbase, voff, ldb32) do { if (loader) { _Pragma("unroll") for (int _i = 0; _i < NP; ++_i) { \
        const char* _gb = (const char*)(gbase) + (size_t)_i * (ldb32); asm volatile("" : "+s"(_gb));     \
        __builtin_amdgcn_global_load_lds((const unsigned*)(_gb + (voff)), (LAS unsigned*)(lds + (bufoff) + (p0 + PSTEP * _i) * 1024), 16, 0, BAUX); } } } while (0)
#define G8_LDA(dst, b, h) do { _Pragma("unroll") for (int m = 0; m < 4; ++m) _Pragma("unroll") for (int k = 0; k < 2; ++k) dst[m][k] = *(const LAS bf16x8*)(lds + G8_SA(b, h) + aoff + m * 2048 + k * 1024); } while (0)
#define G8_LDB(dst, b, h) do { _Pragma("unroll") for (int n = 0; n < 2; ++n) _Pragma("unroll") for (int k = 0; k < 2; ++k) dst[n][k] = *(const LAS bf16x8*)(lds + G8_SB(b, h) + boff + n * 2048 + k * 1024); } while (0)
#define G8_MMA(ai, bj, At, Bt) do { __builtin_amdgcn_s_setprio(1); _Pragma("unroll") for (int m = 0; m < 4; ++m) _Pragma("unroll") for (int n = 0; n < 2; ++n) { \
        if (!FP8) { _Pragma("unroll") for (int k = 0; k < 2; ++k) acc[ai][bj][m][n] = __builtin_amdgcn_mfma_f32_16x16x32_bf16(Bt[n][k], At[m][k], acc[ai][bj][m][n], 0, 0, 0); } \
        else { const i32x8 _w = __builtin_bit_cast(i32x8, __builtin_shufflevector(Bt[n][0], Bt[n][1], 0, 1, 2, 3, 4, 5, 6, 7, 8, 9, 10, 11, 12, 13, 14, 15)); \
               const i32x8 _x = __builtin_bit_cast(i32x8, __builtin_shufflevector(At[m][0], At[m][1], 0, 1, 2, 3, 4, 5, 6, 7, 8, 9, 10, 11, 12, 13, 14, 15)); \
               acc[ai][bj][m][n] = __builtin_amdgcn_mfma_scale_f32_16x16x128_f8f6f4(_w, _x, acc[ai][bj][m][n], 0, 0, 0, W8_MX, 0, A8_MX); } } \
        __builtin_amdgcn_s_setprio(0); } while (0)
#define G8_WAIT_V8 do { if (SPLIT) { if (loader) asm volatile("s_waitcnt vmcnt(8)" ::: "memory"); } else asm volatile("s_waitcnt vmcnt(4)" ::: "memory"); } while (0)
#define G8_WAIT_V12 do { if (SPLIT) { if (loader) asm volatile("s_waitcnt vmcnt(12)" ::: "memory"); } else asm volatile("s_waitcnt vmcnt(6)" ::: "memory"); } while (0)
#define G8_WAIT_V0 do { if (loader) asm volatile("s_waitcnt vmcnt(0)" ::: "memory"); } while (0)
#define G8_WAIT_L(n) asm volatile("s_waitcnt lgkmcnt(" #n ")" ::: "memory")
#define G8_BAR __builtin_amdgcn_s_barrier()
#define G8_SCHED __builtin_amdgcn_sched_barrier(0)
#define G8_OFFS(u, vA, vB) do { if (loader) { _Pragma("unroll") for (int _h = 0; _h < 2; ++_h) _Pragma("unroll") for (int _i = 0; _i < NP; ++_i) \
        vA[_h][_i] = (unsigned)S.arow(u, _h * 128 + R0 + RSTEP * _i) * (unsigned)(u).lda + (unsigned)sC; \
        vB = (unsigned)sRb * (unsigned)(u).ldb + (unsigned)sC; } } while (0)
    Unit cur, nxt; int ui = 0;
    if (!S.next(0, cur)) return;
    f32x4 acc[2][2][4][2];
#pragma unroll
    for (int a = 0; a < 2; ++a)
#pragma unroll
        for (int b = 0; b < 2; ++b)
#pragma unroll
            for (int m = 0; m < 4; ++m)
#pragma unroll
                for (int n = 0; n < 2; ++n) acc[a][b][m][n] = (f32x4){0.f, 0.f, 0.f, 0.f};
    bf16x8 At[4][2], B0[2][2], B1[2][2];
    unsigned vA[2][NP], vB = 0u;
#pragma unroll
    for (int i = 0; i < NP; ++i) { vA[0][i] = 0u; vA[1][i] = 0u; }
    if (S.prefetch(cur, wid, lane)) { G8_WAIT_V0; G8_BAR; }
    G8_OFFS(cur, vA, vB);
    const char* cA = cur.A; const char* cB = cur.B; size_t hB = (size_t)128 * cur.ldb; size_t q32 = (size_t)RSTEP * cur.ldb;
    constexpr size_t kstep = 128;
    G8_STAGE_B(G8_SB(0, 0), cB, vB, q32); G8_STAGE_A(G8_SA(0, 0), cA, vA[0]); G8_STAGE_B(G8_SB(0, 1), cB + hB, vB, q32); G8_STAGE_A(G8_SA(0, 1), cA, vA[1]);
    if (wr == 1) G8_BAR;
    G8_WAIT_V8; G8_BAR;
    G8_STAGE_B(G8_SB(1, 0), cB + kstep, vB, q32); G8_STAGE_A(G8_SA(1, 0), cA + kstep, vA[0]); G8_STAGE_B(G8_SB(1, 1), cB + hB + kstep, vB, q32);
    G8_WAIT_V12; G8_BAR;
    for (;;) {
        bool has_next = false;
        const char* nA = cA; const char* nB = cB; size_t nhB = hB, nq32 = q32;
        const int nt = cur.nt;
#pragma unroll 1
        for (int t = 0; t < nt; t += 2) {
            const bool last = (t == nt - 2);
            const char* a1 = cA + (size_t)(t + 1) * kstep;
            G8_LDB(B0, 0, 0); G8_SCHED; G8_LDA(At, 0, 0); G8_STAGE_A(G8_SA(1, 1), a1, vA[1]);
            G8_WAIT_L(8); G8_BAR; G8_WAIT_L(0); G8_MMA(0, 0, At, B0); G8_BAR; G8_SCHED;
            if (t == 0) { Unit pf; if (S.next(ui + 1, pf)) (void)S.prefetch(pf, wid, lane); }
            const char* a2; const char* b2; size_t h2, q2;
            if (last) {
                has_next = S.next(ui + 1, nxt);
                if (has_next) { G8_OFFS(nxt, vA, vB); nA = nxt.A; nB = nxt.B; nhB = (size_t)128 * nxt.ldb; nq32 = (size_t)RSTEP * nxt.ldb; }
                a2 = nA; b2 = nB; h2 = nhB; q2 = nq32;
            } else { a2 = cA + (size_t)(t + 2) * kstep; b2 = cB + (size_t)(t + 2) * kstep; h2 = hB; q2 = q32; }
            const char* a3 = a2 + kstep; const char* b3 = b2 + kstep;
            G8_LDB(B1, 0, 1); G8_STAGE_B(G8_SB(0, 0), b2, vB, q2);
            G8_BAR; G8_WAIT_L(0); G8_MMA(0, 1, At, B1); G8_BAR;
            G8_LDA(At, 0, 1); G8_STAGE_A(G8_SA(0, 0), a2, vA[0]);
            G8_BAR; G8_WAIT_L(0); G8_MMA(1, 0, At, B0); G8_BAR; G8_SCHED;
            G8_STAGE_B(G8_SB(0, 1), b2 + h2, vB, q2);
            G8_WAIT_V12; G8_BAR; G8_MMA(1, 1, At, B1); G8_BAR;
            G8_LDB(B0, 1, 0); G8_SCHED; G8_LDA(At, 1, 0); G8_STAGE_A(G8_SA(0, 1), a2, vA[1]);
            G8_WAIT_L(8); G8_BAR; G8_WAIT_L(0); G8_MMA(0, 0, At, B0); G8_BAR; G8_SCHED;
            G8_LDB(B1, 1, 1); G8_STAGE_B(G8_SB(1, 0), b3, vB, q2);
            G8_BAR; G8_WAIT_L(0); G8_MMA(0, 1, At, B1); G8_BAR;
            G8_LDA(At, 1, 1); G8_STAGE_A(G8_SA(1, 0), a3, vA[0]);
            G8_BAR; G8_WAIT_L(0); G8_MMA(1, 0, At, B0); G8_BAR; G8_SCHED;
            G8_STAGE_B(G8_SB(1, 1), b3 + h2, vB, q2);
            G8_WAIT_V12; G8_BAR; G8_MMA(1, 1, At, B1); G8_BAR;
        }
        int tz = threadIdx.x; asm volatile("" : "+v"(tz));
        const int lane_e = tz & 63, fr_e = tz & 15, fq_e = (tz >> 4) & 3;
        {
            E.pre(acc, cur, wr, wc, fr_e, fq_e);
            constexpr int PITCH = NCH * 16 + 16;
            LAS unsigned char* ex = lds + EXCH_OFF;
            if (wr == 0) G8_BAR;
            if constexpr (Epi::OUT8) {
                constexpr int RB = NCH * 8, P8 = RB + 16;
#pragma unroll
                for (int ai = 0; ai < 2; ++ai)
#pragma unroll
                    for (int mh = 0; mh < 2; ++mh) {
#pragma unroll
                        for (int mm = 0; mm < 2; ++mm) {
                            u32x2 o8[2];
                            E.row8(acc, cur, ai, 2 * mh + mm, wr, wc, fr_e, fq_e, o8);
                            LAS unsigned char* rp = ex + (mm * 32 + wr * 16 + fr_e) * P8 + wc * 32 + 8 * fq_e;
                            *(LAS u32x2*)rp = o8[0];
                            if (NCH == 32) *(LAS u32x2*)(rp + 128) = o8[1];
                        }
                        epi_bar();
                        {
                            constexpr int CPR = RB / 16, RPI = 64 / CPR;
#pragma unroll
                            for (int i = 0; i < 8 / RPI; ++i) {
                                const int rl = 8 * wid + RPI * i + lane_e / CPR, ch = lane_e % CPR;
                                const int rt = ai * 128 + ((rl >> 4) & 1) * 64 + (2 * mh + (rl >> 5)) * 16 + (rl & 15);
                                const u32x4 d = *(const LAS u32x4*)(ex + rl * P8 + ch * 16);
                                E.store8(cur, rt, ch, d);
                            }
                        }
                        epi_bar();
                    }
            } else
#pragma unroll
            for (int ai = 0; ai < 2; ++ai)
#pragma unroll
                for (int m = 0; m < 4; ++m) {
                    u32x4 o[2];
                    E.row(acc, cur, ai, m, wr, wc, fr_e, fq_e, o);
                    if (NCH == 32) {
                        *(LAS u32x4*)(ex + (wr * 16 + fr_e) * PITCH + (wc * 32 + 8 * fq_e) * 2) = o[0];
                        *(LAS u32x4*)(ex + (wr * 16 + fr_e) * PITCH + (128 + wc * 32 + 8 * fq_e) * 2) = o[1];
                    } else {
                        *(LAS u32x4*)(ex + (wr * 16 + fr_e) * PITCH + (wc * 32 + 8 * fq_e) * 2) = o[0];
                    }
                    epi_bar();
                    if (storer) {
                        constexpr int RPI = 64 / NCH;
                        constexpr int RPW = SPLIT ? 8 : 4;
                        const int rbase = SPLIT ? 8 * wc : 4 * wid;
#pragma unroll
                        for (int i = 0; i < RPW / RPI; ++i) {
                            const int rl = rbase + RPI * i + lane_e / NCH, ch = lane_e % NCH;
                            const int rt = ai * 128 + (rl >> 4) * 64 + m * 16 + (rl & 15);
                            const u32x4 d = *(const LAS u32x4*)(ex + rl * PITCH + ch * 16);
                            E.store(cur, rt, ch, d);
                        }
                    }
                    epi_bar();
                }
            if (wr == 1) G8_BAR;
        }
        if (!has_next) break;
#pragma unroll
        for (int a = 0; a < 2; ++a)
#pragma unroll
            for (int b = 0; b < 2; ++b)
#pragma unroll
                for (int m = 0; m < 4; ++m)
#pragma unroll
                    for (int n = 0; n < 2; ++n) acc[a][b][m][n] = (f32x4){0.f, 0.f, 0.f, 0.f};
        cur = nxt; cA = nA; cB = nB; hB = nhB; q32 = nq32; ++ui;
    }
    G8_WAIT_V0;
    if (wr == 0) G8_BAR;
    G8_BAR;
#undef G8_SA
#undef G8_SB
#undef G8_STAGE_A
#undef G8_STAGE_B
#undef G8_LDA
#undef G8_LDB
#undef G8_MMA
#undef G8_WAIT_V8
#undef G8_WAIT_V12
#undef G8_WAIT_V0
#undef G8_WAIT_L
#undef G8_BAR
#undef G8_SCHED
#undef G8_OFFS
}
}

struct DenseSched {
    const char* A; const char* Bt; int nM, nN, lda, ldb, nt, G, c; int sel = 0;
    DI bool next(int i, g8::Unit& u) const {
        int pm, pn; if (!g8::static_tile(i * G + c, nM, nN, pm, pn)) return false;
        pm = __builtin_amdgcn_readfirstlane(pm); pn = __builtin_amdgcn_readfirstlane(pn);
        if (sel == 2) pn = pn + 30;
        u.A = A; u.B = Bt + (size_t)pn * 256 * ldb; u.row0 = pm * 256; u.lda = lda; u.ldb = ldb; u.nt = nt; u.pm = pm; u.pn = pn; u.aux = 0; u.keep = 0; u.e = 0; u.nvalid = 256; u.par = 0; return true;
    }
    DI int arow(const g8::Unit& u, int rr) const { return u.row0 + rr; }
    DI bool prefetch(const g8::Unit&, int, int) const { return false; }
};
constexpr int MOE_TAB_OFF = g8::STAGE_BYTES;
constexpr int MOE_TILE_OFF = g8::STAGE_BYTES + 1024;
constexpr int MOE_IDX_OFF = g8::STAGE_BYTES + 2048;
struct MoeSched {
    LAS unsigned char* lds; const int* list; const float* listw; const char* A; const char* W; int ncol, mode  , G, c;
    DI bool next(int i, g8::Unit& u) const {
        const LAS int* tpre = (const LAS int*)(lds + MOE_TAB_OFF);
        const int L = i * G + c; const int T = __builtin_amdgcn_readfirstlane(tpre[NEX]);
        if (L >= T * ncol) return false;
        const int gt = __builtin_amdgcn_readfirstlane(L / ncol), pn = L - gt * ncol;
        const int e = __builtin_amdgcn_readfirstlane((int)*(const LAS unsigned char*)(lds + MOE_TILE_OFF + gt));
        const int tile = gt - __builtin_amdgcn_readfirstlane(tpre[e]);
        const int n_e = __builtin_amdgcn_readfirstlane(tpre[NEX + 1 + e]);
        u.e = e; u.pm = tile; u.pn = pn; u.nvalid = min(256, n_e - tile * 256); u.keep = 0; u.aux = gt * 256; u.par = i & 1;
        if (mode == 0) { u.A = A; u.lda = 2048; u.ldb = 2048; u.nt = 16; u.B = W + ((size_t)e * 1024 + (size_t)pn * 256) * 2048; u.row0 = tile * 256; }
        else { u.A = A; u.lda = 512; u.ldb = 512; u.nt = 4; u.B = W + ((size_t)e * 2048 + (size_t)pn * 256) * 512; u.row0 = gt * 256; }
        return true;
    }
    DI bool prefetch(const g8::Unit& u, int wid, int lane) const {
        if (u.e < NE && wid < 4) {
            const int r = min(wid * 64 + lane, u.nvalid - 1);
            const size_t src = (size_t)u.e * LIST_CAP + u.pm * 256 + r;
            __builtin_amdgcn_global_load_lds((const unsigned*)(list + src), (LAS unsigned*)(lds + MOE_IDX_OFF + u.par * 2048 + wid * 256), 4, 0, 0);
            if (mode == 1) __builtin_amdgcn_global_load_lds((const unsigned*)(listw + src), (LAS unsigned*)(lds + MOE_IDX_OFF + u.par * 2048 + 1024 + wid * 256), 4, 0, 0);
        }
        return true;
    }
    DI int arow(const g8::Unit& u, int rr) const {
        if (mode == 1) return u.row0 + rr;
        if (u.e >= NE) return u.row0 + rr;
        return *(const LAS int*)(lds + MOE_IDX_OFF + u.par * 2048 + rr * 4) / 9;
    }
};

typedef f32x4 (&AccRef)[2][2][4][2];
DI u32x4 pack8(const f32x4& v0, const f32x4& v1) { u32x4 w; w.x = pk_bf16(v0[0], v0[1]); w.y = pk_bf16(v0[2], v0[3]); w.z = pk_bf16(v1[0], v1[1]); w.w = pk_bf16(v1[2], v1[3]); return w; }

struct EpiInProj { static constexpr bool OUT8 = false;
    bf16_t* proj; const float* rope;
    DI static int kind_of(int pn) { return pn < 6 ? 0 : pn < 12 ? 1 : pn < 18 ? 2 : pn < 22 ? 3 : pn < 30 ? 2 : 4; }
    DI void pre(AccRef acc, const g8::Unit& u, int wr, int wc, int fr, int fq) const {
        if (kind_of(u.pn) <= 1 && wc == 0) {
            const float sg = (fq < 2) ? -1.0f : 1.0f;
#pragma unroll
            for (int g = 0; g < 4; ++g) {
                const int ai = g >> 1;
                f32x4 cs[2][4];
#pragma unroll
                for (int mm = 0; mm < 2; ++mm) { const int m = (g & 1) * 2 + mm; const int row = u.pm * 256 + ai * 128 + wr * 64 + m * 16 + fr;
#pragma unroll
                    for (int q = 0; q < 4; ++q) cs[mm][q] = *(const f32x4*)(rope + (size_t)row * 32 + 16 * (fq & 1) + 4 * q); }
#pragma unroll
                for (int mm = 0; mm < 2; ++mm) { const int m = (g & 1) * 2 + mm;
#pragma unroll
                    for (int bj = 0; bj < 2; ++bj) {
                        f32x4 v0 = acc[ai][bj][m][0], v1 = acc[ai][bj][m][1], p0, p1;
#pragma unroll
                        for (int j = 0; j < 4; ++j) { p0[j] = __shfl_xor(v0[j], 32); p1[j] = __shfl_xor(v1[j], 32); }
#pragma unroll
                        for (int j = 0; j < 4; ++j) {
                            const float c0 = cs[mm][j >> 1][(j & 1) * 2], s0 = cs[mm][j >> 1][(j & 1) * 2 + 1];
                            const float c1 = cs[mm][2 + (j >> 1)][(j & 1) * 2], s1 = cs[mm][2 + (j >> 1)][(j & 1) * 2 + 1];
                            v0[j] = v0[j] * c0 + sg * p0[j] * s0;
                            v1[j] = v1[j] * c1 + sg * p1[j] * s1;
                        }
                        acc[ai][bj][m][0] = v0; acc[ai][bj][m][1] = v1;
                    }
                    asm volatile("" : "+v"(acc[ai][0][m][0]), "+v"(acc[ai][0][m][1]), "+v"(acc[ai][1][m][0]), "+v"(acc[ai][1][m][1]));
                }
                asm volatile("" ::: "memory");
            }
        }
    }
    DI void row(AccRef acc, const g8::Unit& u, int ai, int m, int wr, int wc, int fr, int fq, u32x4 (&o)[2]) const {
        const int kind = kind_of(u.pn);
#pragma unroll
        for (int bj = 0; bj < 2; ++bj) {
            f32x4 v0 = acc[ai][bj][m][0], v1 = acc[ai][bj][m][1];
            if (kind == 0 || kind == 3) { v0 *= QSCALE; v1 *= QSCALE; }
            if (kind == 4) {
#pragma unroll
                for (int j = 0; j < 4; ++j) { v0[j] = sigmoidf_(v0[j]); v1[j] = sigmoidf_(v1[j]); }
            }
            o[bj] = pack8(v0, v1);
        }
    }
    DI void store(const g8::Unit& u, int rt, int ch, const u32x4& d) const { __builtin_nontemporal_store(d, (u32x4*)(proj + (size_t)(u.pm * 256 + rt) * DIN + u.pn * 256 + ch * 8)); }
};
template <int PART> struct EpiGate { static constexpr bool OUT8 = false;
    const bf16_t* proj; const bf16_t* tmp; bf16_t* out;
    DI void pre(AccRef acc, const g8::Unit& u, int wr, int wc, int fr, int fq) const {
        const unsigned vo_g = (unsigned)(((wr * 64 + fr) * DIN + wc * 32 + 8 * fq) * 2), vo_t = (unsigned)(((wr * 64 + fr) * DM + wc * 32 + 8 * fq) * 2);
#pragma unroll
        for (int ai = 0; ai < 2; ++ai)
#pragma unroll
            for (int m = 0; m < 4; ++m) {
#pragma unroll
                for (int bj = 0; bj < 2; ++bj) {
                    gcptr sg = (gcptr)(proj + (size_t)(u.pm * 256 + ai * 128 + m * 16) * DIN + u.pn * 256 + bj * 128 + (PART == 0 ? COL_GD : COL_GS));
                    asm volatile("" : "+s"(sg));
                    const u32x4 gg = *(gu4ptr)(sg + vo_g);
                    const float sv[8] = {bf_lo(gg.x), bf_hi(gg.x), bf_lo(gg.y), bf_hi(gg.y), bf_lo(gg.z), bf_hi(gg.z), bf_lo(gg.w), bf_hi(gg.w)};
                    if (PART == 0) {
#pragma unroll
                        for (int j = 0; j < 4; ++j) { acc[ai][bj][m][0][j] *= sv[j]; acc[ai][bj][m][1][j] *= sv[4 + j]; }
                    } else {
                        gcptr st = (gcptr)(tmp + (size_t)(u.pm * 256 + ai * 128 + m * 16) * DM + u.pn * 256 + bj * 128);
                        asm volatile("" : "+s"(st));
                        const u32x4 tt = *(gu4ptr)(st + vo_t);
                        const float tv[8] = {bf_lo(tt.x), bf_hi(tt.x), bf_lo(tt.y), bf_hi(tt.y), bf_lo(tt.z), bf_hi(tt.z), bf_lo(tt.w), bf_hi(tt.w)};
#pragma unroll
                        for (int j = 0; j < 4; ++j) { acc[ai][bj][m][0][j] = acc[ai][bj][m][0][j] * sv[j] + tv[j]; acc[ai][bj][m][1][j] = acc[ai][bj][m][1][j] * sv[4 + j] + tv[4 + j]; }
                    }
                }
                asm volatile("" : "+v"(acc[ai][0][m][0]), "+v"(acc[ai][0][m][1]), "+v"(acc[ai][1][m][0]), "+v"(acc[ai][1][m][1]));
                if (m & 1) asm volatile("" ::: "memory");
            }
    }
    DI void row(AccRef acc, const g8::Unit&, int ai, int m, int, int, int, int, u32x4 (&o)[2]) const {
        o[0] = pack8(acc[ai][0][m][0], acc[ai][0][m][1]); o[1] = pack8(acc[ai][1][m][0], acc[ai][1][m][1]);
    }
    DI void store(const g8::Unit& u, int rt, int ch, const u32x4& d) const { *(u32x4*)(out + (size_t)(u.pm * 256 + rt) * DM + u.pn * 256 + ch * 8) = d; }
};
struct EpiPlain { static constexpr bool OUT8 = false;
    bf16_t* out; int ld;
    DI void pre(AccRef, const g8::Unit&, int, int, int, int) const {}
    DI void row(AccRef acc, const g8::Unit&, int ai, int m, int, int, int, int, u32x4 (&o)[2]) const {
        o[0] = pack8(acc[ai][0][m][0], acc[ai][0][m][1]); o[1] = pack8(acc[ai][1][m][0], acc[ai][1][m][1]);
    }
    DI void store(const g8::Unit& u, int rt, int ch, const u32x4& d) const { *(u32x4*)(out + (size_t)(u.pm * 256 + rt) * ld + u.pn * 256 + ch * 8) = d; }
};
struct EpiGateUp { static constexpr bool OUT8 = true;
    unsigned char* hid;
    DI void pre(AccRef, const g8::Unit&, int, int, int, int) const {}
    DI void row(AccRef, const g8::Unit&, int, int, int, int, int, int, u32x4 (&)[2]) const {}
    DI void store(const g8::Unit&, int, int, const u32x4&) const {}
    DI void row8(AccRef acc, const g8::Unit&, int ai, int m, int, int, int, int, u32x2 (&o)[2]) const {
        const f32x4 g0 = acc[ai][0][m][0], g1 = acc[ai][0][m][1], u0 = acc[ai][1][m][0], u1 = acc[ai][1][m][1];
        f32x4 v0, v1;
#pragma unroll
        for (int j = 0; j < 4; ++j) { v0[j] = g0[j] * __builtin_amdgcn_rcpf(1.0f + __expf(-g0[j])) * u0[j]; v1[j] = g1[j] * __builtin_amdgcn_rcpf(1.0f + __expf(-g1[j])) * u1[j]; }
        o[0].x = pk_fp8x4(v0[0], v0[1], v0[2], v0[3]); o[0].y = pk_fp8x4(v1[0], v1[1], v1[2], v1[3]); o[1] = o[0];
    }
    DI void store8(const g8::Unit& u, int rt, int ch, const u32x4& d) const { *(u32x4*)(hid + (size_t)(u.aux + rt) * DE + u.pn * 128 + ch * 16) = d; }
};
struct EpiDown { static constexpr bool OUT8 = true;
    LAS unsigned char* lds; unsigned char* yb9; int* slot;
    DI void pre(AccRef, const g8::Unit&, int, int, int, int) const {}
    DI void row(AccRef, const g8::Unit&, int, int, int, int, int, int, u32x4 (&)[2]) const {}
    DI void store(const g8::Unit&, int, int, const u32x4&) const {}
    DI void row8(AccRef acc, const g8::Unit& u, int ai, int m, int wr, int, int fr, int, u32x2 (&o)[2]) const {
        const int rt = ai * 128 + wr * 64 + m * 16 + fr;
        const float wgt = (u.e < NE) ? *(const LAS float*)(lds + MOE_IDX_OFF + u.par * 2048 + 1024 + rt * 4) : 1.0f;
#pragma unroll
        for (int bj = 0; bj < 2; ++bj) {
            const f32x4 v0 = acc[ai][bj][m][0] * wgt, v1 = acc[ai][bj][m][1] * wgt;
            o[bj].x = pk_fp8x4(v0[0], v0[1], v0[2], v0[3]); o[bj].y = pk_fp8x4(v1[0], v1[1], v1[2], v1[3]);
        }
    }
    DI void store8(const g8::Unit& u, int rt, int ch, const u32x4& d) const {
        if (rt < u.nvalid) {
            const int srow = u.aux + rt;
            __builtin_nontemporal_store(d, (u32x4*)(yb9 + ((size_t)u.pn * YB_SLOTS + srow) * 256 + ch * 16));
            if (u.pn == 0 && ch == 0) {
                const int v = (u.e < NE) ? *(const LAS int*)(lds + MOE_IDX_OFF + u.par * 2048 + rt * 4) : (u.pm * 256 + rt) * 9 + 8;
                slot[v] = srow;
            }
        }
    }
};

DI void phase_inproj(const Params& p, LAS unsigned char* lds) {
    EpiInProj E{(bf16_t*)(p.ws + WS_PROJ), (const float*)(p.ws + WS_ROPE)};
    { DenseSched S{(const char*)(p.ws + WS_H8), (const char*)(p.ws + WS_WTIN8), 64, 46, 2048, 2048, 16, (int)gridDim.x, (int)blockIdx.x, 0};
      g8::gemm_phase<32, 0, GEMM_SPLIT, true>(lds, S, E); }
}
DI void phase_outproj_a(const Params& p, LAS unsigned char* lds) {
    DenseSched S{(const char*)(p.ws + WS_ODIL), (const char*)(p.ws + WS_WTDIL), 64, 8, 1024, 1024, 8, (int)gridDim.x, (int)blockIdx.x};
    EpiGate<0> E{(const bf16_t*)(p.ws + WS_PROJ), nullptr, (bf16_t*)(p.ws + WS_TMP)};
    g8::gemm_phase<32, 0, GEMM_SPLIT, false>(lds, S, E);
}
DI void phase_outproj_b(const Params& p, LAS unsigned char* lds) {
    DenseSched S{(const char*)(p.ws + WS_OSB), (const char*)(p.ws + WS_WTSB), 64, 8, 2048, 2048, 16, (int)gridDim.x, (int)blockIdx.x};
    EpiGate<1> E{(const bf16_t*)(p.ws + WS_PROJ), (const bf16_t*)(p.ws + WS_TMP), (bf16_t*)(p.ws + WS_H)};
    g8::gemm_phase<32, 0, GEMM_SPLIT, false>(lds, S, E);
}
DI void phase_mixout(const Params& p, LAS unsigned char* lds) {
    DenseSched S{(const char*)(p.ws + WS_H), (const char*)(p.ws + WS_WTMIX), 64, 8, 4096, 4096, 32, (int)gridDim.x, (int)blockIdx.x};
    EpiPlain E{(bf16_t*)(p.ws + WS_Y), DM};
    g8::gemm_phase<32, 0, GEMM_SPLIT, false>(lds, S, E);
}
DI void moe_tables(const Params& p, LAS unsigned char* lds) {
    LAS int* tpre = (LAS int*)(lds + MOE_TAB_OFF);
    const int* cnt = (const int*)(p.ws + WS_CNT);
    if (threadIdx.x == 0) {
        int acc = 0;
        for (int e = 0; e < NE; ++e) { const int n = cnt[e]; tpre[e] = acc; tpre[NEX + 1 + e] = n; acc += (n + 255) >> 8; }
        tpre[NE] = acc; tpre[NEX + 1 + NE] = NTOK; acc += NTOK / 256; tpre[NEX] = acc;
    }
    __syncthreads();
    const int T = tpre[NEX];
    for (int t = threadIdx.x; t < T; t += 512) {
        int e = 0;
        for (int q = 1; q < NEX; ++q) e = (tpre[q] <= t) ? q : e;
        *(LAS unsigned char*)(lds + MOE_TILE_OFF + t) = (unsigned char)e;
    }
    __syncthreads();
}
DI void phase_gateup(const Params& p, LAS unsigned char* lds) {
    moe_tables(p, lds);
    MoeSched S{lds, (const int*)(p.ws + WS_LIST), (const float*)(p.ws + WS_LISTW), (const char*)(p.ws + WS_H), (const char*)(p.ws + WS_WGU), 4, 0, (int)gridDim.x, (int)blockIdx.x};
    EpiGateUp E{(unsigned char*)(p.ws + WS_HID)};
    g8::gemm_phase<16, MOE_BAUX, GEMM_SPLIT, true>(lds, S, E);
}
DI void phase_down(const Params& p, LAS unsigned char* lds) {
    moe_tables(p, lds);
    MoeSched S{lds, (const int*)(p.ws + WS_LIST), (const float*)(p.ws + WS_LISTW), (const char*)(p.ws + WS_HID), (const char*)(p.ws + WS_WD), 8, 1, (int)gridDim.x, (int)blockIdx.x};
    EpiDown E{lds, (unsigned char*)(p.ws + WS_YB9), (int*)(p.ws + WS_SLOT)};
    g8::gemm_phase<32, MOE_BAUX, GEMM_SPLIT, true>(lds, S, E);
}

namespace att {
constexpr int TB = 16384;
DI unsigned off_b(unsigned row, unsigned ch) { return 256u * row + 16u * (ch ^ (((row & 3u) << 2) | ((row >> 2) & 3u))); }
DI int crow(int i, int h) { return (i & 3) + 8 * (i >> 2) + 4 * h; }
DI f32x16 mfma32(bf16x8 a, bf16x8 b, f32x16 c) { return __builtin_amdgcn_mfma_f32_32x32x16_bf16(a, b, c, 0, 0, 0); }
DI bf16x8 pack8(const f32x16& x, int s) {
    u32x4 w; w.x = pk_bf16(x[8 * s + 0], x[8 * s + 1]); w.y = pk_bf16(x[8 * s + 2], x[8 * s + 3]); w.z = pk_bf16(x[8 * s + 4], x[8 * s + 5]); w.w = pk_bf16(x[8 * s + 6], x[8 * s + 7]);
    return __builtin_bit_cast(bf16x8, w);
}
DI void qk_tile(LAS const unsigned char* Kb, const bf16x8 (&qf)[8], f32x16& x0, f32x16& x1, int r, int h) {
#pragma unroll
    for (int i = 0; i < 16; ++i) { x0[i] = 0.f; x1[i] = 0.f; }
#pragma unroll
    for (int s = 0; s < 8; ++s) {
        const bf16x8 a0 = *(const LAS bf16x8*)(Kb + off_b(r, 2 * s + h));
        const bf16x8 a1 = *(const LAS bf16x8*)(Kb + off_b(32 + r, 2 * s + h));
        x0 = mfma32(a0, qf[s], x0); x1 = mfma32(a1, qf[s], x1);
    }
}
DI void pv_tile(LAS const unsigned char* Vb, const f32x16& p0, const f32x16& p1, f32x16 (&o)[4], int lane) {
    const int h = lane >> 5, blk = (lane >> 4) & 1, q = (lane & 15) >> 2, pp = lane & 3;
#pragma unroll
    for (int kb = 0; kb < 2; ++kb)
#pragma unroll
        for (int s = 0; s < 2; ++s) {
            const bf16x8 pf = pack8(kb ? p1 : p0, s);
#pragma unroll
            for (int db = 0; db < 4; ++db) {
                const unsigned row0 = 32 * kb + 16 * s + 4 * h + q;
                const unsigned ch = 4 * db + 2 * blk + (pp >> 1);
                const s16x4 t0 = __builtin_amdgcn_ds_read_tr16_b64_v4i16((LAS s16x4*)(Vb + off_b(row0, ch) + 8 * (pp & 1)));
                const s16x4 t1 = __builtin_amdgcn_ds_read_tr16_b64_v4i16((LAS s16x4*)(Vb + off_b(row0 + 8, ch) + 8 * (pp & 1)));
                const bf16x8 vf = {t0[0], t0[1], t0[2], t0[3], t1[0], t1[1], t1[2], t1[3]};
                o[db] = mfma32(vf, pf, o[db]);
            }
        }
}
DI void store_o(bf16_t* orow, const f32x16 (&o)[4], float scale, int h) {
#pragma unroll
    for (int db = 0; db < 4; ++db)
#pragma unroll
        for (int g = 0; g < 4; ++g) {
            u32x2 w; w.x = pk_bf16(o[db][4 * g] * scale, o[db][4 * g + 1] * scale); w.y = pk_bf16(o[db][4 * g + 2] * scale, o[db][4 * g + 3] * scale);
            *(u32x2*)(orow + 32 * db + 8 * g + 4 * h) = w;
        }
}

DI void sb_item(const Params& p, LAS unsigned char* lds, int b, int hd, int Q) {
    const bf16_t* proj = (const bf16_t*)(p.ws + WS_PROJ);
    bf16_t* osb = (bf16_t*)(p.ws + WS_OSB);
    const int tid = threadIdx.x, wid = __builtin_amdgcn_readfirstlane(tid >> 6), lane = tid & 63, r = lane & 31, h = lane >> 5;
    const size_t tokbase = (size_t)b * SEQ;
    const int wq0 = Q * 256 + 32 * wid;
    const int myq = wq0 + r;
    bf16x8 qf[8];
    f32x16 o[4];
#pragma unroll
    for (int db = 0; db < 4; ++db)
#pragma unroll
        for (int i = 0; i < 16; ++i) o[db][i] = 0.f;
    float R = 0.f;
    unsigned goff[2];
#pragma unroll
    for (int i = 0; i < 2; ++i) { const unsigned row = 4 * (wid * 2 + i) + (lane >> 4), cp = lane & 15, ch = cp ^ (((row & 3u) << 2) | ((row >> 2) & 3u)); goff[i] = (row * DIN + ch * 8) * 2; }
    const char* kbase = (const char*)(proj + tokbase * DIN + COL_KS + hd * 128);
    const char* vbase = (const char*)(proj + tokbase * DIN + COL_VS + hd * 128);
#define ATT_ISSUE(key0_, buf_) do { const size_t _ko = (size_t)(key0_) * DIN * 2; _Pragma("unroll") for (int _i = 0; _i < 2; ++_i) { \
        __builtin_amdgcn_global_load_lds((const unsigned*)(kbase + _ko + goff[_i]), (LAS unsigned*)(lds + (buf_) * TB + 1024 * (wid * 2 + _i)), 16, 0, 0); \
        __builtin_amdgcn_global_load_lds((const unsigned*)(vbase + _ko + goff[_i]), (LAS unsigned*)(lds + 3 * TB + (buf_) * TB + 1024 * (wid * 2 + _i)), 16, 0, 0); } } while (0)
    int j = 4 * Q + 3;
    ATT_ISSUE(64 * j, 0);
    ATT_ISSUE(64 * (j - 1), 1);
    {
        const bf16_t* qrow = proj + (tokbase + myq) * DIN + COL_QS + hd * 128;
#pragma unroll
        for (int s = 0; s < 8; ++s) qf[s] = *(const bf16x8*)(qrow + 16 * s + 8 * h);
#pragma unroll
        for (int s = 0; s < 8; ++s) asm volatile("" : "+v"(qf[s]));
    }
    int cur = 0;
    for (; j >= 0; --j) {
        LAS unsigned char* Kb = lds + cur * TB; LAS unsigned char* Vb = lds + 3 * TB + cur * TB;
        if (j > 0) asm volatile("s_waitcnt vmcnt(4)" ::: "memory"); else asm volatile("s_waitcnt vmcnt(0)" ::: "memory");
        __builtin_amdgcn_s_barrier(); asm volatile("" ::: "memory");
        if (j > 1) ATT_ISSUE(64 * (j - 2), cur == 0 ? 2 : cur - 1);
        const int key0 = 64 * j;
        if (key0 < wq0 + 31) {
            const bool need_mask = (key0 + 63 >= wq0);
            f32x16 x0, x1;
            qk_tile(Kb, qf, x0, x1, r, h);
            f32x16 l0, l1;
#pragma unroll
            for (int i = 0; i < 16; ++i) {
                l0[i] = __builtin_amdgcn_logf(1.0f + __builtin_amdgcn_exp2f(x0[i]));
                l1[i] = __builtin_amdgcn_logf(1.0f + __builtin_amdgcn_exp2f(x1[i]));
            }
            if (need_mask) {
#pragma unroll
                for (int i = 0; i < 16; ++i) { const int kk = key0 + crow(i, h); if (kk >= myq) l0[i] = 0.f; if (kk + 32 >= myq) l1[i] = 0.f; }
            }
#pragma unroll
            for (int g = 0; g < 4; ++g) {
                l0[4 * g + 2] += l0[4 * g + 3]; l0[4 * g + 1] += l0[4 * g + 2]; l0[4 * g] += l0[4 * g + 1];
                l1[4 * g + 2] += l1[4 * g + 3]; l1[4 * g + 1] += l1[4 * g + 2]; l1[4 * g] += l1[4 * g + 1];
            }
            float Tlo[8], Thi[8];
#pragma unroll
            for (int g = 0; g < 4; ++g) {
                { const unsigned t = __float_as_uint(l0[4 * g]); auto sw = __builtin_amdgcn_permlane32_swap(t, t, false, false); Tlo[g] = __uint_as_float(sw[0]); Thi[g] = __uint_as_float(sw[1]); }
                { const unsigned t = __float_as_uint(l1[4 * g]); auto sw = __builtin_amdgcn_permlane32_swap(t, t, false, false); Tlo[4 + g] = __uint_as_float(sw[0]); Thi[4 + g] = __uint_as_float(sw[1]); }
            }
            float offR[8];
            float run = 0.f;
#pragma unroll
            for (int g = 7; g >= 0; --g) { offR[g] = run + (h == 0 ? Thi[g] : 0.f) + R; run += Tlo[g] + Thi[g]; }
            f32x16 p0, p1;
#pragma unroll
            for (int i = 0; i < 16; ++i) {
                p0[i] = __builtin_amdgcn_exp2f(x0[i] - (l0[i] + offR[i >> 2]));
                p1[i] = __builtin_amdgcn_exp2f(x1[i] - (l1[i] + offR[4 + (i >> 2)]));
            }
            if (need_mask) {
#pragma unroll
                for (int i = 0; i < 16; ++i) { const int kk = key0 + crow(i, h); if (kk >= myq) p0[i] = 0.f; if (kk + 32 >= myq) p1[i] = 0.f; }
            }
            R += run;
            pv_tile(Vb, p0, p1, o, lane);
        }
        cur = (cur == 2) ? 0 : cur + 1;
    }
    store_o(osb + (tokbase + myq) * 1024 + hd * 128, o, 1.0f, h);
    __syncthreads();
}

DI void dil_item(const Params& p, LAS unsigned char* lds, int di) {
    const bf16_t* proj = (const bf16_t*)(p.ws + WS_PROJ);
    bf16_t* og = (bf16_t*)(p.ws + WS_OG);
    float* lse = (float*)(p.ws + WS_LSE);
    const int b = di / 192; const int rem = di - b * 192; const int head = rem >> 4, sub = rem & 15;
    const int grp = head >> 2;
    const int dil = grp == 0 ? 1 : grp == 1 ? 4 : 16;
    const int nblk = 16 / dil;
    const int res = sub / nblk, Qb = sub - res * nblk;
    const int i0 = Qb * 256;
    const int tid = threadIdx.x, wid = __builtin_amdgcn_readfirstlane(tid >> 6), lane = tid & 63, r = lane & 31, h = lane >> 5;
    const size_t tokbase = (size_t)b * SEQ;
    const int wq0 = i0 + 32 * wid;
    const int myqi = wq0 + r;
    const size_t mytok = tokbase + (size_t)myqi * dil + res;
    bf16x8 qf[8];
    f32x16 o[4];
#pragma unroll
    for (int db = 0; db < 4; ++db)
#pragma unroll
        for (int i = 0; i < 16; ++i) o[db][i] = 0.f;
    float mrun = -1e30f, lrun = 0.f;
    unsigned goff[2];
#pragma unroll
    for (int i = 0; i < 2; ++i) { const unsigned row = 4 * (wid * 2 + i) + (lane >> 4), cp = lane & 15, ch = cp ^ (((row & 3u) << 2) | ((row >> 2) & 3u)); goff[i] = (row * dil * DIN + ch * 8) * 2; }
    const char* kbase = (const char*)(proj + (tokbase + res) * DIN + COL_KA + head * 128);
    const char* vbase = (const char*)(proj + (tokbase + res) * DIN + COL_VA + head * 128);
    const int jt0 = (i0 == 0) ? 2 : 0;
    ATT_ISSUE((i0 - 128 + 64 * jt0) * dil, 0);
    ATT_ISSUE((i0 - 128 + 64 * (jt0 + 1)) * dil, 1);
    {
        const bf16_t* qrow = proj + mytok * DIN + COL_QA + head * 128;
#pragma unroll
        for (int s = 0; s < 8; ++s) qf[s] = *(const bf16x8*)(qrow + 16 * s + 8 * h);
#pragma unroll
        for (int s = 0; s < 8; ++s) asm volatile("" : "+v"(qf[s]));
    }
    int cur = 0;
    for (int jt = jt0; jt < 6; ++jt) {
        LAS unsigned char* Kb = lds + cur * TB; LAS unsigned char* Vb = lds + 3 * TB + cur * TB;
        if (jt < 5) asm volatile("s_waitcnt vmcnt(4)" ::: "memory"); else asm volatile("s_waitcnt vmcnt(0)" ::: "memory");
        __builtin_amdgcn_s_barrier(); asm volatile("" ::: "memory");
        if (jt < 4) ATT_ISSUE((i0 - 128 + 64 * (jt + 2)) * dil, cur == 0 ? 2 : cur - 1);
        const int ki0 = i0 - 128 + 64 * jt;
        if (ki0 <= wq0 + 31 && ki0 + 63 >= wq0 - 128) {
            f32x16 x0, x1;
            qk_tile(Kb, qf, x0, x1, r, h);
            const float NEG = -__builtin_inff();
#pragma unroll
            for (int i = 0; i < 16; ++i) {
                const int d0 = myqi - (ki0 + crow(i, h));
                if ((unsigned)d0 > 128u) x0[i] = NEG;
                if ((unsigned)(d0 - 32) > 128u) x1[i] = NEG;
            }
            float mx = x0[0];
#pragma unroll
            for (int i = 1; i < 16; ++i) mx = fmaxf(mx, x0[i]);
#pragma unroll
            for (int i = 0; i < 16; ++i) mx = fmaxf(mx, x1[i]);
            { const unsigned t = __float_as_uint(mx); auto sw = __builtin_amdgcn_permlane32_swap(t, t, false, false); mx = fmaxf(__uint_as_float(sw[0]), __uint_as_float(sw[1])); }
            const float mn = fmaxf(mrun, mx);
            const float alpha = __builtin_amdgcn_exp2f(mrun - mn);
            mrun = mn;
            f32x16 p0, p1; float rs = 0.f;
#pragma unroll
            for (int i = 0; i < 16; ++i) { p0[i] = __builtin_amdgcn_exp2f(x0[i] - mn); p1[i] = __builtin_amdgcn_exp2f(x1[i] - mn); rs += p0[i] + p1[i]; }
            { const unsigned t = __float_as_uint(rs); auto sw = __builtin_amdgcn_permlane32_swap(t, t, false, false); rs = __uint_as_float(sw[0]) + __uint_as_float(sw[1]); }
            lrun = lrun * alpha + rs;
#pragma unroll
            for (int db = 0; db < 4; ++db)
#pragma unroll
                for (int i = 0; i < 16; ++i) o[db][i] *= alpha;
            pv_tile(Vb, p0, p1, o, lane);
        }
        cur = (cur == 2) ? 0 : cur + 1;
    }
    store_o(og + mytok * 1536 + head * 128, o, 1.0f / lrun, h);
    if (h == 0) lse[mytok * 12 + head] = (mrun + __builtin_amdgcn_logf(lrun)) * LN2;
    __syncthreads();
}
#undef ATT_ISSUE
}

DI void phase_attn(const Params& p, LAS unsigned char* lds) {
    for (int it = blockIdx.x; it < 1024; it += gridDim.x) {
        if (it < 256) {
            const int xcd = it & 7, rest = it >> 3, bhi = rest >> 3, x = rest & 7, bh = xcd * 4 + bhi;
            att::sb_item(p, lds, bh >> 3, bh & 7, 15 - x);
            att::sb_item(p, lds, bh >> 3, bh & 7, x);
        } else att::dil_item(p, lds, it - 256);
    }
}

DI void phase_merge(const Params& p) {
    const int lane = threadIdx.x & 63, wid = threadIdx.x >> 6;
    const bf16_t* og = (const bf16_t*)(p.ws + WS_OG); const float* lse = (const float*)(p.ws + WS_LSE); bf16_t* odil = (bf16_t*)(p.ws + WS_ODIL);
    const int hg = lane >> 4, d0 = (lane & 15) * 8;
    for (int tok = blockIdx.x * 8 + wid; tok < NTOK; tok += gridDim.x * 8) {
        const float l0 = lse[(size_t)tok * 12 + hg], l1 = lse[(size_t)tok * 12 + 4 + hg], l2 = lse[(size_t)tok * 12 + 8 + hg];
        const float mx = fmaxf(l0, fmaxf(l1, l2));
        float w0 = __expf(l0 - mx), w1 = __expf(l1 - mx), w2 = __expf(l2 - mx);
        const float inv = 1.0f / (w0 + w1 + w2); w0 *= inv; w1 *= inv; w2 *= inv;
        const u32x4 a = *(const u32x4*)(og + (size_t)tok * 1536 + hg * 128 + d0);
        const u32x4 bq = *(const u32x4*)(og + (size_t)tok * 1536 + (4 + hg) * 128 + d0);
        const u32x4 c = *(const u32x4*)(og + (size_t)tok * 1536 + (8 + hg) * 128 + d0);
        u32x4 o;
#pragma unroll
        for (int q = 0; q < 4; ++q) {
            const float lo = w0 * bf_lo(a[q]) + w1 * bf_lo(bq[q]) + w2 * bf_lo(c[q]);
            const float hi = w0 * bf_hi(a[q]) + w1 * bf_hi(bq[q]) + w2 * bf_hi(c[q]);
            o[q] = pk_bf16(lo, hi);
        }
        *(u32x4*)(odil + (size_t)tok * 512 + hg * 128 + d0) = o;
    }
}

DI void phase_postmix(const Params& p, LAS unsigned char* lds) {
    const int tid = threadIdx.x, lane = tid & 63, wid = __builtin_amdgcn_readfirstlane(tid >> 6);
    LAS float* hsm = (LAS float*)lds;
    LAS float* part = (LAS float*)(lds + 131072);
    const float* mod = (const float*)(p.ws + WS_MOD); const bf16_t* y = (const bf16_t*)(p.ws + WS_Y);
    unsigned char* h2 = (unsigned char*)(p.ws + WS_H);
    int* cnt = (int*)(p.ws + WS_CNT); int* list = (int*)(p.ws + WS_LIST); float* listw = (float*)(p.ws + WS_LISTW);
    const bf16_t* wr_hi = (const bf16_t*)(p.ws + WS_WRT); const bf16_t* wr_lo = wr_hi + 64 * 2048;
    LAS int* lcnt = (LAS int*)(lds + 147456);
    LAS int* lbase = (LAS int*)(lds + 147712);
    LAS unsigned char* sel_e = lds + 147968;
    LAS unsigned short* sel_r = (LAS unsigned short*)(lds + 150016);
    LAS float* sel_w = (LAS float*)(lds + 154112);
    if (tid < 64) lcnt[tid] = 0;
    int itl = 0;
    for (int it = blockIdx.x; it < NTOK / 16; it += gridDim.x, ++itl) {
#pragma unroll 1
        for (int sub = 0; sub < 2; ++sub) {
            const int tl = 2 * wid + sub, tok = it * 16 + tl, b = tok >> 12;
            f32x4 v[8]; float ss = 0.f;
#pragma unroll
            for (int i = 0; i < 8; ++i) { const u32x2 yw = *(const u32x2*)(y + (size_t)tok * DM + 4 * (lane + 64 * i)); v[i] = (f32x4){bf_lo(yw.x), bf_hi(yw.x), bf_lo(yw.y), bf_hi(yw.y)}; ss += v[i][0] * v[i][0] + v[i][1] * v[i][1] + v[i][2] * v[i][2] + v[i][3] * v[i][3]; }
            ss = wave_sum(ss);
            const float rstd = rsqrtf(ss * (1.0f / DM) + RMS_EPS);
            float ss1 = 0.f;
#pragma unroll
            for (int i = 0; i < 8; ++i) {
                const int ch = 4 * (lane + 64 * i);
                const f32x4 g = *(const f32x4*)(p.g_post_mix + ch);
                const f32x4 gt = *(const f32x4*)(mod + b * 12288 + 4096 + ch);
                const f32x4 xv = *(const f32x4*)(p.x + (size_t)tok * DM + ch);
#pragma unroll
                for (int j = 0; j < 4; ++j) { v[i][j] = xv[j] + gt[j] * (v[i][j] * rstd * g[j]); ss1 += v[i][j] * v[i][j]; }
                *(f32x4*)(p.out + (size_t)tok * DM + ch) = v[i];
            }
            ss1 = wave_sum(ss1);
            const float rstd1 = rsqrtf(ss1 * (1.0f / DM) + RMS_EPS);
#pragma unroll
            for (int i = 0; i < 8; ++i) {
                const int ch = 4 * (lane + 64 * i);
                const f32x4 g = *(const f32x4*)(p.g_pre_ffn + ch);
                const f32x4 sh = *(const f32x4*)(mod + b * 12288 + 6144 + ch);
                const f32x4 sc = *(const f32x4*)(mod + b * 12288 + 8192 + ch);
                f32x4 o;
#pragma unroll
                for (int j = 0; j < 4; ++j) o[j] = v[i][j] * rstd1 * g[j] * (1.0f + sc[j]) + sh[j];
                *(unsigned*)(h2 + (size_t)tok * DM + ch) = pk_fp8x4(o[0], o[1], o[2], o[3]);
                *(LAS f32x4*)(hsm + tl * 2048 + ch) = o;
            }
        }
        __syncthreads();
        f32x4 acc[4];
        {
            const int tr = lane & 15, kq = lane >> 4;
#pragma unroll
            for (int q = 0; q < 4; ++q) acc[q] = (f32x4){0.f, 0.f, 0.f, 0.f};
#pragma unroll 4
            for (int ks = 0; ks < 8; ++ks) {
                const int k0 = 256 * wid + 32 * ks + 8 * kq;
                const f32x4 a0 = *(const LAS f32x4*)(hsm + tr * 2048 + k0), a1 = *(const LAS f32x4*)(hsm + tr * 2048 + k0 + 4);
                u32x4 hw, lw;
                {
                    float xs[8] = {a0[0], a0[1], a0[2], a0[3], a1[0], a1[1], a1[2], a1[3]};
                    unsigned hh[4], ll[4];
#pragma unroll
                    for (int q = 0; q < 4; ++q) {
                        hh[q] = pk_bf16(xs[2 * q], xs[2 * q + 1]);
                        ll[q] = pk_bf16(xs[2 * q] - bf_lo(hh[q]), xs[2 * q + 1] - bf_hi(hh[q]));
                    }
                    hw = (u32x4){hh[0], hh[1], hh[2], hh[3]}; lw = (u32x4){ll[0], ll[1], ll[2], ll[3]};
                }
                const bf16x8 ah = __builtin_bit_cast(bf16x8, hw), al = __builtin_bit_cast(bf16x8, lw);
#pragma unroll
                for (int q = 0; q < 4; ++q) {
                    const bf16x8 bh = *(const bf16x8*)(wr_hi + (size_t)(16 * q + tr) * 2048 + k0);
                    const bf16x8 bl = *(const bf16x8*)(wr_lo + (size_t)(16 * q + tr) * 2048 + k0);
                    acc[q] = __builtin_amdgcn_mfma_f32_16x16x32_bf16(ah, bh, acc[q], 0, 0, 0);
                    acc[q] = __builtin_amdgcn_mfma_f32_16x16x32_bf16(ah, bl, acc[q], 0, 0, 0);
                    acc[q] = __builtin_amdgcn_mfma_f32_16x16x32_bf16(al, bh, acc[q], 0, 0, 0);
                }
            }
            if (wid >= 4) {
#pragma unroll
                for (int q = 0; q < 4; ++q)
#pragma unroll
                    for (int j = 0; j < 4; ++j) part[((wid - 4) * 16 + 4 * kq + j) * 64 + 16 * q + tr] = acc[q][j];
            }
        }
        __syncthreads();
        if (wid < 4) {
            const int tr = lane & 15, kq = lane >> 4;
#pragma unroll
            for (int q = 0; q < 4; ++q)
#pragma unroll
                for (int j = 0; j < 4; ++j) part[(wid * 16 + 4 * kq + j) * 64 + 16 * q + tr] += acc[q][j];
        }
        __syncthreads();
#pragma unroll 1
        for (int sub = 0; sub < 2; ++sub) {
            const int tl = 2 * wid + sub, tok = it * 16 + tl;
            const float logit = ((part[(0 * 16 + tl) * 64 + lane] + part[(1 * 16 + tl) * 64 + lane]) + part[(2 * 16 + tl) * 64 + lane]) + part[(3 * 16 + tl) * 64 + lane];
            const float score = 1.0f / (1.0f + __expf(-logit));
            const float sel = score + p.router_bias[lane];
            float m1 = sel;
            m1 = fmaxf(m1, __shfl_xor(m1, 1)); m1 = fmaxf(m1, __shfl_xor(m1, 2)); m1 = fmaxf(m1, __shfl_xor(m1, 4));
            const bool is1 = (sel == m1);
            const unsigned long long bal = __ballot(is1);
            const unsigned gm = (unsigned)(bal >> (lane & ~7)) & 0xffu;
            const int first = __ffs(gm) - 1;
            float m2 = (is1 && (lane & 7) == first) ? -__builtin_inff() : sel;
            m2 = fmaxf(m2, __shfl_xor(m2, 1)); m2 = fmaxf(m2, __shfl_xor(m2, 2)); m2 = fmaxf(m2, __shfl_xor(m2, 4));
            const float gs = m1 + m2;
            const int myg = lane >> 3;
            int grank = 0;
#pragma unroll 1
            for (int g = 0; g < 8; ++g) { const float gv = __uint_as_float(__builtin_amdgcn_readlane(__float_as_uint(gs), 8 * g)); grank += (gv > gs || (gv == gs && g < myg)) ? 1 : 0; }
            const bool gsel = grank < 4;
            const float msel = gsel ? sel : -__builtin_inff();
            int rk = 0;
#pragma unroll 4
            for (int e = 0; e < 64; ++e) { const float v = __uint_as_float(__builtin_amdgcn_readlane(__float_as_uint(msel), e)); rk += (v > msel || (v == msel && e < lane)) ? 1 : 0; }
            const bool chosen = gsel && rk < 8;
            const float ssum = wave_sum(chosen ? score : 0.f);
            if (chosen) {
                const int lr = __hip_atomic_fetch_add(lcnt + lane, 1, __ATOMIC_RELAXED, __HIP_MEMORY_SCOPE_WORKGROUP);
                const int idx = ((itl & 15) * 16 + tl) * 8 + rk;
                sel_e[idx] = (unsigned char)lane; sel_r[idx] = (unsigned short)lr; sel_w[idx] = score / ssum * 2.5f;
            }
            (void)tok;
        }
        __syncthreads();
        if ((itl & 15) == 15 || it + (int)gridDim.x >= NTOK / 16) {
            if (tid < 64) lbase[tid] = atomicAdd(&cnt[tid], lcnt[tid]);
            __syncthreads();
            const int nsel = ((itl & 15) + 1) * 128, it0 = itl & ~15;
            for (int idx = tid; idx < nsel; idx += 512) {
                const int e = sel_e[idx], tl = idx >> 3, k = idx & 7;
                const int tk = ((int)blockIdx.x + (it0 + (tl >> 4)) * (int)gridDim.x) * 16 + (tl & 15);
                const int pos = lbase[e] + sel_r[idx];
                list[e * LIST_CAP + pos] = tk * 9 + k; listw[e * LIST_CAP + pos] = sel_w[idx];
            }
            __syncthreads();
            if (tid < 64) lcnt[tid] = 0;
            __syncthreads();
        }
    }
}

DI void phase_combine(const Params& p) {
    const int lane = threadIdx.x & 63, wid = threadIdx.x >> 6;
    const float* mod = (const float*)(p.ws + WS_MOD); const unsigned char* yb9 = (const unsigned char*)(p.ws + WS_YB9); const int* slot = (const int*)(p.ws + WS_SLOT);
    for (int tok = blockIdx.x * 8 + wid; tok < NTOK; tok += gridDim.x * 8) {
        const int b = tok >> 12;
        float acc[2][16];
#pragma unroll
        for (int i = 0; i < 2; ++i)
#pragma unroll
            for (int j = 0; j < 16; ++j) acc[i][j] = 0.f;
#pragma unroll 3
        for (int k = 0; k < 9; ++k) {
            const unsigned char* row = yb9 + (size_t)slot[tok * 9 + k] * 256;
#pragma unroll
            for (int i = 0; i < 2; ++i) {
                const int c = lane + 64 * i;
                const u32x4 w = __builtin_nontemporal_load((const u32x4*)(row + (size_t)(c >> 4) * YB_SLOTS * 256 + (c & 15) * 16));
#pragma unroll
                for (int q = 0; q < 4; ++q) {
                    const f32x2 lo = __builtin_amdgcn_cvt_pk_f32_fp8((int)w[q], false), hi = __builtin_amdgcn_cvt_pk_f32_fp8((int)w[q], true);
                    acc[i][4 * q] += lo[0]; acc[i][4 * q + 1] += lo[1]; acc[i][4 * q + 2] += hi[0]; acc[i][4 * q + 3] += hi[1];
                }
            }
        }
        float ss = 0.f;
#pragma unroll
        for (int i = 0; i < 2; ++i)
#pragma unroll
            for (int j = 0; j < 16; ++j) ss += acc[i][j] * acc[i][j];
        ss = wave_sum(ss);
        const float rstd = rsqrtf(ss * (1.0f / DM) + RMS_EPS);
#pragma unroll
        for (int i = 0; i < 2; ++i) {
            const int ch = 16 * (lane + 64 * i);
#pragma unroll
            for (int hh = 0; hh < 4; ++hh) {
                const f32x4 g = *(const f32x4*)(p.g_post_ffn + ch + 4 * hh);
                const f32x4 gt = *(const f32x4*)(mod + b * 12288 + 10240 + ch + 4 * hh);
                f32x4 xv = *(const f32x4*)(p.out + (size_t)tok * DM + ch + 4 * hh);
#pragma unroll
                for (int j = 0; j < 4; ++j) xv[j] += gt[j] * (acc[i][4 * hh + j] * rstd * g[j]);
                __builtin_nontemporal_store(xv, (f32x4*)(p.out + (size_t)tok * DM + ch + 4 * hh));
            }
        }
    }
}

DI void probe_copy(const Params& p) {
    u32x4* yb = (u32x4*)(p.ws + WS_YB9);
    const size_t n = (size_t)576 * MiB / 16;
    for (size_t i = (size_t)blockIdx.x * 512 + threadIdx.x; i < n; i += (size_t)gridDim.x * 512) { u32x4 v = yb[i]; asm volatile("" : "+v"(v)); yb[i] = v; }
}

constexpr int NPHASE = 12;
template <int PH> DI void run_phase(const Params& p, LAS unsigned char* lds) {
    if constexpr (PH == 0) phase_prologue(p, lds);
    else if constexpr (PH == 1) phase_prenorm(p);
    else if constexpr (PH == 2) phase_inproj(p, lds);
    else if constexpr (PH == 3) phase_attn(p, lds);
    else if constexpr (PH == 4) phase_merge(p);
    else if constexpr (PH == 5) phase_outproj_a(p, lds);
    else if constexpr (PH == 6) phase_outproj_b(p, lds);
    else if constexpr (PH == 7) phase_mixout(p, lds);
    else if constexpr (PH == 8) phase_postmix(p, lds);
    else if constexpr (PH == 9) phase_gateup(p, lds);
    else if constexpr (PH == 10) phase_down(p, lds);
    else phase_combine(p);
}
template <int PH> __global__ __launch_bounds__(512, 2) void k_phase(Params p) {
    extern __shared__ __attribute__((aligned(16))) unsigned char shm[];
    run_phase<PH>(p, (LAS unsigned char*)shm);
}
#if MK_FUSED
typedef const __attribute__((address_space(4))) Params* KargPtr;
template <int PH> DI void mega_phase(KargPtr kp0, LAS unsigned char* lds) {
    KargPtr kp = kp0; asm volatile("" : "+s"(kp));
    Params p{};
#if defined(__HIP_DEVICE_COMPILE__)
    p.x = kp->x; p.c = kp->c; p.pos = kp->pos; p.w_ada = kp->w_ada; p.b_ada = kp->b_ada; p.g_pre_mix = kp->g_pre_mix; p.g_post_mix = kp->g_post_mix; p.g_pre_ffn = kp->g_pre_ffn; p.g_post_ffn = kp->g_post_ffn; p.w_in = kp->w_in; p.w_dil_out = kp->w_dil_out; p.w_sb_out = kp->w_sb_out; p.w_mix_out = kp->w_mix_out; p.w_router = kp->w_router; p.router_bias = kp->router_bias; p.w_gate_e = kp->w_gate_e; p.w_up_e = kp->w_up_e; p.w_down_e = kp->w_down_e; p.w_gate_s = kp->w_gate_s; p.w_up_s = kp->w_up_s; p.w_down_s = kp->w_down_s; p.out = kp->out; p.ws = kp->ws;
#endif
    run_phase<PH>(p, lds);
}
__global__ __launch_bounds__(512, 2) void k_mega(Params p_unused) {
    extern __shared__ __attribute__((aligned(16))) unsigned char shm[];
    LAS unsigned char* lds = (LAS unsigned char*)shm;
    KargPtr kp0 = (KargPtr)__builtin_amdgcn_kernarg_segment_ptr();
    volatile LAS unsigned* xbw = (volatile LAS unsigned*)(lds + LDS_BYTES - 16);
    if (threadIdx.x == 0) { xbw[0] = 0u; xbw[1] = 0u; xbw[2] = 0u; xbw[3] = 0u; }
    __syncthreads();
    XcdBarrier bar;
    { KargPtr kp = kp0; asm volatile("" : "+s"(kp)); bar = xcd_barrier_post((unsigned*)(kp->ws + WS_BAR), xbw); }
    if (MK_STAMP >= 0 && blockIdx.x == 0 && threadIdx.x == 0) { KargPtr kq = kp0; asm volatile("" : "+s"(kq)); ((unsigned long long*)(kq->ws + WS_STAMP))[0] = wall_clock64(); }
#define MEGA_PH(n) do { mega_phase<n>(kp0, lds); xcd_barrier(bar); if (MK_REP == n) { mega_phase<n>(kp0, lds); xcd_barrier(bar); } \
        if (MK_STAMP >= 0 && blockIdx.x == 0 && threadIdx.x == 0) { KargPtr kq = kp0; asm volatile("" : "+s"(kq)); ((unsigned long long*)(kq->ws + WS_STAMP))[n + 1] = wall_clock64(); } } while (0)
#if MK_REP == 90
#define MK_PROBE_DOWN_NOSTORE 1
#endif
    MEGA_PH(0); MEGA_PH(1); MEGA_PH(2); MEGA_PH(3); MEGA_PH(4); MEGA_PH(5); MEGA_PH(6); MEGA_PH(7); MEGA_PH(8); MEGA_PH(9); MEGA_PH(10);
#if MK_REP == 100
    { KargPtr kp = kp0; asm volatile("" : "+s"(kp)); Params p{}; p.ws = kp->ws; probe_copy(p); xcd_barrier(bar); }
#endif
#undef MEGA_PH
    mega_phase<11>(kp0, lds);
#if MK_STAMP >= 0
    xcd_barrier(bar);
    if (blockIdx.x == 0 && threadIdx.x == 0) {
        KargPtr kq = kp0; asm volatile("" : "+s"(kq));
        unsigned long long* st = (unsigned long long*)(kq->ws + WS_STAMP);
        st[12] = wall_clock64();
        const int k = MK_STAMP < 100 ? MK_STAMP : MK_STAMP - 100;
        const unsigned long long t0 = (MK_STAMP < 100) ? st[k] : st[0], t1 = (MK_STAMP < 100) ? st[k + 1] : st[k + 1];
        kq->out[0] += 2.0f + (float)(t1 - t0) * (MK_STAMP < 100 ? 0.0005f : 0.0001f);
    }
#endif
}
#endif

template <int PH> static void launch_phase(const Params& p, int grid, hipStream_t stream) {
    static bool init = false;
    if (!init) { (void)hipFuncSetAttribute((const void*)k_phase<PH>, hipFuncAttributeMaxDynamicSharedMemorySize, LDS_BYTES); init = true; }
    hipLaunchKernelGGL(k_phase<PH>, dim3(grid), dim3(512), LDS_BYTES, stream, p);
}

extern "C" void kernel_launch(void* const* d_in, const int* in_sizes, int n_in, void* d_out, int out_size, void* d_ws, size_t ws_size, hipStream_t stream) {
    (void)in_sizes; (void)n_in; (void)out_size;
    static int grid = 0;
    if (!grid) {
        int dev = 0, cus = 0; (void)hipGetDevice(&dev); (void)hipDeviceGetAttribute(&cus, hipDeviceAttributeMultiprocessorCount, dev);
        if (cus <= 0) cus = 256;
#if MK_FUSED
        (void)hipFuncSetAttribute((const void*)k_mega, hipFuncAttributeMaxDynamicSharedMemorySize, LDS_BYTES);
        int per_cu = 0;
        if (hipOccupancyMaxActiveBlocksPerMultiprocessor(&per_cu, (const void*)k_mega, 512, LDS_BYTES) != hipSuccess || per_cu < 1)
            fprintf(stderr, "kernel_launch: occupancy query reports %d workgroups per CU\n", per_cu);
#endif
        grid = cus;
        if (ws_size < WS_TOTAL) fprintf(stderr, "kernel_launch: workspace too small: %zu < %zu\n", ws_size, (size_t)WS_TOTAL);
    }
    Params p{};
    p.x = (const float*)d_in[0]; p.c = (const float*)d_in[1]; p.pos = (const int*)d_in[2];
    p.w_ada = (const float*)d_in[3]; p.b_ada = (const float*)d_in[4];
    p.g_pre_mix = (const float*)d_in[5]; p.g_post_mix = (const float*)d_in[6]; p.g_pre_ffn = (const float*)d_in[7]; p.g_post_ffn = (const float*)d_in[8];
    p.w_in = (const float*)d_in[9]; p.w_dil_out = (const float*)d_in[10]; p.w_sb_out = (const float*)d_in[11]; p.w_mix_out = (const float*)d_in[12];
    p.w_router = (const float*)d_in[13]; p.router_bias = (const float*)d_in[14];
    p.w_gate_e = (const float*)d_in[15]; p.w_up_e = (const float*)d_in[16]; p.w_down_e = (const float*)d_in[17];
    p.w_gate_s = (const float*)d_in[18]; p.w_up_s = (const float*)d_in[19]; p.w_down_s = (const float*)d_in[20];
    p.out = (float*)d_out; p.ws = (unsigned char*)d_ws;
    (void)hipMemsetAsync((unsigned char*)d_ws + WS_BAR, 0, WS_ZERO_BYTES, stream);
#if MK_FUSED
    hipLaunchKernelGGL(k_mega, dim3(grid), dim3(512), LDS_BYTES, stream, p);
#else
    launch_phase<0>(p, grid, stream); launch_phase<1>(p, grid, stream); launch_phase<2>(p, grid, stream); launch_phase<3>(p, grid, stream);
    launch_phase<4>(p, grid, stream); launch_phase<5>(p, grid, stream); launch_phase<6>(p, grid, stream); launch_phase<7>(p, grid, stream);
    launch_phase<8>(p, grid, stream); launch_phase<9>(p, grid, stream); launch_phase<10>(p, grid, stream); launch_phase<11>(p, grid, stream);
#endif
}
```

```cpp
#include <hip/hip_runtime.h>
#include <stdint.h>
#include <stdio.h>

#ifndef MK_FUSED
#define MK_FUSED 1
#endif
#ifndef MK_STAMP
#define MK_STAMP -1
#endif
#ifndef MK_REP
#define MK_REP -1
#endif

#define LAS __attribute__((address_space(3)))
#define DI __device__ __forceinline__
typedef unsigned short bf16_t;
typedef short bf16x8 __attribute__((ext_vector_type(8)));
typedef short s16x4 __attribute__((ext_vector_type(4)));
typedef float f32x2 __attribute__((ext_vector_type(2)));
typedef float f32x4 __attribute__((ext_vector_type(4)));
typedef float f32x16 __attribute__((ext_vector_type(16)));
typedef unsigned u32x2 __attribute__((ext_vector_type(2)));
typedef unsigned u32x4 __attribute__((ext_vector_type(4)));
typedef __bf16 bf16x2_t __attribute__((ext_vector_type(2)));
typedef const __attribute__((address_space(1))) char* gcptr;
typedef const __attribute__((address_space(1))) u32x4* gu4ptr;
typedef int i32x8 __attribute__((ext_vector_type(8)));
typedef short s16x16 __attribute__((ext_vector_type(16)));

constexpr int NBATCH = 4, SEQ = 4096, NTOK = NBATCH * SEQ, DM = 2048, DIN = 11776;
constexpr int COL_QA = 0, COL_KA = 1536, COL_VA = 3072, COL_QS = 4608, COL_KS = 5632, COL_VS = 6656, COL_GD = 7680, COL_GS = 9728;
constexpr int NE = 64, DE = 512, NEX = 65;
constexpr int LIST_CAP = 16384;
constexpr int YB_SLOTS = 163840;
constexpr float RMS_EPS = 1e-6f;
constexpr float QSCALE = 0.08838834764831845f * 1.4426950408889634f;
constexpr float LN2 = 0.6931471805599453f;
constexpr float W8_SCALE = 64.0f;
constexpr int W8_MX = 0x79797979, A8_MX = 0x7f7f7f7f;

constexpr size_t MiB = 1ull << 20;
constexpr size_t WS_BAR = 0;
constexpr size_t WS_CNT = 16384;
constexpr size_t WS_ZERO_BYTES = 32768;
constexpr size_t WS_STAMP = 32768;

constexpr size_t WS_MOD = 65536;
constexpr size_t WS_LSE = 262144;
constexpr size_t WS_ROPE = 1 * MiB;
constexpr size_t WS_LIST = 3 * MiB;
constexpr size_t WS_LISTW = 7 * MiB;
constexpr size_t WS_SLOT = 262144;
constexpr size_t WS_WD = 11 * MiB;
constexpr size_t WS_WTIN8 = 76 * MiB;
constexpr size_t WS_X1 = 76 * MiB;
constexpr size_t WS_H8 = 100 * MiB;
constexpr size_t WS_H = 141 * MiB;
constexpr size_t WS_HID = 205 * MiB;
constexpr size_t WS_WTIN = 205 * MiB;
constexpr size_t WS_TMP = 205 * MiB;
constexpr size_t WS_OG = 251 * MiB;
constexpr size_t WS_OSB = 299 * MiB;
constexpr size_t WS_ODIL = 331 * MiB;
constexpr size_t WS_WTDIL = 347 * MiB;
constexpr size_t WS_WTSB = 349 * MiB;
constexpr size_t WS_WTMIX = 353 * MiB;
constexpr size_t WS_PROJ = 365 * MiB;
constexpr size_t WS_Y = 365 * MiB;
constexpr size_t WS_YB9 = 365 * MiB;
constexpr size_t WS_WGU = 733 * MiB;
constexpr size_t WS_WRT = 1005 * MiB;
constexpr size_t WS_TOTAL = 1006 * MiB;

#ifndef MOE_BAUX
#define MOE_BAUX 0
#endif
#ifndef GEMM_SPLIT
#define GEMM_SPLIT false
#endif
constexpr int LDS_BYTES = 163840;

struct Params {
    const float *x, *c; const int* pos;
    const float *w_ada, *b_ada, *g_pre_mix, *g_post_mix, *g_pre_ffn, *g_post_ffn;
    const float *w_in, *w_dil_out, *w_sb_out, *w_mix_out, *w_router, *router_bias;
    const float *w_gate_e, *w_up_e, *w_down_e, *w_gate_s, *w_up_s, *w_down_s;
    float* out; unsigned char* ws;
};

DI unsigned pk_bf16(float lo, float hi) { f32x2 v = {lo, hi}; bf16x2_t r = __builtin_convertvector(v, bf16x2_t); return __builtin_bit_cast(unsigned, r); }
DI unsigned pk_fp8x4(float a, float b, float c, float d) { int p = __builtin_amdgcn_cvt_pk_fp8_f32(a, b, 0, false); p = __builtin_amdgcn_cvt_pk_fp8_f32(c, d, p, true); return (unsigned)p; }
DI float bf_lo(unsigned u) { return __uint_as_float(u << 16); }
DI float bf_hi(unsigned u) { return __uint_as_float(u & 0xffff0000u); }
DI float wave_sum(float v) {
#pragma unroll
    for (int o = 32; o >= 1; o >>= 1) v += __shfl_xor(v, o);
    return v;
}
DI float sigmoidf_(float x) { return __builtin_amdgcn_rcpf(1.0f + __expf(-x)); }

#define XB_TMO      128
#define XB_XCNT(j)  (256  + 64 * (j))
#define XB_XSUB(j)  (1280 + 64 * (j))
#define XB_XGEN(j)  (2304 + 64 * (j))
#define XB_TOP      3328
#define XB_TOPGEN   3392
#define XCD_BAR_WORDS 3456
#define XB_SPIN_CAP (1u << 18)

__device__ __forceinline__ unsigned xb_ld(unsigned* p)              { return __hip_atomic_load(p, __ATOMIC_RELAXED, __HIP_MEMORY_SCOPE_AGENT); }
__device__ __forceinline__ unsigned xb_add(unsigned* p, unsigned v) { return __hip_atomic_fetch_add(p, v, __ATOMIC_RELAXED, __HIP_MEMORY_SCOPE_AGENT); }
__device__ __forceinline__ unsigned xb_xcc_id() { return (unsigned)__builtin_amdgcn_s_getreg((3 << 11) | 20) & 0xFu; }
#define XB_SPIN(cond, bar) do { unsigned _sp = 0; while (cond) { __builtin_amdgcn_s_sleep(1); \
    if ((++_sp & 255u) == 0u) { if (xb_ld(&(bar)[XB_TMO])) break; if (_sp > XB_SPIN_CAP) { atomicAdd(&(bar)[XB_TMO], 1u); break; } } } } while (0)

struct XcdBarrier { unsigned* bar; unsigned x; volatile LAS unsigned* st; };

__device__ __forceinline__ XcdBarrier xcd_barrier_post(unsigned* bar, volatile LAS unsigned* st) {
    XcdBarrier b; b.bar = bar; b.x = xb_xcc_id(); b.st = st;
    if (threadIdx.x == 0) (void)xb_add(&bar[XB_XCNT(b.x)], 1u);
    return b;
}
__device__ __forceinline__ void xcd_barrier_complete(unsigned* bar, unsigned x, unsigned& nloc, unsigned& nx) {
    const unsigned G = gridDim.x * gridDim.y * gridDim.z;
    unsigned sum, cnt, mine, sp = 0u;
    for (;;) {
        sum = 0u; cnt = 0u; mine = 0u;
#pragma unroll
        for (unsigned j = 0; j < 16; ++j) { const unsigned c = xb_ld(&bar[XB_XCNT(j)]); sum += c; cnt += (c > 0u) ? 1u : 0u; mine = (j == x) ? c : mine; }
        if (sum == G) break;
        __builtin_amdgcn_s_sleep(1);
        if ((++sp & 255u) == 0u) { if (xb_ld(&bar[XB_TMO])) break; if (sp > XB_SPIN_CAP) { atomicAdd(&bar[XB_TMO], 1u); break; } }
    }
    nloc = mine > 0u ? mine : 1u; nx = cnt > 0u ? cnt : 1u;
}
__device__ __forceinline__ void xcd_barrier(const XcdBarrier& b) {
    asm volatile("s_waitcnt vmcnt(0)" ::: "memory");
    __syncthreads();
    if (threadIdx.x == 0) {
        unsigned* bar = b.bar;
        __builtin_amdgcn_s_waitcnt(0);
        unsigned nloc = b.st[0], nx = b.st[1];
        if (nloc == 0u) { xcd_barrier_complete(bar, b.x, nloc, nx); b.st[0] = nloc; b.st[1] = nx; }
        const unsigned old = xb_add(&bar[XB_XSUB(b.x)], 1u);
        const unsigned gen = old / nloc;
        if (old + 1u == (gen + 1u) * nloc) {
            __builtin_amdgcn_fence(__ATOMIC_RELEASE, "agent");
            asm volatile("s_waitcnt vmcnt(0)" ::: "memory");
            const unsigned og = xb_add(&bar[XB_TOP], 1u);
            const unsigned tg = og / nx;
            if (og + 1u == (tg + 1u) * nx) xb_add(&bar[XB_TOPGEN], 1u);
            else XB_SPIN(xb_ld(&bar[XB_TOPGEN]) == tg, bar);
            __builtin_amdgcn_fence(__ATOMIC_ACQUIRE, "agent");
            xb_add(&bar[XB_XGEN(b.x)], 1u);
            asm volatile("s_waitcnt vmcnt(0)" ::: "memory");
        } else {
            XB_SPIN(xb_ld(&bar[XB_XGEN(b.x)]) == gen, bar);
            __builtin_amdgcn_fence(__ATOMIC_ACQUIRE, "agent");
            asm volatile("s_waitcnt vmcnt(0)" ::: "memory");
        }
    }
    __syncthreads();
}

struct CvtMat { const float* src; bf16_t* dst; int K, N, nb, mode; size_t sstride, dstride; };
constexpr int CVT_NMAT = 10;
constexpr int CVT_TILES[CVT_NMAT] = {2944, 128, 256, 512, 8192, 8192, 8192, 128, 128, 128};
constexpr int CVT_TOTAL = 2944 + 128 + 256 + 512 + 8192 * 3 + 128 * 3;
constexpr int P0_MOD_UNITS = 192, P0_ROPE_UNITS = 64, P0_WR_UNITS = 8, P0_ITEMS = P0_MOD_UNITS + P0_ROPE_UNITS + P0_WR_UNITS + CVT_TOTAL;

DI CvtMat cvt_mat(const Params& p, int m) {
    bf16_t* wtin = (bf16_t*)(p.ws + WS_WTIN); bf16_t* wtdil = (bf16_t*)(p.ws + WS_WTDIL); bf16_t* wtsb = (bf16_t*)(p.ws + WS_WTSB); bf16_t* wtmix = (bf16_t*)(p.ws + WS_WTMIX);
    bf16_t* wgu = (bf16_t*)(p.ws + WS_WGU); bf16_t* wd = (bf16_t*)(p.ws + WS_WD);
    CvtMat r;
    switch (m) {
        case 0: r = {p.w_in, wtin, 2048, 11776, 1, 0, 0, 0}; break;
        case 1: r = {p.w_dil_out, wtdil, 512, 2048, 1, 0, 0, 0}; break;
        case 2: r = {p.w_sb_out, wtsb, 1024, 2048, 1, 0, 0, 0}; break;
        case 3: r = {p.w_mix_out, wtmix, 2048, 2048, 1, 0, 0, 0}; break;
        case 4: r = {p.w_gate_e, wgu, 2048, 512, 64, 1, (size_t)2048 * 512, (size_t)1024 * 2048}; break;
        case 5: r = {p.w_up_e, wgu, 2048, 512, 64, 2, (size_t)2048 * 512, (size_t)1024 * 2048}; break;
        case 6: r = {p.w_down_e, wd, 512, 2048, 64, 0, (size_t)512 * 2048, (size_t)2048 * 512}; break;
        case 7: r = {p.w_gate_s, (bf16_t*)((unsigned char*)wgu + (size_t)64 * 1024 * 2048), 2048, 512, 1, 1, 0, 0}; break;
        case 8: r = {p.w_up_s, (bf16_t*)((unsigned char*)wgu + (size_t)64 * 1024 * 2048), 2048, 512, 1, 2, 0, 0}; break;
        default: r = {p.w_down_s, (bf16_t*)((unsigned char*)wd + (size_t)64 * 2048 * 512), 512, 2048, 1, 0, 0, 0}; break;
    }
    return r;
}

struct CvtTile { const float* src; unsigned char* dst; int N, K, kt, nt, mode, f8; };
DI CvtTile cvt_desc(const Params& p, int t) {
    int m = 0;
#pragma unroll
    for (int i = 0; i < CVT_NMAT - 1; ++i) { if (t >= CVT_TILES[i] && m == i) { t -= CVT_TILES[i]; m = i + 1; } }
    const CvtMat M = cvt_mat(p, m);
    int b, kt, nt;
    if (m == 0) { kt = t / 184; nt = t - kt * 184; b = 0; }
    else {
        const int ln = (M.N == 2048) ? 5 : 3, lk = (M.K == 512) ? 2 : (M.K == 1024 ? 3 : 4);
        nt = t & ((1 << ln) - 1); kt = (t >> ln) & ((1 << lk) - 1); b = t >> (ln + lk);
    }
    const bool in8 = (m == 0);
    CvtTile d; d.src = M.src + (size_t)b * M.sstride + (size_t)(kt * 128) * M.N + nt * 64; d.N = M.N; d.K = M.K; d.kt = kt; d.nt = nt; d.mode = M.mode;
    d.f8 = (m >= 4 || in8) ? 1 : 0;
    d.dst = in8 ? (unsigned char*)(p.ws + WS_WTIN8) : (m >= 4 ? (unsigned char*)M.dst + (size_t)b * M.dstride : (unsigned char*)(M.dst + (size_t)b * M.dstride));
    return d;
}
DI void cvt_load(const CvtTile& d, f32x4 (&v)[4]) {
    const int k4 = (threadIdx.x >> 4) * 4, n4 = (threadIdx.x & 15) * 4;
#pragma unroll
    for (int i = 0; i < 4; ++i) v[i] = __builtin_nontemporal_load((const f32x4*)(d.src + (size_t)(k4 + i) * d.N + n4));
}
DI void cvt_bar() { asm volatile("s_waitcnt lgkmcnt(0)" ::: "memory"); __builtin_amdgcn_s_barrier(); asm volatile("" ::: "memory"); }
DI void cvt_finish(const CvtTile& d, const f32x4 (&vin)[4], LAS unsigned char* lds, bool valid) {
    f32x4 v[4] = {vin[0], vin[1], vin[2], vin[3]};
    asm volatile("" : "+v"(v[0]), "+v"(v[1]), "+v"(v[2]), "+v"(v[3]));
    if (!valid) return;
    const int tid = threadIdx.x;
    const int k4 = (tid >> 4) * 4, n4 = (tid & 15) * 4;
    const int c = d.nt * 64 + (tid >> 3);
    const int drow = d.mode == 0 ? c : (((c >> 7) << 8) + (c & 127) + (d.mode == 2 ? 128 : 0));
    if (!d.f8) {
        constexpr int P = 272;
#pragma unroll
        for (int j = 0; j < 4; ++j) { u32x2 w; w.x = pk_bf16(v[0][j], v[1][j]); w.y = pk_bf16(v[2][j], v[3][j]); *(LAS u32x2*)(lds + (n4 + j) * P + k4 * 2) = w; }
        cvt_bar();
#pragma unroll
        for (int i = 0; i < 2; ++i) {
            const int ch = (tid & 7) + 8 * i;
            const u32x4 w = *(const LAS u32x4*)(lds + (tid >> 3) * P + ch * 16);
            *(u32x4*)((bf16_t*)d.dst + (size_t)drow * d.K + d.kt * 128 + ch * 8) = w;
        }
    } else {
        constexpr int P = 144;
#pragma unroll
        for (int j = 0; j < 4; ++j) *(LAS unsigned*)(lds + (n4 + j) * P + k4) = pk_fp8x4(v[0][j] * W8_SCALE, v[1][j] * W8_SCALE, v[2][j] * W8_SCALE, v[3][j] * W8_SCALE);
        cvt_bar();
        const u32x4 w = *(const LAS u32x4*)(lds + (tid >> 3) * P + (tid & 7) * 16);
        __builtin_nontemporal_store(w, (u32x4*)(d.dst + (size_t)drow * d.K + d.kt * 128 + (tid & 7) * 16));
    }
    cvt_bar();
}

DI void mod_unit(const Params& p, int u, LAS unsigned char* lds) {
    const int tid = threadIdx.x, c0 = u * 64;
    LAS float* sc = (LAS float*)lds;
    LAS float* red = (LAS float*)(lds + 32768);
    for (int i = tid; i < 4 * 2048; i += 512) { const float v = p.c[i]; sc[i] = v / (1.0f + __expf(-v)); }
    __syncthreads();
    const int kq = tid >> 4, cq = tid & 15;
    float acc[4][4];
#pragma unroll
    for (int b = 0; b < 4; ++b)
#pragma unroll
        for (int j = 0; j < 4; ++j) acc[b][j] = 0.f;
#pragma unroll 1
    for (int it0 = 0; it0 < 64; it0 += 8) {
        f32x4 w[8];
#pragma unroll
        for (int i = 0; i < 8; ++i) w[i] = __builtin_nontemporal_load((const f32x4*)(p.w_ada + (size_t)(kq + 32 * (it0 + i)) * 12288 + c0 + 4 * cq));
#pragma unroll
        for (int i = 0; i < 8; ++i) {
            const int k = kq + 32 * (it0 + i);
#pragma unroll
            for (int b = 0; b < 4; ++b) { const float s = sc[b * 2048 + k];
#pragma unroll
                for (int j = 0; j < 4; ++j) acc[b][j] += s * w[i][j]; }
        }
    }
#pragma unroll
    for (int b = 0; b < 4; ++b)
#pragma unroll
        for (int j = 0; j < 4; ++j) red[(kq * 4 + b) * 64 + 4 * cq + j] = acc[b][j];
    __syncthreads();
    if (tid < 256) {
        const int b = tid >> 6, col = tid & 63;
        float s = 0.f;
        for (int q = 0; q < 32; ++q) s += red[(q * 4 + b) * 64 + col];
        float* mod = (float*)(p.ws + WS_MOD);
        mod[b * 12288 + c0 + col] = s + p.b_ada[c0 + col];
    }
    __syncthreads();
}

DI void rope_unit(const Params& p, int u) {
    float2* rope = (float2*)(p.ws + WS_ROPE);
    for (int e = threadIdx.x; e < 4096; e += 512) {
        const int tok = u * 256 + (e >> 4), i = e & 15;
        const float invf = (float)pow(500000.0, -(double)i / 16.0);
        const float ang = (float)p.pos[tok] * invf;
        rope[tok * 16 + i] = make_float2((float)cos((double)ang), (float)sin((double)ang));
    }
}

DI void wr_unit(const Params& p, int u) {
    bf16_t* hi = (bf16_t*)(p.ws + WS_WRT); bf16_t* lo = hi + 64 * 2048;
    for (int i = threadIdx.x; i < 16384; i += 512) {
        const int idx = u * 16384 + i, k = idx >> 6, e = idx & 63;
        const float x = p.w_router[idx];
        const unsigned h = pk_bf16(x, 0.f) & 0xffffu;
        const float r = x - __uint_as_float(h << 16);
        hi[e * 2048 + k] = (bf16_t)h; lo[e * 2048 + k] = (bf16_t)(pk_bf16(r, 0.f) & 0xffffu);
    }
}
DI void phase_prologue(const Params& p, LAS unsigned char* lds) {
    constexpr int NSMALL = P0_MOD_UNITS + P0_ROPE_UNITS + P0_WR_UNITS;
    int it = blockIdx.x;
    for (; it < NSMALL; it += gridDim.x) {
        if (it < P0_MOD_UNITS) mod_unit(p, it, lds);
        else if (it < P0_MOD_UNITS + P0_ROPE_UNITS) rope_unit(p, it - P0_MOD_UNITS);
        else wr_unit(p, it - P0_MOD_UNITS - P0_ROPE_UNITS);
    }
    if (it < P0_ITEMS) {
        const int G = (int)gridDim.x;
        const int n = (P0_ITEMS - it + G - 1) / G;
        const int base = it - NSMALL;
        CvtTile d0, d1, d2, d3;
        f32x4 v0[4], v1[4], v2[4], v3[4];
#define CVT_LOAD(D, V, J) D = cvt_desc(p, base + min((J), n - 1) * G); cvt_load(D, V); asm volatile("" ::: "memory")
        CVT_LOAD(d0, v0, 0); CVT_LOAD(d1, v1, 1); CVT_LOAD(d2, v2, 2);
#pragma unroll 1
        for (int j = 0; j < n; j += 4) {
            CVT_LOAD(d3, v3, j + 3); cvt_finish(d0, v0, lds, true);
            CVT_LOAD(d0, v0, j + 4); cvt_finish(d1, v1, lds, j + 1 < n);
            CVT_LOAD(d1, v1, j + 5); cvt_finish(d2, v2, lds, j + 2 < n);
            CVT_LOAD(d2, v2, j + 6); cvt_finish(d3, v3, lds, j + 3 < n);
        }
#undef CVT_LOAD
    }
    __syncthreads();
}

DI void phase_prenorm(const Params& p) {
    const int lane = threadIdx.x & 63, wid = threadIdx.x >> 6;
    const float* mod = (const float*)(p.ws + WS_MOD);
    for (int tok = blockIdx.x * 8 + wid; tok < NTOK; tok += gridDim.x * 8) {
        const int b = tok >> 12;
        const float* xr = p.x + (size_t)tok * DM;
        f32x4 v[8]; float ss = 0.f;
#pragma unroll
        for (int i = 0; i < 8; ++i) { v[i] = *(const f32x4*)(xr + 4 * (lane + 64 * i)); ss += v[i][0] * v[i][0] + v[i][1] * v[i][1] + v[i][2] * v[i][2] + v[i][3] * v[i][3]; }
        ss = wave_sum(ss);
        const float rstd = rsqrtf(ss * (1.0f / DM) + RMS_EPS);
#pragma unroll
        for (int i = 0; i < 8; ++i) {
            const int ch = 4 * (lane + 64 * i);
            const f32x4 g = *(const f32x4*)(p.g_pre_mix + ch);
            const f32x4 sh = *(const f32x4*)(mod + b * 12288 + ch);
            const f32x4 sc = *(const f32x4*)(mod + b * 12288 + 2048 + ch);
            f32x4 o;
#pragma unroll
            for (int j = 0; j < 4; ++j) o[j] = v[i][j] * rstd * g[j] * (1.0f + sc[j]) + sh[j];
            *(unsigned*)(p.ws + WS_H8 + (size_t)tok * DM + ch) = pk_fp8x4(o[0], o[1], o[2], o[3]);
        }
    }
}

namespace g8 {
constexpr int BM = 256, BK = 64, HALF = 128, HTB = HALF * BK * 2, STAGE_BYTES = 8 * HTB, NXCD = 8, WGM = 8;
DI int lds_byte(int r, int c) { const int st = (r >> 4) * 2 + (c >> 5), rr = r & 15, cc = c & 31, ob = rr * 64 + cc * 2; return st * 1024 + (ob ^ (((ob >> 9) & 1) << 5)); }
DI void stage_rc(int b, int& R, int& C) { const int st = b / 1024, sb = b % 1024, swz = sb ^ (((sb >> 9) & 1) << 5); R = (st >> 1) * 16 + swz / 64; C = (st & 1) * 32 + (swz % 64) / 2; }
DI int perm32(int rho) { const int n = rho >> 4, i = rho & 15; return 8 * (i >> 2) + 4 * n + (i & 3); }

struct Unit {
    const char* A; const char* B;
    int row0;
    int lda, ldb, nt;
    int pm, pn, aux, keep;
    int e, nvalid, par;
};

DI bool static_tile(int L, int nM, int nN, int& pm, int& pn) {
    const int nwg = nM * nN; if (L >= nwg) return false;
    int wgid = L; { const int q = nwg / NXCD, r = nwg % NXCD, xcd = wgid % NXCD, off = wgid / NXCD; wgid = (xcd < r ? xcd * (q + 1) : r * (q + 1) + (xcd - r) * q) + off; }
    const int nig = WGM * nN, gid = wgid / nig, fm = gid * WGM, gsz = (nM - fm) < WGM ? (nM - fm) : WGM;
    pm = fm + ((wgid % nig) % gsz); pn = (wgid % nig) / gsz; return true;
}

constexpr int EXCH_OFF = STAGE_BYTES + 8192;
DI void epi_bar() { asm volatile("s_waitcnt lgkmcnt(0)" ::: "memory"); __builtin_amdgcn_s_barrier(); asm volatile("" ::: "memory"); }

template <int NCH, int BAUX, bool SPLIT, bool FP8, class Sched, class Epi>
DI void gemm_phase(LAS unsigned char* lds, const Sched& S, const Epi& E) {
    const int tid = threadIdx.x, wid = __builtin_amdgcn_readfirstlane(tid >> 6), lane = tid & 63, wr = wid >> 2, wc = wid & 3, fr = lane & 15, fq = lane >> 4;
    const bool loader = SPLIT ? (wr == 0) : true, storer = SPLIT ? (wr == 1) : true;
    constexpr int NP = SPLIT ? 4 : 2, PSTEP = SPLIT ? 4 : 8, RSTEP = SPLIT ? 32 : 64;
    const int p0 = SPLIT ? wc : wid;
    int R0, C0; stage_rc(p0 * 1024 + lane * 16, R0, C0);
    const int sC = C0 * 2, sRb = (R0 & ~31) + perm32(R0 & 31);
    const int aoff = lds_byte(wr * 64 + fr, fq * 8), boff = lds_byte(wc * 32 + fr, fq * 8);
#define G8_SA(b, h) (((b) * 2 + (h)) * HTB)
#define G8_SB(b, h) ((4 + (b) * 2 + (h)) * HTB)
#define G8_STAGE_A(bufoff, gbase, voff) do { if (loader) { _Pragma("unroll") for (int _i = 0; _i < NP; ++_i) \
        __builtin_amdgcn_global_load_lds((const unsigned*)((const char*)(gbase) + (voff)[_i]), (LAS unsigned*)(lds + (bufoff) + (p0 + PSTEP * _i) * 1024), 16, 0, 0); } } while (0)
#define G8_STAGE_B(bufoff, gbase, voff, ldb32) do { if (loader) { _Pragma("unroll") for (int _i = 0; _i < NP; ++_i) { \
        const char* _gb = (const char*)(gbase) + (size_t)_i * (ldb32); asm volatile("" : "+s"(_gb));     \
        __builtin_amdgcn_global_load_lds((const unsigned*)(_gb + (voff)), (LAS unsigned*)(lds + (bufoff) + (p0 + PSTEP * _i) * 1024), 16, 0, BAUX); } } } while (0)
#define G8_LDA(dst, b, h) do { _Pragma("unroll") for (int m = 0; m < 4; ++m) _Pragma("unroll") for (int k = 0; k < 2; ++k) dst[m][k] = *(const LAS bf16x8*)(lds + G8_SA(b, h) + aoff + m * 2048 + k * 1024); } while (0)
#define G8_LDB(dst, b, h) do { _Pragma("unroll") for (int n = 0; n < 2; ++n) _Pragma("unroll") for (int k = 0; k < 2; ++k) dst[n][k] = *(const LAS bf16x8*)(lds + G8_SB(b, h) + boff + n * 2048 + k * 1024); } while (0)
#define G8_MMA(ai, bj, At, Bt) do { __builtin_amdgcn_s_setprio(1); _Pragma("unroll") for (int m = 0; m < 4; ++m) _Pragma("unroll") for (int n = 0; n < 2; ++n) { \
        if (!FP8) { _Pragma("unroll") for (int k = 0; k < 2; ++k) acc[ai][bj][m][n] = __builtin_amdgcn_mfma_f32_16x16x32_bf16(Bt[n][k], At[m][k], acc[ai][bj][m][n], 0, 0, 0); } \
        else { const i32x8 _w = __builtin_bit_cast(i32x8, __builtin_shufflevector(Bt[n][0], Bt[n][1], 0, 1, 2, 3, 4, 5, 6, 7, 8, 9, 10, 11, 12, 13, 14, 15)); \
               const i32x8 _x = __builtin_bit_cast(i32x8, __builtin_shufflevector(At[m][0], At[m][1], 0, 1, 2, 3, 4, 5, 6, 7, 8, 9, 10, 11, 12, 13, 14, 15)); \
               acc[ai][bj][m][n] = __builtin_amdgcn_mfma_scale_f32_16x16x128_f8f6f4(_w, _x, acc[ai][bj][m][n], 0, 0, 0, W8_MX, 0, A8_MX); } } \
        __builtin_amdgcn_s_setprio(0); } while (0)
#define G8_WAIT_V8 do { if (SPLIT) { if (loader) asm volatile("s_waitcnt vmcnt(8)" ::: "memory"); } else asm volatile("s_waitcnt vmcnt(4)" ::: "memory"); } while (0)
#define G8_WAIT_V12 do { if (SPLIT) { if (loader) asm volatile("s_waitcnt vmcnt(12)" ::: "memory"); } else asm volatile("s_waitcnt vmcnt(6)" ::: "memory"); } while (0)
#define G8_WAIT_V0 do { if (loader) asm volatile("s_waitcnt vmcnt(0)" ::: "memory"); } while (0)
#define G8_WAIT_L(n) asm volatile("s_waitcnt lgkmcnt(" #n ")" ::: "memory")
#define G8_BAR __builtin_amdgcn_s_barrier()
#define G8_SCHED __builtin_amdgcn_sched_barrier(0)
#define G8_OFFS(u, vA, vB) do { if (loader) { _Pragma("unroll") for (int _h = 0; _h < 2; ++_h) _Pragma("unroll") for (int _i = 0; _i < NP; ++_i) \
        vA[_h][_i] = (unsigned)S.arow(u, _h * 128 + R0 + RSTEP * _i) * (unsigned)(u).lda + (unsigned)sC; \
        vB = (unsigned)sRb * (unsigned)(u).ldb + (unsigned)sC; } } while (0)
    Unit cur, nxt; int ui = 0;
    if (!S.next(0, cur)) return;
    f32x4 acc[2][2][4][2];
#pragma unroll
    for (int a = 0; a < 2; ++a)
#pragma unroll
        for (int b = 0; b < 2; ++b)
#pragma unroll
            for (int m = 0; m < 4; ++m)
#pragma unroll
                for (int n = 0; n < 2; ++n) acc[a][b][m][n] = (f32x4){0.f, 0.f, 0.f, 0.f};
    bf16x8 At[4][2], B0[2][2], B1[2][2];
    unsigned vA[2][NP], vB = 0u;
#pragma unroll
    for (int i = 0; i < NP; ++i) { vA[0][i] = 0u; vA[1][i] = 0u; }
    if (S.prefetch(cur, wid, lane)) { G8_WAIT_V0; G8_BAR; }
    G8_OFFS(cur, vA, vB);
    const char* cA = cur.A; const char* cB = cur.B; size_t hB = (size_t)128 * cur.ldb; size_t q32 = (size_t)RSTEP * cur.ldb;
    constexpr size_t kstep = 128;
    G8_STAGE_B(G8_SB(0, 0), cB, vB, q32); G8_STAGE_A(G8_SA(0, 0), cA, vA[0]); G8_STAGE_B(G8_SB(0, 1), cB + hB, vB, q32); G8_STAGE_A(G8_SA(0, 1), cA, vA[1]);
    if (wr == 1) G8_BAR;
    G8_WAIT_V8; G8_BAR;
    G8_STAGE_B(G8_SB(1, 0), cB + kstep, vB, q32); G8_STAGE_A(G8_SA(1, 0), cA + kstep, vA[0]); G8_STAGE_B(G8_SB(1, 1), cB + hB + kstep, vB, q32);
    G8_WAIT_V12; G8_BAR;
    for (;;) {
        bool has_next = false;
        const char* nA = cA; const char* nB = cB; size_t nhB = hB, nq32 = q32;
        const int nt = cur.nt;
#pragma unroll 1
        for (int t = 0; t < nt; t += 2) {
            const bool last = (t == nt - 2);
            const char* a1 = cA + (size_t)(t + 1) * kstep;
            G8_LDB(B0, 0, 0); G8_SCHED; G8_LDA(At, 0, 0); G8_STAGE_A(G8_SA(1, 1), a1, vA[1]);
            G8_WAIT_L(8); G8_BAR; G8_WAIT_L(0); G8_MMA(0, 0, At, B0); G8_BAR; G8_SCHED;
            if (t == 0) { Unit pf; if (S.next(ui + 1, pf)) (void)S.prefetch(pf, wid, lane); }
            const char* a2; const char* b2; size_t h2, q2;
            if (last) {
                has_next = S.next(ui + 1, nxt);
                if (has_next) { G8_OFFS(nxt, vA, vB); nA = nxt.A; nB = nxt.B; nhB = (size_t)128 * nxt.ldb; nq32 = (size_t)RSTEP * nxt.ldb; }
                a2 = nA; b2 = nB; h2 = nhB; q2 = nq32;
            } else { a2 = cA + (size_t)(t + 2) * kstep; b2 = cB + (size_t)(t + 2) * kstep; h2 = hB; q2 = q32; }
            const char* a3 = a2 + kstep; const char* b3 = b2 + kstep;
            G8_LDB(B1, 0, 1); G8_STAGE_B(G8_SB(0, 0), b2, vB, q2);
            G8_BAR; G8_WAIT_L(0); G8_MMA(0, 1, At, B1); G8_BAR;
            G8_LDA(At, 0, 1); G8_STAGE_A(G8_SA(0, 0), a2, vA[0]);
            G8_BAR; G8_WAIT_L(0); G8_MMA(1, 0, At, B0); G8_BAR; G8_SCHED;
            G8_STAGE_B(G8_SB(0, 1), b2 + h2, vB, q2);
            G8_WAIT_V12; G8_BAR; G8_MMA(1, 1, At, B1); G8_BAR;
            G8_LDB(B0, 1, 0); G8_SCHED; G8_LDA(At, 1, 0); G8_STAGE_A(G8_SA(0, 1), a2, vA[1]);
            G8_WAIT_L(8); G8_BAR; G8_WAIT_L(0); G8_MMA(0, 0, At, B0); G8_BAR; G8_SCHED;
            G8_LDB(B1, 1, 1); G8_STAGE_B(G8_SB(1, 0), b3, vB, q2);
            G8_BAR; G8_WAIT_L(0); G8_MMA(0, 1, At, B1); G8_BAR;
            G8_LDA(At, 1, 1); G8_STAGE_A(G8_SA(1, 0), a3, vA[0]);
            G8_BAR; G8_WAIT_L(0); G8_MMA(1, 0, At, B0); G8_BAR; G8_SCHED;
            G8_STAGE_B(G8_SB(1, 1), b3 + h2, vB, q2);
            G8_WAIT_V12; G8_BAR; G8_MMA(1, 1, At, B1); G8_BAR;
        }
        int tz = threadIdx.x; asm volatile("" : "+v"(tz));
        const int lane_e = tz & 63, fr_e = tz & 15, fq_e = (tz >> 4) & 3;
        {
            E.pre(acc, cur, wr, wc, fr_e, fq_e);
            constexpr int PITCH = NCH * 16 + 16;
            LAS unsigned char* ex = lds + EXCH_OFF;
            if (wr == 0) G8_BAR;
            if constexpr (Epi::OUT8) {
                constexpr int RB = NCH * 8, P8 = RB + 16;
#pragma unroll
                for (int ai = 0; ai < 2; ++ai)
#pragma unroll
                    for (int mh = 0; mh < 2; ++mh) {
#pragma unroll
                        for (int mm = 0; mm < 2; ++mm) {
                            u32x2 o8[2];
                            E.row8(acc, cur, ai, 2 * mh + mm, wr, wc, fr_e, fq_e, o8);
                            LAS unsigned char* rp = ex + (mm * 32 + wr * 16 + fr_e) * P8 + wc * 32 + 8 * fq_e;
                            *(LAS u32x2*)rp = o8[0];
                            if (NCH == 32) *(LAS u32x2*)(rp + 128) = o8[1];
                        }
                        epi_bar();
                        {
                            constexpr int CPR = RB / 16, RPI = 64 / CPR;
#pragma unroll
                            for (int i = 0; i < 8 / RPI; ++i) {
                                const int rl = 8 * wid + RPI * i + lane_e / CPR, ch = lane_e % CPR;
                                const int rt = ai * 128 + ((rl >> 4) & 1) * 64 + (2 * mh + (rl >> 5)) * 16 + (rl & 15);
                                const u32x4 d = *(const LAS u32x4*)(ex + rl * P8 + ch * 16);
                                E.store8(cur, rt, ch, d);
                            }
                        }
                        epi_bar();
                    }
            } else
#pragma unroll
            for (int ai = 0; ai < 2; ++ai)
#pragma unroll
                for (int m = 0; m < 4; ++m) {
                    u32x4 o[2];
                    E.row(acc, cur, ai, m, wr, wc, fr_e, fq_e, o);
                    if (NCH == 32) {
                        *(LAS u32x4*)(ex + (wr * 16 + fr_e) * PITCH + (wc * 32 + 8 * fq_e) * 2) = o[0];
                        *(LAS u32x4*)(ex + (wr * 16 + fr_e) * PITCH + (128 + wc * 32 + 8 * fq_e) * 2) = o[1];
                    } else {
                        *(LAS u32x4*)(ex + (wr * 16 + fr_e) * PITCH + (wc * 32 + 8 * fq_e) * 2) = o[0];
                    }
                    epi_bar();
                    if (storer) {
                        constexpr int RPI = 64 / NCH;
                        constexpr int RPW = SPLIT ? 8 : 4;
                        const int rbase = SPLIT ? 8 * wc : 4 * wid;
#pragma unroll
                        for (int i = 0; i < RPW / RPI; ++i) {
                            const int rl = rbase + RPI * i + lane_e / NCH, ch = lane_e % NCH;
                            const int rt = ai * 128 + (rl >> 4) * 64 + m * 16 + (rl & 15);
                            const u32x4 d = *(const LAS u32x4*)(ex + rl * PITCH + ch * 16);
                            E.store(cur, rt, ch, d);
                        }
                    }
                    epi_bar();
                }
            if (wr == 1) G8_BAR;
        }
        if (!has_next) break;
#pragma unroll
        for (int a = 0; a < 2; ++a)
#pragma unroll
            for (int b = 0; b < 2; ++b)
#pragma unroll
                for (int m = 0; m < 4; ++m)
#pragma unroll
                    for (int n = 0; n < 2; ++n) acc[a][b][m][n] = (f32x4){0.f, 0.f, 0.f, 0.f};
        cur = nxt; cA = nA; cB = nB; hB = nhB; q32 = nq32; ++ui;
    }
    G8_WAIT_V0;
    if (wr == 0) G8_BAR;
    G8_BAR;
#undef G8_SA
#undef G8_SB
#undef G8_STAGE_A
#undef G8_STAGE_B
#undef G8_LDA
#undef G8_LDB
#undef G8_MMA
#undef G8_WAIT_V8
#undef G8_WAIT_V12
#undef G8_WAIT_V0
#undef G8_WAIT_L
#undef G8_BAR
#undef G8_SCHED
#undef G8_OFFS
}
}

struct DenseSched {
    const char* A; const char* Bt; int nM, nN, lda, ldb, nt, G, c; int sel = 0;
    DI bool next(int i, g8::Unit& u) const {
        int pm, pn; if (!g8::static_tile(i * G + c, nM, nN, pm, pn)) return false;
        pm = __builtin_amdgcn_readfirstlane(pm); pn = __builtin_amdgcn_readfirstlane(pn);
        if (sel == 2) pn = pn + 30;
        u.A = A; u.B = Bt + (size_t)pn * 256 * ldb; u.row0 = pm * 256; u.lda = lda; u.ldb = ldb; u.nt = nt; u.pm = pm; u.pn = pn; u.aux = 0; u.keep = 0; u.e = 0; u.nvalid = 256; u.par = 0; return true;
    }
    DI int arow(const g8::Unit& u, int rr) const { return u.row0 + rr; }
    DI bool prefetch(const g8::Unit&, int, int) const { return false; }
};
constexpr int MOE_TAB_OFF = g8::STAGE_BYTES;
constexpr int MOE_TILE_OFF = g8::STAGE_BYTES + 1024;
constexpr int MOE_IDX_OFF = g8::STAGE_BYTES + 2048;
struct MoeSched {
    LAS unsigned char* lds; const int* list; const float* listw; const char* A; const char* W; int ncol, mode  , G, c;
    DI bool next(int i, g8::Unit& u) const {
        const LAS int* tpre = (const LAS int*)(lds + MOE_TAB_OFF);
        const int L = i * G + c; const int T = __builtin_amdgcn_readfirstlane(tpre[NEX]);
        if (L >= T * ncol) return false;
        const int gt = __builtin_amdgcn_readfirstlane(L / ncol), pn = L - gt * ncol;
        const int e = __builtin_amdgcn_readfirstlane((int)*(const LAS unsigned char*)(lds + MOE_TILE_OFF + gt));
        const int tile = gt - __builtin_amdgcn_readfirstlane(tpre[e]);
        const int n_e = __builtin_amdgcn_readfirstlane(tpre[NEX + 1 + e]);
        u.e = e; u.pm = tile; u.pn = pn; u.nvalid = min(256, n_e - tile * 256); u.keep = 0; u.aux = gt * 256; u.par = i & 1;
        if (mode == 0) { u.A = A; u.lda = 2048; u.ldb = 2048; u.nt = 16; u.B = W + ((size_t)e * 1024 + (size_t)pn * 256) * 2048; u.row0 = tile * 256; }
        else { u.A = A; u.lda = 512; u.ldb = 512; u.nt = 4; u.B = W + ((size_t)e * 2048 + (size_t)pn * 256) * 512; u.row0 = gt * 256; }
        return true;
    }
    DI bool prefetch(const g8::Unit& u, int wid, int lane) const {
        if (u.e < NE && wid < 4) {
            const int r = min(wid * 64 + lane, u.nvalid - 1);
            const size_t src = (size_t)u.e * LIST_CAP + u.pm * 256 + r;
            __builtin_amdgcn_global_load_lds((const unsigned*)(list + src), (LAS unsigned*)(lds + MOE_IDX_OFF + u.par * 2048 + wid * 256), 4, 0, 0);
            if (mode == 1) __builtin_amdgcn_global_load_lds((const unsigned*)(listw + src), (LAS unsigned*)(lds + MOE_IDX_OFF + u.par * 2048 + 1024 + wid * 256), 4, 0, 0);
        }
        return true;
    }
    DI int arow(const g8::Unit& u, int rr) const {
        if (mode == 1) return u.row0 + rr;
        if (u.e >= NE) return u.row0 + rr;
        return *(const LAS int*)(lds + MOE_IDX_OFF + u.par * 2048 + rr * 4) / 9;
    }
};

typedef f32x4 (&AccRef)[2][2][4][2];
DI u32x4 pack8(const f32x4& v0, const f32x4& v1) { u32x4 w; w.x = pk_bf16(v0[0], v0[1]); w.y = pk_bf16(v0[2], v0[3]); w.z = pk_bf16(v1[0], v1[1]); w.w = pk_bf16(v1[2], v1[3]); return w; }

struct EpiInProj { static constexpr bool OUT8 = false;
    bf16_t* proj; const float* rope;
    DI static int kind_of(int pn) { return pn < 6 ? 0 : pn < 12 ? 1 : pn < 18 ? 2 : pn < 22 ? 3 : pn < 30 ? 2 : 4; }
    DI void pre(AccRef acc, const g8::Unit& u, int wr, int wc, int fr, int fq) const {
        if (kind_of(u.pn) <= 1 && wc == 0) {
            const float sg = (fq < 2) ? -1.0f : 1.0f;
#pragma unroll
            for (int g = 0; g < 4; ++g) {
                const int ai = g >> 1;
                f32x4 cs[2][4];
#pragma unroll
                for (int mm = 0; mm < 2; ++mm) { const int m = (g & 1) * 2 + mm; const int row = u.pm * 256 + ai * 128 + wr * 64 + m * 16 + fr;
#pragma unroll
                    for (int q = 0; q < 4; ++q) cs[mm][q] = *(const f32x4*)(rope + (size_t)row * 32 + 16 * (fq & 1) + 4 * q); }
#pragma unroll
                for (int mm = 0; mm < 2; ++mm) { const int m = (g & 1) * 2 + mm;
#pragma unroll
                    for (int bj = 0; bj < 2; ++bj) {
                        f32x4 v0 = acc[ai][bj][m][0], v1 = acc[ai][bj][m][1], p0, p1;
#pragma unroll
                        for (int j = 0; j < 4; ++j) { p0[j] = __shfl_xor(v0[j], 32); p1[j] = __shfl_xor(v1[j], 32); }
#pragma unroll
                        for (int j = 0; j < 4; ++j) {
                            const float c0 = cs[mm][j >> 1][(j & 1) * 2], s0 = cs[mm][j >> 1][(j & 1) * 2 + 1];
                            const float c1 = cs[mm][2 + (j >> 1)][(j & 1) * 2], s1 = cs[mm][2 + (j >> 1)][(j & 1) * 2 + 1];
                            v0[j] = v0[j] * c0 + sg * p0[j] * s0;
                            v1[j] = v1[j] * c1 + sg * p1[j] * s1;
                        }
                        acc[ai][bj][m][0] = v0; acc[ai][bj][m][1] = v1;
                    }
                    asm volatile("" : "+v"(acc[ai][0][m][0]), "+v"(acc[ai][0][m][1]), "+v"(acc[ai][1][m][0]), "+v"(acc[ai][1][m][1]));
                }
                asm volatile("" ::: "memory");
            }
        }
    }
    DI void row(AccRef acc, const g8::Unit& u, int ai, int m, int wr, int wc, int fr, int fq, u32x4 (&o)[2]) const {
        const int kind = kind_of(u.pn);
#pragma unroll
        for (int bj = 0; bj < 2; ++bj) {
            f32x4 v0 = acc[ai][bj][m][0], v1 = acc[ai][bj][m][1];
            if (kind == 0 || kind == 3) { v0 *= QSCALE; v1 *= QSCALE; }
            if (kind == 4) {
#pragma unroll
                for (int j = 0; j < 4; ++j) { v0[j] = sigmoidf_(v0[j]); v1[j] = sigmoidf_(v1[j]); }
            }
            o[bj] = pack8(v0, v1);
        }
    }
    DI void store(const g8::Unit& u, int rt, int ch, const u32x4& d) const { __builtin_nontemporal_store(d, (u32x4*)(proj + (size_t)(u.pm * 256 + rt) * DIN + u.pn * 256 + ch * 8)); }
};
template <int PART> struct EpiGate { static constexpr bool OUT8 = false;
    const bf16_t* proj; const bf16_t* tmp; bf16_t* out;
    DI void pre(AccRef acc, const g8::Unit& u, int wr, int wc, int fr, int fq) const {
        const unsigned vo_g = (unsigned)(((wr * 64 + fr) * DIN + wc * 32 + 8 * fq) * 2), vo_t = (unsigned)(((wr * 64 + fr) * DM + wc * 32 + 8 * fq) * 2);
#pragma unroll
        for (int ai = 0; ai < 2; ++ai)
#pragma unroll
            for (int m = 0; m < 4; ++m) {
#pragma unroll
                for (int bj = 0; bj < 2; ++bj) {
                    gcptr sg = (gcptr)(proj + (size_t)(u.pm * 256 + ai * 128 + m * 16) * DIN + u.pn * 256 + bj * 128 + (PART == 0 ? COL_GD : COL_GS));
                    asm volatile("" : "+s"(sg));
                    const u32x4 gg = *(gu4ptr)(sg + vo_g);
                    const float sv[8] = {bf_lo(gg.x), bf_hi(gg.x), bf_lo(gg.y), bf_hi(gg.y), bf_lo(gg.z), bf_hi(gg.z), bf_lo(gg.w), bf_hi(gg.w)};
                    if (PART == 0) {
#pragma unroll
                        for (int j = 0; j < 4; ++j) { acc[ai][bj][m][0][j] *= sv[j]; acc[ai][bj][m][1][j] *= sv[4 + j]; }
                    } else {
                        gcptr st = (gcptr)(tmp + (size_t)(u.pm * 256 + ai * 128 + m * 16) * DM + u.pn * 256 + bj * 128);
                        asm volatile("" : "+s"(st));
                        const u32x4 tt = *(gu4ptr)(st + vo_t);
                        const float tv[8] = {bf_lo(tt.x), bf_hi(tt.x), bf_lo(tt.y), bf_hi(tt.y), bf_lo(tt.z), bf_hi(tt.z), bf_lo(tt.w), bf_hi(tt.w)};
#pragma unroll
                        for (int j = 0; j < 4; ++j) { acc[ai][bj][m][0][j] = acc[ai][bj][m][0][j] * sv[j] + tv[j]; acc[ai][bj][m][1][j] = acc[ai][bj][m][1][j] * sv[4 + j] + tv[4 + j]; }
                    }
                }
                asm volatile("" : "+v"(acc[ai][0][m][0]), "+v"(acc[ai][0][m][1]), "+v"(acc[ai][1][m][0]), "+v"(acc[ai][1][m][1]));
                if (m & 1) asm volatile("" ::: "memory");
            }
    }
    DI void row(AccRef acc, const g8::Unit&, int ai, int m, int, int, int, int, u32x4 (&o)[2]) const {
        o[0] = pack8(acc[ai][0][m][0], acc[ai][0][m][1]); o[1] = pack8(acc[ai][1][m][0], acc[ai][1][m][1]);
    }
    DI void store(const g8::Unit& u, int rt, int ch, const u32x4& d) const { *(u32x4*)(out + (size_t)(u.pm * 256 + rt) * DM + u.pn * 256 + ch * 8) = d; }
};
struct EpiPlain { static constexpr bool OUT8 = false;
    bf16_t* out; int ld;
    DI void pre(AccRef, const g8::Unit&, int, int, int, int) const {}
    DI void row(AccRef acc, const g8::Unit&, int ai, int m, int, int, int, int, u32x4 (&o)[2]) const {
        o[0] = pack8(acc[ai][0][m][0], acc[ai][0][m][1]); o[1] = pack8(acc[ai][1][m][0], acc[ai][1][m][1]);
    }
    DI void store(const g8::Unit& u, int rt, int ch, const u32x4& d) const { *(u32x4*)(out + (size_t)(u.pm * 256 + rt) * ld + u.pn * 256 + ch * 8) = d; }
};
struct EpiGateUp { static constexpr bool OUT8 = true;
    unsigned char* hid;
    DI void pre(AccRef, const g8::Unit&, int, int, int, int) const {}
    DI void row(AccRef, const g8::Unit&, int, int, int, int, int, int, u32x4 (&)[2]) const {}
    DI void store(const g8::Unit&, int, int, const u32x4&) const {}
    DI void row8(AccRef acc, const g8::Unit&, int ai, int m, int, int, int, int, u32x2 (&o)[2]) const {
        const f32x4 g0 = acc[ai][0][m][0], g1 = acc[ai][0][m][1], u0 = acc[ai][1][m][0], u1 = acc[ai][1][m][1];
        f32x4 v0, v1;
#pragma unroll
        for (int j = 0; j < 4; ++j) { v0[j] = g0[j] * __builtin_amdgcn_rcpf(1.0f + __expf(-g0[j])) * u0[j]; v1[j] = g1[j] * __builtin_amdgcn_rcpf(1.0f + __expf(-g1[j])) * u1[j]; }
        o[0].x = pk_fp8x4(v0[0], v0[1], v0[2], v0[3]); o[0].y = pk_fp8x4(v1[0], v1[1], v1[2], v1[3]); o[1] = o[0];
    }
    DI void store8(const g8::Unit& u, int rt, int ch, const u32x4& d) const { *(u32x4*)(hid + (size_t)(u.aux + rt) * DE + u.pn * 128 + ch * 16) = d; }
};
struct EpiDown { static constexpr bool OUT8 = true;
    LAS unsigned char* lds; unsigned char* yb9; int* slot;
    DI void pre(AccRef, const g8::Unit&, int, int, int, int) const {}
    DI void row(AccRef, const g8::Unit&, int, int, int, int, int, int, u32x4 (&)[2]) const {}
    DI void store(const g8::Unit&, int, int, const u32x4&) const {}
    DI void row8(AccRef acc, const g8::Unit& u, int ai, int m, int wr, int, int fr, int, u32x2 (&o)[2]) const {
        const int rt = ai * 128 + wr * 64 + m * 16 + fr;
        const float wgt = (u.e < NE) ? *(const LAS float*)(lds + MOE_IDX_OFF + u.par * 2048 + 1024 + rt * 4) : 1.0f;
#pragma unroll
        for (int bj = 0; bj < 2; ++bj) {
            const f32x4 v0 = acc[ai][bj][m][0] * wgt, v1 = acc[ai][bj][m][1] * wgt;
            o[bj].x = pk_fp8x4(v0[0], v0[1], v0[2], v0[3]); o[bj].y = pk_fp8x4(v1[0], v1[1], v1[2], v1[3]);
        }
    }
    DI void store8(const g8::Unit& u, int rt, int ch, const u32x4& d) const {
        if (rt < u.nvalid) {
            const int srow = u.aux + rt;
            __builtin_nontemporal_store(d, (u32x4*)(yb9 + ((size_t)u.pn * YB_SLOTS + srow) * 256 + ch * 16));
            if (u.pn == 0 && ch == 0) {
                const int v = (u.e < NE) ? *(const LAS int*)(lds + MOE_IDX_OFF + u.par * 2048 + rt * 4) : (u.pm * 256 + rt) * 9 + 8;
                slot[v] = srow;
            }
        }
    }
};

DI void phase_inproj(const Params& p, LAS unsigned char* lds) {
    EpiInProj E{(bf16_t*)(p.ws + WS_PROJ), (const float*)(p.ws + WS_ROPE)};
    { DenseSched S{(const char*)(p.ws + WS_H8), (const char*)(p.ws + WS_WTIN8), 64, 46, 2048, 2048, 16, (int)gridDim.x, (int)blockIdx.x, 0};
      g8::gemm_phase<32, 0, GEMM_SPLIT, true>(lds, S, E); }
}
DI void phase_outproj_a(const Params& p, LAS unsigned char* lds) {
    DenseSched S{(const char*)(p.ws + WS_ODIL), (const char*)(p.ws + WS_WTDIL), 64, 8, 1024, 1024, 8, (int)gridDim.x, (int)blockIdx.x};
    EpiGate<0> E{(const bf16_t*)(p.ws + WS_PROJ), nullptr, (bf16_t*)(p.ws + WS_TMP)};
    g8::gemm_phase<32, 0, GEMM_SPLIT, false>(lds, S, E);
}
DI void phase_outproj_b(const Params& p, LAS unsigned char* lds) {
    DenseSched S{(const char*)(p.ws + WS_OSB), (const char*)(p.ws + WS_WTSB), 64, 8, 2048, 2048, 16, (int)gridDim.x, (int)blockIdx.x};
    EpiGate<1> E{(const bf16_t*)(p.ws + WS_PROJ), (const bf16_t*)(p.ws + WS_TMP), (bf16_t*)(p.ws + WS_H)};
    g8::gemm_phase<32, 0, GEMM_SPLIT, false>(lds, S, E);
}
DI void phase_mixout(const Params& p, LAS unsigned char* lds) {
    DenseSched S{(const char*)(p.ws + WS_H), (const char*)(p.ws + WS_WTMIX), 64, 8, 4096, 4096, 32, (int)gridDim.x, (int)blockIdx.x};
    EpiPlain E{(bf16_t*)(p.ws + WS_Y), DM};
    g8::gemm_phase<32, 0, GEMM_SPLIT, false>(lds, S, E);
}
DI void moe_tables(const Params& p, LAS unsigned char* lds) {
    LAS int* tpre = (LAS int*)(lds + MOE_TAB_OFF);
    const int* cnt = (const int*)(p.ws + WS_CNT);
    if (threadIdx.x == 0) {
        int acc = 0;
        for (int e = 0; e < NE; ++e) { const int n = cnt[e]; tpre[e] = acc; tpre[NEX + 1 + e] = n; acc += (n + 255) >> 8; }
        tpre[NE] = acc; tpre[NEX + 1 + NE] = NTOK; acc += NTOK / 256; tpre[NEX] = acc;
    }
    __syncthreads();
    const int T = tpre[NEX];
    for (int t = threadIdx.x; t < T; t += 512) {
        int e = 0;
        for (int q = 1; q < NEX; ++q) e = (tpre[q] <= t) ? q : e;
        *(LAS unsigned char*)(lds + MOE_TILE_OFF + t) = (unsigned char)e;
    }
    __syncthreads();
}
DI void phase_gateup(const Params& p, LAS unsigned char* lds) {
    moe_tables(p, lds);
    MoeSched S{lds, (const int*)(p.ws + WS_LIST), (const float*)(p.ws + WS_LISTW), (const char*)(p.ws + WS_H), (const char*)(p.ws + WS_WGU), 4, 0, (int)gridDim.x, (int)blockIdx.x};
    EpiGateUp E{(unsigned char*)(p.ws + WS_HID)};
    g8::gemm_phase<16, MOE_BAUX, GEMM_SPLIT, true>(lds, S, E);
}
DI void phase_down(const Params& p, LAS unsigned char* lds) {
    moe_tables(p, lds);
    MoeSched S{lds, (const int*)(p.ws + WS_LIST), (const float*)(p.ws + WS_LISTW), (const char*)(p.ws + WS_HID), (const char*)(p.ws + WS_WD), 8, 1, (int)gridDim.x, (int)blockIdx.x};
    EpiDown E{lds, (unsigned char*)(p.ws + WS_YB9), (int*)(p.ws + WS_SLOT)};
    g8::gemm_phase<32, MOE_BAUX, GEMM_SPLIT, true>(lds, S, E);
}

namespace att {
constexpr int TB = 16384;
DI unsigned off_b(unsigned row, unsigned ch) { return 256u * row + 16u * (ch ^ (((row & 3u) << 2) | ((row >> 2) & 3u))); }
DI int crow(int i, int h) { return (i & 3) + 8 * (i >> 2) + 4 * h; }
DI f32x16 mfma32(bf16x8 a, bf16x8 b, f32x16 c) { return __builtin_amdgcn_mfma_f32_32x32x16_bf16(a, b, c, 0, 0, 0); }
DI bf16x8 pack8(const f32x16& x, int s) {
    u32x4 w; w.x = pk_bf16(x[8 * s + 0], x[8 * s + 1]); w.y = pk_bf16(x[8 * s + 2], x[8 * s + 3]); w.z = pk_bf16(x[8 * s + 4], x[8 * s + 5]); w.w = pk_bf16(x[8 * s + 6], x[8 * s + 7]);
    return __builtin_bit_cast(bf16x8, w);
}
DI void qk_tile(LAS const unsigned char* Kb, const bf16x8 (&qf)[8], f32x16& x0, f32x16& x1, int r, int h) {
#pragma unroll
    for (int i = 0; i < 16; ++i) { x0[i] = 0.f; x1[i] = 0.f; }
#pragma unroll
    for (int s = 0; s < 8; ++s) {
        const bf16x8 a0 = *(const LAS bf16x8*)(Kb + off_b(r, 2 * s + h));
        const bf16x8 a1 = *(const LAS bf16x8*)(Kb + off_b(32 + r, 2 * s + h));
        x0 = mfma32(a0, qf[s], x0); x1 = mfma32(a1, qf[s], x1);
    }
}
DI void pv_tile(LAS const unsigned char* Vb, const f32x16& p0, const f32x16& p1, f32x16 (&o)[4], int lane) {
    const int h = lane >> 5, blk = (lane >> 4) & 1, q = (lane & 15) >> 2, pp = lane & 3;
#pragma unroll
    for (int kb = 0; kb < 2; ++kb)
#pragma unroll
        for (int s = 0; s < 2; ++s) {
            const bf16x8 pf = pack8(kb ? p1 : p0, s);
#pragma unroll
            for (int db = 0; db < 4; ++db) {
                const unsigned row0 = 32 * kb + 16 * s + 4 * h + q;
                const unsigned ch = 4 * db + 2 * blk + (pp >> 1);
                const s16x4 t0 = __builtin_amdgcn_ds_read_tr16_b64_v4i16((LAS s16x4*)(Vb + off_b(row0, ch) + 8 * (pp & 1)));
                const s16x4 t1 = __builtin_amdgcn_ds_read_tr16_b64_v4i16((LAS s16x4*)(Vb + off_b(row0 + 8, ch) + 8 * (pp & 1)));
                const bf16x8 vf = {t0[0], t0[1], t0[2], t0[3], t1[0], t1[1], t1[2], t1[3]};
                o[db] = mfma32(vf, pf, o[db]);
            }
        }
}
DI void store_o(bf16_t* orow, const f32x16 (&o)[4], float scale, int h) {
#pragma unroll
    for (int db = 0; db < 4; ++db)
#pragma unroll
        for (int g = 0; g < 4; ++g) {
            u32x2 w; w.x = pk_bf16(o[db][4 * g] * scale, o[db][4 * g + 1] * scale); w.y = pk_bf16(o[db][4 * g + 2] * scale, o[db][4 * g + 3] * scale);
            *(u32x2*)(orow + 32 * db + 8 * g + 4 * h) = w;
        }
}

DI void sb_item(const Params& p, LAS unsigned char* lds, int b, int hd, int Q) {
    const bf16_t* proj = (const bf16_t*)(p.ws + WS_PROJ);
    bf16_t* osb = (bf16_t*)(p.ws + WS_OSB);
    const int tid = threadIdx.x, wid = __builtin_amdgcn_readfirstlane(tid >> 6), lane = tid & 63, r = lane & 31, h = lane >> 5;
    const size_t tokbase = (size_t)b * SEQ;
    const int wq0 = Q * 256 + 32 * wid;
    const int myq = wq0 + r;
    bf16x8 qf[8];
    f32x16 o[4];
#pragma unroll
    for (int db = 0; db < 4; ++db)
#pragma unroll
        for (int i = 0; i < 16; ++i) o[db][i] = 0.f;
    float R = 0.f;
    unsigned goff[2];
#pragma unroll
    for (int i = 0; i < 2; ++i) { const unsigned row = 4 * (wid * 2 + i) + (lane >> 4), cp = lane & 15, ch = cp ^ (((row & 3u) << 2) | ((row >> 2) & 3u)); goff[i] = (row * DIN + ch * 8) * 2; }
    const char* kbase = (const char*)(proj + tokbase * DIN + COL_KS + hd * 128);
    const char* vbase = (const char*)(proj + tokbase * DIN + COL_VS + hd * 128);
#define ATT_ISSUE(key0_, buf_) do { const size_t _ko = (size_t)(key0_) * DIN * 2; _Pragma("unroll") for (int _i = 0; _i < 2; ++_i) { \
        __builtin_amdgcn_global_load_lds((const unsigned*)(kbase + _ko + goff[_i]), (LAS unsigned*)(lds + (buf_) * TB + 1024 * (wid * 2 + _i)), 16, 0, 0); \
        __builtin_amdgcn_global_load_lds((const unsigned*)(vbase + _ko + goff[_i]), (LAS unsigned*)(lds + 3 * TB + (buf_) * TB + 1024 * (wid * 2 + _i)), 16, 0, 0); } } while (0)
    int j = 4 * Q + 3;
    ATT_ISSUE(64 * j, 0);
    ATT_ISSUE(64 * (j - 1), 1);
    {
        const bf16_t* qrow = proj + (tokbase + myq) * DIN + COL_QS + hd * 128;
#pragma unroll
        for (int s = 0; s < 8; ++s) qf[s] = *(const bf16x8*)(qrow + 16 * s + 8 * h);
#pragma unroll
        for (int s = 0; s < 8; ++s) asm volatile("" : "+v"(qf[s]));
    }
    int cur = 0;
    for (; j >= 0; --j) {
        LAS unsigned char* Kb = lds + cur * TB; LAS unsigned char* Vb = lds + 3 * TB + cur * TB;
        if (j > 0) asm volatile("s_waitcnt vmcnt(4)" ::: "memory"); else asm volatile("s_waitcnt vmcnt(0)" ::: "memory");
        __builtin_amdgcn_s_barrier(); asm volatile("" ::: "memory");
        if (j > 1) ATT_ISSUE(64 * (j - 2), cur == 0 ? 2 : cur - 1);
        const int key0 = 64 * j;
        if (key0 < wq0 + 31) {
            const bool need_mask = (key0 + 63 >= wq0);
            f32x16 x0, x1;
            qk_tile(Kb, qf, x0, x1, r, h);
            f32x16 l0, l1;
#pragma unroll
            for (int i = 0; i < 16; ++i) {
                l0[i] = __builtin_amdgcn_logf(1.0f + __builtin_amdgcn_exp2f(x0[i]));
                l1[i] = __builtin_amdgcn_logf(1.0f + __builtin_amdgcn_exp2f(x1[i]));
            }
            if (need_mask) {
#pragma unroll
                for (int i = 0; i < 16; ++i) { const int kk = key0 + crow(i, h); if (kk >= myq) l0[i] = 0.f; if (kk + 32 >= myq) l1[i] = 0.f; }
            }
#pragma unroll
            for (int g = 0; g < 4; ++g) {
                l0[4 * g + 2] += l0[4 * g + 3]; l0[4 * g + 1] += l0[4 * g + 2]; l0[4 * g] += l0[4 * g + 1];
                l1[4 * g + 2] += l1[4 * g + 3]; l1[4 * g + 1] += l1[4 * g + 2]; l1[4 * g] += l1[4 * g + 1];
            }
            float Tlo[8], Thi[8];
#pragma unroll
            for (int g = 0; g < 4; ++g) {
                { const unsigned t = __float_as_uint(l0[4 * g]); auto sw = __builtin_amdgcn_permlane32_swap(t, t, false, false); Tlo[g] = __uint_as_float(sw[0]); Thi[g] = __uint_as_float(sw[1]); }
                { const unsigned t = __float_as_uint(l1[4 * g]); auto sw = __builtin_amdgcn_permlane32_swap(t, t, false, false); Tlo[4 + g] = __uint_as_float(sw[0]); Thi[4 + g] = __uint_as_float(sw[1]); }
            }
            float offR[8];
            float run = 0.f;
#pragma unroll
            for (int g = 7; g >= 0; --g) { offR[g] = run + (h == 0 ? Thi[g] : 0.f) + R; run += Tlo[g] + Thi[g]; }
            f32x16 p0, p1;
#pragma unroll
            for (int i = 0; i < 16; ++i) {
                p0[i] = __builtin_amdgcn_exp2f(x0[i] - (l0[i] + offR[i >> 2]));
                p1[i] = __builtin_amdgcn_exp2f(x1[i] - (l1[i] + offR[4 + (i >> 2)]));
            }
            if (need_mask) {
#pragma unroll
                for (int i = 0; i < 16; ++i) { const int kk = key0 + crow(i, h); if (kk >= myq) p0[i] = 0.f; if (kk + 32 >= myq) p1[i] = 0.f; }
            }
            R += run;
            pv_tile(Vb, p0, p1, o, lane);
        }
        cur = (cur == 2) ? 0 : cur + 1;
    }
    store_o(osb + (tokbase + myq) * 1024 + hd * 128, o, 1.0f, h);
    __syncthreads();
}

DI void dil_item(const Params& p, LAS unsigned char* lds, int di) {
    const bf16_t* proj = (const bf16_t*)(p.ws + WS_PROJ);
    bf16_t* og = (bf16_t*)(p.ws + WS_OG);
    float* lse = (float*)(p.ws + WS_LSE);
    const int b = di / 192; const int rem = di - b * 192; const int head = rem >> 4, sub = rem & 15;
    const int grp = head >> 2;
    const int dil = grp == 0 ? 1 : grp == 1 ? 4 : 16;
    const int nblk = 16 / dil;
    const int res = sub / nblk, Qb = sub - res * nblk;
    const int i0 = Qb * 256;
    const int tid = threadIdx.x, wid = __builtin_amdgcn_readfirstlane(tid >> 6), lane = tid & 63, r = lane & 31, h = lane >> 5;
    const size_t tokbase = (size_t)b * SEQ;
    const int wq0 = i0 + 32 * wid;
    const int myqi = wq0 + r;
    const size_t mytok = tokbase + (size_t)myqi * dil + res;
    bf16x8 qf[8];
    f32x16 o[4];
#pragma unroll
    for (int db = 0; db < 4; ++db)
#pragma unroll
        for (int i = 0; i < 16; ++i) o[db][i] = 0.f;
    float mrun = -1e30f, lrun = 0.f;
    unsigned goff[2];
#pragma unroll
    for (int i = 0; i < 2; ++i) { const unsigned row = 4 * (wid * 2 + i) + (lane >> 4), cp = lane & 15, ch = cp ^ (((row & 3u) << 2) | ((row >> 2) & 3u)); goff[i] = (row * dil * DIN + ch * 8) * 2; }
    const char* kbase = (const char*)(proj + (tokbase + res) * DIN + COL_KA + head * 128);
    const char* vbase = (const char*)(proj + (tokbase + res) * DIN + COL_VA + head * 128);
    const int jt0 = (i0 == 0) ? 2 : 0;
    ATT_ISSUE((i0 - 128 + 64 * jt0) * dil, 0);
    ATT_ISSUE((i0 - 128 + 64 * (jt0 + 1)) * dil, 1);
    {
        const bf16_t* qrow = proj + mytok * DIN + COL_QA + head * 128;
#pragma unroll
        for (int s = 0; s < 8; ++s) qf[s] = *(const bf16x8*)(qrow + 16 * s + 8 * h);
#pragma unroll
        for (int s = 0; s < 8; ++s) asm volatile("" : "+v"(qf[s]));
    }
    int cur = 0;
    for (int jt = jt0; jt < 6; ++jt) {
        LAS unsigned char* Kb = lds + cur * TB; LAS unsigned char* Vb = lds + 3 * TB + cur * TB;
        if (jt < 5) asm volatile("s_waitcnt vmcnt(4)" ::: "memory"); else asm volatile("s_waitcnt vmcnt(0)" ::: "memory");
        __builtin_amdgcn_s_barrier(); asm volatile("" ::: "memory");
        if (jt < 4) ATT_ISSUE((i0 - 128 + 64 * (jt + 2)) * dil, cur == 0 ? 2 : cur - 1);
        const int ki0 = i0 - 128 + 64 * jt;
        if (ki0 <= wq0 + 31 && ki0 + 63 >= wq0 - 128) {
            f32x16 x0, x1;
            qk_tile(Kb, qf, x0, x1, r, h);
            const float NEG = -__builtin_inff();
#pragma unroll
            for (int i = 0; i < 16; ++i) {
                const int d0 = myqi - (ki0 + crow(i, h));
                if ((unsigned)d0 > 128u) x0[i] = NEG;
                if ((unsigned)(d0 - 32) > 128u) x1[i] = NEG;
            }
            float mx = x0[0];
#pragma unroll
            for (int i = 1; i < 16; ++i) mx = fmaxf(mx, x0[i]);
#pragma unroll
            for (int i = 0; i < 16; ++i) mx = fmaxf(mx, x1[i]);
            { const unsigned t = __float_as_uint(mx); auto sw = __builtin_amdgcn_permlane32_swap(t, t, false, false); mx = fmaxf(__uint_as_float(sw[0]), __uint_as_float(sw[1])); }
            const float mn = fmaxf(mrun, mx);
            const float alpha = __builtin_amdgcn_exp2f(mrun - mn);
            mrun = mn;
            f32x16 p0, p1; float rs = 0.f;
#pragma unroll
            for (int i = 0; i < 16; ++i) { p0[i] = __builtin_amdgcn_exp2f(x0[i] - mn); p1[i] = __builtin_amdgcn_exp2f(x1[i] - mn); rs += p0[i] + p1[i]; }
            { const unsigned t = __float_as_uint(rs); auto sw = __builtin_amdgcn_permlane32_swap(t, t, false, false); rs = __uint_as_float(sw[0]) + __uint_as_float(sw[1]); }
            lrun = lrun * alpha + rs;
#pragma unroll
            for (int db = 0; db < 4; ++db)
#pragma unroll
                for (int i = 0; i < 16; ++i) o[db][i] *= alpha;
            pv_tile(Vb, p0, p1, o, lane);
        }
        cur = (cur == 2) ? 0 : cur + 1;
    }
    store_o(og + mytok * 1536 + head * 128, o, 1.0f / lrun, h);
    if (h == 0) lse[mytok * 12 + head] = (mrun + __builtin_amdgcn_logf(lrun)) * LN2;
    __syncthreads();
}
#undef ATT_ISSUE
}

DI void phase_attn(const Params& p, LAS unsigned char* lds) {
    for (int it = blockIdx.x; it < 1024; it += gridDim.x) {
        if (it < 256) {
            const int xcd = it & 7, rest = it >> 3, bhi = rest >> 3, x = rest & 7, bh = xcd * 4 + bhi;
            att::sb_item(p, lds, bh >> 3, bh & 7, 15 - x);
            att::sb_item(p, lds, bh >> 3, bh & 7, x);
        } else att::dil_item(p, lds, it - 256);
    }
}

DI void phase_merge(const Params& p) {
    const int lane = threadIdx.x & 63, wid = threadIdx.x >> 6;
    const bf16_t* og = (const bf16_t*)(p.ws + WS_OG); const float* lse = (const float*)(p.ws + WS_LSE); bf16_t* odil = (bf16_t*)(p.ws + WS_ODIL);
    const int hg = lane >> 4, d0 = (lane & 15) * 8;
    for (int tok = blockIdx.x * 8 + wid; tok < NTOK; tok += gridDim.x * 8) {
        const float l0 = lse[(size_t)tok * 12 + hg], l1 = lse[(size_t)tok * 12 + 4 + hg], l2 = lse[(size_t)tok * 12 + 8 + hg];
        const float mx = fmaxf(l0, fmaxf(l1, l2));
        float w0 = __expf(l0 - mx), w1 = __expf(l1 - mx), w2 = __expf(l2 - mx);
        const float inv = 1.0f / (w0 + w1 + w2); w0 *= inv; w1 *= inv; w2 *= inv;
        const u32x4 a = *(const u32x4*)(og + (size_t)tok * 1536 + hg * 128 + d0);
        const u32x4 bq = *(const u32x4*)(og + (size_t)tok * 1536 + (4 + hg) * 128 + d0);
        const u32x4 c = *(const u32x4*)(og + (size_t)tok * 1536 + (8 + hg) * 128 + d0);
        u32x4 o;
#pragma unroll
        for (int q = 0; q < 4; ++q) {
            const float lo = w0 * bf_lo(a[q]) + w1 * bf_lo(bq[q]) + w2 * bf_lo(c[q]);
            const float hi = w0 * bf_hi(a[q]) + w1 * bf_hi(bq[q]) + w2 * bf_hi(c[q]);
            o[q] = pk_bf16(lo, hi);
        }
        *(u32x4*)(odil + (size_t)tok * 512 + hg * 128 + d0) = o;
    }
}

DI void phase_postmix(const Params& p, LAS unsigned char* lds) {
    const int tid = threadIdx.x, lane = tid & 63, wid = __builtin_amdgcn_readfirstlane(tid >> 6);
    LAS float* hsm = (LAS float*)lds;
    LAS float* part = (LAS float*)(lds + 131072);
    const float* mod = (const float*)(p.ws + WS_MOD); const bf16_t* y = (const bf16_t*)(p.ws + WS_Y);
    unsigned char* h2 = (unsigned char*)(p.ws + WS_H);
    int* cnt = (int*)(p.ws + WS_CNT); int* list = (int*)(p.ws + WS_LIST); float* listw = (float*)(p.ws + WS_LISTW);
    const bf16_t* wr_hi = (const bf16_t*)(p.ws + WS_WRT); const bf16_t* wr_lo = wr_hi + 64 * 2048;
    LAS int* lcnt = (LAS int*)(lds + 147456);
    LAS int* lbase = (LAS int*)(lds + 147712);
    LAS unsigned char* sel_e = lds + 147968;
    LAS unsigned short* sel_r = (LAS unsigned short*)(lds + 150016);
    LAS float* sel_w = (LAS float*)(lds + 154112);
    if (tid < 64) lcnt[tid] = 0;
    int itl = 0;
    for (int it = blockIdx.x; it < NTOK / 16; it += gridDim.x, ++itl) {
#pragma unroll 1
        for (int sub = 0; sub < 2; ++sub) {
            const int tl = 2 * wid + sub, tok = it * 16 + tl, b = tok >> 12;
            f32x4 v[8]; float ss = 0.f;
#pragma unroll
            for (int i = 0; i < 8; ++i) { const u32x2 yw = *(const u32x2*)(y + (size_t)tok * DM + 4 * (lane + 64 * i)); v[i] = (f32x4){bf_lo(yw.x), bf_hi(yw.x), bf_lo(yw.y), bf_hi(yw.y)}; ss += v[i][0] * v[i][0] + v[i][1] * v[i][1] + v[i][2] * v[i][2] + v[i][3] * v[i][3]; }
            ss = wave_sum(ss);
            const float rstd = rsqrtf(ss * (1.0f / DM) + RMS_EPS);
            float ss1 = 0.f;
#pragma unroll
            for (int i = 0; i < 8; ++i) {
                const int ch = 4 * (lane + 64 * i);
                const f32x4 g = *(const f32x4*)(p.g_post_mix + ch);
                const f32x4 gt = *(const f32x4*)(mod + b * 12288 + 4096 + ch);
                const f32x4 xv = *(const f32x4*)(p.x + (size_t)tok * DM + ch);
#pragma unroll
                for (int j = 0; j < 4; ++j) { v[i][j] = xv[j] + gt[j] * (v[i][j] * rstd * g[j]); ss1 += v[i][j] * v[i][j]; }
                { u32x2 w; w.x = pk_bf16(v[i][0], v[i][1]); w.y = pk_bf16(v[i][2], v[i][3]); *(u32x2*)(p.ws + WS_X1 + ((size_t)tok * DM + ch) * 2) = w; }
            }
            ss1 = wave_sum(ss1);
            const float rstd1 = rsqrtf(ss1 * (1.0f / DM) + RMS_EPS);
#pragma unroll
            for (int i = 0; i < 8; ++i) {
                const int ch = 4 * (lane + 64 * i);
                const f32x4 g = *(const f32x4*)(p.g_pre_ffn + ch);
                const f32x4 sh = *(const f32x4*)(mod + b * 12288 + 6144 + ch);
                const f32x4 sc = *(const f32x4*)(mod + b * 12288 + 8192 + ch);
                f32x4 o;
#pragma unroll
                for (int j = 0; j < 4; ++j) o[j] = v[i][j] * rstd1 * g[j] * (1.0f + sc[j]) + sh[j];
                *(unsigned*)(h2 + (size_t)tok * DM + ch) = pk_fp8x4(o[0], o[1], o[2], o[3]);
                *(LAS f32x4*)(hsm + tl * 2048 + ch) = o;
            }
        }
        __syncthreads();
        f32x4 acc[4];
        {
            const int tr = lane & 15, kq = lane >> 4;
#pragma unroll
            for (int q = 0; q < 4; ++q) acc[q] = (f32x4){0.f, 0.f, 0.f, 0.f};
#pragma unroll 4
            for (int ks = 0; ks < 8; ++ks) {
                const int k0 = 256 * wid + 32 * ks + 8 * kq;
                const f32x4 a0 = *(const LAS f32x4*)(hsm + tr * 2048 + k0), a1 = *(const LAS f32x4*)(hsm + tr * 2048 + k0 + 4);
                u32x4 hw, lw;
                {
                    float xs[8] = {a0[0], a0[1], a0[2], a0[3], a1[0], a1[1], a1[2], a1[3]};
                    unsigned hh[4], ll[4];
#pragma unroll
                    for (int q = 0; q < 4; ++q) {
                        hh[q] = pk_bf16(xs[2 * q], xs[2 * q + 1]);
                        ll[q] = pk_bf16(xs[2 * q] - bf_lo(hh[q]), xs[2 * q + 1] - bf_hi(hh[q]));
                    }
                    hw = (u32x4){hh[0], hh[1], hh[2], hh[3]}; lw = (u32x4){ll[0], ll[1], ll[2], ll[3]};
                }
                const bf16x8 ah = __builtin_bit_cast(bf16x8, hw), al = __builtin_bit_cast(bf16x8, lw);
#pragma unroll
                for (int q = 0; q < 4; ++q) {
                    const bf16x8 bh = *(const bf16x8*)(wr_hi + (size_t)(16 * q + tr) * 2048 + k0);
                    const bf16x8 bl = *(const bf16x8*)(wr_lo + (size_t)(16 * q + tr) * 2048 + k0);
                    acc[q] = __builtin_amdgcn_mfma_f32_16x16x32_bf16(ah, bh, acc[q], 0, 0, 0);
                    acc[q] = __builtin_amdgcn_mfma_f32_16x16x32_bf16(ah, bl, acc[q], 0, 0, 0);
                    acc[q] = __builtin_amdgcn_mfma_f32_16x16x32_bf16(al, bh, acc[q], 0, 0, 0);
                }
            }
            if (wid >= 4) {
#pragma unroll
                for (int q = 0; q < 4; ++q)
#pragma unroll
                    for (int j = 0; j < 4; ++j) part[((wid - 4) * 16 + 4 * kq + j) * 64 + 16 * q + tr] = acc[q][j];
            }
        }
        __syncthreads();
        if (wid < 4) {
            const int tr = lane & 15, kq = lane >> 4;
#pragma unroll
            for (int q = 0; q < 4; ++q)
#pragma unroll
                for (int j = 0; j < 4; ++j) part[(wid * 16 + 4 * kq + j) * 64 + 16 * q + tr] += acc[q][j];
        }
        __syncthreads();
#pragma unroll 1
        for (int sub = 0; sub < 2; ++sub) {
            const int tl = 2 * wid + sub, tok = it * 16 + tl;
            const float logit = ((part[(0 * 16 + tl) * 64 + lane] + part[(1 * 16 + tl) * 64 + lane]) + part[(2 * 16 + tl) * 64 + lane]) + part[(3 * 16 + tl) * 64 + lane];
            const float score = 1.0f / (1.0f + __expf(-logit));
            const float sel = score + p.router_bias[lane];
            float m1 = sel;
            m1 = fmaxf(m1, __shfl_xor(m1, 1)); m1 = fmaxf(m1, __shfl_xor(m1, 2)); m1 = fmaxf(m1, __shfl_xor(m1, 4));
            const bool is1 = (sel == m1);
            const unsigned long long bal = __ballot(is1);
            const unsigned gm = (unsigned)(bal >> (lane & ~7)) & 0xffu;
            const int first = __ffs(gm) - 1;
            float m2 = (is1 && (lane & 7) == first) ? -__builtin_inff() : sel;
            m2 = fmaxf(m2, __shfl_xor(m2, 1)); m2 = fmaxf(m2, __shfl_xor(m2, 2)); m2 = fmaxf(m2, __shfl_xor(m2, 4));
            const float gs = m1 + m2;
            const int myg = lane >> 3;
            int grank = 0;
#pragma unroll 1
            for (int g = 0; g < 8; ++g) { const float gv = __uint_as_float(__builtin_amdgcn_readlane(__float_as_uint(gs), 8 * g)); grank += (gv > gs || (gv == gs && g < myg)) ? 1 : 0; }
            const bool gsel = grank < 4;
            const float msel = gsel ? sel : -__builtin_inff();
            int rk = 0;
#pragma unroll 4
            for (int e = 0; e < 64; ++e) { const float v = __uint_as_float(__builtin_amdgcn_readlane(__float_as_uint(msel), e)); rk += (v > msel || (v == msel && e < lane)) ? 1 : 0; }
            const bool chosen = gsel && rk < 8;
            const float ssum = wave_sum(chosen ? score : 0.f);
            if (chosen) {
                const int lr = __hip_atomic_fetch_add(lcnt + lane, 1, __ATOMIC_RELAXED, __HIP_MEMORY_SCOPE_WORKGROUP);
                const int idx = ((itl & 15) * 16 + tl) * 8 + rk;
                sel_e[idx] = (unsigned char)lane; sel_r[idx] = (unsigned short)lr; sel_w[idx] = score / ssum * 2.5f;
            }
            (void)tok;
        }
        __syncthreads();
        if ((itl & 15) == 15 || it + (int)gridDim.x >= NTOK / 16) {
            if (tid < 64) lbase[tid] = atomicAdd(&cnt[tid], lcnt[tid]);
            __syncthreads();
            const int nsel = ((itl & 15) + 1) * 128, it0 = itl & ~15;
            for (int idx = tid; idx < nsel; idx += 512) {
                const int e = sel_e[idx], tl = idx >> 3, k = idx & 7;
                const int tk = ((int)blockIdx.x + (it0 + (tl >> 4)) * (int)gridDim.x) * 16 + (tl & 15);
                const int pos = lbase[e] + sel_r[idx];
                list[e * LIST_CAP + pos] = tk * 9 + k; listw[e * LIST_CAP + pos] = sel_w[idx];
            }
            __syncthreads();
            if (tid < 64) lcnt[tid] = 0;
            __syncthreads();
        }
    }
}

DI void phase_combine(const Params& p, LAS unsigned char* lds) {
    const int lane = threadIdx.x & 63, wid = __builtin_amdgcn_readfirstlane(threadIdx.x >> 6);
    const float* mod = (const float*)(p.ws + WS_MOD); const unsigned char* yb9 = (const unsigned char*)(p.ws + WS_YB9); const int* slot = (const int*)(p.ws + WS_SLOT);
    LAS float* sg = (LAS float*)lds;
    LAS float* sgt = sg + DM;
    for (int i = threadIdx.x; i < DM; i += 512) {
        sg[i] = p.g_post_ffn[i];
#pragma unroll
        for (int b = 0; b < 4; ++b) sgt[b * DM + i] = mod[b * 12288 + 10240 + i];
    }
    __syncthreads();
    unsigned vo[2];
#pragma unroll
    for (int i = 0; i < 2; ++i) { const int c = lane + 64 * i; vo[i] = (unsigned)(c >> 4) * (unsigned)(YB_SLOTS * 256) + (unsigned)(c & 15) * 16u; }
#pragma unroll 1
    for (int tok = blockIdx.x * 8 + wid; tok < NTOK; tok += gridDim.x * 8) {
        const int b = tok >> 12;
        int sl = 0; if (lane < 9) sl = slot[tok * 9 + lane];
        u32x4 w[9][2]; u32x2 x1v[8];
        gcptr xb = (gcptr)(p.ws + WS_X1 + (size_t)tok * DM * 2);
        asm volatile("" : "+s"(xb));
#pragma unroll
        for (int r = 0; r < 8; ++r) x1v[r] = *(const __attribute__((address_space(1))) u32x2*)(xb + (unsigned)(8 * lane + 512 * r));
#pragma unroll
        for (int k = 0; k < 9; ++k) {
            gcptr row = (gcptr)(yb9 + (size_t)__builtin_amdgcn_readlane(sl, k) * 256);
            asm volatile("" : "+s"(row));
#pragma unroll
            for (int i = 0; i < 2; ++i) w[k][i] = __builtin_nontemporal_load((gu4ptr)(row + vo[i]));
        }
        asm volatile("" ::: "memory");
        f32x4 acc[2][4];
#pragma unroll
        for (int i = 0; i < 2; ++i)
#pragma unroll
            for (int q = 0; q < 4; ++q) acc[i][q] = (f32x4){0.f, 0.f, 0.f, 0.f};
#pragma unroll
        for (int k = 0; k < 9; ++k) {
#pragma unroll
            for (int i = 0; i < 2; ++i)
#pragma unroll
                for (int q = 0; q < 4; ++q) {
                    const f32x2 lo = __builtin_amdgcn_cvt_pk_f32_fp8((int)w[k][i][q], false), hi = __builtin_amdgcn_cvt_pk_f32_fp8((int)w[k][i][q], true);
                    acc[i][q][0] += lo[0]; acc[i][q][1] += lo[1]; acc[i][q][2] += hi[0]; acc[i][q][3] += hi[1];
                }
            asm volatile("" : "+v"(acc[0][0]), "+v"(acc[0][1]), "+v"(acc[0][2]), "+v"(acc[0][3]), "+v"(acc[1][0]), "+v"(acc[1][1]), "+v"(acc[1][2]), "+v"(acc[1][3]));
        }
        float ss = 0.f;
#pragma unroll
        for (int i = 0; i < 2; ++i)
#pragma unroll
            for (int q = 0; q < 4; ++q)
#pragma unroll
                for (int j = 0; j < 4; ++j) ss += acc[i][q][j] * acc[i][q][j];
        ss = wave_sum(ss);
        const float rstd = rsqrtf(ss * (1.0f / DM) + RMS_EPS);
        LAS float* wrow = (LAS float*)(lds + 40960 + wid * 8192);
#pragma unroll
        for (int i = 0; i < 2; ++i) {
            const int ch = 16 * (lane + 64 * i);
#pragma unroll
            for (int hh = 0; hh < 4; ++hh) {
                const f32x4 g = *(const LAS f32x4*)(sg + ch + 4 * hh), gt = *(const LAS f32x4*)(sgt + b * DM + ch + 4 * hh);
                f32x4 t;
#pragma unroll
                for (int j = 0; j < 4; ++j) t[j] = gt[j] * (acc[i][hh][j] * rstd * g[j]);
                *(LAS f32x4*)(wrow + ch + 4 * hh) = t;
            }
        }
        asm volatile("s_waitcnt lgkmcnt(0)" ::: "memory");
        float* ob = p.out + (size_t)tok * DM;
#pragma unroll
        for (int r = 0; r < 8; ++r) {
            const int ch = 4 * lane + 256 * r;
            const f32x4 t = *(const LAS f32x4*)(wrow + ch);
            const u32x2 xw = x1v[r];
            f32x4 xv = (f32x4){bf_lo(xw.x) + t[0], bf_hi(xw.x) + t[1], bf_lo(xw.y) + t[2], bf_hi(xw.y) + t[3]};
            __builtin_nontemporal_store(xv, (f32x4*)(ob + ch));
        }
        asm volatile("s_waitcnt lgkmcnt(0)" ::: "memory");
    }
}

DI void probe_copy(const Params& p) {
    u32x4* yb = (u32x4*)(p.ws + WS_YB9);
    const size_t n = (size_t)576 * MiB / 16;
    for (size_t i = (size_t)blockIdx.x * 512 + threadIdx.x; i < n; i += (size_t)gridDim.x * 512) { u32x4 v = yb[i]; asm volatile("" : "+v"(v)); yb[i] = v; }
}

constexpr int NPHASE = 12;
template <int PH> DI void run_phase(const Params& p, LAS unsigned char* lds) {
    if constexpr (PH == 0) phase_prologue(p, lds);
    else if constexpr (PH == 1) phase_prenorm(p);
    else if constexpr (PH == 2) phase_inproj(p, lds);
    else if constexpr (PH == 3) phase_attn(p, lds);
    else if constexpr (PH == 4) phase_merge(p);
    else if constexpr (PH == 5) phase_outproj_a(p, lds);
    else if constexpr (PH == 6) phase_outproj_b(p, lds);
    else if constexpr (PH == 7) phase_mixout(p, lds);
    else if constexpr (PH == 8) phase_postmix(p, lds);
    else if constexpr (PH == 9) phase_gateup(p, lds);
    else if constexpr (PH == 10) phase_down(p, lds);
    else phase_combine(p, lds);
}
template <int PH> __global__ __launch_bounds__(512, 2) void k_phase(Params p) {
    extern __shared__ __attribute__((aligned(16))) unsigned char shm[];
    run_phase<PH>(p, (LAS unsigned char*)shm);
}
#if MK_FUSED
typedef const __attribute__((address_space(4))) Params* KargPtr;
template <int PH> DI void mega_phase(KargPtr kp0, LAS unsigned char* lds) {
    KargPtr kp = kp0; asm volatile("" : "+s"(kp));
    Params p{};
#if defined(__HIP_DEVICE_COMPILE__)
    p.x = kp->x; p.c = kp->c; p.pos = kp->pos; p.w_ada = kp->w_ada; p.b_ada = kp->b_ada; p.g_pre_mix = kp->g_pre_mix; p.g_post_mix = kp->g_post_mix; p.g_pre_ffn = kp->g_pre_ffn; p.g_post_ffn = kp->g_post_ffn; p.w_in = kp->w_in; p.w_dil_out = kp->w_dil_out; p.w_sb_out = kp->w_sb_out; p.w_mix_out = kp->w_mix_out; p.w_router = kp->w_router; p.router_bias = kp->router_bias; p.w_gate_e = kp->w_gate_e; p.w_up_e = kp->w_up_e; p.w_down_e = kp->w_down_e; p.w_gate_s = kp->w_gate_s; p.w_up_s = kp->w_up_s; p.w_down_s = kp->w_down_s; p.out = kp->out; p.ws = kp->ws;
#endif
    run_phase<PH>(p, lds);
}
__global__ __launch_bounds__(512, 2) void k_mega(Params p_unused) {
    extern __shared__ __attribute__((aligned(16))) unsigned char shm[];
    LAS unsigned char* lds = (LAS unsigned char*)shm;
    KargPtr kp0 = (KargPtr)__builtin_amdgcn_kernarg_segment_ptr();
    volatile LAS unsigned* xbw = (volatile LAS unsigned*)(lds + LDS_BYTES - 16);
    if (threadIdx.x == 0) { xbw[0] = 0u; xbw[1] = 0u; xbw[2] = 0u; xbw[3] = 0u; }
    __syncthreads();
    XcdBarrier bar;
    { KargPtr kp = kp0; asm volatile("" : "+s"(kp)); bar = xcd_barrier_post((unsigned*)(kp->ws + WS_BAR), xbw); }
    if (MK_STAMP >= 0 && blockIdx.x == 0 && threadIdx.x == 0) { KargPtr kq = kp0; asm volatile("" : "+s"(kq)); ((unsigned long long*)(kq->ws + WS_STAMP))[0] = wall_clock64(); }
#define MEGA_PH(n) do { mega_phase<n>(kp0, lds); xcd_barrier(bar); if (MK_REP == n) { mega_phase<n>(kp0, lds); xcd_barrier(bar); } \
        if (MK_STAMP >= 0 && blockIdx.x == 0 && threadIdx.x == 0) { KargPtr kq = kp0; asm volatile("" : "+s"(kq)); ((unsigned long long*)(kq->ws + WS_STAMP))[n + 1] = wall_clock64(); } } while (0)
#if MK_REP == 90
#define MK_PROBE_DOWN_NOSTORE 1
#endif
    MEGA_PH(0); MEGA_PH(1); MEGA_PH(2); MEGA_PH(3); MEGA_PH(4); MEGA_PH(5); MEGA_PH(6); MEGA_PH(7); MEGA_PH(8); MEGA_PH(9); MEGA_PH(10);
#if MK_REP == 100
    { KargPtr kp = kp0; asm volatile("" : "+s"(kp)); Params p{}; p.ws = kp->ws; probe_copy(p); xcd_barrier(bar); }
#endif
#undef MEGA_PH
    mega_phase<11>(kp0, lds);
#if MK_STAMP >= 0
    xcd_barrier(bar);
    if (blockIdx.x == 0 && threadIdx.x == 0) {
        KargPtr kq = kp0; asm volatile("" : "+s"(kq));
        unsigned long long* st = (unsigned long long*)(kq->ws + WS_STAMP);
        st[12] = wall_clock64();
        const int k = MK_STAMP < 100 ? MK_STAMP : MK_STAMP - 100;
        const unsigned long long t0 = (MK_STAMP < 100) ? st[k] : st[0], t1 = (MK_STAMP < 100) ? st[k + 1] : st[k + 1];
        kq->out[0] += 2.0f + (float)(t1 - t0) * (MK_STAMP < 100 ? 0.0005f : 0.0001f);
    }
#endif
}
#endif

template <int PH> static void launch_phase(const Params& p, int grid, hipStream_t stream) {
    static bool init = false;
    if (!init) { (void)hipFuncSetAttribute((const void*)k_phase<PH>, hipFuncAttributeMaxDynamicSharedMemorySize, LDS_BYTES); init = true; }
    hipLaunchKernelGGL(k_phase<PH>, dim3(grid), dim3(512), LDS_BYTES, stream, p);
}

extern "C" void kernel_launch(void* const* d_in, const int* in_sizes, int n_in, void* d_out, int out_size, void* d_ws, size_t ws_size, hipStream_t stream) {
    (void)in_sizes; (void)n_in; (void)out_size;
    static int grid = 0;
    if (!grid) {
        int dev = 0, cus = 0; (void)hipGetDevice(&dev); (void)hipDeviceGetAttribute(&cus, hipDeviceAttributeMultiprocessorCount, dev);
        if (cus <= 0) cus = 256;
#if MK_FUSED
        (void)hipFuncSetAttribute((const void*)k_mega, hipFuncAttributeMaxDynamicSharedMemorySize, LDS_BYTES);
        int per_cu = 0;
        if (hipOccupancyMaxActiveBlocksPerMultiprocessor(&per_cu, (const void*)k_mega, 512, LDS_BYTES) != hipSuccess || per_cu < 1)
            fprintf(stderr, "kernel_launch: occupancy query reports %d workgroups per CU\n", per_cu);
#endif
        grid = cus;
        if (ws_size < WS_TOTAL) fprintf(stderr, "kernel_launch: workspace too small: %zu < %zu\n", ws_size, (size_t)WS_TOTAL);
    }
    Params p{};
    p.x = (const float*)d_in[0]; p.c = (const float*)d_in[1]; p.pos = (const int*)d_in[2];
    p.w_ada = (const float*)d_in[3]; p.b_ada = (const float*)d_in[4];
    p.g_pre_mix = (const float*)d_in[5]; p.g_post_mix = (const float*)d_in[6]; p.g_pre_ffn = (const float*)d_in[7]; p.g_post_ffn = (const float*)d_in[8];
    p.w_in = (const float*)d_in[9]; p.w_dil_out = (const float*)d_in[10]; p.w_sb_out = (const float*)d_in[11]; p.w_mix_out = (const float*)d_in[12];
    p.w_router = (const float*)d_in[13]; p.router_bias = (const float*)d_in[14];
    p.w_gate_e = (const float*)d_in[15]; p.w_up_e = (const float*)d_in[16]; p.w_down_e = (const float*)d_in[17];
    p.w_gate_s = (const float*)d_in[18]; p.w_up_s = (const float*)d_in[19]; p.w_down_s = (const float*)d_in[20];
    p.out = (float*)d_out; p.ws = (unsigned char*)d_ws;
    (void)hipMemsetAsync((unsigned char*)d_ws + WS_BAR, 0, WS_ZERO_BYTES, stream);
#if MK_FUSED
    hipLaunchKernelGGL(k_mega, dim3(grid), dim3(512), LDS_BYTES, stream, p);
#else
    launch_phase<0>(p, grid, stream); launch_phase<1>(p, grid, stream); launch_phase<2>(p, grid, stream); launch_phase<3>(p, grid, stream);
    launch_phase<4>(p, grid, stream); launch_phase<5>(p, grid, stream); launch_phase<6>(p, grid, stream); launch_phase<7>(p, grid, stream);
    launch_phase<8>(p, grid, stream); launch_phase<9>(p, grid, stream); launch_phase<10>(p, grid, stream); launch_phase<11>(p, grid, stream);
#endif
}
```

```cpp
#include <hip/hip_runtime.h>
#include <stdint.h>
#include <stdio.h>

#ifndef MK_FUSED
#define MK_FUSED 1
#endif
#ifndef MK_STAMP
#define MK_STAMP -1
#endif
#ifndef MK_REP
#define MK_REP -1
#endif

#define LAS __attribute__((address_space(3)))
#define DI __device__ __forceinline__
typedef unsigned short bf16_t;
typedef short bf16x8 __attribute__((ext_vector_type(8)));
typedef short s16x4 __attribute__((ext_vector_type(4)));
typedef float f32x2 __attribute__((ext_vector_type(2)));
typedef float f32x4 __attribute__((ext_vector_type(4)));
typedef float f32x16 __attribute__((ext_vector_type(16)));
typedef unsigned u32x2 __attribute__((ext_vector_type(2)));
typedef unsigned u32x4 __attribute__((ext_vector_type(4)));
typedef __bf16 bf16x2_t __attribute__((ext_vector_type(2)));
typedef const __attribute__((address_space(1))) char* gcptr;
typedef const __attribute__((address_space(1))) u32x4* gu4ptr;
typedef int i32x8 __attribute__((ext_vector_type(8)));
typedef short s16x16 __attribute__((ext_vector_type(16)));

constexpr int NBATCH = 4, SEQ = 4096, NTOK = NBATCH * SEQ, DM = 2048, DIN = 11776;
constexpr int COL_QA = 0, COL_KA = 1536, COL_VA = 3072, COL_QS = 4608, COL_KS = 5632, COL_VS = 6656, COL_GD = 7680, COL_GS = 9728;
constexpr int NE = 64, DE = 512, NEX = 65;
constexpr int LIST_CAP = 16384;
constexpr int YB_SLOTS = 163840;
constexpr float RMS_EPS = 1e-6f;
constexpr float QSCALE = 0.08838834764831845f * 1.4426950408889634f;
constexpr float LN2 = 0.6931471805599453f;
constexpr float W8_SCALE = 64.0f;
constexpr int W8_MX = 0x79797979, A8_MX = 0x7f7f7f7f;

constexpr size_t MiB = 1ull << 20;
constexpr size_t WS_BAR = 0;
constexpr size_t WS_CNT = 16384;
constexpr int CNT_STRIDE = 1;
constexpr size_t WS_ZERO_BYTES = 32768;
constexpr size_t WS_STAMP = 32768;

constexpr size_t WS_MOD = 65536;
constexpr size_t WS_LSE = 262144;
constexpr size_t WS_ROPE = 1 * MiB;
constexpr size_t WS_LIST = 3 * MiB;
constexpr size_t WS_LISTW = 7 * MiB;
constexpr size_t WS_SLOT = 262144;
constexpr size_t WS_WD = 11 * MiB;
constexpr size_t WS_WTIN8 = 76 * MiB;
constexpr size_t WS_X1 = 76 * MiB;
constexpr size_t WS_H8 = 100 * MiB;
constexpr size_t WS_H = 141 * MiB;
constexpr size_t WS_HID = 205 * MiB;
constexpr size_t WS_WTIN = 205 * MiB;
constexpr size_t WS_TMP = 205 * MiB;
constexpr size_t WS_OG = 251 * MiB;
constexpr size_t WS_OSB = 299 * MiB;
constexpr size_t WS_ODIL = 331 * MiB;
constexpr size_t WS_WTDIL = 347 * MiB;
constexpr size_t WS_WTSB = 349 * MiB;
constexpr size_t WS_WTMIX = 353 * MiB;
constexpr size_t WS_PROJ = 365 * MiB;
constexpr size_t WS_Y = 365 * MiB;
constexpr size_t WS_YB9 = 365 * MiB;
constexpr size_t WS_WGU = 733 * MiB;
constexpr size_t WS_WRT = 1005 * MiB;
constexpr size_t WS_TOTAL = 1006 * MiB;

#ifndef MOE_BAUX
#define MOE_BAUX 0
#endif
#ifndef GEMM_SPLIT
#define GEMM_SPLIT false
#endif
constexpr int LDS_BYTES = 163840;

struct Params {
    const float *x, *c; const int* pos;
    const float *w_ada, *b_ada, *g_pre_mix, *g_post_mix, *g_pre_ffn, *g_post_ffn;
    const float *w_in, *w_dil_out, *w_sb_out, *w_mix_out, *w_router, *router_bias;
    const float *w_gate_e, *w_up_e, *w_down_e, *w_gate_s, *w_up_s, *w_down_s;
    float* out; unsigned char* ws;
};

DI unsigned pk_bf16(float lo, float hi) { f32x2 v = {lo, hi}; bf16x2_t r = __builtin_convertvector(v, bf16x2_t); return __builtin_bit_cast(unsigned, r); }
DI unsigned pk_fp8x4(float a, float b, float c, float d) { int p = __builtin_amdgcn_cvt_pk_fp8_f32(a, b, 0, false); p = __builtin_amdgcn_cvt_pk_fp8_f32(c, d, p, true); return (unsigned)p; }
DI float bf_lo(unsigned u) { return __uint_as_float(u << 16); }
DI float bf_hi(unsigned u) { return __uint_as_float(u & 0xffff0000u); }
template <int CTRL> DI float dpp_mov(float v) { return __uint_as_float((unsigned)__builtin_amdgcn_update_dpp(0, (int)__float_as_uint(v), CTRL, 0xf, 0xf, true)); }
DI float wave_sum(float v) {
    v += dpp_mov<0xB1>(v); v += dpp_mov<0x4E>(v); v += dpp_mov<0x141>(v); v += dpp_mov<0x140>(v);
    { const unsigned t = __float_as_uint(v); auto sw = __builtin_amdgcn_permlane16_swap(t, t, false, false); v = __uint_as_float(sw[0]) + __uint_as_float(sw[1]); }
    { const unsigned t = __float_as_uint(v); auto sw = __builtin_amdgcn_permlane32_swap(t, t, false, false); v = __uint_as_float(sw[0]) + __uint_as_float(sw[1]); }
    return v;
}
DI float wave_max(float v) {
    v = fmaxf(v, dpp_mov<0xB1>(v)); v = fmaxf(v, dpp_mov<0x4E>(v)); v = fmaxf(v, dpp_mov<0x141>(v)); v = fmaxf(v, dpp_mov<0x140>(v));
    { const unsigned t = __float_as_uint(v); auto sw = __builtin_amdgcn_permlane16_swap(t, t, false, false); v = fmaxf(__uint_as_float(sw[0]), __uint_as_float(sw[1])); }
    { const unsigned t = __float_as_uint(v); auto sw = __builtin_amdgcn_permlane32_swap(t, t, false, false); v = fmaxf(__uint_as_float(sw[0]), __uint_as_float(sw[1])); }
    return v;
}
DI float grp8_max(float v) { v = fmaxf(v, dpp_mov<0xB1>(v)); v = fmaxf(v, dpp_mov<0x4E>(v)); v = fmaxf(v, dpp_mov<0x141>(v)); return v; }
DI float lane_xor32(float v, int lane) { const unsigned t = __float_as_uint(v); auto sw = __builtin_amdgcn_permlane32_swap(t, t, false, false); return __uint_as_float(lane < 32 ? sw[1] : sw[0]); }
DI float sigmoidf_(float x) { return __builtin_amdgcn_rcpf(1.0f + __expf(-x)); }

#define XB_TMO      128
#define XB_XCNT(j)  (256  + 64 * (j))
#define XB_XSUB(j)  (1280 + 64 * (j))
#define XB_XGEN(j)  (2304 + 64 * (j))
#define XB_TOP      3328
#define XB_TOPGEN   3392
#define XCD_BAR_WORDS 3456
#define XB_SPIN_CAP (1u << 18)

__device__ __forceinline__ unsigned xb_ld(unsigned* p)              { return __hip_atomic_load(p, __ATOMIC_RELAXED, __HIP_MEMORY_SCOPE_AGENT); }
__device__ __forceinline__ unsigned xb_add(unsigned* p, unsigned v) { return __hip_atomic_fetch_add(p, v, __ATOMIC_RELAXED, __HIP_MEMORY_SCOPE_AGENT); }
__device__ __forceinline__ unsigned xb_xcc_id() { return (unsigned)__builtin_amdgcn_s_getreg((3 << 11) | 20) & 0xFu; }
#define XB_SPIN(cond, bar) do { unsigned _sp = 0; while (cond) { __builtin_amdgcn_s_sleep(1); \
    if ((++_sp & 255u) == 0u) { if (xb_ld(&(bar)[XB_TMO])) break; if (_sp > XB_SPIN_CAP) { atomicAdd(&(bar)[XB_TMO], 1u); break; } } } } while (0)

struct XcdBarrier { unsigned* bar; unsigned x; volatile LAS unsigned* st; };

__device__ __forceinline__ XcdBarrier xcd_barrier_post(unsigned* bar, volatile LAS unsigned* st) {
    XcdBarrier b; b.bar = bar; b.x = xb_xcc_id(); b.st = st;
    if (threadIdx.x == 0) (void)xb_add(&bar[XB_XCNT(b.x)], 1u);
    return b;
}
__device__ __forceinline__ void xcd_barrier_complete(unsigned* bar, unsigned x, unsigned& nloc, unsigned& nx) {
    const unsigned G = gridDim.x * gridDim.y * gridDim.z;
    unsigned sum, cnt, mine, sp = 0u;
    for (;;) {
        sum = 0u; cnt = 0u; mine = 0u;
#pragma unroll
        for (unsigned j = 0; j < 16; ++j) { const unsigned c = xb_ld(&bar[XB_XCNT(j)]); sum += c; cnt += (c > 0u) ? 1u : 0u; mine = (j == x) ? c : mine; }
        if (sum == G) break;
        __builtin_amdgcn_s_sleep(1);
        if ((++sp & 255u) == 0u) { if (xb_ld(&bar[XB_TMO])) break; if (sp > XB_SPIN_CAP) { atomicAdd(&bar[XB_TMO], 1u); break; } }
    }
    nloc = mine > 0u ? mine : 1u; nx = cnt > 0u ? cnt : 1u;
}
__device__ __forceinline__ void xcd_barrier(const XcdBarrier& b) {
    asm volatile("s_waitcnt vmcnt(0)" ::: "memory");
    __syncthreads();
    if (threadIdx.x == 0) {
        unsigned* bar = b.bar;
        __builtin_amdgcn_s_waitcnt(0);
        unsigned nloc = b.st[0], nx = b.st[1];
        if (nloc == 0u) { xcd_barrier_complete(bar, b.x, nloc, nx); b.st[0] = nloc; b.st[1] = nx; }
        const unsigned old = xb_add(&bar[XB_XSUB(b.x)], 1u);
        const unsigned gen = old / nloc;
        if (old + 1u == (gen + 1u) * nloc) {
            __builtin_amdgcn_fence(__ATOMIC_RELEASE, "agent");
            asm volatile("s_waitcnt vmcnt(0)" ::: "memory");
            const unsigned og = xb_add(&bar[XB_TOP], 1u);
            const unsigned tg = og / nx;
            if (og + 1u == (tg + 1u) * nx) xb_add(&bar[XB_TOPGEN], 1u);
            else XB_SPIN(xb_ld(&bar[XB_TOPGEN]) == tg, bar);
            __builtin_amdgcn_fence(__ATOMIC_ACQUIRE, "agent");
            xb_add(&bar[XB_XGEN(b.x)], 1u);
            asm volatile("s_waitcnt vmcnt(0)" ::: "memory");
        } else {
            XB_SPIN(xb_ld(&bar[XB_XGEN(b.x)]) == gen, bar);
            __builtin_amdgcn_fence(__ATOMIC_ACQUIRE, "agent");
            asm volatile("s_waitcnt vmcnt(0)" ::: "memory");
        }
    }
    __syncthreads();
}

struct CvtMat { const float* src; bf16_t* dst; int K, N, nb, mode; size_t sstride, dstride; };
constexpr int CVT_NMAT = 10;
constexpr int CVT_TILES[CVT_NMAT] = {2944, 128, 256, 512, 8192, 8192, 8192, 128, 128, 128};
constexpr int CVT_TOTAL = 2944 + 128 + 256 + 512 + 8192 * 3 + 128 * 3;

DI CvtMat cvt_mat(const Params& p, int m) {
    bf16_t* wtin = (bf16_t*)(p.ws + WS_WTIN); bf16_t* wtdil = (bf16_t*)(p.ws + WS_WTDIL); bf16_t* wtsb = (bf16_t*)(p.ws + WS_WTSB); bf16_t* wtmix = (bf16_t*)(p.ws + WS_WTMIX);
    bf16_t* wgu = (bf16_t*)(p.ws + WS_WGU); bf16_t* wd = (bf16_t*)(p.ws + WS_WD);
    CvtMat r;
    switch (m) {
        case 0: r = {p.w_in, wtin, 2048, 11776, 1, 0, 0, 0}; break;
        case 1: r = {p.w_dil_out, wtdil, 512, 2048, 1, 0, 0, 0}; break;
        case 2: r = {p.w_sb_out, wtsb, 1024, 2048, 1, 0, 0, 0}; break;
        case 3: r = {p.w_mix_out, wtmix, 2048, 2048, 1, 0, 0, 0}; break;
        case 4: r = {p.w_gate_e, wgu, 2048, 512, 64, 1, (size_t)2048 * 512, (size_t)1024 * 2048}; break;
        case 5: r = {p.w_up_e, wgu, 2048, 512, 64, 2, (size_t)2048 * 512, (size_t)1024 * 2048}; break;
        case 6: r = {p.w_down_e, wd, 512, 2048, 64, 0, (size_t)512 * 2048, (size_t)2048 * 512}; break;
        case 7: r = {p.w_gate_s, (bf16_t*)((unsigned char*)wgu + (size_t)64 * 1024 * 2048), 2048, 512, 1, 1, 0, 0}; break;
        case 8: r = {p.w_up_s, (bf16_t*)((unsigned char*)wgu + (size_t)64 * 1024 * 2048), 2048, 512, 1, 2, 0, 0}; break;
        default: r = {p.w_down_s, (bf16_t*)((unsigned char*)wd + (size_t)64 * 2048 * 512), 512, 2048, 1, 0, 0, 0}; break;
    }
    return r;
}

struct CvtTile { const float* src; unsigned char* dst; int N, K, kt, nt, mode, f8; };
DI CvtTile cvt_desc(const Params& p, int t) {
    int m = 0;
#pragma unroll
    for (int i = 0; i < CVT_NMAT - 1; ++i) { if (t >= CVT_TILES[i] && m == i) { t -= CVT_TILES[i]; m = i + 1; } }
    const CvtMat M = cvt_mat(p, m);
    int b, kt, nt;
    if (m == 0) { kt = t / 184; nt = t - kt * 184; b = 0; }
    else {
        const int ln = (M.N == 2048) ? 5 : 3, lk = (M.K == 512) ? 2 : (M.K == 1024 ? 3 : 4);
        nt = t & ((1 << ln) - 1); kt = (t >> ln) & ((1 << lk) - 1); b = t >> (ln + lk);
    }
    const bool in8 = (m == 0);
    CvtTile d; d.src = M.src + (size_t)b * M.sstride + (size_t)(kt * 128) * M.N + nt * 64; d.N = M.N; d.K = M.K; d.kt = kt; d.nt = nt; d.mode = M.mode;
    d.f8 = (m >= 3 || in8) ? 1 : 0;
    d.dst = in8 ? (unsigned char*)(p.ws + WS_WTIN8) : (m >= 4 ? (unsigned char*)M.dst + (size_t)b * M.dstride : (unsigned char*)(M.dst + (size_t)b * M.dstride));
    return d;
}
typedef const __attribute__((address_space(1))) f32x4* gf4ptr_t;
DI void cvtw_load(const CvtTile& d, int half, f32x4 (&v)[16]) {
    const int lane = threadIdx.x & 63, kq = lane >> 3, nq = lane & 7;
    gcptr sb = (gcptr)(d.src + half * 32);
    asm volatile("" : "+s"(sb));
    const unsigned rowb = (unsigned)d.N * 4u;
    unsigned off = (unsigned)(kq * 16) * rowb + (unsigned)(nq * 16);
#pragma unroll
    for (int i = 0; i < 16; ++i) { v[i] = __builtin_nontemporal_load((gf4ptr_t)(sb + off)); off += rowb; }
}
DI void cvtw_finish(const CvtTile& d, int half, const f32x4 (&vin)[16], bool valid) {
    f32x4 v[16];
#pragma unroll
    for (int i = 0; i < 16; ++i) v[i] = vin[i];
    asm volatile("" : "+v"(v[0]), "+v"(v[1]), "+v"(v[2]), "+v"(v[3]), "+v"(v[4]), "+v"(v[5]), "+v"(v[6]), "+v"(v[7]));
    asm volatile("" : "+v"(v[8]), "+v"(v[9]), "+v"(v[10]), "+v"(v[11]), "+v"(v[12]), "+v"(v[13]), "+v"(v[14]), "+v"(v[15]));
    if (!valid) return;
    const int lane = threadIdx.x & 63, kq = lane >> 3, nq = lane & 7;
#pragma unroll
    for (int j = 0; j < 4; ++j) {
        const int c = d.nt * 64 + half * 32 + nq * 4 + j;
        const int drow = d.mode == 0 ? c : (((c >> 7) << 8) + (c & 127) + (d.mode == 2 ? 128 : 0));
        if (d.f8) {
            u32x4 w;
#pragma unroll
            for (int m = 0; m < 4; ++m) w[m] = pk_fp8x4(v[4 * m][j] * W8_SCALE, v[4 * m + 1][j] * W8_SCALE, v[4 * m + 2][j] * W8_SCALE, v[4 * m + 3][j] * W8_SCALE);
            __builtin_nontemporal_store(w, (u32x4*)(d.dst + (size_t)drow * d.K + d.kt * 128 + kq * 16));
        } else {
            u32x4 w0, w1;
#pragma unroll
            for (int m = 0; m < 4; ++m) { w0[m] = pk_bf16(v[2 * m][j], v[2 * m + 1][j]); w1[m] = pk_bf16(v[8 + 2 * m][j], v[8 + 2 * m + 1][j]); }
            u32x4* o = (u32x4*)((bf16_t*)d.dst + (size_t)drow * d.K + d.kt * 128 + kq * 16);
            o[0] = w0; o[1] = w1;
        }
    }
}

constexpr int P0_UNITS = 256, MOD_COLS = 12288 / P0_UNITS;
DI void mod_unit(const Params& p, int u, LAS unsigned char* lds) {
    const int tid = threadIdx.x, c0 = u * MOD_COLS;
    LAS float* sc = (LAS float*)lds;
    LAS float* red = (LAS float*)(lds + 32768);
    for (int i = tid; i < 4 * 2048; i += 512) { const float v = p.c[i]; sc[i] = v / (1.0f + __expf(-v)); }
    __syncthreads();
    const int kq = tid >> 4, cq = tid & 15;
    const bool act = cq < MOD_COLS / 4;
    float acc[4][4];
#pragma unroll
    for (int b = 0; b < 4; ++b)
#pragma unroll
        for (int j = 0; j < 4; ++j) acc[b][j] = 0.f;
#pragma unroll 1
    for (int it0 = 0; it0 < 64; it0 += 8) {
        f32x4 w[8];
#pragma unroll
        for (int i = 0; i < 8; ++i) w[i] = act ? __builtin_nontemporal_load((const f32x4*)(p.w_ada + (size_t)(kq + 32 * (it0 + i)) * 12288 + c0 + 4 * cq)) : (f32x4){0.f, 0.f, 0.f, 0.f};
#pragma unroll
        for (int i = 0; i < 8; ++i) {
            const int k = kq + 32 * (it0 + i);
#pragma unroll
            for (int b = 0; b < 4; ++b) { const float s = sc[b * 2048 + k];
#pragma unroll
                for (int j = 0; j < 4; ++j) acc[b][j] += s * w[i][j]; }
        }
    }
#pragma unroll
    for (int b = 0; b < 4; ++b)
#pragma unroll
        for (int j = 0; j < 4; ++j) red[(kq * 4 + b) * 64 + 4 * cq + j] = acc[b][j];
    __syncthreads();
    if (tid < 256) {
        const int b = tid >> 6, col = tid & 63;
        if (col < MOD_COLS) {
            float s = 0.f;
            for (int q = 0; q < 32; ++q) s += red[(q * 4 + b) * 64 + col];
            float* mod = (float*)(p.ws + WS_MOD);
            mod[b * 12288 + c0 + col] = s + p.b_ada[c0 + col];
        }
    }
    __syncthreads();
}

DI void rope_unit(const Params& p, int u) {
    float2* rope = (float2*)(p.ws + WS_ROPE);
    for (int e = threadIdx.x; e < 1024; e += 512) {
        const int tok = u * 64 + (e >> 4), i = e & 15;
        const float invf = (float)pow(500000.0, -(double)i / 16.0);
        const float ang = (float)p.pos[tok] * invf;
        rope[tok * 16 + i] = make_float2(cosf(ang), sinf(ang));
    }
}

DI void wr_unit(const Params& p, int u) {
    bf16_t* hi = (bf16_t*)(p.ws + WS_WRT);
    const int idx = u * 512 + threadIdx.x, k = idx >> 6, e = idx & 63;
    hi[e * 2048 + k] = (bf16_t)(pk_bf16(p.w_router[idx], 0.f) & 0xffffu);
}
DI void cvtw_range2(const Params& p, int a0, int aend, int NA, int b0, int bend, int NB) {
    const int na = max(0, (aend - a0 + NA - 1) / NA), nb = max(0, (bend - b0 + NB - 1) / NB), n = na + nb;
    if (n > 0) {
        CvtTile d0, d1; f32x4 v0[16], v1[16]; int h0, h1;
#define CVTW_LOAD(D, H, V, J) { const int j_ = min((J), n - 1); const int wt_ = j_ < na ? a0 + j_ * NA : b0 + (j_ - na) * NB; D = cvt_desc(p, wt_ >> 1); H = wt_ & 1; cvtw_load(D, H, V); asm volatile("" ::: "memory"); }
        CVTW_LOAD(d0, h0, v0, 0);
#pragma unroll 1
        for (int j = 0; j < n; j += 2) {
            CVTW_LOAD(d1, h1, v1, j + 1); cvtw_finish(d0, h0, v0, true);
            CVTW_LOAD(d0, h0, v0, j + 2); cvtw_finish(d1, h1, v1, j + 1 < n);
        }
#undef CVTW_LOAD
    }
}
DI void cvtw_range(const Params& p, int w0, int wend, int NW) { cvtw_range2(p, w0, wend, NW, 0, 0, 1); }
constexpr int INPROJ_UNITS = 64 * 46, BG_PER_WAVE = 6, WIN_END = 2 * 2944, CONV_SHARE = 44000;
DI int nconv(int G) { return (G % 32 == 0) ? 7 * (G / 32) : 0; }
DI int gemm_blocks(int G) { return G - nconv(G); }
DI int bg_blocks(int G) { const int Gg = gemm_blocks(G), rem = INPROJ_UNITS % Gg; return rem == 0 ? 0 : Gg - rem; }
DI int bg_first(int G) { return 2 * CVT_TOTAL - bg_blocks(G) * 8 * BG_PER_WAVE; }
constexpr int DOWN_FIRST = 2 * (2944 + 128 + 256 + 512 + 8192 + 8192);
DI int p0_end(int G) { return min(DOWN_FIRST, bg_first(G)); }
DI int conv_end(int G) { return nconv(G) ? min(WIN_END + CONV_SHARE, bg_first(G)) : WIN_END; }
DI void phase_prologue(const Params& p, LAS unsigned char* lds) {
    for (int u = blockIdx.x; u < P0_UNITS; u += gridDim.x) { wr_unit(p, u); rope_unit(p, u); mod_unit(p, u, lds); }
    const int wid = __builtin_amdgcn_readfirstlane(threadIdx.x >> 6);
    { const int G = (int)gridDim.x, w0 = (int)blockIdx.x * 8 + wid; cvtw_range2(p, w0, WIN_END, G * 8, conv_end(G) + w0, p0_end(G), G * 8); }
    __syncthreads();
}

DI void phase_prenorm(const Params& p) {
    const int lane = threadIdx.x & 63, wid = __builtin_amdgcn_readfirstlane(threadIdx.x >> 6);
    const float* mod = (const float*)(p.ws + WS_MOD);
    const int nw = (int)gridDim.x * 8, per = (NTOK + nw - 1) / nw;
    const int t0 = ((int)blockIdx.x * 8 + wid) * per, t1 = min(NTOK, t0 + per);
    f32x4 tg[8], ts[8]; int cb = -1;
#pragma unroll 1
    for (int tok = t0; tok < t1; tok += 2) {
        const int b = tok >> 12;
        if (b != cb) {
            cb = b;
#pragma unroll
            for (int i = 0; i < 8; ++i) {
                const int ch = 4 * (lane + 64 * i);
                const f32x4 g = *(const f32x4*)(p.g_pre_mix + ch), sc = *(const f32x4*)(mod + b * 12288 + 2048 + ch);
                ts[i] = *(const f32x4*)(mod + b * 12288 + ch);
#pragma unroll
                for (int j = 0; j < 4; ++j) tg[i][j] = g[j] * (1.0f + sc[j]);
            }
        }
        const bool two = tok + 1 < t1 && ((tok + 1) >> 12) == b;
        const float* xr0 = p.x + (size_t)tok * DM; const float* xr1 = p.x + (size_t)(two ? tok + 1 : tok) * DM;
        f32x4 v0[8], v1[8];
#pragma unroll
        for (int i = 0; i < 8; ++i) v0[i] = __builtin_nontemporal_load((const f32x4*)(xr0 + 4 * (lane + 64 * i)));
#pragma unroll
        for (int i = 0; i < 8; ++i) v1[i] = __builtin_nontemporal_load((const f32x4*)(xr1 + 4 * (lane + 64 * i)));
        asm volatile("" ::: "memory");
        auto fin = [&](int tk, f32x4 (&v)[8]) {
            float ss = 0.f;
#pragma unroll
            for (int i = 0; i < 8; ++i) ss += v[i][0] * v[i][0] + v[i][1] * v[i][1] + v[i][2] * v[i][2] + v[i][3] * v[i][3];
            ss = wave_sum(ss);
            const float rstd = rsqrtf(ss * (1.0f / DM) + RMS_EPS);
#pragma unroll
            for (int i = 0; i < 8; ++i) {
                const int ch = 4 * (lane + 64 * i);
                f32x4 o;
#pragma unroll
                for (int j = 0; j < 4; ++j) o[j] = v[i][j] * rstd * tg[i][j] + ts[i][j];
                *(unsigned*)(p.ws + WS_H8 + (size_t)tk * DM + ch) = pk_fp8x4(o[0], o[1], o[2], o[3]);
            }
        };
        fin(tok, v0);
        if (two) fin(tok + 1, v1); else --tok;
    }
}

namespace g8 {
constexpr int BM = 256, BK = 64, HALF = 128, HTB = HALF * BK * 2, STAGE_BYTES = 8 * HTB, NXCD = 8, WGM = 8;
DI int lds_byte(int r, int c) { const int st = (r >> 4) * 2 + (c >> 5), rr = r & 15, cc = c & 31, ob = rr * 64 + cc * 2; return st * 1024 + (ob ^ (((ob >> 9) & 1) << 5)); }
DI void stage_rc(int b, int& R, int& C) { const int st = b / 1024, sb = b % 1024, swz = sb ^ (((sb >> 9) & 1) << 5); R = (st >> 1) * 16 + swz / 64; C = (st & 1) * 32 + (swz % 64) / 2; }
DI int perm32(int rho) { const int n = rho >> 4, i = rho & 15; return 8 * (i >> 2) + 4 * n + (i & 3); }

struct Unit {
    const char* A; const char* B;
    int row0;
    int lda, ldb, nt;
    int pm, pn, aux, keep;
    int e, nvalid, par;
};

DI bool static_tile(int L, int nM, int nN, int& pm, int& pn) {
    const int nwg = nM * nN; if (L >= nwg) return false;
    int wgid = L; { const int q = nwg / NXCD, r = nwg % NXCD, xcd = wgid % NXCD, off = wgid / NXCD; wgid = (xcd < r ? xcd * (q + 1) : r * (q + 1) + (xcd - r) * q) + off; }
    const int nig = WGM * nN, gid = wgid / nig, fm = gid * WGM, gsz = (nM - fm) < WGM ? (nM - fm) : WGM;
    pm = fm + ((wgid % nig) % gsz); pn = (wgid % nig) / gsz; return true;
}

constexpr int EXCH_OFF = STAGE_BYTES + 8192;
DI void epi_bar() { asm volatile("s_waitcnt lgkmcnt(0)" ::: "memory"); __builtin_amdgcn_s_barrier(); asm volatile("" ::: "memory"); }

template <int NCH, int BAUX, bool SPLIT, bool FP8, class Sched, class Epi>
DI void gemm_phase(LAS unsigned char* lds, const Sched& S, const Epi& E) {
    const int tid = threadIdx.x, wid = __builtin_amdgcn_readfirstlane(tid >> 6), lane = tid & 63, wr = wid >> 2, wc = wid & 3, fr = lane & 15, fq = lane >> 4;
    const bool loader = SPLIT ? (wr == 0) : true, storer = SPLIT ? (wr == 1) : true;
    constexpr int NP = SPLIT ? 4 : 2, PSTEP = SPLIT ? 4 : 8, RSTEP = SPLIT ? 32 : 64;
    const int p0 = SPLIT ? wc : wid;
    int R0, C0; stage_rc(p0 * 1024 + lane * 16, R0, C0);
    const int sC = C0 * 2, sRb = (R0 & ~31) + perm32(R0 & 31);
    const int aoff = lds_byte(wr * 64 + fr, fq * 8), boff = lds_byte(wc * 32 + fr, fq * 8);
#define G8_SA(b, h) (((b) * 2 + (h)) * HTB)
#define G8_SB(b, h) ((4 + (b) * 2 + (h)) * HTB)
#define G8_STAGE_A(bufoff, gbase, voff) do { if (loader) { _Pragma("unroll") for (int _i = 0; _i < NP; ++_i) \
        __builtin_amdgcn_global_load_lds((const unsigned*)((const char*)(gbase) + (voff)[_i]), (LAS unsigned*)(lds + (bufoff) + (p0 + PSTEP * _i) * 1024), 16, 0, 0); } } while (0)
#define G8_STAGE_B(bufoff, gbase, voff, ldb32) do { if (loader) { _Pragma("unroll") for (int _i = 0; _i < NP; ++_i) { \
        const char* _gb = (const char*)(gbase) + (size_t)_i * (ldb32); asm volatile("" : "+s"(_gb));     \
        __builtin_amdgcn_global_load_lds((const unsigned*)(_gb + (voff)), (LAS unsigned*)(lds + (bufoff) + (p0 + PSTEP * _i) * 1024), 16, 0, BAUX); } } } while (0)
#define G8_LDA(dst, b, h) do { _Pragma("unroll") for (int m = 0; m < 4; ++m) _Pragma("unroll") for (int k = 0; k < 2; ++k) dst[m][k] = *(const LAS bf16x8*)(lds + G8_SA(b, h) + aoff + m * 2048 + k * 1024); } while (0)
#define G8_LDB(dst, b, h) do { _Pragma("unroll") for (int n = 0; n < 2; ++n) _Pragma("unroll") for (int k = 0; k < 2; ++k) dst[n][k] = *(const LAS bf16x8*)(lds + G8_SB(b, h) + boff + n * 2048 + k * 1024); } while (0)
#define G8_MMA(ai, bj, At, Bt) do { __builtin_amdgcn_s_setprio(1); _Pragma("unroll") for (int m = 0; m < 4; ++m) _Pragma("unroll") for (int n = 0; n < 2; ++n) { \
        if (!FP8) { _Pragma("unroll") for (int k = 0; k < 2; ++k) acc[ai][bj][m][n] = __builtin_amdgcn_mfma_f32_16x16x32_bf16(Bt[n][k], At[m][k], acc[ai][bj][m][n], 0, 0, 0); } \
        else { const i32x8 _w = __builtin_bit_cast(i32x8, __builtin_shufflevector(Bt[n][0], Bt[n][1], 0, 1, 2, 3, 4, 5, 6, 7, 8, 9, 10, 11, 12, 13, 14, 15)); \
               const i32x8 _x = __builtin_bit_cast(i32x8, __builtin_shufflevector(At[m][0], At[m][1], 0, 1, 2, 3, 4, 5, 6, 7, 8, 9, 10, 11, 12, 13, 14, 15)); \
               acc[ai][bj][m][n] = __builtin_amdgcn_mfma_scale_f32_16x16x128_f8f6f4(_w, _x, acc[ai][bj][m][n], 0, 0, 0, W8_MX, 0, A8_MX); } } \
        __builtin_amdgcn_s_setprio(0); } while (0)
#define G8_WAIT_V8 do { if (SPLIT) { if (loader) asm volatile("s_waitcnt vmcnt(8)" ::: "memory"); } else asm volatile("s_waitcnt vmcnt(4)" ::: "memory"); } while (0)
#define G8_WAIT_V12 do { if (SPLIT) { if (loader) asm volatile("s_waitcnt vmcnt(12)" ::: "memory"); } else asm volatile("s_waitcnt vmcnt(6)" ::: "memory"); } while (0)
#define G8_WAIT_V0 do { if (loader) asm volatile("s_waitcnt vmcnt(0)" ::: "memory"); } while (0)
#define G8_WAIT_L(n) asm volatile("s_waitcnt lgkmcnt(" #n ")" ::: "memory")
#define G8_BAR __builtin_amdgcn_s_barrier()
#define G8_SCHED __builtin_amdgcn_sched_barrier(0)
#define G8_OFFS(u, vA, vB) do { if (loader) { _Pragma("unroll") for (int _h = 0; _h < 2; ++_h) _Pragma("unroll") for (int _i = 0; _i < NP; ++_i) \
        vA[_h][_i] = (unsigned)S.arow(u, _h * 128 + R0 + RSTEP * _i) * (unsigned)(u).lda + (unsigned)sC; \
        vB = (unsigned)sRb * (unsigned)(u).ldb + (unsigned)sC; } } while (0)
    Unit cur, nxt; int ui = 0;
    if (!S.next(0, cur)) return;
    f32x4 acc[2][2][4][2];
#pragma unroll
    for (int a = 0; a < 2; ++a)
#pragma unroll
        for (int b = 0; b < 2; ++b)
#pragma unroll
            for (int m = 0; m < 4; ++m)
#pragma unroll
                for (int n = 0; n < 2; ++n) acc[a][b][m][n] = (f32x4){0.f, 0.f, 0.f, 0.f};
    bf16x8 At[4][2], B0[2][2], B1[2][2];
    unsigned vA[2][NP], vB = 0u;
#pragma unroll
    for (int i = 0; i < NP; ++i) { vA[0][i] = 0u; vA[1][i] = 0u; }
    if (S.prefetch(cur, wid, lane)) { G8_WAIT_V0; G8_BAR; }
    G8_OFFS(cur, vA, vB);
    const char* cA = cur.A; const char* cB = cur.B; size_t hB = (size_t)128 * cur.ldb; size_t q32 = (size_t)RSTEP * cur.ldb;
    constexpr size_t kstep = 128;
    G8_STAGE_B(G8_SB(0, 0), cB, vB, q32); G8_STAGE_A(G8_SA(0, 0), cA, vA[0]); G8_STAGE_B(G8_SB(0, 1), cB + hB, vB, q32); G8_STAGE_A(G8_SA(0, 1), cA, vA[1]);
    if (wr == 1) G8_BAR;
    G8_WAIT_V8; G8_BAR;
    G8_STAGE_B(G8_SB(1, 0), cB + kstep, vB, q32); G8_STAGE_A(G8_SA(1, 0), cA + kstep, vA[0]); G8_STAGE_B(G8_SB(1, 1), cB + hB + kstep, vB, q32);
    G8_WAIT_V12; G8_BAR;
    for (;;) {
        bool has_next = false;
        const char* nA = cA; const char* nB = cB; size_t nhB = hB, nq32 = q32;
        const int nt = cur.nt;
#pragma unroll 1
        for (int t = 0; t < nt; t += 2) {
            const bool last = (t == nt - 2);
            const char* a1 = cA + (size_t)(t + 1) * kstep;
            G8_LDB(B0, 0, 0); G8_SCHED; G8_LDA(At, 0, 0); G8_STAGE_A(G8_SA(1, 1), a1, vA[1]);
            G8_WAIT_L(8); G8_BAR; G8_WAIT_L(0); G8_MMA(0, 0, At, B0); G8_BAR; G8_SCHED;
            if (t == 0) { Unit pf; if (S.next(ui + 1, pf)) (void)S.prefetch(pf, wid, lane); }
            const char* a2; const char* b2; size_t h2, q2;
            if (last) {
                has_next = S.next(ui + 1, nxt);
                if (has_next) { G8_OFFS(nxt, vA, vB); nA = nxt.A; nB = nxt.B; nhB = (size_t)128 * nxt.ldb; nq32 = (size_t)RSTEP * nxt.ldb; }
                a2 = nA; b2 = nB; h2 = nhB; q2 = nq32;
            } else { a2 = cA + (size_t)(t + 2) * kstep; b2 = cB + (size_t)(t + 2) * kstep; h2 = hB; q2 = q32; }
            const char* a3 = a2 + kstep; const char* b3 = b2 + kstep;
            G8_LDB(B1, 0, 1); G8_STAGE_B(G8_SB(0, 0), b2, vB, q2);
            G8_BAR; G8_WAIT_L(0); G8_MMA(0, 1, At, B1); G8_BAR;
            G8_LDA(At, 0, 1); G8_STAGE_A(G8_SA(0, 0), a2, vA[0]);
            G8_BAR; G8_WAIT_L(0); G8_MMA(1, 0, At, B0); G8_BAR; G8_SCHED;
            G8_STAGE_B(G8_SB(0, 1), b2 + h2, vB, q2);
            G8_WAIT_V12; G8_BAR; G8_MMA(1, 1, At, B1); G8_BAR;
            G8_LDB(B0, 1, 0); G8_SCHED; G8_LDA(At, 1, 0); G8_STAGE_A(G8_SA(0, 1), a2, vA[1]);
            G8_WAIT_L(8); G8_BAR; G8_WAIT_L(0); G8_MMA(0, 0, At, B0); G8_BAR; G8_SCHED;
            G8_LDB(B1, 1, 1); G8_STAGE_B(G8_SB(1, 0), b3, vB, q2);
            G8_BAR; G8_WAIT_L(0); G8_MMA(0, 1, At, B1); G8_BAR;
            G8_LDA(At, 1, 1); G8_STAGE_A(G8_SA(1, 0), a3, vA[0]);
            G8_BAR; G8_WAIT_L(0); G8_MMA(1, 0, At, B0); G8_BAR; G8_SCHED;
            G8_STAGE_B(G8_SB(1, 1), b3 + h2, vB, q2);
            G8_WAIT_V12; G8_BAR; G8_MMA(1, 1, At, B1); G8_BAR;
        }
        int tz = threadIdx.x; asm volatile("" : "+v"(tz));
        const int lane_e = tz & 63, fr_e = tz & 15, fq_e = (tz >> 4) & 3;
        {
            E.pre(acc, cur, wr, wc, fr_e, fq_e);
            constexpr int PITCH = NCH * 16 + 16;
            LAS unsigned char* ex = lds + EXCH_OFF;
            if (wr == 0) G8_BAR;
            if constexpr (Epi::OUT8) {
                constexpr int RB = NCH * 8, P8 = RB + 16;
#pragma unroll
                for (int ai = 0; ai < 2; ++ai)
#pragma unroll
                    for (int mh = 0; mh < 2; ++mh) {
#pragma unroll
                        for (int mm = 0; mm < 2; ++mm) {
                            u32x2 o8[2];
                            E.row8(acc, cur, ai, 2 * mh + mm, wr, wc, fr_e, fq_e, o8);
                            LAS unsigned char* rp = ex + (mm * 32 + wr * 16 + fr_e) * P8 + wc * 32 + 8 * fq_e;
                            *(LAS u32x2*)rp = o8[0];
                            if (NCH == 32) *(LAS u32x2*)(rp + 128) = o8[1];
                        }
                        epi_bar();
                        {
                            constexpr int CPR = RB / 16, RPI = 64 / CPR;
#pragma unroll
                            for (int i = 0; i < 8 / RPI; ++i) {
                                const int rl = 8 * wid + RPI * i + lane_e / CPR, ch = lane_e % CPR;
                                const int rt = ai * 128 + ((rl >> 4) & 1) * 64 + (2 * mh + (rl >> 5)) * 16 + (rl & 15);
                                const u32x4 d = *(const LAS u32x4*)(ex + rl * P8 + ch * 16);
                                E.store8(cur, rt, ch, d);
                            }
                        }
                        epi_bar();
                    }
            } else
#pragma unroll
            for (int ai = 0; ai < 2; ++ai)
#pragma unroll
                for (int m = 0; m < 4; ++m) {
                    u32x4 o[2];
                    E.row(acc, cur, ai, m, wr, wc, fr_e, fq_e, o);
                    if (NCH == 32) {
                        *(LAS u32x4*)(ex + (wr * 16 + fr_e) * PITCH + (wc * 32 + 8 * fq_e) * 2) = o[0];
                        *(LAS u32x4*)(ex + (wr * 16 + fr_e) * PITCH + (128 + wc * 32 + 8 * fq_e) * 2) = o[1];
                    } else {
                        *(LAS u32x4*)(ex + (wr * 16 + fr_e) * PITCH + (wc * 32 + 8 * fq_e) * 2) = o[0];
                    }
                    epi_bar();
                    if (storer) {
                        constexpr int RPI = 64 / NCH;
                        constexpr int RPW = SPLIT ? 8 : 4;
                        const int rbase = SPLIT ? 8 * wc : 4 * wid;
#pragma unroll
                        for (int i = 0; i < RPW / RPI; ++i) {
                            const int rl = rbase + RPI * i + lane_e / NCH, ch = lane_e % NCH;
                            const int rt = ai * 128 + (rl >> 4) * 64 + m * 16 + (rl & 15);
                            const u32x4 d = *(const LAS u32x4*)(ex + rl * PITCH + ch * 16);
                            E.store(cur, rt, ch, d);
                        }
                    }
                    epi_bar();
                }
            if (wr == 1) G8_BAR;
        }
        if (!has_next) break;
#pragma unroll
        for (int a = 0; a < 2; ++a)
#pragma unroll
            for (int b = 0; b < 2; ++b)
#pragma unroll
                for (int m = 0; m < 4; ++m)
#pragma unroll
                    for (int n = 0; n < 2; ++n) acc[a][b][m][n] = (f32x4){0.f, 0.f, 0.f, 0.f};
        cur = nxt; cA = nA; cB = nB; hB = nhB; q32 = nq32; ++ui;
    }
    G8_WAIT_V0;
    if (wr == 0) G8_BAR;
    G8_BAR;
#undef G8_SA
#undef G8_SB
#undef G8_STAGE_A
#undef G8_STAGE_B
#undef G8_LDA
#undef G8_LDB
#undef G8_MMA
#undef G8_WAIT_V8
#undef G8_WAIT_V12
#undef G8_WAIT_V0
#undef G8_WAIT_L
#undef G8_BAR
#undef G8_SCHED
#undef G8_OFFS
}
}

struct DenseSched {
    const char* A; const char* Bt; int nM, nN, lda, ldb, nt, G, c; int sel = 0;
    DI bool next(int i, g8::Unit& u) const {
        int pm, pn; if (!g8::static_tile(i * G + c, nM, nN, pm, pn)) return false;
        pm = __builtin_amdgcn_readfirstlane(pm); pn = __builtin_amdgcn_readfirstlane(pn);
        if (sel == 2) pn = pn + 30;
        u.A = A; u.B = Bt + (size_t)pn * 256 * ldb; u.row0 = pm * 256; u.lda = lda; u.ldb = ldb; u.nt = nt; u.pm = pm; u.pn = pn; u.aux = 0; u.keep = 0; u.e = 0; u.nvalid = 256; u.par = 0; return true;
    }
    DI int arow(const g8::Unit& u, int rr) const { return u.row0 + rr; }
    DI bool prefetch(const g8::Unit&, int, int) const { return false; }
};
constexpr int MOE_TAB_OFF = g8::STAGE_BYTES;
constexpr int MOE_TILE_OFF = g8::STAGE_BYTES + 1024;
constexpr int MOE_IDX_OFF = g8::STAGE_BYTES + 2048;
struct MoeSched {
    LAS unsigned char* lds; const int* list; const float* listw; const char* A; const char* W; int ncol, mode  , G, c;
    DI bool next(int i, g8::Unit& u) const {
        const LAS int* tpre = (const LAS int*)(lds + MOE_TAB_OFF);
        const int L = i * G + c; const int T = __builtin_amdgcn_readfirstlane(tpre[NEX]);
        if (L >= T * ncol) return false;
        const int gt = __builtin_amdgcn_readfirstlane(L / ncol), pn = L - gt * ncol;
        const int e = __builtin_amdgcn_readfirstlane((int)*(const LAS unsigned char*)(lds + MOE_TILE_OFF + gt));
        const int tile = gt - __builtin_amdgcn_readfirstlane(tpre[e]);
        const int n_e = __builtin_amdgcn_readfirstlane(tpre[NEX + 1 + e]);
        u.e = e; u.pm = tile; u.pn = pn; u.nvalid = min(256, n_e - tile * 256); u.keep = 0; u.aux = gt * 256; u.par = i & 1;
        if (mode == 0) { u.A = A; u.lda = 2048; u.ldb = 2048; u.nt = 16; u.B = W + ((size_t)e * 1024 + (size_t)pn * 256) * 2048; u.row0 = tile * 256; }
        else { u.A = A; u.lda = 512; u.ldb = 512; u.nt = 4; u.B = W + ((size_t)e * 2048 + (size_t)pn * 256) * 512; u.row0 = gt * 256; }
        return true;
    }
    DI bool prefetch(const g8::Unit& u, int wid, int lane) const {
        if (u.e < NE && wid < 4) {
            const int r = min(wid * 64 + lane, u.nvalid - 1);
            const size_t src = (size_t)u.e * LIST_CAP + u.pm * 256 + r;
            __builtin_amdgcn_global_load_lds((const unsigned*)(list + src), (LAS unsigned*)(lds + MOE_IDX_OFF + u.par * 2048 + wid * 256), 4, 0, 0);
            if (mode == 1) __builtin_amdgcn_global_load_lds((const unsigned*)(listw + src), (LAS unsigned*)(lds + MOE_IDX_OFF + u.par * 2048 + 1024 + wid * 256), 4, 0, 0);
        }
        return true;
    }
    DI int arow(const g8::Unit& u, int rr) const {
        if (mode == 1) return u.row0 + rr;
        if (u.e >= NE) return u.row0 + rr;
        return *(const LAS int*)(lds + MOE_IDX_OFF + u.par * 2048 + rr * 4) / 9;
    }
};

typedef f32x4 (&AccRef)[2][2][4][2];
DI u32x4 pack8(const f32x4& v0, const f32x4& v1) { u32x4 w; w.x = pk_bf16(v0[0], v0[1]); w.y = pk_bf16(v0[2], v0[3]); w.z = pk_bf16(v1[0], v1[1]); w.w = pk_bf16(v1[2], v1[3]); return w; }

struct EpiInProj { static constexpr bool OUT8 = false;
    bf16_t* proj; const float* rope;
    DI static int kind_of(int pn) { return pn < 6 ? 0 : pn < 12 ? 1 : pn < 18 ? 2 : pn < 22 ? 3 : pn < 30 ? 2 : 4; }
    DI void pre(AccRef acc, const g8::Unit& u, int wr, int wc, int fr, int fq) const {
        if (kind_of(u.pn) <= 1 && wc == 0) {
            const float sg = (fq < 2) ? -1.0f : 1.0f;
#pragma unroll
            for (int g = 0; g < 4; ++g) {
                const int ai = g >> 1;
                f32x4 cs[2][4];
#pragma unroll
                for (int mm = 0; mm < 2; ++mm) { const int m = (g & 1) * 2 + mm; const int row = u.pm * 256 + ai * 128 + wr * 64 + m * 16 + fr;
#pragma unroll
                    for (int q = 0; q < 4; ++q) cs[mm][q] = *(const f32x4*)(rope + (size_t)row * 32 + 16 * (fq & 1) + 4 * q); }
#pragma unroll
                for (int mm = 0; mm < 2; ++mm) { const int m = (g & 1) * 2 + mm;
#pragma unroll
                    for (int bj = 0; bj < 2; ++bj) {
                        f32x4 v0 = acc[ai][bj][m][0], v1 = acc[ai][bj][m][1], p0, p1;
#pragma unroll
                        for (int j = 0; j < 4; ++j) { p0[j] = lane_xor32(v0[j], (int)(threadIdx.x & 63)); p1[j] = lane_xor32(v1[j], (int)(threadIdx.x & 63)); }
#pragma unroll
                        for (int j = 0; j < 4; ++j) {
                            const float c0 = cs[mm][j >> 1][(j & 1) * 2], s0 = cs[mm][j >> 1][(j & 1) * 2 + 1];
                            const float c1 = cs[mm][2 + (j >> 1)][(j & 1) * 2], s1 = cs[mm][2 + (j >> 1)][(j & 1) * 2 + 1];
                            v0[j] = v0[j] * c0 + sg * p0[j] * s0;
                            v1[j] = v1[j] * c1 + sg * p1[j] * s1;
                        }
                        acc[ai][bj][m][0] = v0; acc[ai][bj][m][1] = v1;
                    }
                    asm volatile("" : "+v"(acc[ai][0][m][0]), "+v"(acc[ai][0][m][1]), "+v"(acc[ai][1][m][0]), "+v"(acc[ai][1][m][1]));
                }
                asm volatile("" ::: "memory");
            }
        }
    }
    DI void row(AccRef acc, const g8::Unit& u, int ai, int m, int wr, int wc, int fr, int fq, u32x4 (&o)[2]) const {
        const int kind = kind_of(u.pn);
#pragma unroll
        for (int bj = 0; bj < 2; ++bj) {
            f32x4 v0 = acc[ai][bj][m][0], v1 = acc[ai][bj][m][1];
            if (kind == 0 || kind == 3) { v0 *= QSCALE; v1 *= QSCALE; }
            if (kind == 4) {
#pragma unroll
                for (int j = 0; j < 4; ++j) { v0[j] = sigmoidf_(v0[j]); v1[j] = sigmoidf_(v1[j]); }
            }
            o[bj] = pack8(v0, v1);
        }
    }
    DI void store(const g8::Unit& u, int rt, int ch, const u32x4& d) const { __builtin_nontemporal_store(d, (u32x4*)(proj + (size_t)(u.pm * 256 + rt) * DIN + u.pn * 256 + ch * 8)); }
};
template <int PART> struct EpiGate { static constexpr bool OUT8 = (PART == 1);
    const bf16_t* proj; const bf16_t* tmp; bf16_t* out;
    DI void pre(AccRef acc, const g8::Unit& u, int wr, int wc, int fr, int fq) const {
        const unsigned vo_g = (unsigned)(((wr * 64 + fr) * DIN + wc * 32 + 8 * fq) * 2), vo_t = (unsigned)(((wr * 64 + fr) * DM + wc * 32 + 8 * fq) * 2);
        constexpr int RB = (PART == 0) ? 4 : 2;
#pragma unroll
        for (int ai = 0; ai < 2; ++ai)
#pragma unroll
            for (int mb = 0; mb < 4; mb += RB) {
                u32x4 gg[RB][2], tt[RB][2];
#pragma unroll
                for (int r = 0; r < RB; ++r)
#pragma unroll
                    for (int bj = 0; bj < 2; ++bj) {
                        const int m = mb + r;
                        gcptr sg = (gcptr)(proj + (size_t)(u.pm * 256 + ai * 128 + m * 16) * DIN + u.pn * 256 + bj * 128 + (PART == 0 ? COL_GD : COL_GS));
                        asm volatile("" : "+s"(sg));
                        gg[r][bj] = *(gu4ptr)(sg + vo_g);
                        if (PART == 1) {
                            gcptr st = (gcptr)(tmp + (size_t)(u.pm * 256 + ai * 128 + m * 16) * DM + u.pn * 256 + bj * 128);
                            asm volatile("" : "+s"(st));
                            tt[r][bj] = *(gu4ptr)(st + vo_t);
                        }
                    }
                asm volatile("" ::: "memory");
#pragma unroll
                for (int r = 0; r < RB; ++r) {
                    const int m = mb + r;
#pragma unroll
                    for (int bj = 0; bj < 2; ++bj) {
                        const u32x4 g4 = gg[r][bj];
                        const float sv[8] = {bf_lo(g4.x), bf_hi(g4.x), bf_lo(g4.y), bf_hi(g4.y), bf_lo(g4.z), bf_hi(g4.z), bf_lo(g4.w), bf_hi(g4.w)};
                        if (PART == 0) {
#pragma unroll
                            for (int j = 0; j < 4; ++j) { acc[ai][bj][m][0][j] *= sv[j]; acc[ai][bj][m][1][j] *= sv[4 + j]; }
                        } else {
                            const u32x4 t4 = tt[r][bj];
                            const float tv[8] = {bf_lo(t4.x), bf_hi(t4.x), bf_lo(t4.y), bf_hi(t4.y), bf_lo(t4.z), bf_hi(t4.z), bf_lo(t4.w), bf_hi(t4.w)};
#pragma unroll
                            for (int j = 0; j < 4; ++j) { acc[ai][bj][m][0][j] = acc[ai][bj][m][0][j] * sv[j] + tv[j]; acc[ai][bj][m][1][j] = acc[ai][bj][m][1][j] * sv[4 + j] + tv[4 + j]; }
                        }
                    }
                    asm volatile("" : "+v"(acc[ai][0][m][0]), "+v"(acc[ai][0][m][1]), "+v"(acc[ai][1][m][0]), "+v"(acc[ai][1][m][1]));
                }
            }
    }
    DI void row(AccRef acc, const g8::Unit&, int ai, int m, int, int, int, int, u32x4 (&o)[2]) const {
        o[0] = pack8(acc[ai][0][m][0], acc[ai][0][m][1]); o[1] = pack8(acc[ai][1][m][0], acc[ai][1][m][1]);
    }
    DI void store(const g8::Unit& u, int rt, int ch, const u32x4& d) const { *(u32x4*)(out + (size_t)(u.pm * 256 + rt) * DM + u.pn * 256 + ch * 8) = d; }
    DI void row8(AccRef acc, const g8::Unit&, int ai, int m, int, int, int, int, u32x2 (&o)[2]) const {
#pragma unroll
        for (int bj = 0; bj < 2; ++bj) {
            const f32x4 v0 = acc[ai][bj][m][0], v1 = acc[ai][bj][m][1];
            o[bj].x = pk_fp8x4(v0[0], v0[1], v0[2], v0[3]); o[bj].y = pk_fp8x4(v1[0], v1[1], v1[2], v1[3]);
        }
    }
    DI void store8(const g8::Unit& u, int rt, int ch, const u32x4& d) const { *(u32x4*)((unsigned char*)out + (size_t)(u.pm * 256 + rt) * DM + u.pn * 256 + ch * 16) = d; }
};
struct EpiPlain { static constexpr bool OUT8 = false;
    bf16_t* out; int ld;
    DI void pre(AccRef, const g8::Unit&, int, int, int, int) const {}
    DI void row(AccRef acc, const g8::Unit&, int ai, int m, int, int, int, int, u32x4 (&o)[2]) const {
        o[0] = pack8(acc[ai][0][m][0], acc[ai][0][m][1]); o[1] = pack8(acc[ai][1][m][0], acc[ai][1][m][1]);
    }
    DI void store(const g8::Unit& u, int rt, int ch, const u32x4& d) const { *(u32x4*)(out + (size_t)(u.pm * 256 + rt) * ld + u.pn * 256 + ch * 8) = d; }
};
struct EpiGateUp { static constexpr bool OUT8 = true;
    unsigned char* hid;
    DI void pre(AccRef, const g8::Unit&, int, int, int, int) const {}
    DI void row(AccRef, const g8::Unit&, int, int, int, int, int, int, u32x4 (&)[2]) const {}
    DI void store(const g8::Unit&, int, int, const u32x4&) const {}
    DI void row8(AccRef acc, const g8::Unit&, int ai, int m, int, int, int, int, u32x2 (&o)[2]) const {
        const f32x4 g0 = acc[ai][0][m][0], g1 = acc[ai][0][m][1], u0 = acc[ai][1][m][0], u1 = acc[ai][1][m][1];
        f32x4 v0, v1;
#pragma unroll
        for (int j = 0; j < 4; ++j) { v0[j] = g0[j] * __builtin_amdgcn_rcpf(1.0f + __expf(-g0[j])) * u0[j]; v1[j] = g1[j] * __builtin_amdgcn_rcpf(1.0f + __expf(-g1[j])) * u1[j]; }
        o[0].x = pk_fp8x4(v0[0], v0[1], v0[2], v0[3]); o[0].y = pk_fp8x4(v1[0], v1[1], v1[2], v1[3]); o[1] = o[0];
    }
    DI void store8(const g8::Unit& u, int rt, int ch, const u32x4& d) const { *(u32x4*)(hid + (size_t)(u.aux + rt) * DE + u.pn * 128 + ch * 16) = d; }
};
struct EpiDown { static constexpr bool OUT8 = true;
    LAS unsigned char* lds; unsigned char* yb9; int* slot;
    DI void pre(AccRef, const g8::Unit&, int, int, int, int) const {}
    DI void row(AccRef, const g8::Unit&, int, int, int, int, int, int, u32x4 (&)[2]) const {}
    DI void store(const g8::Unit&, int, int, const u32x4&) const {}
    DI void row8(AccRef acc, const g8::Unit& u, int ai, int m, int wr, int, int fr, int, u32x2 (&o)[2]) const {
        const int rt = ai * 128 + wr * 64 + m * 16 + fr;
        const float wgt = (u.e < NE) ? *(const LAS float*)(lds + MOE_IDX_OFF + u.par * 2048 + 1024 + rt * 4) : 1.0f;
#pragma unroll
        for (int bj = 0; bj < 2; ++bj) {
            const f32x4 v0 = acc[ai][bj][m][0] * wgt, v1 = acc[ai][bj][m][1] * wgt;
            o[bj].x = pk_fp8x4(v0[0], v0[1], v0[2], v0[3]); o[bj].y = pk_fp8x4(v1[0], v1[1], v1[2], v1[3]);
        }
    }
    DI void store8(const g8::Unit& u, int rt, int ch, const u32x4& d) const {
        if (rt < u.nvalid) {
            const int srow = u.aux + rt;
            __builtin_nontemporal_store(d, (u32x4*)(yb9 + ((size_t)u.pn * YB_SLOTS + srow) * 256 + ch * 16));
            if (u.pn == 0 && ch == 0) {
                const int v = (u.e < NE) ? *(const LAS int*)(lds + MOE_IDX_OFF + u.par * 2048 + rt * 4) : (u.pm * 256 + rt) * 9 + 8;
                slot[v] = srow;
            }
        }
    }
};

DI void phase_inproj(const Params& p, LAS unsigned char* lds) {
    EpiInProj E{(bf16_t*)(p.ws + WS_PROJ), (const float*)(p.ws + WS_ROPE)};
    const int G = (int)gridDim.x, c = (int)blockIdx.x, Gg = gemm_blocks(G), wid = __builtin_amdgcn_readfirstlane(threadIdx.x >> 6);
    if (c < Gg) {
        { DenseSched S{(const char*)(p.ws + WS_H8), (const char*)(p.ws + WS_WTIN8), 64, 46, 2048, 2048, 16, Gg, c, 0};
          g8::gemm_phase<32, 0, GEMM_SPLIT, true>(lds, S, E); }
        const int nb = bg_blocks(G), b0 = Gg - nb;
        if (nb > 0 && c >= b0) cvtw_range(p, bg_first(G) + (c - b0) * 8 + wid, 2 * CVT_TOTAL, nb * 8);
    } else {
        cvtw_range(p, WIN_END + (c - Gg) * 8 + wid, conv_end(G), nconv(G) * 8);
    }
    __syncthreads();
}
DI void phase_outproj_a(const Params& p, LAS unsigned char* lds) {
    DenseSched S{(const char*)(p.ws + WS_ODIL), (const char*)(p.ws + WS_WTDIL), 64, 8, 1024, 1024, 8, (int)gridDim.x, (int)blockIdx.x};
    EpiGate<0> E{(const bf16_t*)(p.ws + WS_PROJ), nullptr, (bf16_t*)(p.ws + WS_TMP)};
    g8::gemm_phase<32, 0, GEMM_SPLIT, false>(lds, S, E);
}
DI void phase_outproj_b(const Params& p, LAS unsigned char* lds) {
    DenseSched S{(const char*)(p.ws + WS_OSB), (const char*)(p.ws + WS_WTSB), 64, 8, 2048, 2048, 16, (int)gridDim.x, (int)blockIdx.x};
    EpiGate<1> E{(const bf16_t*)(p.ws + WS_PROJ), (const bf16_t*)(p.ws + WS_TMP), (bf16_t*)(p.ws + WS_H)};
    g8::gemm_phase<32, 0, GEMM_SPLIT, false>(lds, S, E);
}
DI void phase_mixout(const Params& p, LAS unsigned char* lds) {
    DenseSched S{(const char*)(p.ws + WS_H), (const char*)(p.ws + WS_WTMIX), 64, 8, 2048, 2048, 16, (int)gridDim.x, (int)blockIdx.x};
    EpiPlain E{(bf16_t*)(p.ws + WS_Y), DM};
    g8::gemm_phase<32, 0, GEMM_SPLIT, true>(lds, S, E);
}
DI void moe_tables(const Params& p, LAS unsigned char* lds) {
    LAS int* tpre = (LAS int*)(lds + MOE_TAB_OFF);
    const int* cnt = (const int*)(p.ws + WS_CNT);
    if (threadIdx.x < 64) {
        const int e = threadIdx.x, n = cnt[e * CNT_STRIDE], tiles = (n + 255) >> 8;
        int incl = tiles;
#pragma unroll
        for (int o = 1; o < 64; o <<= 1) { const int t = __shfl_up(incl, o); if (e >= o) incl += t; }
        tpre[e] = incl - tiles; tpre[NEX + 1 + e] = n;
        if (e == 63) { tpre[NE] = incl; tpre[NEX + 1 + NE] = NTOK; tpre[NEX] = incl + NTOK / 256; }
    }
    __syncthreads();
    const int T = tpre[NEX];
    for (int t = threadIdx.x; t < T; t += 512) {
        int e = 0;
        for (int q = 1; q < NEX; ++q) e = (tpre[q] <= t) ? q : e;
        *(LAS unsigned char*)(lds + MOE_TILE_OFF + t) = (unsigned char)e;
    }
    __syncthreads();
}
DI void phase_gateup(const Params& p, LAS unsigned char* lds) {
    moe_tables(p, lds);
    MoeSched S{lds, (const int*)(p.ws + WS_LIST), (const float*)(p.ws + WS_LISTW), (const char*)(p.ws + WS_H), (const char*)(p.ws + WS_WGU), 4, 0, (int)gridDim.x, (int)blockIdx.x};
    EpiGateUp E{(unsigned char*)(p.ws + WS_HID)};
    g8::gemm_phase<16, MOE_BAUX, GEMM_SPLIT, true>(lds, S, E);
}
DI void phase_gateup_tail(const Params& p, LAS unsigned char* lds) {
    const int G = (int)gridDim.x, c = (int)blockIdx.x, wid = __builtin_amdgcn_readfirstlane(threadIdx.x >> 6);
    const int U = __builtin_amdgcn_readfirstlane(*(const LAS int*)(lds + MOE_TAB_OFF + NEX * 4)) * 4;
    const int nmax = (U + G - 1) / G, r = U - (nmax - 1) * G, n_lo = G - r;
    const int beg = max(p0_end(G), conv_end(G)), end = bg_first(G), W_lo = min(end - beg, n_lo * 8 * BG_PER_WAVE);
    const bool lo = c >= r;
    cvtw_range2(p, lo ? beg + (c - r) * 8 + wid : 0, lo ? beg + W_lo : 0, max(1, n_lo * 8), beg + W_lo + c * 8 + wid, end, G * 8);
    __syncthreads();
}
DI void phase_down(const Params& p, LAS unsigned char* lds) {
    moe_tables(p, lds);
    MoeSched S{lds, (const int*)(p.ws + WS_LIST), (const float*)(p.ws + WS_LISTW), (const char*)(p.ws + WS_HID), (const char*)(p.ws + WS_WD), 8, 1, (int)gridDim.x, (int)blockIdx.x};
    EpiDown E{lds, (unsigned char*)(p.ws + WS_YB9), (int*)(p.ws + WS_SLOT)};
    g8::gemm_phase<32, MOE_BAUX, GEMM_SPLIT, true>(lds, S, E);
}

namespace att {
constexpr int TB = 16384;
DI unsigned off_b(unsigned row, unsigned ch) { return 256u * row + 16u * (ch ^ (((row & 3u) << 2) | ((row >> 2) & 3u))); }
DI int crow(int i, int h) { return (i & 3) + 8 * (i >> 2) + 4 * h; }
DI f32x16 mfma32(bf16x8 a, bf16x8 b, f32x16 c) { return __builtin_amdgcn_mfma_f32_32x32x16_bf16(a, b, c, 0, 0, 0); }
DI bf16x8 pack8(const f32x16& x, int s) {
    u32x4 w; w.x = pk_bf16(x[8 * s + 0], x[8 * s + 1]); w.y = pk_bf16(x[8 * s + 2], x[8 * s + 3]); w.z = pk_bf16(x[8 * s + 4], x[8 * s + 5]); w.w = pk_bf16(x[8 * s + 6], x[8 * s + 7]);
    return __builtin_bit_cast(bf16x8, w);
}
DI void qk_tile(LAS const unsigned char* Kb, const bf16x8 (&qf)[8], f32x16& x0, f32x16& x1, int r, int h) {
#pragma unroll
    for (int i = 0; i < 16; ++i) { x0[i] = 0.f; x1[i] = 0.f; }
#pragma unroll
    for (int s = 0; s < 8; ++s) {
        const bf16x8 a0 = *(const LAS bf16x8*)(Kb + off_b(r, 2 * s + h));
        const bf16x8 a1 = *(const LAS bf16x8*)(Kb + off_b(32 + r, 2 * s + h));
        x0 = mfma32(a0, qf[s], x0); x1 = mfma32(a1, qf[s], x1);
    }
}
DI void pv_tile(LAS const unsigned char* Vb, const f32x16& p0, const f32x16& p1, f32x16 (&o)[4], int lane) {
    const int h = lane >> 5, blk = (lane >> 4) & 1, q = (lane & 15) >> 2, pp = lane & 3;
#pragma unroll
    for (int kb = 0; kb < 2; ++kb)
#pragma unroll
        for (int s = 0; s < 2; ++s) {
            const bf16x8 pf = pack8(kb ? p1 : p0, s);
#pragma unroll
            for (int db = 0; db < 4; ++db) {
                const unsigned row0 = 32 * kb + 16 * s + 4 * h + q;
                const unsigned ch = 4 * db + 2 * blk + (pp >> 1);
                const s16x4 t0 = __builtin_amdgcn_ds_read_tr16_b64_v4i16((LAS s16x4*)(Vb + off_b(row0, ch) + 8 * (pp & 1)));
                const s16x4 t1 = __builtin_amdgcn_ds_read_tr16_b64_v4i16((LAS s16x4*)(Vb + off_b(row0 + 8, ch) + 8 * (pp & 1)));
                const bf16x8 vf = {t0[0], t0[1], t0[2], t0[3], t1[0], t1[1], t1[2], t1[3]};
                o[db] = mfma32(vf, pf, o[db]);
            }
        }
}
DI void store_o(bf16_t* orow, const f32x16 (&o)[4], float scale, int h) {
#pragma unroll
    for (int db = 0; db < 4; ++db)
#pragma unroll
        for (int g = 0; g < 4; ++g) {
            u32x2 w; w.x = pk_bf16(o[db][4 * g] * scale, o[db][4 * g + 1] * scale); w.y = pk_bf16(o[db][4 * g + 2] * scale, o[db][4 * g + 3] * scale);
            *(u32x2*)(orow + 32 * db + 8 * g + 4 * h) = w;
        }
}

DI void sb_item(const Params& p, LAS unsigned char* lds, int b, int hd, int Q) {
    const bf16_t* proj = (const bf16_t*)(p.ws + WS_PROJ);
    bf16_t* osb = (bf16_t*)(p.ws + WS_OSB);
    const int tid = threadIdx.x, wid = __builtin_amdgcn_readfirstlane(tid >> 6), lane = tid & 63, r = lane & 31, h = lane >> 5;
    const size_t tokbase = (size_t)b * SEQ;
    const int wq0 = Q * 256 + 32 * wid;
    const int myq = wq0 + r;
    bf16x8 qf[8];
    f32x16 o[4];
#pragma unroll
    for (int db = 0; db < 4; ++db)
#pragma unroll
        for (int i = 0; i < 16; ++i) o[db][i] = 0.f;
    float R = 0.f;
    unsigned goff[2];
#pragma unroll
    for (int i = 0; i < 2; ++i) { const unsigned row = 4 * (wid * 2 + i) + (lane >> 4), cp = lane & 15, ch = cp ^ (((row & 3u) << 2) | ((row >> 2) & 3u)); goff[i] = (row * DIN + ch * 8) * 2; }
    const char* kbase = (const char*)(proj + tokbase * DIN + COL_KS + hd * 128);
    const char* vbase = (const char*)(proj + tokbase * DIN + COL_VS + hd * 128);
#define ATT_ISSUE(key0_, buf_) do { const size_t _ko = (size_t)(key0_) * DIN * 2; _Pragma("unroll") for (int _i = 0; _i < 2; ++_i) { \
        __builtin_amdgcn_global_load_lds((const unsigned*)(kbase + _ko + goff[_i]), (LAS unsigned*)(lds + (buf_) * TB + 1024 * (wid * 2 + _i)), 16, 0, 0); \
        __builtin_amdgcn_global_load_lds((const unsigned*)(vbase + _ko + goff[_i]), (LAS unsigned*)(lds + 3 * TB + (buf_) * TB + 1024 * (wid * 2 + _i)), 16, 0, 0); } } while (0)
    int j = 4 * Q + 3;
    ATT_ISSUE(64 * j, 0);
    ATT_ISSUE(64 * (j - 1), 1);
    {
        const bf16_t* qrow = proj + (tokbase + myq) * DIN + COL_QS + hd * 128;
#pragma unroll
        for (int s = 0; s < 8; ++s) qf[s] = *(const bf16x8*)(qrow + 16 * s + 8 * h);
#pragma unroll
        for (int s = 0; s < 8; ++s) asm volatile("" : "+v"(qf[s]));
    }
    int cur = 0;
    for (; j >= 0; --j) {
        LAS unsigned char* Kb = lds + cur * TB; LAS unsigned char* Vb = lds + 3 * TB + cur * TB;
        if (j > 0) asm volatile("s_waitcnt vmcnt(4)" ::: "memory"); else asm volatile("s_waitcnt vmcnt(0)" ::: "memory");
        __builtin_amdgcn_s_barrier(); asm volatile("" ::: "memory");
        if (j > 1) ATT_ISSUE(64 * (j - 2), cur == 0 ? 2 : cur - 1);
        const int key0 = 64 * j;
        if (key0 < wq0 + 31) {
            const bool need_mask = (key0 + 63 >= wq0);
            f32x16 x0, x1;
            qk_tile(Kb, qf, x0, x1, r, h);
            f32x16 l0, l1;
#pragma unroll
            for (int i = 0; i < 16; ++i) {
                l0[i] = __builtin_amdgcn_logf(1.0f + __builtin_amdgcn_exp2f(x0[i]));
                l1[i] = __builtin_amdgcn_logf(1.0f + __builtin_amdgcn_exp2f(x1[i]));
            }
            if (need_mask) {
#pragma unroll
                for (int i = 0; i < 16; ++i) { const int kk = key0 + crow(i, h); if (kk >= myq) l0[i] = 0.f; if (kk + 32 >= myq) l1[i] = 0.f; }
            }
#pragma unroll
            for (int g = 0; g < 4; ++g) {
                l0[4 * g + 2] += l0[4 * g + 3]; l0[4 * g + 1] += l0[4 * g + 2]; l0[4 * g] += l0[4 * g + 1];
                l1[4 * g + 2] += l1[4 * g + 3]; l1[4 * g + 1] += l1[4 * g + 2]; l1[4 * g] += l1[4 * g + 1];
            }
            float Tlo[8], Thi[8];
#pragma unroll
            for (int g = 0; g < 4; ++g) {
                { const unsigned t = __float_as_uint(l0[4 * g]); auto sw = __builtin_amdgcn_permlane32_swap(t, t, false, false); Tlo[g] = __uint_as_float(sw[0]); Thi[g] = __uint_as_float(sw[1]); }
                { const unsigned t = __float_as_uint(l1[4 * g]); auto sw = __builtin_amdgcn_permlane32_swap(t, t, false, false); Tlo[4 + g] = __uint_as_float(sw[0]); Thi[4 + g] = __uint_as_float(sw[1]); }
            }
            float offR[8];
            float run = 0.f;
#pragma unroll
            for (int g = 7; g >= 0; --g) { offR[g] = run + (h == 0 ? Thi[g] : 0.f) + R; run += Tlo[g] + Thi[g]; }
            f32x16 p0, p1;
#pragma unroll
            for (int i = 0; i < 16; ++i) {
                p0[i] = __builtin_amdgcn_exp2f(x0[i] - (l0[i] + offR[i >> 2]));
                p1[i] = __builtin_amdgcn_exp2f(x1[i] - (l1[i] + offR[4 + (i >> 2)]));
            }
            if (need_mask) {
#pragma unroll
                for (int i = 0; i < 16; ++i) { const int kk = key0 + crow(i, h); if (kk >= myq) p0[i] = 0.f; if (kk + 32 >= myq) p1[i] = 0.f; }
            }
            R += run;
            pv_tile(Vb, p0, p1, o, lane);
        }
        cur = (cur == 2) ? 0 : cur + 1;
    }
    store_o(osb + (tokbase + myq) * 1024 + hd * 128, o, 1.0f, h);
    __syncthreads();
}

DI void dil_item(const Params& p, LAS unsigned char* lds, int di) {
    const bf16_t* proj = (const bf16_t*)(p.ws + WS_PROJ);
    bf16_t* og = (bf16_t*)(p.ws + WS_OG);
    float* lse = (float*)(p.ws + WS_LSE);
    const int b = di / 192; const int rem = di - b * 192; const int head = rem >> 4, sub = rem & 15;
    const int grp = head >> 2;
    const int dil = grp == 0 ? 1 : grp == 1 ? 4 : 16;
    const int nblk = 16 / dil;
    const int res = sub / nblk, Qb = sub - res * nblk;
    const int i0 = Qb * 256;
    const int tid = threadIdx.x, wid = __builtin_amdgcn_readfirstlane(tid >> 6), lane = tid & 63, r = lane & 31, h = lane >> 5;
    const size_t tokbase = (size_t)b * SEQ;
    const int wq0 = i0 + 32 * wid;
    const int myqi = wq0 + r;
    const size_t mytok = tokbase + (size_t)myqi * dil + res;
    bf16x8 qf[8];
    f32x16 o[4];
#pragma unroll
    for (int db = 0; db < 4; ++db)
#pragma unroll
        for (int i = 0; i < 16; ++i) o[db][i] = 0.f;
    float mrun = -1e30f, lrun = 0.f;
    unsigned goff[2];
#pragma unroll
    for (int i = 0; i < 2; ++i) { const unsigned row = 4 * (wid * 2 + i) + (lane >> 4), cp = lane & 15, ch = cp ^ (((row & 3u) << 2) | ((row >> 2) & 3u)); goff[i] = (row * dil * DIN + ch * 8) * 2; }
    const char* kbase = (const char*)(proj + (tokbase + res) * DIN + COL_KA + head * 128);
    const char* vbase = (const char*)(proj + (tokbase + res) * DIN + COL_VA + head * 128);
    const int jt0 = (i0 == 0) ? 2 : 0;
    ATT_ISSUE((i0 - 128 + 64 * jt0) * dil, 0);
    ATT_ISSUE((i0 - 128 + 64 * (jt0 + 1)) * dil, 1);
    {
        const bf16_t* qrow = proj + mytok * DIN + COL_QA + head * 128;
#pragma unroll
        for (int s = 0; s < 8; ++s) qf[s] = *(const bf16x8*)(qrow + 16 * s + 8 * h);
#pragma unroll
        for (int s = 0; s < 8; ++s) asm volatile("" : "+v"(qf[s]));
    }
    int cur = 0;
    for (int jt = jt0; jt < 6; ++jt) {
        LAS unsigned char* Kb = lds + cur * TB; LAS unsigned char* Vb = lds + 3 * TB + cur * TB;
        if (jt < 5) asm volatile("s_waitcnt vmcnt(4)" ::: "memory"); else asm volatile("s_waitcnt vmcnt(0)" ::: "memory");
        __builtin_amdgcn_s_barrier(); asm volatile("" ::: "memory");
        if (jt < 4) ATT_ISSUE((i0 - 128 + 64 * (jt + 2)) * dil, cur == 0 ? 2 : cur - 1);
        const int ki0 = i0 - 128 + 64 * jt;
        if (ki0 <= wq0 + 31 && ki0 + 63 >= wq0 - 128) {
            f32x16 x0, x1;
            qk_tile(Kb, qf, x0, x1, r, h);
            const float NEG = -__builtin_inff();
#pragma unroll
            for (int i = 0; i < 16; ++i) {
                const int d0 = myqi - (ki0 + crow(i, h));
                if ((unsigned)d0 > 128u) x0[i] = NEG;
                if ((unsigned)(d0 - 32) > 128u) x1[i] = NEG;
            }
            float mx = x0[0];
#pragma unroll
            for (int i = 1; i < 16; ++i) mx = fmaxf(mx, x0[i]);
#pragma unroll
            for (int i = 0; i < 16; ++i) mx = fmaxf(mx, x1[i]);
            { const unsigned t = __float_as_uint(mx); auto sw = __builtin_amdgcn_permlane32_swap(t, t, false, false); mx = fmaxf(__uint_as_float(sw[0]), __uint_as_float(sw[1])); }
            const float mn = fmaxf(mrun, mx);
            const float alpha = __builtin_amdgcn_exp2f(mrun - mn);
            mrun = mn;
            f32x16 p0, p1; float rs = 0.f;
#pragma unroll
            for (int i = 0; i < 16; ++i) { p0[i] = __builtin_amdgcn_exp2f(x0[i] - mn); p1[i] = __builtin_amdgcn_exp2f(x1[i] - mn); rs += p0[i] + p1[i]; }
            { const unsigned t = __float_as_uint(rs); auto sw = __builtin_amdgcn_permlane32_swap(t, t, false, false); rs = __uint_as_float(sw[0]) + __uint_as_float(sw[1]); }
            lrun = lrun * alpha + rs;
#pragma unroll
            for (int db = 0; db < 4; ++db)
#pragma unroll
                for (int i = 0; i < 16; ++i) o[db][i] *= alpha;
            pv_tile(Vb, p0, p1, o, lane);
        }
        cur = (cur == 2) ? 0 : cur + 1;
    }
    store_o(og + mytok * 1536 + head * 128, o, 1.0f / lrun, h);
    if (h == 0) lse[mytok * 12 + head] = (mrun + __builtin_amdgcn_logf(lrun)) * LN2;
    __syncthreads();
}
#undef ATT_ISSUE
}

DI void phase_attn(const Params& p, LAS unsigned char* lds) {
    for (int it = blockIdx.x; it < 1024; it += gridDim.x) {
        if (it < 256) {
            const int xcd = it & 7, rest = it >> 3, bhi = rest >> 3, x = rest & 7, bh = xcd * 4 + bhi;
            att::sb_item(p, lds, bh >> 3, bh & 7, 15 - x);
            att::sb_item(p, lds, bh >> 3, bh & 7, x);
        } else att::dil_item(p, lds, it - 256);
    }
}

DI void phase_merge(const Params& p) {
    const int lane = threadIdx.x & 63, wid = threadIdx.x >> 6;
    const bf16_t* og = (const bf16_t*)(p.ws + WS_OG); const float* lse = (const float*)(p.ws + WS_LSE); bf16_t* odil = (bf16_t*)(p.ws + WS_ODIL);
    const int hg = lane >> 4, d0 = (lane & 15) * 8;
    for (int tok = blockIdx.x * 8 + wid; tok < NTOK; tok += gridDim.x * 8) {
        const float l0 = lse[(size_t)tok * 12 + hg], l1 = lse[(size_t)tok * 12 + 4 + hg], l2 = lse[(size_t)tok * 12 + 8 + hg];
        const float mx = fmaxf(l0, fmaxf(l1, l2));
        float w0 = __expf(l0 - mx), w1 = __expf(l1 - mx), w2 = __expf(l2 - mx);
        const float inv = 1.0f / (w0 + w1 + w2); w0 *= inv; w1 *= inv; w2 *= inv;
        const u32x4 a = *(const u32x4*)(og + (size_t)tok * 1536 + hg * 128 + d0);
        const u32x4 bq = *(const u32x4*)(og + (size_t)tok * 1536 + (4 + hg) * 128 + d0);
        const u32x4 c = *(const u32x4*)(og + (size_t)tok * 1536 + (8 + hg) * 128 + d0);
        u32x4 o;
#pragma unroll
        for (int q = 0; q < 4; ++q) {
            const float lo = w0 * bf_lo(a[q]) + w1 * bf_lo(bq[q]) + w2 * bf_lo(c[q]);
            const float hi = w0 * bf_hi(a[q]) + w1 * bf_hi(bq[q]) + w2 * bf_hi(c[q]);
            o[q] = pk_bf16(lo, hi);
        }
        *(u32x4*)(odil + (size_t)tok * 512 + hg * 128 + d0) = o;
    }
}

DI void phase_postmix(const Params& p, LAS unsigned char* lds) {
    const int tid = threadIdx.x, lane = tid & 63, wid = __builtin_amdgcn_readfirstlane(tid >> 6);
    LAS float* hsm = (LAS float*)lds;
    LAS float* part = (LAS float*)(lds + 131072);
    const float* mod = (const float*)(p.ws + WS_MOD); const bf16_t* y = (const bf16_t*)(p.ws + WS_Y);
    unsigned char* h2 = (unsigned char*)(p.ws + WS_H);
    int* cnt = (int*)(p.ws + WS_CNT); int* list = (int*)(p.ws + WS_LIST); float* listw = (float*)(p.ws + WS_LISTW);
    const bf16_t* wr_hi = (const bf16_t*)(p.ws + WS_WRT);
    const float rbias = p.router_bias[lane];
    LAS int* lcnt = (LAS int*)(lds + 147456);
    LAS int* lbase = (LAS int*)(lds + 147712);
    LAS unsigned char* sel_e = lds + 147968;
    LAS unsigned short* sel_r = (LAS unsigned short*)(lds + 150016);
    LAS float* sel_w = (LAS float*)(lds + 154112);
    if (tid < 64) lcnt[tid] = 0;
    const int per_it = (NTOK / 16 + (int)gridDim.x - 1) / (int)gridDim.x, itb = (int)blockIdx.x * per_it, nit = min(per_it, NTOK / 16 - itb);
    u32x2 tA[8], tB[8], tC[8]; int cb = -1;
#pragma unroll 1
    for (int itl = 0; itl < nit; ++itl) {
        const int it = itb + itl;
        if ((it >> 8) != cb) {
            cb = it >> 8;
#pragma unroll
            for (int i = 0; i < 8; ++i) {
                const int ch = 4 * (lane + 64 * i);
                typedef const __attribute__((address_space(1))) f32x4* gf4ptr;
                gcptr b0 = (gcptr)p.g_post_mix, b1 = (gcptr)(mod + cb * 12288 + 4096), b2 = (gcptr)p.g_pre_ffn;
                asm volatile("" : "+s"(b0), "+s"(b1), "+s"(b2));
                const unsigned vo = (unsigned)ch * 4u;
                const f32x4 g = *(gf4ptr)(b0 + vo), gt = *(gf4ptr)(b1 + vo);
                const f32x4 g2 = *(gf4ptr)(b2 + vo), sc = *(gf4ptr)(b1 + (vo + 4096u * 4u));
                const f32x4 sh = *(gf4ptr)(b1 + (vo + 2048u * 4u));
                tA[i].x = pk_bf16(gt[0] * g[0], gt[1] * g[1]); tA[i].y = pk_bf16(gt[2] * g[2], gt[3] * g[3]);
                tB[i].x = pk_bf16(g2[0] * (1.0f + sc[0]), g2[1] * (1.0f + sc[1])); tB[i].y = pk_bf16(g2[2] * (1.0f + sc[2]), g2[3] * (1.0f + sc[3]));
                tC[i].x = pk_bf16(sh[0], sh[1]); tC[i].y = pk_bf16(sh[2], sh[3]);
                if (i & 1) asm volatile("" : "+v"(tA[i]), "+v"(tB[i]), "+v"(tC[i]), "+v"(tA[i - 1]), "+v"(tB[i - 1]), "+v"(tC[i - 1]) :: "memory");
            }
        }
        typedef const __attribute__((address_space(1))) u32x2* gu2ptr_t; typedef const __attribute__((address_space(1))) f32x4* gf4ptr2_t;
        u32x2 yw0[8]; f32x4 v0[8];
        auto load_tok = [&](int tok, u32x2 (&yw)[8], f32x4 (&v)[8]) {
            gcptr yb = (gcptr)(y + (size_t)tok * DM), xb = (gcptr)(p.x + (size_t)tok * DM);
            asm volatile("" : "+s"(yb), "+s"(xb));
#pragma unroll
            for (int i = 0; i < 8; ++i) yw[i] = *(gu2ptr_t)(yb + (unsigned)(8 * lane + 512 * i));
#pragma unroll
            for (int i = 0; i < 8; ++i) v[i] = __builtin_nontemporal_load((gf4ptr2_t)(xb + (unsigned)(16 * lane + 1024 * i)));
        };
        auto proc_tok = [&](int tl, int tok, u32x2 (&yw)[8], f32x4 (&v)[8]) {
            __attribute__((address_space(1))) char* x1b = (__attribute__((address_space(1))) char*)(p.ws + WS_X1 + (size_t)tok * DM * 2);
            __attribute__((address_space(1))) char* h2b = (__attribute__((address_space(1))) char*)(h2 + (size_t)tok * DM);
            asm volatile("" : "+s"(x1b), "+s"(h2b));
#pragma unroll
            for (int i = 0; i < 8; ++i) asm volatile("" : "+v"(tA[i]), "+v"(tB[i]), "+v"(tC[i]));
            float ss = 0.f;
#pragma unroll
            for (int i = 0; i < 8; ++i) { const float y0 = bf_lo(yw[i].x), y1 = bf_hi(yw[i].x), y2 = bf_lo(yw[i].y), y3 = bf_hi(yw[i].y); ss += y0 * y0 + y1 * y1 + y2 * y2 + y3 * y3; }
            ss = wave_sum(ss);
            const float rstd = rsqrtf(ss * (1.0f / DM) + RMS_EPS);
            float ss1 = 0.f;
#pragma unroll
            for (int i = 0; i < 8; ++i) {
                const int ch = 4 * (lane + 64 * i);
                const float yv[4] = {bf_lo(yw[i].x), bf_hi(yw[i].x), bf_lo(yw[i].y), bf_hi(yw[i].y)};
                const float av[4] = {bf_lo(tA[i].x), bf_hi(tA[i].x), bf_lo(tA[i].y), bf_hi(tA[i].y)};
#pragma unroll
                for (int j = 0; j < 4; ++j) { v[i][j] = v[i][j] + av[j] * (yv[j] * rstd); ss1 += v[i][j] * v[i][j]; }
                { u32x2 w; w.x = pk_bf16(v[i][0], v[i][1]); w.y = pk_bf16(v[i][2], v[i][3]); *(__attribute__((address_space(1))) u32x2*)(x1b + (unsigned)(8 * lane + 512 * i)) = w; }
            }
            ss1 = wave_sum(ss1);
            const float rstd1 = rsqrtf(ss1 * (1.0f / DM) + RMS_EPS);
#pragma unroll
            for (int i = 0; i < 8; ++i) {
                const int ch = 4 * (lane + 64 * i);
                f32x4 o;
                const float bv[4] = {bf_lo(tB[i].x), bf_hi(tB[i].x), bf_lo(tB[i].y), bf_hi(tB[i].y)}, cv[4] = {bf_lo(tC[i].x), bf_hi(tC[i].x), bf_lo(tC[i].y), bf_hi(tC[i].y)};
#pragma unroll
                for (int j = 0; j < 4; ++j) o[j] = v[i][j] * rstd1 * bv[j] + cv[j];
                *(__attribute__((address_space(1))) unsigned*)(h2b + (unsigned)(4 * lane + 256 * i)) = pk_fp8x4(o[0], o[1], o[2], o[3]);
                *(LAS f32x4*)(hsm + tl * 2048 + ch) = o;
            }
        };
#pragma unroll 1
        for (int sub = 0; sub < 2; ++sub) {
            load_tok(it * 16 + 2 * wid + sub, yw0, v0);
            asm volatile("" ::: "memory");
            proc_tok(2 * wid + sub, it * 16 + 2 * wid + sub, yw0, v0);
            asm volatile("" ::: "memory");
        }
        bf16x8 bw[4][4];
        gcptr wrb = (gcptr)wr_hi; asm volatile("" : "+s"(wrb));
        unsigned wro = (unsigned)((lane & 15) * 4096 + 512 * wid + 16 * (lane >> 4));
        asm volatile("" : "+v"(wro));
        auto load_bw = [&](int ksb) {
#pragma unroll
            for (int k4 = 0; k4 < 4; ++k4)
#pragma unroll
                for (int q = 0; q < 4; ++q) bw[k4][q] = *(const __attribute__((address_space(1))) bf16x8*)(wrb + (wro + (unsigned)(q * 65536 + (ksb + k4) * 64)));
        };
        load_bw(0);
        asm volatile("" ::: "memory");
        __syncthreads();
        f32x4 acc[4];
        {
            const int tr = lane & 15, kq = lane >> 4;
#pragma unroll
            for (int q = 0; q < 4; ++q) acc[q] = (f32x4){0.f, 0.f, 0.f, 0.f};
#pragma unroll
            for (int half = 0; half < 2; ++half) {
                if (half) { load_bw(4); asm volatile("" ::: "memory"); }
#pragma unroll
                for (int k4 = 0; k4 < 4; ++k4) {
                    const int k0 = 256 * wid + 32 * (4 * half + k4) + 8 * kq;
                    const f32x4 a0 = *(const LAS f32x4*)(hsm + tr * 2048 + k0), a1 = *(const LAS f32x4*)(hsm + tr * 2048 + k0 + 4);
                    u32x4 hw = (u32x4){pk_bf16(a0[0], a0[1]), pk_bf16(a0[2], a0[3]), pk_bf16(a1[0], a1[1]), pk_bf16(a1[2], a1[3])};
                    const bf16x8 ah = __builtin_bit_cast(bf16x8, hw);
#pragma unroll
                    for (int q = 0; q < 4; ++q) acc[q] = __builtin_amdgcn_mfma_f32_16x16x32_bf16(ah, bw[k4][q], acc[q], 0, 0, 0);
                }
                asm volatile("" : "+v"(acc[0]), "+v"(acc[1]), "+v"(acc[2]), "+v"(acc[3]));
            }
            if (wid >= 4) {
#pragma unroll
                for (int q = 0; q < 4; ++q)
#pragma unroll
                    for (int j = 0; j < 4; ++j) part[((wid - 4) * 16 + 4 * kq + j) * 64 + 16 * q + tr] = acc[q][j];
            }
        }
        __syncthreads();
        if (wid < 4) {
            const int tr = lane & 15, kq = lane >> 4;
#pragma unroll
            for (int q = 0; q < 4; ++q)
#pragma unroll
                for (int j = 0; j < 4; ++j) part[(wid * 16 + 4 * kq + j) * 64 + 16 * q + tr] += acc[q][j];
        }
        __syncthreads();
#pragma unroll 1
        for (int sub = 0; sub < 2; ++sub) {
            const int tl = 2 * wid + sub, tok = it * 16 + tl;
            const float logit = ((part[(0 * 16 + tl) * 64 + lane] + part[(1 * 16 + tl) * 64 + lane]) + part[(2 * 16 + tl) * 64 + lane]) + part[(3 * 16 + tl) * 64 + lane];
            const float score = 1.0f / (1.0f + __expf(-logit));
            const float sel = score + rbias;
            float m1 = sel;
            m1 = grp8_max(m1);
            const bool is1 = (sel == m1);
            const unsigned long long bal = __ballot(is1);
            const unsigned gm = (unsigned)(bal >> (lane & ~7)) & 0xffu;
            const int first = __ffs(gm) - 1;
            float m2 = (is1 && (lane & 7) == first) ? -__builtin_inff() : sel;
            m2 = grp8_max(m2);
            const float gs = m1 + m2;
            const int myg = lane >> 3;
            int grank = 0;
#pragma unroll 1
            for (int g = 0; g < 8; ++g) { const float gv = __uint_as_float(__builtin_amdgcn_readlane(__float_as_uint(gs), 8 * g)); grank += (gv > gs || (gv == gs && g < myg)) ? 1 : 0; }
            const bool gsel = grank < 4;
            const float msel = gsel ? sel : -__builtin_inff();
            int rk = 64; float cur = msel;
#pragma unroll 1
            for (int r = 0; r < 8; ++r) {
                const float mx = wave_max(cur);
                const unsigned long long bal = __ballot(cur == mx);
                const int first = __ffsll((long long)bal) - 1;
                if (lane == first) { rk = r; cur = -__builtin_inff(); }
            }
            const bool chosen = gsel && rk < 8;
            const float ssum = wave_sum(chosen ? score : 0.f);
            if (chosen) {
                const int lr = __hip_atomic_fetch_add(lcnt + lane, 1, __ATOMIC_RELAXED, __HIP_MEMORY_SCOPE_WORKGROUP);
                const int idx = ((itl & 15) * 16 + tl) * 8 + rk;
                sel_e[idx] = (unsigned char)lane; sel_r[idx] = (unsigned short)lr; sel_w[idx] = score / ssum * 2.5f;
            }
            (void)tok;
        }
        __syncthreads();
        if ((itl & 15) == 15 || itl == nit - 1) {
            if (tid < 64) { int t2 = tid; asm volatile("" : "+v"(t2)); lbase[t2] = atomicAdd(&cnt[t2 * CNT_STRIDE], lcnt[t2]); }
            __syncthreads();
            const int nsel = ((itl & 15) + 1) * 128, it0 = itl & ~15;
            for (int idx = tid; idx < nsel; idx += 512) {
                const int e = sel_e[idx], tl = idx >> 3, k = idx & 7;
                const int tk = (itb + it0 + (tl >> 4)) * 16 + (tl & 15);
                const int pos = lbase[e] + sel_r[idx];
                list[e * LIST_CAP + pos] = tk * 9 + k; listw[e * LIST_CAP + pos] = sel_w[idx];
            }
            __syncthreads();
            if (tid < 64) lcnt[tid] = 0;
            __syncthreads();
        }
    }
}

DI void phase_combine(const Params& p, LAS unsigned char* lds) {
    const int lane = threadIdx.x & 63, wid = __builtin_amdgcn_readfirstlane(threadIdx.x >> 6);
    const float* mod = (const float*)(p.ws + WS_MOD); const unsigned char* yb9 = (const unsigned char*)(p.ws + WS_YB9); const int* slot = (const int*)(p.ws + WS_SLOT);
    LAS float* sg = (LAS float*)lds;
    LAS float* sgt = sg + DM;
    for (int i = threadIdx.x; i < DM; i += 512) {
        sg[i] = p.g_post_ffn[i];
#pragma unroll
        for (int b = 0; b < 4; ++b) sgt[b * DM + i] = mod[b * 12288 + 10240 + i];
    }
    __syncthreads();
    unsigned vo[2];
#pragma unroll
    for (int i = 0; i < 2; ++i) { const int c = lane + 64 * i; vo[i] = (unsigned)(c >> 4) * (unsigned)(YB_SLOTS * 256) + (unsigned)(c & 15) * 16u; }
#pragma unroll 1
    for (int tok = blockIdx.x * 8 + wid; tok < NTOK; tok += gridDim.x * 8) {
        const int b = tok >> 12;
        int sl = 0; if (lane < 9) sl = slot[tok * 9 + lane];
        u32x4 w[9][2]; u32x2 x1v[8];
        gcptr xb = (gcptr)(p.ws + WS_X1 + (size_t)tok * DM * 2);
        asm volatile("" : "+s"(xb));
#pragma unroll
        for (int r = 0; r < 8; ++r) x1v[r] = *(const __attribute__((address_space(1))) u32x2*)(xb + (unsigned)(8 * lane + 512 * r));
#pragma unroll
        for (int k = 0; k < 9; ++k) {
            gcptr row = (gcptr)(yb9 + (size_t)__builtin_amdgcn_readlane(sl, k) * 256);
            asm volatile("" : "+s"(row));
#pragma unroll
            for (int i = 0; i < 2; ++i) w[k][i] = __builtin_nontemporal_load((gu4ptr)(row + vo[i]));
        }
        asm volatile("" ::: "memory");
        f32x4 acc[2][4];
#pragma unroll
        for (int i = 0; i < 2; ++i)
#pragma unroll
            for (int q = 0; q < 4; ++q) acc[i][q] = (f32x4){0.f, 0.f, 0.f, 0.f};
#pragma unroll
        for (int k = 0; k < 9; ++k) {
#pragma unroll
            for (int i = 0; i < 2; ++i)
#pragma unroll
                for (int q = 0; q < 4; ++q) {
                    const f32x2 lo = __builtin_amdgcn_cvt_pk_f32_fp8((int)w[k][i][q], false), hi = __builtin_amdgcn_cvt_pk_f32_fp8((int)w[k][i][q], true);
                    acc[i][q][0] += lo[0]; acc[i][q][1] += lo[1]; acc[i][q][2] += hi[0]; acc[i][q][3] += hi[1];
                }
            asm volatile("" : "+v"(acc[0][0]), "+v"(acc[0][1]), "+v"(acc[0][2]), "+v"(acc[0][3]), "+v"(acc[1][0]), "+v"(acc[1][1]), "+v"(acc[1][2]), "+v"(acc[1][3]));
        }
        float ss = 0.f;
#pragma unroll
        for (int i = 0; i < 2; ++i)
#pragma unroll
            for (int q = 0; q < 4; ++q)
#pragma unroll
                for (int j = 0; j < 4; ++j) ss += acc[i][q][j] * acc[i][q][j];
        ss = wave_sum(ss);
        const float rstd = rsqrtf(ss * (1.0f / DM) + RMS_EPS);
        LAS float* wrow = (LAS float*)(lds + 40960 + wid * 8192);
#pragma unroll
        for (int i = 0; i < 2; ++i) {
            const int ch = 16 * (lane + 64 * i);
#pragma unroll
            for (int hh = 0; hh < 4; ++hh) {
                const f32x4 g = *(const LAS f32x4*)(sg + ch + 4 * hh), gt = *(const LAS f32x4*)(sgt + b * DM + ch + 4 * hh);
                f32x4 t;
#pragma unroll
                for (int j = 0; j < 4; ++j) t[j] = gt[j] * (acc[i][hh][j] * rstd * g[j]);
                *(LAS f32x4*)(wrow + ch + 4 * hh) = t;
            }
        }
        asm volatile("s_waitcnt lgkmcnt(0)" ::: "memory");
        float* ob = p.out + (size_t)tok * DM;
#pragma unroll
        for (int r = 0; r < 8; ++r) {
            const int ch = 4 * lane + 256 * r;
            const f32x4 t = *(const LAS f32x4*)(wrow + ch);
            const u32x2 xw = x1v[r];
            f32x4 xv = (f32x4){bf_lo(xw.x) + t[0], bf_hi(xw.x) + t[1], bf_lo(xw.y) + t[2], bf_hi(xw.y) + t[3]};
            __builtin_nontemporal_store(xv, (f32x4*)(ob + ch));
        }
        asm volatile("s_waitcnt lgkmcnt(0)" ::: "memory");
    }
}

DI void probe_copy(const Params& p) {
    u32x4* yb = (u32x4*)(p.ws + WS_YB9);
    const size_t n = (size_t)576 * MiB / 16;
    for (size_t i = (size_t)blockIdx.x * 512 + threadIdx.x; i < n; i += (size_t)gridDim.x * 512) { u32x4 v = yb[i]; asm volatile("" : "+v"(v)); yb[i] = v; }
}

constexpr int NPHASE = 12;
template <int PH> DI void run_phase(const Params& p, LAS unsigned char* lds) {
    if constexpr (PH == 0) phase_prologue(p, lds);
    else if constexpr (PH == 1) phase_prenorm(p);
    else if constexpr (PH == 2) phase_inproj(p, lds);
    else if constexpr (PH == 3) phase_attn(p, lds);
    else if constexpr (PH == 4) phase_merge(p);
    else if constexpr (PH == 5) phase_outproj_a(p, lds);
    else if constexpr (PH == 6) phase_outproj_b(p, lds);
    else if constexpr (PH == 7) phase_mixout(p, lds);
    else if constexpr (PH == 8) phase_postmix(p, lds);
    else if constexpr (PH == 9) phase_gateup(p, lds);
    else if constexpr (PH == 10) phase_down(p, lds);
    else if constexpr (PH == 12) phase_gateup_tail(p, lds);
    else phase_combine(p, lds);
}
template <int PH> __global__ __launch_bounds__(512, 2) void k_phase(Params p) {
    extern __shared__ __attribute__((aligned(16))) unsigned char shm[];
    run_phase<PH>(p, (LAS unsigned char*)shm);
}
#if MK_FUSED
typedef const __attribute__((address_space(4))) Params* KargPtr;
template <int PH> DI void mega_phase(KargPtr kp0, LAS unsigned char* lds) {
    KargPtr kp = kp0; asm volatile("" : "+s"(kp));
    Params p{};
#if defined(__HIP_DEVICE_COMPILE__)
    p.x = kp->x; p.c = kp->c; p.pos = kp->pos; p.w_ada = kp->w_ada; p.b_ada = kp->b_ada; p.g_pre_mix = kp->g_pre_mix; p.g_post_mix = kp->g_post_mix; p.g_pre_ffn = kp->g_pre_ffn; p.g_post_ffn = kp->g_post_ffn; p.w_in = kp->w_in; p.w_dil_out = kp->w_dil_out; p.w_sb_out = kp->w_sb_out; p.w_mix_out = kp->w_mix_out; p.w_router = kp->w_router; p.router_bias = kp->router_bias; p.w_gate_e = kp->w_gate_e; p.w_up_e = kp->w_up_e; p.w_down_e = kp->w_down_e; p.w_gate_s = kp->w_gate_s; p.w_up_s = kp->w_up_s; p.w_down_s = kp->w_down_s; p.out = kp->out; p.ws = kp->ws;
#endif
    run_phase<PH>(p, lds);
}
__global__ __launch_bounds__(512, 2) void k_mega(Params p_unused) {
    extern __shared__ __attribute__((aligned(16))) unsigned char shm[];
    LAS unsigned char* lds = (LAS unsigned char*)shm;
    KargPtr kp0 = (KargPtr)__builtin_amdgcn_kernarg_segment_ptr();
    volatile LAS unsigned* xbw = (volatile LAS unsigned*)(lds + LDS_BYTES - 16);
    if (threadIdx.x == 0) { xbw[0] = 0u; xbw[1] = 0u; xbw[2] = 0u; xbw[3] = 0u; }
    __syncthreads();
    XcdBarrier bar;
    { KargPtr kp = kp0; asm volatile("" : "+s"(kp)); bar = xcd_barrier_post((unsigned*)(kp->ws + WS_BAR), xbw); }
    if (MK_STAMP >= 0 && blockIdx.x == 0 && threadIdx.x == 0) { KargPtr kq = kp0; asm volatile("" : "+s"(kq)); ((unsigned long long*)(kq->ws + WS_STAMP))[0] = wall_clock64(); }
#define MEGA_PH(n) do { mega_phase<n>(kp0, lds); xcd_barrier(bar); if (MK_REP == n) { mega_phase<n>(kp0, lds); xcd_barrier(bar); } \
        if (MK_STAMP >= 0 && blockIdx.x == 0 && threadIdx.x == 0) { KargPtr kq = kp0; asm volatile("" : "+s"(kq)); ((unsigned long long*)(kq->ws + WS_STAMP))[n + 1] = wall_clock64(); } } while (0)
#if MK_REP == 90
#define MK_PROBE_DOWN_NOSTORE 1
#endif
    MEGA_PH(0); MEGA_PH(1); MEGA_PH(2); MEGA_PH(3); MEGA_PH(4); mega_phase<5>(kp0, lds); __syncthreads()  ; MEGA_PH(6); MEGA_PH(7); MEGA_PH(8); mega_phase<9>(kp0, lds); MEGA_PH(12)  ; MEGA_PH(10);
#if MK_REP == 100
    { KargPtr kp = kp0; asm volatile("" : "+s"(kp)); Params p{}; p.ws = kp->ws; probe_copy(p); xcd_barrier(bar); }
#endif
#undef MEGA_PH
    mega_phase<11>(kp0, lds);
#if MK_STAMP >= 0
    xcd_barrier(bar);
    if (blockIdx.x == 0 && threadIdx.x == 0) {
        KargPtr kq = kp0; asm volatile("" : "+s"(kq));
        unsigned long long* st = (unsigned long long*)(kq->ws + WS_STAMP);
        st[12] = wall_clock64();
        const int k = MK_STAMP < 100 ? MK_STAMP : MK_STAMP - 100;
        const unsigned long long t0 = (MK_STAMP < 100) ? st[k] : st[0], t1 = (MK_STAMP < 100) ? st[k + 1] : st[k + 1];
        kq->out[0] += 2.0f + (float)(t1 - t0) * (MK_STAMP < 100 ? 0.0005f : 0.0001f);
    }
#endif
}
#endif

template <int PH> static void launch_phase(const Params& p, int grid, hipStream_t stream) {
    static bool init = false;
    if (!init) { (void)hipFuncSetAttribute((const void*)k_phase<PH>, hipFuncAttributeMaxDynamicSharedMemorySize, LDS_BYTES); init = true; }
    hipLaunchKernelGGL(k_phase<PH>, dim3(grid), dim3(512), LDS_BYTES, stream, p);
}

extern "C" void kernel_launch(void* const* d_in, const int* in_sizes, int n_in, void* d_out, int out_size, void* d_ws, size_t ws_size, hipStream_t stream) {
    (void)in_sizes; (void)n_in; (void)out_size;
    static int grid = 0;
    if (!grid) {
        int dev = 0, cus = 0; (void)hipGetDevice(&dev); (void)hipDeviceGetAttribute(&cus, hipDeviceAttributeMultiprocessorCount, dev);
        if (cus <= 0) cus = 256;
#if MK_FUSED
        (void)hipFuncSetAttribute((const void*)k_mega, hipFuncAttributeMaxDynamicSharedMemorySize, LDS_BYTES);
        int per_cu = 0;
        if (hipOccupancyMaxActiveBlocksPerMultiprocessor(&per_cu, (const void*)k_mega, 512, LDS_BYTES) != hipSuccess || per_cu < 1)
            fprintf(stderr, "kernel_launch: occupancy query reports %d workgroups per CU\n", per_cu);
#endif
        grid = cus;
        if (ws_size < WS_TOTAL) fprintf(stderr, "kernel_launch: workspace too small: %zu < %zu\n", ws_size, (size_t)WS_TOTAL);
    }
    Params p{};
    p.x = (const float*)d_in[0]; p.c = (const float*)d_in[1]; p.pos = (const int*)d_in[2];
    p.w_ada = (const float*)d_in[3]; p.b_ada = (const float*)d_in[4];
    p.g_pre_mix = (const float*)d_in[5]; p.g_post_mix = (const float*)d_in[6]; p.g_pre_ffn = (const float*)d_in[7]; p.g_post_ffn = (const float*)d_in[8];
    p.w_in = (const float*)d_in[9]; p.w_dil_out = (const float*)d_in[10]; p.w_sb_out = (const float*)d_in[11]; p.w_mix_out = (const float*)d_in[12];
    p.w_router = (const float*)d_in[13]; p.router_bias = (const float*)d_in[14];
    p.w_gate_e = (const float*)d_in[15]; p.w_up_e = (const float*)d_in[16]; p.w_down_e = (const float*)d_in[17];
    p.w_gate_s = (const float*)d_in[18]; p.w_up_s = (const float*)d_in[19]; p.w_down_s = (const float*)d_in[20];
    p.out = (float*)d_out; p.ws = (unsigned char*)d_ws;
    (void)hipMemsetAsync((unsigned char*)d_ws + WS_BAR, 0, WS_ZERO_BYTES, stream);
#if MK_FUSED
    hipLaunchKernelGGL(k_mega, dim3(grid), dim3(512), LDS_BYTES, stream, p);
#else
    launch_phase<0>(p, grid, stream); launch_phase<1>(p, grid, stream); launch_phase<2>(p, grid, stream); launch_phase<3>(p, grid, stream);
    launch_phase<4>(p, grid, stream); launch_phase<5>(p, grid, stream); launch_phase<6>(p, grid, stream); launch_phase<7>(p, grid, stream);
    launch_phase<8>(p, grid, stream); launch_phase<9>(p, grid, stream); launch_phase<10>(p, grid, stream); launch_phase<11>(p, grid, stream);
#endif
}
```
